# Optimizing an MI355X kernel written in HIP

```python
import math
import jax
import jax.numpy as jnp
from jax import lax
import numpy as np


D_MODEL = 1024
BATCH = 16
SEQ = 2048
DEPTH = 2

MEM_LEN = 256
CHUNK = 128
SGU_GROUPS = 4
SGU_GROUP_DIM = 128
SGU_WIDTH = SGU_GROUPS * SGU_GROUP_DIM
DIFF_HEADS = 4
DIFF_HEAD_DIM = 64
DIFF_V_DIM = 2 * DIFF_HEAD_DIM
DIFF_QK_WIDTH = DIFF_HEADS * 2 * DIFF_HEAD_DIM
DIFF_V_WIDTH = DIFF_HEADS * DIFF_V_DIM
Q_BLOCK = 128
IN_EVEN = 2 * SGU_WIDTH + 2 * DIFF_QK_WIDTH + DIFF_V_WIDTH
MIX_EVEN = SGU_WIDTH + DIFF_V_WIDTH
S5_WIDTH = D_MODEL
S5_GROUP = 16
S5_GROUPS = S5_WIDTH // S5_GROUP
S5_STATE = 64
DT_MIN = 0.001
DT_MAX = 0.1
X_HEADS = 4
X_HEAD_DIM = D_MODEL // X_HEADS
N_EXPERTS = 32
TOP_K = 4
D_FF = D_MODEL
SWIGLU_LIMIT = 7.0
SWIGLU_ALPHA = 1.702
MOE_BLOCK = 256
ALPHA = (2 * DEPTH) ** 0.25
BETA = (8 * DEPTH) ** -0.25
LN_EPS = 1e-5
NEG_INF = -1e30

kernel_name = 'hybrid_sgu_diffattn_s5_moe_block'


def layer_norm(x, g, b):
    xf = x.astype(jnp.float32)
    mu = jnp.mean(xf, axis=-1, keepdims=True)
    var = jnp.mean(jnp.square(xf - mu), axis=-1, keepdims=True)
    return ((xf - mu) * lax.rsqrt(var + LN_EPS)).astype(x.dtype) * g + b


def rms_norm(x, g):
    xf = x.astype(jnp.float32)
    return (xf * lax.rsqrt(jnp.mean(jnp.square(xf), axis=-1, keepdims=True) + LN_EPS)).astype(x.dtype) * g


def diff_lambda_init(layer_idx):
    return 0.8 - 0.6 * math.exp(-0.3 * layer_idx)


def spatial_gating(u, v, ln_g, ln_b, w_spatial, b_spatial):
    b, s, _ = u.shape
    u = jax.nn.gelu(u)
    v = jax.nn.gelu(v).reshape(b, s, SGU_GROUPS, SGU_GROUP_DIM)
    v = layer_norm(v, ln_g.reshape(SGU_GROUPS, SGU_GROUP_DIM), ln_b.reshape(SGU_GROUPS, SGU_GROUP_DIM))
    v = v.reshape(b, s // CHUNK, CHUNK, SGU_GROUPS, SGU_GROUP_DIM)
    w = jnp.tril(w_spatial)
    gate = jnp.einsum('gts,bcsgd->bctgd', w, v) + b_spatial.T[None, None, :, :, None]
    return u * gate.reshape(b, s, SGU_WIDTH)


def diff_attention(q, k, v, lam_q1, lam_k1, lam_q2, lam_k2, subln_g, lam_init):
    b, s, _ = q.shape
    q = q.reshape(b, s, DIFF_HEADS, 2, DIFF_HEAD_DIM)
    k = k.reshape(b, s, DIFF_HEADS, 2, DIFF_HEAD_DIM)
    v = v.reshape(b, s, DIFF_HEADS, DIFF_V_DIM)
    lam = (jnp.exp(jnp.sum(lam_q1 * lam_k1).astype(jnp.float32))
           - jnp.exp(jnp.sum(lam_q2 * lam_k2).astype(jnp.float32)) + lam_init)
    n_blk = s // Q_BLOCK
    q_blocks = jnp.moveaxis(q.reshape(b, n_blk, Q_BLOCK, DIFF_HEADS, 2, DIFF_HEAD_DIM), 1, 0)
    k_pos = jnp.arange(s)
    scale = DIFF_HEAD_DIM ** -0.5

    def attend_block(args):
        qb, blk = args
        q_pos = blk * Q_BLOCK + jnp.arange(Q_BLOCK)
        mask = k_pos[None, :] <= q_pos[:, None]
        sc = jnp.einsum('bqhcd,bkhcd->bhcqk', qb, k).astype(jnp.float32) * scale
        p = jax.nn.softmax(jnp.where(mask, sc, NEG_INF), axis=-1)
        attn = p[:, :, 0] - lam * p[:, :, 1]
        return jnp.einsum('bhqk,bkhe->bqhe', attn.astype(v.dtype), v)

    o = lax.map(attend_block, (q_blocks, jnp.arange(n_blk)))
    o = jnp.moveaxis(o, 0, 1).reshape(b, s, DIFF_HEADS, DIFF_V_DIM)
    o = rms_norm(o, subln_g) * (1.0 - lam_init)
    return o.reshape(b, s, DIFF_V_WIDTH)


def even_mixer(x, w_in, sgu_ln_g, sgu_ln_b, w_spatial, b_spatial,
               lam_q1, lam_k1, lam_q2, lam_k2, subln_g, w_out, lam_init):
    h = x @ w_in
    u, v_s, q, k, v_d = jnp.split(
        h, [SGU_WIDTH, 2 * SGU_WIDTH, 2 * SGU_WIDTH + DIFF_QK_WIDTH,
            2 * SGU_WIDTH + 2 * DIFF_QK_WIDTH], axis=-1)
    a = spatial_gating(u, v_s, sgu_ln_g, sgu_ln_b, w_spatial, b_spatial)
    d = diff_attention(q, k, v_d, lam_q1, lam_k1, lam_q2, lam_k2, subln_g, lam_init)
    return jnp.concatenate([a, d], axis=-1) @ w_out


def s5_mixer(x, w_in, log_dt, lambda_re, lambda_im, b_re, b_im, c_re, c_im, d_skip, w_val, w_gate):
    b, s, _ = x.shape
    u = (x @ w_in).reshape(b, s, S5_GROUPS, S5_GROUP).astype(jnp.float32)
    dt = jnp.exp(log_dt.astype(jnp.float32))[:, None]
    lr = lambda_re.astype(jnp.float32)
    li = lambda_im.astype(jnp.float32)
    mag = jnp.exp(lr * dt)
    ar = mag * jnp.cos(li * dt)
    ai = mag * jnp.sin(li * dt)
    den = lr * lr + li * li
    zr = ((ar - 1.0) * lr + ai * li) / den
    zi = (ai * lr - (ar - 1.0) * li) / den
    br = b_re.astype(jnp.float32)
    bi = b_im.astype(jnp.float32)
    bbar_re = zr[..., None] * br - zi[..., None] * bi
    bbar_im = zr[..., None] * bi + zi[..., None] * br
    bu_re = jnp.einsum('bsgc,gpc->bsgp', u, bbar_re)
    bu_im = jnp.einsum('bsgc,gpc->bsgp', u, bbar_im)
    a_re = jnp.broadcast_to(ar, (1, s, S5_GROUPS, S5_STATE))
    a_im = jnp.broadcast_to(ai, (1, s, S5_GROUPS, S5_STATE))

    def combine(e1, e2):
        a1r, a1i, b1r, b1i = e1
        a2r, a2i, b2r, b2i = e2
        return (a2r * a1r - a2i * a1i,
                a2r * a1i + a2i * a1r,
                a2r * b1r - a2i * b1i + b2r,
                a2r * b1i + a2i * b1r + b2i)

    _, _, xr, xi = lax.associative_scan(combine, (a_re, a_im, bu_re, bu_im), axis=1)
    y = (jnp.einsum('bsgp,gcp->bsgc', xr, c_re.astype(jnp.float32))
         - jnp.einsum('bsgp,gcp->bsgc', xi, c_im.astype(jnp.float32))
         + d_skip.astype(jnp.float32) * u)
    y = jax.nn.gelu(y.reshape(b, s, S5_WIDTH)).astype(x.dtype)
    return (y @ w_val) * jax.nn.sigmoid(y @ w_gate)


def memory_cross_attention(x, k_mem, v_mem, w_q, w_o):
    b, s, _ = x.shape
    q = (x @ w_q).reshape(b, s, X_HEADS, X_HEAD_DIM)
    sc = jnp.einsum('bshd,bmhd->bhsm', q, k_mem).astype(jnp.float32) * (X_HEAD_DIM ** -0.5)
    p = jax.nn.softmax(sc, axis=-1)
    o = jnp.einsum('bhsm,bmhd->bshd', p.astype(v_mem.dtype), v_mem).reshape(b, s, D_MODEL)
    return o @ w_o


def moe_ffn(x, router_w, router_b, w_up, b_up, w_down, b_down):
    b, s, d = x.shape
    n_tok = b * s
    x2d = x.reshape(n_tok, d)
    logits = (x2d @ router_w + router_b).astype(jnp.float32)
    top_logit, top_idx = lax.top_k(logits, TOP_K)
    gates = jax.nn.softmax(top_logit, axis=-1).astype(x.dtype)
    n_assign = n_tok * TOP_K
    flat_e = top_idx.reshape(n_assign)
    flat_t = jnp.repeat(jnp.arange(n_tok, dtype=jnp.int32), TOP_K)
    flat_g = gates.reshape(n_assign)
    order = jnp.argsort(flat_e)
    se, st, sg = flat_e[order], flat_t[order], flat_g[order]
    counts = jnp.bincount(flat_e, length=N_EXPERTS)
    start = jnp.cumsum(counts) - counts
    padded = (counts + MOE_BLOCK - 1) // MOE_BLOCK * MOE_BLOCK
    pend = jnp.cumsum(padded)
    pstart = pend - padded
    dest = pstart[se] + (jnp.arange(n_assign) - start[se])
    n_blocks = -(-n_assign // MOE_BLOCK) + N_EXPERTS
    n_pad = n_blocks * MOE_BLOCK
    buf_tok = jnp.zeros((n_pad,), jnp.int32).at[dest].set(st)
    buf_gate = jnp.zeros((n_pad,), x.dtype).at[dest].set(sg)
    blk_expert = jnp.minimum(
        jnp.searchsorted(pend, jnp.arange(n_blocks) * MOE_BLOCK, side='right'), N_EXPERTS - 1)

    def expert_block(args):
        tok, gate, e = args
        h = x2d[tok] @ w_up[e] + b_up[e]
        h_glu, h_lin = jnp.split(h, 2, axis=-1)
        h_glu = jnp.minimum(h_glu, SWIGLU_LIMIT)
        h_lin = jnp.clip(h_lin, -SWIGLU_LIMIT, SWIGLU_LIMIT)
        act = h_glu * jax.nn.sigmoid(SWIGLU_ALPHA * h_glu) * (h_lin + 1.0)
        return (act @ w_down[e] + b_down[e]) * gate[:, None]

    ys = lax.map(expert_block, (buf_tok.reshape(n_blocks, MOE_BLOCK),
                                buf_gate.reshape(n_blocks, MOE_BLOCK), blk_expert))
    y = jnp.zeros_like(x2d).at[buf_tok].add(ys.reshape(n_pad, d))
    return y.reshape(b, s, d)


def setup_inputs(seed: int = 0) -> dict:
    keys = iter(jax.random.split(jax.random.key(seed), 128))

    def nrm(shape, scale):
        return scale * jax.random.normal(next(keys), shape, jnp.float32)

    def gain(shape):
        return 1.0 + nrm(shape, 0.02)

    def small(shape):
        return nrm(shape, 0.01)

    fan = D_MODEL ** -0.5
    p = {}
    p['x'] = nrm((BATCH, SEQ, D_MODEL), 1.0)
    p['mem'] = nrm((BATCH, MEM_LEN, D_MODEL), 1.0)
    p['w_mem_kv'] = nrm((D_MODEL, 2 * D_MODEL), fan)

    def common(pre):
        p[pre + 'ln1_g'] = gain((D_MODEL,))
        p[pre + 'ln1_b'] = small((D_MODEL,))
        p[pre + 'xq'] = nrm((D_MODEL, D_MODEL), fan)
        p[pre + 'xo'] = nrm((D_MODEL, D_MODEL), BETA * fan)
        p[pre + 'ln2_g'] = gain((D_MODEL,))
        p[pre + 'ln2_b'] = small((D_MODEL,))
        p[pre + 'router_w'] = nrm((D_MODEL, N_EXPERTS), fan)
        p[pre + 'router_b'] = small((N_EXPERTS,))
        p[pre + 'exp_w_up'] = nrm((N_EXPERTS, D_MODEL, 2 * D_FF), fan)
        p[pre + 'exp_b_up'] = small((N_EXPERTS, 2 * D_FF))
        p[pre + 'exp_w_down'] = nrm((N_EXPERTS, D_FF, D_MODEL), BETA * D_FF ** -0.5)
        p[pre + 'exp_b_down'] = small((N_EXPERTS, D_MODEL))
        p[pre + 'ln3_g'] = gain((D_MODEL,))
        p[pre + 'ln3_b'] = small((D_MODEL,))

    p['l0_w_in'] = nrm((D_MODEL, IN_EVEN), fan)
    p['l0_sgu_ln_g'] = gain((SGU_WIDTH,))
    p['l0_sgu_ln_b'] = small((SGU_WIDTH,))
    p['l0_w_spatial'] = nrm((SGU_GROUPS, CHUNK, CHUNK), 0.5 * CHUNK ** -0.5)
    p['l0_b_spatial'] = gain((SGU_GROUPS, CHUNK))
    p['l0_lam_q1'] = nrm((DIFF_HEAD_DIM,), 0.1)
    p['l0_lam_k1'] = nrm((DIFF_HEAD_DIM,), 0.1)
    p['l0_lam_q2'] = nrm((DIFF_HEAD_DIM,), 0.1)
    p['l0_lam_k2'] = nrm((DIFF_HEAD_DIM,), 0.1)
    p['l0_subln_g'] = gain((DIFF_V_DIM,))
    p['l0_w_out'] = nrm((MIX_EVEN, D_MODEL), BETA * MIX_EVEN ** -0.5)
    common('l0_')
    p['l1_w_in'] = nrm((D_MODEL, S5_WIDTH), fan)
    p['l1_log_dt'] = jax.random.uniform(next(keys), (S5_GROUPS,), jnp.float32,
                                        minval=math.log(DT_MIN), maxval=math.log(DT_MAX))
    p['l1_lambda_re'] = -0.5 + small((S5_GROUPS, S5_STATE))
    p['l1_lambda_im'] = (math.pi * jnp.arange(S5_STATE, dtype=jnp.float32))[None, :] + small((S5_GROUPS, S5_STATE))
    p['l1_b_re'] = nrm((S5_GROUPS, S5_STATE, S5_GROUP), (2 * S5_GROUP) ** -0.5)
    p['l1_b_im'] = nrm((S5_GROUPS, S5_STATE, S5_GROUP), (2 * S5_GROUP) ** -0.5)
    p['l1_c_re'] = nrm((S5_GROUPS, S5_GROUP, S5_STATE), 0.5)
    p['l1_c_im'] = nrm((S5_GROUPS, S5_GROUP, S5_STATE), 0.5)
    p['l1_d_skip'] = nrm((S5_GROUPS, S5_GROUP), 1.0)
    p['l1_w_val'] = nrm((S5_WIDTH, D_MODEL), BETA * S5_WIDTH ** -0.5)
    p['l1_w_gate'] = nrm((S5_WIDTH, D_MODEL), S5_WIDTH ** -0.5)
    common('l1_')
    return p


def reference(x, mem, w_mem_kv,
              l0_w_in, l0_sgu_ln_g, l0_sgu_ln_b, l0_w_spatial, l0_b_spatial,
              l0_lam_q1, l0_lam_k1, l0_lam_q2, l0_lam_k2, l0_subln_g, l0_w_out,
              l0_ln1_g, l0_ln1_b, l0_xq, l0_xo, l0_ln2_g, l0_ln2_b,
              l0_router_w, l0_router_b, l0_exp_w_up, l0_exp_b_up, l0_exp_w_down, l0_exp_b_down,
              l0_ln3_g, l0_ln3_b,
              l1_w_in, l1_log_dt, l1_lambda_re, l1_lambda_im, l1_b_re, l1_b_im, l1_c_re, l1_c_im,
              l1_d_skip, l1_w_val, l1_w_gate,
              l1_ln1_g, l1_ln1_b, l1_xq, l1_xo, l1_ln2_g, l1_ln2_b,
              l1_router_w, l1_router_b, l1_exp_w_up, l1_exp_b_up, l1_exp_w_down, l1_exp_b_down,
              l1_ln3_g, l1_ln3_b):
    b = mem.shape[0]
    kv = mem @ w_mem_kv
    k_mem = kv[..., :D_MODEL].reshape(b, MEM_LEN, X_HEADS, X_HEAD_DIM)
    v_mem = kv[..., D_MODEL:].reshape(b, MEM_LEN, X_HEADS, X_HEAD_DIM)

    layers = [
        dict(mixer=(l0_w_in, l0_sgu_ln_g, l0_sgu_ln_b, l0_w_spatial, l0_b_spatial,
                    l0_lam_q1, l0_lam_k1, l0_lam_q2, l0_lam_k2, l0_subln_g, l0_w_out),
             ln1=(l0_ln1_g, l0_ln1_b), cross=(l0_xq, l0_xo), ln2=(l0_ln2_g, l0_ln2_b),
             moe=(l0_router_w, l0_router_b, l0_exp_w_up, l0_exp_b_up, l0_exp_w_down, l0_exp_b_down),
             ln3=(l0_ln3_g, l0_ln3_b)),
        dict(mixer=(l1_w_in, l1_log_dt, l1_lambda_re, l1_lambda_im, l1_b_re, l1_b_im,
                    l1_c_re, l1_c_im, l1_d_skip, l1_w_val, l1_w_gate),
             ln1=(l1_ln1_g, l1_ln1_b), cross=(l1_xq, l1_xo), ln2=(l1_ln2_g, l1_ln2_b),
             moe=(l1_router_w, l1_router_b, l1_exp_w_up, l1_exp_b_up, l1_exp_w_down, l1_exp_b_down),
             ln3=(l1_ln3_g, l1_ln3_b)),
    ]
    for i in range(DEPTH):
        prm = layers[i]
        if i % 2 == 0:
            h = even_mixer(x, *prm['mixer'], lam_init=diff_lambda_init(i))
        else:
            h = s5_mixer(x, *prm['mixer'])
        x = layer_norm(ALPHA * x + h, *prm['ln1'])
        x = layer_norm(ALPHA * x + memory_cross_attention(x, k_mem, v_mem, *prm['cross']), *prm['ln2'])
        x = layer_norm(ALPHA * x + moe_ffn(x, *prm['moe']), *prm['ln3'])
    return x
```

```cpp
#include <hip/hip_runtime.h>
#include <hip/hip_bf16.h>
#include <cstdio>
#include <cstdint>

#ifndef MK_N_LAUNCHES
#define MK_N_LAUNCHES 1
#endif

#ifndef MOE_FP8
#define MOE_FP8 1
#endif
#ifndef PROBE_VARIANT
#define PROBE_VARIANT 0
#endif
#ifndef PROBE_REPEAT_MASK
#define PROBE_REPEAT_MASK 0ull
#endif
#define GAS __attribute__((address_space(1)))
#define LAS __attribute__((address_space(3)))
typedef unsigned short bf16;
typedef unsigned v4u __attribute__((ext_vector_type(4)));
typedef unsigned v2u __attribute__((ext_vector_type(2)));
typedef float f32x4 __attribute__((ext_vector_type(4)));
typedef float f32x2 __attribute__((ext_vector_type(2)));
typedef short bf16x8 __attribute__((ext_vector_type(8)));
typedef int v4i_t __attribute__((ext_vector_type(4)));
typedef GAS unsigned gu32;
#define RLX_AGENT __ATOMIC_RELAXED, __HIP_MEMORY_SCOPE_AGENT
#define LDS_WAIT() asm volatile("s_waitcnt lgkmcnt(0)" ::: "memory")
#define VM_WAIT() asm volatile("s_waitcnt vmcnt(0)" ::: "memory")

constexpr int NB = 16, SEQ = 2048, DM = 1024, MTOK = NB * SEQ;
constexpr int MEMLEN = 256, NEXP = 32, TOPK = 4, NASSIGN = MTOK * TOPK;
constexpr int HW0 = 2560;
constexpr int CAP = MTOK;
constexpr int MAXBLK = NASSIGN / 256 + NEXP;
constexpr float LN_EPS = 1e-5f;
constexpr float ALPHA = 1.41421356237f;
constexpr float LOG2E = 1.4426950408889634f;
constexpr float C2 = 0.125f * LOG2E;
constexpr float CSC = 0.0625f * LOG2E;
constexpr float LAM_INIT0 = 0.2f;

constexpr size_t MiB = 1u << 20;
constexpr size_t WS_CTL = 0, CTL_ZERO_BYTES = 96 * 1024;
constexpr size_t WS_LIST = 1 * MiB;
constexpr size_t WS_GATE = WS_LIST + 4 * MiB;
constexpr size_t WS_ASG = WS_GATE + 512 * 1024;
constexpr size_t WS_LOGIT = WS_GATE + 1 * MiB;
constexpr size_t WS_WKV = WS_LOGIT + 4 * MiB;
constexpr size_t WS_WIN0 = WS_WKV + 4 * MiB;
constexpr size_t WS_WOUT0 = WS_WIN0 + 5 * MiB;
constexpr size_t WS_XQB = WS_WOUT0 + 2 * MiB;
constexpr size_t WS_XOT = WS_XQB + 4 * MiB;
constexpr size_t WS_WIN1 = WS_XOT + 4 * MiB;
constexpr size_t WS_WVG = WS_WIN1 + 2 * MiB;
constexpr size_t WS_WR = WS_WVG + 4 * MiB;
constexpr size_t WS_MEMB = WS_WR + 1 * MiB;
constexpr size_t WS_KB = WS_MEMB + 8 * MiB;
constexpr size_t WS_VB = WS_KB + 8 * MiB;
constexpr size_t WS_KFT = WS_VB + 8 * MiB;
constexpr size_t WS_VFT = WS_KFT + 32 * MiB;
constexpr size_t WS_WUP = WS_VFT + 32 * MiB;
constexpr size_t WS_WDN = WS_WUP + 128 * MiB;
constexpr size_t WS_XB = WS_WDN + 64 * MiB;
constexpr size_t WS_ZB = WS_XB + 64 * MiB;
constexpr size_t WS_BIG1 = WS_ZB + 64 * MiB;
constexpr size_t WS_BIG2 = WS_BIG1 + 272 * MiB;
constexpr size_t WS_END = WS_BIG2 + 272 * MiB;
static_assert(WS_END <= 1024 * MiB, "workspace map exceeds 1 GiB");
constexpr size_t WS_UV = WS_BIG1;
constexpr size_t WS_QX = WS_BIG1 + 64 * MiB;
constexpr size_t WS_KX = WS_BIG1 + 128 * MiB;
constexpr size_t WS_VX = WS_BIG1 + 192 * MiB;
constexpr size_t WS_SC = WS_BIG1;
constexpr size_t WS_WUP8 = WS_WUP;
constexpr size_t WS_WDN8 = WS_WUP + 64 * MiB;
constexpr size_t WS_XF8 = WS_WUP + 96 * MiB;
constexpr float SX8 = 4.0f, SWU8 = 64.0f, SA8 = 4.0f, SWD8 = 128.0f, SP8 = 256.0f, SV8 = 8.0f, SK8 = 32.0f, SY8 = 32.0f;
constexpr size_t WS_XFZ = WS_WDN;
constexpr size_t WS_SCC = WS_WDN + 32 * MiB;
constexpr size_t WS_ST2 = WS_WDN + 40 * MiB;
constexpr size_t WS_ST = WS_LOGIT;
constexpr float SZ8 = 8.0f;
constexpr size_t WS_ACT = WS_BIG1;
constexpr size_t WS_OATT = WS_BIG2;
constexpr size_t WS_MIX = WS_BIG2 + 64 * MiB;
constexpr size_t WS_P = WS_BIG2 + 128 * MiB;
constexpr size_t WS_UG = WS_BIG2;
constexpr size_t WS_YB = WS_BIG2 + 64 * MiB;
constexpr size_t WS_XG = WS_BIG2;
constexpr size_t WS_YS = WS_BIG2;

constexpr int CW_TMO = 0;
constexpr int CW_BAR = 4096;
constexpr int CW_CNT = 16384;
static_assert((CW_CNT + 64 * 64) * 4 <= (int)CTL_ZERO_BYTES && (CW_BAR + 3456) * 4 <= (int)CTL_ZERO_BYTES, "control words inside the per-call memset");

constexpr int RING_BYTES = 131072;
constexpr int SCR_BYTES = 135168;
constexpr int LDSCTL_OFF = SCR_BYTES, MISC_OFF = LDSCTL_OFF + 320;
constexpr int TAB_OFF = MISC_OFF + 128;
constexpr int SMX_OFF = TAB_OFF + 576;
constexpr int LDS_BYTES = 147456;
static_assert(SMX_OFF % 16 == 0 && SMX_OFF + 8192 <= LDS_BYTES, "LDS map");

__device__ __forceinline__ unsigned f2bf(float f) { unsigned u = __builtin_bit_cast(unsigned, f); return (u + 0x7fffu + ((u >> 16) & 1u)) >> 16; }
__device__ __forceinline__ unsigned pk2(float lo, float hi) { return f2bf(lo) | (f2bf(hi) << 16); }
__device__ __forceinline__ float bflo(unsigned w) { return __builtin_bit_cast(float, w << 16); }
__device__ __forceinline__ float bfhi(unsigned w) { return __builtin_bit_cast(float, w & 0xffff0000u); }
__device__ __forceinline__ float bf2f(bf16 b) { return __builtin_bit_cast(float, ((unsigned)b) << 16); }
__device__ __forceinline__ float wave_sum(float v) {
#pragma unroll
    for (int o = 1; o < 64; o <<= 1) v += __shfl_xor(v, o);
    return v;
}
__device__ __forceinline__ float wave_max(float v) {
#pragma unroll
    for (int o = 1; o < 64; o <<= 1) v = fmaxf(v, __shfl_xor(v, o));
    return v;
}
__device__ __forceinline__ float gelu_tanh(float x) {
    const float t = x * (0.7978845608f * 2.0f * LOG2E) * (1.0f + 0.044715f * x * x);
    return x * __builtin_amdgcn_rcpf(1.0f + __builtin_amdgcn_exp2f(-t));
}
__device__ __forceinline__ float sigmoidf_(float x) { return __builtin_amdgcn_rcpf(1.0f + __builtin_amdgcn_exp2f(-x * LOG2E)); }

namespace pg8 {
constexpr int BM = 256, BK = 64, HALF = 128, HTB = HALF * BK * 2, STAGE_BYTES = 8 * HTB, NXCD = 8, WGM = 8;
constexpr int LD = 1024;
constexpr size_t HSTEP = (size_t)HALF * LD * 2, TSTEP = 2 * HSTEP;
__host__ __device__ __forceinline__ int lds_byte(int r, int c) { const int st = (r >> 4) * 2 + (c >> 5), rr = r & 15, cc = c & 31, ob = rr * 64 + cc * 2; return st * 1024 + (ob ^ (((ob >> 9) & 1) << 5)); }
__host__ __device__ __forceinline__ void stage_rc(int b, int& R, int& C) { const int st = b / 1024, sb = b % 1024, swz = sb ^ (((sb >> 9) & 1) << 5); R = (st >> 1) * 16 + swz / 64; C = (st & 1) * 32 + (swz % 64) / 2; }
__host__ __device__ __forceinline__ int perm32(int rho) { const int n = rho >> 4, i = rho & 15; return 8 * (i >> 2) + 4 * n + (i & 3); }

struct Unit { const char* a; const char* b; int row0, col0, z, aux, par; };
template <class E, class = void> struct epi_has_pre { static constexpr bool value = false; };
template <class E> struct epi_has_pre<E, decltype((void)E::HAS_PRE)> { static constexpr bool value = true; };

struct TileOrder {
    int nM, nN, nwg, G, c;
    __device__ void init(int nM_, int nN_, int G_, int c_) { nM = nM_; nN = nN_; nwg = nM * nN; G = G_; c = c_; }
    __device__ bool get(int i, int& pm, int& pn) const {
        const long L = (long)i * G + c; if (L >= nwg) return false;
        int wgid = (int)L; { const int q = nwg / NXCD, r = nwg % NXCD, xcd = wgid % NXCD, off = wgid / NXCD; wgid = (xcd < r ? xcd * (q + 1) : r * (q + 1) + (xcd - r) * q) + off; }
        const int nig = WGM * nN, gid = wgid / nig, fm = gid * WGM, gsz = (nM - fm) < WGM ? (nM - fm) : WGM;
        pm = fm + ((wgid % nig) % gsz); pn = (wgid % nig) / gsz; return true;
    }
};

__device__ __forceinline__ unsigned cvt_pk_bf16(float lo, float hi) { unsigned r; asm volatile("v_cvt_pk_bf16_f32 %0, %1, %2" : "=v"(r) : "v"(lo), "v"(hi)); return r; }

template <class Epi, class Sched, bool GATHER = false, bool FP8 = false, int ALAY = 0>
__device__ __forceinline__ void gemm_phase(LAS unsigned char* lds, const int K, const Sched& S, const Epi& E) {
    int tid = threadIdx.x; asm volatile("" : "+v"(tid));
    const int wid = __builtin_amdgcn_readfirstlane(tid >> 6), lane = tid & 63, wr = wid >> 2, wc = wid & 3, fr = lane & 15, fq = lane >> 4;
    constexpr unsigned ROWB = FP8 ? 1024u : 2048u;
    const int nt = FP8 ? K / 128 : K / BK;
    unsigned voffA[2], voffB[2]; int RA[2], CA[2];
#pragma unroll
    for (int i = 0; i < 2; ++i) { int R, C; stage_rc(tid * 16 + i * 8192, R, C); const int Rb = (R & ~31) + perm32(R & 31);
        voffA[i] = ALAY ? (unsigned)(C >> 3) * (unsigned)(MTOK * 16) + (unsigned)R * 16u : (unsigned)R * ROWB + (unsigned)C * 2u; voffB[i] = (unsigned)Rb * ROWB + (unsigned)C * 2u; RA[i] = R; CA[i] = C; }
    const size_t kstep = (size_t)(BK * 2);
    const size_t kstepA = ALAY ? (size_t)8 * MTOK * 16 : kstep;
    const size_t hstepB = (size_t)HALF * ROWB;
    const size_t hstepA = GATHER ? 0 : (ALAY ? (size_t)HALF * 16 : (size_t)HALF * ROWB);
    const unsigned ldsw = (unsigned)wid * 1024u;
    const int aoff0 = lds_byte(wr * 64 + fr, fq * 8);
    const int boff0 = lds_byte(wc * 32 + fr, fq * 8);
    unsigned aB = (unsigned)(uintptr_t)lds + (unsigned)aoff0, bB = (unsigned)(uintptr_t)lds + 4u * HTB + (unsigned)boff0; asm volatile("" : "+v"(aB), "+v"(bB));
    constexpr int KOFF = 1024;
#define PG8_SA(b, h) (((b) * 2 + (h)) * HTB)
#define PG8_SB(b, h) ((4 + (b) * 2 + (h)) * HTB)
#define PG8_STAGE(bufoff, gbase, voff) do { _Pragma("unroll") for (int _i = 0; _i < 2; ++_i) \
        __builtin_amdgcn_global_load_lds((const unsigned*)((const char*)(gbase) + (voff)[_i]), (LAS unsigned*)(lds + (bufoff) + ldsw + _i * 8192), 16, 0, 0); } while (0)
#define PG8_LD32(base, off0) __builtin_shufflevector(*(const LAS v4i_t*)((base) + (unsigned)(off0)), *(const LAS v4i_t*)((base) + (unsigned)((off0) + KOFF)), 0, 1, 2, 3, 4, 5, 6, 7)
#define PG8_LDA(dst, b, h) do { if constexpr (FP8) { _Pragma("unroll") for (int m = 0; m < 4; ++m) dst##8[m] = PG8_LD32(aB, PG8_SA(b, h) + m * 2048); } else { _Pragma("unroll") for (int m = 0; m < 4; ++m) _Pragma("unroll") for (int k = 0; k < 2; ++k) dst[m][k] = *(const LAS bf16x8*)(aB + (unsigned)(PG8_SA(b, h) + m * 2048 + k * KOFF)); } } while (0)
#define PG8_LDB(dst, b, h) do { if constexpr (FP8) { _Pragma("unroll") for (int n = 0; n < 2; ++n) dst##8[n] = PG8_LD32(bB, PG8_SA(b, h) + n * 2048); } else { _Pragma("unroll") for (int n = 0; n < 2; ++n) _Pragma("unroll") for (int k = 0; k < 2; ++k) dst[n][k] = *(const LAS bf16x8*)(bB + (unsigned)(PG8_SA(b, h) + n * 2048 + k * KOFF)); } } while (0)
#define PG8_MMA(ai, bj, At, Bt) do { __builtin_amdgcn_s_setprio(1); _Pragma("unroll") for (int m = 0; m < 4; ++m) _Pragma("unroll") for (int n = 0; n < 2; ++n) { \
        if constexpr (FP8) asm volatile("v_mfma_scale_f32_16x16x128_f8f6f4 %0, %1, %2, %0, %3, %3 op_sel_hi:[0,0,0]" : "+v"(acc[ai][bj][m][n]) : "v"(Bt##8[n]), "v"(At##8[m]), "v"(sc8)); \
        else { _Pragma("unroll") for (int k = 0; k < 2; ++k) acc[ai][bj][m][n] = __builtin_amdgcn_mfma_f32_16x16x32_bf16(Bt[n][k], At[m][k], acc[ai][bj][m][n], 0, 0, 0); } } __builtin_amdgcn_s_setprio(0); } while (0)
#define PG8_WAIT_V(n) asm volatile("s_waitcnt vmcnt(" #n ")" ::: "memory")
#define PG8_WAIT_L(n) asm volatile("s_waitcnt lgkmcnt(" #n ")" ::: "memory")
#define PG8_BAR __builtin_amdgcn_s_barrier()
#define PG8_SCHED __builtin_amdgcn_sched_barrier(0)
    Unit cur, nxt; int ui = 0;
    if (!S.next(0, cur)) return;
    f32x4 acc[2][2][4][2];
#pragma unroll
    for (int a = 0; a < 2; ++a)
#pragma unroll
        for (int b = 0; b < 2; ++b)
#pragma unroll
            for (int m = 0; m < 4; ++m)
#pragma unroll
                for (int n = 0; n < 2; ++n) acc[a][b][m][n] = (f32x4){0.f, 0.f, 0.f, 0.f};
    typedef int v8i_t __attribute__((ext_vector_type(8)));
    bf16x8 At[4][2], B0[2][2], B1[2][2]; v8i_t At8[4], B08[2], B18[2];
    int sc8 = 0x7f7f7f7f; asm volatile("" : "+v"(sc8));
    const char* cA = cur.a; const char* cB = cur.b;
    unsigned vA0[2], vA1[2], nA0[2], nA1[2];
    if constexpr (GATHER) { const int* rw = S.rows(cur);
#pragma unroll
        for (int i = 0; i < 2; ++i) { vA0[i] = (unsigned)Sched::rowmap(rw[RA[i]]) * ROWB + (unsigned)CA[i] * 2u; vA1[i] = (unsigned)Sched::rowmap(rw[128 + RA[i]]) * ROWB + (unsigned)CA[i] * 2u; nA0[i] = vA0[i]; nA1[i] = vA1[i]; } }
    else {
#pragma unroll
        for (int i = 0; i < 2; ++i) { vA0[i] = voffA[i]; vA1[i] = voffA[i]; nA0[i] = voffA[i]; nA1[i] = voffA[i]; } }
    cur.par = 0; if constexpr (epi_has_pre<Epi>::value) E.pre(cur, wid, lane);
    PG8_STAGE(PG8_SB(0, 0), cB, voffB); PG8_STAGE(PG8_SB(0, 1), cB + hstepB, voffB); PG8_STAGE(PG8_SA(0, 0), cA, vA0); PG8_STAGE(PG8_SA(0, 1), cA + hstepA, vA1);
    if (wr == 1) PG8_BAR;
    PG8_WAIT_V(2); PG8_BAR;
    PG8_STAGE(PG8_SB(1, 0), cB + kstep, voffB); PG8_STAGE(PG8_SA(1, 0), cA + kstepA, vA0); PG8_STAGE(PG8_SB(1, 1), cB + hstepB + kstep, voffB);
    PG8_WAIT_V(6); PG8_BAR;
    for (;;) {
        const bool has_next = S.next(ui + 1, nxt);
        const char* nA = has_next ? nxt.a : cA; const char* nB = has_next ? nxt.b : cB;
        int ri[4] = {0, 0, 0, 0};
        if constexpr (GATHER) { if (has_next) { const int* rw = S.rows(nxt);
#pragma unroll
            for (int i = 0; i < 4; ++i) { const int* pp = rw + (i >> 1) * 128 + RA[i & 1]; asm volatile("global_load_dword %0, %1, off" : "=v"(ri[i]) : "v"(pp) : "memory"); } } }
#pragma nounroll
        for (int t = 0; t < nt; t += 2) {
            const bool last = (t == nt - 2);
            if constexpr (GATHER) { if (last && has_next) { asm volatile("s_waitcnt vmcnt(8) ; ROWIDX" : "+v"(ri[0]), "+v"(ri[1]), "+v"(ri[2]), "+v"(ri[3]) :: "memory");
#pragma unroll
                for (int i = 0; i < 2; ++i) { nA0[i] = (unsigned)Sched::rowmap(ri[i]) * ROWB + (unsigned)CA[i] * 2u; nA1[i] = (unsigned)Sched::rowmap(ri[2 + i]) * ROWB + (unsigned)CA[i] * 2u; } } }
            const char* a1 = cA + (size_t)(t + 1) * kstepA;
            const char* a2 = last ? nA : cA + (size_t)(t + 2) * kstepA; const char* b2 = last ? nB : cB + (size_t)(t + 2) * kstep;
            const char* a3 = a2 + kstepA; const char* b3 = b2 + kstep;
            unsigned w0[2], w1[2];
#pragma unroll
            for (int i = 0; i < 2; ++i) { w0[i] = last ? nA0[i] : vA0[i]; w1[i] = last ? nA1[i] : vA1[i]; }
            PG8_LDB(B0, 0, 0); PG8_LDB(B1, 0, 1); PG8_SCHED; PG8_LDA(At, 0, 0); PG8_STAGE(PG8_SA(1, 1), a1 + hstepA, vA1);
            PG8_WAIT_V(8); PG8_WAIT_L(0); PG8_BAR; PG8_MMA(0, 0, At, B0); PG8_MMA(0, 1, At, B1); PG8_BAR; PG8_SCHED;
            PG8_LDA(At, 0, 1); PG8_STAGE(PG8_SB(0, 0), b2, voffB); PG8_STAGE(PG8_SB(0, 1), b2 + hstepB, voffB); PG8_STAGE(PG8_SA(0, 0), a2, w0);
            PG8_WAIT_V(8); PG8_WAIT_L(0); PG8_BAR; PG8_MMA(1, 0, At, B0); PG8_MMA(1, 1, At, B1); PG8_BAR; PG8_SCHED;
            PG8_LDB(B0, 1, 0); PG8_LDB(B1, 1, 1); PG8_SCHED; PG8_LDA(At, 1, 0); PG8_STAGE(PG8_SA(0, 1), a2 + hstepA, w1);
            PG8_WAIT_V(8); PG8_WAIT_L(0); PG8_BAR; PG8_MMA(0, 0, At, B0); PG8_MMA(0, 1, At, B1); PG8_BAR; PG8_SCHED;
            PG8_LDA(At, 1, 1); PG8_STAGE(PG8_SB(1, 0), b3, voffB); PG8_STAGE(PG8_SB(1, 1), b3 + hstepB, voffB); PG8_STAGE(PG8_SA(1, 0), a3, w0);
            PG8_WAIT_V(8); PG8_WAIT_L(0); PG8_BAR; PG8_MMA(1, 0, At, B0); PG8_MMA(1, 1, At, B1); PG8_BAR; PG8_SCHED;
        }
        if constexpr (epi_has_pre<Epi>::value) { if (has_next) { nxt.par = (ui + 1) & 1; E.pre(nxt, wid, lane); } }
        if (wr == 0) PG8_BAR;
        if constexpr (FP8) asm volatile("s_nop 15\n\ts_nop 15" ::: "memory");
        E(acc, cur, wr, wc, fr, fq);
        if (!has_next) break;
#pragma unroll
        for (int a = 0; a < 2; ++a)
#pragma unroll
            for (int b = 0; b < 2; ++b)
#pragma unroll
                for (int m = 0; m < 4; ++m)
#pragma unroll
                    for (int n = 0; n < 2; ++n) acc[a][b][m][n] = (f32x4){0.f, 0.f, 0.f, 0.f};
        cur = nxt; cA = nA; cB = nB; ++ui;
#pragma unroll
        for (int i = 0; i < 2; ++i) { vA0[i] = nA0[i]; vA1[i] = nA1[i]; }
        if (wr == 1) PG8_BAR;
    }
    PG8_WAIT_V(0);
    PG8_BAR;
#undef PG8_SA
#undef PG8_SB
#undef PG8_STAGE
#undef PG8_LDA
#undef PG8_LDB
#undef PG8_MMA
#undef PG8_LD32
#undef PG8_WAIT_V
#undef PG8_WAIT_L
#undef PG8_BAR
#undef PG8_SCHED
}
}
namespace attn_body {
using bf16=__hip_bfloat16;
using bf16x8=__attribute__((ext_vector_type(8)))short;
using s16x4=__attribute__((ext_vector_type(4)))short;
using f32x16=__attribute__((ext_vector_type(16)))float;
using u32x4=__attribute__((ext_vector_type(4)))unsigned;
constexpr int BATCH=16,NHEAD=16,SEQ=2048,D=64,DM=NHEAD*D;
constexpr int NW=8,QBLK=32,QB=QBLK*NW,KVBLK=64,NQB=SEQ/QB;
constexpr int ATTN_PITCH=DM, ATTN_UNIT_ROWS=QB;
__device__ __forceinline__ int crow(int r,int hi){return (r&3)+8*(r>>2)+4*hi;}
#define SBAR() __builtin_amdgcn_sched_barrier(0)
__device__ __forceinline__ void cmask(f32x16&p0,f32x16&p1,int jb,int qrel,int hi){
  const float NEG=-INFINITY; int kb=64*jb+4*hi;
  #pragma unroll
  for(int r=0;r<16;++r){int kv=kb+(r&3)+8*(r>>2); if(kv>qrel)p0[r]=NEG; if(kv+32>qrel)p1[r]=NEG;}
}

constexpr int NSLOT=3, SLOTB=8192;
constexpr int LDS_K=0, LDS_V=NSLOT*SLOTB, LDS_WS=2*NSLOT*SLOTB, LDS_OST=LDS_WS+NW*64*4, LDS_BYTES=LDS_OST+NW*4096;
constexpr float C2=0.125f*1.4426950408889634f;
__device__ __forceinline__ void glds16(const void*gsrc,unsigned lds_dst){unsigned keep;
  asm volatile("s_mov_b32 %0, m0\n\ts_mov_b32 m0, %2\n\ts_nop 0\n\tglobal_load_lds_dwordx4 %1, off\n\ts_mov_b32 m0, %0":"=&s"(keep):"v"(gsrc),"s"(lds_dst):"memory");}
__device__ __forceinline__ float max3f(float a,float b,float c){float r;asm("v_max3_f32 %0, %1, %2, %3":"=v"(r):"v"(a),"v"(b),"v"(c));return r;}
__device__ __forceinline__ float max2f(float a,float b){float r;asm("v_max_f32_e32 %0, %1, %2":"=v"(r):"v"(a),"v"(b));return r;}
__device__ __forceinline__ float fadd_s(float a,float b){float r;asm("v_add_f32_e32 %0, %1, %2":"=v"(r):"v"(a),"v"(b));return r;}
__device__ __forceinline__ float fsub_s(float a,float b){float r;asm("v_sub_f32_e32 %0, %1, %2":"=v"(r):"v"(a),"v"(b));return r;}
typedef float f32x2_t __attribute__((ext_vector_type(2))); typedef __bf16 bf16x2_t __attribute__((ext_vector_type(2)));
__device__ __forceinline__ unsigned cvtpk_s(float lo,float hi){f32x2_t v={lo,hi};bf16x2_t b=__builtin_convertvector(v,bf16x2_t);return __builtin_bit_cast(unsigned,b);}
#define WAIT_BAR(N) asm volatile("s_waitcnt vmcnt(" #N ") lgkmcnt(0)\n\ts_barrier":::"memory")

__device__ __forceinline__ void qkt(f32x16&p0,f32x16&p1,const char*Kslot,const bf16x8*qr,const f32x16&negm,int r32,int hi){
  const char*kb=Kslot+hi*1024+r32*16;
  #pragma unroll
  for(int d0=0;d0<4;++d0){
    const bf16x8 b0=*reinterpret_cast<const bf16x8*>(kb+d0*2048);
    const bf16x8 b1=*reinterpret_cast<const bf16x8*>(kb+d0*2048+512);
    if(d0==0){p0=__builtin_amdgcn_mfma_f32_32x32x16_bf16(b0,qr[0],negm,0,0,0);p1=__builtin_amdgcn_mfma_f32_32x32x16_bf16(b1,qr[0],negm,0,0,0);}
    else{p0=__builtin_amdgcn_mfma_f32_32x32x16_bf16(b0,qr[d0],p0,0,0,0);p1=__builtin_amdgcn_mfma_f32_32x32x16_bf16(b1,qr[d0],p1,0,0,0);}}
}
typedef __attribute__((address_space(3))) const char* lds_cptr;
typedef short v4i16_t __attribute__((ext_vector_type(4)));
__device__ __forceinline__ void kload8(bf16x8*kf,lds_cptr kp){
  kf[0]=*(const __attribute__((address_space(3))) bf16x8*)(kp);      kf[1]=*(const __attribute__((address_space(3))) bf16x8*)(kp+512);
  kf[2]=*(const __attribute__((address_space(3))) bf16x8*)(kp+2048); kf[3]=*(const __attribute__((address_space(3))) bf16x8*)(kp+2560);
  kf[4]=*(const __attribute__((address_space(3))) bf16x8*)(kp+4096); kf[5]=*(const __attribute__((address_space(3))) bf16x8*)(kp+4608);
  kf[6]=*(const __attribute__((address_space(3))) bf16x8*)(kp+6144); kf[7]=*(const __attribute__((address_space(3))) bf16x8*)(kp+6656);
}
__device__ __forceinline__ void kload2(bf16x8*kf,lds_cptr kp,int j){ kf[2*j]=*(const __attribute__((address_space(3))) bf16x8*)(kp+j*2048); kf[2*j+1]=*(const __attribute__((address_space(3))) bf16x8*)(kp+j*2048+512); }
__device__ __forceinline__ s16x4 vtr(lds_cptr p){ return __builtin_bit_cast(s16x4,__builtin_amdgcn_ds_read_tr16_b64_v4i16((__attribute__((address_space(3))) v4i16_t*)p)); }
__device__ __forceinline__ float rowmax(const f32x16&p0,const f32x16&p1){
  float a=max3f(p0[0],p0[1],p1[0]),b=max3f(p0[2],p0[3],p1[1]);a=max3f(a,p1[2],p1[3]);
  #pragma unroll
  for(int r=4;r<16;r+=4){a=max3f(a,p0[r],p0[r+1]);b=max3f(b,p0[r+2],p0[r+3]);a=max3f(a,p1[r],p1[r+1]);b=max3f(b,p1[r+2],p1[r+3]);}
  const float m=max2f(a,b);
  auto rr=__builtin_amdgcn_permlane32_swap(__float_as_uint(m),__float_as_uint(m),false,false);
  return max2f(__uint_as_float(rr[0]),__uint_as_float(rr[1]));
}
__device__ __forceinline__ void pv(f32x16*o,int vb,bf16x8 pa0,bf16x8 pa1,bf16x8 pa2,bf16x8 pa3){
  #pragma unroll
  for(int d0=0;d0<2;++d0){s16x4 lo[4],hi[4];
    #pragma unroll
    for(int ks=0;ks<4;++ks){
      asm volatile("ds_read_b64_tr_b16 %0,%1 offset:%c2":"=&v"(lo[ks]):"v"(vb),"i"(d0*4096+ks*1024):"memory");
      asm volatile("ds_read_b64_tr_b16 %0,%1 offset:%c2":"=&v"(hi[ks]):"v"(vb),"i"(d0*4096+ks*1024+512):"memory");}
    asm volatile("s_waitcnt lgkmcnt(0)":::"memory");SBAR();
    #define PK(k) (bf16x8){lo[k][0],lo[k][1],lo[k][2],lo[k][3],hi[k][0],hi[k][1],hi[k][2],hi[k][3]}
    o[d0]=__builtin_amdgcn_mfma_f32_32x32x16_bf16(pa0,PK(0),o[d0],0,0,0);
    o[d0]=__builtin_amdgcn_mfma_f32_32x32x16_bf16(pa1,PK(1),o[d0],0,0,0);
    o[d0]=__builtin_amdgcn_mfma_f32_32x32x16_bf16(pa2,PK(2),o[d0],0,0,0);
    o[d0]=__builtin_amdgcn_mfma_f32_32x32x16_bf16(pa3,PK(3),o[d0],0,0,0);
    #undef PK
  }
}

#ifndef ATTN_STORE16
#define ATTN_STORE16(p,v) (*(u32x4*)(p)=(v))
#endif
template<int THRL> __device__ __forceinline__ void attn_unit(int b,int h,int qb,const bf16*Q,const bf16*__restrict__ K,const bf16*__restrict__ V,bf16*O,char*shm){
  const int tid=threadIdx.x,lane=tid&63,r32=lane&31,hi=lane>>5; const int wid=__builtin_amdgcn_readfirstlane(tid>>6);
  const long rowbase=(long)b*SEQ; const int q0=qb*QB;
  const bf16*Qw=Q+(rowbase+q0+wid*QBLK)*DM+h*D;
  const bf16*Kh=K+rowbase*DM+h*D,*Vh=V+rowbase*DM+h*D;
  const unsigned lds0=(unsigned)(uintptr_t)shm;
  float*wsf=(float*)(shm+LDS_WS)+wid*64;
  const bf16*ksrc=Kh+(long)lane*DM+wid*8;
  const bf16*vsrc=Vh+(long)(16*(wid&3)+(lane>>2))*DM+(wid>>2)*32+(lane&3)*8;
  const unsigned kdst=lds0+LDS_K+wid*1024, vdst=lds0+LDS_V+wid*1024;
  #define DMA_K(t,slot) glds16(ksrc+(long)(t)*KVBLK*DM,(unsigned)__builtin_amdgcn_readfirstlane(kdst+(slot)))
  #define DMA_V(t,slot) glds16(vsrc+(long)(t)*KVBLK*DM,(unsigned)__builtin_amdgcn_readfirstlane(vdst+(slot)))
  const int vb0=(int)(lds0+LDS_V)+((lane>>4)&1)*32+(lane&3)*8+(4*hi+((lane&15)>>2))*64;
  const char*Kbase=shm+LDS_K; bf16x8 kf[8];
  const lds_cptr shm3=(lds_cptr)shm; const lds_cptr kp0=shm3+LDS_K+hi*1024+r32*16; const lds_cptr vp0=shm3+LDS_V+((lane>>4)&1)*32+(lane&3)*8+(4*hi+((lane&15)>>2))*64;
  const int NT=(q0+QB)/KVBLK;
  DMA_K(0,0);DMA_V(0,0);DMA_K(1,SLOTB);
  bf16x8 qr[4];
  #pragma unroll
  for(int d0=0;d0<4;++d0)qr[d0]=*reinterpret_cast<const bf16x8*>(&Qw[(long)r32*DM+d0*16+hi*8]);
  float mhat=0.f,l_reg=0.f;f32x16 o[2];o[0]=f32x16{};o[1]=f32x16{};f32x16 negm=f32x16{};asm volatile("":"+v"(negm));
  const int qrel=wid*QBLK+r32;
  #define CMASK(P0,P1,t) do{int jb_=(t)-(NT-4); if(jb_>=0)cmask(P0,P1,jb_,qrel,hi);}while(0)
  bool resc=false;
  #define START(P0,P1) do{ const float rm=rowmax(P0,P1); resc=false; \
    { const float dl=rm; mhat=fadd_s(mhat,dl); \
      _Pragma("unroll") for(int r=0;r<16;++r){P0[r]=fsub_s(P0[r],dl);P1[r]=fsub_s(P1[r],dl);} \
      _Pragma("unroll") for(int r=0;r<16;++r)negm[r]=-mhat; asm volatile("":"+v"(negm)); } \
    _Pragma("unroll") for(int r=0;r<16;++r)P0[r]=__builtin_amdgcn_exp2f(P0[r]); }while(0)
  #define RESC() do{ if(resc){ asm volatile("s_waitcnt lgkmcnt(0)":::"memory"); \
      _Pragma("unroll") for(int d_=0;d_<2;++d_) _Pragma("unroll") for(int r=0;r<16;++r)o[d_][r]*=wsf[crow(r,hi)]; } }while(0)
  f32x16 pA0,pA1,pB0,pB1;
  int sl_prev=0,sl_cur=0,sl_next=SLOTB;
  #define ROT() do{sl_prev=sl_cur;sl_cur=sl_next;sl_next=(sl_next==(NSLOT-1)*SLOTB)?0:sl_next+SLOTB;}while(0)
  DMA_K(2,2*SLOTB);
  WAIT_BAR(3);
  qkt(pA0,pA1,Kbase,qr,negm,r32,hi);asm volatile("s_nop 15\n\ts_nop 7":"+v"(pA0),"+v"(pA1));CMASK(pA0,pA1,0);
  START(pA0,pA1);
  _Pragma("unroll") for(int r=0;r<16;++r)pA1[r]=__builtin_amdgcn_exp2f(pA1[r]);
  WAIT_BAR(0);
  DMA_K(3,0);DMA_V(1,SLOTB);
  ROT();
  kload8(kf,kp0+sl_cur);
  WAIT_BAR(2);
  s16x4 vlo[8],vhi[8]; u32x4 pw0,pw1,pw2,pw3;
  #define PKW(P,B) cvtpk_s(P[B],P[B+1])
  #define PAF(k) __builtin_bit_cast(bf16x8,pw##k)
  #define VFR(i) (bf16x8){vlo[i][0],vlo[i][1],vlo[i][2],vlo[i][3],vhi[i][0],vhi[i][1],vhi[i][2],vhi[i][3]}
  #define PIN(x) asm volatile("":"+v"(x))
  #define MX3(a,b,c) __builtin_fmaxf(__builtin_fmaxf((a),(b)),(c))
  #define GAPA(MF,A0,A1,A2,A3,W0,W1,PW) do{ MF; sacc+=A0; sacc+=A1; sacc+=A2; sacc+=A3; PIN(sacc); W0; W1; PIN(PW); SBAR(); }while(0)
  #define EX(v) __builtin_amdgcn_exp2f(v)
  #define GAPB(MF,X,B) do{ MF; X[B]=EX(X[B]); X[B+1]=EX(X[B+1]); X[B+2]=EX(X[B+2]); X[B+3]=EX(X[B+3]); PIN(X); SBAR(); }while(0)
  #define VRD(i) do{ vlo[i]=vtr(vp_+(((i)>>2)*4096+((i)&3)*1024)); vhi[i]=vtr(vp_+(((i)>>2)*4096+((i)&3)*1024+512)); }while(0)
  #define KRD(G,j) do{ if(G){ kload2(kf,kp0+sl_next,j); SBAR(); } }while(0)
  #define STEP(C0,C1,P0,P1,t,GK,GV,GL) do{ SBAR(); \
    const lds_cptr vp_=vp0+sl_prev; \
    VRD(0); SBAR(); float sacc=(P0[0]+P0[1]); \
    GAPA(C0=__builtin_amdgcn_mfma_f32_32x32x16_bf16(kf[0],qr[0],negm,0,0,0), P0[2],P0[3],P0[4],P0[5],     pw0[0]=PKW(P0,0), pw0[1]=PKW(P0,2), pw0); \
    VRD(4); SBAR(); GAPA(C1=__builtin_amdgcn_mfma_f32_32x32x16_bf16(kf[1],qr[0],negm,0,0,0), P0[6],P0[7],P0[8],P0[9],     pw0[2]=PKW(P0,4), pw0[3]=PKW(P0,6), pw0); \
    VRD(1); SBAR(); GAPA(C0=__builtin_amdgcn_mfma_f32_32x32x16_bf16(kf[2],qr[1],C0,0,0,0),   P0[10],P0[11],P0[12],P0[13], pw1[0]=PKW(P0,8), pw1[1]=PKW(P0,10), pw1); \
    VRD(5); SBAR(); GAPA(C1=__builtin_amdgcn_mfma_f32_32x32x16_bf16(kf[3],qr[1],C1,0,0,0),   P0[14],P0[15],P1[0],P1[1],   pw1[2]=PKW(P0,12),pw1[3]=PKW(P0,14), pw1); \
    VRD(2); SBAR(); GAPA(C0=__builtin_amdgcn_mfma_f32_32x32x16_bf16(kf[4],qr[2],C0,0,0,0),   P1[2],P1[3],P1[4],P1[5],     pw2[0]=PKW(P1,0), pw2[1]=PKW(P1,2), pw2); \
    VRD(6); SBAR(); GAPA(C1=__builtin_amdgcn_mfma_f32_32x32x16_bf16(kf[5],qr[2],C1,0,0,0),   P1[6],P1[7],P1[8],P1[9],     pw2[2]=PKW(P1,4), pw2[3]=PKW(P1,6), pw2); \
    VRD(3); SBAR(); GAPA(C0=__builtin_amdgcn_mfma_f32_32x32x16_bf16(kf[6],qr[3],C0,0,0,0),   P1[10],P1[11],P1[12],P1[13], pw3[0]=PKW(P1,8), pw3[1]=PKW(P1,10), pw3); \
    VRD(7); SBAR(); GAPA(C1=__builtin_amdgcn_mfma_f32_32x32x16_bf16(kf[7],qr[3],C1,0,0,0),   P1[14],P1[15],0.f,0.f,       pw3[2]=PKW(P1,12),pw3[3]=PKW(P1,14), pw3); \
    l_reg+=sacc; \
    if(GK){DMA_K((t)+3,sl_cur);} if(GV){DMA_V((t)+1,sl_next);} \
    CMASK(C0,C1,t); \
    { float a=MX3(C0[0],C0[1],C1[0]),b=MX3(C0[2],C0[3],C1[1]); a=MX3(a,C1[2],C1[3]); \
      _Pragma("unroll") for(int r=4;r<16;r+=4){a=MX3(a,C0[r],C0[r+1]);b=MX3(b,C0[r+2],C0[r+3]);a=MX3(a,C1[r],C1[r+1]);b=MX3(b,C1[r+2],C1[r+3]);} \
      float rm=__builtin_fmaxf(a,b); { auto rr=__builtin_amdgcn_permlane32_swap(__float_as_uint(rm),__float_as_uint(rm),false,false); rm=__builtin_fmaxf(__uint_as_float(rr[0]),__uint_as_float(rr[1])); } \
      resc=false; \
      if(__builtin_expect(__any(rm>(float)THRL),0)){ const float dl=__builtin_fmaxf(rm,0.f); mhat+=dl; \
        _Pragma("unroll") for(int r=0;r<16;++r){C0[r]-=dl;C1[r]-=dl;} \
        _Pragma("unroll") for(int r=0;r<16;++r)negm[r]=-mhat; asm volatile("":"+v"(negm)); \
        const float f=__builtin_amdgcn_exp2f(-dl); l_reg*=f; if(hi==0)wsf[r32]=f; resc=true; } } \
    SBAR(); \
    GAPB(o[0]=__builtin_amdgcn_mfma_f32_32x32x16_bf16(PAF(0),VFR(0),o[0],0,0,0), C0,0); \
    GAPB(o[1]=__builtin_amdgcn_mfma_f32_32x32x16_bf16(PAF(0),VFR(4),o[1],0,0,0), C0,4); \
    KRD(GL,0); GAPB(o[0]=__builtin_amdgcn_mfma_f32_32x32x16_bf16(PAF(1),VFR(1),o[0],0,0,0), C0,8); \
    KRD(GL,1); GAPB(o[1]=__builtin_amdgcn_mfma_f32_32x32x16_bf16(PAF(1),VFR(5),o[1],0,0,0), C0,12); \
    KRD(GL,2); GAPB(o[0]=__builtin_amdgcn_mfma_f32_32x32x16_bf16(PAF(2),VFR(2),o[0],0,0,0), C1,0); \
    KRD(GL,3); GAPB(o[1]=__builtin_amdgcn_mfma_f32_32x32x16_bf16(PAF(2),VFR(6),o[1],0,0,0), C1,4); \
    GAPB(o[0]=__builtin_amdgcn_mfma_f32_32x32x16_bf16(PAF(3),VFR(3),o[0],0,0,0), C1,8); \
    GAPB(o[1]=__builtin_amdgcn_mfma_f32_32x32x16_bf16(PAF(3),VFR(7),o[1],0,0,0), C1,12); \
    }while(0)
  int t=1;
  #undef CMASK
  #define CMASK(P0,P1,t) do{}while(0)
  for(;t+5<NT;t+=2){
    STEP(pB0,pB1,pA0,pA1,t,true,true,true);     WAIT_BAR(2); RESC(); ROT();
    STEP(pA0,pA1,pB0,pB1,t+1,true,true,true);   WAIT_BAR(2); RESC(); ROT();
  }
  #undef CMASK
  #define CMASK(P0,P1,t) do{int jb_=(t)-(NT-4); if(jb_>=0)cmask(P0,P1,jb_,qrel,hi);}while(0)
  #define ENDW(tt) do{ if((tt)+3<NT){WAIT_BAR(2);} else if((tt)+2<NT){WAIT_BAR(1);} else {WAIT_BAR(0);} }while(0)
  for(;t+1<NT;t+=2){
    STEP(pB0,pB1,pA0,pA1,t,(t+3<NT),(t+1<NT),(t+1<NT));       ENDW(t);   RESC(); ROT();
    STEP(pA0,pA1,pB0,pB1,t+1,(t+4<NT),(t+2<NT),(t+2<NT));     ENDW(t+1); RESC(); ROT();
  }
  STEP(pB0,pB1,pA0,pA1,NT-1,false,false,false); RESC();
  { float sacc=pB0[0]+pB0[1]; _Pragma("unroll") for(int r=2;r<16;++r)sacc+=pB0[r]; _Pragma("unroll") for(int r=0;r<16;++r)sacc+=pB1[r]; l_reg+=sacc;
    pw0=(u32x4){PKW(pB0,0),PKW(pB0,2),PKW(pB0,4),PKW(pB0,6)};pw1=(u32x4){PKW(pB0,8),PKW(pB0,10),PKW(pB0,12),PKW(pB0,14)};pw2=(u32x4){PKW(pB1,0),PKW(pB1,2),PKW(pB1,4),PKW(pB1,6)};pw3=(u32x4){PKW(pB1,8),PKW(pB1,10),PKW(pB1,12),PKW(pB1,14)};
    SBAR(); pv(o,vb0+sl_cur,PAF(0),PAF(1),PAF(2),PAF(3)); }
  #undef PKW
  #undef PAF
  #undef VFR
  #undef PIN
  #undef MX3
  #undef GAPA
  #undef GAPB
  #undef EX
  #undef VRD
  #undef KRD
  #undef STEP
  #undef ENDW
  {auto rr=__builtin_amdgcn_permlane32_swap(__float_as_uint(l_reg),__float_as_uint(l_reg),false,false);l_reg=__uint_as_float(rr[0])+__uint_as_float(rr[1]);}
  if(hi==0)wsf[32+r32]=l_reg;asm volatile("s_waitcnt lgkmcnt(0)":::"memory");
  float rli[16];
  #pragma unroll
  for(int r=0;r<16;++r)rli[r]=__builtin_amdgcn_rcpf(wsf[32+crow(r,hi)]);
  bf16*Ow=O+(rowbase+q0+wid*QBLK)*DM+h*D;
  { bf16*stg=(bf16*)(shm+LDS_OST)+wid*2048;
    #pragma unroll
    for(int r=0;r<16;++r){const int orow=crow(r,hi);
      #pragma unroll
      for(int d0=0;d0<2;++d0)stg[orow*64+d0*32+r32]=__float2bfloat16(o[d0][r]*rli[r]);}
    asm volatile("s_waitcnt lgkmcnt(0)":::"memory");
    #pragma unroll
    for(int i=0;i<4;++i){const int row=i*8+(lane>>3),ch=lane&7; const u32x4 v=*(const u32x4*)(stg+row*64+ch*8); ATTN_STORE16(Ow+(long)row*DM+ch*8,v);} }
  asm volatile("s_waitcnt lgkmcnt(0)\n\ts_barrier":::"memory");
  #undef DMA_K
  #undef DMA_V
  #undef CMASK
  #undef START
  #undef RESC
  #undef ROT
}
constexpr int ATTN_LDS_BYTES=LDS_BYTES;
struct AttnTensors { const bf16* Q; const bf16* K; const bf16* V; bf16* O; };
struct AttnUnit { int bh; int qb; };
struct StaticOrder {
  int vcu;
  __device__ __forceinline__ explicit StaticOrder(int grid,int block):vcu((block%8)*(grid/8)+block/8){}
  __device__ __forceinline__ bool next(int i,AttnUnit&u)const{ if(i>=8)return false; const int pr=vcu&3; u.bh=(vcu>>2)*4+(i&3); u.qb=(i==0)?pr:(i==1)?pr:(i==2)?pr:(i==3)?pr:(i==4)?7-pr:(i==5)?7-pr:(i==6)?7-pr:7-pr; return true; }
  __device__ __forceinline__ void a_ready(const AttnUnit&)const{}
  __device__ __forceinline__ void done(const AttnUnit&)const{}
};
template<class Sched,int THRL=8> __device__ __forceinline__ void attn_phase(char*lds,const AttnTensors&T,const Sched&S){
  AttnUnit u;
  for(int i=0;S.next(i,u);++i){ S.a_ready(u); const int vhd=u.bh%NHEAD, hq=vhd>>1, hv=(vhd>>2)*2+(vhd&1);
    attn_unit<THRL>(u.bh/NHEAD,hq,u.qb,T.Q,T.K,T.V+(hv-hq)*D,T.O+(vhd-hq)*D,lds); S.done(u); }
}
#undef SBAR
#undef WAIT_BAR
}
#define XB_TMO      128
#define XB_XCNT(j)  (256  + 64 * (j))
#define XB_XSUB(j)  (1280 + 64 * (j))
#define XB_XGEN(j)  (2304 + 64 * (j))
#define XB_TOP      3328
#define XB_TOPGEN   3392
#define XCD_BAR_WORDS 3456
#define XB_SPIN_CAP (1u << 18)

__device__ __forceinline__ unsigned xb_ld(unsigned* p)              { return __hip_atomic_load(p, __ATOMIC_RELAXED, __HIP_MEMORY_SCOPE_AGENT); }
__device__ __forceinline__ unsigned xb_add(unsigned* p, unsigned v) { return __hip_atomic_fetch_add(p, v, __ATOMIC_RELAXED, __HIP_MEMORY_SCOPE_AGENT); }
__device__ __forceinline__ unsigned xb_xcc_id() { return (unsigned)__builtin_amdgcn_s_getreg((3 << 11) | 20) & 0xFu; }
#define XB_SPIN(cond, bar) do { unsigned _sp = 0; while (cond) { __builtin_amdgcn_s_sleep(1); \
    if ((++_sp & 255u) == 0u) { if (xb_ld(&(bar)[XB_TMO])) break; if (_sp > XB_SPIN_CAP) { atomicAdd(&(bar)[XB_TMO], 1u); break; } } } } while (0)

struct XcdBarrier {
    unsigned* bar; unsigned x;
    volatile LAS unsigned* st;
};

__device__ __forceinline__ XcdBarrier xcd_barrier_post(unsigned* bar, volatile LAS unsigned* st) {
    XcdBarrier b; b.bar = bar; b.x = xb_xcc_id(); b.st = st;
    if (threadIdx.x == 0) (void)xb_add(&bar[XB_XCNT(b.x)], 1u);
    return b;
}
__device__ __forceinline__ void xcd_barrier_complete(unsigned* bar, unsigned x, unsigned& nloc, unsigned& nx) {
    const unsigned G = gridDim.x * gridDim.y * gridDim.z;
    unsigned sum, cnt, mine, sp = 0u;
    for (;;) {
        sum = 0u; cnt = 0u; mine = 0u;
#pragma unroll
        for (unsigned j = 0; j < 16; ++j) { const unsigned c = xb_ld(&bar[XB_XCNT(j)]); sum += c; cnt += (c > 0u) ? 1u : 0u; mine = (j == x) ? c : mine; }
        if (sum == G) break;
        __builtin_amdgcn_s_sleep(1);
        if ((++sp & 255u) == 0u) { if (xb_ld(&bar[XB_TMO])) break; if (sp > XB_SPIN_CAP) { atomicAdd(&bar[XB_TMO], 1u); break; } }
    }
    nloc = mine > 0u ? mine : 1u; nx = cnt > 0u ? cnt : 1u;
}

__device__ __forceinline__ void xcd_barrier(const XcdBarrier& b) {
    asm volatile("s_waitcnt vmcnt(0)" ::: "memory");
    __syncthreads();
    if (threadIdx.x == 0) {
        unsigned* bar = b.bar;
        __builtin_amdgcn_s_waitcnt(0);
        unsigned nloc = b.st[0], nx = b.st[1];
        if (nloc == 0u) { xcd_barrier_complete(bar, b.x, nloc, nx); b.st[0] = nloc; b.st[1] = nx; }
        const unsigned old = xb_add(&bar[XB_XSUB(b.x)], 1u);
        const unsigned gen = old / nloc;
        if (old + 1u == (gen + 1u) * nloc) {
            __builtin_amdgcn_fence(__ATOMIC_RELEASE, "agent");
            asm volatile("s_waitcnt vmcnt(0)" ::: "memory");
            const unsigned og = xb_add(&bar[XB_TOP], 1u);
            const unsigned tg = og / nx;
            if (og + 1u == (tg + 1u) * nx) xb_add(&bar[XB_TOPGEN], 1u);
            else XB_SPIN(xb_ld(&bar[XB_TOPGEN]) == tg, bar);
            __builtin_amdgcn_fence(__ATOMIC_ACQUIRE, "agent");
            xb_add(&bar[XB_XGEN(b.x)], 1u);
            asm volatile("s_waitcnt vmcnt(0)" ::: "memory");
        } else {
            XB_SPIN(xb_ld(&bar[XB_XGEN(b.x)]) == gen, bar);
            __builtin_amdgcn_fence(__ATOMIC_ACQUIRE, "agent");
            asm volatile("s_waitcnt vmcnt(0)" ::: "memory");
        }
    }
    __syncthreads();
}

constexpr int NWAVES = 8;
struct Frame { LAS unsigned char* lds; volatile LAS unsigned* MISC; gu32* ctl; int wave, vcu, G; };
__device__ __forceinline__ int opaque_tid() { int t = (int)threadIdx.x; asm volatile("" : "+v"(t)); return t; }
#define FTID ((int)threadIdx.x)
#define FLANE ((int)(threadIdx.x & 63u))
struct Args { const float* in[53]; float* out; unsigned char* ws; int ph_lo, ph_hi, variant, pad; };
#define EPI_ARGS const f32x4 (&acc)[2][2][4][2], const pg8::Unit& u, int wr, int wc, int fr, int fq

__device__ __forceinline__ int maprow(int mode, int n) {
    if (mode == 0) return n;
    if (mode == 1) return (n >> 7) * 256 + (n & 127);
    if (mode == 2) return (n >> 7) * 256 + 128 + (n & 127);
    const int j = n & 1023; return (j >> 7) * 256 + ((n >> 10) << 7) + (j & 127);
}
__device__ __forceinline__ void tr_item(const float* W, int N, bf16* WT, int mode, LAS float* scr, int item, int lane) {
    const int nblk = N >> 5, kb = item / nblk, nb = item - kb * nblk, k0 = 64 * kb, n0 = 32 * nb;
#pragma unroll 8
    for (int i = 0; i < 32; ++i) { const int kk = 2 * i + (lane >> 5); scr[kk * 33 + (lane & 31)] = W[(size_t)(k0 + kk) * N + n0 + (lane & 31)]; }
    LDS_WAIT(); asm volatile("" ::: "memory");
    const int c = lane & 7; const int r0 = maprow(mode, n0);
#pragma unroll
    for (int j = 0; j < 4; ++j) { const int n = (lane >> 3) + 8 * j; const LAS float* s = scr + (8 * c) * 33 + n;
        v4u o; o.x = pk2(s[0 * 33], s[1 * 33]); o.y = pk2(s[2 * 33], s[3 * 33]); o.z = pk2(s[4 * 33], s[5 * 33]); o.w = pk2(s[6 * 33], s[7 * 33]);
        *(GAS v4u*)(WT + (size_t)(r0 + n) * 1024 + k0 + 8 * c) = o; }
    LDS_WAIT(); asm volatile("" ::: "memory");
}
__device__ __forceinline__ unsigned pk4_fp8(float a, float b, float c, float d) {
    a = __builtin_amdgcn_fmed3f(a, -448.f, 448.f); b = __builtin_amdgcn_fmed3f(b, -448.f, 448.f); c = __builtin_amdgcn_fmed3f(c, -448.f, 448.f); d = __builtin_amdgcn_fmed3f(d, -448.f, 448.f);
    int r = __builtin_amdgcn_cvt_pk_fp8_f32(a, b, 0, false); r = __builtin_amdgcn_cvt_pk_fp8_f32(c, d, r, true); return (unsigned)r; }
__device__ __forceinline__ void tr_item8(const float* W, int N, unsigned char* WT, int mode, float scale, LAS float* scr, int item, int lane) {
    const int nblk = N >> 5, kb = item / nblk, nb = item - kb * nblk, k0 = 128 * kb, n0 = 32 * nb;
#pragma unroll 8
    for (int i = 0; i < 64; ++i) { const int kk = 2 * i + (lane >> 5); scr[kk * 33 + (lane & 31)] = W[(size_t)(k0 + kk) * N + n0 + (lane & 31)] * scale; }
    LDS_WAIT(); asm volatile("" ::: "memory");
    const int c = lane & 7; const int r0 = maprow(mode, n0);
#pragma unroll
    for (int j = 0; j < 4; ++j) { const int n = (lane >> 3) + 8 * j; const LAS float* p = scr + (16 * c) * 33 + n;
        v4u o; o.x = pk4_fp8(p[0 * 33], p[1 * 33], p[2 * 33], p[3 * 33]); o.y = pk4_fp8(p[4 * 33], p[5 * 33], p[6 * 33], p[7 * 33]);
        o.z = pk4_fp8(p[8 * 33], p[9 * 33], p[10 * 33], p[11 * 33]); o.w = pk4_fp8(p[12 * 33], p[13 * 33], p[14 * 33], p[15 * 33]);
        *(GAS v4u*)(WT + (size_t)(r0 + n) * 1024 + k0 + 16 * c) = o; }
    LDS_WAIT(); asm volatile("" ::: "memory");
}
__device__ __forceinline__ void cvt_plain(const float* src, bf16* dst, size_t n, size_t gtid, size_t nth) {
    for (size_t i = gtid * 8; i < n; i += nth * 8) { const f32x4 a = *(const GAS f32x4*)(src + i), b = *(const GAS f32x4*)(src + i + 4);
        v4u o; o.x = pk2(a.x, a.y); o.y = pk2(a.z, a.w); o.z = pk2(b.x, b.y); o.w = pk2(b.z, b.w); *(GAS v4u*)(dst + i) = o; }
}
__device__ __forceinline__ void cvt_experts(Frame& F, const float* wup, const float* wdn, unsigned char* ws) {
    const int gw = F.vcu * NWAVES + F.wave, NGW = F.G * NWAVES;
#if MOE_FP8
    LAS float* tl = (LAS float*)F.lds;
    for (int it = F.vcu; it < NEXP * 96; it += F.G) { const int e = it / 96, r = it - e * 96; const bool up = r < 64; const int rr = up ? r : r - 64;
        const int N = up ? 2048 : 1024, nb = up ? (rr & 7) : (rr & 3), kb = up ? (rr >> 3) : (rr >> 2), k0 = 128 * kb, n0 = 256 * nb;
        const float* W = up ? wup + (size_t)e * 1024 * 2048 : wdn + (size_t)e * 1024 * 1024; unsigned char* WT = up ? ws + WS_WUP8 + (size_t)e * 2048 * 1024 : ws + WS_WDN8 + (size_t)e * 1024 * 1024;
        const float scale = up ? SWU8 : SWD8; const int mode = up ? 3 : 0;
        __syncthreads();
        f32x4 v[16];
#pragma unroll
        for (int i = 0; i < 16; ++i) { const int idx = i * 512 + FTID, row = idx >> 6, c4 = idx & 63; v[i] = *(const GAS f32x4*)(W + (size_t)(k0 + row) * N + n0 + 4 * c4); }
#pragma unroll
        for (int i = 0; i < 16; ++i) { const int idx = i * 512 + FTID, row = idx >> 6, c4 = idx & 63; *(LAS f32x4*)(tl + row * 260 + 4 * (c4 ^ (row >> 4))) = v[i] * scale; }
        __syncthreads();
#pragma unroll
        for (int j = 0; j < 4; ++j) { const int idx = j * 512 + FTID, n = idx >> 3, c = idx & 7; const LAS float* p = tl + (16 * c) * 260 + (n ^ (4 * c));
            v4u o; o.x = pk4_fp8(p[0 * 260], p[1 * 260], p[2 * 260], p[3 * 260]); o.y = pk4_fp8(p[4 * 260], p[5 * 260], p[6 * 260], p[7 * 260]);
            o.z = pk4_fp8(p[8 * 260], p[9 * 260], p[10 * 260], p[11 * 260]); o.w = pk4_fp8(p[12 * 260], p[13 * 260], p[14 * 260], p[15 * 260]);
            *(GAS v4u*)(WT + (size_t)maprow(mode, n0 + n) * 1024 + k0 + 16 * c) = o; }
    }
    __syncthreads();
    return;
#endif
    LAS float* scr = (LAS float*)(F.lds + F.wave * 16384);
    for (int it = gw; it < NEXP * 1536; it += NGW) { const int e = it / 1536, r = it - e * 1536;
        if (r < 1024) tr_item(wup + (size_t)e * 1024 * 2048, 2048, (bf16*)(ws + WS_WUP) + (size_t)e * 2048 * 1024, 3, scr, r, FLANE);
        else tr_item(wdn + (size_t)e * 1024 * 1024, 1024, (bf16*)(ws + WS_WDN) + (size_t)e * 1024 * 1024, 0, scr, r - 1024, FLANE); }
}
__device__ __forceinline__ void p0_prologue(Frame& F, const Args& a) {
    unsigned char* ws = a.ws;
    LAS float* scr = (LAS float*)(F.lds + F.wave * 16896);
    const int gw = F.vcu * NWAVES + F.wave, NGW = F.G * NWAVES;
    constexpr int I0 = 16 * 64, I1 = I0 + 16 * 80, I2 = I1 + 512, I3 = I2 + 512, I4 = I3 + 512, I5 = I4 + 256, I6 = I5 + 256, I7 = I6 + 256, I8 = I7 + 16, I9 = I8 + 16;
    for (int it = gw; it < I9; it += NGW) {
        if (it < I0) tr_item(a.in[2], 2048, (bf16*)(ws + WS_WKV), 0, scr, it, FLANE);
        else if (it < I1) tr_item(a.in[3], 2560, (bf16*)(ws + WS_WIN0), 0, scr, it - I0, FLANE);
        else if (it < I2) tr_item(a.in[13], 1024, (bf16*)(ws + WS_WOUT0), 0, scr, it - I1, FLANE);
        else if (it < I3) tr_item(a.in[17], 1024, (bf16*)(ws + WS_XOT), 0, scr, it - I2, FLANE);
        else if (it < I4) tr_item(a.in[42], 1024, (bf16*)(ws + WS_XOT) + 1024 * 1024, 0, scr, it - I3, FLANE);
        else if (it < I5) tr_item8(a.in[28], 1024, ws + WS_WIN1, 0, SWU8, scr, it - I4, FLANE);
        else if (it < I6) tr_item8(a.in[37], 1024, ws + WS_WVG, 1, SWD8, scr, it - I5, FLANE);
        else if (it < I7) tr_item8(a.in[38], 1024, ws + WS_WVG, 2, SWU8, scr, it - I6, FLANE);
        else if (it < I8) tr_item(a.in[20], 32, (bf16*)(ws + WS_WR), 0, scr, it - I7, FLANE);
        else tr_item(a.in[45], 32, (bf16*)(ws + WS_WR) + 256 * 1024, 0, scr, it - I8, FLANE);
    }
    cvt_experts(F, a.in[22], a.in[24], ws);
    const size_t gtid = (size_t)F.vcu * 512 + FTID, nth = (size_t)F.G * 512;
    cvt_plain(a.in[16], (bf16*)(ws + WS_XQB), 1024 * 1024, gtid, nth);
    cvt_plain(a.in[41], (bf16*)(ws + WS_XQB) + 1024 * 1024, 1024 * 1024, gtid, nth);
    cvt_plain(a.in[1], (bf16*)(ws + WS_MEMB), (size_t)NB * MEMLEN * DM, gtid, nth);
    cvt_plain(a.in[0], (bf16*)(ws + WS_XB), (size_t)MTOK * DM, gtid, nth);
}

__device__ __forceinline__ void moe_tables(Frame& F, gu32* cnt) {
    LAS int* tab = (LAS int*)(F.lds + TAB_OFF);
    if (FTID < 32) tab[FTID] = (int)__hip_atomic_load(cnt + FTID * 64, RLX_AGENT);
    __syncthreads();
    if (FTID == 0) { int s = 0; for (int e = 0; e < NEXP; ++e) { tab[32 + e] = s; s += (tab[e] + 255) >> 8; } tab[64] = s; }
    __syncthreads();
}

template <int MODE>
__device__ __forceinline__ void ph_ln(Frame& F, const bf16* zb, const bf16* ys, bf16* xb, float* outf, const float* g, const float* b, unsigned char* x8 = nullptr, const int* asg = nullptr, const float* gate = nullptr,
                                      const float* st2 = nullptr, const float* g2 = nullptr, const float* b2 = nullptr) {
    LAS const int* tab = (LAS const int*)(F.lds + TAB_OFF);
    const int gw = F.vcu * NWAVES + F.wave, NGW = F.G * NWAVES, c0 = 8 * FLANE;
    float gv[16], bv[16];
#pragma unroll
    for (int h = 0; h < 2; ++h)
#pragma unroll
        for (int q = 0; q < 2; ++q) { const f32x4 t = *(const GAS f32x4*)(g + c0 + 512 * h + 4 * q), s = *(const GAS f32x4*)(b + c0 + 512 * h + 4 * q);
            gv[8 * h + 4 * q + 0] = t.x; gv[8 * h + 4 * q + 1] = t.y; gv[8 * h + 4 * q + 2] = t.z; gv[8 * h + 4 * q + 3] = t.w;
            bv[8 * h + 4 * q + 0] = s.x; bv[8 * h + 4 * q + 1] = s.y; bv[8 * h + 4 * q + 2] = s.z; bv[8 * h + 4 * q + 3] = s.w; }
    constexpr bool REB = (MODE == 1) && MOE_FP8; float g2v[REB ? 16 : 1], b2v[REB ? 16 : 1];
    if constexpr (REB) {
#pragma unroll
        for (int h = 0; h < 2; ++h)
#pragma unroll
            for (int q = 0; q < 2; ++q) { const f32x4 t = *(const GAS f32x4*)(g2 + c0 + 512 * h + 4 * q), s = *(const GAS f32x4*)(b2 + c0 + 512 * h + 4 * q);
#pragma unroll
                for (int j = 0; j < 4; ++j) { g2v[8 * h + 4 * q + j] = ALPHA * t[j]; b2v[8 * h + 4 * q + j] = ALPHA * s[j]; } } }
    constexpr int RI = (MODE == 0) ? 4 : 2;
    for (int m0 = gw * RI; m0 < MTOK; m0 += NGW * RI) {
        v4u raw[RI][2]; v4u yr[(MODE == 1) ? RI : 1][2][4]; f32x4 gt[(MODE == 1) ? RI : 1]; f32x2 ms[RI];
#pragma unroll
        for (int r = 0; r < RI; ++r) { const size_t m = (size_t)(m0 + r); size_t yrow[4] = {0, 0, 0, 0};
            if constexpr (REB) ms[r] = *(const GAS f32x2*)(st2 + m * 2);
            if (MODE == 1) { const v4i_t as = *(const GAS v4i_t*)(asg + m * 4); gt[r] = *(const GAS f32x4*)(gate + m * 4);
#pragma unroll
                for (int k = 0; k < 4; ++k) yrow[k] = (size_t)(tab[32 + (as[k] >> 16)] * 256 + (as[k] & 0xffff)); }
#pragma unroll
            for (int h = 0; h < 2; ++h) {
                raw[r][h] = *(const GAS v4u*)(((MODE == 0 || REB) ? zb : xb) + m * DM + c0 + 512 * h);
                if (MODE == 1) {
#pragma unroll
                    for (int k = 0; k < 4; ++k) { const v2u t8 = *(const GAS v2u*)((const unsigned char*)ys + yrow[k] * DM + c0 + 512 * h); yr[r][h][k] = (v4u){t8.x, t8.y, 0u, 0u}; } } } }
#pragma unroll
        for (int r = 0; r < RI; ++r) { const size_t m = (size_t)(m0 + r);
            float v[16];
#pragma unroll
            for (int h = 0; h < 2; ++h) { const v4u w = raw[r][h]; const float sc = (MODE == 0) ? 1.0f : ALPHA;
                v[8 * h + 0] = sc * bflo(w.x); v[8 * h + 1] = sc * bfhi(w.x); v[8 * h + 2] = sc * bflo(w.y); v[8 * h + 3] = sc * bfhi(w.y); v[8 * h + 4] = sc * bflo(w.z); v[8 * h + 5] = sc * bfhi(w.z); v[8 * h + 6] = sc * bflo(w.w); v[8 * h + 7] = sc * bfhi(w.w);
                if constexpr (REB) { const float mu2 = ms[r][0] * ALPHA, rs2 = ms[r][1];
#pragma unroll
                    for (int j = 0; j < 8; ++j) v[8 * h + j] = (v[8 * h + j] - mu2) * rs2 * g2v[8 * h + j] * (1.0f / ALPHA) + b2v[8 * h + j]; }
                if (MODE == 1) {
#pragma unroll
                    for (int k = 0; k < 4; ++k) { const v4u y = yr[r][h][k]; const float gk = gt[r][k] * (1.0f / SY8);
                        const f32x2 p0 = __builtin_amdgcn_cvt_pk_f32_fp8((int)y.x, false), p1 = __builtin_amdgcn_cvt_pk_f32_fp8((int)y.x, true), p2 = __builtin_amdgcn_cvt_pk_f32_fp8((int)y.y, false), p3 = __builtin_amdgcn_cvt_pk_f32_fp8((int)y.y, true);
                        v[8 * h + 0] += gk * p0[0]; v[8 * h + 1] += gk * p0[1]; v[8 * h + 2] += gk * p1[0]; v[8 * h + 3] += gk * p1[1]; v[8 * h + 4] += gk * p2[0]; v[8 * h + 5] += gk * p2[1]; v[8 * h + 6] += gk * p3[0]; v[8 * h + 7] += gk * p3[1]; } } }
            float s = 0.f;
#pragma unroll
            for (int j = 0; j < 16; ++j) s += v[j];
            const float mean = wave_sum(s) * (1.f / DM); float s2 = 0.f;
#pragma unroll
            for (int j = 0; j < 16; ++j) { v[j] -= mean; s2 += v[j] * v[j]; }
            const float rstd = 1.f / sqrtf(wave_sum(s2) * (1.f / DM) + LN_EPS);
#pragma unroll
            for (int j = 0; j < 16; ++j) v[j] = v[j] * rstd * gv[j] + bv[j];
#pragma unroll
            for (int h = 0; h < 2; ++h) { v4u o; o.x = pk2(v[8 * h], v[8 * h + 1]); o.y = pk2(v[8 * h + 2], v[8 * h + 3]); o.z = pk2(v[8 * h + 4], v[8 * h + 5]); o.w = pk2(v[8 * h + 6], v[8 * h + 7]);
                if (!outf) *(GAS v4u*)(xb + m * DM + c0 + 512 * h) = o;
                if (x8) { v2u o8; o8.x = pk4_fp8(v[8 * h] * SX8, v[8 * h + 1] * SX8, v[8 * h + 2] * SX8, v[8 * h + 3] * SX8); o8.y = pk4_fp8(v[8 * h + 4] * SX8, v[8 * h + 5] * SX8, v[8 * h + 6] * SX8, v[8 * h + 7] * SX8);
                          *(GAS v2u*)(x8 + m * DM + c0 + 512 * h) = o8; }
                if (outf) { *(GAS f32x4*)(outf + m * DM + c0 + 512 * h) = (f32x4){v[8 * h], v[8 * h + 1], v[8 * h + 2], v[8 * h + 3]};
                            *(GAS f32x4*)(outf + m * DM + c0 + 512 * h + 4) = (f32x4){v[8 * h + 4], v[8 * h + 5], v[8 * h + 6], v[8 * h + 7]}; } }
        }
    }
}
__device__ __forceinline__ void ph_ln2_router(Frame& F, const bf16* zb, bf16* xb, unsigned char* x8, const float* g, const float* b, const bf16* wrT, const float* rbias,
                                              gu32* cnt, int* list, float* gate, int* asg, float* st2) {
    LAS int* cl = (LAS int*)F.lds;
    LAS float* gl = (LAS float*)(F.lds + 256);
    LAS bf16* wl = (LAS bf16*)(F.lds + 256 + 8192);
    const int rw = FLANE & 15, q = FLANE >> 4;
    bool first = true;
    for (int blk = F.vcu; blk < MTOK / 128; blk += F.G) {
        __syncthreads();
        if (FTID < 64) cl[FTID] = 0;
        const int row = blk * 128 + F.wave * 16 + rw;
        const bf16* zr = zb + (size_t)row * DM + 8 * q;
        v4u zz[32];
#pragma unroll
        for (int ks = 0; ks < 32; ++ks) zz[ks] = *(const GAS v4u*)(zr + 32 * ks);
        if (first) { first = false;
            for (int i = FTID; i < 256; i += 512) { ((LAS f32x4*)gl)[i] = *(const GAS f32x4*)(g + 4 * i); ((LAS f32x4*)gl)[256 + i] = *(const GAS f32x4*)(b + 4 * i); }
            for (int i = FTID; i < 4096; i += 512) { const int e = i >> 7, c = i & 127; *(LAS v4u*)(wl + e * 1032 + 8 * c) = *(const GAS v4u*)(wrT + (size_t)e * DM + 8 * c); } }
        __syncthreads();
        float s1 = 0.f, s2 = 0.f;
#pragma unroll
        for (int ks = 0; ks < 32; ++ks) { const v4u w = zz[ks]; const float x0 = bflo(w.x), x1 = bfhi(w.x), x2 = bflo(w.y), x3 = bfhi(w.y), x4 = bflo(w.z), x5 = bfhi(w.z), x6 = bflo(w.w), x7 = bfhi(w.w);
            s1 += ((x0 + x1) + (x2 + x3)) + ((x4 + x5) + (x6 + x7)); s2 += ((x0 * x0 + x1 * x1) + (x2 * x2 + x3 * x3)) + ((x4 * x4 + x5 * x5) + (x6 * x6 + x7 * x7)); }
        s1 += __shfl_xor(s1, 16); s1 += __shfl_xor(s1, 32); s2 += __shfl_xor(s2, 16); s2 += __shfl_xor(s2, 32);
        const float mean = s1 * (1.f / DM), rstd = 1.f / sqrtf(fmaxf(s2 * (1.f / DM) - mean * mean, 0.f) + LN_EPS);
        if (MOE_FP8 && q == 0) { f32x2 ms; ms[0] = mean; ms[1] = rstd; *(GAS f32x2*)(st2 + (size_t)row * 2) = ms; }
        f32x4 acc0 = (f32x4){0.f, 0.f, 0.f, 0.f}, acc1 = (f32x4){0.f, 0.f, 0.f, 0.f};
        bf16* xr = xb + (size_t)row * DM + 8 * q; unsigned char* x8r = x8 + (size_t)row * DM + 8 * q;
        const LAS bf16* w0 = wl + rw * 1032 + 8 * q; const LAS bf16* w1 = wl + (16 + rw) * 1032 + 8 * q;
#pragma unroll
        for (int ks = 0; ks < 32; ++ks) { v4u w = zz[ks]; asm volatile("" : "+v"(w));
            const f32x4 g0 = *(const LAS f32x4*)(gl + 32 * ks + 8 * q), g1 = *(const LAS f32x4*)(gl + 32 * ks + 8 * q + 4), b0 = *(const LAS f32x4*)(gl + 1024 + 32 * ks + 8 * q), b1 = *(const LAS f32x4*)(gl + 1024 + 32 * ks + 8 * q + 4);
            const float y0 = (bflo(w.x) - mean) * rstd * g0[0] + b0[0], y1 = (bfhi(w.x) - mean) * rstd * g0[1] + b0[1], y2 = (bflo(w.y) - mean) * rstd * g0[2] + b0[2], y3 = (bfhi(w.y) - mean) * rstd * g0[3] + b0[3];
            const float y4 = (bflo(w.z) - mean) * rstd * g1[0] + b1[0], y5 = (bfhi(w.z) - mean) * rstd * g1[1] + b1[1], y6 = (bflo(w.w) - mean) * rstd * g1[2] + b1[2], y7 = (bfhi(w.w) - mean) * rstd * g1[3] + b1[3];
            v4u o; o.x = pk2(y0, y1); o.y = pk2(y2, y3); o.z = pk2(y4, y5); o.w = pk2(y6, y7);
            if (!MOE_FP8) *(GAS v4u*)(xr + 32 * ks) = o;
            if (x8) { v2u o8; o8.x = pk4_fp8(y0 * SX8, y1 * SX8, y2 * SX8, y3 * SX8); o8.y = pk4_fp8(y4 * SX8, y5 * SX8, y6 * SX8, y7 * SX8); *(GAS v2u*)(x8r + 32 * ks) = o8; }
            const bf16x8 bfrag = __builtin_bit_cast(bf16x8, o);
            acc0 = __builtin_amdgcn_mfma_f32_16x16x32_bf16(*(const LAS bf16x8*)(w0 + 32 * ks), bfrag, acc0, 0, 0, 0);
            acc1 = __builtin_amdgcn_mfma_f32_16x16x32_bf16(*(const LAS bf16x8*)(w1 + 32 * ks), bfrag, acc1, 0, 0, 0);
            if ((ks & 1) == 1) asm volatile("" ::: "memory"); }
        float lg[8]; const f32x4 rb0 = *(const GAS f32x4*)(rbias + 4 * q), rb1 = *(const GAS f32x4*)(rbias + 16 + 4 * q);
#pragma unroll
        for (int j = 0; j < 4; ++j) { lg[j] = acc0[j] + rb0[j]; lg[4 + j] = acc1[j] + rb1[j]; }
        int idx[4]; float val[4];
#pragma unroll
        for (int k = 0; k < 4; ++k) { float bv = -3.0e38f; int bi = 64;
#pragma unroll
            for (int j = 0; j < 8; ++j) { const int e = (j < 4) ? 4 * q + j : 12 + 4 * q + j; if (lg[j] > bv) { bv = lg[j]; bi = e; } }
#pragma unroll
            for (int o = 16; o <= 32; o <<= 1) { const float pv = __shfl_xor(bv, o); const int pi = __shfl_xor(bi, o); if (pv > bv || (pv == bv && pi < bi)) { bv = pv; bi = pi; } }
            bi &= 31; idx[k] = bi; val[k] = bv;
#pragma unroll
            for (int j = 0; j < 8; ++j) { const int e = (j < 4) ? 4 * q + j : 12 + 4 * q + j; if (e == bi) lg[j] = -3.0e38f; } }
        const float e1 = __builtin_amdgcn_exp2f((val[1] - val[0]) * LOG2E), e2 = __builtin_amdgcn_exp2f((val[2] - val[0]) * LOG2E), e3 = __builtin_amdgcn_exp2f((val[3] - val[0]) * LOG2E);
        const float inv = 1.f / (1.f + e1 + e2 + e3);
        int pos[4] = {0, 0, 0, 0};
        for (int e = 0; e < NEXP; ++e) {
            const int k = (q != 0) ? -1 : (idx[0] == e) ? 0 : (idx[1] == e) ? 1 : (idx[2] == e) ? 2 : (idx[3] == e) ? 3 : -1;
            const unsigned long long mask = __ballot(k >= 0);
            if (mask) { const int n = __popcll(mask), leader = __ffsll((long long)mask) - 1; int bp = 0;
                if (FLANE == leader) bp = __hip_atomic_fetch_add(cl + e, n, __ATOMIC_RELAXED, __HIP_MEMORY_SCOPE_WORKGROUP);
                bp = __shfl(bp, leader);
                const int p = bp + __popcll(mask & ((1ull << FLANE) - 1ull));
                pos[0] = (k == 0) ? p : pos[0]; pos[1] = (k == 1) ? p : pos[1]; pos[2] = (k == 2) ? p : pos[2]; pos[3] = (k == 3) ? p : pos[3]; }
        }
        __syncthreads();
        if (FTID < 32) { const int tot = cl[FTID]; cl[32 + FTID] = tot ? (int)__hip_atomic_fetch_add(cnt + FTID * 64, (unsigned)tot, RLX_AGENT) : 0; }
        __syncthreads();
        if (q == 0) {
            *(GAS f32x4*)(gate + (size_t)row * 4) = (f32x4){inv, e1 * inv, e2 * inv, e3 * inv};
#pragma unroll
            for (int k = 0; k < 4; ++k) { const int pe = cl[32 + idx[k]] + pos[k]; list[(size_t)idx[k] * CAP + pe] = row * 4 + k; pos[k] = (idx[k] << 16) | pe; }
            *(GAS v4i_t*)(asg + (size_t)row * 4) = (v4i_t){pos[0], pos[1], pos[2], pos[3]}; }
    }
}
__device__ __forceinline__ void ph_softmax(Frame& F, const float* sc, bf16* P) {
    const int gw = F.vcu * NWAVES + F.wave, NGW = F.G * NWAVES;
    for (int m = gw; m < MTOK; m += NGW) {
#pragma unroll
        for (int h = 0; h < 4; ++h) { f32x4 v = *(const GAS f32x4*)(sc + (size_t)m * DM + 256 * h + 4 * FLANE);
            const float mx = wave_max(fmaxf(fmaxf(v.x, v.y), fmaxf(v.z, v.w)));
            v.x = __builtin_amdgcn_exp2f(v.x - mx); v.y = __builtin_amdgcn_exp2f(v.y - mx); v.z = __builtin_amdgcn_exp2f(v.z - mx); v.w = __builtin_amdgcn_exp2f(v.w - mx);
            const float inv = 1.f / wave_sum((v.x + v.y) + (v.z + v.w));
            v2u o; o.x = pk2(v.x * inv, v.y * inv); o.y = pk2(v.z * inv, v.w * inv);
            *(GAS v2u*)(P + (size_t)m * DM + 256 * h + 4 * FLANE) = o; }
    }
}
__device__ __forceinline__ void ph_topk(Frame& F, const float* logit, const float* rbias, gu32* cnt, int* list, float* gate) {
    for (int base = F.vcu * 512; base < MTOK; base += F.G * 512) {
        const int m = base + FTID;
        float lg[32];
#pragma unroll
        for (int q = 0; q < 8; ++q) { const f32x4 t = *(const GAS f32x4*)(logit + (size_t)m * 32 + 4 * q), bb = *(const GAS f32x4*)(rbias + 4 * q);
            lg[4 * q] = t.x + bb.x; lg[4 * q + 1] = t.y + bb.y; lg[4 * q + 2] = t.z + bb.z; lg[4 * q + 3] = t.w + bb.w; }
        int idx[4]; float val[4];
#pragma unroll
        for (int k = 0; k < 4; ++k) { float bvv = -3.0e38f; int bi = 0;
#pragma unroll
            for (int e = 0; e < 32; ++e) { const bool taken = (k > 0 && idx[0] == e) || (k > 1 && idx[1] == e) || (k > 2 && idx[2] == e); if (!taken && lg[e] > bvv) { bvv = lg[e]; bi = e; } }
            idx[k] = bi; val[k] = bvv; }
        const float e1 = __builtin_amdgcn_exp2f((val[1] - val[0]) * LOG2E), e2 = __builtin_amdgcn_exp2f((val[2] - val[0]) * LOG2E), e3 = __builtin_amdgcn_exp2f((val[3] - val[0]) * LOG2E);
        const float inv = 1.f / (1.f + e1 + e2 + e3);
        *(GAS f32x4*)(gate + (size_t)m * 4) = (f32x4){inv, e1 * inv, e2 * inv, e3 * inv};
        for (int e = 0; e < NEXP; ++e) {
            const int k = (idx[0] == e) ? 0 : (idx[1] == e) ? 1 : (idx[2] == e) ? 2 : (idx[3] == e) ? 3 : -1;
            const unsigned long long mask = __ballot(k >= 0);
            if (mask) { const int n = __popcll(mask), leader = __ffsll((long long)mask) - 1; unsigned bp = 0;
                if (FLANE == leader) bp = __hip_atomic_fetch_add(cnt + e * 64, (unsigned)n, RLX_AGENT);
                bp = __shfl(bp, leader);
                if (k >= 0) { const int rank = __popcll(mask & ((1ull << FLANE) - 1ull)); list[(size_t)e * CAP + bp + rank] = m * 4 + k; } }
        }
    }
}
__device__ __forceinline__ void ph_sgu(Frame& F, const bf16* hb, bf16* mix, const float* lng, const float* lnb, const float* wsp, const float* bsp) {
    LAS bf16* Wb = (LAS bf16*)F.lds;
    LAS bf16* VT = (LAS bf16*)(F.lds + 34816);
    LAS float* GL = (LAS float*)(F.lds + 69632);
    const int r = FTID >> 2, qq = FTID & 3, n16 = FLANE & 15, q = FLANE >> 4;
    int gcur = -1;
    for (int it = F.vcu; it < 1024; it += F.G) {
        const int g = it & 3, row0 = (it >> 2) * 128;
        if (g != gcur) { __syncthreads(); for (int i = FTID; i < 16384; i += 512) { const int t = i >> 7, s2 = i & 127; Wb[t * 136 + s2] = (bf16)((s2 <= t) ? f2bf(wsp[g * 16384 + i]) : 0u); } gcur = g; }
        v4u uw[4];
        { const bf16* usrc = hb + (size_t)(row0 + r) * DM + g * 128 + 32 * qq;
#pragma unroll
            for (int j = 0; j < 4; ++j) uw[j] = *(const GAS v4u*)(usrc + 8 * j); }
        { float v[32]; const bf16* src = hb + (size_t)(row0 + r) * DM + 512 + g * 128 + 32 * qq;
#pragma unroll
            for (int j = 0; j < 4; ++j) { const v4u w = *(const GAS v4u*)(src + 8 * j);
                v[8 * j + 0] = bflo(w.x); v[8 * j + 1] = bfhi(w.x); v[8 * j + 2] = bflo(w.y); v[8 * j + 3] = bfhi(w.y); v[8 * j + 4] = bflo(w.z); v[8 * j + 5] = bfhi(w.z); v[8 * j + 6] = bflo(w.w); v[8 * j + 7] = bfhi(w.w); }
            float s = 0.f;
#pragma unroll
            for (int j = 0; j < 32; ++j) s += v[j];
            s += __shfl_xor(s, 1); s += __shfl_xor(s, 2);
            const float mean = s * (1.f / 128.f); float s2 = 0.f;
#pragma unroll
            for (int j = 0; j < 32; ++j) { v[j] -= mean; s2 += v[j] * v[j]; }
            s2 += __shfl_xor(s2, 1); s2 += __shfl_xor(s2, 2);
            const float rstd = 1.f / sqrtf(s2 * (1.f / 128.f) + LN_EPS);
#pragma unroll
            for (int j = 0; j < 8; ++j) { const f32x4 gg = *(const GAS f32x4*)(lng + g * 128 + 32 * qq + 4 * j), bb = *(const GAS f32x4*)(lnb + g * 128 + 32 * qq + 4 * j);
#pragma unroll
                for (int k = 0; k < 4; ++k) VT[(32 * qq + 4 * j + k) * 136 + r] = (bf16)f2bf(v[4 * j + k] * rstd * gg[k] + bb[k]); } }
        __syncthreads();
        { bf16x8 VF[4];
#pragma unroll
            for (int ks = 0; ks < 4; ++ks) VF[ks] = *(const LAS bf16x8*)(VT + (16 * F.wave + n16) * 136 + 32 * ks + 8 * q);
#pragma unroll
            for (int tb = 0; tb < 8; ++tb) { f32x4 acc = (f32x4){0.f, 0.f, 0.f, 0.f};
#pragma unroll
                for (int ks = 0; ks <= (tb >> 1); ++ks) acc = __builtin_amdgcn_mfma_f32_16x16x32_bf16(*(const LAS bf16x8*)(Wb + (16 * tb + n16) * 136 + 32 * ks + 8 * q), VF[ks], acc, 0, 0, 0);
                const f32x4 bt = *(const GAS f32x4*)(bsp + g * 128 + 16 * tb + 4 * q);
#pragma unroll
                for (int k = 0; k < 4; ++k) GL[(16 * tb + 4 * q + k) * 128 + 16 * F.wave + n16] = acc[k] + bt[k]; } }
        __syncthreads();
        { bf16* dst = mix + (size_t)(row0 + r) * DM + g * 128 + 32 * qq;
#pragma unroll
            for (int j = 0; j < 4; ++j) { const v4u w = uw[j]; const f32x4 g0 = *(const LAS f32x4*)(GL + r * 128 + 32 * qq + 8 * j), g1 = *(const LAS f32x4*)(GL + r * 128 + 32 * qq + 8 * j + 4); v4u o;
                o.x = pk2(bflo(w.x) * g0[0], bfhi(w.x) * g0[1]); o.y = pk2(bflo(w.y) * g0[2], bfhi(w.y) * g0[3]); o.z = pk2(bflo(w.z) * g1[0], bfhi(w.z) * g1[1]); o.w = pk2(bflo(w.w) * g1[2], bfhi(w.w) * g1[3]);
                *(GAS v4u*)(dst + 8 * j) = o; } }
    }
}
__device__ __forceinline__ void ph_combine(Frame& F, const bf16* oatt, bf16* mix, const float* lq1, const float* lk1, const float* lq2, const float* lk2, const float* sg) {
    const int gw = F.vcu * NWAVES + F.wave, NGW = F.G * NWAVES;
    const float d1 = wave_sum(lq1[FLANE] * lk1[FLANE]), d2 = wave_sum(lq2[FLANE] * lk2[FLANE]);
    const float lam = expf(d1) - expf(d2) + LAM_INIT0;
    const int h = FLANE >> 4, e0 = 8 * (FLANE & 15);
    float gsc[8];
#pragma unroll
    for (int j = 0; j < 8; ++j) gsc[j] = sg[e0 + j] * (1.0f - LAM_INIT0);
    for (int m0 = gw * 4; m0 < MTOK; m0 += NGW * 4) {
        v4u av[4], bw[4];
#pragma unroll
        for (int r = 0; r < 4; ++r) { av[r] = *(const GAS v4u*)(oatt + (size_t)(m0 + r) * DM + h * 256 + e0); bw[r] = *(const GAS v4u*)(oatt + (size_t)(m0 + r) * DM + h * 256 + 128 + e0); }
#pragma unroll
        for (int r = 0; r < 4; ++r) { const v4u a = av[r], b = bw[r]; const size_t m = (size_t)(m0 + r);
            float o[8];
            o[0] = bflo(a.x) - lam * bflo(b.x); o[1] = bfhi(a.x) - lam * bfhi(b.x); o[2] = bflo(a.y) - lam * bflo(b.y); o[3] = bfhi(a.y) - lam * bfhi(b.y);
            o[4] = bflo(a.z) - lam * bflo(b.z); o[5] = bfhi(a.z) - lam * bfhi(b.z); o[6] = bflo(a.w) - lam * bflo(b.w); o[7] = bfhi(a.w) - lam * bfhi(b.w);
            float s2 = 0.f;
#pragma unroll
            for (int j = 0; j < 8; ++j) s2 += o[j] * o[j];
            s2 += __shfl_xor(s2, 1); s2 += __shfl_xor(s2, 2); s2 += __shfl_xor(s2, 4); s2 += __shfl_xor(s2, 8);
            const float rs = 1.f / sqrtf(s2 * (1.f / 128.f) + LN_EPS);
            v4u w; w.x = pk2(o[0] * rs * gsc[0], o[1] * rs * gsc[1]); w.y = pk2(o[2] * rs * gsc[2], o[3] * rs * gsc[3]); w.z = pk2(o[4] * rs * gsc[4], o[5] * rs * gsc[5]); w.w = pk2(o[6] * rs * gsc[6], o[7] * rs * gsc[7]);
            *(GAS v4u*)(mix + m * DM + 512 + h * 128 + e0) = w; }
    }
}

__device__ __forceinline__ void combine_local(Frame& F, const bf16* oatt, bf16* mix, const float* lq1, const float* lk1, const float* lq2, const float* lk2, const float* sg, int b, int h, int pr) {
    const float d1 = wave_sum(lq1[FLANE] * lk1[FLANE]), d2 = wave_sum(lq2[FLANE] * lk2[FLANE]);
    const float lam = expf(d1) - expf(d2) + LAM_INIT0;
    const int e0 = 8 * (FLANE & 15);
    float gsc[8];
#pragma unroll
    for (int j = 0; j < 8; ++j) gsc[j] = sg[e0 + j] * (1.0f - LAM_INIT0);
    for (int it = 0; it < 16; it += 4) {
        v4u av[4], bw[4]; size_t rows[4];
#pragma unroll
        for (int r = 0; r < 4; ++r) { const int rl = F.wave * 64 + (it + r) * 4 + (FLANE >> 4); rows[r] = (size_t)b * SEQ + (size_t)((rl < 256) ? pr : 7 - pr) * 256 + (rl & 255);
            av[r] = *(const GAS v4u*)(oatt + rows[r] * DM + h * 256 + e0); bw[r] = *(const GAS v4u*)(oatt + rows[r] * DM + h * 256 + 128 + e0); }
#pragma unroll
        for (int r = 0; r < 4; ++r) { const v4u a = av[r], bb = bw[r];
            float o[8];
            o[0] = bflo(a.x) - lam * bflo(bb.x); o[1] = bfhi(a.x) - lam * bfhi(bb.x); o[2] = bflo(a.y) - lam * bflo(bb.y); o[3] = bfhi(a.y) - lam * bfhi(bb.y);
            o[4] = bflo(a.z) - lam * bflo(bb.z); o[5] = bfhi(a.z) - lam * bfhi(bb.z); o[6] = bflo(a.w) - lam * bflo(bb.w); o[7] = bfhi(a.w) - lam * bfhi(bb.w);
            float s2 = 0.f;
#pragma unroll
            for (int j = 0; j < 8; ++j) s2 += o[j] * o[j];
            s2 += __shfl_xor(s2, 1); s2 += __shfl_xor(s2, 2); s2 += __shfl_xor(s2, 4); s2 += __shfl_xor(s2, 8);
            const float rs = 1.f / sqrtf(s2 * (1.f / 128.f) + LN_EPS);
            v4u w; w.x = pk2(o[0] * rs * gsc[0], o[1] * rs * gsc[1]); w.y = pk2(o[2] * rs * gsc[2], o[3] * rs * gsc[3]); w.z = pk2(o[4] * rs * gsc[4], o[5] * rs * gsc[5]); w.w = pk2(o[6] * rs * gsc[6], o[7] * rs * gsc[7]);
            *(GAS v4u*)(mix + rows[r] * DM + 512 + h * 128 + e0) = w; }
    }
}

__device__ __forceinline__ float dpp_shr1(float x) { return __builtin_bit_cast(float, __builtin_amdgcn_update_dpp(0, __builtin_bit_cast(int, x), 0x111, 0xf, 0xf, true)); }
__device__ __forceinline__ float dpp_shr2(float x) { return __builtin_bit_cast(float, __builtin_amdgcn_update_dpp(0, __builtin_bit_cast(int, x), 0x112, 0xf, 0xf, true)); }
__device__ __forceinline__ float dpp_shr4(float x) { return __builtin_bit_cast(float, __builtin_amdgcn_update_dpp(0, __builtin_bit_cast(int, x), 0x114, 0xf, 0xf, true)); }
__device__ __forceinline__ float dpp_shr8(float x) { return __builtin_bit_cast(float, __builtin_amdgcn_update_dpp(0, __builtin_bit_cast(int, x), 0x118, 0xf, 0xf, true)); }
__device__ __forceinline__ float dpp_ror1(float x) { return __builtin_bit_cast(float, __builtin_amdgcn_update_dpp(0, __builtin_bit_cast(int, x), 0x121, 0xf, 0xf, true)); }
template <int hf>
__device__ __forceinline__ void s5_main(Frame& F, const bf16* ug, bf16* yb, const float* dsk, int g, int bh, LAS bf16* W2F, LAS bf16* W3F, LAS bf16* KT, LAS float* PW, int r, int q, int variant) {
        const int b = bh * 4 + (F.wave & 3);
        LAS bf16x8* XX = (LAS bf16x8*)(F.lds + 91648);
        const bf16* up = ug + ((size_t)g * MTOK + (size_t)b * SEQ) * 16;
        unsigned char* yp = (unsigned char*)yb + ((size_t)g * MTOK + (size_t)b * SEQ) * 16 + 4 * q;
        const f32x4 dk = *(const GAS f32x4*)(dsk + g * 16 + 4 * q);
        f32x4 E[4];
#pragma unroll
        for (int i = 0; i < 4; ++i) E[i] = (f32x4){0.f, 0.f, 0.f, 0.f};
        bf16x8 UFn[4], UF[4]; v2u UWn[4], UW[4];
#pragma unroll
        for (int sp = 0; sp < 4; ++sp) UFn[sp] = *(const GAS bf16x8*)(up + (size_t)(r * 8 + 2 * sp + (q >> 1)) * 16 + 8 * (q & 1));
#pragma unroll
        for (int t = 0; t < 4; ++t) UWn[t] = *(const GAS v2u*)(up + (size_t)(r * 8 + 4 * hf + t) * 16 + 4 * q);
#pragma unroll
        for (int sp = 0; sp < 4; ++sp) UF[sp] = UFn[sp];
#pragma unroll
        for (int t = 0; t < 4; ++t) UW[t] = UWn[t];
        for (int cg = 0; cg < 16; ++cg) {
            const int tokbase = cg * 128 + r * 8;
            if (cg < 15) {
#pragma unroll
                for (int sp = 0; sp < 4; ++sp) UFn[sp] = *(const GAS bf16x8*)(up + (size_t)(tokbase + 128 + 2 * sp + (q >> 1)) * 16 + 8 * (q & 1));
#pragma unroll
                for (int t = 0; t < 4; ++t) UWn[t] = *(const GAS v2u*)(up + (size_t)(tokbase + 128 + 4 * hf + t) * 16 + 4 * q); }
            f32x4 rot[4];
#pragma unroll
            for (int i = 0; i < 4; ++i) {
#pragma unroll
                for (int j = 0; j < 4; ++j) rot[i][j] = dpp_ror1(E[i][j]);
                E[i] = (f32x4){0.f, 0.f, 0.f, 0.f}; }
#pragma unroll
            for (int i = 0; i < 4; ++i)
#pragma unroll
                for (int sp = 0; sp < 4; ++sp) { E[i] = __builtin_amdgcn_mfma_f32_16x16x32_bf16(*(const LAS bf16x8*)(W2F + (((4 * hf + i) * 4 + sp) * 64 + FLANE) * 8), UF[sp], E[i], 0, 0, 0); if (sp == 3) asm volatile("" ::: "memory"); }
#pragma unroll
            for (int i2 = 0; i2 < 2; ++i2) {
                const int rbp = 2 * hf + i2;
                const f32x4 a0 = *(const LAS f32x4*)(PW + (8 * 64 + 16 * rbp + 4 * q) * 2), a1 = *(const LAS f32x4*)(PW + (8 * 64 + 16 * rbp + 4 * q) * 2 + 4);
                float pr[4] = {a0[0], a0[2], a1[0], a1[2]}, pi[4] = {a0[1], a0[3], a1[1], a1[3]};
#pragma unroll
                for (int j = 0; j < 4; ++j) {
                    float er = E[2 * i2][j], ei = E[2 * i2 + 1][j];
                    if (r == 0) { const float cr_ = rot[2 * i2][j], ci_ = rot[2 * i2 + 1][j]; er += pr[j] * cr_ - pi[j] * ci_; ei += pr[j] * ci_ + pi[j] * cr_; }
                    float ar = pr[j], ai = pi[j], sr, si, t2;
                    sr = dpp_shr1(er); si = dpp_shr1(ei); er += ar * sr - ai * si; ei += ar * si + ai * sr; t2 = ar * ar - ai * ai; ai = 2.f * ar * ai; ar = t2;
                    sr = dpp_shr2(er); si = dpp_shr2(ei); er += ar * sr - ai * si; ei += ar * si + ai * sr; t2 = ar * ar - ai * ai; ai = 2.f * ar * ai; ar = t2;
                    sr = dpp_shr4(er); si = dpp_shr4(ei); er += ar * sr - ai * si; ei += ar * si + ai * sr; t2 = ar * ar - ai * ai; ai = 2.f * ar * ai; ar = t2;
                    sr = dpp_shr8(er); si = dpp_shr8(ei); er += ar * sr - ai * si; ei += ar * si + ai * sr;
                    E[2 * i2][j] = er; E[2 * i2 + 1][j] = ei;
                    const float xr = (r == 0) ? rot[2 * i2][j] : dpp_shr1(er), xi = (r == 0) ? rot[2 * i2 + 1][j] : dpp_shr1(ei);
                    rot[2 * i2][j] = xr; rot[2 * i2 + 1][j] = xi; }
            }
            bf16x8 XBf[4];
            LAS bf16x8* xx = XX + ((cg & 1) * 4 + (F.wave & 3)) * 256;
#pragma unroll
            for (int i2 = 0; i2 < 2; ++i2) { v4u w; w.x = pk2(rot[2 * i2][0], rot[2 * i2][1]); w.y = pk2(rot[2 * i2][2], rot[2 * i2][3]); w.z = pk2(rot[2 * i2 + 1][0], rot[2 * i2 + 1][1]); w.w = pk2(rot[2 * i2 + 1][2], rot[2 * i2 + 1][3]);
                XBf[2 * hf + i2] = __builtin_bit_cast(bf16x8, w); xx[(2 * hf + i2) * 64 + FLANE] = XBf[2 * hf + i2]; }
            LDS_WAIT(); __builtin_amdgcn_s_barrier(); asm volatile("" ::: "memory");
#pragma unroll
            for (int i2 = 0; i2 < 2; ++i2) XBf[2 * (1 - hf) + i2] = xx[(2 * (1 - hf) + i2) * 64 + FLANE];
            unsigned yout[4] = {0u, 0u, 0u, 0u};
            if (variant != 2) {
#pragma unroll
            for (int tt = 0; tt < 4; ++tt) { const int t = 4 * hf + tt;
                f32x4 Y = (f32x4){0.f, 0.f, 0.f, 0.f};
#pragma unroll
                for (int sp = 0; sp < 4; ++sp) if (sp <= (t >> 1)) { const int tau1 = t - 2 * sp - (q >> 1) + 1;
                    Y = __builtin_amdgcn_mfma_f32_16x16x32_bf16(*(const LAS bf16x8*)(KT + (tau1 * 16 + r) * 16 + 8 * (q & 1)), UF[sp], Y, 0, 0, 0); }
#pragma unroll
                for (int ks = 0; ks < 4; ++ks) Y = __builtin_amdgcn_mfma_f32_16x16x32_bf16(*(const LAS bf16x8*)(W3F + ((t * 4 + ks) * 64 + FLANE) * 8), XBf[ks], Y, 0, 0, 0);
                const v2u uw = UW[tt];
                const float y0 = gelu_tanh(Y[0] + dk[0] * bflo(uw.x)), y1 = gelu_tanh(Y[1] + dk[1] * bfhi(uw.x)), y2 = gelu_tanh(Y[2] + dk[2] * bflo(uw.y)), y3 = gelu_tanh(Y[3] + dk[3] * bfhi(uw.y));
                yout[tt] = pk4_fp8(y0 * SA8, y1 * SA8, y2 * SA8, y3 * SA8); asm volatile("" ::: "memory");
            } }
            if (cg < 15) {
#pragma unroll
                for (int sp = 0; sp < 4; ++sp) UF[sp] = UFn[sp];
#pragma unroll
                for (int t = 0; t < 4; ++t) UW[t] = UWn[t]; }
            asm volatile("" ::: "memory");
#pragma unroll
            for (int tt = 0; tt < 4; ++tt) *(GAS unsigned*)(yp + (size_t)(tokbase + 4 * hf + tt) * 16) = yout[tt];
        }
}
__device__ __forceinline__ void ph_s5(Frame& F, const bf16* ug, bf16* yb, const float* log_dt, const float* lre, const float* lim, const float* bre, const float* bim,
                                      const float* cre, const float* cim, const float* dsk, int variant) {
    LAS bf16* W2F = (LAS bf16*)F.lds;
    LAS bf16* W3F = (LAS bf16*)(F.lds + 32768);
    LAS bf16* KT = (LAS bf16*)(F.lds + 65536);
    LAS float* PW = (LAS float*)(F.lds + 70144);
    LAS float* ZZ = (LAS float*)(F.lds + 74752);
    LAS float* BB = (LAS float*)(F.lds + 75264);
    LAS float* CC = (LAS float*)(F.lds + 83456);
    LAS bf16* W30 = (LAS bf16*)(F.lds + 124416);
    const int r = FLANE & 15, q = FLANE >> 4;
    for (int it = F.vcu; it < 256; it += F.G) {
        const int g = it & 63, bh = it >> 6;
        __syncthreads();
        if (FTID < 64) { const int p = FTID; const float dt = expf(log_dt[g]), lr = lre[g * 64 + p], li = lim[g * 64 + p];
            const float mg = expf(lr * dt), ar = mg * cosf(li * dt), ai = mg * sinf(li * dt), den = lr * lr + li * li;
            float pr = 1.f, pi = 0.f;
            for (int n = 0; n < 9; ++n) { PW[(n * 64 + p) * 2] = pr; PW[(n * 64 + p) * 2 + 1] = pi; const float t2 = pr * ar - pi * ai; pi = pr * ai + pi * ar; pr = t2; }
            ZZ[p * 2] = ((ar - 1.0f) * lr + ai * li) / den; ZZ[p * 2 + 1] = (ai * lr - (ar - 1.0f) * li) / den; }
        __syncthreads();
        for (int idx = FTID; idx < 1024; idx += 512) {
            { const int p = idx >> 4; const float br = bre[(size_t)g * 1024 + idx], bi = bim[(size_t)g * 1024 + idx], zr = ZZ[p * 2], zi = ZZ[p * 2 + 1];
              BB[idx * 2] = zr * br - zi * bi; BB[idx * 2 + 1] = zr * bi + zi * br; }
            { CC[idx * 2] = cre[(size_t)g * 1024 + idx]; CC[idx * 2 + 1] = cim[(size_t)g * 1024 + idx]; }
        }
        if (FTID < 256) KT[FTID] = 0;
        __syncthreads();
        for (int idx = FTID; idx < 2048; idx += 512) {
            { const int t = idx >> 8, ks = (idx >> 6) & 3, ln = idx & 63, c = ln & 15, qq = ln >> 4; unsigned w[4];
#pragma unroll
              for (int j = 0; j < 4; ++j) { const int p = 16 * ks + 4 * qq + j; const float cr_ = CC[(c * 64 + p) * 2], ci_ = CC[(c * 64 + p) * 2 + 1], pr = PW[((t + 1) * 64 + p) * 2], pi = PW[((t + 1) * 64 + p) * 2 + 1];
                  const float gr = cr_ * pr - ci_ * pi, gi = cr_ * pi + ci_ * pr;
                  if (j & 1) { w[j >> 1] |= f2bf(gr) << 16; w[2 + (j >> 1)] |= f2bf(-gi) << 16; } else { w[j >> 1] = f2bf(gr); w[2 + (j >> 1)] = f2bf(-gi); } }
              *(LAS v4u*)(W3F + (size_t)idx * 8) = (v4u){w[0], w[1], w[2], w[3]}; }
            { const int rb = idx >> 8, sp = (idx >> 6) & 3, ln = idx & 63, rr = ln & 15, qq = ln >> 4, p = 16 * (rb >> 1) + rr, s = 2 * sp + (qq >> 1), c0 = 8 * (qq & 1); unsigned w[4];
              const float pr = PW[((7 - s) * 64 + p) * 2], pi = PW[((7 - s) * 64 + p) * 2 + 1];
#pragma unroll
              for (int j = 0; j < 8; ++j) { const float br = BB[(p * 16 + c0 + j) * 2], bi = BB[(p * 16 + c0 + j) * 2 + 1]; const float v = (rb & 1) ? (pr * bi + pi * br) : (pr * br - pi * bi);
                  if (j & 1) w[j >> 1] |= f2bf(v) << 16; else w[j >> 1] = f2bf(v); }
              *(LAS v4u*)(W2F + (size_t)idx * 8) = (v4u){w[0], w[1], w[2], w[3]}; }
        }
        if (FTID < 256) { const int ks = FTID >> 6, ln = FTID & 63, c = ln & 15, qq = ln >> 4; unsigned w[4];
#pragma unroll
            for (int j = 0; j < 4; ++j) { const int p = 16 * ks + 4 * qq + j; const float gr = CC[(c * 64 + p) * 2], gi = CC[(c * 64 + p) * 2 + 1];
                if (j & 1) { w[j >> 1] |= f2bf(gr) << 16; w[2 + (j >> 1)] |= f2bf(-gi) << 16; } else { w[j >> 1] = f2bf(gr); w[2 + (j >> 1)] = f2bf(-gi); } }
            *(LAS v4u*)(W30 + (size_t)FTID * 8) = (v4u){w[0], w[1], w[2], w[3]}; }
        __syncthreads();
        {
            f32x4 kacc = (f32x4){0.f, 0.f, 0.f, 0.f}; const int tau = F.wave;
#pragma unroll
            for (int ks = 0; ks < 4; ++ks) { unsigned w[4];
#pragma unroll
                for (int j = 0; j < 4; ++j) { const int p = 16 * ks + 4 * q + j; const float br = BB[(p * 16 + r) * 2], bi = BB[(p * 16 + r) * 2 + 1];
                    if (j & 1) { w[j >> 1] |= f2bf(br) << 16; w[2 + (j >> 1)] |= f2bf(bi) << 16; } else { w[j >> 1] = f2bf(br); w[2 + (j >> 1)] = f2bf(bi); } }
                const v4u wb = (v4u){w[0], w[1], w[2], w[3]};
                const bf16x8 af = tau == 0 ? *(const LAS bf16x8*)(W30 + (ks * 64 + FLANE) * 8) : *(const LAS bf16x8*)(W3F + (((tau - 1) * 4 + ks) * 64 + FLANE) * 8);
                kacc = __builtin_amdgcn_mfma_f32_16x16x32_bf16(af, __builtin_bit_cast(bf16x8, wb), kacc, 0, 0, 0); }
#pragma unroll
            for (int k = 0; k < 4; ++k) KT[(tau + 1) * 256 + (4 * q + k) * 16 + r] = (bf16)f2bf(kacc[k]); }
        __syncthreads();
        if (variant != 1) { if ((F.wave >> 2) == 0) s5_main<0>(F, ug, yb, dsk, g, bh, W2F, W3F, KT, PW, r, q, variant); else s5_main<1>(F, ug, yb, dsk, g, bh, W2F, W3F, KT, PW, r, q, variant); }
    }
}

struct PlainSched {
    pg8::TileOrder T; const char* A; const char* B; int tilesPerBatch; size_t bBatch; int splitN; size_t aT = pg8::TSTEP, bT = pg8::TSTEP;
    __device__ __forceinline__ bool next(int i, pg8::Unit& u) const {
        int pm, pn; if (!T.get(i, pm, pn)) return false;
        const int z = pm / tilesPerBatch;
        u.a = A + (size_t)pm * aT; u.b = B + (size_t)z * bBatch + (size_t)pn * bT; u.row0 = pm * 256; u.col0 = pn * 256; u.z = z; u.aux = 0;
        if (splitN) { u.z = pn >= splitN; u.col0 = (pn >= splitN ? pn - splitN : pn) * 256; }
        return true;
    }
};
struct FoldSched {
    int G, c, first; const char* KB; const char* VB; const char* XQ; const char* XOT;
    __device__ __forceinline__ bool next(int i, pg8::Unit& u) const {
        const int idx = i * G + c - first; if (idx < 0 || idx >= 512) return false;
        const int type = idx >> 8, j = idx & 255, b = j >> 4, h = (j >> 2) & 3, t = j & 3;
        if (type == 0) { u.a = KB + (size_t)b * 256 * 2048 + h * 512; u.b = XQ + (size_t)t * pg8::TSTEP + h * 512; u.row0 = b * 1024 + h * 256; u.col0 = t * 256; u.z = 0; }
        else { u.a = XOT + (size_t)t * pg8::TSTEP + h * 512; u.b = VB + (size_t)b * 256 * 2048 + h * 512; u.row0 = b * 1024 + t * 256; u.col0 = h * 256; u.z = 1; }
        u.aux = 0; return true;
    }
};
struct MoeSched {
    LAS const int* tab; int NT, G, c; const char* A; const char* B; size_t bExp; int colw; const int* list; bool gather; size_t tileB;
    __device__ __forceinline__ bool next(int i, pg8::Unit& u) const {
        const int nblk = __builtin_amdgcn_readfirstlane(tab[64]);
        const int x = c >> 5, r = c & 31; int mbl, pn;
        if (G != 256 || NT != 8) { mbl = c / NT; pn = c % NT; } else { pn = 4 * (x & 1) + (r & 3); mbl = 8 * (x >> 1) + (r >> 2); }
        const int mbg = i * (G / NT) + mbl; if (mbg >= nblk) return false;
        const int lane = opaque_tid() & 63; const int v = (lane <= 32) ? tab[32 + lane] : 0x7fffffff;
        const int e = __popcll(__ballot(v <= mbg)) - 1;
        const int mb = mbg - __builtin_amdgcn_readfirstlane(tab[32 + e]);
        u.a = gather ? A : A + (size_t)mbg * tileB; u.b = B + (size_t)e * bExp + (size_t)pn * tileB;
        u.row0 = mbg * 256; u.col0 = pn * colw; u.z = e; u.aux = mb; return true;
    }
    __device__ __forceinline__ const int* rows(const pg8::Unit& u) const { return list + (size_t)u.z * CAP + u.aux * 256; }
    __device__ __forceinline__ static int rowmap(int v) { return (int)(((unsigned)v >> 2) & (unsigned)(MTOK - 1)); }
};

#define EPI_ROWS_BEGIN _Pragma("unroll") for (int ai = 0; ai < 2; ++ai) _Pragma("unroll") for (int m = 0; m < 4; ++m) { const int rloc = ai * 128 + wr * 64 + m * 16 + fr;
#define EPI_ROWS_END }
__device__ __forceinline__ v4u pack8(f32x4 v0, f32x4 v1) { v4u w; w.x = pg8::cvt_pk_bf16(v0[0], v0[1]); w.y = pg8::cvt_pk_bf16(v0[2], v0[3]); w.z = pg8::cvt_pk_bf16(v1[0], v1[1]); w.w = pg8::cvt_pk_bf16(v1[2], v1[3]); return w; }
__device__ __forceinline__ void unpack8(v4u w, f32x4& a, f32x4& b) { a = (f32x4){bflo(w.x), bfhi(w.x), bflo(w.y), bfhi(w.y)}; b = (f32x4){bflo(w.z), bfhi(w.z), bflo(w.w), bfhi(w.w)}; }
__device__ __forceinline__ void rowpair_publish(LAS float* tab, float* dst, int nslot, int slot, int row0, const float (&ss)[8], const float (&qq)[8], int wr, int wc, int fr, int fq) {
    if (fq == 0) {
#pragma unroll
        for (int i = 0; i < 8; ++i) { const int rl = (i >> 2) * 128 + wr * 64 + (i & 3) * 16 + fr; tab[(rl * 4 + wc) * 2] = ss[i]; tab[(rl * 4 + wc) * 2 + 1] = qq[i]; } }
    LDS_WAIT(); __builtin_amdgcn_s_barrier(); asm volatile("" ::: "memory");
    { const int t = opaque_tid(), row = t >> 1, which = t & 1;
      const float v = (tab[(row * 4 + 0) * 2 + which] + tab[(row * 4 + 1) * 2 + which]) + (tab[(row * 4 + 2) * 2 + which] + tab[(row * 4 + 3) * 2 + which]);
      dst[((size_t)(row0 + row) * nslot + slot) * 2 + which] = v; }
    LDS_WAIT(); __builtin_amdgcn_s_barrier(); asm volatile("" ::: "memory");
}
__device__ __forceinline__ void ln_tables(LAS float* tabR, LAS float* tabC, const float* st, int nslot, int row0, const float* sc, int scrow0, const float* v0, const float* v1, int col0) {
    const int t = opaque_tid();
    if (t < 256) { const float* p = st + (size_t)(row0 + t) * 16; float s = 0.f, q = 0.f;
        for (int k = 0; k < nslot; ++k) { s += p[2 * k]; q += p[2 * k + 1]; }
        const float mu = s * (1.f / DM); tabR[2 * t] = mu; tabR[2 * t + 1] = 1.f / sqrtf(fmaxf(q * (1.f / DM) - mu * mu, 0.f) + LN_EPS); }
    else { const int c = t - 256;
        if (sc) { const f32x4 a = *(const GAS f32x4*)(sc + (size_t)(scrow0 + c) * 8), b = *(const GAS f32x4*)(sc + (size_t)(scrow0 + c) * 8 + 4);
            tabC[c] = (a[0] + a[2]) + (b[0] + b[2]); tabC[256 + c] = (a[1] + a[3]) + (b[1] + b[3]); }
        else { tabC[c] = v0[col0 + c]; tabC[256 + c] = v1[col0 + c]; } }
    LDS_WAIT(); __builtin_amdgcn_s_barrier(); asm volatile("" ::: "memory");
}
struct EpiResidStats { const bf16* xb; bf16* zb; unsigned char* z8; float* st; LAS float* tab;
    __device__ __forceinline__ void operator()(EPI_ARGS) const {
        float ss[8], qq[8]; v4u xr[2][4][2];
        EPI_ROWS_BEGIN const size_t off = (size_t)(u.row0 + rloc) * DM + u.col0 + wc * 32 + 8 * fq; xr[ai][m][0] = *(const GAS v4u*)(xb + off); xr[ai][m][1] = *(const GAS v4u*)(xb + off + 128); EPI_ROWS_END
        EPI_ROWS_BEGIN const size_t off = (size_t)(u.row0 + rloc) * DM + u.col0 + wc * 32 + 8 * fq; float s = 0.f, q = 0.f;
#pragma unroll
            for (int bj = 0; bj < 2; ++bj) { f32x4 x0, x1; unpack8(xr[ai][m][bj], x0, x1);
                const f32x4 z0 = x0 * ALPHA + acc[ai][bj][m][0], z1 = x1 * ALPHA + acc[ai][bj][m][1];
                *(GAS v4u*)(zb + off + bj * 128) = pack8(z0, z1);
                v2u w; w.x = pk4_fp8(z0[0] * SZ8, z0[1] * SZ8, z0[2] * SZ8, z0[3] * SZ8); w.y = pk4_fp8(z1[0] * SZ8, z1[1] * SZ8, z1[2] * SZ8, z1[3] * SZ8); *(GAS v2u*)(z8 + off + bj * 128) = w;
                s += ((z0[0] + z0[1]) + (z0[2] + z0[3])) + ((z1[0] + z1[1]) + (z1[2] + z1[3])); q += ((z0[0] * z0[0] + z0[1] * z0[1]) + (z0[2] * z0[2] + z0[3] * z0[3])) + ((z1[0] * z1[0] + z1[1] * z1[1]) + (z1[2] * z1[2] + z1[3] * z1[3])); }
            s += __shfl_xor(s, 16); s += __shfl_xor(s, 32); q += __shfl_xor(q, 16); q += __shfl_xor(q, 32); ss[ai * 4 + m] = s; qq[ai * 4 + m] = q; EPI_ROWS_END
        rowpair_publish(tab, st, 8, u.col0 >> 8, u.row0, ss, qq, wr, wc, fr, fq);
    } };
struct EpiResidLN { bf16* zb; float rs; const float* st; LAS float* tab; const float* g; const float* b; int nslot;
    __device__ __forceinline__ void operator()(EPI_ARGS) const {
        LAS float* tabC = tab + 512; ln_tables(tab, tabC, st, nslot, u.row0, nullptr, 0, g, b, u.col0);
        const int c8 = u.col0 + wc * 32 + 8 * fq, cl = wc * 32 + 8 * fq; v4u zr[2][4][2];
        EPI_ROWS_BEGIN const size_t off = (size_t)(u.row0 + rloc) * DM + c8; zr[ai][m][0] = *(const GAS v4u*)(zb + off); zr[ai][m][1] = *(const GAS v4u*)(zb + off + 128); EPI_ROWS_END
        EPI_ROWS_BEGIN const size_t off = (size_t)(u.row0 + rloc) * DM + c8; const float mu = tab[2 * rloc], rstd = tab[2 * rloc + 1];
#pragma unroll
            for (int bj = 0; bj < 2; ++bj) { f32x4 x0, x1; unpack8(zr[ai][m][bj], x0, x1);
                const f32x4 g0 = *(const LAS f32x4*)(tabC + cl + bj * 128), g1 = *(const LAS f32x4*)(tabC + cl + bj * 128 + 4), b0 = *(const LAS f32x4*)(tabC + 256 + cl + bj * 128), b1 = *(const LAS f32x4*)(tabC + 256 + cl + bj * 128 + 4);
                x0 = (x0 - mu) * rstd * g0 + b0; x1 = (x1 - mu) * rstd * g1 + b1;
                *(GAS v4u*)(zb + off + bj * 128) = pack8(x0 * ALPHA + acc[ai][bj][m][0] * rs, x1 * ALPHA + acc[ai][bj][m][1] * rs); } EPI_ROWS_END
        LDS_WAIT(); __builtin_amdgcn_s_barrier(); asm volatile("" ::: "memory");
    } };
struct EpiFold { unsigned char* kft; unsigned char* vft; const float* g; const float* b; float* sc; LAS float* tab;
    __device__ __forceinline__ void operator()(EPI_ARGS) const {
        if (u.z) {
            EPI_ROWS_BEGIN unsigned char* rowp = vft + (size_t)(u.row0 + rloc) * 1024 + u.col0 + wc * 32 + 8 * fq;
#pragma unroll
                for (int bj = 0; bj < 2; ++bj) { const f32x4 v0 = acc[ai][bj][m][0] * SV8, v1 = acc[ai][bj][m][1] * SV8; v2u w; w.x = pk4_fp8(v0[0], v0[1], v0[2], v0[3]); w.y = pk4_fp8(v1[0], v1[1], v1[2], v1[3]); *(GAS v2u*)(rowp + bj * 128) = w; } EPI_ROWS_END
            return; }
        float ss[8], qq[8]; const int c8 = u.col0 + wc * 32 + 8 * fq, cl = wc * 32 + 8 * fq; LAS float* tabC = tab + 2048;
        { const int t = opaque_tid(); if (t < 256) tabC[t] = g[u.col0 + t] * CSC; else tabC[t] = b[u.col0 + t - 256] * CSC; }
        LDS_WAIT(); __builtin_amdgcn_s_barrier(); asm volatile("" ::: "memory");
        EPI_ROWS_BEGIN unsigned char* rowp = kft + (size_t)(u.row0 + rloc) * 1024 + c8; float s = 0.f, q = 0.f;
#pragma unroll
            for (int bj = 0; bj < 2; ++bj) { const f32x4 g0 = *(const LAS f32x4*)(tabC + cl + bj * 128), g1 = *(const LAS f32x4*)(tabC + cl + bj * 128 + 4), b0 = *(const LAS f32x4*)(tabC + 256 + cl + bj * 128), b1 = *(const LAS f32x4*)(tabC + 256 + cl + bj * 128 + 4);
                const f32x4 k0 = acc[ai][bj][m][0] * g0, k1 = acc[ai][bj][m][1] * g1, c0 = acc[ai][bj][m][0] * b0, c1 = acc[ai][bj][m][1] * b1;
                s += ((k0[0] + k0[1]) + (k0[2] + k0[3])) + ((k1[0] + k1[1]) + (k1[2] + k1[3])); q += ((c0[0] + c0[1]) + (c0[2] + c0[3])) + ((c1[0] + c1[1]) + (c1[2] + c1[3]));
                v2u w; w.x = pk4_fp8(k0[0] * SK8, k0[1] * SK8, k0[2] * SK8, k0[3] * SK8); w.y = pk4_fp8(k1[0] * SK8, k1[1] * SK8, k1[2] * SK8, k1[3] * SK8); *(GAS v2u*)(rowp + bj * 128) = w; }
            s += __shfl_xor(s, 16); s += __shfl_xor(s, 32); q += __shfl_xor(q, 16); q += __shfl_xor(q, 32); ss[ai * 4 + m] = s; qq[ai * 4 + m] = q; EPI_ROWS_END
        rowpair_publish(tab, sc, 4, u.col0 >> 8, u.row0, ss, qq, wr, wc, fr, fq);
    } };
struct EpiStore { bf16* base0; bf16* base1; float s0, s1; int ldc; int f8mask = 0;
    __device__ __forceinline__ void operator()(EPI_ARGS) const {
        bf16* base = u.z ? base1 : base0; const float sc = u.z ? s1 : s0;
        if ((f8mask >> (u.z ? 1 : 0)) & 1) { unsigned char* b8 = (unsigned char*)base;
            EPI_ROWS_BEGIN unsigned char* rowp = b8 + (size_t)(u.row0 + rloc) * ldc + u.col0 + wc * 32 + 8 * fq;
#pragma unroll
                for (int bj = 0; bj < 2; ++bj) { const f32x4 v0 = acc[ai][bj][m][0] * sc, v1 = acc[ai][bj][m][1] * sc; v2u w; w.x = pk4_fp8(v0[0], v0[1], v0[2], v0[3]); w.y = pk4_fp8(v1[0], v1[1], v1[2], v1[3]); *(GAS v2u*)(rowp + bj * 128) = w; } EPI_ROWS_END
            return; }
        EPI_ROWS_BEGIN bf16* rowp = base + (size_t)(u.row0 + rloc) * ldc + u.col0 + wc * 32 + 8 * fq;
#pragma unroll
            for (int bj = 0; bj < 2; ++bj) *(GAS v4u*)(rowp + bj * 128) = pack8(acc[ai][bj][m][0] * sc, acc[ai][bj][m][1] * sc); EPI_ROWS_END
    } };
struct EpiH0 { bf16* uv; bf16* qx; bf16* kx; bf16* vx; float rs;
    __device__ __forceinline__ void operator()(EPI_ARGS) const {
        const int pn = u.col0 >> 8, kind = pn < 4 ? 0 : ((pn - 4) >> 1) + 1;
        bf16* base = kind == 0 ? uv : kind == 1 ? qx : kind == 2 ? kx : vx;
        EPI_ROWS_BEGIN bf16* rowp = base + (size_t)(u.row0 + rloc) * DM;
#pragma unroll
            for (int bj = 0; bj < 2; ++bj) { f32x4 v0 = acc[ai][bj][m][0] * rs, v1 = acc[ai][bj][m][1] * rs;
                if (kind == 0) {
#pragma unroll
                    for (int j = 0; j < 4; ++j) { v0[j] = gelu_tanh(v0[j]); v1[j] = gelu_tanh(v1[j]); }
                    *(GAS v4u*)(rowp + u.col0 + bj * 128 + wc * 32 + 8 * fq) = pack8(v0, v1); }
                else { const int cr = ((pn - 4) & 1) * 256 + bj * 128 + wc * 32 + 8 * fq;
                    if (kind == 1) { v0 = v0 * C2; v1 = v1 * C2; }
                    *(GAS v4u*)(rowp + cr) = pack8(v0, v1); } } EPI_ROWS_END
    } };
struct EpiResid { const bf16* xb; bf16* zb; float rs = 1.0f;
    __device__ __forceinline__ void operator()(EPI_ARGS) const {
        EPI_ROWS_BEGIN const size_t off = (size_t)(u.row0 + rloc) * DM + u.col0 + wc * 32 + 8 * fq;
#pragma unroll
            for (int bj = 0; bj < 2; ++bj) { f32x4 x0, x1; unpack8(*(const GAS v4u*)(xb + off + bj * 128), x0, x1);
                *(GAS v4u*)(zb + off + bj * 128) = pack8(x0 * ALPHA + acc[ai][bj][m][0] * rs, x1 * ALPHA + acc[ai][bj][m][1] * rs); } EPI_ROWS_END
    } };
struct EpiUG { bf16* ug; float rs;
    __device__ __forceinline__ void operator()(EPI_ARGS) const {
        EPI_ROWS_BEGIN
#pragma unroll
            for (int bj = 0; bj < 2; ++bj) { const int col = u.col0 + bj * 128 + wc * 32 + 8 * fq;
                *(GAS v4u*)(ug + ((size_t)(col >> 4) * MTOK + (u.row0 + rloc)) * 16 + (col & 15)) = pack8(acc[ai][bj][m][0] * rs, acc[ai][bj][m][1] * rs); } EPI_ROWS_END
    } };
struct EpiScore { float* sc;
    __device__ __forceinline__ void operator()(EPI_ARGS) const {
        EPI_ROWS_BEGIN float* rowp = sc + (size_t)(u.row0 + rloc) * DM + u.col0 + wc * 32 + 8 * fq;
#pragma unroll
            for (int bj = 0; bj < 2; ++bj) { *(GAS f32x4*)(rowp + bj * 128) = acc[ai][bj][m][0]; *(GAS f32x4*)(rowp + bj * 128 + 4) = acc[ai][bj][m][1]; } EPI_ROWS_END
    } };
struct EpiSoftmaxP { bf16* P; LAS float* tab; float rs0; const float* st; const float* sc; int nslot;
    __device__ __forceinline__ void operator()(EPI_ARGS) const {
        { auto& A = const_cast<f32x4 (&)[2][2][4][2]>(acc); LAS float* tabC = tab + 512; ln_tables(tab, tabC, st, nslot, u.row0, sc, u.z * 1024 + u.col0, nullptr, nullptr, 0);
          const int cl = wc * 32 + 8 * fq;
          EPI_ROWS_BEGIN const float mu = tab[2 * rloc], rstd = tab[2 * rloc + 1];
#pragma unroll
              for (int bj = 0; bj < 2; ++bj)
#pragma unroll
                  for (int n = 0; n < 2; ++n) { const f32x4 s1 = *(const LAS f32x4*)(tabC + cl + bj * 128 + 4 * n), c1 = *(const LAS f32x4*)(tabC + 256 + cl + bj * 128 + 4 * n);
                      A[ai][bj][m][n] = (A[ai][bj][m][n] * rs0 - s1 * mu) * rstd + c1; } EPI_ROWS_END
          LDS_WAIT(); __builtin_amdgcn_s_barrier(); asm volatile("" ::: "memory"); }
        constexpr float rs = 1.0f;
        EPI_ROWS_BEGIN float mx = -3.0e38f;
#pragma unroll
            for (int bj = 0; bj < 2; ++bj)
#pragma unroll
                for (int n = 0; n < 2; ++n)
#pragma unroll
                    for (int j = 0; j < 4; ++j) mx = fmaxf(mx, acc[ai][bj][m][n][j]);
            mx *= rs; mx = fmaxf(mx, __shfl_xor(mx, 16)); mx = fmaxf(mx, __shfl_xor(mx, 32));
            float sm = 0.f;
#pragma unroll
            for (int bj = 0; bj < 2; ++bj)
#pragma unroll
                for (int n = 0; n < 2; ++n)
#pragma unroll
                    for (int j = 0; j < 4; ++j) sm += __builtin_amdgcn_exp2f(acc[ai][bj][m][n][j] * rs - mx);
            sm += __shfl_xor(sm, 16); sm += __shfl_xor(sm, 32);
            if (fq == 0) { tab[(rloc * 4 + wc) * 2] = mx; tab[(rloc * 4 + wc) * 2 + 1] = sm; } EPI_ROWS_END
        LDS_WAIT(); __builtin_amdgcn_s_barrier(); asm volatile("" ::: "memory");
        EPI_ROWS_BEGIN const f32x4 a = *(const LAS f32x4*)(tab + rloc * 8), b = *(const LAS f32x4*)(tab + rloc * 8 + 4);
            const float M = fmaxf(fmaxf(a[0], a[2]), fmaxf(b[0], b[2]));
            const float S = a[1] * __builtin_amdgcn_exp2f(a[0] - M) + a[3] * __builtin_amdgcn_exp2f(a[2] - M) + b[1] * __builtin_amdgcn_exp2f(b[0] - M) + b[3] * __builtin_amdgcn_exp2f(b[2] - M);
            const float inv = SP8 / S; unsigned char* rowp = (unsigned char*)P + (size_t)(u.row0 + rloc) * DM + u.col0 + wc * 32 + 8 * fq;
#pragma unroll
            for (int bj = 0; bj < 2; ++bj) { f32x4 v0, v1;
#pragma unroll
                for (int j = 0; j < 4; ++j) { v0[j] = __builtin_amdgcn_exp2f(acc[ai][bj][m][0][j] * rs - M) * inv; v1[j] = __builtin_amdgcn_exp2f(acc[ai][bj][m][1][j] * rs - M) * inv; }
                v2u w; w.x = pk4_fp8(v0[0], v0[1], v0[2], v0[3]); w.y = pk4_fp8(v1[0], v1[1], v1[2], v1[3]); *(GAS v2u*)(rowp + bj * 128) = w; } EPI_ROWS_END
        LDS_WAIT(); __builtin_amdgcn_s_barrier(); asm volatile("" ::: "memory");
    } };
struct EpiRouter { float* logit;
    __device__ __forceinline__ void operator()(EPI_ARGS) const {
        if (wc == 0) { EPI_ROWS_BEGIN float* rowp = logit + (size_t)(u.row0 + rloc) * 32 + 8 * fq; *(GAS f32x4*)(rowp) = acc[ai][0][m][0]; *(GAS f32x4*)(rowp + 4) = acc[ai][0][m][1]; EPI_ROWS_END }
    } };
struct EpiSwiglu { const float* bup; bf16* act;
    __device__ __forceinline__ void operator()(EPI_ARGS) const {
        const int j0 = u.col0 + wc * 32 + 8 * fq; const float* bb = bup + (size_t)u.z * 2048;
        const f32x4 bg0 = *(const GAS f32x4*)(bb + j0), bg1 = *(const GAS f32x4*)(bb + j0 + 4), bl0 = *(const GAS f32x4*)(bb + 1024 + j0), bl1 = *(const GAS f32x4*)(bb + 1024 + j0 + 4);
        EPI_ROWS_BEGIN f32x4 o0, o1;
#pragma unroll
            for (int j = 0; j < 4; ++j) {
                { const float gl = fminf(acc[ai][0][m][0][j] + bg0[j], 7.0f), ln = fminf(fmaxf(acc[ai][1][m][0][j] + bl0[j], -7.0f), 7.0f); o0[j] = gl * sigmoidf_(1.702f * gl) * (ln + 1.0f); }
                { const float gl = fminf(acc[ai][0][m][1][j] + bg1[j], 7.0f), ln = fminf(fmaxf(acc[ai][1][m][1][j] + bl1[j], -7.0f), 7.0f); o1[j] = gl * sigmoidf_(1.702f * gl) * (ln + 1.0f); } }
            *(GAS v4u*)(act + (size_t)(u.row0 + rloc) * DM + j0) = pack8(o0, o1); EPI_ROWS_END
    } };
struct EpiDown { const float* bdn; const int* list; const float* gate; bf16* ys; LAS const int* tab;
    __device__ __forceinline__ void operator()(EPI_ARGS) const {
        const int e = u.z, cnt = tab[e], c8 = u.col0 + wc * 32 + 8 * fq; const float* bb = bdn + (size_t)e * 1024 + c8;
        f32x4 bv[2][2];
#pragma unroll
        for (int bj = 0; bj < 2; ++bj) { bv[bj][0] = *(const GAS f32x4*)(bb + bj * 128); bv[bj][1] = *(const GAS f32x4*)(bb + bj * 128 + 4); }
        int av[8]; float gv[8];
#pragma unroll
        for (int i = 0; i < 8; ++i) { const int slot = u.aux * 256 + (i >> 2) * 128 + wr * 64 + (i & 3) * 16 + fr; const int sl = slot < cnt ? slot : 0;
            av[i] = (int)((unsigned)list[(size_t)e * CAP + sl] & (unsigned)(NASSIGN - 1)); }
#pragma unroll
        for (int i = 0; i < 8; ++i) gv[i] = gate[av[i]];
        EPI_ROWS_BEGIN const int slot = u.aux * 256 + rloc; const int a = av[ai * 4 + m]; const float gt = gv[ai * 4 + m]; bf16* rowp = ys + (size_t)a * DM + c8;
            if (slot < cnt) {
#pragma unroll
                for (int bj = 0; bj < 2; ++bj) *(GAS v4u*)(rowp + bj * 128) = pack8((acc[ai][bj][m][0] + bv[bj][0]) * gt, (acc[ai][bj][m][1] + bv[bj][1]) * gt); } EPI_ROWS_END
    } };
struct EpiSwiglu8 { const float* bup; unsigned char* act; int skip; LAS float* slot;
    static constexpr bool HAS_PRE = true;
    __device__ __forceinline__ void pre(const pg8::Unit& u, int wid, int lane) const {
        if (wid < 4) { const int t = wid * 64 + lane; const float* src = bup + (size_t)u.z * 2048 + u.col0 + (t < 128 ? t : 1024 + t - 128);
            __builtin_amdgcn_global_load_lds((const unsigned*)src, (LAS unsigned*)(slot + u.par * 256 + wid * 64), 4, 0, 0); } }
    __device__ __forceinline__ void operator()(EPI_ARGS) const {
        if (skip) {
#pragma unroll
            for (int a = 0; a < 2; ++a)
#pragma unroll
                for (int b = 0; b < 2; ++b)
#pragma unroll
                    for (int m = 0; m < 4; ++m) asm volatile("" :: "v"(acc[a][b][m][0]), "v"(acc[a][b][m][1])); return; }
        const int j0 = u.col0 + wc * 32 + 8 * fq; constexpr float RS = 1.0f / (SX8 * SWU8); const LAS float* sb = slot + u.par * 256 + wc * 32 + 8 * fq;
        const f32x4 bg0 = *(const LAS f32x4*)(sb), bg1 = *(const LAS f32x4*)(sb + 4), bl0 = *(const LAS f32x4*)(sb + 128), bl1 = *(const LAS f32x4*)(sb + 132);
        typedef float f32x2 __attribute__((ext_vector_type(2)));
        EPI_ROWS_BEGIN f32x4 o0, o1;
#pragma unroll
            for (int n = 0; n < 2; ++n)
#pragma unroll
                for (int h = 0; h < 2; ++h) {
                    const f32x4 ga = acc[ai][0][m][n], la = acc[ai][1][m][n], bgv = n ? bg1 : bg0, blv = n ? bl1 : bl0;
                    const f32x2 g2 = h ? ga.hi : ga.lo, l2 = h ? la.hi : la.lo, bg2 = h ? bgv.hi : bgv.lo, bl2 = h ? blv.hi : blv.lo;
                    f32x2 gl = g2 * RS + bg2, ln = l2 * RS + bl2;
                    gl.x = fminf(gl.x, 7.0f); gl.y = fminf(gl.y, 7.0f); ln.x = __builtin_amdgcn_fmed3f(ln.x, -7.0f, 7.0f); ln.y = __builtin_amdgcn_fmed3f(ln.y, -7.0f, 7.0f);
                    const f32x2 ea = gl * (-1.702f * LOG2E); f32x2 d; d.x = __builtin_amdgcn_exp2f(ea.x); d.y = __builtin_amdgcn_exp2f(ea.y); d = d + 1.0f;
                    f32x2 rc; rc.x = __builtin_amdgcn_rcpf(d.x); rc.y = __builtin_amdgcn_rcpf(d.y);
                    const f32x2 o = (gl * rc) * (ln * SA8 + SA8);
                    if (n == 0) { o0[2 * h] = o.x; o0[2 * h + 1] = o.y; } else { o1[2 * h] = o.x; o1[2 * h + 1] = o.y; } }
            v2u w; { int r0 = __builtin_amdgcn_cvt_pk_fp8_f32(o0[0], o0[1], 0, false); r0 = __builtin_amdgcn_cvt_pk_fp8_f32(o0[2], o0[3], r0, true); int r1 = __builtin_amdgcn_cvt_pk_fp8_f32(o1[0], o1[1], 0, false); r1 = __builtin_amdgcn_cvt_pk_fp8_f32(o1[2], o1[3], r1, true); w.x = (unsigned)r0; w.y = (unsigned)r1; }
            *(GAS v2u*)(act + (size_t)(u.row0 + rloc) * DM + j0) = w; EPI_ROWS_END
    } };
struct EpiDown8 { const float* bdn; bf16* ys; LAS float* slot;
    static constexpr bool HAS_PRE = true;
    __device__ __forceinline__ void pre(const pg8::Unit& u, int wid, int lane) const {
        if (wid < 4) __builtin_amdgcn_global_load_lds((const unsigned*)(bdn + (size_t)u.z * 1024 + u.col0 + wid * 64 + lane), (LAS unsigned*)(slot + u.par * 256 + wid * 64), 4, 0, 0); }
    __device__ __forceinline__ void operator()(EPI_ARGS) const {
        const int c8 = u.col0 + wc * 32 + 8 * fq; const LAS float* bb = slot + u.par * 256 + wc * 32 + 8 * fq; constexpr float RS = 1.0f / (SA8 * SWD8);
        f32x4 bv[2][2];
#pragma unroll
        for (int bj = 0; bj < 2; ++bj) { bv[bj][0] = *(const LAS f32x4*)(bb + bj * 128); bv[bj][1] = *(const LAS f32x4*)(bb + bj * 128 + 4); }
        EPI_ROWS_BEGIN unsigned char* rowp = (unsigned char*)ys + (size_t)(u.row0 + rloc) * DM + c8;
#pragma unroll
            for (int bj = 0; bj < 2; ++bj) { const f32x4 v0 = (acc[ai][bj][m][0] * RS + bv[bj][0]) * SY8, v1 = (acc[ai][bj][m][1] * RS + bv[bj][1]) * SY8; v2u w; w.x = pk4_fp8(v0[0], v0[1], v0[2], v0[3]); w.y = pk4_fp8(v1[0], v1[1], v1[2], v1[3]); *(GAS v2u*)(rowp + bj * 128) = w; } EPI_ROWS_END
    } };
struct EpiValGate { const bf16* xb; bf16* zb; float rsv, rsg; unsigned char* z8; float* st; LAS float* tab;
    __device__ __forceinline__ void operator()(EPI_ARGS) const {
        float ss[8], qq[8]; v4u xr[2][4];
        EPI_ROWS_BEGIN xr[ai][m] = *(const GAS v4u*)(xb + (size_t)(u.row0 + rloc) * DM + u.col0 + wc * 32 + 8 * fq); EPI_ROWS_END
        EPI_ROWS_BEGIN const size_t off = (size_t)(u.row0 + rloc) * DM + u.col0 + wc * 32 + 8 * fq; f32x4 x0, x1; unpack8(xr[ai][m], x0, x1); f32x4 o0, o1;
#pragma unroll
            for (int j = 0; j < 4; ++j) { o0[j] = x0[j] * ALPHA + acc[ai][0][m][0][j] * rsv * sigmoidf_(acc[ai][1][m][0][j] * rsg); o1[j] = x1[j] * ALPHA + acc[ai][0][m][1][j] * rsv * sigmoidf_(acc[ai][1][m][1][j] * rsg); }
            *(GAS v4u*)(zb + off) = pack8(o0, o1);
            { v2u w; w.x = pk4_fp8(o0[0] * SZ8, o0[1] * SZ8, o0[2] * SZ8, o0[3] * SZ8); w.y = pk4_fp8(o1[0] * SZ8, o1[1] * SZ8, o1[2] * SZ8, o1[3] * SZ8); *(GAS v2u*)(z8 + off) = w; }
            float s = ((o0[0] + o0[1]) + (o0[2] + o0[3])) + ((o1[0] + o1[1]) + (o1[2] + o1[3])), q = ((o0[0] * o0[0] + o0[1] * o0[1]) + (o0[2] * o0[2] + o0[3] * o0[3])) + ((o1[0] * o1[0] + o1[1] * o1[1]) + (o1[2] * o1[2] + o1[3] * o1[3]));
            s += __shfl_xor(s, 16); s += __shfl_xor(s, 32); q += __shfl_xor(q, 16); q += __shfl_xor(q, 32); ss[ai * 4 + m] = s; qq[ai * 4 + m] = q;
            asm volatile("" ::: "memory"); EPI_ROWS_END
        rowpair_publish(tab, st, 8, u.col0 >> 7, u.row0, ss, qq, wr, wc, fr, fq);
    } };

#ifndef ONLY_SITE
#define ONLY_SITE -1
#endif
#define SITE(s) (ONLY_SITE < 0 || ONLY_SITE == (s))
#define IN(k) (lo <= (k) && (k) < hi)
#define SEAM(k) do { if (IN(k) && IN((k) + 1)) xcd_barrier(bar); } while (0)
template <int l>
__device__ __forceinline__ void layer_shared(Frame& F, const Args& args, const XcdBarrier& bar, const int lo, const int hi) {
    unsigned char* ws = args.ws; bf16* const XB = (bf16*)(ws + WS_XB); bf16* const ZB = (bf16*)(ws + WS_ZB); const int cid = (int)blockIdx.x;
    constexpr int pb = 5 + 14 * l;
        gu32* cnt = F.ctl + CW_CNT + l * 32 * 64;
    const float* st1 = (const float*)(ws + WS_ST) + (size_t)l * MTOK * 16; const float* sc1 = (const float*)(ws + WS_SCC) + (size_t)l * 16384 * 8;
    if (IN(pb + 1) && SITE(6)) { PlainSched S; S.T.init(MTOK / 256, 4, F.G, cid); S.A = (const char*)(ws + WS_XFZ); S.B = (const char*)(ws + WS_KFT); S.tilesPerBatch = SEQ / 256; S.bBatch = (size_t)1024 * 1024; S.splitN = 0; S.aT = (size_t)256 * 1024; S.bT = (size_t)256 * 1024;
        EpiSoftmaxP E{(bf16*)(ws + WS_P), (LAS float*)(F.lds + SMX_OFF), 1.0f / (SZ8 * SK8), st1, sc1, l ? 8 : 4}; pg8::gemm_phase<EpiSoftmaxP, PlainSched, false, true>(F.lds, 1024, S, E); } SEAM(pb + 1);
    if (IN(pb + 3) && SITE(8)) { PlainSched S; S.T.init(MTOK / 256, 4, F.G, cid); S.A = (const char*)(ws + WS_P); S.B = (const char*)(ws + WS_VFT); S.tilesPerBatch = SEQ / 256; S.bBatch = (size_t)1024 * 1024; S.splitN = 0; S.aT = (size_t)256 * 1024; S.bT = (size_t)256 * 1024;
        EpiResidLN E{ZB, 1.0f / (SP8 * SV8), st1, (LAS float*)(F.lds + SMX_OFF), (l ? args.in[39] : args.in[14]), (l ? args.in[40] : args.in[15]), l ? 8 : 4}; pg8::gemm_phase<EpiResidLN, PlainSched, false, true>(F.lds, 1024, S, E); } SEAM(pb + 3);
    if (IN(pb + 4) && SITE(9)) { ph_ln2_router(F, ZB, XB, MOE_FP8 ? ws + WS_XF8 : nullptr, (l ? args.in[43] : args.in[18]), (l ? args.in[44] : args.in[19]), (const bf16*)(ws + WS_WR) + (size_t)l * 256 * 1024,
                                               (l ? args.in[46] : args.in[21]), cnt, (int*)(ws + WS_LIST), (float*)(ws + WS_GATE), (int*)(ws + WS_ASG), (float*)(ws + WS_ST2)); } SEAM(pb + 4);
    if (IN(pb + 7) && SITE(12)) { moe_tables(F, cnt);
#if MOE_FP8
        MoeSched S{(LAS const int*)(F.lds + TAB_OFF), 8, F.G, F.vcu, (const char*)(ws + WS_XF8), (const char*)(ws + WS_WUP8), (size_t)2048 * 1024, 128, (const int*)(ws + WS_LIST), true, (size_t)256 * 1024};
        EpiSwiglu8 E{(l ? args.in[48] : args.in[23]), ws + WS_ACT, args.variant == 9, (LAS float*)(F.lds + SMX_OFF)}; pg8::gemm_phase<EpiSwiglu8, MoeSched, true, true>(F.lds, 1024, S, E);
#else
        MoeSched S{(LAS const int*)(F.lds + TAB_OFF), 8, F.G, F.vcu, (const char*)XB, (const char*)(ws + WS_WUP), (size_t)2048 * 1024 * 2, 128, (const int*)(ws + WS_LIST), true, pg8::TSTEP};
        EpiSwiglu E{(l ? args.in[48] : args.in[23]), (bf16*)(ws + WS_ACT)}; pg8::gemm_phase<EpiSwiglu, MoeSched, true>(F.lds, 1024, S, E);
#endif
    } SEAM(pb + 7);
    if (IN(pb + 8) && SITE(13)) { moe_tables(F, cnt);
#if MOE_FP8
        MoeSched S{(LAS const int*)(F.lds + TAB_OFF), 4, F.G, F.vcu, (const char*)(ws + WS_ACT), (const char*)(ws + WS_WDN8), (size_t)1024 * 1024, 256, (const int*)(ws + WS_LIST), false, (size_t)256 * 1024};
        EpiDown8 E{(l ? args.in[50] : args.in[25]), (bf16*)(ws + WS_YS), (LAS float*)(F.lds + SMX_OFF)}; pg8::gemm_phase<EpiDown8, MoeSched, false, true>(F.lds, 1024, S, E);
#else
        MoeSched S{(LAS const int*)(F.lds + TAB_OFF), 4, F.G, F.vcu, (const char*)(ws + WS_ACT), (const char*)(ws + WS_WDN), (size_t)1024 * 1024 * 2, 256, (const int*)(ws + WS_LIST), false, pg8::TSTEP};
        EpiDown E{(l ? args.in[50] : args.in[25]), (const int*)(ws + WS_LIST), (const float*)(ws + WS_GATE), (bf16*)(ws + WS_YS), (LAS const int*)(F.lds + TAB_OFF)}; pg8::gemm_phase<EpiDown, MoeSched, false>(F.lds, 1024, S, E);
#endif
    } SEAM(pb + 8);
    if (IN(pb + 9) && SITE(14)) { moe_tables(F, cnt); ph_ln<1>(F, ZB, (const bf16*)(ws + WS_YS), XB, l ? args.out : nullptr, (l ? args.in[51] : args.in[26]), (l ? args.in[52] : args.in[27]), (l == 0) ? ws + WS_XF8 : nullptr, (const int*)(ws + WS_ASG), (const float*)(ws + WS_GATE),
                                                             (const float*)(ws + WS_ST2), (l ? args.in[43] : args.in[18]), (l ? args.in[44] : args.in[19]));
        if (l == 0) { __syncthreads(); cvt_experts(F, args.in[47], args.in[49], ws); } } SEAM(pb + 9);
}

constexpr int PH_TOTAL = 29;
__global__ void __launch_bounds__(NWAVES * 64, 2) mk_fwd(Args args) {
    extern __shared__ __attribute__((aligned(16))) unsigned char lds[];
    Frame F;
    F.lds = (LAS unsigned char*)lds; F.MISC = (volatile LAS unsigned*)(F.lds + MISC_OFF);
    F.wave = __builtin_amdgcn_readfirstlane((int)threadIdx.x >> 6);
    F.G = gridDim.x; { const int bx = blockIdx.x; F.vcu = (F.G % 8 == 0) ? (bx % 8) * (F.G / 8) + bx / 8 : bx; }
    unsigned char* ws = args.ws;
    F.ctl = (gu32*)(ws + WS_CTL);
    for (int u = FTID; u < (LDS_BYTES - LDSCTL_OFF) / 4; u += NWAVES * 64) ((LAS unsigned*)(F.lds + LDSCTL_OFF))[u] = 0u;
    __syncthreads();
    const int lo = args.ph_lo, hi = args.ph_hi;
    XcdBarrier bar; bar.bar = (unsigned*)(F.ctl + CW_BAR); bar.x = 0; bar.st = nullptr;
    if (hi - lo > 1) bar = xcd_barrier_post((unsigned*)(F.ctl + CW_BAR), F.MISC + 8);
    bf16* const XB = (bf16*)(ws + WS_XB); bf16* const ZB = (bf16*)(ws + WS_ZB);
    const int cid = (int)blockIdx.x;

    if (IN(0) && SITE(0)) { p0_prologue(F, args); } SEAM(0);
    if (IN(1) && SITE(1)) {
        { PlainSched S; S.T.init(MTOK / 256, HW0 / 256, F.G, cid); S.A = (const char*)XB; S.B = (const char*)(ws + WS_WIN0); S.tilesPerBatch = 1 << 20; S.bBatch = 0; S.splitN = 0;
          EpiH0 E{(bf16*)(ws + WS_UV), (bf16*)(ws + WS_QX), (bf16*)(ws + WS_QX) + 512, (bf16*)(ws + WS_VX), 1.0f}; pg8::gemm_phase<EpiH0, PlainSched>(F.lds, 1024, S, E); }
        { PlainSched S; S.T.init(NB * MEMLEN / 256, 2048 / 256, F.G, cid); S.A = (const char*)(ws + WS_MEMB); S.B = (const char*)(ws + WS_WKV); S.tilesPerBatch = 1 << 20; S.bBatch = 0; S.splitN = 4;
          EpiStore E{(bf16*)(ws + WS_KB), (bf16*)(ws + WS_VB), 1.f, 1.f, 1024}; pg8::gemm_phase<EpiStore, PlainSched>(F.lds, 1024, S, E); }
    } SEAM(1);
    if (IN(2) && SITE(2)) {
        attn_body::bf16* oat = (attn_body::bf16*)(ws + WS_OATT);
        { const attn_body::AttnTensors AT{(const attn_body::bf16*)(ws + WS_QX), (const attn_body::bf16*)(ws + WS_QX) + 512, (const attn_body::bf16*)(ws + WS_VX), oat};
          const attn_body::StaticOrder S((int)F.G, (int)blockIdx.x); attn_body::attn_phase<attn_body::StaticOrder>((char*)lds, AT, S); }
        VM_WAIT(); __syncthreads();
        if (F.G == 256) combine_local(F, (const bf16*)(ws + WS_OATT), (bf16*)(ws + WS_MIX), args.in[8], args.in[9], args.in[10], args.in[11], args.in[12], F.vcu >> 4, (F.vcu >> 2) & 3, F.vcu & 3);
        __syncthreads();
        ph_sgu(F, (const bf16*)(ws + WS_UV), (bf16*)(ws + WS_MIX), args.in[4], args.in[5], args.in[6], args.in[7]);
    } SEAM(2);
    if (IN(4) && SITE(4)) {
        { PlainSched S; S.T.init(MTOK / 256, 4, F.G, cid); S.A = (const char*)(ws + WS_MIX); S.B = (const char*)(ws + WS_WOUT0); S.tilesPerBatch = 1 << 20; S.bBatch = 0; S.splitN = 0;
          EpiResidStats E{XB, ZB, ws + WS_XFZ, (float*)(ws + WS_ST), (LAS float*)(F.lds + SMX_OFF)}; pg8::gemm_phase<EpiResidStats, PlainSched>(F.lds, 1024, S, E); }
        { FoldSched S{F.G, F.vcu, 0, (const char*)(ws + WS_KB), (const char*)(ws + WS_VB), (const char*)(ws + WS_XQB), (const char*)(ws + WS_XOT)};
          EpiFold E{ws + WS_KFT, ws + WS_VFT, args.in[14], args.in[15], (float*)(ws + WS_SCC), (LAS float*)(F.lds + SMX_OFF)}; int kf = 256; asm volatile("" : "+s"(kf)); pg8::gemm_phase<EpiFold, FoldSched>(F.lds, kf, S, E); }
    } SEAM(4);

    layer_shared<0>(F, args, bar, lo, hi);
    if (IN(15) && SITE(15)) { { PlainSched S; S.T.init(MTOK / 256, 4, F.G, cid); S.A = (const char*)(ws + WS_XF8); S.B = (const char*)(ws + WS_WIN1); S.tilesPerBatch = 1 << 20; S.bBatch = 0; S.splitN = 0; S.aT = (size_t)256 * 1024; S.bT = (size_t)256 * 1024;
        EpiUG E{(bf16*)(ws + WS_UG), 1.0f / (SX8 * SWU8)}; pg8::gemm_phase<EpiUG, PlainSched, false, true>(F.lds, 1024, S, E); }
        { FoldSched S{F.G, F.vcu, 0, (const char*)(ws + WS_KB), (const char*)(ws + WS_VB), (const char*)(ws + WS_XQB) + 1024 * 1024 * 2, (const char*)(ws + WS_XOT) + 1024 * 1024 * 2};
      EpiFold E{ws + WS_KFT, ws + WS_VFT, args.in[39], args.in[40], (float*)(ws + WS_SCC) + (size_t)16384 * 8, (LAS float*)(F.lds + SMX_OFF)}; int kf = 256; asm volatile("" : "+s"(kf)); pg8::gemm_phase<EpiFold, FoldSched>(F.lds, kf, S, E); }
    } SEAM(15);
    if (IN(16) && SITE(16)) { ph_s5(F, (const bf16*)(ws + WS_UG), (bf16*)(ws + WS_YB), args.in[29], args.in[30], args.in[31], args.in[32], args.in[33], args.in[34], args.in[35], args.in[36], args.variant); } SEAM(16);
    if (IN(17) && SITE(17)) { PlainSched S; S.T.init(MTOK / 256, 8, F.G, cid); S.A = (const char*)(ws + WS_YB); S.B = (const char*)(ws + WS_WVG); S.tilesPerBatch = 1 << 20; S.bBatch = 0; S.splitN = 0; S.aT = (size_t)256 * 16; S.bT = (size_t)256 * 1024;
        struct VGS { PlainSched P; __device__ __forceinline__ bool next(int i, pg8::Unit& u) const { if (!P.next(i, u)) return false; u.col0 >>= 1; return true; } } S2{S};
        EpiValGate E{XB, ZB, 1.0f / (SA8 * SWD8), 1.0f / (SA8 * SWU8), ws + WS_XFZ, (float*)(ws + WS_ST) + (size_t)MTOK * 16, (LAS float*)(F.lds + SMX_OFF)}; pg8::gemm_phase<EpiValGate, VGS, false, true, 1>(F.lds, 1024, S2, E); } SEAM(17);
    layer_shared<1>(F, args, bar, lo, hi);
#undef IN
#undef SEAM
}

extern "C" void kernel_launch(void* const* d_in, const int* in_sizes, int n_in, void* d_out, int out_size, void* d_ws, size_t ws_size, hipStream_t stream) {
    static int grid = 0;
    if (grid == 0) {
        if (n_in != 53 || in_sizes[0] != MTOK * DM || out_size != MTOK * DM || ws_size < WS_END) { fprintf(stderr, "kernel_launch: unexpected problem (n_in %d, in0 %d, out %d, ws %zu < %zu); nothing launched\n", n_in, n_in > 0 ? in_sizes[0] : -1, out_size, ws_size, (size_t)WS_END); grid = -1; return; }
        int dev = 0, cus = 0, per_cu = 0;
        if (hipGetDevice(&dev) != hipSuccess || hipDeviceGetAttribute(&cus, hipDeviceAttributeMultiprocessorCount, dev) != hipSuccess) { grid = -1; return; }
        if (hipFuncSetAttribute((const void*)mk_fwd, hipFuncAttributeMaxDynamicSharedMemorySize, LDS_BYTES) != hipSuccess) { fprintf(stderr, "kernel_launch: hipFuncSetAttribute failed\n"); grid = -1; return; }
        if (hipOccupancyMaxActiveBlocksPerMultiprocessor(&per_cu, (const void*)mk_fwd, NWAVES * 64, LDS_BYTES) != hipSuccess || per_cu < 1) fprintf(stderr, "kernel_launch: note: occupancy query reports %d\n", per_cu);
        (void)hipGetLastError();
        grid = cus;
    }
    if (grid < 0) return;
    if (hipMemsetAsync((char*)d_ws + WS_CTL, 0, CTL_ZERO_BYTES, stream) != hipSuccess) return;
    Args a{};
    for (int i = 0; i < 53; ++i) a.in[i] = (const float*)d_in[i];
    a.out = (float*)d_out; a.ws = (unsigned char*)d_ws;
#if MK_N_LAUNCHES == 1
    a.ph_lo = 0; a.ph_hi = PH_TOTAL;
    hipLaunchKernelGGL(mk_fwd, dim3(grid), dim3(NWAVES * 64), LDS_BYTES, stream, a);
#else
    for (int p = 0; p < PH_TOTAL; ++p) { if (p == 18 || p == 5 || p == 19) continue; a.ph_lo = p; a.ph_hi = p + 1;
        for (int rep = 0; rep < 1 + (int)(((PROBE_REPEAT_MASK) >> p) & 1ull); ++rep) { a.variant = (rep == 0 && (((PROBE_REPEAT_MASK) >> p) & 1ull)) ? PROBE_VARIANT : 0; hipLaunchKernelGGL(mk_fwd, dim3(grid), dim3(NWAVES * 64), LDS_BYTES, stream, a); } }
#endif
}
```

```cpp
#include <hip/hip_runtime.h>
#include <hip/hip_bf16.h>
#include <cstdio>
#include <cstdint>

#ifndef MK_N_LAUNCHES
#define MK_N_LAUNCHES 1
#endif

#ifndef MOE_FP8
#define MOE_FP8 1
#endif
#ifndef PROBE_VARIANT
#define PROBE_VARIANT 0
#endif
#ifndef PROBE_REPEAT_MASK
#define PROBE_REPEAT_MASK 0ull
#endif
#define GAS __attribute__((address_space(1)))
#define LAS __attribute__((address_space(3)))
typedef unsigned short bf16;
typedef unsigned v4u __attribute__((ext_vector_type(4)));
typedef unsigned v2u __attribute__((ext_vector_type(2)));
typedef float f32x4 __attribute__((ext_vector_type(4)));
typedef float f32x2 __attribute__((ext_vector_type(2)));
typedef short bf16x8 __attribute__((ext_vector_type(8)));
typedef int v4i_t __attribute__((ext_vector_type(4)));
typedef GAS unsigned gu32;
#define RLX_AGENT __ATOMIC_RELAXED, __HIP_MEMORY_SCOPE_AGENT
#define LDS_WAIT() asm volatile("s_waitcnt lgkmcnt(0)" ::: "memory")
#define VM_WAIT() asm volatile("s_waitcnt vmcnt(0)" ::: "memory")

constexpr int NB = 16, SEQ = 2048, DM = 1024, MTOK = NB * SEQ;
constexpr int MEMLEN = 256, NEXP = 32, TOPK = 4, NASSIGN = MTOK * TOPK;
constexpr int HW0 = 2560;
constexpr int CAP = MTOK;
constexpr int MAXBLK = NASSIGN / 256 + NEXP;
constexpr float LN_EPS = 1e-5f;
constexpr float ALPHA = 1.41421356237f;
constexpr float LOG2E = 1.4426950408889634f;
constexpr float C2 = 0.125f * LOG2E;
constexpr float CSC = 0.0625f * LOG2E;
constexpr float LAM_INIT0 = 0.2f;

constexpr size_t MiB = 1u << 20;
constexpr size_t WS_CTL = 0, CTL_ZERO_BYTES = 96 * 1024;
constexpr size_t WS_LIST = 1 * MiB;
constexpr size_t WS_GATE = WS_LIST + 4 * MiB;
constexpr size_t WS_ASG = WS_GATE + 512 * 1024;
constexpr size_t WS_LOGIT = WS_GATE + 1 * MiB;
constexpr size_t WS_WKV = WS_LOGIT + 4 * MiB;
constexpr size_t WS_WIN0 = WS_WKV + 4 * MiB;
constexpr size_t WS_WOUT0 = WS_WIN0 + 5 * MiB;
constexpr size_t WS_XQB = WS_WOUT0 + 2 * MiB;
constexpr size_t WS_XOT = WS_XQB + 4 * MiB;
constexpr size_t WS_WIN1 = WS_XOT + 4 * MiB;
constexpr size_t WS_WVG = WS_WIN1 + 2 * MiB;
constexpr size_t WS_WR = WS_WVG + 4 * MiB;
constexpr size_t WS_MEMB = WS_WR + 1 * MiB;
constexpr size_t WS_KB = WS_MEMB + 8 * MiB;
constexpr size_t WS_VB = WS_KB + 8 * MiB;
constexpr size_t WS_KFT = WS_VB + 8 * MiB;
constexpr size_t WS_VFT = WS_KFT + 32 * MiB;
constexpr size_t WS_WUP = WS_VFT + 32 * MiB;
constexpr size_t WS_WDN = WS_WUP + 128 * MiB;
constexpr size_t WS_XB = WS_WDN + 64 * MiB;
constexpr size_t WS_ZB = WS_XB + 64 * MiB;
constexpr size_t WS_BIG1 = WS_ZB + 64 * MiB;
constexpr size_t WS_BIG2 = WS_BIG1 + 272 * MiB;
constexpr size_t WS_END = WS_BIG2 + 272 * MiB;
static_assert(WS_END <= 1024 * MiB, "workspace map exceeds 1 GiB");
constexpr size_t WS_UV = WS_BIG1;
constexpr size_t WS_QX = WS_BIG1 + 64 * MiB;
constexpr size_t WS_KX = WS_BIG1 + 128 * MiB;
constexpr size_t WS_VX = WS_BIG1 + 192 * MiB;
constexpr size_t WS_SC = WS_BIG1;
constexpr size_t WS_WUP8 = WS_WUP;
constexpr size_t WS_WDN8 = WS_WUP + 64 * MiB;
constexpr size_t WS_XF8 = WS_WUP + 96 * MiB;
constexpr float SX8 = 4.0f, SWU8 = 64.0f, SA8 = 4.0f, SWD8 = 128.0f, SP8 = 256.0f, SV8 = 8.0f, SK8 = 32.0f, SY8 = 32.0f;
constexpr size_t WS_XFZ = WS_WDN;
constexpr size_t WS_SCC = WS_WDN + 32 * MiB;
constexpr size_t WS_ST2 = WS_WDN + 40 * MiB;
constexpr size_t WS_ST = WS_LOGIT;
constexpr float SZ8 = 8.0f;
constexpr size_t WS_ACT = WS_BIG1;
constexpr size_t WS_OATT = WS_BIG2;
constexpr size_t WS_MIX = WS_BIG2 + 64 * MiB;
constexpr size_t WS_P = WS_BIG2 + 128 * MiB;
constexpr size_t WS_UG = WS_BIG2;
constexpr size_t WS_YB = WS_BIG2 + 64 * MiB;
constexpr size_t WS_XG = WS_BIG2;
constexpr size_t WS_YS = WS_BIG2;

constexpr int CW_TMO = 0;
constexpr int CW_BAR = 4096;
constexpr int CW_CNT = 16384;
static_assert((CW_CNT + 64 * 64) * 4 <= (int)CTL_ZERO_BYTES && (CW_BAR + 3456) * 4 <= (int)CTL_ZERO_BYTES, "control words inside the per-call memset");

constexpr int RING_BYTES = 131072;
constexpr int SCR_BYTES = 135168;
constexpr int LDSCTL_OFF = SCR_BYTES, MISC_OFF = LDSCTL_OFF + 320;
constexpr int TAB_OFF = MISC_OFF + 128;
constexpr int SMX_OFF = TAB_OFF + 576;
constexpr int LDS_BYTES = 147456;
static_assert(SMX_OFF % 16 == 0 && SMX_OFF + 8192 <= LDS_BYTES, "LDS map");

__device__ __forceinline__ unsigned f2bf(float f) { unsigned u = __builtin_bit_cast(unsigned, f); return (u + 0x7fffu + ((u >> 16) & 1u)) >> 16; }
__device__ __forceinline__ unsigned pk2(float lo, float hi) { return f2bf(lo) | (f2bf(hi) << 16); }
__device__ __forceinline__ float bflo(unsigned w) { return __builtin_bit_cast(float, w << 16); }
__device__ __forceinline__ float bfhi(unsigned w) { return __builtin_bit_cast(float, w & 0xffff0000u); }
__device__ __forceinline__ float bf2f(bf16 b) { return __builtin_bit_cast(float, ((unsigned)b) << 16); }
__device__ __forceinline__ float wave_sum(float v) {
#pragma unroll
    for (int o = 1; o < 64; o <<= 1) v += __shfl_xor(v, o);
    return v;
}
__device__ __forceinline__ float wave_max(float v) {
#pragma unroll
    for (int o = 1; o < 64; o <<= 1) v = fmaxf(v, __shfl_xor(v, o));
    return v;
}
__device__ __forceinline__ float gelu_tanh(float x) {
    const float t = x * (0.7978845608f * 2.0f * LOG2E) * (1.0f + 0.044715f * x * x);
    return x * __builtin_amdgcn_rcpf(1.0f + __builtin_amdgcn_exp2f(-t));
}
__device__ __forceinline__ float sigmoidf_(float x) { return __builtin_amdgcn_rcpf(1.0f + __builtin_amdgcn_exp2f(-x * LOG2E)); }

namespace pg8 {
constexpr int BM = 256, BK = 64, HALF = 128, HTB = HALF * BK * 2, STAGE_BYTES = 8 * HTB, NXCD = 8, WGM = 8;
constexpr int LD = 1024;
constexpr size_t HSTEP = (size_t)HALF * LD * 2, TSTEP = 2 * HSTEP;
__host__ __device__ __forceinline__ int lds_byte(int r, int c) { const int st = (r >> 4) * 2 + (c >> 5), rr = r & 15, cc = c & 31, ob = rr * 64 + cc * 2; return st * 1024 + (ob ^ (((ob >> 9) & 1) << 5)); }
__host__ __device__ __forceinline__ void stage_rc(int b, int& R, int& C) { const int st = b / 1024, sb = b % 1024, swz = sb ^ (((sb >> 9) & 1) << 5); R = (st >> 1) * 16 + swz / 64; C = (st & 1) * 32 + (swz % 64) / 2; }
__host__ __device__ __forceinline__ int perm32(int rho) { const int n = rho >> 4, i = rho & 15; return 8 * (i >> 2) + 4 * n + (i & 3); }

struct Unit { const char* a; const char* b; int row0, col0, z, aux, par; };
template <class E, class = void> struct epi_has_pre { static constexpr bool value = false; };
template <class E> struct epi_has_pre<E, decltype((void)E::HAS_PRE)> { static constexpr bool value = true; };

struct TileOrder {
    int nM, nN, nwg, G, c;
    __device__ void init(int nM_, int nN_, int G_, int c_) { nM = nM_; nN = nN_; nwg = nM * nN; G = G_; c = c_; }
    __device__ bool get(int i, int& pm, int& pn) const {
        const long L = (long)i * G + c; if (L >= nwg) return false;
        int wgid = (int)L; { const int q = nwg / NXCD, r = nwg % NXCD, xcd = wgid % NXCD, off = wgid / NXCD; wgid = (xcd < r ? xcd * (q + 1) : r * (q + 1) + (xcd - r) * q) + off; }
        const int nig = WGM * nN, gid = wgid / nig, fm = gid * WGM, gsz = (nM - fm) < WGM ? (nM - fm) : WGM;
        pm = fm + ((wgid % nig) % gsz); pn = (wgid % nig) / gsz; return true;
    }
};

__device__ __forceinline__ unsigned cvt_pk_bf16(float lo, float hi) { unsigned r; asm volatile("v_cvt_pk_bf16_f32 %0, %1, %2" : "=v"(r) : "v"(lo), "v"(hi)); return r; }

template <class Epi, class Sched, bool GATHER = false, bool FP8 = false, int ALAY = 0>
__device__ __forceinline__ void gemm_phase(LAS unsigned char* lds, const int K, const Sched& S, const Epi& E) {
    int tid = threadIdx.x; asm volatile("" : "+v"(tid));
    const int wid = __builtin_amdgcn_readfirstlane(tid >> 6), lane = tid & 63, wr = wid >> 2, wc = wid & 3, fr = lane & 15, fq = lane >> 4;
    constexpr unsigned ROWB = FP8 ? 1024u : 2048u;
    const int nt = FP8 ? K / 128 : K / BK;
    unsigned voffA[2], voffB[2]; int RA[2], CA[2];
#pragma unroll
    for (int i = 0; i < 2; ++i) { int R, C; stage_rc(tid * 16 + i * 8192, R, C); const int Rb = (R & ~31) + perm32(R & 31);
        voffA[i] = ALAY ? (unsigned)(C >> 3) * (unsigned)(MTOK * 16) + (unsigned)R * 16u : (unsigned)R * ROWB + (unsigned)C * 2u; voffB[i] = (unsigned)Rb * ROWB + (unsigned)C * 2u; RA[i] = R; CA[i] = C; }
    const size_t kstep = (size_t)(BK * 2);
    const size_t kstepA = ALAY ? (size_t)8 * MTOK * 16 : kstep;
    const size_t hstepB = (size_t)HALF * ROWB;
    const size_t hstepA = GATHER ? 0 : (ALAY ? (size_t)HALF * 16 : (size_t)HALF * ROWB);
    const unsigned ldsw = (unsigned)wid * 1024u;
    const int aoff0 = lds_byte(wr * 64 + fr, fq * 8);
    const int boff0 = lds_byte(wc * 32 + fr, fq * 8);
    unsigned aB = (unsigned)(uintptr_t)lds + (unsigned)aoff0, bB = (unsigned)(uintptr_t)lds + 4u * HTB + (unsigned)boff0; asm volatile("" : "+v"(aB), "+v"(bB));
    constexpr int KOFF = 1024;
#define PG8_SA(b, h) (((b) * 2 + (h)) * HTB)
#define PG8_SB(b, h) ((4 + (b) * 2 + (h)) * HTB)
#define PG8_STAGE(bufoff, gbase, voff) do { _Pragma("unroll") for (int _i = 0; _i < 2; ++_i) \
        __builtin_amdgcn_global_load_lds((const unsigned*)((const char*)(gbase) + (voff)[_i]), (LAS unsigned*)(lds + (bufoff) + ldsw + _i * 8192), 16, 0, 0); } while (0)
#define PG8_LD32(base, off0) __builtin_shufflevector(*(const LAS v4i_t*)((base) + (unsigned)(off0)), *(const LAS v4i_t*)((base) + (unsigned)((off0) + KOFF)), 0, 1, 2, 3, 4, 5, 6, 7)
#define PG8_LDA(dst, b, h) do { if constexpr (FP8) { _Pragma("unroll") for (int m = 0; m < 4; ++m) dst##8[m] = PG8_LD32(aB, PG8_SA(b, h) + m * 2048); } else { _Pragma("unroll") for (int m = 0; m < 4; ++m) _Pragma("unroll") for (int k = 0; k < 2; ++k) dst[m][k] = *(const LAS bf16x8*)(aB + (unsigned)(PG8_SA(b, h) + m * 2048 + k * KOFF)); } } while (0)
#define PG8_LDB(dst, b, h) do { if constexpr (FP8) { _Pragma("unroll") for (int n = 0; n < 2; ++n) dst##8[n] = PG8_LD32(bB, PG8_SA(b, h) + n * 2048); } else { _Pragma("unroll") for (int n = 0; n < 2; ++n) _Pragma("unroll") for (int k = 0; k < 2; ++k) dst[n][k] = *(const LAS bf16x8*)(bB + (unsigned)(PG8_SA(b, h) + n * 2048 + k * KOFF)); } } while (0)
#define PG8_MMA(ai, bj, At, Bt) do { __builtin_amdgcn_s_setprio(1); _Pragma("unroll") for (int m = 0; m < 4; ++m) _Pragma("unroll") for (int n = 0; n < 2; ++n) { \
        if constexpr (FP8) asm volatile("v_mfma_scale_f32_16x16x128_f8f6f4 %0, %1, %2, %0, %3, %3 op_sel_hi:[0,0,0]" : "+v"(acc[ai][bj][m][n]) : "v"(Bt##8[n]), "v"(At##8[m]), "v"(sc8)); \
        else { _Pragma("unroll") for (int k = 0; k < 2; ++k) acc[ai][bj][m][n] = __builtin_amdgcn_mfma_f32_16x16x32_bf16(Bt[n][k], At[m][k], acc[ai][bj][m][n], 0, 0, 0); } } __builtin_amdgcn_s_setprio(0); } while (0)
#define PG8_WAIT_V(n) asm volatile("s_waitcnt vmcnt(" #n ")" ::: "memory")
#define PG8_WAIT_L(n) asm volatile("s_waitcnt lgkmcnt(" #n ")" ::: "memory")
#define PG8_BAR __builtin_amdgcn_s_barrier()
#define PG8_SCHED __builtin_amdgcn_sched_barrier(0)
    Unit cur, nxt; int ui = 0;
    if (!S.next(0, cur)) return;
    f32x4 acc[2][2][4][2];
#pragma unroll
    for (int a = 0; a < 2; ++a)
#pragma unroll
        for (int b = 0; b < 2; ++b)
#pragma unroll
            for (int m = 0; m < 4; ++m)
#pragma unroll
                for (int n = 0; n < 2; ++n) acc[a][b][m][n] = (f32x4){0.f, 0.f, 0.f, 0.f};
    typedef int v8i_t __attribute__((ext_vector_type(8)));
    bf16x8 At[4][2], B0[2][2], B1[2][2]; v8i_t At8[4], B08[2], B18[2];
    int sc8 = 0x7f7f7f7f; asm volatile("" : "+v"(sc8));
    const char* cA = cur.a; const char* cB = cur.b;
    unsigned vA0[2], vA1[2], nA0[2], nA1[2];
    if constexpr (GATHER) { const int* rw = S.rows(cur);
#pragma unroll
        for (int i = 0; i < 2; ++i) { vA0[i] = (unsigned)Sched::rowmap(rw[RA[i]]) * ROWB + (unsigned)CA[i] * 2u; vA1[i] = (unsigned)Sched::rowmap(rw[128 + RA[i]]) * ROWB + (unsigned)CA[i] * 2u; nA0[i] = vA0[i]; nA1[i] = vA1[i]; } }
    else {
#pragma unroll
        for (int i = 0; i < 2; ++i) { vA0[i] = voffA[i]; vA1[i] = voffA[i]; nA0[i] = voffA[i]; nA1[i] = voffA[i]; } }
    cur.par = 0; if constexpr (epi_has_pre<Epi>::value) E.pre(cur, wid, lane);
    PG8_STAGE(PG8_SB(0, 0), cB, voffB); PG8_STAGE(PG8_SB(0, 1), cB + hstepB, voffB); PG8_STAGE(PG8_SA(0, 0), cA, vA0); PG8_STAGE(PG8_SA(0, 1), cA + hstepA, vA1);
    if (wr == 1) PG8_BAR;
    PG8_WAIT_V(2); PG8_BAR;
    PG8_STAGE(PG8_SB(1, 0), cB + kstep, voffB); PG8_STAGE(PG8_SA(1, 0), cA + kstepA, vA0); PG8_STAGE(PG8_SB(1, 1), cB + hstepB + kstep, voffB);
    PG8_WAIT_V(6); PG8_BAR;
    for (;;) {
        const bool has_next = S.next(ui + 1, nxt);
        const char* nA = has_next ? nxt.a : cA; const char* nB = has_next ? nxt.b : cB;
        int ri[4] = {0, 0, 0, 0};
        if constexpr (GATHER) { if (has_next) { const int* rw = S.rows(nxt);
#pragma unroll
            for (int i = 0; i < 4; ++i) { const int* pp = rw + (i >> 1) * 128 + RA[i & 1]; asm volatile("global_load_dword %0, %1, off" : "=v"(ri[i]) : "v"(pp) : "memory"); } } }
#pragma nounroll
        for (int t = 0; t < nt; t += 2) {
            const bool last = (t == nt - 2);
            if constexpr (GATHER) { if (last && has_next) { asm volatile("s_waitcnt vmcnt(8) ; ROWIDX" : "+v"(ri[0]), "+v"(ri[1]), "+v"(ri[2]), "+v"(ri[3]) :: "memory");
#pragma unroll
                for (int i = 0; i < 2; ++i) { nA0[i] = (unsigned)Sched::rowmap(ri[i]) * ROWB + (unsigned)CA[i] * 2u; nA1[i] = (unsigned)Sched::rowmap(ri[2 + i]) * ROWB + (unsigned)CA[i] * 2u; } } }
            const char* a1 = cA + (size_t)(t + 1) * kstepA;
            const char* a2 = last ? nA : cA + (size_t)(t + 2) * kstepA; const char* b2 = last ? nB : cB + (size_t)(t + 2) * kstep;
            const char* a3 = a2 + kstepA; const char* b3 = b2 + kstep;
            unsigned w0[2], w1[2];
#pragma unroll
            for (int i = 0; i < 2; ++i) { w0[i] = last ? nA0[i] : vA0[i]; w1[i] = last ? nA1[i] : vA1[i]; }
            PG8_LDB(B0, 0, 0); PG8_LDB(B1, 0, 1); PG8_SCHED; PG8_LDA(At, 0, 0); PG8_STAGE(PG8_SA(1, 1), a1 + hstepA, vA1);
            PG8_WAIT_V(8); PG8_WAIT_L(0); PG8_BAR; PG8_MMA(0, 0, At, B0); PG8_MMA(0, 1, At, B1); PG8_BAR; PG8_SCHED;
            PG8_LDA(At, 0, 1); PG8_STAGE(PG8_SB(0, 0), b2, voffB); PG8_STAGE(PG8_SB(0, 1), b2 + hstepB, voffB); PG8_STAGE(PG8_SA(0, 0), a2, w0);
            PG8_WAIT_V(8); PG8_WAIT_L(0); PG8_BAR; PG8_MMA(1, 0, At, B0); PG8_MMA(1, 1, At, B1); PG8_BAR; PG8_SCHED;
            PG8_LDB(B0, 1, 0); PG8_LDB(B1, 1, 1); PG8_SCHED; PG8_LDA(At, 1, 0); PG8_STAGE(PG8_SA(0, 1), a2 + hstepA, w1);
            PG8_WAIT_V(8); PG8_WAIT_L(0); PG8_BAR; PG8_MMA(0, 0, At, B0); PG8_MMA(0, 1, At, B1); PG8_BAR; PG8_SCHED;
            PG8_LDA(At, 1, 1); PG8_STAGE(PG8_SB(1, 0), b3, voffB); PG8_STAGE(PG8_SB(1, 1), b3 + hstepB, voffB); PG8_STAGE(PG8_SA(1, 0), a3, w0);
            PG8_WAIT_V(8); PG8_WAIT_L(0); PG8_BAR; PG8_MMA(1, 0, At, B0); PG8_MMA(1, 1, At, B1); PG8_BAR; PG8_SCHED;
        }
        if constexpr (epi_has_pre<Epi>::value) { if (has_next) { nxt.par = (ui + 1) & 1; E.pre(nxt, wid, lane); } }
        if (wr == 0) PG8_BAR;
        if constexpr (FP8) asm volatile("s_nop 15\n\ts_nop 15" ::: "memory");
        E(acc, cur, wr, wc, fr, fq);
        if (!has_next) break;
#pragma unroll
        for (int a = 0; a < 2; ++a)
#pragma unroll
            for (int b = 0; b < 2; ++b)
#pragma unroll
                for (int m = 0; m < 4; ++m)
#pragma unroll
                    for (int n = 0; n < 2; ++n) acc[a][b][m][n] = (f32x4){0.f, 0.f, 0.f, 0.f};
        cur = nxt; cA = nA; cB = nB; ++ui;
#pragma unroll
        for (int i = 0; i < 2; ++i) { vA0[i] = nA0[i]; vA1[i] = nA1[i]; }
        if (wr == 1) PG8_BAR;
    }
    PG8_WAIT_V(0);
    PG8_BAR;
#undef PG8_SA
#undef PG8_SB
#undef PG8_STAGE
#undef PG8_LDA
#undef PG8_LDB
#undef PG8_MMA
#undef PG8_LD32
#undef PG8_WAIT_V
#undef PG8_WAIT_L
#undef PG8_BAR
#undef PG8_SCHED
}
}
namespace attn_body {
using bf16=__hip_bfloat16;
using bf16x8=__attribute__((ext_vector_type(8)))short;
using s16x4=__attribute__((ext_vector_type(4)))short;
using f32x16=__attribute__((ext_vector_type(16)))float;
using u32x4=__attribute__((ext_vector_type(4)))unsigned;
constexpr int BATCH=16,NHEAD=16,SEQ=2048,D=64,DM=NHEAD*D;
constexpr int NW=8,QBLK=32,QB=QBLK*NW,KVBLK=64,NQB=SEQ/QB;
constexpr int ATTN_PITCH=DM, ATTN_UNIT_ROWS=QB;
__device__ __forceinline__ int crow(int r,int hi){return (r&3)+8*(r>>2)+4*hi;}
#define SBAR() __builtin_amdgcn_sched_barrier(0)
__device__ __forceinline__ void cmask(f32x16&p0,f32x16&p1,int jb,int qrel,int hi){
  const float NEG=-INFINITY; int kb=64*jb+4*hi;
  #pragma unroll
  for(int r=0;r<16;++r){int kv=kb+(r&3)+8*(r>>2); if(kv>qrel)p0[r]=NEG; if(kv+32>qrel)p1[r]=NEG;}
}

constexpr int NSLOT=3, SLOTB=8192;
constexpr int LDS_K=0, LDS_V=NSLOT*SLOTB, LDS_WS=2*NSLOT*SLOTB, LDS_OST=LDS_WS+NW*64*4, LDS_BYTES=LDS_OST+NW*4096;
constexpr float C2=0.125f*1.4426950408889634f;
__device__ __forceinline__ void glds16(const void*gsrc,unsigned lds_dst){unsigned keep;
  asm volatile("s_mov_b32 %0, m0\n\ts_mov_b32 m0, %2\n\ts_nop 0\n\tglobal_load_lds_dwordx4 %1, off\n\ts_mov_b32 m0, %0":"=&s"(keep):"v"(gsrc),"s"(lds_dst):"memory");}
__device__ __forceinline__ float max3f(float a,float b,float c){float r;asm("v_max3_f32 %0, %1, %2, %3":"=v"(r):"v"(a),"v"(b),"v"(c));return r;}
__device__ __forceinline__ float max2f(float a,float b){float r;asm("v_max_f32_e32 %0, %1, %2":"=v"(r):"v"(a),"v"(b));return r;}
__device__ __forceinline__ float fadd_s(float a,float b){float r;asm("v_add_f32_e32 %0, %1, %2":"=v"(r):"v"(a),"v"(b));return r;}
__device__ __forceinline__ float fsub_s(float a,float b){float r;asm("v_sub_f32_e32 %0, %1, %2":"=v"(r):"v"(a),"v"(b));return r;}
typedef float f32x2_t __attribute__((ext_vector_type(2))); typedef __bf16 bf16x2_t __attribute__((ext_vector_type(2)));
__device__ __forceinline__ unsigned cvtpk_s(float lo,float hi){f32x2_t v={lo,hi};bf16x2_t b=__builtin_convertvector(v,bf16x2_t);return __builtin_bit_cast(unsigned,b);}
#define WAIT_BAR(N) asm volatile("s_waitcnt vmcnt(" #N ") lgkmcnt(0)\n\ts_barrier":::"memory")

__device__ __forceinline__ void qkt(f32x16&p0,f32x16&p1,const char*Kslot,const bf16x8*qr,const f32x16&negm,int r32,int hi){
  const char*kb=Kslot+hi*1024+r32*16;
  #pragma unroll
  for(int d0=0;d0<4;++d0){
    const bf16x8 b0=*reinterpret_cast<const bf16x8*>(kb+d0*2048);
    const bf16x8 b1=*reinterpret_cast<const bf16x8*>(kb+d0*2048+512);
    if(d0==0){p0=__builtin_amdgcn_mfma_f32_32x32x16_bf16(b0,qr[0],negm,0,0,0);p1=__builtin_amdgcn_mfma_f32_32x32x16_bf16(b1,qr[0],negm,0,0,0);}
    else{p0=__builtin_amdgcn_mfma_f32_32x32x16_bf16(b0,qr[d0],p0,0,0,0);p1=__builtin_amdgcn_mfma_f32_32x32x16_bf16(b1,qr[d0],p1,0,0,0);}}
}
typedef __attribute__((address_space(3))) const char* lds_cptr;
typedef short v4i16_t __attribute__((ext_vector_type(4)));
__device__ __forceinline__ void kload8(bf16x8*kf,lds_cptr kp){
  kf[0]=*(const __attribute__((address_space(3))) bf16x8*)(kp);      kf[1]=*(const __attribute__((address_space(3))) bf16x8*)(kp+512);
  kf[2]=*(const __attribute__((address_space(3))) bf16x8*)(kp+2048); kf[3]=*(const __attribute__((address_space(3))) bf16x8*)(kp+2560);
  kf[4]=*(const __attribute__((address_space(3))) bf16x8*)(kp+4096); kf[5]=*(const __attribute__((address_space(3))) bf16x8*)(kp+4608);
  kf[6]=*(const __attribute__((address_space(3))) bf16x8*)(kp+6144); kf[7]=*(const __attribute__((address_space(3))) bf16x8*)(kp+6656);
}
__device__ __forceinline__ void kload2(bf16x8*kf,lds_cptr kp,int j){ kf[2*j]=*(const __attribute__((address_space(3))) bf16x8*)(kp+j*2048); kf[2*j+1]=*(const __attribute__((address_space(3))) bf16x8*)(kp+j*2048+512); }
__device__ __forceinline__ s16x4 vtr(lds_cptr p){ return __builtin_bit_cast(s16x4,__builtin_amdgcn_ds_read_tr16_b64_v4i16((__attribute__((address_space(3))) v4i16_t*)p)); }
__device__ __forceinline__ float rowmax(const f32x16&p0,const f32x16&p1){
  float a=max3f(p0[0],p0[1],p1[0]),b=max3f(p0[2],p0[3],p1[1]);a=max3f(a,p1[2],p1[3]);
  #pragma unroll
  for(int r=4;r<16;r+=4){a=max3f(a,p0[r],p0[r+1]);b=max3f(b,p0[r+2],p0[r+3]);a=max3f(a,p1[r],p1[r+1]);b=max3f(b,p1[r+2],p1[r+3]);}
  const float m=max2f(a,b);
  auto rr=__builtin_amdgcn_permlane32_swap(__float_as_uint(m),__float_as_uint(m),false,false);
  return max2f(__uint_as_float(rr[0]),__uint_as_float(rr[1]));
}
__device__ __forceinline__ void pv(f32x16*o,int vb,bf16x8 pa0,bf16x8 pa1,bf16x8 pa2,bf16x8 pa3){
  #pragma unroll
  for(int d0=0;d0<2;++d0){s16x4 lo[4],hi[4];
    #pragma unroll
    for(int ks=0;ks<4;++ks){
      asm volatile("ds_read_b64_tr_b16 %0,%1 offset:%c2":"=&v"(lo[ks]):"v"(vb),"i"(d0*4096+ks*1024):"memory");
      asm volatile("ds_read_b64_tr_b16 %0,%1 offset:%c2":"=&v"(hi[ks]):"v"(vb),"i"(d0*4096+ks*1024+512):"memory");}
    asm volatile("s_waitcnt lgkmcnt(0)":::"memory");SBAR();
    #define PK(k) (bf16x8){lo[k][0],lo[k][1],lo[k][2],lo[k][3],hi[k][0],hi[k][1],hi[k][2],hi[k][3]}
    o[d0]=__builtin_amdgcn_mfma_f32_32x32x16_bf16(pa0,PK(0),o[d0],0,0,0);
    o[d0]=__builtin_amdgcn_mfma_f32_32x32x16_bf16(pa1,PK(1),o[d0],0,0,0);
    o[d0]=__builtin_amdgcn_mfma_f32_32x32x16_bf16(pa2,PK(2),o[d0],0,0,0);
    o[d0]=__builtin_amdgcn_mfma_f32_32x32x16_bf16(pa3,PK(3),o[d0],0,0,0);
    #undef PK
  }
}

#ifndef ATTN_STORE16
#define ATTN_STORE16(p,v) (*(u32x4*)(p)=(v))
#endif
template<int THRL> __device__ __forceinline__ void attn_unit(int b,int h,int qb,const bf16*Q,const bf16*__restrict__ K,const bf16*__restrict__ V,bf16*O,char*shm){
  const int tid=threadIdx.x,lane=tid&63,r32=lane&31,hi=lane>>5; const int wid=__builtin_amdgcn_readfirstlane(tid>>6);
  const long rowbase=(long)b*SEQ; const int q0=qb*QB;
  const bf16*Qw=Q+(rowbase+q0+wid*QBLK)*DM+h*D;
  const bf16*Kh=K+rowbase*DM+h*D,*Vh=V+rowbase*DM+h*D;
  const unsigned lds0=(unsigned)(uintptr_t)shm;
  float*wsf=(float*)(shm+LDS_WS)+wid*64;
  const bf16*ksrc=Kh+(long)lane*DM+wid*8;
  const bf16*vsrc=Vh+(long)(16*(wid&3)+(lane>>2))*DM+(wid>>2)*32+(lane&3)*8;
  const unsigned kdst=lds0+LDS_K+wid*1024, vdst=lds0+LDS_V+wid*1024;
  #define DMA_K(t,slot) glds16(ksrc+(long)(t)*KVBLK*DM,(unsigned)__builtin_amdgcn_readfirstlane(kdst+(slot)))
  #define DMA_V(t,slot) glds16(vsrc+(long)(t)*KVBLK*DM,(unsigned)__builtin_amdgcn_readfirstlane(vdst+(slot)))
  const int vb0=(int)(lds0+LDS_V)+((lane>>4)&1)*32+(lane&3)*8+(4*hi+((lane&15)>>2))*64;
  const char*Kbase=shm+LDS_K; bf16x8 kf[8];
  const lds_cptr shm3=(lds_cptr)shm; const lds_cptr kp0=shm3+LDS_K+hi*1024+r32*16; const lds_cptr vp0=shm3+LDS_V+((lane>>4)&1)*32+(lane&3)*8+(4*hi+((lane&15)>>2))*64;
  const int NT=(q0+QB)/KVBLK;
  DMA_K(0,0);DMA_V(0,0);DMA_K(1,SLOTB);
  bf16x8 qr[4];
  #pragma unroll
  for(int d0=0;d0<4;++d0)qr[d0]=*reinterpret_cast<const bf16x8*>(&Qw[(long)r32*DM+d0*16+hi*8]);
  float mhat=0.f,l_reg=0.f;f32x16 o[2];o[0]=f32x16{};o[1]=f32x16{};f32x16 negm=f32x16{};asm volatile("":"+v"(negm));
  const int qrel=wid*QBLK+r32;
  #define CMASK(P0,P1,t) do{int jb_=(t)-(NT-4); if(jb_>=0)cmask(P0,P1,jb_,qrel,hi);}while(0)
  bool resc=false;
  #define START(P0,P1) do{ const float rm=rowmax(P0,P1); resc=false; \
    { const float dl=rm; mhat=fadd_s(mhat,dl); \
      _Pragma("unroll") for(int r=0;r<16;++r){P0[r]=fsub_s(P0[r],dl);P1[r]=fsub_s(P1[r],dl);} \
      _Pragma("unroll") for(int r=0;r<16;++r)negm[r]=-mhat; asm volatile("":"+v"(negm)); } \
    _Pragma("unroll") for(int r=0;r<16;++r)P0[r]=__builtin_amdgcn_exp2f(P0[r]); }while(0)
  #define RESC() do{ if(resc){ asm volatile("s_waitcnt lgkmcnt(0)":::"memory"); \
      _Pragma("unroll") for(int d_=0;d_<2;++d_) _Pragma("unroll") for(int r=0;r<16;++r)o[d_][r]*=wsf[crow(r,hi)]; } }while(0)
  f32x16 pA0,pA1,pB0,pB1;
  int sl_prev=0,sl_cur=0,sl_next=SLOTB;
  #define ROT() do{sl_prev=sl_cur;sl_cur=sl_next;sl_next=(sl_next==(NSLOT-1)*SLOTB)?0:sl_next+SLOTB;}while(0)
  DMA_K(2,2*SLOTB);
  WAIT_BAR(3);
  qkt(pA0,pA1,Kbase,qr,negm,r32,hi);asm volatile("s_nop 15\n\ts_nop 7":"+v"(pA0),"+v"(pA1));CMASK(pA0,pA1,0);
  START(pA0,pA1);
  _Pragma("unroll") for(int r=0;r<16;++r)pA1[r]=__builtin_amdgcn_exp2f(pA1[r]);
  WAIT_BAR(0);
  DMA_K(3,0);DMA_V(1,SLOTB);
  ROT();
  kload8(kf,kp0+sl_cur);
  WAIT_BAR(2);
  s16x4 vlo[8],vhi[8]; u32x4 pw0,pw1,pw2,pw3;
  #define PKW(P,B) cvtpk_s(P[B],P[B+1])
  #define PAF(k) __builtin_bit_cast(bf16x8,pw##k)
  #define VFR(i) (bf16x8){vlo[i][0],vlo[i][1],vlo[i][2],vlo[i][3],vhi[i][0],vhi[i][1],vhi[i][2],vhi[i][3]}
  #define PIN(x) asm volatile("":"+v"(x))
  #define MX3(a,b,c) __builtin_fmaxf(__builtin_fmaxf((a),(b)),(c))
  #define GAPA(MF,A0,A1,A2,A3,W0,W1,PW) do{ MF; sacc+=A0; sacc+=A1; sacc+=A2; sacc+=A3; PIN(sacc); W0; W1; PIN(PW); SBAR(); }while(0)
  #define EX(v) __builtin_amdgcn_exp2f(v)
  #define GAPB(MF,X,B) do{ MF; X[B]=EX(X[B]); X[B+1]=EX(X[B+1]); X[B+2]=EX(X[B+2]); X[B+3]=EX(X[B+3]); PIN(X); SBAR(); }while(0)
  #define VRD(i) do{ vlo[i]=vtr(vp_+(((i)>>2)*4096+((i)&3)*1024)); vhi[i]=vtr(vp_+(((i)>>2)*4096+((i)&3)*1024+512)); }while(0)
  #define KRD(G,j) do{ if(G){ kload2(kf,kp0+sl_next,j); SBAR(); } }while(0)
  #define STEP(C0,C1,P0,P1,t,GK,GV,GL) do{ SBAR(); \
    const lds_cptr vp_=vp0+sl_prev; \
    VRD(0); SBAR(); float sacc=(P0[0]+P0[1]); \
    GAPA(C0=__builtin_amdgcn_mfma_f32_32x32x16_bf16(kf[0],qr[0],negm,0,0,0), P0[2],P0[3],P0[4],P0[5],     pw0[0]=PKW(P0,0), pw0[1]=PKW(P0,2), pw0); \
    VRD(4); SBAR(); GAPA(C1=__builtin_amdgcn_mfma_f32_32x32x16_bf16(kf[1],qr[0],negm,0,0,0), P0[6],P0[7],P0[8],P0[9],     pw0[2]=PKW(P0,4), pw0[3]=PKW(P0,6), pw0); \
    VRD(1); SBAR(); GAPA(C0=__builtin_amdgcn_mfma_f32_32x32x16_bf16(kf[2],qr[1],C0,0,0,0),   P0[10],P0[11],P0[12],P0[13], pw1[0]=PKW(P0,8), pw1[1]=PKW(P0,10), pw1); \
    VRD(5); SBAR(); GAPA(C1=__builtin_amdgcn_mfma_f32_32x32x16_bf16(kf[3],qr[1],C1,0,0,0),   P0[14],P0[15],P1[0],P1[1],   pw1[2]=PKW(P0,12),pw1[3]=PKW(P0,14), pw1); \
    VRD(2); SBAR(); GAPA(C0=__builtin_amdgcn_mfma_f32_32x32x16_bf16(kf[4],qr[2],C0,0,0,0),   P1[2],P1[3],P1[4],P1[5],     pw2[0]=PKW(P1,0), pw2[1]=PKW(P1,2), pw2); \
    VRD(6); SBAR(); GAPA(C1=__builtin_amdgcn_mfma_f32_32x32x16_bf16(kf[5],qr[2],C1,0,0,0),   P1[6],P1[7],P1[8],P1[9],     pw2[2]=PKW(P1,4), pw2[3]=PKW(P1,6), pw2); \
    VRD(3); SBAR(); GAPA(C0=__builtin_amdgcn_mfma_f32_32x32x16_bf16(kf[6],qr[3],C0,0,0,0),   P1[10],P1[11],P1[12],P1[13], pw3[0]=PKW(P1,8), pw3[1]=PKW(P1,10), pw3); \
    VRD(7); SBAR(); GAPA(C1=__builtin_amdgcn_mfma_f32_32x32x16_bf16(kf[7],qr[3],C1,0,0,0),   P1[14],P1[15],0.f,0.f,       pw3[2]=PKW(P1,12),pw3[3]=PKW(P1,14), pw3); \
    l_reg+=sacc; \
    if(GK){DMA_K((t)+3,sl_cur);} if(GV){DMA_V((t)+1,sl_next);} \
    CMASK(C0,C1,t); \
    { float a=MX3(C0[0],C0[1],C1[0]),b=MX3(C0[2],C0[3],C1[1]); a=MX3(a,C1[2],C1[3]); \
      _Pragma("unroll") for(int r=4;r<16;r+=4){a=MX3(a,C0[r],C0[r+1]);b=MX3(b,C0[r+2],C0[r+3]);a=MX3(a,C1[r],C1[r+1]);b=MX3(b,C1[r+2],C1[r+3]);} \
      float rm=__builtin_fmaxf(a,b); { auto rr=__builtin_amdgcn_permlane32_swap(__float_as_uint(rm),__float_as_uint(rm),false,false); rm=__builtin_fmaxf(__uint_as_float(rr[0]),__uint_as_float(rr[1])); } \
      resc=false; \
      if(__builtin_expect(__any(rm>(float)THRL),0)){ const float dl=__builtin_fmaxf(rm,0.f); mhat+=dl; \
        _Pragma("unroll") for(int r=0;r<16;++r){C0[r]-=dl;C1[r]-=dl;} \
        _Pragma("unroll") for(int r=0;r<16;++r)negm[r]=-mhat; asm volatile("":"+v"(negm)); \
        const float f=__builtin_amdgcn_exp2f(-dl); l_reg*=f; if(hi==0)wsf[r32]=f; resc=true; } } \
    SBAR(); \
    GAPB(o[0]=__builtin_amdgcn_mfma_f32_32x32x16_bf16(PAF(0),VFR(0),o[0],0,0,0), C0,0); \
    GAPB(o[1]=__builtin_amdgcn_mfma_f32_32x32x16_bf16(PAF(0),VFR(4),o[1],0,0,0), C0,4); \
    KRD(GL,0); GAPB(o[0]=__builtin_amdgcn_mfma_f32_32x32x16_bf16(PAF(1),VFR(1),o[0],0,0,0), C0,8); \
    KRD(GL,1); GAPB(o[1]=__builtin_amdgcn_mfma_f32_32x32x16_bf16(PAF(1),VFR(5),o[1],0,0,0), C0,12); \
    KRD(GL,2); GAPB(o[0]=__builtin_amdgcn_mfma_f32_32x32x16_bf16(PAF(2),VFR(2),o[0],0,0,0), C1,0); \
    KRD(GL,3); GAPB(o[1]=__builtin_amdgcn_mfma_f32_32x32x16_bf16(PAF(2),VFR(6),o[1],0,0,0), C1,4); \
    GAPB(o[0]=__builtin_amdgcn_mfma_f32_32x32x16_bf16(PAF(3),VFR(3),o[0],0,0,0), C1,8); \
    GAPB(o[1]=__builtin_amdgcn_mfma_f32_32x32x16_bf16(PAF(3),VFR(7),o[1],0,0,0), C1,12); \
    }while(0)
  int t=1;
  #undef CMASK
  #define CMASK(P0,P1,t) do{}while(0)
  for(;t+5<NT;t+=2){
    STEP(pB0,pB1,pA0,pA1,t,true,true,true);     WAIT_BAR(2); RESC(); ROT();
    STEP(pA0,pA1,pB0,pB1,t+1,true,true,true);   WAIT_BAR(2); RESC(); ROT();
  }
  #undef CMASK
  #define CMASK(P0,P1,t) do{int jb_=(t)-(NT-4); if(jb_>=0)cmask(P0,P1,jb_,qrel,hi);}while(0)
  #define ENDW(tt) do{ if((tt)+3<NT){WAIT_BAR(2);} else if((tt)+2<NT){WAIT_BAR(1);} else {WAIT_BAR(0);} }while(0)
  for(;t+1<NT;t+=2){
    STEP(pB0,pB1,pA0,pA1,t,(t+3<NT),(t+1<NT),(t+1<NT));       ENDW(t);   RESC(); ROT();
    STEP(pA0,pA1,pB0,pB1,t+1,(t+4<NT),(t+2<NT),(t+2<NT));     ENDW(t+1); RESC(); ROT();
  }
  STEP(pB0,pB1,pA0,pA1,NT-1,false,false,false); RESC();
  { float sacc=pB0[0]+pB0[1]; _Pragma("unroll") for(int r=2;r<16;++r)sacc+=pB0[r]; _Pragma("unroll") for(int r=0;r<16;++r)sacc+=pB1[r]; l_reg+=sacc;
    pw0=(u32x4){PKW(pB0,0),PKW(pB0,2),PKW(pB0,4),PKW(pB0,6)};pw1=(u32x4){PKW(pB0,8),PKW(pB0,10),PKW(pB0,12),PKW(pB0,14)};pw2=(u32x4){PKW(pB1,0),PKW(pB1,2),PKW(pB1,4),PKW(pB1,6)};pw3=(u32x4){PKW(pB1,8),PKW(pB1,10),PKW(pB1,12),PKW(pB1,14)};
    SBAR(); pv(o,vb0+sl_cur,PAF(0),PAF(1),PAF(2),PAF(3)); }
  #undef PKW
  #undef PAF
  #undef VFR
  #undef PIN
  #undef MX3
  #undef GAPA
  #undef GAPB
  #undef EX
  #undef VRD
  #undef KRD
  #undef STEP
  #undef ENDW
  {auto rr=__builtin_amdgcn_permlane32_swap(__float_as_uint(l_reg),__float_as_uint(l_reg),false,false);l_reg=__uint_as_float(rr[0])+__uint_as_float(rr[1]);}
  if(hi==0)wsf[32+r32]=l_reg;asm volatile("s_waitcnt lgkmcnt(0)":::"memory");
  float rli[16];
  #pragma unroll
  for(int r=0;r<16;++r)rli[r]=__builtin_amdgcn_rcpf(wsf[32+crow(r,hi)]);
  bf16*Ow=O+(rowbase+q0+wid*QBLK)*DM+h*D;
  { bf16*stg=(bf16*)(shm+LDS_OST)+wid*2048;
    #pragma unroll
    for(int r=0;r<16;++r){const int orow=crow(r,hi);
      #pragma unroll
      for(int d0=0;d0<2;++d0)stg[orow*64+d0*32+r32]=__float2bfloat16(o[d0][r]*rli[r]);}
    asm volatile("s_waitcnt lgkmcnt(0)":::"memory");
    #pragma unroll
    for(int i=0;i<4;++i){const int row=i*8+(lane>>3),ch=lane&7; const u32x4 v=*(const u32x4*)(stg+row*64+ch*8); ATTN_STORE16(Ow+(long)row*DM+ch*8,v);} }
  asm volatile("s_waitcnt lgkmcnt(0)\n\ts_barrier":::"memory");
  #undef DMA_K
  #undef DMA_V
  #undef CMASK
  #undef START
  #undef RESC
  #undef ROT
}
constexpr int ATTN_LDS_BYTES=LDS_BYTES;
struct AttnTensors { const bf16* Q; const bf16* K; const bf16* V; bf16* O; };
struct AttnUnit { int bh; int qb; };
struct StaticOrder {
  int vcu;
  __device__ __forceinline__ explicit StaticOrder(int grid,int block):vcu((block%8)*(grid/8)+block/8){}
  __device__ __forceinline__ bool next(int i,AttnUnit&u)const{ if(i>=8)return false; const int pr=vcu&3; u.bh=(vcu>>2)*4+(i&3); u.qb=(i==0)?pr:(i==1)?pr:(i==2)?pr:(i==3)?pr:(i==4)?7-pr:(i==5)?7-pr:(i==6)?7-pr:7-pr; return true; }
  __device__ __forceinline__ void a_ready(const AttnUnit&)const{}
  __device__ __forceinline__ void done(const AttnUnit&)const{}
};
template<class Sched,int THRL=8> __device__ __forceinline__ void attn_phase(char*lds,const AttnTensors&T,const Sched&S){
  AttnUnit u;
  for(int i=0;S.next(i,u);++i){ S.a_ready(u); const int vhd=u.bh%NHEAD, hq=vhd>>1, hv=(vhd>>2)*2+(vhd&1);
    attn_unit<THRL>(u.bh/NHEAD,hq,u.qb,T.Q,T.K,T.V+(hv-hq)*D,T.O+(vhd-hq)*D,lds); S.done(u); }
}
#undef SBAR
#undef WAIT_BAR
}
#define XB_TMO      128
#define XB_XCNT(j)  (256  + 64 * (j))
#define XB_XSUB(j)  (1280 + 64 * (j))
#define XB_XGEN(j)  (2304 + 64 * (j))
#define XB_TOP      3328
#define XB_TOPGEN   3392
#define XCD_BAR_WORDS 3456
#define XB_SPIN_CAP (1u << 18)

__device__ __forceinline__ unsigned xb_ld(unsigned* p)              { return __hip_atomic_load(p, __ATOMIC_RELAXED, __HIP_MEMORY_SCOPE_AGENT); }
__device__ __forceinline__ unsigned xb_add(unsigned* p, unsigned v) { return __hip_atomic_fetch_add(p, v, __ATOMIC_RELAXED, __HIP_MEMORY_SCOPE_AGENT); }
__device__ __forceinline__ unsigned xb_xcc_id() { return (unsigned)__builtin_amdgcn_s_getreg((3 << 11) | 20) & 0xFu; }
#define XB_SPIN(cond, bar) do { unsigned _sp = 0; while (cond) { __builtin_amdgcn_s_sleep(1); \
    if ((++_sp & 255u) == 0u) { if (xb_ld(&(bar)[XB_TMO])) break; if (_sp > XB_SPIN_CAP) { atomicAdd(&(bar)[XB_TMO], 1u); break; } } } } while (0)

struct XcdBarrier {
    unsigned* bar; unsigned x;
    volatile LAS unsigned* st;
};

__device__ __forceinline__ XcdBarrier xcd_barrier_post(unsigned* bar, volatile LAS unsigned* st) {
    XcdBarrier b; b.bar = bar; b.x = xb_xcc_id(); b.st = st;
    if (threadIdx.x == 0) (void)xb_add(&bar[XB_XCNT(b.x)], 1u);
    return b;
}
__device__ __forceinline__ void xcd_barrier_complete(unsigned* bar, unsigned x, unsigned& nloc, unsigned& nx) {
    const unsigned G = gridDim.x * gridDim.y * gridDim.z;
    unsigned sum, cnt, mine, sp = 0u;
    for (;;) {
        sum = 0u; cnt = 0u; mine = 0u;
#pragma unroll
        for (unsigned j = 0; j < 16; ++j) { const unsigned c = xb_ld(&bar[XB_XCNT(j)]); sum += c; cnt += (c > 0u) ? 1u : 0u; mine = (j == x) ? c : mine; }
        if (sum == G) break;
        __builtin_amdgcn_s_sleep(1);
        if ((++sp & 255u) == 0u) { if (xb_ld(&bar[XB_TMO])) break; if (sp > XB_SPIN_CAP) { atomicAdd(&bar[XB_TMO], 1u); break; } }
    }
    nloc = mine > 0u ? mine : 1u; nx = cnt > 0u ? cnt : 1u;
}

__device__ __forceinline__ void xcd_barrier(const XcdBarrier& b) {
    asm volatile("s_waitcnt vmcnt(0)" ::: "memory");
    __syncthreads();
    if (threadIdx.x == 0) {
        unsigned* bar = b.bar;
        __builtin_amdgcn_s_waitcnt(0);
        unsigned nloc = b.st[0], nx = b.st[1];
        if (nloc == 0u) { xcd_barrier_complete(bar, b.x, nloc, nx); b.st[0] = nloc; b.st[1] = nx; }
        const unsigned old = xb_add(&bar[XB_XSUB(b.x)], 1u);
        const unsigned gen = old / nloc;
        if (old + 1u == (gen + 1u) * nloc) {
            __builtin_amdgcn_fence(__ATOMIC_RELEASE, "agent");
            asm volatile("s_waitcnt vmcnt(0)" ::: "memory");
            const unsigned og = xb_add(&bar[XB_TOP], 1u);
            const unsigned tg = og / nx;
            if (og + 1u == (tg + 1u) * nx) xb_add(&bar[XB_TOPGEN], 1u);
            else XB_SPIN(xb_ld(&bar[XB_TOPGEN]) == tg, bar);
            __builtin_amdgcn_fence(__ATOMIC_ACQUIRE, "agent");
            xb_add(&bar[XB_XGEN(b.x)], 1u);
            asm volatile("s_waitcnt vmcnt(0)" ::: "memory");
        } else {
            XB_SPIN(xb_ld(&bar[XB_XGEN(b.x)]) == gen, bar);
            __builtin_amdgcn_fence(__ATOMIC_ACQUIRE, "agent");
            asm volatile("s_waitcnt vmcnt(0)" ::: "memory");
        }
    }
    __syncthreads();
}

constexpr int NWAVES = 8;
struct Frame { LAS unsigned char* lds; volatile LAS unsigned* MISC; gu32* ctl; int wave, vcu, G; };
__device__ __forceinline__ int opaque_tid() { int t = (int)threadIdx.x; asm volatile("" : "+v"(t)); return t; }
#define FTID ((int)threadIdx.x)
#define FLANE ((int)(threadIdx.x & 63u))
struct Args { const float* in[53]; float* out; unsigned char* ws; int ph_lo, ph_hi, variant, pad; };
#define EPI_ARGS const f32x4 (&acc)[2][2][4][2], const pg8::Unit& u, int wr, int wc, int fr, int fq

__device__ __forceinline__ int maprow(int mode, int n) {
    if (mode == 0) return n;
    if (mode == 1) return (n >> 7) * 256 + (n & 127);
    if (mode == 2) return (n >> 7) * 256 + 128 + (n & 127);
    const int j = n & 1023; return (j >> 7) * 256 + ((n >> 10) << 7) + (j & 127);
}
__device__ __forceinline__ void tr_item(const float* W, int N, bf16* WT, int mode, LAS float* scr, int item, int lane) {
    const int nblk = N >> 5, kb = item / nblk, nb = item - kb * nblk, k0 = 64 * kb, n0 = 32 * nb;
#pragma unroll 8
    for (int i = 0; i < 32; ++i) { const int kk = 2 * i + (lane >> 5); scr[kk * 33 + (lane & 31)] = W[(size_t)(k0 + kk) * N + n0 + (lane & 31)]; }
    LDS_WAIT(); asm volatile("" ::: "memory");
    const int c = lane & 7; const int r0 = maprow(mode, n0);
#pragma unroll
    for (int j = 0; j < 4; ++j) { const int n = (lane >> 3) + 8 * j; const LAS float* s = scr + (8 * c) * 33 + n;
        v4u o; o.x = pk2(s[0 * 33], s[1 * 33]); o.y = pk2(s[2 * 33], s[3 * 33]); o.z = pk2(s[4 * 33], s[5 * 33]); o.w = pk2(s[6 * 33], s[7 * 33]);
        *(GAS v4u*)(WT + (size_t)(r0 + n) * 1024 + k0 + 8 * c) = o; }
    LDS_WAIT(); asm volatile("" ::: "memory");
}
__device__ __forceinline__ unsigned pk4_fp8(float a, float b, float c, float d) {
    a = __builtin_amdgcn_fmed3f(a, -448.f, 448.f); b = __builtin_amdgcn_fmed3f(b, -448.f, 448.f); c = __builtin_amdgcn_fmed3f(c, -448.f, 448.f); d = __builtin_amdgcn_fmed3f(d, -448.f, 448.f);
    int r = __builtin_amdgcn_cvt_pk_fp8_f32(a, b, 0, false); r = __builtin_amdgcn_cvt_pk_fp8_f32(c, d, r, true); return (unsigned)r; }
__device__ __forceinline__ void tr_item8(const float* W, int N, unsigned char* WT, int mode, float scale, LAS float* scr, int item, int lane) {
    const int nblk = N >> 5, kb = item / nblk, nb = item - kb * nblk, k0 = 128 * kb, n0 = 32 * nb;
#pragma unroll 8
    for (int i = 0; i < 64; ++i) { const int kk = 2 * i + (lane >> 5); scr[kk * 33 + (lane & 31)] = W[(size_t)(k0 + kk) * N + n0 + (lane & 31)] * scale; }
    LDS_WAIT(); asm volatile("" ::: "memory");
    const int c = lane & 7; const int r0 = maprow(mode, n0);
#pragma unroll
    for (int j = 0; j < 4; ++j) { const int n = (lane >> 3) + 8 * j; const LAS float* p = scr + (16 * c) * 33 + n;
        v4u o; o.x = pk4_fp8(p[0 * 33], p[1 * 33], p[2 * 33], p[3 * 33]); o.y = pk4_fp8(p[4 * 33], p[5 * 33], p[6 * 33], p[7 * 33]);
        o.z = pk4_fp8(p[8 * 33], p[9 * 33], p[10 * 33], p[11 * 33]); o.w = pk4_fp8(p[12 * 33], p[13 * 33], p[14 * 33], p[15 * 33]);
        *(GAS v4u*)(WT + (size_t)(r0 + n) * 1024 + k0 + 16 * c) = o; }
    LDS_WAIT(); asm volatile("" ::: "memory");
}
__device__ __forceinline__ void cvt_plain(const float* src, bf16* dst, size_t n, size_t gtid, size_t nth) {
    for (size_t i = gtid * 8; i < n; i += nth * 8) { const f32x4 a = *(const GAS f32x4*)(src + i), b = *(const GAS f32x4*)(src + i + 4);
        v4u o; o.x = pk2(a.x, a.y); o.y = pk2(a.z, a.w); o.z = pk2(b.x, b.y); o.w = pk2(b.z, b.w); *(GAS v4u*)(dst + i) = o; }
}
__device__ __forceinline__ void cvt_experts(Frame& F, const float* wup, const float* wdn, unsigned char* ws) {
    const int gw = F.vcu * NWAVES + F.wave, NGW = F.G * NWAVES;
#if MOE_FP8
    LAS float* tl = (LAS float*)F.lds;
    for (int it = F.vcu; it < NEXP * 96; it += F.G) { const int e = it / 96, r = it - e * 96; const bool up = r < 64; const int rr = up ? r : r - 64;
        const int N = up ? 2048 : 1024, nb = up ? (rr & 7) : (rr & 3), kb = up ? (rr >> 3) : (rr >> 2), k0 = 128 * kb, n0 = 256 * nb;
        const float* W = up ? wup + (size_t)e * 1024 * 2048 : wdn + (size_t)e * 1024 * 1024; unsigned char* WT = up ? ws + WS_WUP8 + (size_t)e * 2048 * 1024 : ws + WS_WDN8 + (size_t)e * 1024 * 1024;
        const float scale = up ? SWU8 : SWD8; const int mode = up ? 3 : 0;
        __syncthreads();
        f32x4 v[16];
#pragma unroll
        for (int i = 0; i < 16; ++i) { const int idx = i * 512 + FTID, row = idx >> 6, c4 = idx & 63; v[i] = *(const GAS f32x4*)(W + (size_t)(k0 + row) * N + n0 + 4 * c4); }
#pragma unroll
        for (int i = 0; i < 16; ++i) { const int idx = i * 512 + FTID, row = idx >> 6, c4 = idx & 63; *(LAS f32x4*)(tl + row * 260 + 4 * (c4 ^ (row >> 4))) = v[i] * scale; }
        __syncthreads();
#pragma unroll
        for (int j = 0; j < 4; ++j) { const int idx = j * 512 + FTID, n = idx >> 3, c = idx & 7; const LAS float* p = tl + (16 * c) * 260 + (n ^ (4 * c));
            v4u o; o.x = pk4_fp8(p[0 * 260], p[1 * 260], p[2 * 260], p[3 * 260]); o.y = pk4_fp8(p[4 * 260], p[5 * 260], p[6 * 260], p[7 * 260]);
            o.z = pk4_fp8(p[8 * 260], p[9 * 260], p[10 * 260], p[11 * 260]); o.w = pk4_fp8(p[12 * 260], p[13 * 260], p[14 * 260], p[15 * 260]);
            *(GAS v4u*)(WT + (size_t)maprow(mode, n0 + n) * 1024 + k0 + 16 * c) = o; }
    }
    __syncthreads();
    return;
#endif
    LAS float* scr = (LAS float*)(F.lds + F.wave * 16384);
    for (int it = gw; it < NEXP * 1536; it += NGW) { const int e = it / 1536, r = it - e * 1536;
        if (r < 1024) tr_item(wup + (size_t)e * 1024 * 2048, 2048, (bf16*)(ws + WS_WUP) + (size_t)e * 2048 * 1024, 3, scr, r, FLANE);
        else tr_item(wdn + (size_t)e * 1024 * 1024, 1024, (bf16*)(ws + WS_WDN) + (size_t)e * 1024 * 1024, 0, scr, r - 1024, FLANE); }
}
__device__ __forceinline__ void p0_prologue(Frame& F, const Args& a) {
    unsigned char* ws = a.ws;
    LAS float* scr = (LAS float*)(F.lds + F.wave * 16896);
    const int gw = F.vcu * NWAVES + F.wave, NGW = F.G * NWAVES;
    constexpr int I0 = 16 * 64, I1 = I0 + 16 * 80, I2 = I1 + 512, I3 = I2 + 512, I4 = I3 + 512, I5 = I4 + 256, I6 = I5 + 256, I7 = I6 + 256, I8 = I7 + 16, I9 = I8 + 16;
    for (int it = gw; it < I9; it += NGW) {
        if (it < I0) tr_item(a.in[2], 2048, (bf16*)(ws + WS_WKV), 0, scr, it, FLANE);
        else if (it < I1) tr_item(a.in[3], 2560, (bf16*)(ws + WS_WIN0), 0, scr, it - I0, FLANE);
        else if (it < I2) tr_item(a.in[13], 1024, (bf16*)(ws + WS_WOUT0), 0, scr, it - I1, FLANE);
        else if (it < I3) tr_item(a.in[17], 1024, (bf16*)(ws + WS_XOT), 0, scr, it - I2, FLANE);
        else if (it < I4) tr_item(a.in[42], 1024, (bf16*)(ws + WS_XOT) + 1024 * 1024, 0, scr, it - I3, FLANE);
        else if (it < I5) tr_item8(a.in[28], 1024, ws + WS_WIN1, 0, SWU8, scr, it - I4, FLANE);
        else if (it < I6) tr_item8(a.in[37], 1024, ws + WS_WVG, 1, SWD8, scr, it - I5, FLANE);
        else if (it < I7) tr_item8(a.in[38], 1024, ws + WS_WVG, 2, SWU8, scr, it - I6, FLANE);
        else if (it < I8) tr_item(a.in[20], 32, (bf16*)(ws + WS_WR), 0, scr, it - I7, FLANE);
        else tr_item(a.in[45], 32, (bf16*)(ws + WS_WR) + 256 * 1024, 0, scr, it - I8, FLANE);
    }
    cvt_experts(F, a.in[22], a.in[24], ws);
    const size_t gtid = (size_t)F.vcu * 512 + FTID, nth = (size_t)F.G * 512;
    cvt_plain(a.in[16], (bf16*)(ws + WS_XQB), 1024 * 1024, gtid, nth);
    cvt_plain(a.in[41], (bf16*)(ws + WS_XQB) + 1024 * 1024, 1024 * 1024, gtid, nth);
    cvt_plain(a.in[1], (bf16*)(ws + WS_MEMB), (size_t)NB * MEMLEN * DM, gtid, nth);
    cvt_plain(a.in[0], (bf16*)(ws + WS_XB), (size_t)MTOK * DM, gtid, nth);
}

__device__ __forceinline__ void moe_tables(Frame& F, gu32* cnt) {
    LAS int* tab = (LAS int*)(F.lds + TAB_OFF);
    if (FTID < 32) tab[FTID] = (int)__hip_atomic_load(cnt + FTID * 64, RLX_AGENT);
    __syncthreads();
    if (FTID == 0) { int s = 0; for (int e = 0; e < NEXP; ++e) { tab[32 + e] = s; s += (tab[e] + 255) >> 8; } tab[64] = s; }
    __syncthreads();
}

template <int MODE>
__device__ __forceinline__ void ph_ln(Frame& F, const bf16* zb, const bf16* ys, bf16* xb, float* outf, const float* g, const float* b, unsigned char* x8 = nullptr, const int* asg = nullptr, const float* gate = nullptr,
                                      const float* st2 = nullptr, const float* g2 = nullptr, const float* b2 = nullptr) {
    LAS const int* tab = (LAS const int*)(F.lds + TAB_OFF);
    const int gw = F.vcu * NWAVES + F.wave, NGW = F.G * NWAVES, c0 = 8 * FLANE;
    float gv[16], bv[16];
#pragma unroll
    for (int h = 0; h < 2; ++h)
#pragma unroll
        for (int q = 0; q < 2; ++q) { const f32x4 t = *(const GAS f32x4*)(g + c0 + 512 * h + 4 * q), s = *(const GAS f32x4*)(b + c0 + 512 * h + 4 * q);
            gv[8 * h + 4 * q + 0] = t.x; gv[8 * h + 4 * q + 1] = t.y; gv[8 * h + 4 * q + 2] = t.z; gv[8 * h + 4 * q + 3] = t.w;
            bv[8 * h + 4 * q + 0] = s.x; bv[8 * h + 4 * q + 1] = s.y; bv[8 * h + 4 * q + 2] = s.z; bv[8 * h + 4 * q + 3] = s.w; }
    constexpr bool REB = (MODE == 1) && MOE_FP8; float g2v[REB ? 16 : 1], b2v[REB ? 16 : 1];
    if constexpr (REB) {
#pragma unroll
        for (int h = 0; h < 2; ++h)
#pragma unroll
            for (int q = 0; q < 2; ++q) { const f32x4 t = *(const GAS f32x4*)(g2 + c0 + 512 * h + 4 * q), s = *(const GAS f32x4*)(b2 + c0 + 512 * h + 4 * q);
#pragma unroll
                for (int j = 0; j < 4; ++j) { g2v[8 * h + 4 * q + j] = ALPHA * t[j]; b2v[8 * h + 4 * q + j] = ALPHA * s[j]; } } }
    constexpr int RI = (MODE == 0) ? 4 : 2;
    for (int m0 = gw * RI; m0 < MTOK; m0 += NGW * RI) {
        v4u raw[RI][2]; v4u yr[(MODE == 1) ? RI : 1][2][4]; f32x4 gt[(MODE == 1) ? RI : 1]; f32x2 ms[RI];
#pragma unroll
        for (int r = 0; r < RI; ++r) { const size_t m = (size_t)(m0 + r); size_t yrow[4] = {0, 0, 0, 0};
            if constexpr (REB) ms[r] = *(const GAS f32x2*)(st2 + m * 2);
            if (MODE == 1) { const v4i_t as = *(const GAS v4i_t*)(asg + m * 4); gt[r] = *(const GAS f32x4*)(gate + m * 4);
#pragma unroll
                for (int k = 0; k < 4; ++k) yrow[k] = (size_t)(tab[32 + (as[k] >> 16)] * 256 + (as[k] & 0xffff)); }
#pragma unroll
            for (int h = 0; h < 2; ++h) {
                raw[r][h] = *(const GAS v4u*)(((MODE == 0 || REB) ? zb : xb) + m * DM + c0 + 512 * h);
                if (MODE == 1) {
#pragma unroll
                    for (int k = 0; k < 4; ++k) { const v2u t8 = *(const GAS v2u*)((const unsigned char*)ys + yrow[k] * DM + c0 + 512 * h); yr[r][h][k] = (v4u){t8.x, t8.y, 0u, 0u}; } } } }
#pragma unroll
        for (int r = 0; r < RI; ++r) { const size_t m = (size_t)(m0 + r);
            float v[16];
#pragma unroll
            for (int h = 0; h < 2; ++h) { const v4u w = raw[r][h]; const float sc = (MODE == 0) ? 1.0f : ALPHA;
                v[8 * h + 0] = sc * bflo(w.x); v[8 * h + 1] = sc * bfhi(w.x); v[8 * h + 2] = sc * bflo(w.y); v[8 * h + 3] = sc * bfhi(w.y); v[8 * h + 4] = sc * bflo(w.z); v[8 * h + 5] = sc * bfhi(w.z); v[8 * h + 6] = sc * bflo(w.w); v[8 * h + 7] = sc * bfhi(w.w);
                if constexpr (REB) { const float mu2 = ms[r][0] * ALPHA, rs2 = ms[r][1];
#pragma unroll
                    for (int j = 0; j < 8; ++j) v[8 * h + j] = (v[8 * h + j] - mu2) * rs2 * g2v[8 * h + j] * (1.0f / ALPHA) + b2v[8 * h + j]; }
                if (MODE == 1) {
#pragma unroll
                    for (int k = 0; k < 4; ++k) { const v4u y = yr[r][h][k]; const float gk = gt[r][k] * (1.0f / SY8);
                        const f32x2 p0 = __builtin_amdgcn_cvt_pk_f32_fp8((int)y.x, false), p1 = __builtin_amdgcn_cvt_pk_f32_fp8((int)y.x, true), p2 = __builtin_amdgcn_cvt_pk_f32_fp8((int)y.y, false), p3 = __builtin_amdgcn_cvt_pk_f32_fp8((int)y.y, true);
                        v[8 * h + 0] += gk * p0[0]; v[8 * h + 1] += gk * p0[1]; v[8 * h + 2] += gk * p1[0]; v[8 * h + 3] += gk * p1[1]; v[8 * h + 4] += gk * p2[0]; v[8 * h + 5] += gk * p2[1]; v[8 * h + 6] += gk * p3[0]; v[8 * h + 7] += gk * p3[1]; } } }
            float s = 0.f;
#pragma unroll
            for (int j = 0; j < 16; ++j) s += v[j];
            const float mean = wave_sum(s) * (1.f / DM); float s2 = 0.f;
#pragma unroll
            for (int j = 0; j < 16; ++j) { v[j] -= mean; s2 += v[j] * v[j]; }
            const float rstd = 1.f / sqrtf(wave_sum(s2) * (1.f / DM) + LN_EPS);
#pragma unroll
            for (int j = 0; j < 16; ++j) v[j] = v[j] * rstd * gv[j] + bv[j];
#pragma unroll
            for (int h = 0; h < 2; ++h) { v4u o; o.x = pk2(v[8 * h], v[8 * h + 1]); o.y = pk2(v[8 * h + 2], v[8 * h + 3]); o.z = pk2(v[8 * h + 4], v[8 * h + 5]); o.w = pk2(v[8 * h + 6], v[8 * h + 7]);
                if (!outf) *(GAS v4u*)(xb + m * DM + c0 + 512 * h) = o;
                if (x8) { v2u o8; o8.x = pk4_fp8(v[8 * h] * SX8, v[8 * h + 1] * SX8, v[8 * h + 2] * SX8, v[8 * h + 3] * SX8); o8.y = pk4_fp8(v[8 * h + 4] * SX8, v[8 * h + 5] * SX8, v[8 * h + 6] * SX8, v[8 * h + 7] * SX8);
                          *(GAS v2u*)(x8 + m * DM + c0 + 512 * h) = o8; }
                if (outf) { *(GAS f32x4*)(outf + m * DM + c0 + 512 * h) = (f32x4){v[8 * h], v[8 * h + 1], v[8 * h + 2], v[8 * h + 3]};
                            *(GAS f32x4*)(outf + m * DM + c0 + 512 * h + 4) = (f32x4){v[8 * h + 4], v[8 * h + 5], v[8 * h + 6], v[8 * h + 7]}; } }
        }
    }
}
__device__ __forceinline__ void ph_ln2_router(Frame& F, const bf16* zb, bf16* xb, unsigned char* x8, const float* g, const float* b, const bf16* wrT, const float* rbias,
                                              gu32* cnt, int* list, float* gate, int* asg, float* st2) {
    LAS int* cl = (LAS int*)F.lds;
    LAS float* gl = (LAS float*)(F.lds + 256);
    LAS bf16* wl = (LAS bf16*)(F.lds + 256 + 8192);
    const int rw = FLANE & 15, q = FLANE >> 4;
    for (int i = FTID; i < 256; i += 512) { ((LAS f32x4*)gl)[i] = *(const GAS f32x4*)(g + 4 * i); ((LAS f32x4*)gl)[256 + i] = *(const GAS f32x4*)(b + 4 * i); }
    for (int i = FTID; i < 4096; i += 512) { const int e = i >> 7, c = i & 127; *(LAS v4u*)(wl + e * 1032 + 8 * c) = *(const GAS v4u*)(wrT + (size_t)e * DM + 8 * c); }
    for (int blk = F.vcu; blk < MTOK / 128; blk += F.G) {
        __syncthreads();
        if (FTID < 64) cl[FTID] = 0;
        __syncthreads();
        const int row = blk * 128 + F.wave * 16 + rw;
        const bf16* zr = zb + (size_t)row * DM + 8 * q;
        v4u zz[32];
#pragma unroll
        for (int ks = 0; ks < 32; ++ks) zz[ks] = *(const GAS v4u*)(zr + 32 * ks);
        float s1 = 0.f, s2 = 0.f;
#pragma unroll
        for (int ks = 0; ks < 32; ++ks) { const v4u w = zz[ks]; const float x0 = bflo(w.x), x1 = bfhi(w.x), x2 = bflo(w.y), x3 = bfhi(w.y), x4 = bflo(w.z), x5 = bfhi(w.z), x6 = bflo(w.w), x7 = bfhi(w.w);
            s1 += ((x0 + x1) + (x2 + x3)) + ((x4 + x5) + (x6 + x7)); s2 += ((x0 * x0 + x1 * x1) + (x2 * x2 + x3 * x3)) + ((x4 * x4 + x5 * x5) + (x6 * x6 + x7 * x7)); }
        s1 += __shfl_xor(s1, 16); s1 += __shfl_xor(s1, 32); s2 += __shfl_xor(s2, 16); s2 += __shfl_xor(s2, 32);
        const float mean = s1 * (1.f / DM), rstd = 1.f / sqrtf(fmaxf(s2 * (1.f / DM) - mean * mean, 0.f) + LN_EPS);
        if (MOE_FP8 && q == 0) { f32x2 ms; ms[0] = mean; ms[1] = rstd; *(GAS f32x2*)(st2 + (size_t)row * 2) = ms; }
        f32x4 acc0 = (f32x4){0.f, 0.f, 0.f, 0.f}, acc1 = (f32x4){0.f, 0.f, 0.f, 0.f};
        bf16* xr = xb + (size_t)row * DM + 8 * q; unsigned char* x8r = x8 + (size_t)row * DM + 8 * q;
        const LAS bf16* w0 = wl + rw * 1032 + 8 * q; const LAS bf16* w1 = wl + (16 + rw) * 1032 + 8 * q;
#pragma unroll
        for (int ks = 0; ks < 32; ++ks) { v4u w = zz[ks]; asm volatile("" : "+v"(w));
            const f32x4 g0 = *(const LAS f32x4*)(gl + 32 * ks + 8 * q), g1 = *(const LAS f32x4*)(gl + 32 * ks + 8 * q + 4), b0 = *(const LAS f32x4*)(gl + 1024 + 32 * ks + 8 * q), b1 = *(const LAS f32x4*)(gl + 1024 + 32 * ks + 8 * q + 4);
            const float y0 = (bflo(w.x) - mean) * rstd * g0[0] + b0[0], y1 = (bfhi(w.x) - mean) * rstd * g0[1] + b0[1], y2 = (bflo(w.y) - mean) * rstd * g0[2] + b0[2], y3 = (bfhi(w.y) - mean) * rstd * g0[3] + b0[3];
            const float y4 = (bflo(w.z) - mean) * rstd * g1[0] + b1[0], y5 = (bfhi(w.z) - mean) * rstd * g1[1] + b1[1], y6 = (bflo(w.w) - mean) * rstd * g1[2] + b1[2], y7 = (bfhi(w.w) - mean) * rstd * g1[3] + b1[3];
            v4u o; o.x = pk2(y0, y1); o.y = pk2(y2, y3); o.z = pk2(y4, y5); o.w = pk2(y6, y7);
            if (!MOE_FP8) *(GAS v4u*)(xr + 32 * ks) = o;
            if (x8) { v2u o8; o8.x = pk4_fp8(y0 * SX8, y1 * SX8, y2 * SX8, y3 * SX8); o8.y = pk4_fp8(y4 * SX8, y5 * SX8, y6 * SX8, y7 * SX8); *(GAS v2u*)(x8r + 32 * ks) = o8; }
            const bf16x8 bfrag = __builtin_bit_cast(bf16x8, o);
            acc0 = __builtin_amdgcn_mfma_f32_16x16x32_bf16(*(const LAS bf16x8*)(w0 + 32 * ks), bfrag, acc0, 0, 0, 0);
            acc1 = __builtin_amdgcn_mfma_f32_16x16x32_bf16(*(const LAS bf16x8*)(w1 + 32 * ks), bfrag, acc1, 0, 0, 0);
            if ((ks & 1) == 1) asm volatile("" ::: "memory"); }
        float lg[8]; const f32x4 rb0 = *(const GAS f32x4*)(rbias + 4 * q), rb1 = *(const GAS f32x4*)(rbias + 16 + 4 * q);
#pragma unroll
        for (int j = 0; j < 4; ++j) { lg[j] = acc0[j] + rb0[j]; lg[4 + j] = acc1[j] + rb1[j]; }
        int idx[4]; float val[4];
#pragma unroll
        for (int k = 0; k < 4; ++k) { float bv = -3.0e38f; int bi = 64;
#pragma unroll
            for (int j = 0; j < 8; ++j) { const int e = (j < 4) ? 4 * q + j : 12 + 4 * q + j; if (lg[j] > bv) { bv = lg[j]; bi = e; } }
#pragma unroll
            for (int o = 16; o <= 32; o <<= 1) { const float pv = __shfl_xor(bv, o); const int pi = __shfl_xor(bi, o); if (pv > bv || (pv == bv && pi < bi)) { bv = pv; bi = pi; } }
            bi &= 31; idx[k] = bi; val[k] = bv;
#pragma unroll
            for (int j = 0; j < 8; ++j) { const int e = (j < 4) ? 4 * q + j : 12 + 4 * q + j; if (e == bi) lg[j] = -3.0e38f; } }
        const float e1 = __builtin_amdgcn_exp2f((val[1] - val[0]) * LOG2E), e2 = __builtin_amdgcn_exp2f((val[2] - val[0]) * LOG2E), e3 = __builtin_amdgcn_exp2f((val[3] - val[0]) * LOG2E);
        const float inv = 1.f / (1.f + e1 + e2 + e3);
        int pos[4] = {0, 0, 0, 0};
        for (int e = 0; e < NEXP; ++e) {
            const int k = (q != 0) ? -1 : (idx[0] == e) ? 0 : (idx[1] == e) ? 1 : (idx[2] == e) ? 2 : (idx[3] == e) ? 3 : -1;
            const unsigned long long mask = __ballot(k >= 0);
            if (mask) { const int n = __popcll(mask), leader = __ffsll((long long)mask) - 1; int bp = 0;
                if (FLANE == leader) bp = __hip_atomic_fetch_add(cl + e, n, __ATOMIC_RELAXED, __HIP_MEMORY_SCOPE_WORKGROUP);
                bp = __shfl(bp, leader);
                const int p = bp + __popcll(mask & ((1ull << FLANE) - 1ull));
                pos[0] = (k == 0) ? p : pos[0]; pos[1] = (k == 1) ? p : pos[1]; pos[2] = (k == 2) ? p : pos[2]; pos[3] = (k == 3) ? p : pos[3]; }
        }
        __syncthreads();
        if (FTID < 32) { const int tot = cl[FTID]; cl[32 + FTID] = tot ? (int)__hip_atomic_fetch_add(cnt + FTID * 64, (unsigned)tot, RLX_AGENT) : 0; }
        __syncthreads();
        if (q == 0) {
            *(GAS f32x4*)(gate + (size_t)row * 4) = (f32x4){inv, e1 * inv, e2 * inv, e3 * inv};
#pragma unroll
            for (int k = 0; k < 4; ++k) { const int pe = cl[32 + idx[k]] + pos[k]; list[(size_t)idx[k] * CAP + pe] = row * 4 + k; pos[k] = (idx[k] << 16) | pe; }
            *(GAS v4i_t*)(asg + (size_t)row * 4) = (v4i_t){pos[0], pos[1], pos[2], pos[3]}; }
    }
}
__device__ __forceinline__ void ph_softmax(Frame& F, const float* sc, bf16* P) {
    const int gw = F.vcu * NWAVES + F.wave, NGW = F.G * NWAVES;
    for (int m = gw; m < MTOK; m += NGW) {
#pragma unroll
        for (int h = 0; h < 4; ++h) { f32x4 v = *(const GAS f32x4*)(sc + (size_t)m * DM + 256 * h + 4 * FLANE);
            const float mx = wave_max(fmaxf(fmaxf(v.x, v.y), fmaxf(v.z, v.w)));
            v.x = __builtin_amdgcn_exp2f(v.x - mx); v.y = __builtin_amdgcn_exp2f(v.y - mx); v.z = __builtin_amdgcn_exp2f(v.z - mx); v.w = __builtin_amdgcn_exp2f(v.w - mx);
            const float inv = 1.f / wave_sum((v.x + v.y) + (v.z + v.w));
            v2u o; o.x = pk2(v.x * inv, v.y * inv); o.y = pk2(v.z * inv, v.w * inv);
            *(GAS v2u*)(P + (size_t)m * DM + 256 * h + 4 * FLANE) = o; }
    }
}
__device__ __forceinline__ void ph_topk(Frame& F, const float* logit, const float* rbias, gu32* cnt, int* list, float* gate) {
    for (int base = F.vcu * 512; base < MTOK; base += F.G * 512) {
        const int m = base + FTID;
        float lg[32];
#pragma unroll
        for (int q = 0; q < 8; ++q) { const f32x4 t = *(const GAS f32x4*)(logit + (size_t)m * 32 + 4 * q), bb = *(const GAS f32x4*)(rbias + 4 * q);
            lg[4 * q] = t.x + bb.x; lg[4 * q + 1] = t.y + bb.y; lg[4 * q + 2] = t.z + bb.z; lg[4 * q + 3] = t.w + bb.w; }
        int idx[4]; float val[4];
#pragma unroll
        for (int k = 0; k < 4; ++k) { float bvv = -3.0e38f; int bi = 0;
#pragma unroll
            for (int e = 0; e < 32; ++e) { const bool taken = (k > 0 && idx[0] == e) || (k > 1 && idx[1] == e) || (k > 2 && idx[2] == e); if (!taken && lg[e] > bvv) { bvv = lg[e]; bi = e; } }
            idx[k] = bi; val[k] = bvv; }
        const float e1 = __builtin_amdgcn_exp2f((val[1] - val[0]) * LOG2E), e2 = __builtin_amdgcn_exp2f((val[2] - val[0]) * LOG2E), e3 = __builtin_amdgcn_exp2f((val[3] - val[0]) * LOG2E);
        const float inv = 1.f / (1.f + e1 + e2 + e3);
        *(GAS f32x4*)(gate + (size_t)m * 4) = (f32x4){inv, e1 * inv, e2 * inv, e3 * inv};
        for (int e = 0; e < NEXP; ++e) {
            const int k = (idx[0] == e) ? 0 : (idx[1] == e) ? 1 : (idx[2] == e) ? 2 : (idx[3] == e) ? 3 : -1;
            const unsigned long long mask = __ballot(k >= 0);
            if (mask) { const int n = __popcll(mask), leader = __ffsll((long long)mask) - 1; unsigned bp = 0;
                if (FLANE == leader) bp = __hip_atomic_fetch_add(cnt + e * 64, (unsigned)n, RLX_AGENT);
                bp = __shfl(bp, leader);
                if (k >= 0) { const int rank = __popcll(mask & ((1ull << FLANE) - 1ull)); list[(size_t)e * CAP + bp + rank] = m * 4 + k; } }
        }
    }
}
__device__ __forceinline__ void ph_sgu(Frame& F, const bf16* hb, bf16* mix, const float* lng, const float* lnb, const float* wsp, const float* bsp) {
    LAS bf16* Wb = (LAS bf16*)F.lds;
    LAS bf16* VT = (LAS bf16*)(F.lds + 34816);
    LAS float* GL = (LAS float*)(F.lds + 69632);
    const int r = FTID >> 2, qq = FTID & 3, n16 = FLANE & 15, q = FLANE >> 4;
    int gcur = -1;
    for (int it = F.vcu; it < 1024; it += F.G) {
        const int g = it & 3, row0 = (it >> 2) * 128;
        if (g != gcur) { __syncthreads(); for (int i = FTID; i < 16384; i += 512) { const int t = i >> 7, s2 = i & 127; Wb[t * 136 + s2] = (bf16)((s2 <= t) ? f2bf(wsp[g * 16384 + i]) : 0u); } gcur = g; }
        { float v[32]; const bf16* src = hb + (size_t)(row0 + r) * DM + 512 + g * 128 + 32 * qq;
#pragma unroll
            for (int j = 0; j < 4; ++j) { const v4u w = *(const GAS v4u*)(src + 8 * j);
                v[8 * j + 0] = bflo(w.x); v[8 * j + 1] = bfhi(w.x); v[8 * j + 2] = bflo(w.y); v[8 * j + 3] = bfhi(w.y); v[8 * j + 4] = bflo(w.z); v[8 * j + 5] = bfhi(w.z); v[8 * j + 6] = bflo(w.w); v[8 * j + 7] = bfhi(w.w); }
            float s = 0.f;
#pragma unroll
            for (int j = 0; j < 32; ++j) s += v[j];
            s += __shfl_xor(s, 1); s += __shfl_xor(s, 2);
            const float mean = s * (1.f / 128.f); float s2 = 0.f;
#pragma unroll
            for (int j = 0; j < 32; ++j) { v[j] -= mean; s2 += v[j] * v[j]; }
            s2 += __shfl_xor(s2, 1); s2 += __shfl_xor(s2, 2);
            const float rstd = 1.f / sqrtf(s2 * (1.f / 128.f) + LN_EPS);
#pragma unroll
            for (int j = 0; j < 8; ++j) { const f32x4 gg = *(const GAS f32x4*)(lng + g * 128 + 32 * qq + 4 * j), bb = *(const GAS f32x4*)(lnb + g * 128 + 32 * qq + 4 * j);
#pragma unroll
                for (int k = 0; k < 4; ++k) VT[(32 * qq + 4 * j + k) * 136 + r] = (bf16)f2bf(v[4 * j + k] * rstd * gg[k] + bb[k]); } }
        __syncthreads();
        { bf16x8 VF[4];
#pragma unroll
            for (int ks = 0; ks < 4; ++ks) VF[ks] = *(const LAS bf16x8*)(VT + (16 * F.wave + n16) * 136 + 32 * ks + 8 * q);
#pragma unroll
            for (int tb = 0; tb < 8; ++tb) { f32x4 acc = (f32x4){0.f, 0.f, 0.f, 0.f};
#pragma unroll
                for (int ks = 0; ks <= (tb >> 1); ++ks) acc = __builtin_amdgcn_mfma_f32_16x16x32_bf16(*(const LAS bf16x8*)(Wb + (16 * tb + n16) * 136 + 32 * ks + 8 * q), VF[ks], acc, 0, 0, 0);
                const f32x4 bt = *(const GAS f32x4*)(bsp + g * 128 + 16 * tb + 4 * q);
#pragma unroll
                for (int k = 0; k < 4; ++k) GL[(16 * tb + 4 * q + k) * 128 + 16 * F.wave + n16] = acc[k] + bt[k]; } }
        __syncthreads();
        { const bf16* usrc = hb + (size_t)(row0 + r) * DM + g * 128 + 32 * qq; bf16* dst = mix + (size_t)(row0 + r) * DM + g * 128 + 32 * qq;
#pragma unroll
            for (int j = 0; j < 4; ++j) { const v4u w = *(const GAS v4u*)(usrc + 8 * j); const f32x4 g0 = *(const LAS f32x4*)(GL + r * 128 + 32 * qq + 8 * j), g1 = *(const LAS f32x4*)(GL + r * 128 + 32 * qq + 8 * j + 4); v4u o;
                o.x = pk2(bflo(w.x) * g0[0], bfhi(w.x) * g0[1]); o.y = pk2(bflo(w.y) * g0[2], bfhi(w.y) * g0[3]); o.z = pk2(bflo(w.z) * g1[0], bfhi(w.z) * g1[1]); o.w = pk2(bflo(w.w) * g1[2], bfhi(w.w) * g1[3]);
                *(GAS v4u*)(dst + 8 * j) = o; } }
    }
}
__device__ __forceinline__ void ph_combine(Frame& F, const bf16* oatt, bf16* mix, const float* lq1, const float* lk1, const float* lq2, const float* lk2, const float* sg) {
    const int gw = F.vcu * NWAVES + F.wave, NGW = F.G * NWAVES;
    const float d1 = wave_sum(lq1[FLANE] * lk1[FLANE]), d2 = wave_sum(lq2[FLANE] * lk2[FLANE]);
    const float lam = expf(d1) - expf(d2) + LAM_INIT0;
    const int h = FLANE >> 4, e0 = 8 * (FLANE & 15);
    float gsc[8];
#pragma unroll
    for (int j = 0; j < 8; ++j) gsc[j] = sg[e0 + j] * (1.0f - LAM_INIT0);
    for (int m0 = gw * 4; m0 < MTOK; m0 += NGW * 4) {
        v4u av[4], bw[4];
#pragma unroll
        for (int r = 0; r < 4; ++r) { av[r] = *(const GAS v4u*)(oatt + (size_t)(m0 + r) * DM + h * 256 + e0); bw[r] = *(const GAS v4u*)(oatt + (size_t)(m0 + r) * DM + h * 256 + 128 + e0); }
#pragma unroll
        for (int r = 0; r < 4; ++r) { const v4u a = av[r], b = bw[r]; const size_t m = (size_t)(m0 + r);
            float o[8];
            o[0] = bflo(a.x) - lam * bflo(b.x); o[1] = bfhi(a.x) - lam * bfhi(b.x); o[2] = bflo(a.y) - lam * bflo(b.y); o[3] = bfhi(a.y) - lam * bfhi(b.y);
            o[4] = bflo(a.z) - lam * bflo(b.z); o[5] = bfhi(a.z) - lam * bfhi(b.z); o[6] = bflo(a.w) - lam * bflo(b.w); o[7] = bfhi(a.w) - lam * bfhi(b.w);
            float s2 = 0.f;
#pragma unroll
            for (int j = 0; j < 8; ++j) s2 += o[j] * o[j];
            s2 += __shfl_xor(s2, 1); s2 += __shfl_xor(s2, 2); s2 += __shfl_xor(s2, 4); s2 += __shfl_xor(s2, 8);
            const float rs = 1.f / sqrtf(s2 * (1.f / 128.f) + LN_EPS);
            v4u w; w.x = pk2(o[0] * rs * gsc[0], o[1] * rs * gsc[1]); w.y = pk2(o[2] * rs * gsc[2], o[3] * rs * gsc[3]); w.z = pk2(o[4] * rs * gsc[4], o[5] * rs * gsc[5]); w.w = pk2(o[6] * rs * gsc[6], o[7] * rs * gsc[7]);
            *(GAS v4u*)(mix + m * DM + 512 + h * 128 + e0) = w; }
    }
}

__device__ __forceinline__ void combine_local(Frame& F, const bf16* oatt, bf16* mix, const float* lq1, const float* lk1, const float* lq2, const float* lk2, const float* sg, int b, int h, int pr) {
    const float d1 = wave_sum(lq1[FLANE] * lk1[FLANE]), d2 = wave_sum(lq2[FLANE] * lk2[FLANE]);
    const float lam = expf(d1) - expf(d2) + LAM_INIT0;
    const int e0 = 8 * (FLANE & 15);
    float gsc[8];
#pragma unroll
    for (int j = 0; j < 8; ++j) gsc[j] = sg[e0 + j] * (1.0f - LAM_INIT0);
    for (int it = 0; it < 16; it += 4) {
        v4u av[4], bw[4]; size_t rows[4];
#pragma unroll
        for (int r = 0; r < 4; ++r) { const int rl = F.wave * 64 + (it + r) * 4 + (FLANE >> 4); rows[r] = (size_t)b * SEQ + (size_t)((rl < 256) ? pr : 7 - pr) * 256 + (rl & 255);
            av[r] = *(const GAS v4u*)(oatt + rows[r] * DM + h * 256 + e0); bw[r] = *(const GAS v4u*)(oatt + rows[r] * DM + h * 256 + 128 + e0); }
#pragma unroll
        for (int r = 0; r < 4; ++r) { const v4u a = av[r], bb = bw[r];
            float o[8];
            o[0] = bflo(a.x) - lam * bflo(bb.x); o[1] = bfhi(a.x) - lam * bfhi(bb.x); o[2] = bflo(a.y) - lam * bflo(bb.y); o[3] = bfhi(a.y) - lam * bfhi(bb.y);
            o[4] = bflo(a.z) - lam * bflo(bb.z); o[5] = bfhi(a.z) - lam * bfhi(bb.z); o[6] = bflo(a.w) - lam * bflo(bb.w); o[7] = bfhi(a.w) - lam * bfhi(bb.w);
            float s2 = 0.f;
#pragma unroll
            for (int j = 0; j < 8; ++j) s2 += o[j] * o[j];
            s2 += __shfl_xor(s2, 1); s2 += __shfl_xor(s2, 2); s2 += __shfl_xor(s2, 4); s2 += __shfl_xor(s2, 8);
            const float rs = 1.f / sqrtf(s2 * (1.f / 128.f) + LN_EPS);
            v4u w; w.x = pk2(o[0] * rs * gsc[0], o[1] * rs * gsc[1]); w.y = pk2(o[2] * rs * gsc[2], o[3] * rs * gsc[3]); w.z = pk2(o[4] * rs * gsc[4], o[5] * rs * gsc[5]); w.w = pk2(o[6] * rs * gsc[6], o[7] * rs * gsc[7]);
            *(GAS v4u*)(mix + rows[r] * DM + 512 + h * 128 + e0) = w; }
    }
}

__device__ __forceinline__ float dpp_shr1(float x) { return __builtin_bit_cast(float, __builtin_amdgcn_update_dpp(0, __builtin_bit_cast(int, x), 0x111, 0xf, 0xf, true)); }
__device__ __forceinline__ float dpp_shr2(float x) { return __builtin_bit_cast(float, __builtin_amdgcn_update_dpp(0, __builtin_bit_cast(int, x), 0x112, 0xf, 0xf, true)); }
__device__ __forceinline__ float dpp_shr4(float x) { return __builtin_bit_cast(float, __builtin_amdgcn_update_dpp(0, __builtin_bit_cast(int, x), 0x114, 0xf, 0xf, true)); }
__device__ __forceinline__ float dpp_shr8(float x) { return __builtin_bit_cast(float, __builtin_amdgcn_update_dpp(0, __builtin_bit_cast(int, x), 0x118, 0xf, 0xf, true)); }
__device__ __forceinline__ float dpp_shl15(float x) { return __builtin_bit_cast(float, __builtin_amdgcn_update_dpp(0, __builtin_bit_cast(int, x), 0x10f, 0xf, 0xf, true)); }
#define S5_DPP2(fn, v) ((f32x2){fn((v).x), fn((v).y)})
__device__ __forceinline__ float dpp_ror1(float x) { return __builtin_bit_cast(float, __builtin_amdgcn_update_dpp(0, __builtin_bit_cast(int, x), 0x121, 0xf, 0xf, true)); }
template <int hf>
__device__ __forceinline__ void s5_main(Frame& F, const bf16* ug, bf16* yb, const float* dsk, int g, int bh, LAS bf16* W2F, LAS bf16* W3F, LAS bf16* KT, LAS float* PW, int r, int q, int variant) {
        const int b = bh * 4 + (F.wave & 3);
        LAS bf16x8* XX = (LAS bf16x8*)(F.lds + 91648);
        const bf16* up = ug + ((size_t)g * MTOK + (size_t)b * SEQ) * 16;
        unsigned char* yp = (unsigned char*)yb + ((size_t)g * MTOK + (size_t)b * SEQ) * 16 + 4 * q;
        const f32x4 dk = *(const GAS f32x4*)(dsk + g * 16 + 4 * q);
        f32x4 E[4];
#pragma unroll
        for (int i = 0; i < 4; ++i) E[i] = (f32x4){0.f, 0.f, 0.f, 0.f};
        bf16x8 UFn[4], UF[4]; v2u UWn[4], UW[4];
#pragma unroll
        for (int sp = 0; sp < 4; ++sp) UFn[sp] = *(const GAS bf16x8*)(up + (size_t)(r * 8 + 2 * sp + (q >> 1)) * 16 + 8 * (q & 1));
#pragma unroll
        for (int t = 0; t < 4; ++t) UWn[t] = *(const GAS v2u*)(up + (size_t)(r * 8 + 4 * hf + t) * 16 + 4 * q);
#pragma unroll
        for (int sp = 0; sp < 4; ++sp) UF[sp] = UFn[sp];
#pragma unroll
        for (int t = 0; t < 4; ++t) UW[t] = UWn[t];
        f32x2 Pr[4][2][2], Pi[4][2][2];
#pragma unroll
        for (int i2 = 0; i2 < 2; ++i2) { const int rbp = 2 * hf + i2;
            const f32x4 a0 = *(const LAS f32x4*)(PW + (8 * 64 + 16 * rbp + 4 * q) * 2), a1 = *(const LAS f32x4*)(PW + (8 * 64 + 16 * rbp + 4 * q) * 2 + 4);
            Pr[0][i2][0] = (f32x2){a0[0], a0[2]}; Pi[0][i2][0] = (f32x2){a0[1], a0[3]}; Pr[0][i2][1] = (f32x2){a1[0], a1[2]}; Pi[0][i2][1] = (f32x2){a1[1], a1[3]};
#pragma unroll
            for (int k = 1; k < 4; ++k)
#pragma unroll
                for (int h = 0; h < 2; ++h) { const f32x2 pr = Pr[k - 1][i2][h], pi = Pi[k - 1][i2][h]; Pr[k][i2][h] = pr * pr - pi * pi; Pi[k][i2][h] = 2.0f * pr * pi; } }
        for (int cg = 0; cg < 16; ++cg) {
            const int tokbase = cg * 128 + r * 8;
            if (cg < 15) {
#pragma unroll
                for (int sp = 0; sp < 4; ++sp) UFn[sp] = *(const GAS bf16x8*)(up + (size_t)(tokbase + 128 + 2 * sp + (q >> 1)) * 16 + 8 * (q & 1));
#pragma unroll
                for (int t = 0; t < 4; ++t) UWn[t] = *(const GAS v2u*)(up + (size_t)(tokbase + 128 + 4 * hf + t) * 16 + 4 * q); }
            f32x2 Cr[2][2], Ci[2][2];
#pragma unroll
            for (int i2 = 0; i2 < 2; ++i2)
#pragma unroll
                for (int h = 0; h < 2; ++h) { const f32x2 er = h ? E[2 * i2].hi : E[2 * i2].lo, ei = h ? E[2 * i2 + 1].hi : E[2 * i2 + 1].lo; Cr[i2][h] = S5_DPP2(dpp_shl15, er); Ci[i2][h] = S5_DPP2(dpp_shl15, ei); }
#pragma unroll
            for (int i = 0; i < 4; ++i) E[i] = (f32x4){0.f, 0.f, 0.f, 0.f};
#pragma unroll
            for (int i = 0; i < 4; ++i)
#pragma unroll
                for (int sp = 0; sp < 4; ++sp) { E[i] = __builtin_amdgcn_mfma_f32_16x16x32_bf16(*(const LAS bf16x8*)(W2F + (((4 * hf + i) * 4 + sp) * 64 + FLANE) * 8), UF[sp], E[i], 0, 0, 0); if (sp == 3) asm volatile("" ::: "memory"); }
            bf16x8 XBf[4];
            LAS bf16x8* xx = XX + ((cg & 1) * 4 + (F.wave & 3)) * 256;
#pragma unroll
            for (int i2 = 0; i2 < 2; ++i2) { f32x2 xr[2], xi[2];
#pragma unroll
                for (int h = 0; h < 2; ++h) {
                    f32x2 er = h ? E[2 * i2].hi : E[2 * i2].lo, ei = h ? E[2 * i2 + 1].hi : E[2 * i2 + 1].lo; f32x2 sr, si, nr, ni;
                    nr = er + Pr[0][i2][h] * Cr[i2][h] - Pi[0][i2][h] * Ci[i2][h]; ni = ei + Pr[0][i2][h] * Ci[i2][h] + Pi[0][i2][h] * Cr[i2][h]; er = nr; ei = ni;
                    sr = S5_DPP2(dpp_shr1, er); si = S5_DPP2(dpp_shr1, ei); nr = er + Pr[0][i2][h] * sr - Pi[0][i2][h] * si; ni = ei + Pr[0][i2][h] * si + Pi[0][i2][h] * sr; er = nr; ei = ni;
                    sr = S5_DPP2(dpp_shr2, er); si = S5_DPP2(dpp_shr2, ei); nr = er + Pr[1][i2][h] * sr - Pi[1][i2][h] * si; ni = ei + Pr[1][i2][h] * si + Pi[1][i2][h] * sr; er = nr; ei = ni;
                    sr = S5_DPP2(dpp_shr4, er); si = S5_DPP2(dpp_shr4, ei); nr = er + Pr[2][i2][h] * sr - Pi[2][i2][h] * si; ni = ei + Pr[2][i2][h] * si + Pi[2][i2][h] * sr; er = nr; ei = ni;
                    sr = S5_DPP2(dpp_shr8, er); si = S5_DPP2(dpp_shr8, ei); nr = er + Pr[3][i2][h] * sr - Pi[3][i2][h] * si; ni = ei + Pr[3][i2][h] * si + Pi[3][i2][h] * sr; er = nr; ei = ni;
                    if (h) { E[2 * i2].hi = er; E[2 * i2 + 1].hi = ei; } else { E[2 * i2].lo = er; E[2 * i2 + 1].lo = ei; }
                    xr[h] = S5_DPP2(dpp_shr1, er) + Cr[i2][h]; xi[h] = S5_DPP2(dpp_shr1, ei) + Ci[i2][h]; }
                v4u w; w.x = pk2(xr[0].x, xr[0].y); w.y = pk2(xr[1].x, xr[1].y); w.z = pk2(xi[0].x, xi[0].y); w.w = pk2(xi[1].x, xi[1].y);
                XBf[2 * hf + i2] = __builtin_bit_cast(bf16x8, w); xx[(2 * hf + i2) * 64 + FLANE] = XBf[2 * hf + i2]; }
            LDS_WAIT(); __builtin_amdgcn_s_barrier(); asm volatile("" ::: "memory");
#pragma unroll
            for (int i2 = 0; i2 < 2; ++i2) XBf[2 * (1 - hf) + i2] = xx[(2 * (1 - hf) + i2) * 64 + FLANE];
            unsigned yout[4] = {0u, 0u, 0u, 0u};
            if (variant != 2) {
#pragma unroll
            for (int tt = 0; tt < 4; ++tt) { const int t = 4 * hf + tt;
                f32x4 Y = (f32x4){0.f, 0.f, 0.f, 0.f};
#pragma unroll
                for (int sp = 0; sp < 4; ++sp) if (sp <= (t >> 1)) { const int tau1 = t - 2 * sp - (q >> 1) + 1;
                    Y = __builtin_amdgcn_mfma_f32_16x16x32_bf16(*(const LAS bf16x8*)(KT + (tau1 * 16 + r) * 16 + 8 * (q & 1)), UF[sp], Y, 0, 0, 0); }
#pragma unroll
                for (int ks = 0; ks < 4; ++ks) Y = __builtin_amdgcn_mfma_f32_16x16x32_bf16(*(const LAS bf16x8*)(W3F + ((t * 4 + ks) * 64 + FLANE) * 8), XBf[ks], Y, 0, 0, 0);
                const v2u uw = UW[tt];
                const float y0 = gelu_tanh(Y[0] + dk[0] * bflo(uw.x)), y1 = gelu_tanh(Y[1] + dk[1] * bfhi(uw.x)), y2 = gelu_tanh(Y[2] + dk[2] * bflo(uw.y)), y3 = gelu_tanh(Y[3] + dk[3] * bfhi(uw.y));
                yout[tt] = pk4_fp8(y0 * SA8, y1 * SA8, y2 * SA8, y3 * SA8); asm volatile("" ::: "memory");
            } }
            if (cg < 15) {
#pragma unroll
                for (int sp = 0; sp < 4; ++sp) UF[sp] = UFn[sp];
#pragma unroll
                for (int t = 0; t < 4; ++t) UW[t] = UWn[t]; }
            asm volatile("" ::: "memory");
#pragma unroll
            for (int tt = 0; tt < 4; ++tt) *(GAS unsigned*)(yp + (size_t)(tokbase + 4 * hf + tt) * 16) = yout[tt];
        }
}
__device__ __forceinline__ void ph_s5(Frame& F, const bf16* ug, bf16* yb, const float* log_dt, const float* lre, const float* lim, const float* bre, const float* bim,
                                      const float* cre, const float* cim, const float* dsk, int variant) {
    LAS bf16* W2F = (LAS bf16*)F.lds;
    LAS bf16* W3F = (LAS bf16*)(F.lds + 32768);
    LAS bf16* KT = (LAS bf16*)(F.lds + 65536);
    LAS float* PW = (LAS float*)(F.lds + 70144);
    LAS float* ZZ = (LAS float*)(F.lds + 74752);
    LAS float* BB = (LAS float*)(F.lds + 75264);
    LAS float* CC = (LAS float*)(F.lds + 83456);
    LAS bf16* W30 = (LAS bf16*)(F.lds + 124416);
    const int r = FLANE & 15, q = FLANE >> 4;
    for (int it = F.vcu; it < 256; it += F.G) {
        const int g = it & 63, bh = it >> 6;
        __syncthreads();
        if (FTID < 64) { const int p = FTID; const float dt = expf(log_dt[g]), lr = lre[g * 64 + p], li = lim[g * 64 + p];
            const float mg = expf(lr * dt), ar = mg * cosf(li * dt), ai = mg * sinf(li * dt), den = lr * lr + li * li;
            float pr = 1.f, pi = 0.f;
            for (int n = 0; n < 9; ++n) { PW[(n * 64 + p) * 2] = pr; PW[(n * 64 + p) * 2 + 1] = pi; const float t2 = pr * ar - pi * ai; pi = pr * ai + pi * ar; pr = t2; }
            ZZ[p * 2] = ((ar - 1.0f) * lr + ai * li) / den; ZZ[p * 2 + 1] = (ai * lr - (ar - 1.0f) * li) / den; }
        __syncthreads();
        for (int idx = FTID; idx < 1024; idx += 512) {
            { const int p = idx >> 4; const float br = bre[(size_t)g * 1024 + idx], bi = bim[(size_t)g * 1024 + idx], zr = ZZ[p * 2], zi = ZZ[p * 2 + 1];
              BB[idx * 2] = zr * br - zi * bi; BB[idx * 2 + 1] = zr * bi + zi * br; }
            { CC[idx * 2] = cre[(size_t)g * 1024 + idx]; CC[idx * 2 + 1] = cim[(size_t)g * 1024 + idx]; }
        }
        if (FTID < 256) KT[FTID] = 0;
        __syncthreads();
        for (int idx = FTID; idx < 2048; idx += 512) {
            { const int t = idx >> 8, ks = (idx >> 6) & 3, ln = idx & 63, c = ln & 15, qq = ln >> 4; unsigned w[4];
#pragma unroll
              for (int j = 0; j < 4; ++j) { const int p = 16 * ks + 4 * qq + j; const float cr_ = CC[(c * 64 + p) * 2], ci_ = CC[(c * 64 + p) * 2 + 1], pr = PW[((t + 1) * 64 + p) * 2], pi = PW[((t + 1) * 64 + p) * 2 + 1];
                  const float gr = cr_ * pr - ci_ * pi, gi = cr_ * pi + ci_ * pr;
                  if (j & 1) { w[j >> 1] |= f2bf(gr) << 16; w[2 + (j >> 1)] |= f2bf(-gi) << 16; } else { w[j >> 1] = f2bf(gr); w[2 + (j >> 1)] = f2bf(-gi); } }
              *(LAS v4u*)(W3F + (size_t)idx * 8) = (v4u){w[0], w[1], w[2], w[3]}; }
            { const int rb = idx >> 8, sp = (idx >> 6) & 3, ln = idx & 63, rr = ln & 15, qq = ln >> 4, p = 16 * (rb >> 1) + rr, s = 2 * sp + (qq >> 1), c0 = 8 * (qq & 1); unsigned w[4];
              const float pr = PW[((7 - s) * 64 + p) * 2], pi = PW[((7 - s) * 64 + p) * 2 + 1];
#pragma unroll
              for (int j = 0; j < 8; ++j) { const float br = BB[(p * 16 + c0 + j) * 2], bi = BB[(p * 16 + c0 + j) * 2 + 1]; const float v = (rb & 1) ? (pr * bi + pi * br) : (pr * br - pi * bi);
                  if (j & 1) w[j >> 1] |= f2bf(v) << 16; else w[j >> 1] = f2bf(v); }
              *(LAS v4u*)(W2F + (size_t)idx * 8) = (v4u){w[0], w[1], w[2], w[3]}; }
        }
        if (FTID < 256) { const int ks = FTID >> 6, ln = FTID & 63, c = ln & 15, qq = ln >> 4; unsigned w[4];
#pragma unroll
            for (int j = 0; j < 4; ++j) { const int p = 16 * ks + 4 * qq + j; const float gr = CC[(c * 64 + p) * 2], gi = CC[(c * 64 + p) * 2 + 1];
                if (j & 1) { w[j >> 1] |= f2bf(gr) << 16; w[2 + (j >> 1)] |= f2bf(-gi) << 16; } else { w[j >> 1] = f2bf(gr); w[2 + (j >> 1)] = f2bf(-gi); } }
            *(LAS v4u*)(W30 + (size_t)FTID * 8) = (v4u){w[0], w[1], w[2], w[3]}; }
        __syncthreads();
        {
            f32x4 kacc = (f32x4){0.f, 0.f, 0.f, 0.f}; const int tau = F.wave;
#pragma unroll
            for (int ks = 0; ks < 4; ++ks) { unsigned w[4];
#pragma unroll
                for (int j = 0; j < 4; ++j) { const int p = 16 * ks + 4 * q + j; const float br = BB[(p * 16 + r) * 2], bi = BB[(p * 16 + r) * 2 + 1];
                    if (j & 1) { w[j >> 1] |= f2bf(br) << 16; w[2 + (j >> 1)] |= f2bf(bi) << 16; } else { w[j >> 1] = f2bf(br); w[2 + (j >> 1)] = f2bf(bi); } }
                const v4u wb = (v4u){w[0], w[1], w[2], w[3]};
                const bf16x8 af = tau == 0 ? *(const LAS bf16x8*)(W30 + (ks * 64 + FLANE) * 8) : *(const LAS bf16x8*)(W3F + (((tau - 1) * 4 + ks) * 64 + FLANE) * 8);
                kacc = __builtin_amdgcn_mfma_f32_16x16x32_bf16(af, __builtin_bit_cast(bf16x8, wb), kacc, 0, 0, 0); }
#pragma unroll
            for (int k = 0; k < 4; ++k) KT[(tau + 1) * 256 + (4 * q + k) * 16 + r] = (bf16)f2bf(kacc[k]); }
        __syncthreads();
        if (variant != 1) { if ((F.wave >> 2) == 0) s5_main<0>(F, ug, yb, dsk, g, bh, W2F, W3F, KT, PW, r, q, variant); else s5_main<1>(F, ug, yb, dsk, g, bh, W2F, W3F, KT, PW, r, q, variant); }
    }
}

struct PlainSched {
    pg8::TileOrder T; const char* A; const char* B; int tilesPerBatch; size_t bBatch; int splitN; size_t aT = pg8::TSTEP, bT = pg8::TSTEP;
    __device__ __forceinline__ bool next(int i, pg8::Unit& u) const {
        int pm, pn; if (!T.get(i, pm, pn)) return false;
        const int z = pm / tilesPerBatch;
        u.a = A + (size_t)pm * aT; u.b = B + (size_t)z * bBatch + (size_t)pn * bT; u.row0 = pm * 256; u.col0 = pn * 256; u.z = z; u.aux = 0;
        if (splitN) { u.z = pn >= splitN; u.col0 = (pn >= splitN ? pn - splitN : pn) * 256; }
        return true;
    }
};
struct FoldSched {
    int G, c, first; const char* KB; const char* VB; const char* XQ; const char* XOT;
    __device__ __forceinline__ bool next(int i, pg8::Unit& u) const {
        const int idx = i * G + c - first; if (idx < 0 || idx >= 512) return false;
        const int type = idx >> 8, j = idx & 255, b = j >> 4, h = (j >> 2) & 3, t = j & 3;
        if (type == 0) { u.a = KB + (size_t)b * 256 * 2048 + h * 512; u.b = XQ + (size_t)t * pg8::TSTEP + h * 512; u.row0 = b * 1024 + h * 256; u.col0 = t * 256; u.z = 0; }
        else { u.a = XOT + (size_t)t * pg8::TSTEP + h * 512; u.b = VB + (size_t)b * 256 * 2048 + h * 512; u.row0 = b * 1024 + t * 256; u.col0 = h * 256; u.z = 1; }
        u.aux = 0; return true;
    }
};
struct MoeSched {
    LAS const int* tab; int NT, G, c; const char* A; const char* B; size_t bExp; int colw; const int* list; bool gather; size_t tileB;
    __device__ __forceinline__ bool next(int i, pg8::Unit& u) const {
        const int nblk = __builtin_amdgcn_readfirstlane(tab[64]);
        const int x = c >> 5, r = c & 31; int mbl, pn;
        if (G != 256 || NT != 8) { mbl = c / NT; pn = c % NT; } else { pn = 4 * (x & 1) + (r & 3); mbl = 8 * (x >> 1) + (r >> 2); }
        const int mbg = i * (G / NT) + mbl; if (mbg >= nblk) return false;
        const int lane = opaque_tid() & 63; const int v = (lane <= 32) ? tab[32 + lane] : 0x7fffffff;
        const int e = __popcll(__ballot(v <= mbg)) - 1;
        const int mb = mbg - __builtin_amdgcn_readfirstlane(tab[32 + e]);
        u.a = gather ? A : A + (size_t)mbg * tileB; u.b = B + (size_t)e * bExp + (size_t)pn * tileB;
        u.row0 = mbg * 256; u.col0 = pn * colw; u.z = e; u.aux = mb; return true;
    }
    __device__ __forceinline__ const int* rows(const pg8::Unit& u) const { return list + (size_t)u.z * CAP + u.aux * 256; }
    __device__ __forceinline__ static int rowmap(int v) { return (int)(((unsigned)v >> 2) & (unsigned)(MTOK - 1)); }
};

#define EPI_ROWS_BEGIN _Pragma("unroll") for (int ai = 0; ai < 2; ++ai) _Pragma("unroll") for (int m = 0; m < 4; ++m) { const int rloc = ai * 128 + wr * 64 + m * 16 + fr;
#define EPI_ROWS_END }
__device__ __forceinline__ v4u pack8(f32x4 v0, f32x4 v1) { v4u w; w.x = pg8::cvt_pk_bf16(v0[0], v0[1]); w.y = pg8::cvt_pk_bf16(v0[2], v0[3]); w.z = pg8::cvt_pk_bf16(v1[0], v1[1]); w.w = pg8::cvt_pk_bf16(v1[2], v1[3]); return w; }
__device__ __forceinline__ void unpack8(v4u w, f32x4& a, f32x4& b) { a = (f32x4){bflo(w.x), bfhi(w.x), bflo(w.y), bfhi(w.y)}; b = (f32x4){bflo(w.z), bfhi(w.z), bflo(w.w), bfhi(w.w)}; }
__device__ __forceinline__ void rowpair_publish(LAS float* tab, float* dst, int nslot, int slot, int row0, const float (&ss)[8], const float (&qq)[8], int wr, int wc, int fr, int fq) {
    if (fq == 0) {
#pragma unroll
        for (int i = 0; i < 8; ++i) { const int rl = (i >> 2) * 128 + wr * 64 + (i & 3) * 16 + fr; tab[(rl * 4 + wc) * 2] = ss[i]; tab[(rl * 4 + wc) * 2 + 1] = qq[i]; } }
    LDS_WAIT(); __builtin_amdgcn_s_barrier(); asm volatile("" ::: "memory");
    { const int t = opaque_tid(), row = t >> 1, which = t & 1;
      const float v = (tab[(row * 4 + 0) * 2 + which] + tab[(row * 4 + 1) * 2 + which]) + (tab[(row * 4 + 2) * 2 + which] + tab[(row * 4 + 3) * 2 + which]);
      dst[((size_t)(row0 + row) * nslot + slot) * 2 + which] = v; }
    LDS_WAIT(); __builtin_amdgcn_s_barrier(); asm volatile("" ::: "memory");
}
__device__ __forceinline__ void ln_tables(LAS float* tabR, LAS float* tabC, const float* st, int nslot, int row0, const float* sc, int scrow0, const float* v0, const float* v1, int col0) {
    const int t = opaque_tid();
    if (t < 256) { const float* p = st + (size_t)(row0 + t) * 16; float s = 0.f, q = 0.f;
        for (int k = 0; k < nslot; ++k) { s += p[2 * k]; q += p[2 * k + 1]; }
        const float mu = s * (1.f / DM); tabR[2 * t] = mu; tabR[2 * t + 1] = 1.f / sqrtf(fmaxf(q * (1.f / DM) - mu * mu, 0.f) + LN_EPS); }
    else { const int c = t - 256;
        if (sc) { const f32x4 a = *(const GAS f32x4*)(sc + (size_t)(scrow0 + c) * 8), b = *(const GAS f32x4*)(sc + (size_t)(scrow0 + c) * 8 + 4);
            tabC[c] = (a[0] + a[2]) + (b[0] + b[2]); tabC[256 + c] = (a[1] + a[3]) + (b[1] + b[3]); }
        else { tabC[c] = v0[col0 + c]; tabC[256 + c] = v1[col0 + c]; } }
    LDS_WAIT(); __builtin_amdgcn_s_barrier(); asm volatile("" ::: "memory");
}
struct EpiResidStats { const bf16* xb; bf16* zb; unsigned char* z8; float* st; LAS float* tab;
    __device__ __forceinline__ void operator()(EPI_ARGS) const {
        float ss[8], qq[8]; v4u xr[2][4][2];
        EPI_ROWS_BEGIN const size_t off = (size_t)(u.row0 + rloc) * DM + u.col0 + wc * 32 + 8 * fq; xr[ai][m][0] = *(const GAS v4u*)(xb + off); xr[ai][m][1] = *(const GAS v4u*)(xb + off + 128); EPI_ROWS_END
        EPI_ROWS_BEGIN const size_t off = (size_t)(u.row0 + rloc) * DM + u.col0 + wc * 32 + 8 * fq; float s = 0.f, q = 0.f;
#pragma unroll
            for (int bj = 0; bj < 2; ++bj) { f32x4 x0, x1; unpack8(xr[ai][m][bj], x0, x1);
                const f32x4 z0 = x0 * ALPHA + acc[ai][bj][m][0], z1 = x1 * ALPHA + acc[ai][bj][m][1];
                *(GAS v4u*)(zb + off + bj * 128) = pack8(z0, z1);
                v2u w; w.x = pk4_fp8(z0[0] * SZ8, z0[1] * SZ8, z0[2] * SZ8, z0[3] * SZ8); w.y = pk4_fp8(z1[0] * SZ8, z1[1] * SZ8, z1[2] * SZ8, z1[3] * SZ8); *(GAS v2u*)(z8 + off + bj * 128) = w;
                s += ((z0[0] + z0[1]) + (z0[2] + z0[3])) + ((z1[0] + z1[1]) + (z1[2] + z1[3])); q += ((z0[0] * z0[0] + z0[1] * z0[1]) + (z0[2] * z0[2] + z0[3] * z0[3])) + ((z1[0] * z1[0] + z1[1] * z1[1]) + (z1[2] * z1[2] + z1[3] * z1[3])); }
            s += __shfl_xor(s, 16); s += __shfl_xor(s, 32); q += __shfl_xor(q, 16); q += __shfl_xor(q, 32); ss[ai * 4 + m] = s; qq[ai * 4 + m] = q; EPI_ROWS_END
        rowpair_publish(tab, st, 8, u.col0 >> 8, u.row0, ss, qq, wr, wc, fr, fq);
    } };
struct EpiResidLN { bf16* zb; float rs; const float* st; LAS float* tab; const float* g; const float* b; int nslot;
    __device__ __forceinline__ void operator()(EPI_ARGS) const {
        LAS float* tabC = tab + 512; ln_tables(tab, tabC, st, nslot, u.row0, nullptr, 0, g, b, u.col0);
        const int c8 = u.col0 + wc * 32 + 8 * fq, cl = wc * 32 + 8 * fq; v4u zr[2][4][2];
        EPI_ROWS_BEGIN const size_t off = (size_t)(u.row0 + rloc) * DM + c8; zr[ai][m][0] = *(const GAS v4u*)(zb + off); zr[ai][m][1] = *(const GAS v4u*)(zb + off + 128); EPI_ROWS_END
        EPI_ROWS_BEGIN const size_t off = (size_t)(u.row0 + rloc) * DM + c8; const float mu = tab[2 * rloc], rstd = tab[2 * rloc + 1];
#pragma unroll
            for (int bj = 0; bj < 2; ++bj) { f32x4 x0, x1; unpack8(zr[ai][m][bj], x0, x1);
                const f32x4 g0 = *(const LAS f32x4*)(tabC + cl + bj * 128), g1 = *(const LAS f32x4*)(tabC + cl + bj * 128 + 4), b0 = *(const LAS f32x4*)(tabC + 256 + cl + bj * 128), b1 = *(const LAS f32x4*)(tabC + 256 + cl + bj * 128 + 4);
                x0 = (x0 - mu) * rstd * g0 + b0; x1 = (x1 - mu) * rstd * g1 + b1;
                *(GAS v4u*)(zb + off + bj * 128) = pack8(x0 * ALPHA + acc[ai][bj][m][0] * rs, x1 * ALPHA + acc[ai][bj][m][1] * rs); } EPI_ROWS_END
        LDS_WAIT(); __builtin_amdgcn_s_barrier(); asm volatile("" ::: "memory");
    } };
struct EpiFold { unsigned char* kft; unsigned char* vft; const float* g; const float* b; float* sc; LAS float* tab;
    __device__ __forceinline__ void operator()(EPI_ARGS) const {
        if (u.z) {
            EPI_ROWS_BEGIN unsigned char* rowp = vft + (size_t)(u.row0 + rloc) * 1024 + u.col0 + wc * 32 + 8 * fq;
#pragma unroll
                for (int bj = 0; bj < 2; ++bj) { const f32x4 v0 = acc[ai][bj][m][0] * SV8, v1 = acc[ai][bj][m][1] * SV8; v2u w; w.x = pk4_fp8(v0[0], v0[1], v0[2], v0[3]); w.y = pk4_fp8(v1[0], v1[1], v1[2], v1[3]); *(GAS v2u*)(rowp + bj * 128) = w; } EPI_ROWS_END
            return; }
        float ss[8], qq[8]; const int c8 = u.col0 + wc * 32 + 8 * fq, cl = wc * 32 + 8 * fq; LAS float* tabC = tab + 2048;
        { const int t = opaque_tid(); if (t < 256) tabC[t] = g[u.col0 + t] * CSC; else tabC[t] = b[u.col0 + t - 256] * CSC; }
        LDS_WAIT(); __builtin_amdgcn_s_barrier(); asm volatile("" ::: "memory");
        EPI_ROWS_BEGIN unsigned char* rowp = kft + (size_t)(u.row0 + rloc) * 1024 + c8; float s = 0.f, q = 0.f;
#pragma unroll
            for (int bj = 0; bj < 2; ++bj) { const f32x4 g0 = *(const LAS f32x4*)(tabC + cl + bj * 128), g1 = *(const LAS f32x4*)(tabC + cl + bj * 128 + 4), b0 = *(const LAS f32x4*)(tabC + 256 + cl + bj * 128), b1 = *(const LAS f32x4*)(tabC + 256 + cl + bj * 128 + 4);
                const f32x4 k0 = acc[ai][bj][m][0] * g0, k1 = acc[ai][bj][m][1] * g1, c0 = acc[ai][bj][m][0] * b0, c1 = acc[ai][bj][m][1] * b1;
                s += ((k0[0] + k0[1]) + (k0[2] + k0[3])) + ((k1[0] + k1[1]) + (k1[2] + k1[3])); q += ((c0[0] + c0[1]) + (c0[2] + c0[3])) + ((c1[0] + c1[1]) + (c1[2] + c1[3]));
                v2u w; w.x = pk4_fp8(k0[0] * SK8, k0[1] * SK8, k0[2] * SK8, k0[3] * SK8); w.y = pk4_fp8(k1[0] * SK8, k1[1] * SK8, k1[2] * SK8, k1[3] * SK8); *(GAS v2u*)(rowp + bj * 128) = w; }
            s += __shfl_xor(s, 16); s += __shfl_xor(s, 32); q += __shfl_xor(q, 16); q += __shfl_xor(q, 32); ss[ai * 4 + m] = s; qq[ai * 4 + m] = q; EPI_ROWS_END
        rowpair_publish(tab, sc, 4, u.col0 >> 8, u.row0, ss, qq, wr, wc, fr, fq);
    } };
struct EpiStore { bf16* base0; bf16* base1; float s0, s1; int ldc; int f8mask = 0;
    __device__ __forceinline__ void operator()(EPI_ARGS) const {
        bf16* base = u.z ? base1 : base0; const float sc = u.z ? s1 : s0;
        if ((f8mask >> (u.z ? 1 : 0)) & 1) { unsigned char* b8 = (unsigned char*)base;
            EPI_ROWS_BEGIN unsigned char* rowp = b8 + (size_t)(u.row0 + rloc) * ldc + u.col0 + wc * 32 + 8 * fq;
#pragma unroll
                for (int bj = 0; bj < 2; ++bj) { const f32x4 v0 = acc[ai][bj][m][0] * sc, v1 = acc[ai][bj][m][1] * sc; v2u w; w.x = pk4_fp8(v0[0], v0[1], v0[2], v0[3]); w.y = pk4_fp8(v1[0], v1[1], v1[2], v1[3]); *(GAS v2u*)(rowp + bj * 128) = w; } EPI_ROWS_END
            return; }
        EPI_ROWS_BEGIN bf16* rowp = base + (size_t)(u.row0 + rloc) * ldc + u.col0 + wc * 32 + 8 * fq;
#pragma unroll
            for (int bj = 0; bj < 2; ++bj) *(GAS v4u*)(rowp + bj * 128) = pack8(acc[ai][bj][m][0] * sc, acc[ai][bj][m][1] * sc); EPI_ROWS_END
    } };
struct EpiH0 { bf16* uv; bf16* qx; bf16* kx; bf16* vx; float rs;
    __device__ __forceinline__ void operator()(EPI_ARGS) const {
        const int pn = u.col0 >> 8, kind = pn < 4 ? 0 : ((pn - 4) >> 1) + 1;
        bf16* base = kind == 0 ? uv : kind == 1 ? qx : kind == 2 ? kx : vx;
        EPI_ROWS_BEGIN bf16* rowp = base + (size_t)(u.row0 + rloc) * DM;
#pragma unroll
            for (int bj = 0; bj < 2; ++bj) { f32x4 v0 = acc[ai][bj][m][0] * rs, v1 = acc[ai][bj][m][1] * rs;
                if (kind == 0) {
#pragma unroll
                    for (int j = 0; j < 4; ++j) { v0[j] = gelu_tanh(v0[j]); v1[j] = gelu_tanh(v1[j]); }
                    *(GAS v4u*)(rowp + u.col0 + bj * 128 + wc * 32 + 8 * fq) = pack8(v0, v1); }
                else { const int cr = ((pn - 4) & 1) * 256 + bj * 128 + wc * 32 + 8 * fq;
                    if (kind == 1) { v0 = v0 * C2; v1 = v1 * C2; }
                    *(GAS v4u*)(rowp + cr) = pack8(v0, v1); } } EPI_ROWS_END
    } };
struct EpiResid { const bf16* xb; bf16* zb; float rs = 1.0f;
    __device__ __forceinline__ void operator()(EPI_ARGS) const {
        EPI_ROWS_BEGIN const size_t off = (size_t)(u.row0 + rloc) * DM + u.col0 + wc * 32 + 8 * fq;
#pragma unroll
            for (int bj = 0; bj < 2; ++bj) { f32x4 x0, x1; unpack8(*(const GAS v4u*)(xb + off + bj * 128), x0, x1);
                *(GAS v4u*)(zb + off + bj * 128) = pack8(x0 * ALPHA + acc[ai][bj][m][0] * rs, x1 * ALPHA + acc[ai][bj][m][1] * rs); } EPI_ROWS_END
    } };
struct EpiUG { bf16* ug; float rs;
    __device__ __forceinline__ void operator()(EPI_ARGS) const {
        EPI_ROWS_BEGIN
#pragma unroll
            for (int bj = 0; bj < 2; ++bj) { const int col = u.col0 + bj * 128 + wc * 32 + 8 * fq;
                *(GAS v4u*)(ug + ((size_t)(col >> 4) * MTOK + (u.row0 + rloc)) * 16 + (col & 15)) = pack8(acc[ai][bj][m][0] * rs, acc[ai][bj][m][1] * rs); } EPI_ROWS_END
    } };
struct EpiScore { float* sc;
    __device__ __forceinline__ void operator()(EPI_ARGS) const {
        EPI_ROWS_BEGIN float* rowp = sc + (size_t)(u.row0 + rloc) * DM + u.col0 + wc * 32 + 8 * fq;
#pragma unroll
            for (int bj = 0; bj < 2; ++bj) { *(GAS f32x4*)(rowp + bj * 128) = acc[ai][bj][m][0]; *(GAS f32x4*)(rowp + bj * 128 + 4) = acc[ai][bj][m][1]; } EPI_ROWS_END
    } };
struct EpiSoftmaxP { bf16* P; LAS float* tab; float rs0; const float* st; const float* sc; int nslot;
    __device__ __forceinline__ void operator()(EPI_ARGS) const {
        { auto& A = const_cast<f32x4 (&)[2][2][4][2]>(acc); LAS float* tabC = tab + 512; ln_tables(tab, tabC, st, nslot, u.row0, sc, u.z * 1024 + u.col0, nullptr, nullptr, 0);
          const int cl = wc * 32 + 8 * fq;
          EPI_ROWS_BEGIN const float mu = tab[2 * rloc], rstd = tab[2 * rloc + 1];
#pragma unroll
              for (int bj = 0; bj < 2; ++bj)
#pragma unroll
                  for (int n = 0; n < 2; ++n) { const f32x4 s1 = *(const LAS f32x4*)(tabC + cl + bj * 128 + 4 * n), c1 = *(const LAS f32x4*)(tabC + 256 + cl + bj * 128 + 4 * n);
                      A[ai][bj][m][n] = (A[ai][bj][m][n] * rs0 - s1 * mu) * rstd + c1; } EPI_ROWS_END
          LDS_WAIT(); __builtin_amdgcn_s_barrier(); asm volatile("" ::: "memory"); }
        constexpr float rs = 1.0f;
        EPI_ROWS_BEGIN float mx = -3.0e38f;
#pragma unroll
            for (int bj = 0; bj < 2; ++bj)
#pragma unroll
                for (int n = 0; n < 2; ++n)
#pragma unroll
                    for (int j = 0; j < 4; ++j) mx = fmaxf(mx, acc[ai][bj][m][n][j]);
            mx *= rs; mx = fmaxf(mx, __shfl_xor(mx, 16)); mx = fmaxf(mx, __shfl_xor(mx, 32));
            float sm = 0.f;
#pragma unroll
            for (int bj = 0; bj < 2; ++bj)
#pragma unroll
                for (int n = 0; n < 2; ++n)
#pragma unroll
                    for (int j = 0; j < 4; ++j) sm += __builtin_amdgcn_exp2f(acc[ai][bj][m][n][j] * rs - mx);
            sm += __shfl_xor(sm, 16); sm += __shfl_xor(sm, 32);
            if (fq == 0) { tab[(rloc * 4 + wc) * 2] = mx; tab[(rloc * 4 + wc) * 2 + 1] = sm; } EPI_ROWS_END
        LDS_WAIT(); __builtin_amdgcn_s_barrier(); asm volatile("" ::: "memory");
        EPI_ROWS_BEGIN const f32x4 a = *(const LAS f32x4*)(tab + rloc * 8), b = *(const LAS f32x4*)(tab + rloc * 8 + 4);
            const float M = fmaxf(fmaxf(a[0], a[2]), fmaxf(b[0], b[2]));
            const float S = a[1] * __builtin_amdgcn_exp2f(a[0] - M) + a[3] * __builtin_amdgcn_exp2f(a[2] - M) + b[1] * __builtin_amdgcn_exp2f(b[0] - M) + b[3] * __builtin_amdgcn_exp2f(b[2] - M);
            const float inv = SP8 / S; unsigned char* rowp = (unsigned char*)P + (size_t)(u.row0 + rloc) * DM + u.col0 + wc * 32 + 8 * fq;
#pragma unroll
            for (int bj = 0; bj < 2; ++bj) { f32x4 v0, v1;
#pragma unroll
                for (int j = 0; j < 4; ++j) { v0[j] = __builtin_amdgcn_exp2f(acc[ai][bj][m][0][j] * rs - M) * inv; v1[j] = __builtin_amdgcn_exp2f(acc[ai][bj][m][1][j] * rs - M) * inv; }
                v2u w; w.x = pk4_fp8(v0[0], v0[1], v0[2], v0[3]); w.y = pk4_fp8(v1[0], v1[1], v1[2], v1[3]); *(GAS v2u*)(rowp + bj * 128) = w; } EPI_ROWS_END
        LDS_WAIT(); __builtin_amdgcn_s_barrier(); asm volatile("" ::: "memory");
    } };
struct EpiRouter { float* logit;
    __device__ __forceinline__ void operator()(EPI_ARGS) const {
        if (wc == 0) { EPI_ROWS_BEGIN float* rowp = logit + (size_t)(u.row0 + rloc) * 32 + 8 * fq; *(GAS f32x4*)(rowp) = acc[ai][0][m][0]; *(GAS f32x4*)(rowp + 4) = acc[ai][0][m][1]; EPI_ROWS_END }
    } };
struct EpiSwiglu { const float* bup; bf16* act;
    __device__ __forceinline__ void operator()(EPI_ARGS) const {
        const int j0 = u.col0 + wc * 32 + 8 * fq; const float* bb = bup + (size_t)u.z * 2048;
        const f32x4 bg0 = *(const GAS f32x4*)(bb + j0), bg1 = *(const GAS f32x4*)(bb + j0 + 4), bl0 = *(const GAS f32x4*)(bb + 1024 + j0), bl1 = *(const GAS f32x4*)(bb + 1024 + j0 + 4);
        EPI_ROWS_BEGIN f32x4 o0, o1;
#pragma unroll
            for (int j = 0; j < 4; ++j) {
                { const float gl = fminf(acc[ai][0][m][0][j] + bg0[j], 7.0f), ln = fminf(fmaxf(acc[ai][1][m][0][j] + bl0[j], -7.0f), 7.0f); o0[j] = gl * sigmoidf_(1.702f * gl) * (ln + 1.0f); }
                { const float gl = fminf(acc[ai][0][m][1][j] + bg1[j], 7.0f), ln = fminf(fmaxf(acc[ai][1][m][1][j] + bl1[j], -7.0f), 7.0f); o1[j] = gl * sigmoidf_(1.702f * gl) * (ln + 1.0f); } }
            *(GAS v4u*)(act + (size_t)(u.row0 + rloc) * DM + j0) = pack8(o0, o1); EPI_ROWS_END
    } };
struct EpiDown { const float* bdn; const int* list; const float* gate; bf16* ys; LAS const int* tab;
    __device__ __forceinline__ void operator()(EPI_ARGS) const {
        const int e = u.z, cnt = tab[e], c8 = u.col0 + wc * 32 + 8 * fq; const float* bb = bdn + (size_t)e * 1024 + c8;
        f32x4 bv[2][2];
#pragma unroll
        for (int bj = 0; bj < 2; ++bj) { bv[bj][0] = *(const GAS f32x4*)(bb + bj * 128); bv[bj][1] = *(const GAS f32x4*)(bb + bj * 128 + 4); }
        int av[8]; float gv[8];
#pragma unroll
        for (int i = 0; i < 8; ++i) { const int slot = u.aux * 256 + (i >> 2) * 128 + wr * 64 + (i & 3) * 16 + fr; const int sl = slot < cnt ? slot : 0;
            av[i] = (int)((unsigned)list[(size_t)e * CAP + sl] & (unsigned)(NASSIGN - 1)); }
#pragma unroll
        for (int i = 0; i < 8; ++i) gv[i] = gate[av[i]];
        EPI_ROWS_BEGIN const int slot = u.aux * 256 + rloc; const int a = av[ai * 4 + m]; const float gt = gv[ai * 4 + m]; bf16* rowp = ys + (size_t)a * DM + c8;
            if (slot < cnt) {
#pragma unroll
                for (int bj = 0; bj < 2; ++bj) *(GAS v4u*)(rowp + bj * 128) = pack8((acc[ai][bj][m][0] + bv[bj][0]) * gt, (acc[ai][bj][m][1] + bv[bj][1]) * gt); } EPI_ROWS_END
    } };
struct EpiSwiglu8 { const float* bup; unsigned char* act; int skip; LAS float* slot;
    static constexpr bool HAS_PRE = true;
    __device__ __forceinline__ void pre(const pg8::Unit& u, int wid, int lane) const {
        if (wid < 4) { const int t = wid * 64 + lane; const float* src = bup + (size_t)u.z * 2048 + u.col0 + (t < 128 ? t : 1024 + t - 128);
            __builtin_amdgcn_global_load_lds((const unsigned*)src, (LAS unsigned*)(slot + u.par * 256 + wid * 64), 4, 0, 0); } }
    __device__ __forceinline__ void operator()(EPI_ARGS) const {
        if (skip) {
#pragma unroll
            for (int a = 0; a < 2; ++a)
#pragma unroll
                for (int b = 0; b < 2; ++b)
#pragma unroll
                    for (int m = 0; m < 4; ++m) asm volatile("" :: "v"(acc[a][b][m][0]), "v"(acc[a][b][m][1])); return; }
        const int j0 = u.col0 + wc * 32 + 8 * fq; constexpr float RS = 1.0f / (SX8 * SWU8); const LAS float* sb = slot + u.par * 256 + wc * 32 + 8 * fq;
        const f32x4 bg0 = *(const LAS f32x4*)(sb), bg1 = *(const LAS f32x4*)(sb + 4), bl0 = *(const LAS f32x4*)(sb + 128), bl1 = *(const LAS f32x4*)(sb + 132);
        typedef float f32x2 __attribute__((ext_vector_type(2)));
        EPI_ROWS_BEGIN f32x4 o0, o1;
#pragma unroll
            for (int n = 0; n < 2; ++n)
#pragma unroll
                for (int h = 0; h < 2; ++h) {
                    const f32x4 ga = acc[ai][0][m][n], la = acc[ai][1][m][n], bgv = n ? bg1 : bg0, blv = n ? bl1 : bl0;
                    const f32x2 g2 = h ? ga.hi : ga.lo, l2 = h ? la.hi : la.lo, bg2 = h ? bgv.hi : bgv.lo, bl2 = h ? blv.hi : blv.lo;
                    f32x2 gl = g2 * RS + bg2, ln = l2 * RS + bl2;
                    gl.x = fminf(gl.x, 7.0f); gl.y = fminf(gl.y, 7.0f); ln.x = __builtin_amdgcn_fmed3f(ln.x, -7.0f, 7.0f); ln.y = __builtin_amdgcn_fmed3f(ln.y, -7.0f, 7.0f);
                    const f32x2 ea = gl * (-1.702f * LOG2E); f32x2 d; d.x = __builtin_amdgcn_exp2f(ea.x); d.y = __builtin_amdgcn_exp2f(ea.y); d = d + 1.0f;
                    f32x2 rc; rc.x = __builtin_amdgcn_rcpf(d.x); rc.y = __builtin_amdgcn_rcpf(d.y);
                    const f32x2 o = (gl * rc) * (ln * SA8 + SA8);
                    if (n == 0) { o0[2 * h] = o.x; o0[2 * h + 1] = o.y; } else { o1[2 * h] = o.x; o1[2 * h + 1] = o.y; } }
            v2u w; { int r0 = __builtin_amdgcn_cvt_pk_fp8_f32(o0[0], o0[1], 0, false); r0 = __builtin_amdgcn_cvt_pk_fp8_f32(o0[2], o0[3], r0, true); int r1 = __builtin_amdgcn_cvt_pk_fp8_f32(o1[0], o1[1], 0, false); r1 = __builtin_amdgcn_cvt_pk_fp8_f32(o1[2], o1[3], r1, true); w.x = (unsigned)r0; w.y = (unsigned)r1; }
            *(GAS v2u*)(act + (size_t)(u.row0 + rloc) * DM + j0) = w; EPI_ROWS_END
    } };
struct EpiDown8 { const float* bdn; bf16* ys; LAS float* slot;
    static constexpr bool HAS_PRE = true;
    __device__ __forceinline__ void pre(const pg8::Unit& u, int wid, int lane) const {
        if (wid < 4) __builtin_amdgcn_global_load_lds((const unsigned*)(bdn + (size_t)u.z * 1024 + u.col0 + wid * 64 + lane), (LAS unsigned*)(slot + u.par * 256 + wid * 64), 4, 0, 0); }
    __device__ __forceinline__ void operator()(EPI_ARGS) const {
        const int c8 = u.col0 + wc * 32 + 8 * fq; const LAS float* bb = slot + u.par * 256 + wc * 32 + 8 * fq; constexpr float RS = 1.0f / (SA8 * SWD8);
        f32x4 bv[2][2];
#pragma unroll
        for (int bj = 0; bj < 2; ++bj) { bv[bj][0] = *(const LAS f32x4*)(bb + bj * 128); bv[bj][1] = *(const LAS f32x4*)(bb + bj * 128 + 4); }
        EPI_ROWS_BEGIN unsigned char* rowp = (unsigned char*)ys + (size_t)(u.row0 + rloc) * DM + c8;
#pragma unroll
            for (int bj = 0; bj < 2; ++bj) { const f32x4 v0 = (acc[ai][bj][m][0] * RS + bv[bj][0]) * SY8, v1 = (acc[ai][bj][m][1] * RS + bv[bj][1]) * SY8; v2u w; w.x = pk4_fp8(v0[0], v0[1], v0[2], v0[3]); w.y = pk4_fp8(v1[0], v1[1], v1[2], v1[3]); *(GAS v2u*)(rowp + bj * 128) = w; } EPI_ROWS_END
    } };
struct EpiValGate { const bf16* xb; bf16* zb; float rsv, rsg; unsigned char* z8; float* st; LAS float* tab;
    __device__ __forceinline__ void operator()(EPI_ARGS) const {
        float ss[8], qq[8]; v4u xr[2][4];
        EPI_ROWS_BEGIN xr[ai][m] = *(const GAS v4u*)(xb + (size_t)(u.row0 + rloc) * DM + u.col0 + wc * 32 + 8 * fq); EPI_ROWS_END
        EPI_ROWS_BEGIN const size_t off = (size_t)(u.row0 + rloc) * DM + u.col0 + wc * 32 + 8 * fq; f32x4 x0, x1; unpack8(xr[ai][m], x0, x1); f32x4 o0, o1;
#pragma unroll
            for (int j = 0; j < 4; ++j) { o0[j] = x0[j] * ALPHA + acc[ai][0][m][0][j] * rsv * sigmoidf_(acc[ai][1][m][0][j] * rsg); o1[j] = x1[j] * ALPHA + acc[ai][0][m][1][j] * rsv * sigmoidf_(acc[ai][1][m][1][j] * rsg); }
            *(GAS v4u*)(zb + off) = pack8(o0, o1);
            { v2u w; w.x = pk4_fp8(o0[0] * SZ8, o0[1] * SZ8, o0[2] * SZ8, o0[3] * SZ8); w.y = pk4_fp8(o1[0] * SZ8, o1[1] * SZ8, o1[2] * SZ8, o1[3] * SZ8); *(GAS v2u*)(z8 + off) = w; }
            float s = ((o0[0] + o0[1]) + (o0[2] + o0[3])) + ((o1[0] + o1[1]) + (o1[2] + o1[3])), q = ((o0[0] * o0[0] + o0[1] * o0[1]) + (o0[2] * o0[2] + o0[3] * o0[3])) + ((o1[0] * o1[0] + o1[1] * o1[1]) + (o1[2] * o1[2] + o1[3] * o1[3]));
            s += __shfl_xor(s, 16); s += __shfl_xor(s, 32); q += __shfl_xor(q, 16); q += __shfl_xor(q, 32); ss[ai * 4 + m] = s; qq[ai * 4 + m] = q;
            asm volatile("" ::: "memory"); EPI_ROWS_END
        rowpair_publish(tab, st, 8, u.col0 >> 7, u.row0, ss, qq, wr, wc, fr, fq);
    } };

#ifndef ONLY_SITE
#define ONLY_SITE -1
#endif
#define SITE(s) (ONLY_SITE < 0 || ONLY_SITE == (s))
#define IN(k) (lo <= (k) && (k) < hi)
#define SEAM(k) do { if (IN(k) && IN((k) + 1)) xcd_barrier(bar); } while (0)
template <int l>
__device__ __forceinline__ void layer_shared(Frame& F, const Args& args, const XcdBarrier& bar, const int lo, const int hi) {
    unsigned char* ws = args.ws; bf16* const XB = (bf16*)(ws + WS_XB); bf16* const ZB = (bf16*)(ws + WS_ZB); const int cid = (int)blockIdx.x;
    constexpr int pb = 5 + 14 * l;
        gu32* cnt = F.ctl + CW_CNT + l * 32 * 64;
    const float* st1 = (const float*)(ws + WS_ST) + (size_t)l * MTOK * 16; const float* sc1 = (const float*)(ws + WS_SCC) + (size_t)l * 16384 * 8;
    if (IN(pb + 1) && SITE(6)) { PlainSched S; S.T.init(MTOK / 256, 4, F.G, cid); S.A = (const char*)(ws + WS_XFZ); S.B = (const char*)(ws + WS_KFT); S.tilesPerBatch = SEQ / 256; S.bBatch = (size_t)1024 * 1024; S.splitN = 0; S.aT = (size_t)256 * 1024; S.bT = (size_t)256 * 1024;
        EpiSoftmaxP E{(bf16*)(ws + WS_P), (LAS float*)(F.lds + SMX_OFF), 1.0f / (SZ8 * SK8), st1, sc1, l ? 8 : 4}; pg8::gemm_phase<EpiSoftmaxP, PlainSched, false, true>(F.lds, 1024, S, E); } SEAM(pb + 1);
    if (IN(pb + 3) && SITE(8)) { PlainSched S; S.T.init(MTOK / 256, 4, F.G, cid); S.A = (const char*)(ws + WS_P); S.B = (const char*)(ws + WS_VFT); S.tilesPerBatch = SEQ / 256; S.bBatch = (size_t)1024 * 1024; S.splitN = 0; S.aT = (size_t)256 * 1024; S.bT = (size_t)256 * 1024;
        EpiResidLN E{ZB, 1.0f / (SP8 * SV8), st1, (LAS float*)(F.lds + SMX_OFF), (l ? args.in[39] : args.in[14]), (l ? args.in[40] : args.in[15]), l ? 8 : 4}; pg8::gemm_phase<EpiResidLN, PlainSched, false, true>(F.lds, 1024, S, E); } SEAM(pb + 3);
    if (IN(pb + 4) && SITE(9)) { ph_ln2_router(F, ZB, XB, MOE_FP8 ? ws + WS_XF8 : nullptr, (l ? args.in[43] : args.in[18]), (l ? args.in[44] : args.in[19]), (const bf16*)(ws + WS_WR) + (size_t)l * 256 * 1024,
                                               (l ? args.in[46] : args.in[21]), cnt, (int*)(ws + WS_LIST), (float*)(ws + WS_GATE), (int*)(ws + WS_ASG), (float*)(ws + WS_ST2)); } SEAM(pb + 4);
    if (IN(pb + 7) && SITE(12)) { moe_tables(F, cnt);
#if MOE_FP8
        MoeSched S{(LAS const int*)(F.lds + TAB_OFF), 8, F.G, F.vcu, (const char*)(ws + WS_XF8), (const char*)(ws + WS_WUP8), (size_t)2048 * 1024, 128, (const int*)(ws + WS_LIST), true, (size_t)256 * 1024};
        EpiSwiglu8 E{(l ? args.in[48] : args.in[23]), ws + WS_ACT, args.variant == 9, (LAS float*)(F.lds + SMX_OFF)}; pg8::gemm_phase<EpiSwiglu8, MoeSched, true, true>(F.lds, 1024, S, E);
#else
        MoeSched S{(LAS const int*)(F.lds + TAB_OFF), 8, F.G, F.vcu, (const char*)XB, (const char*)(ws + WS_WUP), (size_t)2048 * 1024 * 2, 128, (const int*)(ws + WS_LIST), true, pg8::TSTEP};
        EpiSwiglu E{(l ? args.in[48] : args.in[23]), (bf16*)(ws + WS_ACT)}; pg8::gemm_phase<EpiSwiglu, MoeSched, true>(F.lds, 1024, S, E);
#endif
    } SEAM(pb + 7);
    if (IN(pb + 8) && SITE(13)) { moe_tables(F, cnt);
#if MOE_FP8
        MoeSched S{(LAS const int*)(F.lds + TAB_OFF), 4, F.G, F.vcu, (const char*)(ws + WS_ACT), (const char*)(ws + WS_WDN8), (size_t)1024 * 1024, 256, (const int*)(ws + WS_LIST), false, (size_t)256 * 1024};
        EpiDown8 E{(l ? args.in[50] : args.in[25]), (bf16*)(ws + WS_YS), (LAS float*)(F.lds + SMX_OFF)}; pg8::gemm_phase<EpiDown8, MoeSched, false, true>(F.lds, 1024, S, E);
#else
        MoeSched S{(LAS const int*)(F.lds + TAB_OFF), 4, F.G, F.vcu, (const char*)(ws + WS_ACT), (const char*)(ws + WS_WDN), (size_t)1024 * 1024 * 2, 256, (const int*)(ws + WS_LIST), false, pg8::TSTEP};
        EpiDown E{(l ? args.in[50] : args.in[25]), (const int*)(ws + WS_LIST), (const float*)(ws + WS_GATE), (bf16*)(ws + WS_YS), (LAS const int*)(F.lds + TAB_OFF)}; pg8::gemm_phase<EpiDown, MoeSched, false>(F.lds, 1024, S, E);
#endif
    } SEAM(pb + 8);
    if (IN(pb + 9) && SITE(14)) { moe_tables(F, cnt); ph_ln<1>(F, ZB, (const bf16*)(ws + WS_YS), XB, l ? args.out : nullptr, (l ? args.in[51] : args.in[26]), (l ? args.in[52] : args.in[27]), (l == 0) ? ws + WS_XF8 : nullptr, (const int*)(ws + WS_ASG), (const float*)(ws + WS_GATE),
                                                             (const float*)(ws + WS_ST2), (l ? args.in[43] : args.in[18]), (l ? args.in[44] : args.in[19]));
        if (l == 0) { __syncthreads(); cvt_experts(F, args.in[47], args.in[49], ws); } } SEAM(pb + 9);
}

constexpr int PH_TOTAL = 29;
__global__ void __launch_bounds__(NWAVES * 64, 2) mk_fwd(Args args) {
    extern __shared__ __attribute__((aligned(16))) unsigned char lds[];
    Frame F;
    F.lds = (LAS unsigned char*)lds; F.MISC = (volatile LAS unsigned*)(F.lds + MISC_OFF);
    F.wave = __builtin_amdgcn_readfirstlane((int)threadIdx.x >> 6);
    F.G = gridDim.x; { const int bx = blockIdx.x; F.vcu = (F.G % 8 == 0) ? (bx % 8) * (F.G / 8) + bx / 8 : bx; }
    unsigned char* ws = args.ws;
    F.ctl = (gu32*)(ws + WS_CTL);
    for (int u = FTID; u < (LDS_BYTES - LDSCTL_OFF) / 4; u += NWAVES * 64) ((LAS unsigned*)(F.lds + LDSCTL_OFF))[u] = 0u;
    __syncthreads();
    const int lo = args.ph_lo, hi = args.ph_hi;
    XcdBarrier bar; bar.bar = (unsigned*)(F.ctl + CW_BAR); bar.x = 0; bar.st = nullptr;
    if (hi - lo > 1) bar = xcd_barrier_post((unsigned*)(F.ctl + CW_BAR), F.MISC + 8);
    bf16* const XB = (bf16*)(ws + WS_XB); bf16* const ZB = (bf16*)(ws + WS_ZB);
    const int cid = (int)blockIdx.x;

    if (IN(0) && SITE(0)) { p0_prologue(F, args); } SEAM(0);
    if (IN(1) && SITE(1)) {
        { PlainSched S; S.T.init(MTOK / 256, HW0 / 256, F.G, cid); S.A = (const char*)XB; S.B = (const char*)(ws + WS_WIN0); S.tilesPerBatch = 1 << 20; S.bBatch = 0; S.splitN = 0;
          EpiH0 E{(bf16*)(ws + WS_UV), (bf16*)(ws + WS_QX), (bf16*)(ws + WS_QX) + 512, (bf16*)(ws + WS_VX), 1.0f}; pg8::gemm_phase<EpiH0, PlainSched>(F.lds, 1024, S, E); }
        { PlainSched S; S.T.init(NB * MEMLEN / 256, 2048 / 256, F.G, cid); S.A = (const char*)(ws + WS_MEMB); S.B = (const char*)(ws + WS_WKV); S.tilesPerBatch = 1 << 20; S.bBatch = 0; S.splitN = 4;
          EpiStore E{(bf16*)(ws + WS_KB), (bf16*)(ws + WS_VB), 1.f, 1.f, 1024}; pg8::gemm_phase<EpiStore, PlainSched>(F.lds, 1024, S, E); }
    } SEAM(1);
    if (IN(2) && SITE(2)) {
        attn_body::bf16* oat = (attn_body::bf16*)(ws + WS_OATT);
        { const attn_body::AttnTensors AT{(const attn_body::bf16*)(ws + WS_QX), (const attn_body::bf16*)(ws + WS_QX) + 512, (const attn_body::bf16*)(ws + WS_VX), oat};
          const attn_body::StaticOrder S((int)F.G, (int)blockIdx.x); attn_body::attn_phase<attn_body::StaticOrder>((char*)lds, AT, S); }
        VM_WAIT(); __syncthreads();
        if (F.G == 256) combine_local(F, (const bf16*)(ws + WS_OATT), (bf16*)(ws + WS_MIX), args.in[8], args.in[9], args.in[10], args.in[11], args.in[12], F.vcu >> 4, (F.vcu >> 2) & 3, F.vcu & 3);
        __syncthreads();
        ph_sgu(F, (const bf16*)(ws + WS_UV), (bf16*)(ws + WS_MIX), args.in[4], args.in[5], args.in[6], args.in[7]);
    } SEAM(2);
    if (IN(4) && SITE(4)) {
        { PlainSched S; S.T.init(MTOK / 256, 4, F.G, cid); S.A = (const char*)(ws + WS_MIX); S.B = (const char*)(ws + WS_WOUT0); S.tilesPerBatch = 1 << 20; S.bBatch = 0; S.splitN = 0;
          EpiResidStats E{XB, ZB, ws + WS_XFZ, (float*)(ws + WS_ST), (LAS float*)(F.lds + SMX_OFF)}; pg8::gemm_phase<EpiResidStats, PlainSched>(F.lds, 1024, S, E); }
        { FoldSched S{F.G, F.vcu, 0, (const char*)(ws + WS_KB), (const char*)(ws + WS_VB), (const char*)(ws + WS_XQB), (const char*)(ws + WS_XOT)};
          EpiFold E{ws + WS_KFT, ws + WS_VFT, args.in[14], args.in[15], (float*)(ws + WS_SCC), (LAS float*)(F.lds + SMX_OFF)}; int kf = 256; asm volatile("" : "+s"(kf)); pg8::gemm_phase<EpiFold, FoldSched>(F.lds, kf, S, E); }
    } SEAM(4);

    layer_shared<0>(F, args, bar, lo, hi);
    if (IN(15) && SITE(15)) { { PlainSched S; S.T.init(MTOK / 256, 4, F.G, cid); S.A = (const char*)(ws + WS_XF8); S.B = (const char*)(ws + WS_WIN1); S.tilesPerBatch = 1 << 20; S.bBatch = 0; S.splitN = 0; S.aT = (size_t)256 * 1024; S.bT = (size_t)256 * 1024;
        EpiUG E{(bf16*)(ws + WS_UG), 1.0f / (SX8 * SWU8)}; pg8::gemm_phase<EpiUG, PlainSched, false, true>(F.lds, 1024, S, E); }
        { FoldSched S{F.G, F.vcu, 0, (const char*)(ws + WS_KB), (const char*)(ws + WS_VB), (const char*)(ws + WS_XQB) + 1024 * 1024 * 2, (const char*)(ws + WS_XOT) + 1024 * 1024 * 2};
      EpiFold E{ws + WS_KFT, ws + WS_VFT, args.in[39], args.in[40], (float*)(ws + WS_SCC) + (size_t)16384 * 8, (LAS float*)(F.lds + SMX_OFF)}; int kf = 256; asm volatile("" : "+s"(kf)); pg8::gemm_phase<EpiFold, FoldSched>(F.lds, kf, S, E); }
    } SEAM(15);
    if (IN(16) && SITE(16)) { ph_s5(F, (const bf16*)(ws + WS_UG), (bf16*)(ws + WS_YB), args.in[29], args.in[30], args.in[31], args.in[32], args.in[33], args.in[34], args.in[35], args.in[36], args.variant); } SEAM(16);
    if (IN(17) && SITE(17)) { PlainSched S; S.T.init(MTOK / 256, 8, F.G, cid); S.A = (const char*)(ws + WS_YB); S.B = (const char*)(ws + WS_WVG); S.tilesPerBatch = 1 << 20; S.bBatch = 0; S.splitN = 0; S.aT = (size_t)256 * 16; S.bT = (size_t)256 * 1024;
        struct VGS { PlainSched P; __device__ __forceinline__ bool next(int i, pg8::Unit& u) const { if (!P.next(i, u)) return false; u.col0 >>= 1; return true; } } S2{S};
        EpiValGate E{XB, ZB, 1.0f / (SA8 * SWD8), 1.0f / (SA8 * SWU8), ws + WS_XFZ, (float*)(ws + WS_ST) + (size_t)MTOK * 16, (LAS float*)(F.lds + SMX_OFF)}; pg8::gemm_phase<EpiValGate, VGS, false, true, 1>(F.lds, 1024, S2, E); } SEAM(17);
    layer_shared<1>(F, args, bar, lo, hi);
#undef IN
#undef SEAM
}

extern "C" void kernel_launch(void* const* d_in, const int* in_sizes, int n_in, void* d_out, int out_size, void* d_ws, size_t ws_size, hipStream_t stream) {
    static int grid = 0;
    if (grid == 0) {
        if (n_in != 53 || in_sizes[0] != MTOK * DM || out_size != MTOK * DM || ws_size < WS_END) { fprintf(stderr, "kernel_launch: unexpected problem (n_in %d, in0 %d, out %d, ws %zu < %zu); nothing launched\n", n_in, n_in > 0 ? in_sizes[0] : -1, out_size, ws_size, (size_t)WS_END); grid = -1; return; }
        int dev = 0, cus = 0, per_cu = 0;
        if (hipGetDevice(&dev) != hipSuccess || hipDeviceGetAttribute(&cus, hipDeviceAttributeMultiprocessorCount, dev) != hipSuccess) { grid = -1; return; }
        if (hipFuncSetAttribute((const void*)mk_fwd, hipFuncAttributeMaxDynamicSharedMemorySize, LDS_BYTES) != hipSuccess) { fprintf(stderr, "kernel_launch: hipFuncSetAttribute failed\n"); grid = -1; return; }
        if (hipOccupancyMaxActiveBlocksPerMultiprocessor(&per_cu, (const void*)mk_fwd, NWAVES * 64, LDS_BYTES) != hipSuccess || per_cu < 1) fprintf(stderr, "kernel_launch: note: occupancy query reports %d\n", per_cu);
        (void)hipGetLastError();
        grid = cus;
    }
    if (grid < 0) return;
    if (hipMemsetAsync((char*)d_ws + WS_CTL, 0, CTL_ZERO_BYTES, stream) != hipSuccess) return;
    Args a{};
    for (int i = 0; i < 53; ++i) a.in[i] = (const float*)d_in[i];
    a.out = (float*)d_out; a.ws = (unsigned char*)d_ws;
#if MK_N_LAUNCHES == 1
    a.ph_lo = 0; a.ph_hi = PH_TOTAL;
    hipLaunchKernelGGL(mk_fwd, dim3(grid), dim3(NWAVES * 64), LDS_BYTES, stream, a);
#else
    for (int p = 0; p < PH_TOTAL; ++p) { if (p == 18 || p == 5 || p == 19) continue; a.ph_lo = p; a.ph_hi = p + 1;
        for (int rep = 0; rep < 1 + (int)(((PROBE_REPEAT_MASK) >> p) & 1ull); ++rep) { a.variant = (rep == 0 && (((PROBE_REPEAT_MASK) >> p) & 1ull)) ? PROBE_VARIANT : 0; hipLaunchKernelGGL(mk_fwd, dim3(grid), dim3(NWAVES * 64), LDS_BYTES, stream, a); } }
#endif
}
```

```cpp
#include <hip/hip_runtime.h>
#include <hip/hip_bf16.h>
#include <cstdio>
#include <cstdint>

#ifndef MK_N_LAUNCHES
#define MK_N_LAUNCHES 1
#endif

#ifndef MOE_FP8
#define MOE_FP8 1
#endif
#ifndef PROBE_VARIANT
#define PROBE_VARIANT 0
#endif
#ifndef PROBE_REPEAT_MASK
#define PROBE_REPEAT_MASK 0ull
#endif
#define GAS __attribute__((address_space(1)))
#define LAS __attribute__((address_space(3)))
typedef unsigned short bf16;
typedef unsigned v4u __attribute__((ext_vector_type(4)));
typedef unsigned v2u __attribute__((ext_vector_type(2)));
typedef float f32x4 __attribute__((ext_vector_type(4)));
typedef float f32x2 __attribute__((ext_vector_type(2)));
typedef short bf16x8 __attribute__((ext_vector_type(8)));
typedef int v4i_t __attribute__((ext_vector_type(4)));
typedef GAS unsigned gu32;
#define RLX_AGENT __ATOMIC_RELAXED, __HIP_MEMORY_SCOPE_AGENT
#define LDS_WAIT() asm volatile("s_waitcnt lgkmcnt(0)" ::: "memory")
#define VM_WAIT() asm volatile("s_waitcnt vmcnt(0)" ::: "memory")

constexpr int NB = 16, SEQ = 2048, DM = 1024, MTOK = NB * SEQ;
constexpr int MEMLEN = 256, NEXP = 32, TOPK = 4, NASSIGN = MTOK * TOPK;
constexpr int HW0 = 2560;
constexpr int CAP = MTOK;
constexpr int MAXBLK = NASSIGN / 256 + NEXP;
constexpr float LN_EPS = 1e-5f;
constexpr float ALPHA = 1.41421356237f;
constexpr float LOG2E = 1.4426950408889634f;
constexpr float C2 = 0.125f * LOG2E;
constexpr float CSC = 0.0625f * LOG2E;
constexpr float LAM_INIT0 = 0.2f;

constexpr size_t MiB = 1u << 20;
constexpr size_t WS_CTL = 0, CTL_ZERO_BYTES = 96 * 1024;
constexpr size_t WS_LIST = 1 * MiB;
constexpr size_t WS_GATE = WS_LIST + 4 * MiB;
constexpr size_t WS_ASG = WS_GATE + 512 * 1024;
constexpr size_t WS_LOGIT = WS_GATE + 1 * MiB;
constexpr size_t WS_WKV = WS_LOGIT + 4 * MiB;
constexpr size_t WS_WIN0 = WS_WKV + 4 * MiB;
constexpr size_t WS_WOUT0 = WS_WIN0 + 5 * MiB;
constexpr size_t WS_XQB = WS_WOUT0 + 2 * MiB;
constexpr size_t WS_XOT = WS_XQB + 4 * MiB;
constexpr size_t WS_WIN1 = WS_XOT + 4 * MiB;
constexpr size_t WS_WVG = WS_WIN1 + 2 * MiB;
constexpr size_t WS_WR = WS_WVG + 4 * MiB;
constexpr size_t WS_MEMB = WS_WR + 1 * MiB;
constexpr size_t WS_KB = WS_MEMB + 8 * MiB;
constexpr size_t WS_VB = WS_KB + 8 * MiB;
constexpr size_t WS_KFT = WS_VB + 8 * MiB;
constexpr size_t WS_VFT = WS_KFT + 32 * MiB;
constexpr size_t WS_WUP = WS_VFT + 32 * MiB;
constexpr size_t WS_WDN = WS_WUP + 128 * MiB;
constexpr size_t WS_XB = WS_WDN + 64 * MiB;
constexpr size_t WS_ZB = WS_XB + 64 * MiB;
constexpr size_t WS_BIG1 = WS_ZB + 64 * MiB;
constexpr size_t WS_BIG2 = WS_BIG1 + 272 * MiB;
constexpr size_t WS_END = WS_BIG2 + 272 * MiB;
static_assert(WS_END <= 1024 * MiB, "workspace map exceeds 1 GiB");
constexpr size_t WS_UV = WS_BIG1;
constexpr size_t WS_QX = WS_BIG1 + 64 * MiB;
constexpr size_t WS_KX = WS_BIG1 + 128 * MiB;
constexpr size_t WS_VX = WS_BIG1 + 192 * MiB;
constexpr size_t WS_SC = WS_BIG1;
constexpr size_t WS_WUP8 = WS_WUP;
constexpr size_t WS_WDN8 = WS_WUP + 64 * MiB;
constexpr size_t WS_XF8 = WS_WUP + 96 * MiB;
constexpr float SX8 = 4.0f, SWU8 = 64.0f, SA8 = 4.0f, SWD8 = 128.0f, SP8 = 256.0f, SV8 = 8.0f, SK8 = 32.0f, SY8 = 32.0f;
constexpr size_t WS_XFZ = WS_WDN;
constexpr size_t WS_SCC = WS_WDN + 32 * MiB;
constexpr size_t WS_ST2 = WS_WDN + 40 * MiB;
constexpr size_t WS_ST = WS_LOGIT;
constexpr float SZ8 = 8.0f;
constexpr size_t WS_ACT = WS_BIG1;
constexpr size_t WS_OATT = WS_BIG2;
constexpr size_t WS_MIX = WS_BIG2 + 64 * MiB;
constexpr size_t WS_P = WS_BIG2 + 128 * MiB;
constexpr size_t WS_UG = WS_BIG2;
constexpr size_t WS_YB = WS_BIG2 + 64 * MiB;
constexpr size_t WS_XG = WS_BIG2;
constexpr size_t WS_YS = WS_BIG2;

constexpr int CW_TMO = 0;
constexpr int CW_BAR = 4096;
constexpr int CW_CNT = 16384;
static_assert((CW_CNT + 64 * 64) * 4 <= (int)CTL_ZERO_BYTES && (CW_BAR + 3456) * 4 <= (int)CTL_ZERO_BYTES, "control words inside the per-call memset");

constexpr int RING_BYTES = 131072;
constexpr int SCR_BYTES = 135168;
constexpr int LDSCTL_OFF = SCR_BYTES, MISC_OFF = LDSCTL_OFF + 320;
constexpr int TAB_OFF = MISC_OFF + 128;
constexpr int SMX_OFF = TAB_OFF + 576;
constexpr int LDS_BYTES = 147456;
static_assert(SMX_OFF % 16 == 0 && SMX_OFF + 8192 <= LDS_BYTES, "LDS map");

__device__ __forceinline__ unsigned f2bf(float f) { unsigned u = __builtin_bit_cast(unsigned, f); return (u + 0x7fffu + ((u >> 16) & 1u)) >> 16; }
typedef float pk2_f32x2 __attribute__((ext_vector_type(2))); typedef __bf16 pk2_bf16x2 __attribute__((ext_vector_type(2)));
__device__ __forceinline__ unsigned pk2(float lo, float hi) { const pk2_f32x2 v = {lo, hi}; return __builtin_bit_cast(unsigned, __builtin_convertvector(v, pk2_bf16x2)); }
__device__ __forceinline__ float bflo(unsigned w) { return __builtin_bit_cast(float, w << 16); }
__device__ __forceinline__ float bfhi(unsigned w) { return __builtin_bit_cast(float, w & 0xffff0000u); }
__device__ __forceinline__ float bf2f(bf16 b) { return __builtin_bit_cast(float, ((unsigned)b) << 16); }
__device__ __forceinline__ float wave_sum(float v) {
#pragma unroll
    for (int o = 1; o < 64; o <<= 1) v += __shfl_xor(v, o);
    return v;
}
__device__ __forceinline__ float wave_max(float v) {
#pragma unroll
    for (int o = 1; o < 64; o <<= 1) v = fmaxf(v, __shfl_xor(v, o));
    return v;
}
__device__ __forceinline__ float gelu_tanh(float x) {
    const float t = x * (0.7978845608f * 2.0f * LOG2E) * (1.0f + 0.044715f * x * x);
    return x * __builtin_amdgcn_rcpf(1.0f + __builtin_amdgcn_exp2f(-t));
}
__device__ __forceinline__ f32x2 gelu_tanh2(f32x2 x, float osc) {
    constexpr float K1 = 0.7978845608f * 2.0f * LOG2E, K2 = K1 * 0.044715f; const float io = 1.0f / osc;
    const f32x2 t = x * (x * x * K2 + K1); f32x2 e; e.x = __builtin_amdgcn_exp2f(-t.x); e.y = __builtin_amdgcn_exp2f(-t.y);
    const f32x2 d = e * io + io; f32x2 rc; rc.x = __builtin_amdgcn_rcpf(d.x); rc.y = __builtin_amdgcn_rcpf(d.y); return x * rc; }
__device__ __forceinline__ float sigmoidf_(float x) { return __builtin_amdgcn_rcpf(1.0f + __builtin_amdgcn_exp2f(-x * LOG2E)); }

namespace pg8 {
constexpr int BM = 256, BK = 64, HALF = 128, HTB = HALF * BK * 2, STAGE_BYTES = 8 * HTB, NXCD = 8, WGM = 8;
constexpr int LD = 1024;
constexpr size_t HSTEP = (size_t)HALF * LD * 2, TSTEP = 2 * HSTEP;
__host__ __device__ __forceinline__ int lds_byte(int r, int c) { const int st = (r >> 4) * 2 + (c >> 5), rr = r & 15, cc = c & 31, ob = rr * 64 + cc * 2; return st * 1024 + (ob ^ (((ob >> 9) & 1) << 5)); }
__host__ __device__ __forceinline__ void stage_rc(int b, int& R, int& C) { const int st = b / 1024, sb = b % 1024, swz = sb ^ (((sb >> 9) & 1) << 5); R = (st >> 1) * 16 + swz / 64; C = (st & 1) * 32 + (swz % 64) / 2; }
__host__ __device__ __forceinline__ int perm32(int rho) { const int n = rho >> 4, i = rho & 15; return 8 * (i >> 2) + 4 * n + (i & 3); }

struct Unit { const char* a; const char* b; int row0, col0, z, aux, par; };
template <class E, class = void> struct epi_has_pre { static constexpr bool value = false; };
template <class E> struct epi_has_pre<E, decltype((void)E::HAS_PRE)> { static constexpr bool value = true; };

struct TileOrder {
    int nM, nN, nwg, G, c;
    __device__ void init(int nM_, int nN_, int G_, int c_) { nM = nM_; nN = nN_; nwg = nM * nN; G = G_; c = c_; }
    __device__ bool get(int i, int& pm, int& pn) const {
        const long L = (long)i * G + c; if (L >= nwg) return false;
        int wgid = (int)L; { const int q = nwg / NXCD, r = nwg % NXCD, xcd = wgid % NXCD, off = wgid / NXCD; wgid = (xcd < r ? xcd * (q + 1) : r * (q + 1) + (xcd - r) * q) + off; }
        const int nig = WGM * nN, gid = wgid / nig, fm = gid * WGM, gsz = (nM - fm) < WGM ? (nM - fm) : WGM;
        pm = fm + ((wgid % nig) % gsz); pn = (wgid % nig) / gsz; return true;
    }
};

__device__ __forceinline__ unsigned cvt_pk_bf16(float lo, float hi) { unsigned r; asm volatile("v_cvt_pk_bf16_f32 %0, %1, %2" : "=v"(r) : "v"(lo), "v"(hi)); return r; }

template <class Epi, class Sched, bool GATHER = false, bool FP8 = false, int ALAY = 0>
__device__ __forceinline__ void gemm_phase(LAS unsigned char* lds, const int K, const Sched& S, const Epi& E) {
    int tid = threadIdx.x; asm volatile("" : "+v"(tid));
    const int wid = __builtin_amdgcn_readfirstlane(tid >> 6), lane = tid & 63, wr = wid >> 2, wc = wid & 3, fr = lane & 15, fq = lane >> 4;
    constexpr unsigned ROWB = FP8 ? 1024u : 2048u;
    const int nt = FP8 ? K / 128 : K / BK;
    unsigned voffA[2], voffB[2]; int RA[2], CA[2];
#pragma unroll
    for (int i = 0; i < 2; ++i) { int R, C; stage_rc(tid * 16 + i * 8192, R, C); const int Rb = (R & ~31) + perm32(R & 31);
        voffA[i] = ALAY ? (unsigned)(C >> 3) * (unsigned)(MTOK * 16) + (unsigned)R * 16u : (unsigned)R * ROWB + (unsigned)C * 2u; voffB[i] = (unsigned)Rb * ROWB + (unsigned)C * 2u; RA[i] = R; CA[i] = C; }
    const size_t kstep = (size_t)(BK * 2);
    const size_t kstepA = ALAY ? (size_t)8 * MTOK * 16 : kstep;
    const size_t hstepB = (size_t)HALF * ROWB;
    const size_t hstepA = GATHER ? 0 : (ALAY ? (size_t)HALF * 16 : (size_t)HALF * ROWB);
    const unsigned ldsw = (unsigned)wid * 1024u;
    const int aoff0 = lds_byte(wr * 64 + fr, fq * 8);
    const int boff0 = lds_byte(wc * 32 + fr, fq * 8);
    unsigned aB = (unsigned)(uintptr_t)lds + (unsigned)aoff0, bB = (unsigned)(uintptr_t)lds + 4u * HTB + (unsigned)boff0; asm volatile("" : "+v"(aB), "+v"(bB));
    constexpr int KOFF = 1024;
#define PG8_SA(b, h) (((b) * 2 + (h)) * HTB)
#define PG8_SB(b, h) ((4 + (b) * 2 + (h)) * HTB)
#define PG8_STAGE(bufoff, gbase, voff) do { _Pragma("unroll") for (int _i = 0; _i < 2; ++_i) \
        __builtin_amdgcn_global_load_lds((const unsigned*)((const char*)(gbase) + (voff)[_i]), (LAS unsigned*)(lds + (bufoff) + ldsw + _i * 8192), 16, 0, 0); } while (0)
#define PG8_LD32(base, off0) __builtin_shufflevector(*(const LAS v4i_t*)((base) + (unsigned)(off0)), *(const LAS v4i_t*)((base) + (unsigned)((off0) + KOFF)), 0, 1, 2, 3, 4, 5, 6, 7)
#define PG8_LDA(dst, b, h) do { if constexpr (FP8) { _Pragma("unroll") for (int m = 0; m < 4; ++m) dst##8[m] = PG8_LD32(aB, PG8_SA(b, h) + m * 2048); } else { _Pragma("unroll") for (int m = 0; m < 4; ++m) _Pragma("unroll") for (int k = 0; k < 2; ++k) dst[m][k] = *(const LAS bf16x8*)(aB + (unsigned)(PG8_SA(b, h) + m * 2048 + k * KOFF)); } } while (0)
#define PG8_LDB(dst, b, h) do { if constexpr (FP8) { _Pragma("unroll") for (int n = 0; n < 2; ++n) dst##8[n] = PG8_LD32(bB, PG8_SA(b, h) + n * 2048); } else { _Pragma("unroll") for (int n = 0; n < 2; ++n) _Pragma("unroll") for (int k = 0; k < 2; ++k) dst[n][k] = *(const LAS bf16x8*)(bB + (unsigned)(PG8_SA(b, h) + n * 2048 + k * KOFF)); } } while (0)
#define PG8_MMA(ai, bj, At, Bt) do { __builtin_amdgcn_s_setprio(1); _Pragma("unroll") for (int m = 0; m < 4; ++m) _Pragma("unroll") for (int n = 0; n < 2; ++n) { \
        if constexpr (FP8) asm volatile("v_mfma_scale_f32_16x16x128_f8f6f4 %0, %1, %2, %0, %3, %3 op_sel_hi:[0,0,0]" : "+v"(acc[ai][bj][m][n]) : "v"(Bt##8[n]), "v"(At##8[m]), "v"(sc8)); \
        else { _Pragma("unroll") for (int k = 0; k < 2; ++k) acc[ai][bj][m][n] = __builtin_amdgcn_mfma_f32_16x16x32_bf16(Bt[n][k], At[m][k], acc[ai][bj][m][n], 0, 0, 0); } } __builtin_amdgcn_s_setprio(0); } while (0)
#define PG8_WAIT_V(n) asm volatile("s_waitcnt vmcnt(" #n ")" ::: "memory")
#define PG8_WAIT_L(n) asm volatile("s_waitcnt lgkmcnt(" #n ")" ::: "memory")
#define PG8_BAR __builtin_amdgcn_s_barrier()
#define PG8_SCHED __builtin_amdgcn_sched_barrier(0)
    Unit cur, nxt; int ui = 0;
    if (!S.next(0, cur)) return;
    f32x4 acc[2][2][4][2];
#pragma unroll
    for (int a = 0; a < 2; ++a)
#pragma unroll
        for (int b = 0; b < 2; ++b)
#pragma unroll
            for (int m = 0; m < 4; ++m)
#pragma unroll
                for (int n = 0; n < 2; ++n) acc[a][b][m][n] = (f32x4){0.f, 0.f, 0.f, 0.f};
    typedef int v8i_t __attribute__((ext_vector_type(8)));
    bf16x8 At[4][2], B0[2][2], B1[2][2]; v8i_t At8[4], B08[2], B18[2];
    int sc8 = 0x7f7f7f7f; asm volatile("" : "+v"(sc8));
    const char* cA = cur.a; const char* cB = cur.b;
    unsigned vA0[2], vA1[2], nA0[2], nA1[2];
    if constexpr (GATHER) { const int* rw = S.rows(cur);
#pragma unroll
        for (int i = 0; i < 2; ++i) { vA0[i] = (unsigned)Sched::rowmap(rw[RA[i]]) * ROWB + (unsigned)CA[i] * 2u; vA1[i] = (unsigned)Sched::rowmap(rw[128 + RA[i]]) * ROWB + (unsigned)CA[i] * 2u; nA0[i] = vA0[i]; nA1[i] = vA1[i]; } }
    else {
#pragma unroll
        for (int i = 0; i < 2; ++i) { vA0[i] = voffA[i]; vA1[i] = voffA[i]; nA0[i] = voffA[i]; nA1[i] = voffA[i]; } }
    cur.par = 0; if constexpr (epi_has_pre<Epi>::value) E.pre(cur, wid, lane);
    PG8_STAGE(PG8_SB(0, 0), cB, voffB); PG8_STAGE(PG8_SB(0, 1), cB + hstepB, voffB); PG8_STAGE(PG8_SA(0, 0), cA, vA0); PG8_STAGE(PG8_SA(0, 1), cA + hstepA, vA1);
    if (wr == 1) PG8_BAR;
    PG8_WAIT_V(2); PG8_BAR;
    PG8_STAGE(PG8_SB(1, 0), cB + kstep, voffB); PG8_STAGE(PG8_SA(1, 0), cA + kstepA, vA0); PG8_STAGE(PG8_SB(1, 1), cB + hstepB + kstep, voffB);
    PG8_WAIT_V(6); PG8_BAR;
    for (;;) {
        const bool has_next = S.next(ui + 1, nxt);
        const char* nA = has_next ? nxt.a : cA; const char* nB = has_next ? nxt.b : cB;
        int ri[4] = {0, 0, 0, 0};
        if constexpr (GATHER) { if (has_next) { const int* rw = S.rows(nxt);
#pragma unroll
            for (int i = 0; i < 4; ++i) { const int* pp = rw + (i >> 1) * 128 + RA[i & 1]; asm volatile("global_load_dword %0, %1, off" : "=v"(ri[i]) : "v"(pp) : "memory"); } } }
#pragma nounroll
        for (int t = 0; t < nt; t += 2) {
            const bool last = (t == nt - 2);
            if constexpr (GATHER) { if (last && has_next) { asm volatile("s_waitcnt vmcnt(8) ; ROWIDX" : "+v"(ri[0]), "+v"(ri[1]), "+v"(ri[2]), "+v"(ri[3]) :: "memory");
#pragma unroll
                for (int i = 0; i < 2; ++i) { nA0[i] = (unsigned)Sched::rowmap(ri[i]) * ROWB + (unsigned)CA[i] * 2u; nA1[i] = (unsigned)Sched::rowmap(ri[2 + i]) * ROWB + (unsigned)CA[i] * 2u; } } }
            const char* a1 = cA + (size_t)(t + 1) * kstepA;
            const char* a2 = last ? nA : cA + (size_t)(t + 2) * kstepA; const char* b2 = last ? nB : cB + (size_t)(t + 2) * kstep;
            const char* a3 = a2 + kstepA; const char* b3 = b2 + kstep;
            unsigned w0[2], w1[2];
#pragma unroll
            for (int i = 0; i < 2; ++i) { w0[i] = last ? nA0[i] : vA0[i]; w1[i] = last ? nA1[i] : vA1[i]; }
            PG8_LDB(B0, 0, 0); PG8_LDB(B1, 0, 1); PG8_SCHED; PG8_LDA(At, 0, 0); PG8_STAGE(PG8_SA(1, 1), a1 + hstepA, vA1);
            PG8_WAIT_V(8); PG8_WAIT_L(0); PG8_BAR; PG8_MMA(0, 0, At, B0); PG8_MMA(0, 1, At, B1); PG8_BAR; PG8_SCHED;
            PG8_LDA(At, 0, 1); PG8_STAGE(PG8_SB(0, 0), b2, voffB); PG8_STAGE(PG8_SB(0, 1), b2 + hstepB, voffB); PG8_STAGE(PG8_SA(0, 0), a2, w0);
            PG8_WAIT_V(8); PG8_WAIT_L(0); PG8_BAR; PG8_MMA(1, 0, At, B0); PG8_MMA(1, 1, At, B1); PG8_BAR; PG8_SCHED;
            PG8_LDB(B0, 1, 0); PG8_LDB(B1, 1, 1); PG8_SCHED; PG8_LDA(At, 1, 0); PG8_STAGE(PG8_SA(0, 1), a2 + hstepA, w1);
            PG8_WAIT_V(8); PG8_WAIT_L(0); PG8_BAR; PG8_MMA(0, 0, At, B0); PG8_MMA(0, 1, At, B1); PG8_BAR; PG8_SCHED;
            PG8_LDA(At, 1, 1); PG8_STAGE(PG8_SB(1, 0), b3, voffB); PG8_STAGE(PG8_SB(1, 1), b3 + hstepB, voffB); PG8_STAGE(PG8_SA(1, 0), a3, w0);
            PG8_WAIT_V(8); PG8_WAIT_L(0); PG8_BAR; PG8_MMA(1, 0, At, B0); PG8_MMA(1, 1, At, B1); PG8_BAR; PG8_SCHED;
        }
        if constexpr (epi_has_pre<Epi>::value) { if (has_next) { nxt.par = (ui + 1) & 1; E.pre(nxt, wid, lane); } }
        if (wr == 0) PG8_BAR;
        if constexpr (FP8) asm volatile("s_nop 15\n\ts_nop 15" ::: "memory");
        E(acc, cur, wr, wc, fr, fq);
        if (!has_next) break;
#pragma unroll
        for (int a = 0; a < 2; ++a)
#pragma unroll
            for (int b = 0; b < 2; ++b)
#pragma unroll
                for (int m = 0; m < 4; ++m)
#pragma unroll
                    for (int n = 0; n < 2; ++n) acc[a][b][m][n] = (f32x4){0.f, 0.f, 0.f, 0.f};
        cur = nxt; cA = nA; cB = nB; ++ui;
#pragma unroll
        for (int i = 0; i < 2; ++i) { vA0[i] = nA0[i]; vA1[i] = nA1[i]; }
        if (wr == 1) PG8_BAR;
    }
    PG8_WAIT_V(0);
    PG8_BAR;
#undef PG8_SA
#undef PG8_SB
#undef PG8_STAGE
#undef PG8_LDA
#undef PG8_LDB
#undef PG8_MMA
#undef PG8_LD32
#undef PG8_WAIT_V
#undef PG8_WAIT_L
#undef PG8_BAR
#undef PG8_SCHED
}
}
namespace attn_body {
using bf16=__hip_bfloat16;
using bf16x8=__attribute__((ext_vector_type(8)))short;
using s16x4=__attribute__((ext_vector_type(4)))short;
using f32x16=__attribute__((ext_vector_type(16)))float;
using u32x4=__attribute__((ext_vector_type(4)))unsigned;
constexpr int BATCH=16,NHEAD=16,SEQ=2048,D=64,DM=NHEAD*D;
constexpr int NW=8,QBLK=32,QB=QBLK*NW,KVBLK=64,NQB=SEQ/QB;
constexpr int ATTN_PITCH=DM, ATTN_UNIT_ROWS=QB;
__device__ __forceinline__ int crow(int r,int hi){return (r&3)+8*(r>>2)+4*hi;}
#define SBAR() __builtin_amdgcn_sched_barrier(0)
__device__ __forceinline__ void cmask(f32x16&p0,f32x16&p1,int jb,int qrel,int hi){
  const float NEG=-INFINITY; int kb=64*jb+4*hi;
  #pragma unroll
  for(int r=0;r<16;++r){int kv=kb+(r&3)+8*(r>>2); if(kv>qrel)p0[r]=NEG; if(kv+32>qrel)p1[r]=NEG;}
}

constexpr int NSLOT=3, SLOTB=8192;
constexpr int LDS_K=0, LDS_V=NSLOT*SLOTB, LDS_WS=2*NSLOT*SLOTB, LDS_OST=LDS_WS+NW*64*4, LDS_BYTES=LDS_OST+NW*4096;
constexpr float C2=0.125f*1.4426950408889634f;
__device__ __forceinline__ void glds16(const void*gsrc,unsigned lds_dst){unsigned keep;
  asm volatile("s_mov_b32 %0, m0\n\ts_mov_b32 m0, %2\n\ts_nop 0\n\tglobal_load_lds_dwordx4 %1, off\n\ts_mov_b32 m0, %0":"=&s"(keep):"v"(gsrc),"s"(lds_dst):"memory");}
__device__ __forceinline__ float max3f(float a,float b,float c){float r;asm("v_max3_f32 %0, %1, %2, %3":"=v"(r):"v"(a),"v"(b),"v"(c));return r;}
__device__ __forceinline__ float max2f(float a,float b){float r;asm("v_max_f32_e32 %0, %1, %2":"=v"(r):"v"(a),"v"(b));return r;}
__device__ __forceinline__ float fadd_s(float a,float b){float r;asm("v_add_f32_e32 %0, %1, %2":"=v"(r):"v"(a),"v"(b));return r;}
__device__ __forceinline__ float fsub_s(float a,float b){float r;asm("v_sub_f32_e32 %0, %1, %2":"=v"(r):"v"(a),"v"(b));return r;}
typedef float f32x2_t __attribute__((ext_vector_type(2))); typedef __bf16 bf16x2_t __attribute__((ext_vector_type(2)));
__device__ __forceinline__ unsigned cvtpk_s(float lo,float hi){f32x2_t v={lo,hi};bf16x2_t b=__builtin_convertvector(v,bf16x2_t);return __builtin_bit_cast(unsigned,b);}
#define WAIT_BAR(N) asm volatile("s_waitcnt vmcnt(" #N ") lgkmcnt(0)\n\ts_barrier":::"memory")

__device__ __forceinline__ void qkt(f32x16&p0,f32x16&p1,const char*Kslot,const bf16x8*qr,const f32x16&negm,int r32,int hi){
  const char*kb=Kslot+hi*1024+r32*16;
  #pragma unroll
  for(int d0=0;d0<4;++d0){
    const bf16x8 b0=*reinterpret_cast<const bf16x8*>(kb+d0*2048);
    const bf16x8 b1=*reinterpret_cast<const bf16x8*>(kb+d0*2048+512);
    if(d0==0){p0=__builtin_amdgcn_mfma_f32_32x32x16_bf16(b0,qr[0],negm,0,0,0);p1=__builtin_amdgcn_mfma_f32_32x32x16_bf16(b1,qr[0],negm,0,0,0);}
    else{p0=__builtin_amdgcn_mfma_f32_32x32x16_bf16(b0,qr[d0],p0,0,0,0);p1=__builtin_amdgcn_mfma_f32_32x32x16_bf16(b1,qr[d0],p1,0,0,0);}}
}
typedef __attribute__((address_space(3))) const char* lds_cptr;
typedef short v4i16_t __attribute__((ext_vector_type(4)));
__device__ __forceinline__ void kload8(bf16x8*kf,lds_cptr kp){
  kf[0]=*(const __attribute__((address_space(3))) bf16x8*)(kp);      kf[1]=*(const __attribute__((address_space(3))) bf16x8*)(kp+512);
  kf[2]=*(const __attribute__((address_space(3))) bf16x8*)(kp+2048); kf[3]=*(const __attribute__((address_space(3))) bf16x8*)(kp+2560);
  kf[4]=*(const __attribute__((address_space(3))) bf16x8*)(kp+4096); kf[5]=*(const __attribute__((address_space(3))) bf16x8*)(kp+4608);
  kf[6]=*(const __attribute__((address_space(3))) bf16x8*)(kp+6144); kf[7]=*(const __attribute__((address_space(3))) bf16x8*)(kp+6656);
}
__device__ __forceinline__ void kload2(bf16x8*kf,lds_cptr kp,int j){ kf[2*j]=*(const __attribute__((address_space(3))) bf16x8*)(kp+j*2048); kf[2*j+1]=*(const __attribute__((address_space(3))) bf16x8*)(kp+j*2048+512); }
__device__ __forceinline__ s16x4 vtr(lds_cptr p){ return __builtin_bit_cast(s16x4,__builtin_amdgcn_ds_read_tr16_b64_v4i16((__attribute__((address_space(3))) v4i16_t*)p)); }
__device__ __forceinline__ float rowmax(const f32x16&p0,const f32x16&p1){
  float a=max3f(p0[0],p0[1],p1[0]),b=max3f(p0[2],p0[3],p1[1]);a=max3f(a,p1[2],p1[3]);
  #pragma unroll
  for(int r=4;r<16;r+=4){a=max3f(a,p0[r],p0[r+1]);b=max3f(b,p0[r+2],p0[r+3]);a=max3f(a,p1[r],p1[r+1]);b=max3f(b,p1[r+2],p1[r+3]);}
  const float m=max2f(a,b);
  auto rr=__builtin_amdgcn_permlane32_swap(__float_as_uint(m),__float_as_uint(m),false,false);
  return max2f(__uint_as_float(rr[0]),__uint_as_float(rr[1]));
}
__device__ __forceinline__ void pv(f32x16*o,int vb,bf16x8 pa0,bf16x8 pa1,bf16x8 pa2,bf16x8 pa3){
  #pragma unroll
  for(int d0=0;d0<2;++d0){s16x4 lo[4],hi[4];
    #pragma unroll
    for(int ks=0;ks<4;++ks){
      asm volatile("ds_read_b64_tr_b16 %0,%1 offset:%c2":"=&v"(lo[ks]):"v"(vb),"i"(d0*4096+ks*1024):"memory");
      asm volatile("ds_read_b64_tr_b16 %0,%1 offset:%c2":"=&v"(hi[ks]):"v"(vb),"i"(d0*4096+ks*1024+512):"memory");}
    asm volatile("s_waitcnt lgkmcnt(0)":::"memory");SBAR();
    #define PK(k) (bf16x8){lo[k][0],lo[k][1],lo[k][2],lo[k][3],hi[k][0],hi[k][1],hi[k][2],hi[k][3]}
    o[d0]=__builtin_amdgcn_mfma_f32_32x32x16_bf16(pa0,PK(0),o[d0],0,0,0);
    o[d0]=__builtin_amdgcn_mfma_f32_32x32x16_bf16(pa1,PK(1),o[d0],0,0,0);
    o[d0]=__builtin_amdgcn_mfma_f32_32x32x16_bf16(pa2,PK(2),o[d0],0,0,0);
    o[d0]=__builtin_amdgcn_mfma_f32_32x32x16_bf16(pa3,PK(3),o[d0],0,0,0);
    #undef PK
  }
}

#ifndef ATTN_STORE16
#define ATTN_STORE16(p,v) (*(u32x4*)(p)=(v))
#endif
template<int THRL> __device__ __forceinline__ void attn_unit(int b,int h,int qb,const bf16*Q,const bf16*__restrict__ K,const bf16*__restrict__ V,bf16*O,char*shm){
  const int tid=threadIdx.x,lane=tid&63,r32=lane&31,hi=lane>>5; const int wid=__builtin_amdgcn_readfirstlane(tid>>6);
  const long rowbase=(long)b*SEQ; const int q0=qb*QB;
  const bf16*Qw=Q+(rowbase+q0+wid*QBLK)*DM+h*D;
  const bf16*Kh=K+rowbase*DM+h*D,*Vh=V+rowbase*DM+h*D;
  const unsigned lds0=(unsigned)(uintptr_t)shm;
  float*wsf=(float*)(shm+LDS_WS)+wid*64;
  const bf16*ksrc=Kh+(long)lane*DM+wid*8;
  const bf16*vsrc=Vh+(long)(16*(wid&3)+(lane>>2))*DM+(wid>>2)*32+(lane&3)*8;
  const unsigned kdst=lds0+LDS_K+wid*1024, vdst=lds0+LDS_V+wid*1024;
  #define DMA_K(t,slot) glds16(ksrc+(long)(t)*KVBLK*DM,(unsigned)__builtin_amdgcn_readfirstlane(kdst+(slot)))
  #define DMA_V(t,slot) glds16(vsrc+(long)(t)*KVBLK*DM,(unsigned)__builtin_amdgcn_readfirstlane(vdst+(slot)))
  const int vb0=(int)(lds0+LDS_V)+((lane>>4)&1)*32+(lane&3)*8+(4*hi+((lane&15)>>2))*64;
  const char*Kbase=shm+LDS_K; bf16x8 kf[8];
  const lds_cptr shm3=(lds_cptr)shm; const lds_cptr kp0=shm3+LDS_K+hi*1024+r32*16; const lds_cptr vp0=shm3+LDS_V+((lane>>4)&1)*32+(lane&3)*8+(4*hi+((lane&15)>>2))*64;
  const int NT=(q0+QB)/KVBLK;
  DMA_K(0,0);DMA_V(0,0);DMA_K(1,SLOTB);
  bf16x8 qr[4];
  #pragma unroll
  for(int d0=0;d0<4;++d0)qr[d0]=*reinterpret_cast<const bf16x8*>(&Qw[(long)r32*DM+d0*16+hi*8]);
  float mhat=0.f,l_reg=0.f;f32x16 o[2];o[0]=f32x16{};o[1]=f32x16{};f32x16 negm=f32x16{};asm volatile("":"+v"(negm));
  const int qrel=wid*QBLK+r32;
  #define CMASK(P0,P1,t) do{int jb_=(t)-(NT-4); if(jb_>=0)cmask(P0,P1,jb_,qrel,hi);}while(0)
  bool resc=false;
  #define START(P0,P1) do{ const float rm=rowmax(P0,P1); resc=false; \
    { const float dl=rm; mhat=fadd_s(mhat,dl); \
      _Pragma("unroll") for(int r=0;r<16;++r){P0[r]=fsub_s(P0[r],dl);P1[r]=fsub_s(P1[r],dl);} \
      _Pragma("unroll") for(int r=0;r<16;++r)negm[r]=-mhat; asm volatile("":"+v"(negm)); } \
    _Pragma("unroll") for(int r=0;r<16;++r)P0[r]=__builtin_amdgcn_exp2f(P0[r]); }while(0)
  #define RESC() do{ if(resc){ asm volatile("s_waitcnt lgkmcnt(0)":::"memory"); \
      _Pragma("unroll") for(int d_=0;d_<2;++d_) _Pragma("unroll") for(int r=0;r<16;++r)o[d_][r]*=wsf[crow(r,hi)]; } }while(0)
  f32x16 pA0,pA1,pB0,pB1;
  int sl_prev=0,sl_cur=0,sl_next=SLOTB;
  #define ROT() do{sl_prev=sl_cur;sl_cur=sl_next;sl_next=(sl_next==(NSLOT-1)*SLOTB)?0:sl_next+SLOTB;}while(0)
  DMA_K(2,2*SLOTB);
  WAIT_BAR(3);
  qkt(pA0,pA1,Kbase,qr,negm,r32,hi);asm volatile("s_nop 15\n\ts_nop 7":"+v"(pA0),"+v"(pA1));CMASK(pA0,pA1,0);
  START(pA0,pA1);
  _Pragma("unroll") for(int r=0;r<16;++r)pA1[r]=__builtin_amdgcn_exp2f(pA1[r]);
  WAIT_BAR(0);
  DMA_K(3,0);DMA_V(1,SLOTB);
  ROT();
  kload8(kf,kp0+sl_cur);
  WAIT_BAR(2);
  s16x4 vlo[8],vhi[8]; u32x4 pw0,pw1,pw2,pw3;
  #define PKW(P,B) cvtpk_s(P[B],P[B+1])
  #define PAF(k) __builtin_bit_cast(bf16x8,pw##k)
  #define VFR(i) (bf16x8){vlo[i][0],vlo[i][1],vlo[i][2],vlo[i][3],vhi[i][0],vhi[i][1],vhi[i][2],vhi[i][3]}
  #define PIN(x) asm volatile("":"+v"(x))
  #define MX3(a,b,c) __builtin_fmaxf(__builtin_fmaxf((a),(b)),(c))
  #define GAPA(MF,A0,A1,A2,A3,W0,W1,PW) do{ MF; sacc+=A0; sacc+=A1; sacc+=A2; sacc+=A3; PIN(sacc); W0; W1; PIN(PW); SBAR(); }while(0)
  #define EX(v) __builtin_amdgcn_exp2f(v)
  #define GAPB(MF,X,B) do{ MF; X[B]=EX(X[B]); X[B+1]=EX(X[B+1]); X[B+2]=EX(X[B+2]); X[B+3]=EX(X[B+3]); PIN(X); SBAR(); }while(0)
  #define VRD(i) do{ vlo[i]=vtr(vp_+(((i)>>2)*4096+((i)&3)*1024)); vhi[i]=vtr(vp_+(((i)>>2)*4096+((i)&3)*1024+512)); }while(0)
  #define KRD(G,j) do{ if(G){ kload2(kf,kp0+sl_next,j); SBAR(); } }while(0)
  #define STEP(C0,C1,P0,P1,t,GK,GV,GL) do{ SBAR(); \
    const lds_cptr vp_=vp0+sl_prev; \
    VRD(0); SBAR(); float sacc=(P0[0]+P0[1]); \
    GAPA(C0=__builtin_amdgcn_mfma_f32_32x32x16_bf16(kf[0],qr[0],negm,0,0,0), P0[2],P0[3],P0[4],P0[5],     pw0[0]=PKW(P0,0), pw0[1]=PKW(P0,2), pw0); \
    VRD(4); SBAR(); GAPA(C1=__builtin_amdgcn_mfma_f32_32x32x16_bf16(kf[1],qr[0],negm,0,0,0), P0[6],P0[7],P0[8],P0[9],     pw0[2]=PKW(P0,4), pw0[3]=PKW(P0,6), pw0); \
    VRD(1); SBAR(); GAPA(C0=__builtin_amdgcn_mfma_f32_32x32x16_bf16(kf[2],qr[1],C0,0,0,0),   P0[10],P0[11],P0[12],P0[13], pw1[0]=PKW(P0,8), pw1[1]=PKW(P0,10), pw1); \
    VRD(5); SBAR(); GAPA(C1=__builtin_amdgcn_mfma_f32_32x32x16_bf16(kf[3],qr[1],C1,0,0,0),   P0[14],P0[15],P1[0],P1[1],   pw1[2]=PKW(P0,12),pw1[3]=PKW(P0,14), pw1); \
    VRD(2); SBAR(); GAPA(C0=__builtin_amdgcn_mfma_f32_32x32x16_bf16(kf[4],qr[2],C0,0,0,0),   P1[2],P1[3],P1[4],P1[5],     pw2[0]=PKW(P1,0), pw2[1]=PKW(P1,2), pw2); \
    VRD(6); SBAR(); GAPA(C1=__builtin_amdgcn_mfma_f32_32x32x16_bf16(kf[5],qr[2],C1,0,0,0),   P1[6],P1[7],P1[8],P1[9],     pw2[2]=PKW(P1,4), pw2[3]=PKW(P1,6), pw2); \
    VRD(3); SBAR(); GAPA(C0=__builtin_amdgcn_mfma_f32_32x32x16_bf16(kf[6],qr[3],C0,0,0,0),   P1[10],P1[11],P1[12],P1[13], pw3[0]=PKW(P1,8), pw3[1]=PKW(P1,10), pw3); \
    VRD(7); SBAR(); GAPA(C1=__builtin_amdgcn_mfma_f32_32x32x16_bf16(kf[7],qr[3],C1,0,0,0),   P1[14],P1[15],0.f,0.f,       pw3[2]=PKW(P1,12),pw3[3]=PKW(P1,14), pw3); \
    l_reg+=sacc; \
    if(GK){DMA_K((t)+3,sl_cur);} if(GV){DMA_V((t)+1,sl_next);} \
    CMASK(C0,C1,t); \
    { float a=MX3(C0[0],C0[1],C1[0]),b=MX3(C0[2],C0[3],C1[1]); a=MX3(a,C1[2],C1[3]); \
      _Pragma("unroll") for(int r=4;r<16;r+=4){a=MX3(a,C0[r],C0[r+1]);b=MX3(b,C0[r+2],C0[r+3]);a=MX3(a,C1[r],C1[r+1]);b=MX3(b,C1[r+2],C1[r+3]);} \
      float rm=__builtin_fmaxf(a,b); { auto rr=__builtin_amdgcn_permlane32_swap(__float_as_uint(rm),__float_as_uint(rm),false,false); rm=__builtin_fmaxf(__uint_as_float(rr[0]),__uint_as_float(rr[1])); } \
      resc=false; \
      if(__builtin_expect(__any(rm>(float)THRL),0)){ const float dl=__builtin_fmaxf(rm,0.f); mhat+=dl; \
        _Pragma("unroll") for(int r=0;r<16;++r){C0[r]-=dl;C1[r]-=dl;} \
        _Pragma("unroll") for(int r=0;r<16;++r)negm[r]=-mhat; asm volatile("":"+v"(negm)); \
        const float f=__builtin_amdgcn_exp2f(-dl); l_reg*=f; if(hi==0)wsf[r32]=f; resc=true; } } \
    SBAR(); \
    GAPB(o[0]=__builtin_amdgcn_mfma_f32_32x32x16_bf16(PAF(0),VFR(0),o[0],0,0,0), C0,0); \
    GAPB(o[1]=__builtin_amdgcn_mfma_f32_32x32x16_bf16(PAF(0),VFR(4),o[1],0,0,0), C0,4); \
    KRD(GL,0); GAPB(o[0]=__builtin_amdgcn_mfma_f32_32x32x16_bf16(PAF(1),VFR(1),o[0],0,0,0), C0,8); \
    KRD(GL,1); GAPB(o[1]=__builtin_amdgcn_mfma_f32_32x32x16_bf16(PAF(1),VFR(5),o[1],0,0,0), C0,12); \
    KRD(GL,2); GAPB(o[0]=__builtin_amdgcn_mfma_f32_32x32x16_bf16(PAF(2),VFR(2),o[0],0,0,0), C1,0); \
    KRD(GL,3); GAPB(o[1]=__builtin_amdgcn_mfma_f32_32x32x16_bf16(PAF(2),VFR(6),o[1],0,0,0), C1,4); \
    GAPB(o[0]=__builtin_amdgcn_mfma_f32_32x32x16_bf16(PAF(3),VFR(3),o[0],0,0,0), C1,8); \
    GAPB(o[1]=__builtin_amdgcn_mfma_f32_32x32x16_bf16(PAF(3),VFR(7),o[1],0,0,0), C1,12); \
    }while(0)
  int t=1;
  #undef CMASK
  #define CMASK(P0,P1,t) do{}while(0)
  for(;t+5<NT;t+=2){
    STEP(pB0,pB1,pA0,pA1,t,true,true,true);     WAIT_BAR(2); RESC(); ROT();
    STEP(pA0,pA1,pB0,pB1,t+1,true,true,true);   WAIT_BAR(2); RESC(); ROT();
  }
  #undef CMASK
  #define CMASK(P0,P1,t) do{int jb_=(t)-(NT-4); if(jb_>=0)cmask(P0,P1,jb_,qrel,hi);}while(0)
  #define ENDW(tt) do{ if((tt)+3<NT){WAIT_BAR(2);} else if((tt)+2<NT){WAIT_BAR(1);} else {WAIT_BAR(0);} }while(0)
  for(;t+1<NT;t+=2){
    STEP(pB0,pB1,pA0,pA1,t,(t+3<NT),(t+1<NT),(t+1<NT));       ENDW(t);   RESC(); ROT();
    STEP(pA0,pA1,pB0,pB1,t+1,(t+4<NT),(t+2<NT),(t+2<NT));     ENDW(t+1); RESC(); ROT();
  }
  STEP(pB0,pB1,pA0,pA1,NT-1,false,false,false); RESC();
  { float sacc=pB0[0]+pB0[1]; _Pragma("unroll") for(int r=2;r<16;++r)sacc+=pB0[r]; _Pragma("unroll") for(int r=0;r<16;++r)sacc+=pB1[r]; l_reg+=sacc;
    pw0=(u32x4){PKW(pB0,0),PKW(pB0,2),PKW(pB0,4),PKW(pB0,6)};pw1=(u32x4){PKW(pB0,8),PKW(pB0,10),PKW(pB0,12),PKW(pB0,14)};pw2=(u32x4){PKW(pB1,0),PKW(pB1,2),PKW(pB1,4),PKW(pB1,6)};pw3=(u32x4){PKW(pB1,8),PKW(pB1,10),PKW(pB1,12),PKW(pB1,14)};
    SBAR(); pv(o,vb0+sl_cur,PAF(0),PAF(1),PAF(2),PAF(3)); }
  #undef PKW
  #undef PAF
  #undef VFR
  #undef PIN
  #undef MX3
  #undef GAPA
  #undef GAPB
  #undef EX
  #undef VRD
  #undef KRD
  #undef STEP
  #undef ENDW
  {auto rr=__builtin_amdgcn_permlane32_swap(__float_as_uint(l_reg),__float_as_uint(l_reg),false,false);l_reg=__uint_as_float(rr[0])+__uint_as_float(rr[1]);}
  if(hi==0)wsf[32+r32]=l_reg;asm volatile("s_waitcnt lgkmcnt(0)":::"memory");
  float rli[16];
  #pragma unroll
  for(int r=0;r<16;++r)rli[r]=__builtin_amdgcn_rcpf(wsf[32+crow(r,hi)]);
  bf16*Ow=O+(rowbase+q0+wid*QBLK)*DM+h*D;
  { bf16*stg=(bf16*)(shm+LDS_OST)+wid*2048;
    #pragma unroll
    for(int r=0;r<16;++r){const int orow=crow(r,hi);
      #pragma unroll
      for(int d0=0;d0<2;++d0)stg[orow*64+d0*32+r32]=__float2bfloat16(o[d0][r]*rli[r]);}
    asm volatile("s_waitcnt lgkmcnt(0)":::"memory");
    #pragma unroll
    for(int i=0;i<4;++i){const int row=i*8+(lane>>3),ch=lane&7; const u32x4 v=*(const u32x4*)(stg+row*64+ch*8); ATTN_STORE16(Ow+(long)row*DM+ch*8,v);} }
  asm volatile("s_waitcnt lgkmcnt(0)\n\ts_barrier":::"memory");
  #undef DMA_K
  #undef DMA_V
  #undef CMASK
  #undef START
  #undef RESC
  #undef ROT
}
constexpr int ATTN_LDS_BYTES=LDS_BYTES;
struct AttnTensors { const bf16* Q; const bf16* K; const bf16* V; bf16* O; };
struct AttnUnit { int bh; int qb; };
struct StaticOrder {
  int vcu;
  __device__ __forceinline__ explicit StaticOrder(int grid,int block):vcu((block%8)*(grid/8)+block/8){}
  __device__ __forceinline__ bool next(int i,AttnUnit&u)const{ if(i>=8)return false; const int pr=vcu&3; u.bh=(vcu>>2)*4+(i&3); u.qb=(i==0)?pr:(i==1)?pr:(i==2)?pr:(i==3)?pr:(i==4)?7-pr:(i==5)?7-pr:(i==6)?7-pr:7-pr; return true; }
  __device__ __forceinline__ void a_ready(const AttnUnit&)const{}
  __device__ __forceinline__ void done(const AttnUnit&)const{}
};
template<class Sched,int THRL=8> __device__ __forceinline__ void attn_phase(char*lds,const AttnTensors&T,const Sched&S){
  AttnUnit u;
  for(int i=0;S.next(i,u);++i){ S.a_ready(u); const int vhd=u.bh%NHEAD, hq=vhd>>1, hv=(vhd>>2)*2+(vhd&1);
    attn_unit<THRL>(u.bh/NHEAD,hq,u.qb,T.Q,T.K,T.V+(hv-hq)*D,T.O+(vhd-hq)*D,lds); S.done(u); }
}
#undef SBAR
#undef WAIT_BAR
}
#define XB_TMO      128
#define XB_XCNT(j)  (256  + 64 * (j))
#define XB_XSUB(j)  (1280 + 64 * (j))
#define XB_XGEN(j)  (2304 + 64 * (j))
#define XB_TOP      3328
#define XB_TOPGEN   3392
#define XCD_BAR_WORDS 3456
#define XB_SPIN_CAP (1u << 18)

__device__ __forceinline__ unsigned xb_ld(unsigned* p)              { return __hip_atomic_load(p, __ATOMIC_RELAXED, __HIP_MEMORY_SCOPE_AGENT); }
__device__ __forceinline__ unsigned xb_add(unsigned* p, unsigned v) { return __hip_atomic_fetch_add(p, v, __ATOMIC_RELAXED, __HIP_MEMORY_SCOPE_AGENT); }
__device__ __forceinline__ unsigned xb_xcc_id() { return (unsigned)__builtin_amdgcn_s_getreg((3 << 11) | 20) & 0xFu; }
#define XB_SPIN(cond, bar) do { unsigned _sp = 0; while (cond) { __builtin_amdgcn_s_sleep(1); \
    if ((++_sp & 255u) == 0u) { if (xb_ld(&(bar)[XB_TMO])) break; if (_sp > XB_SPIN_CAP) { atomicAdd(&(bar)[XB_TMO], 1u); break; } } } } while (0)

struct XcdBarrier {
    unsigned* bar; unsigned x;
    volatile LAS unsigned* st;
};

__device__ __forceinline__ XcdBarrier xcd_barrier_post(unsigned* bar, volatile LAS unsigned* st) {
    XcdBarrier b; b.bar = bar; b.x = xb_xcc_id(); b.st = st;
    if (threadIdx.x == 0) (void)xb_add(&bar[XB_XCNT(b.x)], 1u);
    return b;
}
__device__ __forceinline__ void xcd_barrier_complete(unsigned* bar, unsigned x, unsigned& nloc, unsigned& nx) {
    const unsigned G = gridDim.x * gridDim.y * gridDim.z;
    unsigned sum, cnt, mine, sp = 0u;
    for (;;) {
        sum = 0u; cnt = 0u; mine = 0u;
#pragma unroll
        for (unsigned j = 0; j < 16; ++j) { const unsigned c = xb_ld(&bar[XB_XCNT(j)]); sum += c; cnt += (c > 0u) ? 1u : 0u; mine = (j == x) ? c : mine; }
        if (sum == G) break;
        __builtin_amdgcn_s_sleep(1);
        if ((++sp & 255u) == 0u) { if (xb_ld(&bar[XB_TMO])) break; if (sp > XB_SPIN_CAP) { atomicAdd(&bar[XB_TMO], 1u); break; } }
    }
    nloc = mine > 0u ? mine : 1u; nx = cnt > 0u ? cnt : 1u;
}

__device__ __forceinline__ void xcd_barrier(const XcdBarrier& b) {
    asm volatile("s_waitcnt vmcnt(0)" ::: "memory");
    __syncthreads();
    if (threadIdx.x == 0) {
        unsigned* bar = b.bar;
        __builtin_amdgcn_s_waitcnt(0);
        unsigned nloc = b.st[0], nx = b.st[1];
        if (nloc == 0u) { xcd_barrier_complete(bar, b.x, nloc, nx); b.st[0] = nloc; b.st[1] = nx; }
        const unsigned old = xb_add(&bar[XB_XSUB(b.x)], 1u);
        const unsigned gen = old / nloc;
        if (old + 1u == (gen + 1u) * nloc) {
            __builtin_amdgcn_fence(__ATOMIC_RELEASE, "agent");
            asm volatile("s_waitcnt vmcnt(0)" ::: "memory");
            const unsigned og = xb_add(&bar[XB_TOP], 1u);
            const unsigned tg = og / nx;
            if (og + 1u == (tg + 1u) * nx) xb_add(&bar[XB_TOPGEN], 1u);
            else XB_SPIN(xb_ld(&bar[XB_TOPGEN]) == tg, bar);
            __builtin_amdgcn_fence(__ATOMIC_ACQUIRE, "agent");
            xb_add(&bar[XB_XGEN(b.x)], 1u);
            asm volatile("s_waitcnt vmcnt(0)" ::: "memory");
        } else {
            XB_SPIN(xb_ld(&bar[XB_XGEN(b.x)]) == gen, bar);
            __builtin_amdgcn_fence(__ATOMIC_ACQUIRE, "agent");
            asm volatile("s_waitcnt vmcnt(0)" ::: "memory");
        }
    }
    __syncthreads();
}

constexpr int NWAVES = 8;
struct Frame { LAS unsigned char* lds; volatile LAS unsigned* MISC; gu32* ctl; int wave, vcu, G; };
__device__ __forceinline__ int opaque_tid() { int t = (int)threadIdx.x; asm volatile("" : "+v"(t)); return t; }
#define FTID ((int)threadIdx.x)
#define FLANE ((int)(threadIdx.x & 63u))
struct Args { const float* in[53]; float* out; unsigned char* ws; int ph_lo, ph_hi, variant, pad; };
#define EPI_ARGS const f32x4 (&acc)[2][2][4][2], const pg8::Unit& u, int wr, int wc, int fr, int fq

__device__ __forceinline__ int maprow(int mode, int n) {
    if (mode == 0) return n;
    if (mode == 1) return (n >> 7) * 256 + (n & 127);
    if (mode == 2) return (n >> 7) * 256 + 128 + (n & 127);
    const int j = n & 1023; return (j >> 7) * 256 + ((n >> 10) << 7) + (j & 127);
}
__device__ __forceinline__ void tr_item(const float* W, int N, bf16* WT, int mode, LAS float* scr, int item, int lane) {
    const int nblk = N >> 5, kb = item / nblk, nb = item - kb * nblk, k0 = 64 * kb, n0 = 32 * nb;
#pragma unroll 8
    for (int i = 0; i < 32; ++i) { const int kk = 2 * i + (lane >> 5); scr[kk * 33 + (lane & 31)] = W[(size_t)(k0 + kk) * N + n0 + (lane & 31)]; }
    LDS_WAIT(); asm volatile("" ::: "memory");
    const int c = lane & 7; const int r0 = maprow(mode, n0);
#pragma unroll
    for (int j = 0; j < 4; ++j) { const int n = (lane >> 3) + 8 * j; const LAS float* s = scr + (8 * c) * 33 + n;
        v4u o; o.x = pk2(s[0 * 33], s[1 * 33]); o.y = pk2(s[2 * 33], s[3 * 33]); o.z = pk2(s[4 * 33], s[5 * 33]); o.w = pk2(s[6 * 33], s[7 * 33]);
        *(GAS v4u*)(WT + (size_t)(r0 + n) * 1024 + k0 + 8 * c) = o; }
    LDS_WAIT(); asm volatile("" ::: "memory");
}
__device__ __forceinline__ unsigned pk4_fp8(float a, float b, float c, float d) {
    a = __builtin_amdgcn_fmed3f(a, -448.f, 448.f); b = __builtin_amdgcn_fmed3f(b, -448.f, 448.f); c = __builtin_amdgcn_fmed3f(c, -448.f, 448.f); d = __builtin_amdgcn_fmed3f(d, -448.f, 448.f);
    int r = __builtin_amdgcn_cvt_pk_fp8_f32(a, b, 0, false); r = __builtin_amdgcn_cvt_pk_fp8_f32(c, d, r, true); return (unsigned)r; }
__device__ __forceinline__ void tr_item8(const float* W, int N, unsigned char* WT, int mode, float scale, LAS float* scr, int item, int lane) {
    const int nblk = N >> 5, kb = item / nblk, nb = item - kb * nblk, k0 = 128 * kb, n0 = 32 * nb;
#pragma unroll 8
    for (int i = 0; i < 64; ++i) { const int kk = 2 * i + (lane >> 5); scr[kk * 33 + (lane & 31)] = W[(size_t)(k0 + kk) * N + n0 + (lane & 31)] * scale; }
    LDS_WAIT(); asm volatile("" ::: "memory");
    const int c = lane & 7; const int r0 = maprow(mode, n0);
#pragma unroll
    for (int j = 0; j < 4; ++j) { const int n = (lane >> 3) + 8 * j; const LAS float* p = scr + (16 * c) * 33 + n;
        v4u o; o.x = pk4_fp8(p[0 * 33], p[1 * 33], p[2 * 33], p[3 * 33]); o.y = pk4_fp8(p[4 * 33], p[5 * 33], p[6 * 33], p[7 * 33]);
        o.z = pk4_fp8(p[8 * 33], p[9 * 33], p[10 * 33], p[11 * 33]); o.w = pk4_fp8(p[12 * 33], p[13 * 33], p[14 * 33], p[15 * 33]);
        *(GAS v4u*)(WT + (size_t)(r0 + n) * 1024 + k0 + 16 * c) = o; }
    LDS_WAIT(); asm volatile("" ::: "memory");
}
__device__ __forceinline__ void cvt_plain(const float* src, bf16* dst, size_t n, size_t gtid, size_t nth) {
    for (size_t i = gtid * 8; i < n; i += nth * 8) { const f32x4 a = *(const GAS f32x4*)(src + i), b = *(const GAS f32x4*)(src + i + 4);
        v4u o; o.x = pk2(a.x, a.y); o.y = pk2(a.z, a.w); o.z = pk2(b.x, b.y); o.w = pk2(b.z, b.w); *(GAS v4u*)(dst + i) = o; }
}
__device__ __forceinline__ void cvt_experts(Frame& F, const float* wup, const float* wdn, unsigned char* ws) {
    const int gw = F.vcu * NWAVES + F.wave, NGW = F.G * NWAVES;
#if MOE_FP8
    LAS float* tl = (LAS float*)F.lds;
    for (int it = F.vcu; it < NEXP * 96; it += F.G) { const int e = it / 96, r = it - e * 96; const bool up = r < 64; const int rr = up ? r : r - 64;
        const int N = up ? 2048 : 1024, nb = up ? (rr & 7) : (rr & 3), kb = up ? (rr >> 3) : (rr >> 2), k0 = 128 * kb, n0 = 256 * nb;
        const float* W = up ? wup + (size_t)e * 1024 * 2048 : wdn + (size_t)e * 1024 * 1024; unsigned char* WT = up ? ws + WS_WUP8 + (size_t)e * 2048 * 1024 : ws + WS_WDN8 + (size_t)e * 1024 * 1024;
        const float scale = up ? SWU8 : SWD8; const int mode = up ? 3 : 0;
        __syncthreads();
        f32x4 v[16];
#pragma unroll
        for (int i = 0; i < 16; ++i) { const int idx = i * 512 + FTID, row = idx >> 6, c4 = idx & 63; v[i] = *(const GAS f32x4*)(W + (size_t)(k0 + row) * N + n0 + 4 * c4); }
#pragma unroll
        for (int i = 0; i < 16; ++i) { const int idx = i * 512 + FTID, row = idx >> 6, c4 = idx & 63; *(LAS f32x4*)(tl + row * 260 + 4 * (c4 ^ (row >> 4))) = v[i] * scale; }
        __syncthreads();
#pragma unroll
        for (int j = 0; j < 4; ++j) { const int idx = j * 512 + FTID, n = idx >> 3, c = idx & 7; const LAS float* p = tl + (16 * c) * 260 + (n ^ (4 * c));
            v4u o; o.x = pk4_fp8(p[0 * 260], p[1 * 260], p[2 * 260], p[3 * 260]); o.y = pk4_fp8(p[4 * 260], p[5 * 260], p[6 * 260], p[7 * 260]);
            o.z = pk4_fp8(p[8 * 260], p[9 * 260], p[10 * 260], p[11 * 260]); o.w = pk4_fp8(p[12 * 260], p[13 * 260], p[14 * 260], p[15 * 260]);
            *(GAS v4u*)(WT + (size_t)maprow(mode, n0 + n) * 1024 + k0 + 16 * c) = o; }
    }
    __syncthreads();
    return;
#endif
    LAS float* scr = (LAS float*)(F.lds + F.wave * 16384);
    for (int it = gw; it < NEXP * 1536; it += NGW) { const int e = it / 1536, r = it - e * 1536;
        if (r < 1024) tr_item(wup + (size_t)e * 1024 * 2048, 2048, (bf16*)(ws + WS_WUP) + (size_t)e * 2048 * 1024, 3, scr, r, FLANE);
        else tr_item(wdn + (size_t)e * 1024 * 1024, 1024, (bf16*)(ws + WS_WDN) + (size_t)e * 1024 * 1024, 0, scr, r - 1024, FLANE); }
}
__device__ __forceinline__ void p0_prologue(Frame& F, const Args& a) {
    unsigned char* ws = a.ws;
    LAS float* scr = (LAS float*)(F.lds + F.wave * 16896);
    const int gw = F.vcu * NWAVES + F.wave, NGW = F.G * NWAVES;
    constexpr int I0 = 16 * 64, I1 = I0 + 16 * 80, I2 = I1 + 512, I3 = I2 + 512, I4 = I3 + 512, I5 = I4 + 256, I6 = I5 + 256, I7 = I6 + 256, I8 = I7 + 16, I9 = I8 + 16;
    for (int it = gw; it < I9; it += NGW) {
        if (it < I0) tr_item(a.in[2], 2048, (bf16*)(ws + WS_WKV), 0, scr, it, FLANE);
        else if (it < I1) tr_item(a.in[3], 2560, (bf16*)(ws + WS_WIN0), 0, scr, it - I0, FLANE);
        else if (it < I2) tr_item(a.in[13], 1024, (bf16*)(ws + WS_WOUT0), 0, scr, it - I1, FLANE);
        else if (it < I3) tr_item(a.in[17], 1024, (bf16*)(ws + WS_XOT), 0, scr, it - I2, FLANE);
        else if (it < I4) tr_item(a.in[42], 1024, (bf16*)(ws + WS_XOT) + 1024 * 1024, 0, scr, it - I3, FLANE);
        else if (it < I5) tr_item8(a.in[28], 1024, ws + WS_WIN1, 0, SWU8, scr, it - I4, FLANE);
        else if (it < I6) tr_item8(a.in[37], 1024, ws + WS_WVG, 1, SWD8, scr, it - I5, FLANE);
        else if (it < I7) tr_item8(a.in[38], 1024, ws + WS_WVG, 2, SWU8, scr, it - I6, FLANE);
        else if (it < I8) tr_item(a.in[20], 32, (bf16*)(ws + WS_WR), 0, scr, it - I7, FLANE);
        else tr_item(a.in[45], 32, (bf16*)(ws + WS_WR) + 256 * 1024, 0, scr, it - I8, FLANE);
    }
    cvt_experts(F, a.in[22], a.in[24], ws);
    const size_t gtid = (size_t)F.vcu * 512 + FTID, nth = (size_t)F.G * 512;
    cvt_plain(a.in[16], (bf16*)(ws + WS_XQB), 1024 * 1024, gtid, nth);
    cvt_plain(a.in[41], (bf16*)(ws + WS_XQB) + 1024 * 1024, 1024 * 1024, gtid, nth);
    cvt_plain(a.in[1], (bf16*)(ws + WS_MEMB), (size_t)NB * MEMLEN * DM, gtid, nth);
    cvt_plain(a.in[0], (bf16*)(ws + WS_XB), (size_t)MTOK * DM, gtid, nth);
}

__device__ __forceinline__ void moe_tables(Frame& F, gu32* cnt) {
    LAS int* tab = (LAS int*)(F.lds + TAB_OFF);
    if (FTID < 32) tab[FTID] = (int)__hip_atomic_load(cnt + FTID * 64, RLX_AGENT);
    __syncthreads();
    if (FTID == 0) { int s = 0; for (int e = 0; e < NEXP; ++e) { tab[32 + e] = s; s += (tab[e] + 255) >> 8; } tab[64] = s; }
    __syncthreads();
}

template <int MODE>
__device__ __forceinline__ void ph_ln(Frame& F, const bf16* zb, const bf16* ys, bf16* xb, float* outf, const float* g, const float* b, unsigned char* x8 = nullptr, const int* asg = nullptr, const float* gate = nullptr,
                                      const float* st2 = nullptr, const float* g2 = nullptr, const float* b2 = nullptr) {
    LAS const int* tab = (LAS const int*)(F.lds + TAB_OFF);
    const int gw = F.vcu * NWAVES + F.wave, NGW = F.G * NWAVES, c0 = 8 * FLANE;
    float gv[16], bv[16];
#pragma unroll
    for (int h = 0; h < 2; ++h)
#pragma unroll
        for (int q = 0; q < 2; ++q) { const f32x4 t = *(const GAS f32x4*)(g + c0 + 512 * h + 4 * q), s = *(const GAS f32x4*)(b + c0 + 512 * h + 4 * q);
            gv[8 * h + 4 * q + 0] = t.x; gv[8 * h + 4 * q + 1] = t.y; gv[8 * h + 4 * q + 2] = t.z; gv[8 * h + 4 * q + 3] = t.w;
            bv[8 * h + 4 * q + 0] = s.x; bv[8 * h + 4 * q + 1] = s.y; bv[8 * h + 4 * q + 2] = s.z; bv[8 * h + 4 * q + 3] = s.w; }
    constexpr bool REB = (MODE == 1) && MOE_FP8; float g2v[REB ? 16 : 1], b2v[REB ? 16 : 1];
    if constexpr (REB) {
#pragma unroll
        for (int h = 0; h < 2; ++h)
#pragma unroll
            for (int q = 0; q < 2; ++q) { const f32x4 t = *(const GAS f32x4*)(g2 + c0 + 512 * h + 4 * q), s = *(const GAS f32x4*)(b2 + c0 + 512 * h + 4 * q);
#pragma unroll
                for (int j = 0; j < 4; ++j) { g2v[8 * h + 4 * q + j] = ALPHA * t[j]; b2v[8 * h + 4 * q + j] = ALPHA * s[j]; } } }
    constexpr int RI = (MODE == 0) ? 4 : 2;
    for (int m0 = gw * RI; m0 < MTOK; m0 += NGW * RI) {
        v4u raw[RI][2]; v4u yr[(MODE == 1) ? RI : 1][2][4]; f32x4 gt[(MODE == 1) ? RI : 1]; f32x2 ms[RI];
#pragma unroll
        for (int r = 0; r < RI; ++r) { const size_t m = (size_t)(m0 + r); size_t yrow[4] = {0, 0, 0, 0};
            if constexpr (REB) ms[r] = *(const GAS f32x2*)(st2 + m * 2);
            if (MODE == 1) { const v4i_t as = *(const GAS v4i_t*)(asg + m * 4); gt[r] = *(const GAS f32x4*)(gate + m * 4);
#pragma unroll
                for (int k = 0; k < 4; ++k) yrow[k] = (size_t)(tab[32 + (as[k] >> 16)] * 256 + (as[k] & 0xffff)); }
#pragma unroll
            for (int h = 0; h < 2; ++h) {
                raw[r][h] = *(const GAS v4u*)(((MODE == 0 || REB) ? zb : xb) + m * DM + c0 + 512 * h);
                if (MODE == 1) {
#pragma unroll
                    for (int k = 0; k < 4; ++k) { const v2u t8 = *(const GAS v2u*)((const unsigned char*)ys + yrow[k] * DM + c0 + 512 * h); yr[r][h][k] = (v4u){t8.x, t8.y, 0u, 0u}; } } } }
#pragma unroll
        for (int r = 0; r < RI; ++r) { const size_t m = (size_t)(m0 + r);
            float v[16];
#pragma unroll
            for (int h = 0; h < 2; ++h) { const v4u w = raw[r][h]; const float sc = (MODE == 0) ? 1.0f : ALPHA;
                v[8 * h + 0] = sc * bflo(w.x); v[8 * h + 1] = sc * bfhi(w.x); v[8 * h + 2] = sc * bflo(w.y); v[8 * h + 3] = sc * bfhi(w.y); v[8 * h + 4] = sc * bflo(w.z); v[8 * h + 5] = sc * bfhi(w.z); v[8 * h + 6] = sc * bflo(w.w); v[8 * h + 7] = sc * bfhi(w.w);
                if constexpr (REB) { const float mu2 = ms[r][0] * ALPHA, rs2 = ms[r][1];
#pragma unroll
                    for (int j = 0; j < 8; ++j) v[8 * h + j] = (v[8 * h + j] - mu2) * rs2 * g2v[8 * h + j] * (1.0f / ALPHA) + b2v[8 * h + j]; }
                if (MODE == 1) {
#pragma unroll
                    for (int k = 0; k < 4; ++k) { const v4u y = yr[r][h][k]; const float gk = gt[r][k] * (1.0f / SY8);
                        const f32x2 p0 = __builtin_amdgcn_cvt_pk_f32_fp8((int)y.x, false), p1 = __builtin_amdgcn_cvt_pk_f32_fp8((int)y.x, true), p2 = __builtin_amdgcn_cvt_pk_f32_fp8((int)y.y, false), p3 = __builtin_amdgcn_cvt_pk_f32_fp8((int)y.y, true);
                        v[8 * h + 0] += gk * p0[0]; v[8 * h + 1] += gk * p0[1]; v[8 * h + 2] += gk * p1[0]; v[8 * h + 3] += gk * p1[1]; v[8 * h + 4] += gk * p2[0]; v[8 * h + 5] += gk * p2[1]; v[8 * h + 6] += gk * p3[0]; v[8 * h + 7] += gk * p3[1]; } } }
            float s = 0.f;
#pragma unroll
            for (int j = 0; j < 16; ++j) s += v[j];
            const float mean = wave_sum(s) * (1.f / DM); float s2 = 0.f;
#pragma unroll
            for (int j = 0; j < 16; ++j) { v[j] -= mean; s2 += v[j] * v[j]; }
            const float rstd = 1.f / sqrtf(wave_sum(s2) * (1.f / DM) + LN_EPS);
#pragma unroll
            for (int j = 0; j < 16; ++j) v[j] = v[j] * rstd * gv[j] + bv[j];
#pragma unroll
            for (int h = 0; h < 2; ++h) { v4u o; o.x = pk2(v[8 * h], v[8 * h + 1]); o.y = pk2(v[8 * h + 2], v[8 * h + 3]); o.z = pk2(v[8 * h + 4], v[8 * h + 5]); o.w = pk2(v[8 * h + 6], v[8 * h + 7]);
                if (!outf) *(GAS v4u*)(xb + m * DM + c0 + 512 * h) = o;
                if (x8) { v2u o8; o8.x = pk4_fp8(v[8 * h] * SX8, v[8 * h + 1] * SX8, v[8 * h + 2] * SX8, v[8 * h + 3] * SX8); o8.y = pk4_fp8(v[8 * h + 4] * SX8, v[8 * h + 5] * SX8, v[8 * h + 6] * SX8, v[8 * h + 7] * SX8);
                          *(GAS v2u*)(x8 + m * DM + c0 + 512 * h) = o8; }
                if (outf) { *(GAS f32x4*)(outf + m * DM + c0 + 512 * h) = (f32x4){v[8 * h], v[8 * h + 1], v[8 * h + 2], v[8 * h + 3]};
                            *(GAS f32x4*)(outf + m * DM + c0 + 512 * h + 4) = (f32x4){v[8 * h + 4], v[8 * h + 5], v[8 * h + 6], v[8 * h + 7]}; } }
        }
    }
}
__device__ __forceinline__ void ph_ln2_router(Frame& F, const bf16* zb, bf16* xb, unsigned char* x8, const float* g, const float* b, const bf16* wrT, const float* rbias,
                                              gu32* cnt, int* list, float* gate, int* asg, float* st2) {
    LAS int* cl = (LAS int*)F.lds;
    LAS float* gl = (LAS float*)(F.lds + 256);
    LAS bf16* wl = (LAS bf16*)(F.lds + 256 + 8192);
    const int rw = FLANE & 15, q = FLANE >> 4;
    for (int i = FTID; i < 256; i += 512) { ((LAS f32x4*)gl)[i] = *(const GAS f32x4*)(g + 4 * i); ((LAS f32x4*)gl)[256 + i] = *(const GAS f32x4*)(b + 4 * i); }
    for (int i = FTID; i < 4096; i += 512) { const int e = i >> 7, c = i & 127; *(LAS v4u*)(wl + e * 1032 + 8 * c) = *(const GAS v4u*)(wrT + (size_t)e * DM + 8 * c); }
    for (int blk = F.vcu; blk < MTOK / 128; blk += F.G) {
        __syncthreads();
        if (FTID < 64) cl[FTID] = 0;
        __syncthreads();
        const int row = blk * 128 + F.wave * 16 + rw;
        const bf16* zr = zb + (size_t)row * DM + 8 * q;
        v4u zz[32];
#pragma unroll
        for (int ks = 0; ks < 32; ++ks) zz[ks] = *(const GAS v4u*)(zr + 32 * ks);
        float s1 = 0.f, s2 = 0.f;
#pragma unroll
        for (int ks = 0; ks < 32; ++ks) { const v4u w = zz[ks]; const float x0 = bflo(w.x), x1 = bfhi(w.x), x2 = bflo(w.y), x3 = bfhi(w.y), x4 = bflo(w.z), x5 = bfhi(w.z), x6 = bflo(w.w), x7 = bfhi(w.w);
            s1 += ((x0 + x1) + (x2 + x3)) + ((x4 + x5) + (x6 + x7)); s2 += ((x0 * x0 + x1 * x1) + (x2 * x2 + x3 * x3)) + ((x4 * x4 + x5 * x5) + (x6 * x6 + x7 * x7)); }
        s1 += __shfl_xor(s1, 16); s1 += __shfl_xor(s1, 32); s2 += __shfl_xor(s2, 16); s2 += __shfl_xor(s2, 32);
        const float mean = s1 * (1.f / DM), rstd = 1.f / sqrtf(fmaxf(s2 * (1.f / DM) - mean * mean, 0.f) + LN_EPS);
        if (MOE_FP8 && q == 0) { f32x2 ms; ms[0] = mean; ms[1] = rstd; *(GAS f32x2*)(st2 + (size_t)row * 2) = ms; }
        f32x4 acc0 = (f32x4){0.f, 0.f, 0.f, 0.f}, acc1 = (f32x4){0.f, 0.f, 0.f, 0.f};
        bf16* xr = xb + (size_t)row * DM + 8 * q; unsigned char* x8r = x8 + (size_t)row * DM + 8 * q;
        const LAS bf16* w0 = wl + rw * 1032 + 8 * q; const LAS bf16* w1 = wl + (16 + rw) * 1032 + 8 * q;
#pragma unroll
        for (int ks = 0; ks < 32; ++ks) { v4u w = zz[ks]; asm volatile("" : "+v"(w));
            const f32x4 g0 = *(const LAS f32x4*)(gl + 32 * ks + 8 * q), g1 = *(const LAS f32x4*)(gl + 32 * ks + 8 * q + 4), b0 = *(const LAS f32x4*)(gl + 1024 + 32 * ks + 8 * q), b1 = *(const LAS f32x4*)(gl + 1024 + 32 * ks + 8 * q + 4);
            const float y0 = (bflo(w.x) - mean) * rstd * g0[0] + b0[0], y1 = (bfhi(w.x) - mean) * rstd * g0[1] + b0[1], y2 = (bflo(w.y) - mean) * rstd * g0[2] + b0[2], y3 = (bfhi(w.y) - mean) * rstd * g0[3] + b0[3];
            const float y4 = (bflo(w.z) - mean) * rstd * g1[0] + b1[0], y5 = (bfhi(w.z) - mean) * rstd * g1[1] + b1[1], y6 = (bflo(w.w) - mean) * rstd * g1[2] + b1[2], y7 = (bfhi(w.w) - mean) * rstd * g1[3] + b1[3];
            v4u o; o.x = pk2(y0, y1); o.y = pk2(y2, y3); o.z = pk2(y4, y5); o.w = pk2(y6, y7);
            if (!MOE_FP8) *(GAS v4u*)(xr + 32 * ks) = o;
            if (x8) { v2u o8; o8.x = pk4_fp8(y0 * SX8, y1 * SX8, y2 * SX8, y3 * SX8); o8.y = pk4_fp8(y4 * SX8, y5 * SX8, y6 * SX8, y7 * SX8); *(GAS v2u*)(x8r + 32 * ks) = o8; }
            const bf16x8 bfrag = __builtin_bit_cast(bf16x8, o);
            acc0 = __builtin_amdgcn_mfma_f32_16x16x32_bf16(*(const LAS bf16x8*)(w0 + 32 * ks), bfrag, acc0, 0, 0, 0);
            acc1 = __builtin_amdgcn_mfma_f32_16x16x32_bf16(*(const LAS bf16x8*)(w1 + 32 * ks), bfrag, acc1, 0, 0, 0);
            if ((ks & 1) == 1) asm volatile("" ::: "memory"); }
        float lg[8]; const f32x4 rb0 = *(const GAS f32x4*)(rbias + 4 * q), rb1 = *(const GAS f32x4*)(rbias + 16 + 4 * q);
#pragma unroll
        for (int j = 0; j < 4; ++j) { lg[j] = acc0[j] + rb0[j]; lg[4 + j] = acc1[j] + rb1[j]; }
        int idx[4]; float val[4];
#pragma unroll
        for (int k = 0; k < 4; ++k) { float bv = -3.0e38f; int bi = 64;
#pragma unroll
            for (int j = 0; j < 8; ++j) { const int e = (j < 4) ? 4 * q + j : 12 + 4 * q + j; if (lg[j] > bv) { bv = lg[j]; bi = e; } }
#pragma unroll
            for (int o = 16; o <= 32; o <<= 1) { const float pv = __shfl_xor(bv, o); const int pi = __shfl_xor(bi, o); if (pv > bv || (pv == bv && pi < bi)) { bv = pv; bi = pi; } }
            bi &= 31; idx[k] = bi; val[k] = bv;
#pragma unroll
            for (int j = 0; j < 8; ++j) { const int e = (j < 4) ? 4 * q + j : 12 + 4 * q + j; if (e == bi) lg[j] = -3.0e38f; } }
        const float e1 = __builtin_amdgcn_exp2f((val[1] - val[0]) * LOG2E), e2 = __builtin_amdgcn_exp2f((val[2] - val[0]) * LOG2E), e3 = __builtin_amdgcn_exp2f((val[3] - val[0]) * LOG2E);
        const float inv = 1.f / (1.f + e1 + e2 + e3);
        int pos[4] = {0, 0, 0, 0};
        for (int e = 0; e < NEXP; ++e) {
            const int k = (q != 0) ? -1 : (idx[0] == e) ? 0 : (idx[1] == e) ? 1 : (idx[2] == e) ? 2 : (idx[3] == e) ? 3 : -1;
            const unsigned long long mask = __ballot(k >= 0);
            if (mask) { const int n = __popcll(mask), leader = __ffsll((long long)mask) - 1; int bp = 0;
                if (FLANE == leader) bp = __hip_atomic_fetch_add(cl + e, n, __ATOMIC_RELAXED, __HIP_MEMORY_SCOPE_WORKGROUP);
                bp = __shfl(bp, leader);
                const int p = bp + __popcll(mask & ((1ull << FLANE) - 1ull));
                pos[0] = (k == 0) ? p : pos[0]; pos[1] = (k == 1) ? p : pos[1]; pos[2] = (k == 2) ? p : pos[2]; pos[3] = (k == 3) ? p : pos[3]; }
        }
        __syncthreads();
        if (FTID < 32) { const int tot = cl[FTID]; cl[32 + FTID] = tot ? (int)__hip_atomic_fetch_add(cnt + FTID * 64, (unsigned)tot, RLX_AGENT) : 0; }
        __syncthreads();
        if (q == 0) {
            *(GAS f32x4*)(gate + (size_t)row * 4) = (f32x4){inv, e1 * inv, e2 * inv, e3 * inv};
#pragma unroll
            for (int k = 0; k < 4; ++k) { const int pe = cl[32 + idx[k]] + pos[k]; list[(size_t)idx[k] * CAP + pe] = row * 4 + k; pos[k] = (idx[k] << 16) | pe; }
            *(GAS v4i_t*)(asg + (size_t)row * 4) = (v4i_t){pos[0], pos[1], pos[2], pos[3]}; }
    }
}
__device__ __forceinline__ void ph_softmax(Frame& F, const float* sc, bf16* P) {
    const int gw = F.vcu * NWAVES + F.wave, NGW = F.G * NWAVES;
    for (int m = gw; m < MTOK; m += NGW) {
#pragma unroll
        for (int h = 0; h < 4; ++h) { f32x4 v = *(const GAS f32x4*)(sc + (size_t)m * DM + 256 * h + 4 * FLANE);
            const float mx = wave_max(fmaxf(fmaxf(v.x, v.y), fmaxf(v.z, v.w)));
            v.x = __builtin_amdgcn_exp2f(v.x - mx); v.y = __builtin_amdgcn_exp2f(v.y - mx); v.z = __builtin_amdgcn_exp2f(v.z - mx); v.w = __builtin_amdgcn_exp2f(v.w - mx);
            const float inv = 1.f / wave_sum((v.x + v.y) + (v.z + v.w));
            v2u o; o.x = pk2(v.x * inv, v.y * inv); o.y = pk2(v.z * inv, v.w * inv);
            *(GAS v2u*)(P + (size_t)m * DM + 256 * h + 4 * FLANE) = o; }
    }
}
__device__ __forceinline__ void ph_topk(Frame& F, const float* logit, const float* rbias, gu32* cnt, int* list, float* gate) {
    for (int base = F.vcu * 512; base < MTOK; base += F.G * 512) {
        const int m = base + FTID;
        float lg[32];
#pragma unroll
        for (int q = 0; q < 8; ++q) { const f32x4 t = *(const GAS f32x4*)(logit + (size_t)m * 32 + 4 * q), bb = *(const GAS f32x4*)(rbias + 4 * q);
            lg[4 * q] = t.x + bb.x; lg[4 * q + 1] = t.y + bb.y; lg[4 * q + 2] = t.z + bb.z; lg[4 * q + 3] = t.w + bb.w; }
        int idx[4]; float val[4];
#pragma unroll
        for (int k = 0; k < 4; ++k) { float bvv = -3.0e38f; int bi = 0;
#pragma unroll
            for (int e = 0; e < 32; ++e) { const bool taken = (k > 0 && idx[0] == e) || (k > 1 && idx[1] == e) || (k > 2 && idx[2] == e); if (!taken && lg[e] > bvv) { bvv = lg[e]; bi = e; } }
            idx[k] = bi; val[k] = bvv; }
        const float e1 = __builtin_amdgcn_exp2f((val[1] - val[0]) * LOG2E), e2 = __builtin_amdgcn_exp2f((val[2] - val[0]) * LOG2E), e3 = __builtin_amdgcn_exp2f((val[3] - val[0]) * LOG2E);
        const float inv = 1.f / (1.f + e1 + e2 + e3);
        *(GAS f32x4*)(gate + (size_t)m * 4) = (f32x4){inv, e1 * inv, e2 * inv, e3 * inv};
        for (int e = 0; e < NEXP; ++e) {
            const int k = (idx[0] == e) ? 0 : (idx[1] == e) ? 1 : (idx[2] == e) ? 2 : (idx[3] == e) ? 3 : -1;
            const unsigned long long mask = __ballot(k >= 0);
            if (mask) { const int n = __popcll(mask), leader = __ffsll((long long)mask) - 1; unsigned bp = 0;
                if (FLANE == leader) bp = __hip_atomic_fetch_add(cnt + e * 64, (unsigned)n, RLX_AGENT);
                bp = __shfl(bp, leader);
                if (k >= 0) { const int rank = __popcll(mask & ((1ull << FLANE) - 1ull)); list[(size_t)e * CAP + bp + rank] = m * 4 + k; } }
        }
    }
}
__device__ __forceinline__ void ph_sgu(Frame& F, const bf16* hb, bf16* mix, const float* lng, const float* lnb, const float* wsp, const float* bsp) {
    LAS bf16* Wb = (LAS bf16*)F.lds;
    LAS bf16* VT = (LAS bf16*)(F.lds + 34816);
    LAS float* GL = (LAS float*)(F.lds + 69632);
    const int r = FTID >> 2, qq = FTID & 3, n16 = FLANE & 15, q = FLANE >> 4;
    int gcur = -1;
    for (int it = F.vcu; it < 1024; it += F.G) {
        const int g = it & 3, row0 = (it >> 2) * 128;
        if (g != gcur) { __syncthreads(); for (int i = FTID; i < 16384; i += 512) { const int t = i >> 7, s2 = i & 127; Wb[t * 136 + s2] = (bf16)((s2 <= t) ? f2bf(wsp[g * 16384 + i]) : 0u); } gcur = g; }
        { float v[32]; const bf16* src = hb + (size_t)(row0 + r) * DM + 512 + g * 128 + 32 * qq;
#pragma unroll
            for (int j = 0; j < 4; ++j) { const v4u w = *(const GAS v4u*)(src + 8 * j);
                v[8 * j + 0] = bflo(w.x); v[8 * j + 1] = bfhi(w.x); v[8 * j + 2] = bflo(w.y); v[8 * j + 3] = bfhi(w.y); v[8 * j + 4] = bflo(w.z); v[8 * j + 5] = bfhi(w.z); v[8 * j + 6] = bflo(w.w); v[8 * j + 7] = bfhi(w.w); }
            float s = 0.f;
#pragma unroll
            for (int j = 0; j < 32; ++j) s += v[j];
            s += __shfl_xor(s, 1); s += __shfl_xor(s, 2);
            const float mean = s * (1.f / 128.f); float s2 = 0.f;
#pragma unroll
            for (int j = 0; j < 32; ++j) { v[j] -= mean; s2 += v[j] * v[j]; }
            s2 += __shfl_xor(s2, 1); s2 += __shfl_xor(s2, 2);
            const float rstd = 1.f / sqrtf(s2 * (1.f / 128.f) + LN_EPS);
#pragma unroll
            for (int j = 0; j < 8; ++j) { const f32x4 gg = *(const GAS f32x4*)(lng + g * 128 + 32 * qq + 4 * j), bb = *(const GAS f32x4*)(lnb + g * 128 + 32 * qq + 4 * j);
#pragma unroll
                for (int k = 0; k < 4; ++k) VT[(32 * qq + 4 * j + k) * 136 + r] = (bf16)f2bf(v[4 * j + k] * rstd * gg[k] + bb[k]); } }
        __syncthreads();
        { bf16x8 VF[4];
#pragma unroll
            for (int ks = 0; ks < 4; ++ks) VF[ks] = *(const LAS bf16x8*)(VT + (16 * F.wave + n16) * 136 + 32 * ks + 8 * q);
#pragma unroll
            for (int tb = 0; tb < 8; ++tb) { f32x4 acc = (f32x4){0.f, 0.f, 0.f, 0.f};
#pragma unroll
                for (int ks = 0; ks <= (tb >> 1); ++ks) acc = __builtin_amdgcn_mfma_f32_16x16x32_bf16(*(const LAS bf16x8*)(Wb + (16 * tb + n16) * 136 + 32 * ks + 8 * q), VF[ks], acc, 0, 0, 0);
                const f32x4 bt = *(const GAS f32x4*)(bsp + g * 128 + 16 * tb + 4 * q);
#pragma unroll
                for (int k = 0; k < 4; ++k) GL[(16 * tb + 4 * q + k) * 128 + 16 * F.wave + n16] = acc[k] + bt[k]; } }
        __syncthreads();
        { const bf16* usrc = hb + (size_t)(row0 + r) * DM + g * 128 + 32 * qq; bf16* dst = mix + (size_t)(row0 + r) * DM + g * 128 + 32 * qq;
#pragma unroll
            for (int j = 0; j < 4; ++j) { const v4u w = *(const GAS v4u*)(usrc + 8 * j); const f32x4 g0 = *(const LAS f32x4*)(GL + r * 128 + 32 * qq + 8 * j), g1 = *(const LAS f32x4*)(GL + r * 128 + 32 * qq + 8 * j + 4); v4u o;
                o.x = pk2(bflo(w.x) * g0[0], bfhi(w.x) * g0[1]); o.y = pk2(bflo(w.y) * g0[2], bfhi(w.y) * g0[3]); o.z = pk2(bflo(w.z) * g1[0], bfhi(w.z) * g1[1]); o.w = pk2(bflo(w.w) * g1[2], bfhi(w.w) * g1[3]);
                *(GAS v4u*)(dst + 8 * j) = o; } }
    }
}
__device__ __forceinline__ void ph_combine(Frame& F, const bf16* oatt, bf16* mix, const float* lq1, const float* lk1, const float* lq2, const float* lk2, const float* sg) {
    const int gw = F.vcu * NWAVES + F.wave, NGW = F.G * NWAVES;
    const float d1 = wave_sum(lq1[FLANE] * lk1[FLANE]), d2 = wave_sum(lq2[FLANE] * lk2[FLANE]);
    const float lam = expf(d1) - expf(d2) + LAM_INIT0;
    const int h = FLANE >> 4, e0 = 8 * (FLANE & 15);
    float gsc[8];
#pragma unroll
    for (int j = 0; j < 8; ++j) gsc[j] = sg[e0 + j] * (1.0f - LAM_INIT0);
    for (int m0 = gw * 4; m0 < MTOK; m0 += NGW * 4) {
        v4u av[4], bw[4];
#pragma unroll
        for (int r = 0; r < 4; ++r) { av[r] = *(const GAS v4u*)(oatt + (size_t)(m0 + r) * DM + h * 256 + e0); bw[r] = *(const GAS v4u*)(oatt + (size_t)(m0 + r) * DM + h * 256 + 128 + e0); }
#pragma unroll
        for (int r = 0; r < 4; ++r) { const v4u a = av[r], b = bw[r]; const size_t m = (size_t)(m0 + r);
            float o[8];
            o[0] = bflo(a.x) - lam * bflo(b.x); o[1] = bfhi(a.x) - lam * bfhi(b.x); o[2] = bflo(a.y) - lam * bflo(b.y); o[3] = bfhi(a.y) - lam * bfhi(b.y);
            o[4] = bflo(a.z) - lam * bflo(b.z); o[5] = bfhi(a.z) - lam * bfhi(b.z); o[6] = bflo(a.w) - lam * bflo(b.w); o[7] = bfhi(a.w) - lam * bfhi(b.w);
            float s2 = 0.f;
#pragma unroll
            for (int j = 0; j < 8; ++j) s2 += o[j] * o[j];
            s2 += __shfl_xor(s2, 1); s2 += __shfl_xor(s2, 2); s2 += __shfl_xor(s2, 4); s2 += __shfl_xor(s2, 8);
            const float rs = 1.f / sqrtf(s2 * (1.f / 128.f) + LN_EPS);
            v4u w; w.x = pk2(o[0] * rs * gsc[0], o[1] * rs * gsc[1]); w.y = pk2(o[2] * rs * gsc[2], o[3] * rs * gsc[3]); w.z = pk2(o[4] * rs * gsc[4], o[5] * rs * gsc[5]); w.w = pk2(o[6] * rs * gsc[6], o[7] * rs * gsc[7]);
            *(GAS v4u*)(mix + m * DM + 512 + h * 128 + e0) = w; }
    }
}

__device__ __forceinline__ void combine_local(Frame& F, const bf16* oatt, bf16* mix, const float* lq1, const float* lk1, const float* lq2, const float* lk2, const float* sg, int b, int h, int pr) {
    const float d1 = wave_sum(lq1[FLANE] * lk1[FLANE]), d2 = wave_sum(lq2[FLANE] * lk2[FLANE]);
    const float lam = expf(d1) - expf(d2) + LAM_INIT0;
    const int e0 = 8 * (FLANE & 15);
    float gsc[8];
#pragma unroll
    for (int j = 0; j < 8; ++j) gsc[j] = sg[e0 + j] * (1.0f - LAM_INIT0);
    for (int it = 0; it < 16; it += 4) {
        v4u av[4], bw[4]; size_t rows[4];
#pragma unroll
        for (int r = 0; r < 4; ++r) { const int rl = F.wave * 64 + (it + r) * 4 + (FLANE >> 4); rows[r] = (size_t)b * SEQ + (size_t)((rl < 256) ? pr : 7 - pr) * 256 + (rl & 255);
            av[r] = *(const GAS v4u*)(oatt + rows[r] * DM + h * 256 + e0); bw[r] = *(const GAS v4u*)(oatt + rows[r] * DM + h * 256 + 128 + e0); }
#pragma unroll
        for (int r = 0; r < 4; ++r) { const v4u a = av[r], bb = bw[r];
            float o[8];
            o[0] = bflo(a.x) - lam * bflo(bb.x); o[1] = bfhi(a.x) - lam * bfhi(bb.x); o[2] = bflo(a.y) - lam * bflo(bb.y); o[3] = bfhi(a.y) - lam * bfhi(bb.y);
            o[4] = bflo(a.z) - lam * bflo(bb.z); o[5] = bfhi(a.z) - lam * bfhi(bb.z); o[6] = bflo(a.w) - lam * bflo(bb.w); o[7] = bfhi(a.w) - lam * bfhi(bb.w);
            float s2 = 0.f;
#pragma unroll
            for (int j = 0; j < 8; ++j) s2 += o[j] * o[j];
            s2 += __shfl_xor(s2, 1); s2 += __shfl_xor(s2, 2); s2 += __shfl_xor(s2, 4); s2 += __shfl_xor(s2, 8);
            const float rs = 1.f / sqrtf(s2 * (1.f / 128.f) + LN_EPS);
            v4u w; w.x = pk2(o[0] * rs * gsc[0], o[1] * rs * gsc[1]); w.y = pk2(o[2] * rs * gsc[2], o[3] * rs * gsc[3]); w.z = pk2(o[4] * rs * gsc[4], o[5] * rs * gsc[5]); w.w = pk2(o[6] * rs * gsc[6], o[7] * rs * gsc[7]);
            *(GAS v4u*)(mix + rows[r] * DM + 512 + h * 128 + e0) = w; }
    }
}

__device__ __forceinline__ float dpp_shr1(float x) { return __builtin_bit_cast(float, __builtin_amdgcn_update_dpp(0, __builtin_bit_cast(int, x), 0x111, 0xf, 0xf, true)); }
__device__ __forceinline__ float dpp_shr2(float x) { return __builtin_bit_cast(float, __builtin_amdgcn_update_dpp(0, __builtin_bit_cast(int, x), 0x112, 0xf, 0xf, true)); }
__device__ __forceinline__ float dpp_shr4(float x) { return __builtin_bit_cast(float, __builtin_amdgcn_update_dpp(0, __builtin_bit_cast(int, x), 0x114, 0xf, 0xf, true)); }
__device__ __forceinline__ float dpp_shr8(float x) { return __builtin_bit_cast(float, __builtin_amdgcn_update_dpp(0, __builtin_bit_cast(int, x), 0x118, 0xf, 0xf, true)); }
__device__ __forceinline__ float dpp_shl15(float x) { return __builtin_bit_cast(float, __builtin_amdgcn_update_dpp(0, __builtin_bit_cast(int, x), 0x10f, 0xf, 0xf, true)); }
#define S5_DPP2(fn, v) ((f32x2){fn((v).x), fn((v).y)})
__device__ __forceinline__ float dpp_ror1(float x) { return __builtin_bit_cast(float, __builtin_amdgcn_update_dpp(0, __builtin_bit_cast(int, x), 0x121, 0xf, 0xf, true)); }
template <int hf>
__device__ __forceinline__ void s5_main(Frame& F, const bf16* ug, bf16* yb, const float* dsk, int g, int bh, LAS bf16* W2F, LAS bf16* W3F, LAS bf16* KT, LAS float* PW, int r, int q, int variant) {
        const int b = bh * 4 + (F.wave & 3);
        LAS bf16x8* XX = (LAS bf16x8*)(F.lds + 91648);
        const bf16* up = ug + ((size_t)g * MTOK + (size_t)b * SEQ) * 16;
        unsigned char* yp = (unsigned char*)yb + ((size_t)g * MTOK + (size_t)b * SEQ) * 16 + 4 * q;
        const f32x4 dk = *(const GAS f32x4*)(dsk + g * 16 + 4 * q);
        f32x4 E[4];
#pragma unroll
        for (int i = 0; i < 4; ++i) E[i] = (f32x4){0.f, 0.f, 0.f, 0.f};
        bf16x8 UFn[4], UF[4]; v2u UWn[4], UW[4];
#pragma unroll
        for (int sp = 0; sp < 4; ++sp) UFn[sp] = *(const GAS bf16x8*)(up + (size_t)(r * 8 + 2 * sp + (q >> 1)) * 16 + 8 * (q & 1));
#pragma unroll
        for (int t = 0; t < 4; ++t) UWn[t] = *(const GAS v2u*)(up + (size_t)(r * 8 + 4 * hf + t) * 16 + 4 * q);
#pragma unroll
        for (int sp = 0; sp < 4; ++sp) UF[sp] = UFn[sp];
#pragma unroll
        for (int t = 0; t < 4; ++t) UW[t] = UWn[t];
        f32x2 Pr[4][2][2], Pi[4][2][2];
#pragma unroll
        for (int i2 = 0; i2 < 2; ++i2) { const int rbp = 2 * hf + i2;
            const f32x4 a0 = *(const LAS f32x4*)(PW + (8 * 64 + 16 * rbp + 4 * q) * 2), a1 = *(const LAS f32x4*)(PW + (8 * 64 + 16 * rbp + 4 * q) * 2 + 4);
            Pr[0][i2][0] = (f32x2){a0[0], a0[2]}; Pi[0][i2][0] = (f32x2){a0[1], a0[3]}; Pr[0][i2][1] = (f32x2){a1[0], a1[2]}; Pi[0][i2][1] = (f32x2){a1[1], a1[3]};
#pragma unroll
            for (int k = 1; k < 4; ++k)
#pragma unroll
                for (int h = 0; h < 2; ++h) { const f32x2 pr = Pr[k - 1][i2][h], pi = Pi[k - 1][i2][h]; Pr[k][i2][h] = pr * pr - pi * pi; Pi[k][i2][h] = 2.0f * pr * pi; } }
        for (int cg = 0; cg < 16; ++cg) {
            const int tokbase = cg * 128 + r * 8;
            if (cg < 15) {
#pragma unroll
                for (int sp = 0; sp < 4; ++sp) UFn[sp] = *(const GAS bf16x8*)(up + (size_t)(tokbase + 128 + 2 * sp + (q >> 1)) * 16 + 8 * (q & 1));
#pragma unroll
                for (int t = 0; t < 4; ++t) UWn[t] = *(const GAS v2u*)(up + (size_t)(tokbase + 128 + 4 * hf + t) * 16 + 4 * q); }
            f32x2 Cr[2][2], Ci[2][2];
#pragma unroll
            for (int i2 = 0; i2 < 2; ++i2)
#pragma unroll
                for (int h = 0; h < 2; ++h) { const f32x2 er = h ? E[2 * i2].hi : E[2 * i2].lo, ei = h ? E[2 * i2 + 1].hi : E[2 * i2 + 1].lo; Cr[i2][h] = S5_DPP2(dpp_shl15, er); Ci[i2][h] = S5_DPP2(dpp_shl15, ei); }
#pragma unroll
            for (int i = 0; i < 4; ++i) E[i] = (f32x4){0.f, 0.f, 0.f, 0.f};
#pragma unroll
            for (int i = 0; i < 4; ++i)
#pragma unroll
                for (int sp = 0; sp < 4; ++sp) { E[i] = __builtin_amdgcn_mfma_f32_16x16x32_bf16(*(const LAS bf16x8*)(W2F + (((4 * hf + i) * 4 + sp) * 64 + FLANE) * 8), UF[sp], E[i], 0, 0, 0); if (sp == 3) asm volatile("" ::: "memory"); }
            bf16x8 XBf[4];
            LAS bf16x8* xx = XX + ((cg & 1) * 4 + (F.wave & 3)) * 256;
#pragma unroll
            for (int i2 = 0; i2 < 2; ++i2) { f32x2 xr[2], xi[2];
#pragma unroll
                for (int h = 0; h < 2; ++h) {
                    f32x2 er = h ? E[2 * i2].hi : E[2 * i2].lo, ei = h ? E[2 * i2 + 1].hi : E[2 * i2 + 1].lo; f32x2 sr, si, nr, ni;
                    nr = er + Pr[0][i2][h] * Cr[i2][h] - Pi[0][i2][h] * Ci[i2][h]; ni = ei + Pr[0][i2][h] * Ci[i2][h] + Pi[0][i2][h] * Cr[i2][h]; er = nr; ei = ni;
                    sr = S5_DPP2(dpp_shr1, er); si = S5_DPP2(dpp_shr1, ei); nr = er + Pr[0][i2][h] * sr - Pi[0][i2][h] * si; ni = ei + Pr[0][i2][h] * si + Pi[0][i2][h] * sr; er = nr; ei = ni;
                    sr = S5_DPP2(dpp_shr2, er); si = S5_DPP2(dpp_shr2, ei); nr = er + Pr[1][i2][h] * sr - Pi[1][i2][h] * si; ni = ei + Pr[1][i2][h] * si + Pi[1][i2][h] * sr; er = nr; ei = ni;
                    sr = S5_DPP2(dpp_shr4, er); si = S5_DPP2(dpp_shr4, ei); nr = er + Pr[2][i2][h] * sr - Pi[2][i2][h] * si; ni = ei + Pr[2][i2][h] * si + Pi[2][i2][h] * sr; er = nr; ei = ni;
                    sr = S5_DPP2(dpp_shr8, er); si = S5_DPP2(dpp_shr8, ei); nr = er + Pr[3][i2][h] * sr - Pi[3][i2][h] * si; ni = ei + Pr[3][i2][h] * si + Pi[3][i2][h] * sr; er = nr; ei = ni;
                    if (h) { E[2 * i2].hi = er; E[2 * i2 + 1].hi = ei; } else { E[2 * i2].lo = er; E[2 * i2 + 1].lo = ei; }
                    xr[h] = S5_DPP2(dpp_shr1, er) + Cr[i2][h]; xi[h] = S5_DPP2(dpp_shr1, ei) + Ci[i2][h]; }
                v4u w; w.x = pk2(xr[0].x, xr[0].y); w.y = pk2(xr[1].x, xr[1].y); w.z = pk2(xi[0].x, xi[0].y); w.w = pk2(xi[1].x, xi[1].y);
                XBf[2 * hf + i2] = __builtin_bit_cast(bf16x8, w); xx[(2 * hf + i2) * 64 + FLANE] = XBf[2 * hf + i2]; }
            LDS_WAIT(); __builtin_amdgcn_s_barrier(); asm volatile("" ::: "memory");
#pragma unroll
            for (int i2 = 0; i2 < 2; ++i2) XBf[2 * (1 - hf) + i2] = xx[(2 * (1 - hf) + i2) * 64 + FLANE];
            unsigned yout[4] = {0u, 0u, 0u, 0u};
            if (variant != 2) {
#pragma unroll
            for (int tt = 0; tt < 4; ++tt) { const int t = 4 * hf + tt;
                f32x4 Y = (f32x4){0.f, 0.f, 0.f, 0.f};
#pragma unroll
                for (int sp = 0; sp < 4; ++sp) if (sp <= (t >> 1)) { const int tau1 = t - 2 * sp - (q >> 1) + 1;
                    Y = __builtin_amdgcn_mfma_f32_16x16x32_bf16(*(const LAS bf16x8*)(KT + (tau1 * 16 + r) * 16 + 8 * (q & 1)), UF[sp], Y, 0, 0, 0); }
#pragma unroll
                for (int ks = 0; ks < 4; ++ks) Y = __builtin_amdgcn_mfma_f32_16x16x32_bf16(*(const LAS bf16x8*)(W3F + ((t * 4 + ks) * 64 + FLANE) * 8), XBf[ks], Y, 0, 0, 0);
                const v2u uw = UW[tt];
                const f32x2 ya = gelu_tanh2(Y.lo + dk.lo * (f32x2){bflo(uw.x), bfhi(uw.x)}, SA8), yb2 = gelu_tanh2(Y.hi + dk.hi * (f32x2){bflo(uw.y), bfhi(uw.y)}, SA8);
                yout[tt] = pk4_fp8(ya.x, ya.y, yb2.x, yb2.y); asm volatile("" ::: "memory");
            } }
            if (cg < 15) {
#pragma unroll
                for (int sp = 0; sp < 4; ++sp) UF[sp] = UFn[sp];
#pragma unroll
                for (int t = 0; t < 4; ++t) UW[t] = UWn[t]; }
            asm volatile("" ::: "memory");
            { auto s01 = __builtin_amdgcn_permlane16_swap(yout[0], yout[1], false, false); auto s23 = __builtin_amdgcn_permlane16_swap(yout[2], yout[3], false, false);
              auto s02 = __builtin_amdgcn_permlane32_swap(s01[0], s23[0], false, false); auto s13 = __builtin_amdgcn_permlane32_swap(s01[1], s23[1], false, false);
              *(GAS v4u*)(yp - 4 * q + (size_t)(tokbase + 4 * hf + q) * 16) = (v4u){s02[0], s13[0], s02[1], s13[1]}; }
        }
}
__device__ __forceinline__ void ph_s5(Frame& F, const bf16* ug, bf16* yb, const float* log_dt, const float* lre, const float* lim, const float* bre, const float* bim,
                                      const float* cre, const float* cim, const float* dsk, int variant) {
    LAS bf16* W2F = (LAS bf16*)F.lds;
    LAS bf16* W3F = (LAS bf16*)(F.lds + 32768);
    LAS bf16* KT = (LAS bf16*)(F.lds + 65536);
    LAS float* PW = (LAS float*)(F.lds + 70144);
    LAS float* ZZ = (LAS float*)(F.lds + 74752);
    LAS float* BB = (LAS float*)(F.lds + 75264);
    LAS float* CC = (LAS float*)(F.lds + 83456);
    LAS bf16* W30 = (LAS bf16*)(F.lds + 124416);
    const int r = FLANE & 15, q = FLANE >> 4;
    for (int it = F.vcu; it < 256; it += F.G) {
        const int g = it & 63, bh = it >> 6;
        __syncthreads();
        if (FTID < 64) { const int p = FTID; const float dt = expf(log_dt[g]), lr = lre[g * 64 + p], li = lim[g * 64 + p];
            const float mg = expf(lr * dt), ar = mg * cosf(li * dt), ai = mg * sinf(li * dt), den = lr * lr + li * li;
            float pr = 1.f, pi = 0.f;
            for (int n = 0; n < 9; ++n) { PW[(n * 64 + p) * 2] = pr; PW[(n * 64 + p) * 2 + 1] = pi; const float t2 = pr * ar - pi * ai; pi = pr * ai + pi * ar; pr = t2; }
            ZZ[p * 2] = ((ar - 1.0f) * lr + ai * li) / den; ZZ[p * 2 + 1] = (ai * lr - (ar - 1.0f) * li) / den; }
        __syncthreads();
        for (int idx = FTID; idx < 1024; idx += 512) {
            { const int p = idx >> 4; const float br = bre[(size_t)g * 1024 + idx], bi = bim[(size_t)g * 1024 + idx], zr = ZZ[p * 2], zi = ZZ[p * 2 + 1];
              BB[idx * 2] = zr * br - zi * bi; BB[idx * 2 + 1] = zr * bi + zi * br; }
            { CC[idx * 2] = cre[(size_t)g * 1024 + idx]; CC[idx * 2 + 1] = cim[(size_t)g * 1024 + idx]; }
        }
        if (FTID < 256) KT[FTID] = 0;
        __syncthreads();
        for (int idx = FTID; idx < 2048; idx += 512) {
            { const int t = idx >> 8, ks = (idx >> 6) & 3, ln = idx & 63, c = ln & 15, qq = ln >> 4; unsigned w[4];
#pragma unroll
              for (int j = 0; j < 4; ++j) { const int p = 16 * ks + 4 * qq + j; const float cr_ = CC[(c * 64 + p) * 2], ci_ = CC[(c * 64 + p) * 2 + 1], pr = PW[((t + 1) * 64 + p) * 2], pi = PW[((t + 1) * 64 + p) * 2 + 1];
                  const float gr = cr_ * pr - ci_ * pi, gi = cr_ * pi + ci_ * pr;
                  if (j & 1) { w[j >> 1] |= f2bf(gr) << 16; w[2 + (j >> 1)] |= f2bf(-gi) << 16; } else { w[j >> 1] = f2bf(gr); w[2 + (j >> 1)] = f2bf(-gi); } }
              *(LAS v4u*)(W3F + (size_t)idx * 8) = (v4u){w[0], w[1], w[2], w[3]}; }
            { const int rb = idx >> 8, sp = (idx >> 6) & 3, ln = idx & 63, rr = ln & 15, qq = ln >> 4, p = 16 * (rb >> 1) + rr, s = 2 * sp + (qq >> 1), c0 = 8 * (qq & 1); unsigned w[4];
              const float pr = PW[((7 - s) * 64 + p) * 2], pi = PW[((7 - s) * 64 + p) * 2 + 1];
#pragma unroll
              for (int j = 0; j < 8; ++j) { const float br = BB[(p * 16 + c0 + j) * 2], bi = BB[(p * 16 + c0 + j) * 2 + 1]; const float v = (rb & 1) ? (pr * bi + pi * br) : (pr * br - pi * bi);
                  if (j & 1) w[j >> 1] |= f2bf(v) << 16; else w[j >> 1] = f2bf(v); }
              *(LAS v4u*)(W2F + (size_t)idx * 8) = (v4u){w[0], w[1], w[2], w[3]}; }
        }
        if (FTID < 256) { const int ks = FTID >> 6, ln = FTID & 63, c = ln & 15, qq = ln >> 4; unsigned w[4];
#pragma unroll
            for (int j = 0; j < 4; ++j) { const int p = 16 * ks + 4 * qq + j; const float gr = CC[(c * 64 + p) * 2], gi = CC[(c * 64 + p) * 2 + 1];
                if (j & 1) { w[j >> 1] |= f2bf(gr) << 16; w[2 + (j >> 1)] |= f2bf(-gi) << 16; } else { w[j >> 1] = f2bf(gr); w[2 + (j >> 1)] = f2bf(-gi); } }
            *(LAS v4u*)(W30 + (size_t)FTID * 8) = (v4u){w[0], w[1], w[2], w[3]}; }
        __syncthreads();
        {
            f32x4 kacc = (f32x4){0.f, 0.f, 0.f, 0.f}; const int tau = F.wave;
#pragma unroll
            for (int ks = 0; ks < 4; ++ks) { unsigned w[4];
#pragma unroll
                for (int j = 0; j < 4; ++j) { const int p = 16 * ks + 4 * q + j; const float br = BB[(p * 16 + r) * 2], bi = BB[(p * 16 + r) * 2 + 1];
                    if (j & 1) { w[j >> 1] |= f2bf(br) << 16; w[2 + (j >> 1)] |= f2bf(bi) << 16; } else { w[j >> 1] = f2bf(br); w[2 + (j >> 1)] = f2bf(bi); } }
                const v4u wb = (v4u){w[0], w[1], w[2], w[3]};
                const bf16x8 af = tau == 0 ? *(const LAS bf16x8*)(W30 + (ks * 64 + FLANE) * 8) : *(const LAS bf16x8*)(W3F + (((tau - 1) * 4 + ks) * 64 + FLANE) * 8);
                kacc = __builtin_amdgcn_mfma_f32_16x16x32_bf16(af, __builtin_bit_cast(bf16x8, wb), kacc, 0, 0, 0); }
#pragma unroll
            for (int k = 0; k < 4; ++k) KT[(tau + 1) * 256 + (4 * q + k) * 16 + r] = (bf16)f2bf(kacc[k]); }
        __syncthreads();
        if (variant != 1) { if ((F.wave >> 2) == 0) s5_main<0>(F, ug, yb, dsk, g, bh, W2F, W3F, KT, PW, r, q, variant); else s5_main<1>(F, ug, yb, dsk, g, bh, W2F, W3F, KT, PW, r, q, variant); }
    }
}

struct PlainSched {
    pg8::TileOrder T; const char* A; const char* B; int tilesPerBatch; size_t bBatch; int splitN; size_t aT = pg8::TSTEP, bT = pg8::TSTEP;
    __device__ __forceinline__ bool next(int i, pg8::Unit& u) const {
        int pm, pn; if (!T.get(i, pm, pn)) return false;
        const int z = pm / tilesPerBatch;
        u.a = A + (size_t)pm * aT; u.b = B + (size_t)z * bBatch + (size_t)pn * bT; u.row0 = pm * 256; u.col0 = pn * 256; u.z = z; u.aux = 0;
        if (splitN) { u.z = pn >= splitN; u.col0 = (pn >= splitN ? pn - splitN : pn) * 256; }
        return true;
    }
};
struct FoldSched {
    int G, c, first; const char* KB; const char* VB; const char* XQ; const char* XOT;
    __device__ __forceinline__ bool next(int i, pg8::Unit& u) const {
        const int idx = i * G + c - first; if (idx < 0 || idx >= 512) return false;
        const int type = idx >> 8, j = idx & 255, b = j >> 4, h = (j >> 2) & 3, t = j & 3;
        if (type == 0) { u.a = KB + (size_t)b * 256 * 2048 + h * 512; u.b = XQ + (size_t)t * pg8::TSTEP + h * 512; u.row0 = b * 1024 + h * 256; u.col0 = t * 256; u.z = 0; }
        else { u.a = XOT + (size_t)t * pg8::TSTEP + h * 512; u.b = VB + (size_t)b * 256 * 2048 + h * 512; u.row0 = b * 1024 + t * 256; u.col0 = h * 256; u.z = 1; }
        u.aux = 0; return true;
    }
};
struct MoeSched {
    LAS const int* tab; int NT, G, c; const char* A; const char* B; size_t bExp; int colw; const int* list; bool gather; size_t tileB;
    __device__ __forceinline__ bool next(int i, pg8::Unit& u) const {
        const int nblk = __builtin_amdgcn_readfirstlane(tab[64]);
        const int x = c >> 5, r = c & 31; int mbl, pn;
        if (G != 256 || NT != 8) { mbl = c / NT; pn = c % NT; } else { pn = 4 * (x & 1) + (r & 3); mbl = 8 * (x >> 1) + (r >> 2); }
        const int mbg = i * (G / NT) + mbl; if (mbg >= nblk) return false;
        const int lane = opaque_tid() & 63; const int v = (lane <= 32) ? tab[32 + lane] : 0x7fffffff;
        const int e = __popcll(__ballot(v <= mbg)) - 1;
        const int mb = mbg - __builtin_amdgcn_readfirstlane(tab[32 + e]);
        u.a = gather ? A : A + (size_t)mbg * tileB; u.b = B + (size_t)e * bExp + (size_t)pn * tileB;
        u.row0 = mbg * 256; u.col0 = pn * colw; u.z = e; u.aux = mb; return true;
    }
    __device__ __forceinline__ const int* rows(const pg8::Unit& u) const { return list + (size_t)u.z * CAP + u.aux * 256; }
    __device__ __forceinline__ static int rowmap(int v) { return (int)(((unsigned)v >> 2) & (unsigned)(MTOK - 1)); }
};

#define EPI_ROWS_BEGIN _Pragma("unroll") for (int ai = 0; ai < 2; ++ai) _Pragma("unroll") for (int m = 0; m < 4; ++m) { const int rloc = ai * 128 + wr * 64 + m * 16 + fr;
#define EPI_ROWS_END }
__device__ __forceinline__ v4u pack8(f32x4 v0, f32x4 v1) { v4u w; w.x = pg8::cvt_pk_bf16(v0[0], v0[1]); w.y = pg8::cvt_pk_bf16(v0[2], v0[3]); w.z = pg8::cvt_pk_bf16(v1[0], v1[1]); w.w = pg8::cvt_pk_bf16(v1[2], v1[3]); return w; }
__device__ __forceinline__ void unpack8(v4u w, f32x4& a, f32x4& b) { a = (f32x4){bflo(w.x), bfhi(w.x), bflo(w.y), bfhi(w.y)}; b = (f32x4){bflo(w.z), bfhi(w.z), bflo(w.w), bfhi(w.w)}; }
__device__ __forceinline__ void rowpair_publish(LAS float* tab, float* dst, int nslot, int slot, int row0, const float (&ss)[8], const float (&qq)[8], int wr, int wc, int fr, int fq) {
    if (fq == 0) {
#pragma unroll
        for (int i = 0; i < 8; ++i) { const int rl = (i >> 2) * 128 + wr * 64 + (i & 3) * 16 + fr; tab[(rl * 4 + wc) * 2] = ss[i]; tab[(rl * 4 + wc) * 2 + 1] = qq[i]; } }
    LDS_WAIT(); __builtin_amdgcn_s_barrier(); asm volatile("" ::: "memory");
    { const int t = opaque_tid(), row = t >> 1, which = t & 1;
      const float v = (tab[(row * 4 + 0) * 2 + which] + tab[(row * 4 + 1) * 2 + which]) + (tab[(row * 4 + 2) * 2 + which] + tab[(row * 4 + 3) * 2 + which]);
      dst[((size_t)(row0 + row) * nslot + slot) * 2 + which] = v; }
    LDS_WAIT(); __builtin_amdgcn_s_barrier(); asm volatile("" ::: "memory");
}
__device__ __forceinline__ void ln_tables(LAS float* tabR, LAS float* tabC, const float* st, int nslot, int row0, const float* sc, int scrow0, const float* v0, const float* v1, int col0) {
    const int t = opaque_tid();
    if (t < 256) { const float* p = st + (size_t)(row0 + t) * 16; float s = 0.f, q = 0.f;
        for (int k = 0; k < nslot; ++k) { s += p[2 * k]; q += p[2 * k + 1]; }
        const float mu = s * (1.f / DM); tabR[2 * t] = mu; tabR[2 * t + 1] = 1.f / sqrtf(fmaxf(q * (1.f / DM) - mu * mu, 0.f) + LN_EPS); }
    else { const int c = t - 256;
        if (sc) { const f32x4 a = *(const GAS f32x4*)(sc + (size_t)(scrow0 + c) * 8), b = *(const GAS f32x4*)(sc + (size_t)(scrow0 + c) * 8 + 4);
            tabC[c] = (a[0] + a[2]) + (b[0] + b[2]); tabC[256 + c] = (a[1] + a[3]) + (b[1] + b[3]); }
        else { tabC[c] = v0[col0 + c]; tabC[256 + c] = v1[col0 + c]; } }
    LDS_WAIT(); __builtin_amdgcn_s_barrier(); asm volatile("" ::: "memory");
}
struct EpiResidStats { const bf16* xb; bf16* zb; unsigned char* z8; float* st; LAS float* tab;
    __device__ __forceinline__ void operator()(EPI_ARGS) const {
        float ss[8], qq[8]; v4u xr[2][4][2];
        EPI_ROWS_BEGIN const size_t off = (size_t)(u.row0 + rloc) * DM + u.col0 + wc * 32 + 8 * fq; xr[ai][m][0] = *(const GAS v4u*)(xb + off); xr[ai][m][1] = *(const GAS v4u*)(xb + off + 128); EPI_ROWS_END
        EPI_ROWS_BEGIN const size_t off = (size_t)(u.row0 + rloc) * DM + u.col0 + wc * 32 + 8 * fq; float s = 0.f, q = 0.f;
#pragma unroll
            for (int bj = 0; bj < 2; ++bj) { f32x4 x0, x1; unpack8(xr[ai][m][bj], x0, x1);
                const f32x4 z0 = x0 * ALPHA + acc[ai][bj][m][0], z1 = x1 * ALPHA + acc[ai][bj][m][1];
                *(GAS v4u*)(zb + off + bj * 128) = pack8(z0, z1);
                v2u w; w.x = pk4_fp8(z0[0] * SZ8, z0[1] * SZ8, z0[2] * SZ8, z0[3] * SZ8); w.y = pk4_fp8(z1[0] * SZ8, z1[1] * SZ8, z1[2] * SZ8, z1[3] * SZ8); *(GAS v2u*)(z8 + off + bj * 128) = w;
                s += ((z0[0] + z0[1]) + (z0[2] + z0[3])) + ((z1[0] + z1[1]) + (z1[2] + z1[3])); q += ((z0[0] * z0[0] + z0[1] * z0[1]) + (z0[2] * z0[2] + z0[3] * z0[3])) + ((z1[0] * z1[0] + z1[1] * z1[1]) + (z1[2] * z1[2] + z1[3] * z1[3])); }
            s += __shfl_xor(s, 16); s += __shfl_xor(s, 32); q += __shfl_xor(q, 16); q += __shfl_xor(q, 32); ss[ai * 4 + m] = s; qq[ai * 4 + m] = q; EPI_ROWS_END
        rowpair_publish(tab, st, 8, u.col0 >> 8, u.row0, ss, qq, wr, wc, fr, fq);
    } };
struct EpiResidLN { bf16* zb; float rs; const float* st; LAS float* tab; const float* g; const float* b; int nslot;
    __device__ __forceinline__ void operator()(EPI_ARGS) const {
        LAS float* tabC = tab + 512; ln_tables(tab, tabC, st, nslot, u.row0, nullptr, 0, g, b, u.col0);
        const int c8 = u.col0 + wc * 32 + 8 * fq, cl = wc * 32 + 8 * fq; v4u zr[2][4][2];
        EPI_ROWS_BEGIN const size_t off = (size_t)(u.row0 + rloc) * DM + c8; zr[ai][m][0] = *(const GAS v4u*)(zb + off); zr[ai][m][1] = *(const GAS v4u*)(zb + off + 128); EPI_ROWS_END
        EPI_ROWS_BEGIN const size_t off = (size_t)(u.row0 + rloc) * DM + c8; const float mu = tab[2 * rloc], rstd = tab[2 * rloc + 1];
#pragma unroll
            for (int bj = 0; bj < 2; ++bj) { f32x4 x0, x1; unpack8(zr[ai][m][bj], x0, x1);
                const f32x4 g0 = *(const LAS f32x4*)(tabC + cl + bj * 128), g1 = *(const LAS f32x4*)(tabC + cl + bj * 128 + 4), b0 = *(const LAS f32x4*)(tabC + 256 + cl + bj * 128), b1 = *(const LAS f32x4*)(tabC + 256 + cl + bj * 128 + 4);
                x0 = (x0 - mu) * rstd * g0 + b0; x1 = (x1 - mu) * rstd * g1 + b1;
                *(GAS v4u*)(zb + off + bj * 128) = pack8(x0 * ALPHA + acc[ai][bj][m][0] * rs, x1 * ALPHA + acc[ai][bj][m][1] * rs); } EPI_ROWS_END
        LDS_WAIT(); __builtin_amdgcn_s_barrier(); asm volatile("" ::: "memory");
    } };
struct EpiFold { unsigned char* kft; unsigned char* vft; const float* g; const float* b; float* sc; LAS float* tab;
    __device__ __forceinline__ void operator()(EPI_ARGS) const {
        if (u.z) {
            EPI_ROWS_BEGIN unsigned char* rowp = vft + (size_t)(u.row0 + rloc) * 1024 + u.col0 + wc * 32 + 8 * fq;
#pragma unroll
                for (int bj = 0; bj < 2; ++bj) { const f32x4 v0 = acc[ai][bj][m][0] * SV8, v1 = acc[ai][bj][m][1] * SV8; v2u w; w.x = pk4_fp8(v0[0], v0[1], v0[2], v0[3]); w.y = pk4_fp8(v1[0], v1[1], v1[2], v1[3]); *(GAS v2u*)(rowp + bj * 128) = w; } EPI_ROWS_END
            return; }
        float ss[8], qq[8]; const int c8 = u.col0 + wc * 32 + 8 * fq, cl = wc * 32 + 8 * fq; LAS float* tabC = tab + 2048;
        { const int t = opaque_tid(); if (t < 256) tabC[t] = g[u.col0 + t] * CSC; else tabC[t] = b[u.col0 + t - 256] * CSC; }
        LDS_WAIT(); __builtin_amdgcn_s_barrier(); asm volatile("" ::: "memory");
        EPI_ROWS_BEGIN unsigned char* rowp = kft + (size_t)(u.row0 + rloc) * 1024 + c8; float s = 0.f, q = 0.f;
#pragma unroll
            for (int bj = 0; bj < 2; ++bj) { const f32x4 g0 = *(const LAS f32x4*)(tabC + cl + bj * 128), g1 = *(const LAS f32x4*)(tabC + cl + bj * 128 + 4), b0 = *(const LAS f32x4*)(tabC + 256 + cl + bj * 128), b1 = *(const LAS f32x4*)(tabC + 256 + cl + bj * 128 + 4);
                const f32x4 k0 = acc[ai][bj][m][0] * g0, k1 = acc[ai][bj][m][1] * g1, c0 = acc[ai][bj][m][0] * b0, c1 = acc[ai][bj][m][1] * b1;
                s += ((k0[0] + k0[1]) + (k0[2] + k0[3])) + ((k1[0] + k1[1]) + (k1[2] + k1[3])); q += ((c0[0] + c0[1]) + (c0[2] + c0[3])) + ((c1[0] + c1[1]) + (c1[2] + c1[3]));
                v2u w; w.x = pk4_fp8(k0[0] * SK8, k0[1] * SK8, k0[2] * SK8, k0[3] * SK8); w.y = pk4_fp8(k1[0] * SK8, k1[1] * SK8, k1[2] * SK8, k1[3] * SK8); *(GAS v2u*)(rowp + bj * 128) = w; }
            s += __shfl_xor(s, 16); s += __shfl_xor(s, 32); q += __shfl_xor(q, 16); q += __shfl_xor(q, 32); ss[ai * 4 + m] = s; qq[ai * 4 + m] = q; EPI_ROWS_END
        rowpair_publish(tab, sc, 4, u.col0 >> 8, u.row0, ss, qq, wr, wc, fr, fq);
    } };
struct EpiStore { bf16* base0; bf16* base1; float s0, s1; int ldc; int f8mask = 0;
    __device__ __forceinline__ void operator()(EPI_ARGS) const {
        bf16* base = u.z ? base1 : base0; const float sc = u.z ? s1 : s0;
        if ((f8mask >> (u.z ? 1 : 0)) & 1) { unsigned char* b8 = (unsigned char*)base;
            EPI_ROWS_BEGIN unsigned char* rowp = b8 + (size_t)(u.row0 + rloc) * ldc + u.col0 + wc * 32 + 8 * fq;
#pragma unroll
                for (int bj = 0; bj < 2; ++bj) { const f32x4 v0 = acc[ai][bj][m][0] * sc, v1 = acc[ai][bj][m][1] * sc; v2u w; w.x = pk4_fp8(v0[0], v0[1], v0[2], v0[3]); w.y = pk4_fp8(v1[0], v1[1], v1[2], v1[3]); *(GAS v2u*)(rowp + bj * 128) = w; } EPI_ROWS_END
            return; }
        EPI_ROWS_BEGIN bf16* rowp = base + (size_t)(u.row0 + rloc) * ldc + u.col0 + wc * 32 + 8 * fq;
#pragma unroll
            for (int bj = 0; bj < 2; ++bj) *(GAS v4u*)(rowp + bj * 128) = pack8(acc[ai][bj][m][0] * sc, acc[ai][bj][m][1] * sc); EPI_ROWS_END
    } };
struct EpiH0 { bf16* uv; bf16* qx; bf16* kx; bf16* vx; float rs;
    __device__ __forceinline__ void operator()(EPI_ARGS) const {
        const int pn = u.col0 >> 8, kind = pn < 4 ? 0 : ((pn - 4) >> 1) + 1;
        bf16* base = kind == 0 ? uv : kind == 1 ? qx : kind == 2 ? kx : vx;
        EPI_ROWS_BEGIN bf16* rowp = base + (size_t)(u.row0 + rloc) * DM;
#pragma unroll
            for (int bj = 0; bj < 2; ++bj) { f32x4 v0 = acc[ai][bj][m][0] * rs, v1 = acc[ai][bj][m][1] * rs;
                if (kind == 0) {
#pragma unroll
                    for (int j = 0; j < 4; ++j) { v0[j] = gelu_tanh(v0[j]); v1[j] = gelu_tanh(v1[j]); }
                    *(GAS v4u*)(rowp + u.col0 + bj * 128 + wc * 32 + 8 * fq) = pack8(v0, v1); }
                else { const int cr = ((pn - 4) & 1) * 256 + bj * 128 + wc * 32 + 8 * fq;
                    if (kind == 1) { v0 = v0 * C2; v1 = v1 * C2; }
                    *(GAS v4u*)(rowp + cr) = pack8(v0, v1); } } EPI_ROWS_END
    } };
struct EpiResid { const bf16* xb; bf16* zb; float rs = 1.0f;
    __device__ __forceinline__ void operator()(EPI_ARGS) const {
        EPI_ROWS_BEGIN const size_t off = (size_t)(u.row0 + rloc) * DM + u.col0 + wc * 32 + 8 * fq;
#pragma unroll
            for (int bj = 0; bj < 2; ++bj) { f32x4 x0, x1; unpack8(*(const GAS v4u*)(xb + off + bj * 128), x0, x1);
                *(GAS v4u*)(zb + off + bj * 128) = pack8(x0 * ALPHA + acc[ai][bj][m][0] * rs, x1 * ALPHA + acc[ai][bj][m][1] * rs); } EPI_ROWS_END
    } };
struct EpiUG { bf16* ug; float rs;
    __device__ __forceinline__ void operator()(EPI_ARGS) const {
        EPI_ROWS_BEGIN
#pragma unroll
            for (int bj = 0; bj < 2; ++bj) { const int col = u.col0 + bj * 128 + wc * 32 + 8 * fq;
                *(GAS v4u*)(ug + ((size_t)(col >> 4) * MTOK + (u.row0 + rloc)) * 16 + (col & 15)) = pack8(acc[ai][bj][m][0] * rs, acc[ai][bj][m][1] * rs); } EPI_ROWS_END
    } };
struct EpiScore { float* sc;
    __device__ __forceinline__ void operator()(EPI_ARGS) const {
        EPI_ROWS_BEGIN float* rowp = sc + (size_t)(u.row0 + rloc) * DM + u.col0 + wc * 32 + 8 * fq;
#pragma unroll
            for (int bj = 0; bj < 2; ++bj) { *(GAS f32x4*)(rowp + bj * 128) = acc[ai][bj][m][0]; *(GAS f32x4*)(rowp + bj * 128 + 4) = acc[ai][bj][m][1]; } EPI_ROWS_END
    } };
struct EpiSoftmaxP { bf16* P; LAS float* tab; float rs0; const float* st; const float* sc; int nslot;
    __device__ __forceinline__ void operator()(EPI_ARGS) const {
        { auto& A = const_cast<f32x4 (&)[2][2][4][2]>(acc); LAS float* tabC = tab + 512; ln_tables(tab, tabC, st, nslot, u.row0, sc, u.z * 1024 + u.col0, nullptr, nullptr, 0);
          const int cl = wc * 32 + 8 * fq;
          EPI_ROWS_BEGIN const float mu = tab[2 * rloc], rstd = tab[2 * rloc + 1];
#pragma unroll
              for (int bj = 0; bj < 2; ++bj)
#pragma unroll
                  for (int n = 0; n < 2; ++n) { const f32x4 s1 = *(const LAS f32x4*)(tabC + cl + bj * 128 + 4 * n), c1 = *(const LAS f32x4*)(tabC + 256 + cl + bj * 128 + 4 * n);
                      A[ai][bj][m][n] = (A[ai][bj][m][n] * rs0 - s1 * mu) * rstd + c1; } EPI_ROWS_END
          LDS_WAIT(); __builtin_amdgcn_s_barrier(); asm volatile("" ::: "memory"); }
        constexpr float rs = 1.0f;
        EPI_ROWS_BEGIN float mx = -3.0e38f;
#pragma unroll
            for (int bj = 0; bj < 2; ++bj)
#pragma unroll
                for (int n = 0; n < 2; ++n)
#pragma unroll
                    for (int j = 0; j < 4; ++j) mx = fmaxf(mx, acc[ai][bj][m][n][j]);
            mx *= rs; mx = fmaxf(mx, __shfl_xor(mx, 16)); mx = fmaxf(mx, __shfl_xor(mx, 32));
            float sm = 0.f;
#pragma unroll
            for (int bj = 0; bj < 2; ++bj)
#pragma unroll
                for (int n = 0; n < 2; ++n)
#pragma unroll
                    for (int j = 0; j < 4; ++j) sm += __builtin_amdgcn_exp2f(acc[ai][bj][m][n][j] * rs - mx);
            sm += __shfl_xor(sm, 16); sm += __shfl_xor(sm, 32);
            if (fq == 0) { tab[(rloc * 4 + wc) * 2] = mx; tab[(rloc * 4 + wc) * 2 + 1] = sm; } EPI_ROWS_END
        LDS_WAIT(); __builtin_amdgcn_s_barrier(); asm volatile("" ::: "memory");
        EPI_ROWS_BEGIN const f32x4 a = *(const LAS f32x4*)(tab + rloc * 8), b = *(const LAS f32x4*)(tab + rloc * 8 + 4);
            const float M = fmaxf(fmaxf(a[0], a[2]), fmaxf(b[0], b[2]));
            const float S = a[1] * __builtin_amdgcn_exp2f(a[0] - M) + a[3] * __builtin_amdgcn_exp2f(a[2] - M) + b[1] * __builtin_amdgcn_exp2f(b[0] - M) + b[3] * __builtin_amdgcn_exp2f(b[2] - M);
            const float inv = SP8 / S; unsigned char* rowp = (unsigned char*)P + (size_t)(u.row0 + rloc) * DM + u.col0 + wc * 32 + 8 * fq;
#pragma unroll
            for (int bj = 0; bj < 2; ++bj) { f32x4 v0, v1;
#pragma unroll
                for (int j = 0; j < 4; ++j) { v0[j] = __builtin_amdgcn_exp2f(acc[ai][bj][m][0][j] * rs - M) * inv; v1[j] = __builtin_amdgcn_exp2f(acc[ai][bj][m][1][j] * rs - M) * inv; }
                v2u w; w.x = pk4_fp8(v0[0], v0[1], v0[2], v0[3]); w.y = pk4_fp8(v1[0], v1[1], v1[2], v1[3]); *(GAS v2u*)(rowp + bj * 128) = w; } EPI_ROWS_END
        LDS_WAIT(); __builtin_amdgcn_s_barrier(); asm volatile("" ::: "memory");
    } };
struct EpiRouter { float* logit;
    __device__ __forceinline__ void operator()(EPI_ARGS) const {
        if (wc == 0) { EPI_ROWS_BEGIN float* rowp = logit + (size_t)(u.row0 + rloc) * 32 + 8 * fq; *(GAS f32x4*)(rowp) = acc[ai][0][m][0]; *(GAS f32x4*)(rowp + 4) = acc[ai][0][m][1]; EPI_ROWS_END }
    } };
struct EpiSwiglu { const float* bup; bf16* act;
    __device__ __forceinline__ void operator()(EPI_ARGS) const {
        const int j0 = u.col0 + wc * 32 + 8 * fq; const float* bb = bup + (size_t)u.z * 2048;
        const f32x4 bg0 = *(const GAS f32x4*)(bb + j0), bg1 = *(const GAS f32x4*)(bb + j0 + 4), bl0 = *(const GAS f32x4*)(bb + 1024 + j0), bl1 = *(const GAS f32x4*)(bb + 1024 + j0 + 4);
        EPI_ROWS_BEGIN f32x4 o0, o1;
#pragma unroll
            for (int j = 0; j < 4; ++j) {
                { const float gl = fminf(acc[ai][0][m][0][j] + bg0[j], 7.0f), ln = fminf(fmaxf(acc[ai][1][m][0][j] + bl0[j], -7.0f), 7.0f); o0[j] = gl * sigmoidf_(1.702f * gl) * (ln + 1.0f); }
                { const float gl = fminf(acc[ai][0][m][1][j] + bg1[j], 7.0f), ln = fminf(fmaxf(acc[ai][1][m][1][j] + bl1[j], -7.0f), 7.0f); o1[j] = gl * sigmoidf_(1.702f * gl) * (ln + 1.0f); } }
            *(GAS v4u*)(act + (size_t)(u.row0 + rloc) * DM + j0) = pack8(o0, o1); EPI_ROWS_END
    } };
struct EpiDown { const float* bdn; const int* list; const float* gate; bf16* ys; LAS const int* tab;
    __device__ __forceinline__ void operator()(EPI_ARGS) const {
        const int e = u.z, cnt = tab[e], c8 = u.col0 + wc * 32 + 8 * fq; const float* bb = bdn + (size_t)e * 1024 + c8;
        f32x4 bv[2][2];
#pragma unroll
        for (int bj = 0; bj < 2; ++bj) { bv[bj][0] = *(const GAS f32x4*)(bb + bj * 128); bv[bj][1] = *(const GAS f32x4*)(bb + bj * 128 + 4); }
        int av[8]; float gv[8];
#pragma unroll
        for (int i = 0; i < 8; ++i) { const int slot = u.aux * 256 + (i >> 2) * 128 + wr * 64 + (i & 3) * 16 + fr; const int sl = slot < cnt ? slot : 0;
            av[i] = (int)((unsigned)list[(size_t)e * CAP + sl] & (unsigned)(NASSIGN - 1)); }
#pragma unroll
        for (int i = 0; i < 8; ++i) gv[i] = gate[av[i]];
        EPI_ROWS_BEGIN const int slot = u.aux * 256 + rloc; const int a = av[ai * 4 + m]; const float gt = gv[ai * 4 + m]; bf16* rowp = ys + (size_t)a * DM + c8;
            if (slot < cnt) {
#pragma unroll
                for (int bj = 0; bj < 2; ++bj) *(GAS v4u*)(rowp + bj * 128) = pack8((acc[ai][bj][m][0] + bv[bj][0]) * gt, (acc[ai][bj][m][1] + bv[bj][1]) * gt); } EPI_ROWS_END
    } };
struct EpiSwiglu8 { const float* bup; unsigned char* act; int skip; LAS float* slot;
    static constexpr bool HAS_PRE = true;
    __device__ __forceinline__ void pre(const pg8::Unit& u, int wid, int lane) const {
        if (wid < 4) { const int t = wid * 64 + lane; const float* src = bup + (size_t)u.z * 2048 + u.col0 + (t < 128 ? t : 1024 + t - 128);
            __builtin_amdgcn_global_load_lds((const unsigned*)src, (LAS unsigned*)(slot + u.par * 256 + wid * 64), 4, 0, 0); } }
    __device__ __forceinline__ void operator()(EPI_ARGS) const {
        if (skip) {
#pragma unroll
            for (int a = 0; a < 2; ++a)
#pragma unroll
                for (int b = 0; b < 2; ++b)
#pragma unroll
                    for (int m = 0; m < 4; ++m) asm volatile("" :: "v"(acc[a][b][m][0]), "v"(acc[a][b][m][1])); return; }
        const int j0 = u.col0 + wc * 32 + 8 * fq; constexpr float RS = 1.0f / (SX8 * SWU8); const LAS float* sb = slot + u.par * 256 + wc * 32 + 8 * fq;
        const f32x4 bg0 = *(const LAS f32x4*)(sb), bg1 = *(const LAS f32x4*)(sb + 4), bl0 = *(const LAS f32x4*)(sb + 128), bl1 = *(const LAS f32x4*)(sb + 132);
        typedef float f32x2 __attribute__((ext_vector_type(2)));
        EPI_ROWS_BEGIN f32x4 o0, o1;
#pragma unroll
            for (int n = 0; n < 2; ++n)
#pragma unroll
                for (int h = 0; h < 2; ++h) {
                    const f32x4 ga = acc[ai][0][m][n], la = acc[ai][1][m][n], bgv = n ? bg1 : bg0, blv = n ? bl1 : bl0;
                    const f32x2 g2 = h ? ga.hi : ga.lo, l2 = h ? la.hi : la.lo, bg2 = h ? bgv.hi : bgv.lo, bl2 = h ? blv.hi : blv.lo;
                    f32x2 gl = g2 * RS + bg2, ln = l2 * RS + bl2;
                    gl.x = fminf(gl.x, 7.0f); gl.y = fminf(gl.y, 7.0f); ln.x = __builtin_amdgcn_fmed3f(ln.x, -7.0f, 7.0f); ln.y = __builtin_amdgcn_fmed3f(ln.y, -7.0f, 7.0f);
                    const f32x2 ea = gl * (-1.702f * LOG2E); f32x2 d; d.x = __builtin_amdgcn_exp2f(ea.x); d.y = __builtin_amdgcn_exp2f(ea.y); d = d + 1.0f;
                    f32x2 rc; rc.x = __builtin_amdgcn_rcpf(d.x); rc.y = __builtin_amdgcn_rcpf(d.y);
                    const f32x2 o = (gl * rc) * (ln * SA8 + SA8);
                    if (n == 0) { o0[2 * h] = o.x; o0[2 * h + 1] = o.y; } else { o1[2 * h] = o.x; o1[2 * h + 1] = o.y; } }
            v2u w; { int r0 = __builtin_amdgcn_cvt_pk_fp8_f32(o0[0], o0[1], 0, false); r0 = __builtin_amdgcn_cvt_pk_fp8_f32(o0[2], o0[3], r0, true); int r1 = __builtin_amdgcn_cvt_pk_fp8_f32(o1[0], o1[1], 0, false); r1 = __builtin_amdgcn_cvt_pk_fp8_f32(o1[2], o1[3], r1, true); w.x = (unsigned)r0; w.y = (unsigned)r1; }
            *(GAS v2u*)(act + (size_t)(u.row0 + rloc) * DM + j0) = w; EPI_ROWS_END
    } };
struct EpiDown8 { const float* bdn; bf16* ys; LAS float* slot;
    static constexpr bool HAS_PRE = true;
    __device__ __forceinline__ void pre(const pg8::Unit& u, int wid, int lane) const {
        if (wid < 4) __builtin_amdgcn_global_load_lds((const unsigned*)(bdn + (size_t)u.z * 1024 + u.col0 + wid * 64 + lane), (LAS unsigned*)(slot + u.par * 256 + wid * 64), 4, 0, 0); }
    __device__ __forceinline__ void operator()(EPI_ARGS) const {
        const int c8 = u.col0 + wc * 32 + 8 * fq; const LAS float* bb = slot + u.par * 256 + wc * 32 + 8 * fq; constexpr float RS = 1.0f / (SA8 * SWD8);
        f32x4 bv[2][2];
#pragma unroll
        for (int bj = 0; bj < 2; ++bj) { bv[bj][0] = *(const LAS f32x4*)(bb + bj * 128); bv[bj][1] = *(const LAS f32x4*)(bb + bj * 128 + 4); }
        EPI_ROWS_BEGIN unsigned char* rowp = (unsigned char*)ys + (size_t)(u.row0 + rloc) * DM + c8;
#pragma unroll
            for (int bj = 0; bj < 2; ++bj) { const f32x4 v0 = (acc[ai][bj][m][0] * RS + bv[bj][0]) * SY8, v1 = (acc[ai][bj][m][1] * RS + bv[bj][1]) * SY8; v2u w; w.x = pk4_fp8(v0[0], v0[1], v0[2], v0[3]); w.y = pk4_fp8(v1[0], v1[1], v1[2], v1[3]); *(GAS v2u*)(rowp + bj * 128) = w; } EPI_ROWS_END
    } };
struct EpiValGate { const bf16* xb; bf16* zb; float rsv, rsg; unsigned char* z8; float* st; LAS float* tab;
    __device__ __forceinline__ void operator()(EPI_ARGS) const {
        float ss[8], qq[8]; v4u xr[2][4];
        EPI_ROWS_BEGIN xr[ai][m] = *(const GAS v4u*)(xb + (size_t)(u.row0 + rloc) * DM + u.col0 + wc * 32 + 8 * fq); EPI_ROWS_END
        EPI_ROWS_BEGIN const size_t off = (size_t)(u.row0 + rloc) * DM + u.col0 + wc * 32 + 8 * fq; f32x4 x0, x1; unpack8(xr[ai][m], x0, x1); f32x4 o0, o1;
#pragma unroll
            for (int j = 0; j < 4; ++j) { o0[j] = x0[j] * ALPHA + acc[ai][0][m][0][j] * rsv * sigmoidf_(acc[ai][1][m][0][j] * rsg); o1[j] = x1[j] * ALPHA + acc[ai][0][m][1][j] * rsv * sigmoidf_(acc[ai][1][m][1][j] * rsg); }
            *(GAS v4u*)(zb + off) = pack8(o0, o1);
            { v2u w; w.x = pk4_fp8(o0[0] * SZ8, o0[1] * SZ8, o0[2] * SZ8, o0[3] * SZ8); w.y = pk4_fp8(o1[0] * SZ8, o1[1] * SZ8, o1[2] * SZ8, o1[3] * SZ8); *(GAS v2u*)(z8 + off) = w; }
            float s = ((o0[0] + o0[1]) + (o0[2] + o0[3])) + ((o1[0] + o1[1]) + (o1[2] + o1[3])), q = ((o0[0] * o0[0] + o0[1] * o0[1]) + (o0[2] * o0[2] + o0[3] * o0[3])) + ((o1[0] * o1[0] + o1[1] * o1[1]) + (o1[2] * o1[2] + o1[3] * o1[3]));
            s += __shfl_xor(s, 16); s += __shfl_xor(s, 32); q += __shfl_xor(q, 16); q += __shfl_xor(q, 32); ss[ai * 4 + m] = s; qq[ai * 4 + m] = q;
            asm volatile("" ::: "memory"); EPI_ROWS_END
        rowpair_publish(tab, st, 8, u.col0 >> 7, u.row0, ss, qq, wr, wc, fr, fq);
    } };

#ifndef ONLY_SITE
#define ONLY_SITE -1
#endif
#define SITE(s) (ONLY_SITE < 0 || ONLY_SITE == (s))
#define IN(k) (lo <= (k) && (k) < hi)
#define SEAM(k) do { if (IN(k) && IN((k) + 1)) xcd_barrier(bar); } while (0)
template <int l>
__device__ __forceinline__ void layer_shared(Frame& F, const Args& args, const XcdBarrier& bar, const int lo, const int hi) {
    unsigned char* ws = args.ws; bf16* const XB = (bf16*)(ws + WS_XB); bf16* const ZB = (bf16*)(ws + WS_ZB); const int cid = (int)blockIdx.x;
    constexpr int pb = 5 + 14 * l;
        gu32* cnt = F.ctl + CW_CNT + l * 32 * 64;
    const float* st1 = (const float*)(ws + WS_ST) + (size_t)l * MTOK * 16; const float* sc1 = (const float*)(ws + WS_SCC) + (size_t)l * 16384 * 8;
    if (IN(pb + 1) && SITE(6)) { PlainSched S; S.T.init(MTOK / 256, 4, F.G, cid); S.A = (const char*)(ws + WS_XFZ); S.B = (const char*)(ws + WS_KFT); S.tilesPerBatch = SEQ / 256; S.bBatch = (size_t)1024 * 1024; S.splitN = 0; S.aT = (size_t)256 * 1024; S.bT = (size_t)256 * 1024;
        EpiSoftmaxP E{(bf16*)(ws + WS_P), (LAS float*)(F.lds + SMX_OFF), 1.0f / (SZ8 * SK8), st1, sc1, l ? 8 : 4}; pg8::gemm_phase<EpiSoftmaxP, PlainSched, false, true>(F.lds, 1024, S, E); } SEAM(pb + 1);
    if (IN(pb + 3) && SITE(8)) { PlainSched S; S.T.init(MTOK / 256, 4, F.G, cid); S.A = (const char*)(ws + WS_P); S.B = (const char*)(ws + WS_VFT); S.tilesPerBatch = SEQ / 256; S.bBatch = (size_t)1024 * 1024; S.splitN = 0; S.aT = (size_t)256 * 1024; S.bT = (size_t)256 * 1024;
        EpiResidLN E{ZB, 1.0f / (SP8 * SV8), st1, (LAS float*)(F.lds + SMX_OFF), (l ? args.in[39] : args.in[14]), (l ? args.in[40] : args.in[15]), l ? 8 : 4}; pg8::gemm_phase<EpiResidLN, PlainSched, false, true>(F.lds, 1024, S, E); } SEAM(pb + 3);
    if (IN(pb + 4) && SITE(9)) { ph_ln2_router(F, ZB, XB, MOE_FP8 ? ws + WS_XF8 : nullptr, (l ? args.in[43] : args.in[18]), (l ? args.in[44] : args.in[19]), (const bf16*)(ws + WS_WR) + (size_t)l * 256 * 1024,
                                               (l ? args.in[46] : args.in[21]), cnt, (int*)(ws + WS_LIST), (float*)(ws + WS_GATE), (int*)(ws + WS_ASG), (float*)(ws + WS_ST2)); } SEAM(pb + 4);
    if (IN(pb + 7) && SITE(12)) { moe_tables(F, cnt);
#if MOE_FP8
        MoeSched S{(LAS const int*)(F.lds + TAB_OFF), 8, F.G, F.vcu, (const char*)(ws + WS_XF8), (const char*)(ws + WS_WUP8), (size_t)2048 * 1024, 128, (const int*)(ws + WS_LIST), true, (size_t)256 * 1024};
        EpiSwiglu8 E{(l ? args.in[48] : args.in[23]), ws + WS_ACT, args.variant == 9, (LAS float*)(F.lds + SMX_OFF)}; pg8::gemm_phase<EpiSwiglu8, MoeSched, true, true>(F.lds, 1024, S, E);
#else
        MoeSched S{(LAS const int*)(F.lds + TAB_OFF), 8, F.G, F.vcu, (const char*)XB, (const char*)(ws + WS_WUP), (size_t)2048 * 1024 * 2, 128, (const int*)(ws + WS_LIST), true, pg8::TSTEP};
        EpiSwiglu E{(l ? args.in[48] : args.in[23]), (bf16*)(ws + WS_ACT)}; pg8::gemm_phase<EpiSwiglu, MoeSched, true>(F.lds, 1024, S, E);
#endif
    } SEAM(pb + 7);
    if (IN(pb + 8) && SITE(13)) { moe_tables(F, cnt);
#if MOE_FP8
        MoeSched S{(LAS const int*)(F.lds + TAB_OFF), 4, F.G, F.vcu, (const char*)(ws + WS_ACT), (const char*)(ws + WS_WDN8), (size_t)1024 * 1024, 256, (const int*)(ws + WS_LIST), false, (size_t)256 * 1024};
        EpiDown8 E{(l ? args.in[50] : args.in[25]), (bf16*)(ws + WS_YS), (LAS float*)(F.lds + SMX_OFF)}; pg8::gemm_phase<EpiDown8, MoeSched, false, true>(F.lds, 1024, S, E);
#else
        MoeSched S{(LAS const int*)(F.lds + TAB_OFF), 4, F.G, F.vcu, (const char*)(ws + WS_ACT), (const char*)(ws + WS_WDN), (size_t)1024 * 1024 * 2, 256, (const int*)(ws + WS_LIST), false, pg8::TSTEP};
        EpiDown E{(l ? args.in[50] : args.in[25]), (const int*)(ws + WS_LIST), (const float*)(ws + WS_GATE), (bf16*)(ws + WS_YS), (LAS const int*)(F.lds + TAB_OFF)}; pg8::gemm_phase<EpiDown, MoeSched, false>(F.lds, 1024, S, E);
#endif
    } SEAM(pb + 8);
    if (IN(pb + 9) && SITE(14)) { moe_tables(F, cnt); ph_ln<1>(F, ZB, (const bf16*)(ws + WS_YS), XB, l ? args.out : nullptr, (l ? args.in[51] : args.in[26]), (l ? args.in[52] : args.in[27]), (l == 0) ? ws + WS_XF8 : nullptr, (const int*)(ws + WS_ASG), (const float*)(ws + WS_GATE),
                                                             (const float*)(ws + WS_ST2), (l ? args.in[43] : args.in[18]), (l ? args.in[44] : args.in[19]));
        if (l == 0) { __syncthreads(); cvt_experts(F, args.in[47], args.in[49], ws); } } SEAM(pb + 9);
}

constexpr int PH_TOTAL = 29;
__global__ void __launch_bounds__(NWAVES * 64, 2) mk_fwd(Args args) {
    extern __shared__ __attribute__((aligned(16))) unsigned char lds[];
    Frame F;
    F.lds = (LAS unsigned char*)lds; F.MISC = (volatile LAS unsigned*)(F.lds + MISC_OFF);
    F.wave = __builtin_amdgcn_readfirstlane((int)threadIdx.x >> 6);
    F.G = gridDim.x; { const int bx = blockIdx.x; F.vcu = (F.G % 8 == 0) ? (bx % 8) * (F.G / 8) + bx / 8 : bx; }
    unsigned char* ws = args.ws;
    F.ctl = (gu32*)(ws + WS_CTL);
    for (int u = FTID; u < (LDS_BYTES - LDSCTL_OFF) / 4; u += NWAVES * 64) ((LAS unsigned*)(F.lds + LDSCTL_OFF))[u] = 0u;
    __syncthreads();
    const int lo = args.ph_lo, hi = args.ph_hi;
    XcdBarrier bar; bar.bar = (unsigned*)(F.ctl + CW_BAR); bar.x = 0; bar.st = nullptr;
    if (hi - lo > 1) bar = xcd_barrier_post((unsigned*)(F.ctl + CW_BAR), F.MISC + 8);
    bf16* const XB = (bf16*)(ws + WS_XB); bf16* const ZB = (bf16*)(ws + WS_ZB);
    const int cid = (int)blockIdx.x;

    if (IN(0) && SITE(0)) { p0_prologue(F, args); } SEAM(0);
    if (IN(1) && SITE(1)) {
        { PlainSched S; S.T.init(MTOK / 256, HW0 / 256, F.G, cid); S.A = (const char*)XB; S.B = (const char*)(ws + WS_WIN0); S.tilesPerBatch = 1 << 20; S.bBatch = 0; S.splitN = 0;
          EpiH0 E{(bf16*)(ws + WS_UV), (bf16*)(ws + WS_QX), (bf16*)(ws + WS_QX) + 512, (bf16*)(ws + WS_VX), 1.0f}; pg8::gemm_phase<EpiH0, PlainSched>(F.lds, 1024, S, E); }
        { PlainSched S; S.T.init(NB * MEMLEN / 256, 2048 / 256, F.G, cid); S.A = (const char*)(ws + WS_MEMB); S.B = (const char*)(ws + WS_WKV); S.tilesPerBatch = 1 << 20; S.bBatch = 0; S.splitN = 4;
          EpiStore E{(bf16*)(ws + WS_KB), (bf16*)(ws + WS_VB), 1.f, 1.f, 1024}; pg8::gemm_phase<EpiStore, PlainSched>(F.lds, 1024, S, E); }
    } SEAM(1);
    if (IN(2) && SITE(2)) {
        attn_body::bf16* oat = (attn_body::bf16*)(ws + WS_OATT);
        { const attn_body::AttnTensors AT{(const attn_body::bf16*)(ws + WS_QX), (const attn_body::bf16*)(ws + WS_QX) + 512, (const attn_body::bf16*)(ws + WS_VX), oat};
          const attn_body::StaticOrder S((int)F.G, (int)blockIdx.x); attn_body::attn_phase<attn_body::StaticOrder>((char*)lds, AT, S); }
        VM_WAIT(); __syncthreads();
        if (F.G == 256) combine_local(F, (const bf16*)(ws + WS_OATT), (bf16*)(ws + WS_MIX), args.in[8], args.in[9], args.in[10], args.in[11], args.in[12], F.vcu >> 4, (F.vcu >> 2) & 3, F.vcu & 3);
        __syncthreads();
        ph_sgu(F, (const bf16*)(ws + WS_UV), (bf16*)(ws + WS_MIX), args.in[4], args.in[5], args.in[6], args.in[7]);
    } SEAM(2);
    if (IN(4) && SITE(4)) {
        { PlainSched S; S.T.init(MTOK / 256, 4, F.G, cid); S.A = (const char*)(ws + WS_MIX); S.B = (const char*)(ws + WS_WOUT0); S.tilesPerBatch = 1 << 20; S.bBatch = 0; S.splitN = 0;
          EpiResidStats E{XB, ZB, ws + WS_XFZ, (float*)(ws + WS_ST), (LAS float*)(F.lds + SMX_OFF)}; pg8::gemm_phase<EpiResidStats, PlainSched>(F.lds, 1024, S, E); }
        { FoldSched S{F.G, F.vcu, 0, (const char*)(ws + WS_KB), (const char*)(ws + WS_VB), (const char*)(ws + WS_XQB), (const char*)(ws + WS_XOT)};
          EpiFold E{ws + WS_KFT, ws + WS_VFT, args.in[14], args.in[15], (float*)(ws + WS_SCC), (LAS float*)(F.lds + SMX_OFF)}; int kf = 256; asm volatile("" : "+s"(kf)); pg8::gemm_phase<EpiFold, FoldSched>(F.lds, kf, S, E); }
    } SEAM(4);

    layer_shared<0>(F, args, bar, lo, hi);
    if (IN(15) && SITE(15)) { { PlainSched S; S.T.init(MTOK / 256, 4, F.G, cid); S.A = (const char*)(ws + WS_XF8); S.B = (const char*)(ws + WS_WIN1); S.tilesPerBatch = 1 << 20; S.bBatch = 0; S.splitN = 0; S.aT = (size_t)256 * 1024; S.bT = (size_t)256 * 1024;
        EpiUG E{(bf16*)(ws + WS_UG), 1.0f / (SX8 * SWU8)}; pg8::gemm_phase<EpiUG, PlainSched, false, true>(F.lds, 1024, S, E); }
        { FoldSched S{F.G, F.vcu, 0, (const char*)(ws + WS_KB), (const char*)(ws + WS_VB), (const char*)(ws + WS_XQB) + 1024 * 1024 * 2, (const char*)(ws + WS_XOT) + 1024 * 1024 * 2};
      EpiFold E{ws + WS_KFT, ws + WS_VFT, args.in[39], args.in[40], (float*)(ws + WS_SCC) + (size_t)16384 * 8, (LAS float*)(F.lds + SMX_OFF)}; int kf = 256; asm volatile("" : "+s"(kf)); pg8::gemm_phase<EpiFold, FoldSched>(F.lds, kf, S, E); }
    } SEAM(15);
    if (IN(16) && SITE(16)) { ph_s5(F, (const bf16*)(ws + WS_UG), (bf16*)(ws + WS_YB), args.in[29], args.in[30], args.in[31], args.in[32], args.in[33], args.in[34], args.in[35], args.in[36], args.variant); } SEAM(16);
    if (IN(17) && SITE(17)) { PlainSched S; S.T.init(MTOK / 256, 8, F.G, cid); S.A = (const char*)(ws + WS_YB); S.B = (const char*)(ws + WS_WVG); S.tilesPerBatch = 1 << 20; S.bBatch = 0; S.splitN = 0; S.aT = (size_t)256 * 16; S.bT = (size_t)256 * 1024;
        struct VGS { PlainSched P; __device__ __forceinline__ bool next(int i, pg8::Unit& u) const { if (!P.next(i, u)) return false; u.col0 >>= 1; return true; } } S2{S};
        EpiValGate E{XB, ZB, 1.0f / (SA8 * SWD8), 1.0f / (SA8 * SWU8), ws + WS_XFZ, (float*)(ws + WS_ST) + (size_t)MTOK * 16, (LAS float*)(F.lds + SMX_OFF)}; pg8::gemm_phase<EpiValGate, VGS, false, true, 1>(F.lds, 1024, S2, E); } SEAM(17);
    layer_shared<1>(F, args, bar, lo, hi);
#undef IN
#undef SEAM
}

extern "C" void kernel_launch(void* const* d_in, const int* in_sizes, int n_in, void* d_out, int out_size, void* d_ws, size_t ws_size, hipStream_t stream) {
    static int grid = 0;
    if (grid == 0) {
        if (n_in != 53 || in_sizes[0] != MTOK * DM || out_size != MTOK * DM || ws_size < WS_END) { fprintf(stderr, "kernel_launch: unexpected problem (n_in %d, in0 %d, out %d, ws %zu < %zu); nothing launched\n", n_in, n_in > 0 ? in_sizes[0] : -1, out_size, ws_size, (size_t)WS_END); grid = -1; return; }
        int dev = 0, cus = 0, per_cu = 0;
        if (hipGetDevice(&dev) != hipSuccess || hipDeviceGetAttribute(&cus, hipDeviceAttributeMultiprocessorCount, dev) != hipSuccess) { grid = -1; return; }
        if (hipFuncSetAttribute((const void*)mk_fwd, hipFuncAttributeMaxDynamicSharedMemorySize, LDS_BYTES) != hipSuccess) { fprintf(stderr, "kernel_launch: hipFuncSetAttribute failed\n"); grid = -1; return; }
        if (hipOccupancyMaxActiveBlocksPerMultiprocessor(&per_cu, (const void*)mk_fwd, NWAVES * 64, LDS_BYTES) != hipSuccess || per_cu < 1) fprintf(stderr, "kernel_launch: note: occupancy query reports %d\n", per_cu);
        (void)hipGetLastError();
        grid = cus;
    }
    if (grid < 0) return;
    if (hipMemsetAsync((char*)d_ws + WS_CTL, 0, CTL_ZERO_BYTES, stream) != hipSuccess) return;
    Args a{};
    for (int i = 0; i < 53; ++i) a.in[i] = (const float*)d_in[i];
    a.out = (float*)d_out; a.ws = (unsigned char*)d_ws;
#if MK_N_LAUNCHES == 1
    a.ph_lo = 0; a.ph_hi = PH_TOTAL;
    hipLaunchKernelGGL(mk_fwd, dim3(grid), dim3(NWAVES * 64), LDS_BYTES, stream, a);
#else
    for (int p = 0; p < PH_TOTAL; ++p) { if (p == 18 || p == 5 || p == 19) continue; a.ph_lo = p; a.ph_hi = p + 1;
        for (int rep = 0; rep < 1 + (int)(((PROBE_REPEAT_MASK) >> p) & 1ull); ++rep) { a.variant = (rep == 0 && (((PROBE_REPEAT_MASK) >> p) & 1ull)) ? PROBE_VARIANT : 0; hipLaunchKernelGGL(mk_fwd, dim3(grid), dim3(NWAVES * 64), LDS_BYTES, stream, a); } }
#endif
}
```

```cpp
#include <hip/hip_runtime.h>
#include <hip/hip_bf16.h>
#include <cstdio>
#include <cstdint>

#ifndef MK_N_LAUNCHES
#define MK_N_LAUNCHES 1
#endif

#ifndef MOE_FP8
#define MOE_FP8 1
#endif
#ifndef PROBE_VARIANT
#define PROBE_VARIANT 0
#endif
#ifndef PROBE_REPEAT_MASK
#define PROBE_REPEAT_MASK 0ull
#endif
#define GAS __attribute__((address_space(1)))
#define LAS __attribute__((address_space(3)))
typedef unsigned short bf16;
typedef unsigned v4u __attribute__((ext_vector_type(4)));
typedef unsigned v2u __attribute__((ext_vector_type(2)));
typedef float f32x4 __attribute__((ext_vector_type(4)));
typedef float f32x2 __attribute__((ext_vector_type(2)));
typedef short bf16x8 __attribute__((ext_vector_type(8)));
typedef int v4i_t __attribute__((ext_vector_type(4)));
typedef GAS unsigned gu32;
#define RLX_AGENT __ATOMIC_RELAXED, __HIP_MEMORY_SCOPE_AGENT
#define LDS_WAIT() asm volatile("s_waitcnt lgkmcnt(0)" ::: "memory")
#define VM_WAIT() asm volatile("s_waitcnt vmcnt(0)" ::: "memory")

constexpr int NB = 16, SEQ = 2048, DM = 1024, MTOK = NB * SEQ;
constexpr int MEMLEN = 256, NEXP = 32, TOPK = 4, NASSIGN = MTOK * TOPK;
constexpr int HW0 = 2560;
constexpr int CAP = MTOK;
constexpr int MAXBLK = NASSIGN / 256 + NEXP;
constexpr float LN_EPS = 1e-5f;
constexpr float ALPHA = 1.41421356237f;
constexpr float LOG2E = 1.4426950408889634f;
constexpr float C2 = 0.125f * LOG2E;
constexpr float CSC = 0.0625f * LOG2E;
constexpr float LAM_INIT0 = 0.2f;

constexpr size_t MiB = 1u << 20;
constexpr size_t WS_CTL = 0, CTL_ZERO_BYTES = 96 * 1024;
constexpr size_t WS_LIST = 1 * MiB;
constexpr size_t WS_GATE = WS_LIST + 4 * MiB;
constexpr size_t WS_ASG = WS_GATE + 512 * 1024;
constexpr size_t WS_LOGIT = WS_GATE + 1 * MiB;
constexpr size_t WS_WKV = WS_LOGIT + 4 * MiB;
constexpr size_t WS_WIN0 = WS_WKV + 4 * MiB;
constexpr size_t WS_WOUT0 = WS_WIN0 + 5 * MiB;
constexpr size_t WS_XQB = WS_WOUT0 + 2 * MiB;
constexpr size_t WS_XOT = WS_XQB + 4 * MiB;
constexpr size_t WS_WIN1 = WS_XOT + 4 * MiB;
constexpr size_t WS_WVG = WS_WIN1 + 2 * MiB;
constexpr size_t WS_WR = WS_WVG + 4 * MiB;
constexpr size_t WS_MEMB = WS_WR + 1 * MiB;
constexpr size_t WS_KB = WS_MEMB + 8 * MiB;
constexpr size_t WS_VB = WS_KB + 8 * MiB;
constexpr size_t WS_KFT = WS_VB + 8 * MiB;
constexpr size_t WS_VFT = WS_KFT + 32 * MiB;
constexpr size_t WS_WUP = WS_VFT + 32 * MiB;
constexpr size_t WS_WDN = WS_WUP + 128 * MiB;
constexpr size_t WS_XB = WS_WDN + 64 * MiB;
constexpr size_t WS_ZB = WS_XB + 64 * MiB;
constexpr size_t WS_BIG1 = WS_ZB + 64 * MiB;
constexpr size_t WS_BIG2 = WS_BIG1 + 272 * MiB;
constexpr size_t WS_END = WS_BIG2 + 272 * MiB;
static_assert(WS_END <= 1024 * MiB, "workspace map exceeds 1 GiB");
constexpr size_t WS_UV = WS_BIG1;
constexpr size_t WS_QX = WS_BIG1 + 64 * MiB;
constexpr size_t WS_KX = WS_BIG1 + 128 * MiB;
constexpr size_t WS_VX = WS_BIG1 + 192 * MiB;
constexpr size_t WS_SC = WS_BIG1;
constexpr size_t WS_WUP8 = WS_WUP;
constexpr size_t WS_WDN8 = WS_WUP + 64 * MiB;
constexpr size_t WS_XF8 = WS_WUP + 96 * MiB;
constexpr float SX8 = 4.0f, SWU8 = 64.0f, SA8 = 4.0f, SWD8 = 128.0f, SP8 = 256.0f, SV8 = 8.0f, SK8 = 32.0f, SY8 = 32.0f;
constexpr size_t WS_XFZ = WS_WDN;
constexpr size_t WS_SCC = WS_WDN + 32 * MiB;
constexpr size_t WS_ST2 = WS_WDN + 40 * MiB;
constexpr size_t WS_ST = WS_LOGIT;
constexpr float SZ8 = 8.0f;
constexpr size_t WS_ACT = WS_BIG1;
constexpr size_t WS_OATT = WS_BIG2;
constexpr size_t WS_MIX = WS_BIG2 + 64 * MiB;
constexpr size_t WS_P = WS_BIG2 + 128 * MiB;
constexpr size_t WS_UG = WS_BIG2;
constexpr size_t WS_YB = WS_BIG2 + 64 * MiB;
constexpr size_t WS_XG = WS_BIG2;
constexpr size_t WS_YS = WS_BIG2;

constexpr int CW_TMO = 0;
constexpr int CW_BAR = 4096;
constexpr int CW_CNT = 16384;
static_assert((CW_CNT + 64 * 64) * 4 <= (int)CTL_ZERO_BYTES && (CW_BAR + 3456) * 4 <= (int)CTL_ZERO_BYTES, "control words inside the per-call memset");

constexpr int RING_BYTES = 131072;
constexpr int SCR_BYTES = 135168;
constexpr int LDSCTL_OFF = SCR_BYTES, MISC_OFF = LDSCTL_OFF + 320;
constexpr int TAB_OFF = MISC_OFF + 128;
constexpr int SMX_OFF = TAB_OFF + 576;
constexpr int LDS_BYTES = 147456;
static_assert(SMX_OFF % 16 == 0 && SMX_OFF + 8192 <= LDS_BYTES, "LDS map");

__device__ __forceinline__ unsigned f2bf(float f) { unsigned u = __builtin_bit_cast(unsigned, f); return (u + 0x7fffu + ((u >> 16) & 1u)) >> 16; }
typedef float pk2_f32x2 __attribute__((ext_vector_type(2))); typedef __bf16 pk2_bf16x2 __attribute__((ext_vector_type(2)));
__device__ __forceinline__ unsigned pk2(float lo, float hi) { const pk2_f32x2 v = {lo, hi}; return __builtin_bit_cast(unsigned, __builtin_convertvector(v, pk2_bf16x2)); }
__device__ __forceinline__ float bflo(unsigned w) { return __builtin_bit_cast(float, w << 16); }
__device__ __forceinline__ float bfhi(unsigned w) { return __builtin_bit_cast(float, w & 0xffff0000u); }
__device__ __forceinline__ float bf2f(bf16 b) { return __builtin_bit_cast(float, ((unsigned)b) << 16); }
__device__ __forceinline__ float wave_sum(float v) {
#pragma unroll
    for (int o = 1; o < 64; o <<= 1) v += __shfl_xor(v, o);
    return v;
}
__device__ __forceinline__ float wave_max(float v) {
#pragma unroll
    for (int o = 1; o < 64; o <<= 1) v = fmaxf(v, __shfl_xor(v, o));
    return v;
}
__device__ __forceinline__ float gelu_tanh(float x) {
    const float t = x * (0.7978845608f * 2.0f * LOG2E) * (1.0f + 0.044715f * x * x);
    return x * __builtin_amdgcn_rcpf(1.0f + __builtin_amdgcn_exp2f(-t));
}
__device__ __forceinline__ f32x2 gelu_tanh2(f32x2 x, float osc) {
    constexpr float K1 = 0.7978845608f * 2.0f * LOG2E, K2 = K1 * 0.044715f; const float io = 1.0f / osc;
    const f32x2 t = x * (x * x * K2 + K1); f32x2 e; e.x = __builtin_amdgcn_exp2f(-t.x); e.y = __builtin_amdgcn_exp2f(-t.y);
    const f32x2 d = e * io + io; f32x2 rc; rc.x = __builtin_amdgcn_rcpf(d.x); rc.y = __builtin_amdgcn_rcpf(d.y); return x * rc; }
__device__ __forceinline__ float sigmoidf_(float x) { return __builtin_amdgcn_rcpf(1.0f + __builtin_amdgcn_exp2f(-x * LOG2E)); }

namespace pg8 {
constexpr int BM = 256, BK = 64, HALF = 128, HTB = HALF * BK * 2, STAGE_BYTES = 8 * HTB, NXCD = 8, WGM = 8;
constexpr int LD = 1024;
constexpr size_t HSTEP = (size_t)HALF * LD * 2, TSTEP = 2 * HSTEP;
__host__ __device__ __forceinline__ int lds_byte(int r, int c) { const int st = (r >> 4) * 2 + (c >> 5), rr = r & 15, cc = c & 31, ob = rr * 64 + cc * 2; return st * 1024 + (ob ^ (((ob >> 9) & 1) << 5)); }
__host__ __device__ __forceinline__ void stage_rc(int b, int& R, int& C) { const int st = b / 1024, sb = b % 1024, swz = sb ^ (((sb >> 9) & 1) << 5); R = (st >> 1) * 16 + swz / 64; C = (st & 1) * 32 + (swz % 64) / 2; }
__host__ __device__ __forceinline__ int perm32(int rho) { const int n = rho >> 4, i = rho & 15; return 8 * (i >> 2) + 4 * n + (i & 3); }

struct Unit { const char* a; const char* b; int row0, col0, z, aux, par; };
template <class E, class = void> struct epi_has_pre { static constexpr bool value = false; };
template <class E> struct epi_has_pre<E, decltype((void)E::HAS_PRE)> { static constexpr bool value = true; };

struct TileOrder {
    int nM, nN, nwg, G, c;
    __device__ void init(int nM_, int nN_, int G_, int c_) { nM = nM_; nN = nN_; nwg = nM * nN; G = G_; c = c_; }
    __device__ bool get(int i, int& pm, int& pn) const {
        const long L = (long)i * G + c; if (L >= nwg) return false;
        int wgid = (int)L; { const int q = nwg / NXCD, r = nwg % NXCD, xcd = wgid % NXCD, off = wgid / NXCD; wgid = (xcd < r ? xcd * (q + 1) : r * (q + 1) + (xcd - r) * q) + off; }
        const int nig = WGM * nN, gid = wgid / nig, fm = gid * WGM, gsz = (nM - fm) < WGM ? (nM - fm) : WGM;
        pm = fm + ((wgid % nig) % gsz); pn = (wgid % nig) / gsz; return true;
    }
};

__device__ __forceinline__ unsigned cvt_pk_bf16(float lo, float hi) { unsigned r; asm volatile("v_cvt_pk_bf16_f32 %0, %1, %2" : "=v"(r) : "v"(lo), "v"(hi)); return r; }

template <class Epi, class Sched, bool GATHER = false, bool FP8 = false, int ALAY = 0>
__device__ __forceinline__ void gemm_phase(LAS unsigned char* lds, const int K, const Sched& S, const Epi& E) {
    int tid = threadIdx.x; asm volatile("" : "+v"(tid));
    const int wid = __builtin_amdgcn_readfirstlane(tid >> 6), lane = tid & 63, wr = wid >> 2, wc = wid & 3, fr = lane & 15, fq = lane >> 4;
    constexpr unsigned ROWB = FP8 ? 1024u : 2048u;
    const int nt = FP8 ? K / 128 : K / BK;
    unsigned voffA[2], voffB[2]; int RA[2], CA[2];
#pragma unroll
    for (int i = 0; i < 2; ++i) { int R, C; stage_rc(tid * 16 + i * 8192, R, C); const int Rb = (R & ~31) + perm32(R & 31);
        voffA[i] = ALAY ? (unsigned)(C >> 3) * (unsigned)(MTOK * 16) + (unsigned)R * 16u : (unsigned)R * ROWB + (unsigned)C * 2u; voffB[i] = (unsigned)Rb * ROWB + (unsigned)C * 2u; RA[i] = R; CA[i] = C; }
    const size_t kstep = (size_t)(BK * 2);
    const size_t kstepA = ALAY ? (size_t)8 * MTOK * 16 : kstep;
    const size_t hstepB = (size_t)HALF * ROWB;
    const size_t hstepA = GATHER ? 0 : (ALAY ? (size_t)HALF * 16 : (size_t)HALF * ROWB);
    const unsigned ldsw = (unsigned)wid * 1024u;
    const int aoff0 = lds_byte(wr * 64 + fr, fq * 8);
    const int boff0 = lds_byte(wc * 32 + fr, fq * 8);
    unsigned aB = (unsigned)(uintptr_t)lds + (unsigned)aoff0, bB = (unsigned)(uintptr_t)lds + 4u * HTB + (unsigned)boff0; asm volatile("" : "+v"(aB), "+v"(bB));
    constexpr int KOFF = 1024;
#define PG8_SA(b, h) (((b) * 2 + (h)) * HTB)
#define PG8_SB(b, h) ((4 + (b) * 2 + (h)) * HTB)
#define PG8_STAGE(bufoff, gbase, voff) do { _Pragma("unroll") for (int _i = 0; _i < 2; ++_i) \
        __builtin_amdgcn_global_load_lds((const unsigned*)((const char*)(gbase) + (voff)[_i]), (LAS unsigned*)(lds + (bufoff) + ldsw + _i * 8192), 16, 0, 0); } while (0)
#define PG8_LD32(base, off0) __builtin_shufflevector(*(const LAS v4i_t*)((base) + (unsigned)(off0)), *(const LAS v4i_t*)((base) + (unsigned)((off0) + KOFF)), 0, 1, 2, 3, 4, 5, 6, 7)
#define PG8_LDA(dst, b, h) do { if constexpr (FP8) { _Pragma("unroll") for (int m = 0; m < 4; ++m) dst##8[m] = PG8_LD32(aB, PG8_SA(b, h) + m * 2048); } else { _Pragma("unroll") for (int m = 0; m < 4; ++m) _Pragma("unroll") for (int k = 0; k < 2; ++k) dst[m][k] = *(const LAS bf16x8*)(aB + (unsigned)(PG8_SA(b, h) + m * 2048 + k * KOFF)); } } while (0)
#define PG8_LDB(dst, b, h) do { if constexpr (FP8) { _Pragma("unroll") for (int n = 0; n < 2; ++n) dst##8[n] = PG8_LD32(bB, PG8_SA(b, h) + n * 2048); } else { _Pragma("unroll") for (int n = 0; n < 2; ++n) _Pragma("unroll") for (int k = 0; k < 2; ++k) dst[n][k] = *(const LAS bf16x8*)(bB + (unsigned)(PG8_SA(b, h) + n * 2048 + k * KOFF)); } } while (0)
#define PG8_MMA(ai, bj, At, Bt) do { __builtin_amdgcn_s_setprio(1); _Pragma("unroll") for (int m = 0; m < 4; ++m) _Pragma("unroll") for (int n = 0; n < 2; ++n) { \
        if constexpr (FP8) asm volatile("v_mfma_scale_f32_16x16x128_f8f6f4 %0, %1, %2, %0, %3, %3 op_sel_hi:[0,0,0]" : "+v"(acc[ai][bj][m][n]) : "v"(Bt##8[n]), "v"(At##8[m]), "v"(sc8)); \
        else { _Pragma("unroll") for (int k = 0; k < 2; ++k) acc[ai][bj][m][n] = __builtin_amdgcn_mfma_f32_16x16x32_bf16(Bt[n][k], At[m][k], acc[ai][bj][m][n], 0, 0, 0); } } __builtin_amdgcn_s_setprio(0); } while (0)
#define PG8_WAIT_V(n) asm volatile("s_waitcnt vmcnt(" #n ")" ::: "memory")
#define PG8_WAIT_L(n) asm volatile("s_waitcnt lgkmcnt(" #n ")" ::: "memory")
#define PG8_BAR __builtin_amdgcn_s_barrier()
#define PG8_SCHED __builtin_amdgcn_sched_barrier(0)
    Unit cur, nxt; int ui = 0;
    if (!S.next(0, cur)) return;
    f32x4 acc[2][2][4][2];
#pragma unroll
    for (int a = 0; a < 2; ++a)
#pragma unroll
        for (int b = 0; b < 2; ++b)
#pragma unroll
            for (int m = 0; m < 4; ++m)
#pragma unroll
                for (int n = 0; n < 2; ++n) acc[a][b][m][n] = (f32x4){0.f, 0.f, 0.f, 0.f};
    typedef int v8i_t __attribute__((ext_vector_type(8)));
    bf16x8 At[4][2], B0[2][2], B1[2][2]; v8i_t At8[4], B08[2], B18[2];
    int sc8 = 0x7f7f7f7f; asm volatile("" : "+v"(sc8));
    const char* cA = cur.a; const char* cB = cur.b;
    unsigned vA0[2], vA1[2], nA0[2], nA1[2];
    if constexpr (GATHER) { const int* rw = S.rows(cur);
#pragma unroll
        for (int i = 0; i < 2; ++i) { vA0[i] = (unsigned)Sched::rowmap(rw[RA[i]]) * ROWB + (unsigned)CA[i] * 2u; vA1[i] = (unsigned)Sched::rowmap(rw[128 + RA[i]]) * ROWB + (unsigned)CA[i] * 2u; nA0[i] = vA0[i]; nA1[i] = vA1[i]; } }
    else {
#pragma unroll
        for (int i = 0; i < 2; ++i) { vA0[i] = voffA[i]; vA1[i] = voffA[i]; nA0[i] = voffA[i]; nA1[i] = voffA[i]; } }
    cur.par = 0; if constexpr (epi_has_pre<Epi>::value) E.pre(cur, wid, lane);
    PG8_STAGE(PG8_SB(0, 0), cB, voffB); PG8_STAGE(PG8_SB(0, 1), cB + hstepB, voffB); PG8_STAGE(PG8_SA(0, 0), cA, vA0); PG8_STAGE(PG8_SA(0, 1), cA + hstepA, vA1);
    if (wr == 1) PG8_BAR;
    PG8_WAIT_V(2); PG8_BAR;
    PG8_STAGE(PG8_SB(1, 0), cB + kstep, voffB); PG8_STAGE(PG8_SA(1, 0), cA + kstepA, vA0); PG8_STAGE(PG8_SB(1, 1), cB + hstepB + kstep, voffB);
    PG8_WAIT_V(6); PG8_BAR;
    for (;;) {
        const bool has_next = S.next(ui + 1, nxt);
        const char* nA = has_next ? nxt.a : cA; const char* nB = has_next ? nxt.b : cB;
        int ri[4] = {0, 0, 0, 0};
        if constexpr (GATHER) { if (has_next) { const int* rw = S.rows(nxt);
#pragma unroll
            for (int i = 0; i < 4; ++i) { const int* pp = rw + (i >> 1) * 128 + RA[i & 1]; asm volatile("global_load_dword %0, %1, off" : "=v"(ri[i]) : "v"(pp) : "memory"); } } }
#pragma nounroll
        for (int t = 0; t < nt; t += 2) {
            const bool last = (t == nt - 2);
            if constexpr (GATHER) { if (last && has_next) { asm volatile("s_waitcnt vmcnt(8) ; ROWIDX" : "+v"(ri[0]), "+v"(ri[1]), "+v"(ri[2]), "+v"(ri[3]) :: "memory");
#pragma unroll
                for (int i = 0; i < 2; ++i) { nA0[i] = (unsigned)Sched::rowmap(ri[i]) * ROWB + (unsigned)CA[i] * 2u; nA1[i] = (unsigned)Sched::rowmap(ri[2 + i]) * ROWB + (unsigned)CA[i] * 2u; } } }
            const char* a1 = cA + (size_t)(t + 1) * kstepA;
            const char* a2 = last ? nA : cA + (size_t)(t + 2) * kstepA; const char* b2 = last ? nB : cB + (size_t)(t + 2) * kstep;
            const char* a3 = a2 + kstepA; const char* b3 = b2 + kstep;
            unsigned w0[2], w1[2];
#pragma unroll
            for (int i = 0; i < 2; ++i) { w0[i] = last ? nA0[i] : vA0[i]; w1[i] = last ? nA1[i] : vA1[i]; }
            PG8_LDB(B0, 0, 0); PG8_LDB(B1, 0, 1); PG8_SCHED; PG8_LDA(At, 0, 0); PG8_STAGE(PG8_SA(1, 1), a1 + hstepA, vA1);
            PG8_WAIT_V(8); PG8_WAIT_L(0); PG8_BAR; PG8_MMA(0, 0, At, B0); PG8_MMA(0, 1, At, B1); PG8_BAR; PG8_SCHED;
            PG8_LDA(At, 0, 1); PG8_STAGE(PG8_SB(0, 0), b2, voffB); PG8_STAGE(PG8_SB(0, 1), b2 + hstepB, voffB); PG8_STAGE(PG8_SA(0, 0), a2, w0);
            PG8_WAIT_V(8); PG8_WAIT_L(0); PG8_BAR; PG8_MMA(1, 0, At, B0); PG8_MMA(1, 1, At, B1); PG8_BAR; PG8_SCHED;
            PG8_LDB(B0, 1, 0); PG8_LDB(B1, 1, 1); PG8_SCHED; PG8_LDA(At, 1, 0); PG8_STAGE(PG8_SA(0, 1), a2 + hstepA, w1);
            PG8_WAIT_V(8); PG8_WAIT_L(0); PG8_BAR; PG8_MMA(0, 0, At, B0); PG8_MMA(0, 1, At, B1); PG8_BAR; PG8_SCHED;
            PG8_LDA(At, 1, 1); PG8_STAGE(PG8_SB(1, 0), b3, voffB); PG8_STAGE(PG8_SB(1, 1), b3 + hstepB, voffB); PG8_STAGE(PG8_SA(1, 0), a3, w0);
            PG8_WAIT_V(8); PG8_WAIT_L(0); PG8_BAR; PG8_MMA(1, 0, At, B0); PG8_MMA(1, 1, At, B1); PG8_BAR; PG8_SCHED;
        }
        if constexpr (epi_has_pre<Epi>::value) { if (has_next) { nxt.par = (ui + 1) & 1; E.pre(nxt, wid, lane); } }
        if (wr == 0) PG8_BAR;
        if constexpr (FP8) asm volatile("s_nop 15\n\ts_nop 15" ::: "memory");
        E(acc, cur, wr, wc, fr, fq);
        if (!has_next) break;
#pragma unroll
        for (int a = 0; a < 2; ++a)
#pragma unroll
            for (int b = 0; b < 2; ++b)
#pragma unroll
                for (int m = 0; m < 4; ++m)
#pragma unroll
                    for (int n = 0; n < 2; ++n) acc[a][b][m][n] = (f32x4){0.f, 0.f, 0.f, 0.f};
        cur = nxt; cA = nA; cB = nB; ++ui;
#pragma unroll
        for (int i = 0; i < 2; ++i) { vA0[i] = nA0[i]; vA1[i] = nA1[i]; }
        if (wr == 1) PG8_BAR;
    }
    PG8_WAIT_V(0);
    PG8_BAR;
#undef PG8_SA
#undef PG8_SB
#undef PG8_STAGE
#undef PG8_LDA
#undef PG8_LDB
#undef PG8_MMA
#undef PG8_LD32
#undef PG8_WAIT_V
#undef PG8_WAIT_L
#undef PG8_BAR
#undef PG8_SCHED
}
}
namespace attn_body {
using bf16=__hip_bfloat16;
using bf16x8=__attribute__((ext_vector_type(8)))short;
using s16x4=__attribute__((ext_vector_type(4)))short;
using f32x16=__attribute__((ext_vector_type(16)))float;
using u32x4=__attribute__((ext_vector_type(4)))unsigned;
constexpr int BATCH=16,NHEAD=16,SEQ=2048,D=64,DM=NHEAD*D;
constexpr int NW=8,QBLK=32,QB=QBLK*NW,KVBLK=64,NQB=SEQ/QB;
constexpr int ATTN_PITCH=DM, ATTN_UNIT_ROWS=QB;
__device__ __forceinline__ int crow(int r,int hi){return (r&3)+8*(r>>2)+4*hi;}
#define SBAR() __builtin_amdgcn_sched_barrier(0)
__device__ __forceinline__ void cmask(f32x16&p0,f32x16&p1,int jb,int qrel,int hi){
  const float NEG=-INFINITY; int kb=64*jb+4*hi;
  #pragma unroll
  for(int r=0;r<16;++r){int kv=kb+(r&3)+8*(r>>2); if(kv>qrel)p0[r]=NEG; if(kv+32>qrel)p1[r]=NEG;}
}

constexpr int NSLOT=3, SLOTB=8192;
constexpr int LDS_K=0, LDS_V=NSLOT*SLOTB, LDS_WS=2*NSLOT*SLOTB, LDS_OST=LDS_WS+NW*64*4, LDS_BYTES=LDS_OST+NW*4096;
constexpr float C2=0.125f*1.4426950408889634f;
__device__ __forceinline__ void glds16(const void*gsrc,unsigned lds_dst){unsigned keep;
  asm volatile("s_mov_b32 %0, m0\n\ts_mov_b32 m0, %2\n\ts_nop 0\n\tglobal_load_lds_dwordx4 %1, off\n\ts_mov_b32 m0, %0":"=&s"(keep):"v"(gsrc),"s"(lds_dst):"memory");}
__device__ __forceinline__ float max3f(float a,float b,float c){float r;asm("v_max3_f32 %0, %1, %2, %3":"=v"(r):"v"(a),"v"(b),"v"(c));return r;}
__device__ __forceinline__ float max2f(float a,float b){float r;asm("v_max_f32_e32 %0, %1, %2":"=v"(r):"v"(a),"v"(b));return r;}
__device__ __forceinline__ float fadd_s(float a,float b){float r;asm("v_add_f32_e32 %0, %1, %2":"=v"(r):"v"(a),"v"(b));return r;}
__device__ __forceinline__ float fsub_s(float a,float b){float r;asm("v_sub_f32_e32 %0, %1, %2":"=v"(r):"v"(a),"v"(b));return r;}
typedef float f32x2_t __attribute__((ext_vector_type(2))); typedef __bf16 bf16x2_t __attribute__((ext_vector_type(2)));
__device__ __forceinline__ unsigned cvtpk_s(float lo,float hi){f32x2_t v={lo,hi};bf16x2_t b=__builtin_convertvector(v,bf16x2_t);return __builtin_bit_cast(unsigned,b);}
#define WAIT_BAR(N) asm volatile("s_waitcnt vmcnt(" #N ") lgkmcnt(0)\n\ts_barrier":::"memory")

__device__ __forceinline__ void qkt(f32x16&p0,f32x16&p1,const char*Kslot,const bf16x8*qr,const f32x16&negm,int r32,int hi){
  const char*kb=Kslot+hi*1024+r32*16;
  #pragma unroll
  for(int d0=0;d0<4;++d0){
    const bf16x8 b0=*reinterpret_cast<const bf16x8*>(kb+d0*2048);
    const bf16x8 b1=*reinterpret_cast<const bf16x8*>(kb+d0*2048+512);
    if(d0==0){p0=__builtin_amdgcn_mfma_f32_32x32x16_bf16(b0,qr[0],negm,0,0,0);p1=__builtin_amdgcn_mfma_f32_32x32x16_bf16(b1,qr[0],negm,0,0,0);}
    else{p0=__builtin_amdgcn_mfma_f32_32x32x16_bf16(b0,qr[d0],p0,0,0,0);p1=__builtin_amdgcn_mfma_f32_32x32x16_bf16(b1,qr[d0],p1,0,0,0);}}
}
typedef __attribute__((address_space(3))) const char* lds_cptr;
typedef short v4i16_t __attribute__((ext_vector_type(4)));
__device__ __forceinline__ void kload8(bf16x8*kf,lds_cptr kp){
  kf[0]=*(const __attribute__((address_space(3))) bf16x8*)(kp);      kf[1]=*(const __attribute__((address_space(3))) bf16x8*)(kp+512);
  kf[2]=*(const __attribute__((address_space(3))) bf16x8*)(kp+2048); kf[3]=*(const __attribute__((address_space(3))) bf16x8*)(kp+2560);
  kf[4]=*(const __attribute__((address_space(3))) bf16x8*)(kp+4096); kf[5]=*(const __attribute__((address_space(3))) bf16x8*)(kp+4608);
  kf[6]=*(const __attribute__((address_space(3))) bf16x8*)(kp+6144); kf[7]=*(const __attribute__((address_space(3))) bf16x8*)(kp+6656);
}
__device__ __forceinline__ void kload2(bf16x8*kf,lds_cptr kp,int j){ kf[2*j]=*(const __attribute__((address_space(3))) bf16x8*)(kp+j*2048); kf[2*j+1]=*(const __attribute__((address_space(3))) bf16x8*)(kp+j*2048+512); }
__device__ __forceinline__ s16x4 vtr(lds_cptr p){ return __builtin_bit_cast(s16x4,__builtin_amdgcn_ds_read_tr16_b64_v4i16((__attribute__((address_space(3))) v4i16_t*)p)); }
__device__ __forceinline__ float rowmax(const f32x16&p0,const f32x16&p1){
  float a=max3f(p0[0],p0[1],p1[0]),b=max3f(p0[2],p0[3],p1[1]);a=max3f(a,p1[2],p1[3]);
  #pragma unroll
  for(int r=4;r<16;r+=4){a=max3f(a,p0[r],p0[r+1]);b=max3f(b,p0[r+2],p0[r+3]);a=max3f(a,p1[r],p1[r+1]);b=max3f(b,p1[r+2],p1[r+3]);}
  const float m=max2f(a,b);
  auto rr=__builtin_amdgcn_permlane32_swap(__float_as_uint(m),__float_as_uint(m),false,false);
  return max2f(__uint_as_float(rr[0]),__uint_as_float(rr[1]));
}
__device__ __forceinline__ void pv(f32x16*o,int vb,bf16x8 pa0,bf16x8 pa1,bf16x8 pa2,bf16x8 pa3){
  #pragma unroll
  for(int d0=0;d0<2;++d0){s16x4 lo[4],hi[4];
    #pragma unroll
    for(int ks=0;ks<4;++ks){
      asm volatile("ds_read_b64_tr_b16 %0,%1 offset:%c2":"=&v"(lo[ks]):"v"(vb),"i"(d0*4096+ks*1024):"memory");
      asm volatile("ds_read_b64_tr_b16 %0,%1 offset:%c2":"=&v"(hi[ks]):"v"(vb),"i"(d0*4096+ks*1024+512):"memory");}
    asm volatile("s_waitcnt lgkmcnt(0)":::"memory");SBAR();
    #define PK(k) (bf16x8){lo[k][0],lo[k][1],lo[k][2],lo[k][3],hi[k][0],hi[k][1],hi[k][2],hi[k][3]}
    o[d0]=__builtin_amdgcn_mfma_f32_32x32x16_bf16(pa0,PK(0),o[d0],0,0,0);
    o[d0]=__builtin_amdgcn_mfma_f32_32x32x16_bf16(pa1,PK(1),o[d0],0,0,0);
    o[d0]=__builtin_amdgcn_mfma_f32_32x32x16_bf16(pa2,PK(2),o[d0],0,0,0);
    o[d0]=__builtin_amdgcn_mfma_f32_32x32x16_bf16(pa3,PK(3),o[d0],0,0,0);
    #undef PK
  }
}

#ifndef ATTN_STORE16
#define ATTN_STORE16(p,v) (*(u32x4*)(p)=(v))
#endif
template<int THRL> __device__ __forceinline__ void attn_unit(int b,int h,int qb,const bf16*Q,const bf16*__restrict__ K,const bf16*__restrict__ V,bf16*O,char*shm){
  const int tid=threadIdx.x,lane=tid&63,r32=lane&31,hi=lane>>5; const int wid=__builtin_amdgcn_readfirstlane(tid>>6);
  const long rowbase=(long)b*SEQ; const int q0=qb*QB;
  const bf16*Qw=Q+(rowbase+q0+wid*QBLK)*DM+h*D;
  const bf16*Kh=K+rowbase*DM+h*D,*Vh=V+rowbase*DM+h*D;
  const unsigned lds0=(unsigned)(uintptr_t)shm;
  float*wsf=(float*)(shm+LDS_WS)+wid*64;
  const bf16*ksrc=Kh+(long)lane*DM+wid*8;
  const bf16*vsrc=Vh+(long)(16*(wid&3)+(lane>>2))*DM+(wid>>2)*32+(lane&3)*8;
  const unsigned kdst=lds0+LDS_K+wid*1024, vdst=lds0+LDS_V+wid*1024;
  #define DMA_K(t,slot) glds16(ksrc+(long)(t)*KVBLK*DM,(unsigned)__builtin_amdgcn_readfirstlane(kdst+(slot)))
  #define DMA_V(t,slot) glds16(vsrc+(long)(t)*KVBLK*DM,(unsigned)__builtin_amdgcn_readfirstlane(vdst+(slot)))
  const int vb0=(int)(lds0+LDS_V)+((lane>>4)&1)*32+(lane&3)*8+(4*hi+((lane&15)>>2))*64;
  const char*Kbase=shm+LDS_K; bf16x8 kf[8];
  const lds_cptr shm3=(lds_cptr)shm; const lds_cptr kp0=shm3+LDS_K+hi*1024+r32*16; const lds_cptr vp0=shm3+LDS_V+((lane>>4)&1)*32+(lane&3)*8+(4*hi+((lane&15)>>2))*64;
  const int NT=(q0+QB)/KVBLK;
  DMA_K(0,0);DMA_V(0,0);DMA_K(1,SLOTB);
  bf16x8 qr[4];
  #pragma unroll
  for(int d0=0;d0<4;++d0)qr[d0]=*reinterpret_cast<const bf16x8*>(&Qw[(long)r32*DM+d0*16+hi*8]);
  float mhat=0.f,l_reg=0.f;f32x16 o[2];o[0]=f32x16{};o[1]=f32x16{};f32x16 negm=f32x16{};asm volatile("":"+v"(negm));
  const int qrel=wid*QBLK+r32;
  #define CMASK(P0,P1,t) do{int jb_=(t)-(NT-4); if(jb_>=0)cmask(P0,P1,jb_,qrel,hi);}while(0)
  bool resc=false;
  #define START(P0,P1) do{ const float rm=rowmax(P0,P1); resc=false; \
    { const float dl=rm; mhat=fadd_s(mhat,dl); \
      _Pragma("unroll") for(int r=0;r<16;++r){P0[r]=fsub_s(P0[r],dl);P1[r]=fsub_s(P1[r],dl);} \
      _Pragma("unroll") for(int r=0;r<16;++r)negm[r]=-mhat; asm volatile("":"+v"(negm)); } \
    _Pragma("unroll") for(int r=0;r<16;++r)P0[r]=__builtin_amdgcn_exp2f(P0[r]); }while(0)
  #define RESC() do{ if(resc){ asm volatile("s_waitcnt lgkmcnt(0)":::"memory"); \
      _Pragma("unroll") for(int d_=0;d_<2;++d_) _Pragma("unroll") for(int r=0;r<16;++r)o[d_][r]*=wsf[crow(r,hi)]; } }while(0)
  f32x16 pA0,pA1,pB0,pB1;
  int sl_prev=0,sl_cur=0,sl_next=SLOTB;
  #define ROT() do{sl_prev=sl_cur;sl_cur=sl_next;sl_next=(sl_next==(NSLOT-1)*SLOTB)?0:sl_next+SLOTB;}while(0)
  DMA_K(2,2*SLOTB);
  WAIT_BAR(3);
  qkt(pA0,pA1,Kbase,qr,negm,r32,hi);asm volatile("s_nop 15\n\ts_nop 7":"+v"(pA0),"+v"(pA1));CMASK(pA0,pA1,0);
  START(pA0,pA1);
  _Pragma("unroll") for(int r=0;r<16;++r)pA1[r]=__builtin_amdgcn_exp2f(pA1[r]);
  WAIT_BAR(0);
  DMA_K(3,0);DMA_V(1,SLOTB);
  ROT();
  kload8(kf,kp0+sl_cur);
  WAIT_BAR(2);
  s16x4 vlo[8],vhi[8]; u32x4 pw0,pw1,pw2,pw3;
  #define PKW(P,B) cvtpk_s(P[B],P[B+1])
  #define PAF(k) __builtin_bit_cast(bf16x8,pw##k)
  #define VFR(i) (bf16x8){vlo[i][0],vlo[i][1],vlo[i][2],vlo[i][3],vhi[i][0],vhi[i][1],vhi[i][2],vhi[i][3]}
  #define PIN(x) asm volatile("":"+v"(x))
  #define MX3(a,b,c) __builtin_fmaxf(__builtin_fmaxf((a),(b)),(c))
  #define GAPA(MF,A0,A1,A2,A3,W0,W1,PW) do{ MF; sacc+=A0; sacc+=A1; sacc+=A2; sacc+=A3; PIN(sacc); W0; W1; PIN(PW); SBAR(); }while(0)
  #define EX(v) __builtin_amdgcn_exp2f(v)
  #define GAPB(MF,X,B) do{ MF; X[B]=EX(X[B]); X[B+1]=EX(X[B+1]); X[B+2]=EX(X[B+2]); X[B+3]=EX(X[B+3]); PIN(X); SBAR(); }while(0)
  #define VRD(i) do{ vlo[i]=vtr(vp_+(((i)>>2)*4096+((i)&3)*1024)); vhi[i]=vtr(vp_+(((i)>>2)*4096+((i)&3)*1024+512)); }while(0)
  #define KRD(G,j) do{ if(G){ kload2(kf,kp0+sl_next,j); SBAR(); } }while(0)
  #define STEP(C0,C1,P0,P1,t,GK,GV,GL) do{ SBAR(); \
    const lds_cptr vp_=vp0+sl_prev; \
    VRD(0); SBAR(); float sacc=(P0[0]+P0[1]); \
    GAPA(C0=__builtin_amdgcn_mfma_f32_32x32x16_bf16(kf[0],qr[0],negm,0,0,0), P0[2],P0[3],P0[4],P0[5],     pw0[0]=PKW(P0,0), pw0[1]=PKW(P0,2), pw0); \
    VRD(4); SBAR(); GAPA(C1=__builtin_amdgcn_mfma_f32_32x32x16_bf16(kf[1],qr[0],negm,0,0,0), P0[6],P0[7],P0[8],P0[9],     pw0[2]=PKW(P0,4), pw0[3]=PKW(P0,6), pw0); \
    VRD(1); SBAR(); GAPA(C0=__builtin_amdgcn_mfma_f32_32x32x16_bf16(kf[2],qr[1],C0,0,0,0),   P0[10],P0[11],P0[12],P0[13], pw1[0]=PKW(P0,8), pw1[1]=PKW(P0,10), pw1); \
    VRD(5); SBAR(); GAPA(C1=__builtin_amdgcn_mfma_f32_32x32x16_bf16(kf[3],qr[1],C1,0,0,0),   P0[14],P0[15],P1[0],P1[1],   pw1[2]=PKW(P0,12),pw1[3]=PKW(P0,14), pw1); \
    VRD(2); SBAR(); GAPA(C0=__builtin_amdgcn_mfma_f32_32x32x16_bf16(kf[4],qr[2],C0,0,0,0),   P1[2],P1[3],P1[4],P1[5],     pw2[0]=PKW(P1,0), pw2[1]=PKW(P1,2), pw2); \
    VRD(6); SBAR(); GAPA(C1=__builtin_amdgcn_mfma_f32_32x32x16_bf16(kf[5],qr[2],C1,0,0,0),   P1[6],P1[7],P1[8],P1[9],     pw2[2]=PKW(P1,4), pw2[3]=PKW(P1,6), pw2); \
    VRD(3); SBAR(); GAPA(C0=__builtin_amdgcn_mfma_f32_32x32x16_bf16(kf[6],qr[3],C0,0,0,0),   P1[10],P1[11],P1[12],P1[13], pw3[0]=PKW(P1,8), pw3[1]=PKW(P1,10), pw3); \
    VRD(7); SBAR(); GAPA(C1=__builtin_amdgcn_mfma_f32_32x32x16_bf16(kf[7],qr[3],C1,0,0,0),   P1[14],P1[15],0.f,0.f,       pw3[2]=PKW(P1,12),pw3[3]=PKW(P1,14), pw3); \
    l_reg+=sacc; \
    if(GK){DMA_K((t)+3,sl_cur);} if(GV){DMA_V((t)+1,sl_next);} \
    CMASK(C0,C1,t); \
    { float a=MX3(C0[0],C0[1],C1[0]),b=MX3(C0[2],C0[3],C1[1]); a=MX3(a,C1[2],C1[3]); \
      _Pragma("unroll") for(int r=4;r<16;r+=4){a=MX3(a,C0[r],C0[r+1]);b=MX3(b,C0[r+2],C0[r+3]);a=MX3(a,C1[r],C1[r+1]);b=MX3(b,C1[r+2],C1[r+3]);} \
      float rm=__builtin_fmaxf(a,b); { auto rr=__builtin_amdgcn_permlane32_swap(__float_as_uint(rm),__float_as_uint(rm),false,false); rm=__builtin_fmaxf(__uint_as_float(rr[0]),__uint_as_float(rr[1])); } \
      resc=false; \
      if(__builtin_expect(__any(rm>(float)THRL),0)){ const float dl=__builtin_fmaxf(rm,0.f); mhat+=dl; \
        _Pragma("unroll") for(int r=0;r<16;++r){C0[r]-=dl;C1[r]-=dl;} \
        _Pragma("unroll") for(int r=0;r<16;++r)negm[r]=-mhat; asm volatile("":"+v"(negm)); \
        const float f=__builtin_amdgcn_exp2f(-dl); l_reg*=f; if(hi==0)wsf[r32]=f; resc=true; } } \
    SBAR(); \
    GAPB(o[0]=__builtin_amdgcn_mfma_f32_32x32x16_bf16(PAF(0),VFR(0),o[0],0,0,0), C0,0); \
    GAPB(o[1]=__builtin_amdgcn_mfma_f32_32x32x16_bf16(PAF(0),VFR(4),o[1],0,0,0), C0,4); \
    KRD(GL,0); GAPB(o[0]=__builtin_amdgcn_mfma_f32_32x32x16_bf16(PAF(1),VFR(1),o[0],0,0,0), C0,8); \
    KRD(GL,1); GAPB(o[1]=__builtin_amdgcn_mfma_f32_32x32x16_bf16(PAF(1),VFR(5),o[1],0,0,0), C0,12); \
    KRD(GL,2); GAPB(o[0]=__builtin_amdgcn_mfma_f32_32x32x16_bf16(PAF(2),VFR(2),o[0],0,0,0), C1,0); \
    KRD(GL,3); GAPB(o[1]=__builtin_amdgcn_mfma_f32_32x32x16_bf16(PAF(2),VFR(6),o[1],0,0,0), C1,4); \
    GAPB(o[0]=__builtin_amdgcn_mfma_f32_32x32x16_bf16(PAF(3),VFR(3),o[0],0,0,0), C1,8); \
    GAPB(o[1]=__builtin_amdgcn_mfma_f32_32x32x16_bf16(PAF(3),VFR(7),o[1],0,0,0), C1,12); \
    }while(0)
  int t=1;
  #undef CMASK
  #define CMASK(P0,P1,t) do{}while(0)
  for(;t+5<NT;t+=2){
    STEP(pB0,pB1,pA0,pA1,t,true,true,true);     WAIT_BAR(2); RESC(); ROT();
    STEP(pA0,pA1,pB0,pB1,t+1,true,true,true);   WAIT_BAR(2); RESC(); ROT();
  }
  #undef CMASK
  #define CMASK(P0,P1,t) do{int jb_=(t)-(NT-4); if(jb_>=0)cmask(P0,P1,jb_,qrel,hi);}while(0)
  #define ENDW(tt) do{ if((tt)+3<NT){WAIT_BAR(2);} else if((tt)+2<NT){WAIT_BAR(1);} else {WAIT_BAR(0);} }while(0)
  for(;t+1<NT;t+=2){
    STEP(pB0,pB1,pA0,pA1,t,(t+3<NT),(t+1<NT),(t+1<NT));       ENDW(t);   RESC(); ROT();
    STEP(pA0,pA1,pB0,pB1,t+1,(t+4<NT),(t+2<NT),(t+2<NT));     ENDW(t+1); RESC(); ROT();
  }
  STEP(pB0,pB1,pA0,pA1,NT-1,false,false,false); RESC();
  { float sacc=pB0[0]+pB0[1]; _Pragma("unroll") for(int r=2;r<16;++r)sacc+=pB0[r]; _Pragma("unroll") for(int r=0;r<16;++r)sacc+=pB1[r]; l_reg+=sacc;
    pw0=(u32x4){PKW(pB0,0),PKW(pB0,2),PKW(pB0,4),PKW(pB0,6)};pw1=(u32x4){PKW(pB0,8),PKW(pB0,10),PKW(pB0,12),PKW(pB0,14)};pw2=(u32x4){PKW(pB1,0),PKW(pB1,2),PKW(pB1,4),PKW(pB1,6)};pw3=(u32x4){PKW(pB1,8),PKW(pB1,10),PKW(pB1,12),PKW(pB1,14)};
    SBAR(); pv(o,vb0+sl_cur,PAF(0),PAF(1),PAF(2),PAF(3)); }
  #undef PKW
  #undef PAF
  #undef VFR
  #undef PIN
  #undef MX3
  #undef GAPA
  #undef GAPB
  #undef EX
  #undef VRD
  #undef KRD
  #undef STEP
  #undef ENDW
  {auto rr=__builtin_amdgcn_permlane32_swap(__float_as_uint(l_reg),__float_as_uint(l_reg),false,false);l_reg=__uint_as_float(rr[0])+__uint_as_float(rr[1]);}
  if(hi==0)wsf[32+r32]=l_reg;asm volatile("s_waitcnt lgkmcnt(0)":::"memory");
  float rli[16];
  #pragma unroll
  for(int r=0;r<16;++r)rli[r]=__builtin_amdgcn_rcpf(wsf[32+crow(r,hi)]);
  bf16*Ow=O+(rowbase+q0+wid*QBLK)*DM+h*D;
  { bf16*stg=(bf16*)(shm+LDS_OST)+wid*2048;
    #pragma unroll
    for(int r=0;r<16;++r){const int orow=crow(r,hi);
      #pragma unroll
      for(int d0=0;d0<2;++d0)stg[orow*64+d0*32+r32]=__float2bfloat16(o[d0][r]*rli[r]);}
    asm volatile("s_waitcnt lgkmcnt(0)":::"memory");
    #pragma unroll
    for(int i=0;i<4;++i){const int row=i*8+(lane>>3),ch=lane&7; const u32x4 v=*(const u32x4*)(stg+row*64+ch*8); ATTN_STORE16(Ow+(long)row*DM+ch*8,v);} }
  asm volatile("s_waitcnt lgkmcnt(0)\n\ts_barrier":::"memory");
  #undef DMA_K
  #undef DMA_V
  #undef CMASK
  #undef START
  #undef RESC
  #undef ROT
}
constexpr int ATTN_LDS_BYTES=LDS_BYTES;
struct AttnTensors { const bf16* Q; const bf16* K; const bf16* V; bf16* O; };
struct AttnUnit { int bh; int qb; };
struct StaticOrder {
  int vcu;
  __device__ __forceinline__ explicit StaticOrder(int grid,int block):vcu((block%8)*(grid/8)+block/8){}
  __device__ __forceinline__ bool next(int i,AttnUnit&u)const{ if(i>=8)return false; const int pr=vcu&3; u.bh=(vcu>>2)*4+(i&3); u.qb=(i==0)?pr:(i==1)?pr:(i==2)?pr:(i==3)?pr:(i==4)?7-pr:(i==5)?7-pr:(i==6)?7-pr:7-pr; return true; }
  __device__ __forceinline__ void a_ready(const AttnUnit&)const{}
  __device__ __forceinline__ void done(const AttnUnit&)const{}
};
template<class Sched,int THRL=8> __device__ __forceinline__ void attn_phase(char*lds,const AttnTensors&T,const Sched&S){
  AttnUnit u;
  for(int i=0;S.next(i,u);++i){ S.a_ready(u); const int vhd=u.bh%NHEAD, hq=vhd>>1, hv=(vhd>>2)*2+(vhd&1);
    attn_unit<THRL>(u.bh/NHEAD,hq,u.qb,T.Q,T.K,T.V+(hv-hq)*D,T.O+(vhd-hq)*D,lds); S.done(u); }
}
#undef SBAR
#undef WAIT_BAR
}
#define XB_TMO      128
#define XB_XCNT(j)  (256  + 64 * (j))
#define XB_XSUB(j)  (1280 + 64 * (j))
#define XB_XGEN(j)  (2304 + 64 * (j))
#define XB_TOP      3328
#define XB_TOPGEN   3392
#define XCD_BAR_WORDS 3456
#define XB_SPIN_CAP (1u << 18)

__device__ __forceinline__ unsigned xb_ld(unsigned* p)              { return __hip_atomic_load(p, __ATOMIC_RELAXED, __HIP_MEMORY_SCOPE_AGENT); }
__device__ __forceinline__ unsigned xb_add(unsigned* p, unsigned v) { return __hip_atomic_fetch_add(p, v, __ATOMIC_RELAXED, __HIP_MEMORY_SCOPE_AGENT); }
__device__ __forceinline__ unsigned xb_xcc_id() { return (unsigned)__builtin_amdgcn_s_getreg((3 << 11) | 20) & 0xFu; }
#define XB_SPIN(cond, bar) do { unsigned _sp = 0; while (cond) { __builtin_amdgcn_s_sleep(1); \
    if ((++_sp & 255u) == 0u) { if (xb_ld(&(bar)[XB_TMO])) break; if (_sp > XB_SPIN_CAP) { atomicAdd(&(bar)[XB_TMO], 1u); break; } } } } while (0)

struct XcdBarrier {
    unsigned* bar; unsigned x;
    volatile LAS unsigned* st;
};

__device__ __forceinline__ XcdBarrier xcd_barrier_post(unsigned* bar, volatile LAS unsigned* st) {
    XcdBarrier b; b.bar = bar; b.x = xb_xcc_id(); b.st = st;
    if (threadIdx.x == 0) (void)xb_add(&bar[XB_XCNT(b.x)], 1u);
    return b;
}
__device__ __forceinline__ void xcd_barrier_complete(unsigned* bar, unsigned x, unsigned& nloc, unsigned& nx) {
    const unsigned G = gridDim.x * gridDim.y * gridDim.z;
    unsigned sum, cnt, mine, sp = 0u;
    for (;;) {
        sum = 0u; cnt = 0u; mine = 0u;
#pragma unroll
        for (unsigned j = 0; j < 16; ++j) { const unsigned c = xb_ld(&bar[XB_XCNT(j)]); sum += c; cnt += (c > 0u) ? 1u : 0u; mine = (j == x) ? c : mine; }
        if (sum == G) break;
        __builtin_amdgcn_s_sleep(1);
        if ((++sp & 255u) == 0u) { if (xb_ld(&bar[XB_TMO])) break; if (sp > XB_SPIN_CAP) { atomicAdd(&bar[XB_TMO], 1u); break; } }
    }
    nloc = mine > 0u ? mine : 1u; nx = cnt > 0u ? cnt : 1u;
}

__device__ __forceinline__ void xcd_barrier(const XcdBarrier& b) {
    asm volatile("s_waitcnt vmcnt(0)" ::: "memory");
    __syncthreads();
    if (threadIdx.x == 0) {
        unsigned* bar = b.bar;
        __builtin_amdgcn_s_waitcnt(0);
        unsigned nloc = b.st[0], nx = b.st[1];
        if (nloc == 0u) { xcd_barrier_complete(bar, b.x, nloc, nx); b.st[0] = nloc; b.st[1] = nx; }
        const unsigned old = xb_add(&bar[XB_XSUB(b.x)], 1u);
        const unsigned gen = old / nloc;
        if (old + 1u == (gen + 1u) * nloc) {
            __builtin_amdgcn_fence(__ATOMIC_RELEASE, "agent");
            asm volatile("s_waitcnt vmcnt(0)" ::: "memory");
            const unsigned og = xb_add(&bar[XB_TOP], 1u);
            const unsigned tg = og / nx;
            if (og + 1u == (tg + 1u) * nx) xb_add(&bar[XB_TOPGEN], 1u);
            else XB_SPIN(xb_ld(&bar[XB_TOPGEN]) == tg, bar);
            __builtin_amdgcn_fence(__ATOMIC_ACQUIRE, "agent");
            xb_add(&bar[XB_XGEN(b.x)], 1u);
            asm volatile("s_waitcnt vmcnt(0)" ::: "memory");
        } else {
            XB_SPIN(xb_ld(&bar[XB_XGEN(b.x)]) == gen, bar);
            __builtin_amdgcn_fence(__ATOMIC_ACQUIRE, "agent");
            asm volatile("s_waitcnt vmcnt(0)" ::: "memory");
        }
    }
    __syncthreads();
}

constexpr int NWAVES = 8;
struct Frame { LAS unsigned char* lds; volatile LAS unsigned* MISC; gu32* ctl; int wave, vcu, G; };
__device__ __forceinline__ int opaque_tid() { int t = (int)threadIdx.x; asm volatile("" : "+v"(t)); return t; }
#define FTID ((int)threadIdx.x)
#define FLANE ((int)(threadIdx.x & 63u))
struct Args { const float* in[53]; float* out; unsigned char* ws; int ph_lo, ph_hi, variant, pad; };
#define EPI_ARGS const f32x4 (&acc)[2][2][4][2], const pg8::Unit& u, int wr, int wc, int fr, int fq

__device__ __forceinline__ int maprow(int mode, int n) {
    if (mode == 0) return n;
    if (mode == 1) return (n >> 7) * 256 + (n & 127);
    if (mode == 2) return (n >> 7) * 256 + 128 + (n & 127);
    const int j = n & 1023; return (j >> 7) * 256 + ((n >> 10) << 7) + (j & 127);
}
__device__ __forceinline__ void tr_item(const float* W, int N, bf16* WT, int mode, LAS float* scr, int item, int lane) {
    const int nblk = N >> 5, kb = item / nblk, nb = item - kb * nblk, k0 = 64 * kb, n0 = 32 * nb;
#pragma unroll 8
    for (int i = 0; i < 32; ++i) { const int kk = 2 * i + (lane >> 5); scr[kk * 33 + (lane & 31)] = W[(size_t)(k0 + kk) * N + n0 + (lane & 31)]; }
    LDS_WAIT(); asm volatile("" ::: "memory");
    const int c = lane & 7; const int r0 = maprow(mode, n0);
#pragma unroll
    for (int j = 0; j < 4; ++j) { const int n = (lane >> 3) + 8 * j; const LAS float* s = scr + (8 * c) * 33 + n;
        v4u o; o.x = pk2(s[0 * 33], s[1 * 33]); o.y = pk2(s[2 * 33], s[3 * 33]); o.z = pk2(s[4 * 33], s[5 * 33]); o.w = pk2(s[6 * 33], s[7 * 33]);
        *(GAS v4u*)(WT + (size_t)(r0 + n) * 1024 + k0 + 8 * c) = o; }
    LDS_WAIT(); asm volatile("" ::: "memory");
}
__device__ __forceinline__ unsigned pk4_fp8(float a, float b, float c, float d) {
    a = __builtin_amdgcn_fmed3f(a, -448.f, 448.f); b = __builtin_amdgcn_fmed3f(b, -448.f, 448.f); c = __builtin_amdgcn_fmed3f(c, -448.f, 448.f); d = __builtin_amdgcn_fmed3f(d, -448.f, 448.f);
    int r = __builtin_amdgcn_cvt_pk_fp8_f32(a, b, 0, false); r = __builtin_amdgcn_cvt_pk_fp8_f32(c, d, r, true); return (unsigned)r; }
__device__ __forceinline__ void tr_item8(const float* W, int N, unsigned char* WT, int mode, float scale, LAS float* scr, int item, int lane) {
    const int nblk = N >> 5, kb = item / nblk, nb = item - kb * nblk, k0 = 128 * kb, n0 = 32 * nb;
#pragma unroll 8
    for (int i = 0; i < 64; ++i) { const int kk = 2 * i + (lane >> 5); scr[kk * 33 + (lane & 31)] = W[(size_t)(k0 + kk) * N + n0 + (lane & 31)] * scale; }
    LDS_WAIT(); asm volatile("" ::: "memory");
    const int c = lane & 7; const int r0 = maprow(mode, n0);
#pragma unroll
    for (int j = 0; j < 4; ++j) { const int n = (lane >> 3) + 8 * j; const LAS float* p = scr + (16 * c) * 33 + n;
        v4u o; o.x = pk4_fp8(p[0 * 33], p[1 * 33], p[2 * 33], p[3 * 33]); o.y = pk4_fp8(p[4 * 33], p[5 * 33], p[6 * 33], p[7 * 33]);
        o.z = pk4_fp8(p[8 * 33], p[9 * 33], p[10 * 33], p[11 * 33]); o.w = pk4_fp8(p[12 * 33], p[13 * 33], p[14 * 33], p[15 * 33]);
        *(GAS v4u*)(WT + (size_t)(r0 + n) * 1024 + k0 + 16 * c) = o; }
    LDS_WAIT(); asm volatile("" ::: "memory");
}
__device__ __forceinline__ void cvt_plain(const float* src, bf16* dst, size_t n, size_t gtid, size_t nth) {
    for (size_t i = gtid * 8; i < n; i += nth * 8) { const f32x4 a = *(const GAS f32x4*)(src + i), b = *(const GAS f32x4*)(src + i + 4);
        v4u o; o.x = pk2(a.x, a.y); o.y = pk2(a.z, a.w); o.z = pk2(b.x, b.y); o.w = pk2(b.z, b.w); *(GAS v4u*)(dst + i) = o; }
}
__device__ __forceinline__ void cvt_experts(Frame& F, const float* wup, const float* wdn, unsigned char* ws) {
    const int gw = F.vcu * NWAVES + F.wave, NGW = F.G * NWAVES;
#if MOE_FP8
    LAS float* tl = (LAS float*)F.lds;
    for (int it = F.vcu; it < NEXP * 96; it += F.G) { const int e = it / 96, r = it - e * 96; const bool up = r < 64; const int rr = up ? r : r - 64;
        const int N = up ? 2048 : 1024, nb = up ? (rr & 7) : (rr & 3), kb = up ? (rr >> 3) : (rr >> 2), k0 = 128 * kb, n0 = 256 * nb;
        const float* W = up ? wup + (size_t)e * 1024 * 2048 : wdn + (size_t)e * 1024 * 1024; unsigned char* WT = up ? ws + WS_WUP8 + (size_t)e * 2048 * 1024 : ws + WS_WDN8 + (size_t)e * 1024 * 1024;
        const float scale = up ? SWU8 : SWD8; const int mode = up ? 3 : 0;
        __syncthreads();
        f32x4 v[16];
#pragma unroll
        for (int i = 0; i < 16; ++i) { const int idx = i * 512 + FTID, row = idx >> 6, c4 = idx & 63; v[i] = *(const GAS f32x4*)(W + (size_t)(k0 + row) * N + n0 + 4 * c4); }
#pragma unroll
        for (int i = 0; i < 16; ++i) { const int idx = i * 512 + FTID, row = idx >> 6, c4 = idx & 63; *(LAS f32x4*)(tl + row * 260 + 4 * (c4 ^ (row >> 4))) = v[i] * scale; }
        __syncthreads();
#pragma unroll
        for (int j = 0; j < 4; ++j) { const int idx = j * 512 + FTID, n = idx >> 3, c = idx & 7; const LAS float* p = tl + (16 * c) * 260 + (n ^ (4 * c));
            v4u o; o.x = pk4_fp8(p[0 * 260], p[1 * 260], p[2 * 260], p[3 * 260]); o.y = pk4_fp8(p[4 * 260], p[5 * 260], p[6 * 260], p[7 * 260]);
            o.z = pk4_fp8(p[8 * 260], p[9 * 260], p[10 * 260], p[11 * 260]); o.w = pk4_fp8(p[12 * 260], p[13 * 260], p[14 * 260], p[15 * 260]);
            *(GAS v4u*)(WT + (size_t)maprow(mode, n0 + n) * 1024 + k0 + 16 * c) = o; }
    }
    __syncthreads();
    return;
#endif
    LAS float* scr = (LAS float*)(F.lds + F.wave * 16384);
    for (int it = gw; it < NEXP * 1536; it += NGW) { const int e = it / 1536, r = it - e * 1536;
        if (r < 1024) tr_item(wup + (size_t)e * 1024 * 2048, 2048, (bf16*)(ws + WS_WUP) + (size_t)e * 2048 * 1024, 3, scr, r, FLANE);
        else tr_item(wdn + (size_t)e * 1024 * 1024, 1024, (bf16*)(ws + WS_WDN) + (size_t)e * 1024 * 1024, 0, scr, r - 1024, FLANE); }
}
__device__ __forceinline__ void p0_prologue(Frame& F, const Args& a) {
    unsigned char* ws = a.ws;
    LAS float* scr = (LAS float*)(F.lds + F.wave * 16896);
    const int gw = F.vcu * NWAVES + F.wave, NGW = F.G * NWAVES;
    constexpr int I0 = 16 * 64, I1 = I0 + 16 * 80, I2 = I1 + 512, I3 = I2 + 512, I4 = I3 + 512, I5 = I4 + 256, I6 = I5 + 256, I7 = I6 + 256, I8 = I7 + 16, I9 = I8 + 16;
    for (int it = gw; it < I9; it += NGW) {
        if (it < I0) tr_item(a.in[2], 2048, (bf16*)(ws + WS_WKV), 0, scr, it, FLANE);
        else if (it < I1) tr_item(a.in[3], 2560, (bf16*)(ws + WS_WIN0), 0, scr, it - I0, FLANE);
        else if (it < I2) tr_item(a.in[13], 1024, (bf16*)(ws + WS_WOUT0), 0, scr, it - I1, FLANE);
        else if (it < I3) tr_item(a.in[17], 1024, (bf16*)(ws + WS_XOT), 0, scr, it - I2, FLANE);
        else if (it < I4) tr_item(a.in[42], 1024, (bf16*)(ws + WS_XOT) + 1024 * 1024, 0, scr, it - I3, FLANE);
        else if (it < I5) tr_item8(a.in[28], 1024, ws + WS_WIN1, 0, SWU8, scr, it - I4, FLANE);
        else if (it < I6) tr_item8(a.in[37], 1024, ws + WS_WVG, 1, SWD8, scr, it - I5, FLANE);
        else if (it < I7) tr_item8(a.in[38], 1024, ws + WS_WVG, 2, SWU8, scr, it - I6, FLANE);
        else if (it < I8) tr_item(a.in[20], 32, (bf16*)(ws + WS_WR), 0, scr, it - I7, FLANE);
        else tr_item(a.in[45], 32, (bf16*)(ws + WS_WR) + 256 * 1024, 0, scr, it - I8, FLANE);
    }
    cvt_experts(F, a.in[22], a.in[24], ws);
    const size_t gtid = (size_t)F.vcu * 512 + FTID, nth = (size_t)F.G * 512;
    cvt_plain(a.in[16], (bf16*)(ws + WS_XQB), 1024 * 1024, gtid, nth);
    cvt_plain(a.in[41], (bf16*)(ws + WS_XQB) + 1024 * 1024, 1024 * 1024, gtid, nth);
    cvt_plain(a.in[1], (bf16*)(ws + WS_MEMB), (size_t)NB * MEMLEN * DM, gtid, nth);
    cvt_plain(a.in[0], (bf16*)(ws + WS_XB), (size_t)MTOK * DM, gtid, nth);
}

__device__ __forceinline__ void moe_tables(Frame& F, gu32* cnt) {
    LAS int* tab = (LAS int*)(F.lds + TAB_OFF);
    if (FTID < 32) tab[FTID] = (int)__hip_atomic_load(cnt + FTID * 64, RLX_AGENT);
    __syncthreads();
    if (FTID == 0) { int s = 0; for (int e = 0; e < NEXP; ++e) { tab[32 + e] = s; s += (tab[e] + 255) >> 8; } tab[64] = s; }
    __syncthreads();
}

template <int MODE>
__device__ __forceinline__ void ph_ln(Frame& F, const bf16* zb, const bf16* ys, bf16* xb, float* outf, const float* g, const float* b, unsigned char* x8 = nullptr, const int* asg = nullptr, const float* gate = nullptr,
                                      const float* st2 = nullptr, const float* g2 = nullptr, const float* b2 = nullptr) {
    LAS const int* tab = (LAS const int*)(F.lds + TAB_OFF);
    const int gw = F.vcu * NWAVES + F.wave, NGW = F.G * NWAVES, c0 = 8 * FLANE;
    float gv[16], bv[16];
#pragma unroll
    for (int h = 0; h < 2; ++h)
#pragma unroll
        for (int q = 0; q < 2; ++q) { const f32x4 t = *(const GAS f32x4*)(g + c0 + 512 * h + 4 * q), s = *(const GAS f32x4*)(b + c0 + 512 * h + 4 * q);
            gv[8 * h + 4 * q + 0] = t.x; gv[8 * h + 4 * q + 1] = t.y; gv[8 * h + 4 * q + 2] = t.z; gv[8 * h + 4 * q + 3] = t.w;
            bv[8 * h + 4 * q + 0] = s.x; bv[8 * h + 4 * q + 1] = s.y; bv[8 * h + 4 * q + 2] = s.z; bv[8 * h + 4 * q + 3] = s.w; }
    constexpr bool REB = (MODE == 1) && MOE_FP8; float g2v[REB ? 16 : 1], b2v[REB ? 16 : 1];
    if constexpr (REB) {
#pragma unroll
        for (int h = 0; h < 2; ++h)
#pragma unroll
            for (int q = 0; q < 2; ++q) { const f32x4 t = *(const GAS f32x4*)(g2 + c0 + 512 * h + 4 * q), s = *(const GAS f32x4*)(b2 + c0 + 512 * h + 4 * q);
#pragma unroll
                for (int j = 0; j < 4; ++j) { g2v[8 * h + 4 * q + j] = ALPHA * t[j]; b2v[8 * h + 4 * q + j] = ALPHA * s[j]; } } }
    constexpr int RI = (MODE == 0) ? 4 : 2;
    for (int m0 = gw * RI; m0 < MTOK; m0 += NGW * RI) {
        v4u raw[RI][2]; v4u yr[(MODE == 1) ? RI : 1][2][4]; f32x4 gt[(MODE == 1) ? RI : 1]; f32x2 ms[RI];
#pragma unroll
        for (int r = 0; r < RI; ++r) { const size_t m = (size_t)(m0 + r); size_t yrow[4] = {0, 0, 0, 0};
            if constexpr (REB) ms[r] = *(const GAS f32x2*)(st2 + m * 2);
            if (MODE == 1) { const v4i_t as = *(const GAS v4i_t*)(asg + m * 4); gt[r] = *(const GAS f32x4*)(gate + m * 4);
#pragma unroll
                for (int k = 0; k < 4; ++k) yrow[k] = (size_t)(tab[32 + (as[k] >> 16)] * 256 + (as[k] & 0xffff)); }
#pragma unroll
            for (int h = 0; h < 2; ++h) {
                raw[r][h] = *(const GAS v4u*)(((MODE == 0 || REB) ? zb : xb) + m * DM + c0 + 512 * h);
                if (MODE == 1) {
#pragma unroll
                    for (int k = 0; k < 4; ++k) { const v2u t8 = *(const GAS v2u*)((const unsigned char*)ys + yrow[k] * DM + c0 + 512 * h); yr[r][h][k] = (v4u){t8.x, t8.y, 0u, 0u}; } } } }
#pragma unroll
        for (int r = 0; r < RI; ++r) { const size_t m = (size_t)(m0 + r);
            float v[16];
#pragma unroll
            for (int h = 0; h < 2; ++h) { const v4u w = raw[r][h]; const float sc = (MODE == 0) ? 1.0f : ALPHA;
                v[8 * h + 0] = sc * bflo(w.x); v[8 * h + 1] = sc * bfhi(w.x); v[8 * h + 2] = sc * bflo(w.y); v[8 * h + 3] = sc * bfhi(w.y); v[8 * h + 4] = sc * bflo(w.z); v[8 * h + 5] = sc * bfhi(w.z); v[8 * h + 6] = sc * bflo(w.w); v[8 * h + 7] = sc * bfhi(w.w);
                if constexpr (REB) { const float mu2 = ms[r][0] * ALPHA, rs2 = ms[r][1];
#pragma unroll
                    for (int j = 0; j < 8; ++j) v[8 * h + j] = (v[8 * h + j] - mu2) * rs2 * g2v[8 * h + j] * (1.0f / ALPHA) + b2v[8 * h + j]; }
                if (MODE == 1) {
#pragma unroll
                    for (int k = 0; k < 4; ++k) { const v4u y = yr[r][h][k]; const float gk = gt[r][k] * (1.0f / SY8);
                        const f32x2 p0 = __builtin_amdgcn_cvt_pk_f32_fp8((int)y.x, false), p1 = __builtin_amdgcn_cvt_pk_f32_fp8((int)y.x, true), p2 = __builtin_amdgcn_cvt_pk_f32_fp8((int)y.y, false), p3 = __builtin_amdgcn_cvt_pk_f32_fp8((int)y.y, true);
                        v[8 * h + 0] += gk * p0[0]; v[8 * h + 1] += gk * p0[1]; v[8 * h + 2] += gk * p1[0]; v[8 * h + 3] += gk * p1[1]; v[8 * h + 4] += gk * p2[0]; v[8 * h + 5] += gk * p2[1]; v[8 * h + 6] += gk * p3[0]; v[8 * h + 7] += gk * p3[1]; } } }
            float s = 0.f;
#pragma unroll
            for (int j = 0; j < 16; ++j) s += v[j];
            const float mean = wave_sum(s) * (1.f / DM); float s2 = 0.f;
#pragma unroll
            for (int j = 0; j < 16; ++j) { v[j] -= mean; s2 += v[j] * v[j]; }
            const float rstd = 1.f / sqrtf(wave_sum(s2) * (1.f / DM) + LN_EPS);
#pragma unroll
            for (int j = 0; j < 16; ++j) v[j] = v[j] * rstd * gv[j] + bv[j];
#pragma unroll
            for (int h = 0; h < 2; ++h) { v4u o; o.x = pk2(v[8 * h], v[8 * h + 1]); o.y = pk2(v[8 * h + 2], v[8 * h + 3]); o.z = pk2(v[8 * h + 4], v[8 * h + 5]); o.w = pk2(v[8 * h + 6], v[8 * h + 7]);
                if (!outf) *(GAS v4u*)(xb + m * DM + c0 + 512 * h) = o;
                if (x8) { v2u o8; o8.x = pk4_fp8(v[8 * h] * SX8, v[8 * h + 1] * SX8, v[8 * h + 2] * SX8, v[8 * h + 3] * SX8); o8.y = pk4_fp8(v[8 * h + 4] * SX8, v[8 * h + 5] * SX8, v[8 * h + 6] * SX8, v[8 * h + 7] * SX8);
                          *(GAS v2u*)(x8 + m * DM + c0 + 512 * h) = o8; }
                if (outf) { *(GAS f32x4*)(outf + m * DM + c0 + 512 * h) = (f32x4){v[8 * h], v[8 * h + 1], v[8 * h + 2], v[8 * h + 3]};
                            *(GAS f32x4*)(outf + m * DM + c0 + 512 * h + 4) = (f32x4){v[8 * h + 4], v[8 * h + 5], v[8 * h + 6], v[8 * h + 7]}; } }
        }
    }
}
__device__ __forceinline__ void ph_ln2_router(Frame& F, const bf16* zb, bf16* xb, unsigned char* x8, const float* g, const float* b, const bf16* wrT, const float* rbias,
                                              gu32* cnt, int* list, float* gate, int* asg, float* st2) {
    LAS int* cl = (LAS int*)F.lds;
    LAS float* gl = (LAS float*)(F.lds + 256);
    LAS bf16* wl = (LAS bf16*)(F.lds + 256 + 8192);
    const int rw = FLANE & 15, q = FLANE >> 4;
    for (int i = FTID; i < 256; i += 512) { ((LAS f32x4*)gl)[i] = *(const GAS f32x4*)(g + 4 * i); ((LAS f32x4*)gl)[256 + i] = *(const GAS f32x4*)(b + 4 * i); }
    for (int i = FTID; i < 4096; i += 512) { const int e = i >> 7, c = i & 127; *(LAS v4u*)(wl + e * 1032 + 8 * c) = *(const GAS v4u*)(wrT + (size_t)e * DM + 8 * c); }
    for (int blk = F.vcu; blk < MTOK / 128; blk += F.G) {
        __syncthreads();
        if (FTID < 64) cl[FTID] = 0;
        __syncthreads();
        const int row = blk * 128 + F.wave * 16 + rw;
        const bf16* zr = zb + (size_t)row * DM + 8 * q;
        v4u zz[32];
#pragma unroll
        for (int ks = 0; ks < 32; ++ks) zz[ks] = *(const GAS v4u*)(zr + 32 * ks);
        float s1 = 0.f, s2 = 0.f;
#pragma unroll
        for (int ks = 0; ks < 32; ++ks) { const v4u w = zz[ks]; const float x0 = bflo(w.x), x1 = bfhi(w.x), x2 = bflo(w.y), x3 = bfhi(w.y), x4 = bflo(w.z), x5 = bfhi(w.z), x6 = bflo(w.w), x7 = bfhi(w.w);
            s1 += ((x0 + x1) + (x2 + x3)) + ((x4 + x5) + (x6 + x7)); s2 += ((x0 * x0 + x1 * x1) + (x2 * x2 + x3 * x3)) + ((x4 * x4 + x5 * x5) + (x6 * x6 + x7 * x7)); }
        s1 += __shfl_xor(s1, 16); s1 += __shfl_xor(s1, 32); s2 += __shfl_xor(s2, 16); s2 += __shfl_xor(s2, 32);
        const float mean = s1 * (1.f / DM), rstd = 1.f / sqrtf(fmaxf(s2 * (1.f / DM) - mean * mean, 0.f) + LN_EPS);
        if (MOE_FP8 && q == 0) { f32x2 ms; ms[0] = mean; ms[1] = rstd; *(GAS f32x2*)(st2 + (size_t)row * 2) = ms; }
        f32x4 acc0 = (f32x4){0.f, 0.f, 0.f, 0.f}, acc1 = (f32x4){0.f, 0.f, 0.f, 0.f};
        bf16* xr = xb + (size_t)row * DM + 8 * q; unsigned char* x8r = x8 + (size_t)row * DM + 8 * q;
        const LAS bf16* w0 = wl + rw * 1032 + 8 * q; const LAS bf16* w1 = wl + (16 + rw) * 1032 + 8 * q;
#pragma unroll
        for (int ks = 0; ks < 32; ++ks) { v4u w = zz[ks]; asm volatile("" : "+v"(w));
            const f32x4 g0 = *(const LAS f32x4*)(gl + 32 * ks + 8 * q), g1 = *(const LAS f32x4*)(gl + 32 * ks + 8 * q + 4), b0 = *(const LAS f32x4*)(gl + 1024 + 32 * ks + 8 * q), b1 = *(const LAS f32x4*)(gl + 1024 + 32 * ks + 8 * q + 4);
            const float y0 = (bflo(w.x) - mean) * rstd * g0[0] + b0[0], y1 = (bfhi(w.x) - mean) * rstd * g0[1] + b0[1], y2 = (bflo(w.y) - mean) * rstd * g0[2] + b0[2], y3 = (bfhi(w.y) - mean) * rstd * g0[3] + b0[3];
            const float y4 = (bflo(w.z) - mean) * rstd * g1[0] + b1[0], y5 = (bfhi(w.z) - mean) * rstd * g1[1] + b1[1], y6 = (bflo(w.w) - mean) * rstd * g1[2] + b1[2], y7 = (bfhi(w.w) - mean) * rstd * g1[3] + b1[3];
            v4u o; o.x = pk2(y0, y1); o.y = pk2(y2, y3); o.z = pk2(y4, y5); o.w = pk2(y6, y7);
            if (!MOE_FP8) *(GAS v4u*)(xr + 32 * ks) = o;
            if (x8) { v2u o8; o8.x = pk4_fp8(y0 * SX8, y1 * SX8, y2 * SX8, y3 * SX8); o8.y = pk4_fp8(y4 * SX8, y5 * SX8, y6 * SX8, y7 * SX8); *(GAS v2u*)(x8r + 32 * ks) = o8; }
            const bf16x8 bfrag = __builtin_bit_cast(bf16x8, o);
            acc0 = __builtin_amdgcn_mfma_f32_16x16x32_bf16(*(const LAS bf16x8*)(w0 + 32 * ks), bfrag, acc0, 0, 0, 0);
            acc1 = __builtin_amdgcn_mfma_f32_16x16x32_bf16(*(const LAS bf16x8*)(w1 + 32 * ks), bfrag, acc1, 0, 0, 0);
            if ((ks & 1) == 1) asm volatile("" ::: "memory"); }
        float lg[8]; const f32x4 rb0 = *(const GAS f32x4*)(rbias + 4 * q), rb1 = *(const GAS f32x4*)(rbias + 16 + 4 * q);
#pragma unroll
        for (int j = 0; j < 4; ++j) { lg[j] = acc0[j] + rb0[j]; lg[4 + j] = acc1[j] + rb1[j]; }
        int idx[4]; float val[4];
#pragma unroll
        for (int k = 0; k < 4; ++k) { float bv = -3.0e38f; int bi = 64;
#pragma unroll
            for (int j = 0; j < 8; ++j) { const int e = (j < 4) ? 4 * q + j : 12 + 4 * q + j; if (lg[j] > bv) { bv = lg[j]; bi = e; } }
#pragma unroll
            for (int o = 16; o <= 32; o <<= 1) { const float pv = __shfl_xor(bv, o); const int pi = __shfl_xor(bi, o); if (pv > bv || (pv == bv && pi < bi)) { bv = pv; bi = pi; } }
            bi &= 31; idx[k] = bi; val[k] = bv;
#pragma unroll
            for (int j = 0; j < 8; ++j) { const int e = (j < 4) ? 4 * q + j : 12 + 4 * q + j; if (e == bi) lg[j] = -3.0e38f; } }
        const float e1 = __builtin_amdgcn_exp2f((val[1] - val[0]) * LOG2E), e2 = __builtin_amdgcn_exp2f((val[2] - val[0]) * LOG2E), e3 = __builtin_amdgcn_exp2f((val[3] - val[0]) * LOG2E);
        const float inv = 1.f / (1.f + e1 + e2 + e3);
        int pos[4] = {0, 0, 0, 0};
        for (int e = 0; e < NEXP; ++e) {
            const int k = (q != 0) ? -1 : (idx[0] == e) ? 0 : (idx[1] == e) ? 1 : (idx[2] == e) ? 2 : (idx[3] == e) ? 3 : -1;
            const unsigned long long mask = __ballot(k >= 0);
            if (mask) { const int n = __popcll(mask), leader = __ffsll((long long)mask) - 1; int bp = 0;
                if (FLANE == leader) bp = __hip_atomic_fetch_add(cl + e, n, __ATOMIC_RELAXED, __HIP_MEMORY_SCOPE_WORKGROUP);
                bp = __shfl(bp, leader);
                const int p = bp + __popcll(mask & ((1ull << FLANE) - 1ull));
                pos[0] = (k == 0) ? p : pos[0]; pos[1] = (k == 1) ? p : pos[1]; pos[2] = (k == 2) ? p : pos[2]; pos[3] = (k == 3) ? p : pos[3]; }
        }
        __syncthreads();
        if (FTID < 32) { const int tot = cl[FTID]; cl[32 + FTID] = tot ? (int)__hip_atomic_fetch_add(cnt + FTID * 64, (unsigned)tot, RLX_AGENT) : 0; }
        __syncthreads();
        if (q == 0) {
            *(GAS f32x4*)(gate + (size_t)row * 4) = (f32x4){inv, e1 * inv, e2 * inv, e3 * inv};
#pragma unroll
            for (int k = 0; k < 4; ++k) { const int pe = cl[32 + idx[k]] + pos[k]; list[(size_t)idx[k] * CAP + pe] = row * 4 + k; pos[k] = (idx[k] << 16) | pe; }
            *(GAS v4i_t*)(asg + (size_t)row * 4) = (v4i_t){pos[0], pos[1], pos[2], pos[3]}; }
    }
}
__device__ __forceinline__ void ph_softmax(Frame& F, const float* sc, bf16* P) {
    const int gw = F.vcu * NWAVES + F.wave, NGW = F.G * NWAVES;
    for (int m = gw; m < MTOK; m += NGW) {
#pragma unroll
        for (int h = 0; h < 4; ++h) { f32x4 v = *(const GAS f32x4*)(sc + (size_t)m * DM + 256 * h + 4 * FLANE);
            const float mx = wave_max(fmaxf(fmaxf(v.x, v.y), fmaxf(v.z, v.w)));
            v.x = __builtin_amdgcn_exp2f(v.x - mx); v.y = __builtin_amdgcn_exp2f(v.y - mx); v.z = __builtin_amdgcn_exp2f(v.z - mx); v.w = __builtin_amdgcn_exp2f(v.w - mx);
            const float inv = 1.f / wave_sum((v.x + v.y) + (v.z + v.w));
            v2u o; o.x = pk2(v.x * inv, v.y * inv); o.y = pk2(v.z * inv, v.w * inv);
            *(GAS v2u*)(P + (size_t)m * DM + 256 * h + 4 * FLANE) = o; }
    }
}
__device__ __forceinline__ void ph_topk(Frame& F, const float* logit, const float* rbias, gu32* cnt, int* list, float* gate) {
    for (int base = F.vcu * 512; base < MTOK; base += F.G * 512) {
        const int m = base + FTID;
        float lg[32];
#pragma unroll
        for (int q = 0; q < 8; ++q) { const f32x4 t = *(const GAS f32x4*)(logit + (size_t)m * 32 + 4 * q), bb = *(const GAS f32x4*)(rbias + 4 * q);
            lg[4 * q] = t.x + bb.x; lg[4 * q + 1] = t.y + bb.y; lg[4 * q + 2] = t.z + bb.z; lg[4 * q + 3] = t.w + bb.w; }
        int idx[4]; float val[4];
#pragma unroll
        for (int k = 0; k < 4; ++k) { float bvv = -3.0e38f; int bi = 0;
#pragma unroll
            for (int e = 0; e < 32; ++e) { const bool taken = (k > 0 && idx[0] == e) || (k > 1 && idx[1] == e) || (k > 2 && idx[2] == e); if (!taken && lg[e] > bvv) { bvv = lg[e]; bi = e; } }
            idx[k] = bi; val[k] = bvv; }
        const float e1 = __builtin_amdgcn_exp2f((val[1] - val[0]) * LOG2E), e2 = __builtin_amdgcn_exp2f((val[2] - val[0]) * LOG2E), e3 = __builtin_amdgcn_exp2f((val[3] - val[0]) * LOG2E);
        const float inv = 1.f / (1.f + e1 + e2 + e3);
        *(GAS f32x4*)(gate + (size_t)m * 4) = (f32x4){inv, e1 * inv, e2 * inv, e3 * inv};
        for (int e = 0; e < NEXP; ++e) {
            const int k = (idx[0] == e) ? 0 : (idx[1] == e) ? 1 : (idx[2] == e) ? 2 : (idx[3] == e) ? 3 : -1;
            const unsigned long long mask = __ballot(k >= 0);
            if (mask) { const int n = __popcll(mask), leader = __ffsll((long long)mask) - 1; unsigned bp = 0;
                if (FLANE == leader) bp = __hip_atomic_fetch_add(cnt + e * 64, (unsigned)n, RLX_AGENT);
                bp = __shfl(bp, leader);
                if (k >= 0) { const int rank = __popcll(mask & ((1ull << FLANE) - 1ull)); list[(size_t)e * CAP + bp + rank] = m * 4 + k; } }
        }
    }
}
__device__ __forceinline__ void ph_sgu(Frame& F, const bf16* hb, bf16* mix, const float* lng, const float* lnb, const float* wsp, const float* bsp) {
    LAS bf16* Wb = (LAS bf16*)F.lds;
    LAS bf16* VT = (LAS bf16*)(F.lds + 34816);
    LAS float* GL = (LAS float*)(F.lds + 69632);
    const int r = FTID >> 2, qq = FTID & 3, n16 = FLANE & 15, q = FLANE >> 4;
    int gcur = -1;
    for (int it = F.vcu; it < 1024; it += F.G) {
        const int g = it & 3, row0 = (it >> 2) * 128;
        if (g != gcur) { __syncthreads(); for (int i = FTID; i < 16384; i += 512) { const int t = i >> 7, s2 = i & 127; Wb[t * 136 + s2] = (bf16)((s2 <= t) ? f2bf(wsp[g * 16384 + i]) : 0u); } gcur = g; }
        { float v[32]; const bf16* src = hb + (size_t)(row0 + r) * DM + 512 + g * 128 + 32 * qq;
#pragma unroll
            for (int j = 0; j < 4; ++j) { const v4u w = *(const GAS v4u*)(src + 8 * j);
                v[8 * j + 0] = bflo(w.x); v[8 * j + 1] = bfhi(w.x); v[8 * j + 2] = bflo(w.y); v[8 * j + 3] = bfhi(w.y); v[8 * j + 4] = bflo(w.z); v[8 * j + 5] = bfhi(w.z); v[8 * j + 6] = bflo(w.w); v[8 * j + 7] = bfhi(w.w); }
            float s = 0.f;
#pragma unroll
            for (int j = 0; j < 32; ++j) s += v[j];
            s += __shfl_xor(s, 1); s += __shfl_xor(s, 2);
            const float mean = s * (1.f / 128.f); float s2 = 0.f;
#pragma unroll
            for (int j = 0; j < 32; ++j) { v[j] -= mean; s2 += v[j] * v[j]; }
            s2 += __shfl_xor(s2, 1); s2 += __shfl_xor(s2, 2);
            const float rstd = 1.f / sqrtf(s2 * (1.f / 128.f) + LN_EPS);
#pragma unroll
            for (int j = 0; j < 8; ++j) { const f32x4 gg = *(const GAS f32x4*)(lng + g * 128 + 32 * qq + 4 * j), bb = *(const GAS f32x4*)(lnb + g * 128 + 32 * qq + 4 * j);
#pragma unroll
                for (int k = 0; k < 4; ++k) VT[(32 * qq + 4 * j + k) * 136 + r] = (bf16)f2bf(v[4 * j + k] * rstd * gg[k] + bb[k]); } }
        __syncthreads();
        { bf16x8 VF[4];
#pragma unroll
            for (int ks = 0; ks < 4; ++ks) VF[ks] = *(const LAS bf16x8*)(VT + (16 * F.wave + n16) * 136 + 32 * ks + 8 * q);
#pragma unroll
            for (int tb = 0; tb < 8; ++tb) { f32x4 acc = (f32x4){0.f, 0.f, 0.f, 0.f};
#pragma unroll
                for (int ks = 0; ks <= (tb >> 1); ++ks) acc = __builtin_amdgcn_mfma_f32_16x16x32_bf16(*(const LAS bf16x8*)(Wb + (16 * tb + n16) * 136 + 32 * ks + 8 * q), VF[ks], acc, 0, 0, 0);
                const f32x4 bt = *(const GAS f32x4*)(bsp + g * 128 + 16 * tb + 4 * q);
#pragma unroll
                for (int k = 0; k < 4; ++k) GL[(16 * tb + 4 * q + k) * 128 + 16 * F.wave + n16] = acc[k] + bt[k]; } }
        __syncthreads();
        { const bf16* usrc = hb + (size_t)(row0 + r) * DM + g * 128 + 32 * qq; bf16* dst = mix + (size_t)(row0 + r) * DM + g * 128 + 32 * qq;
#pragma unroll
            for (int j = 0; j < 4; ++j) { const v4u w = *(const GAS v4u*)(usrc + 8 * j); const f32x4 g0 = *(const LAS f32x4*)(GL + r * 128 + 32 * qq + 8 * j), g1 = *(const LAS f32x4*)(GL + r * 128 + 32 * qq + 8 * j + 4); v4u o;
                o.x = pk2(bflo(w.x) * g0[0], bfhi(w.x) * g0[1]); o.y = pk2(bflo(w.y) * g0[2], bfhi(w.y) * g0[3]); o.z = pk2(bflo(w.z) * g1[0], bfhi(w.z) * g1[1]); o.w = pk2(bflo(w.w) * g1[2], bfhi(w.w) * g1[3]);
                *(GAS v4u*)(dst + 8 * j) = o; } }
    }
}
__device__ __forceinline__ void ph_combine(Frame& F, const bf16* oatt, bf16* mix, const float* lq1, const float* lk1, const float* lq2, const float* lk2, const float* sg) {
    const int gw = F.vcu * NWAVES + F.wave, NGW = F.G * NWAVES;
    const float d1 = wave_sum(lq1[FLANE] * lk1[FLANE]), d2 = wave_sum(lq2[FLANE] * lk2[FLANE]);
    const float lam = expf(d1) - expf(d2) + LAM_INIT0;
    const int h = FLANE >> 4, e0 = 8 * (FLANE & 15);
    float gsc[8];
#pragma unroll
    for (int j = 0; j < 8; ++j) gsc[j] = sg[e0 + j] * (1.0f - LAM_INIT0);
    for (int m0 = gw * 4; m0 < MTOK; m0 += NGW * 4) {
        v4u av[4], bw[4];
#pragma unroll
        for (int r = 0; r < 4; ++r) { av[r] = *(const GAS v4u*)(oatt + (size_t)(m0 + r) * DM + h * 256 + e0); bw[r] = *(const GAS v4u*)(oatt + (size_t)(m0 + r) * DM + h * 256 + 128 + e0); }
#pragma unroll
        for (int r = 0; r < 4; ++r) { const v4u a = av[r], b = bw[r]; const size_t m = (size_t)(m0 + r);
            float o[8];
            o[0] = bflo(a.x) - lam * bflo(b.x); o[1] = bfhi(a.x) - lam * bfhi(b.x); o[2] = bflo(a.y) - lam * bflo(b.y); o[3] = bfhi(a.y) - lam * bfhi(b.y);
            o[4] = bflo(a.z) - lam * bflo(b.z); o[5] = bfhi(a.z) - lam * bfhi(b.z); o[6] = bflo(a.w) - lam * bflo(b.w); o[7] = bfhi(a.w) - lam * bfhi(b.w);
            float s2 = 0.f;
#pragma unroll
            for (int j = 0; j < 8; ++j) s2 += o[j] * o[j];
            s2 += __shfl_xor(s2, 1); s2 += __shfl_xor(s2, 2); s2 += __shfl_xor(s2, 4); s2 += __shfl_xor(s2, 8);
            const float rs = 1.f / sqrtf(s2 * (1.f / 128.f) + LN_EPS);
            v4u w; w.x = pk2(o[0] * rs * gsc[0], o[1] * rs * gsc[1]); w.y = pk2(o[2] * rs * gsc[2], o[3] * rs * gsc[3]); w.z = pk2(o[4] * rs * gsc[4], o[5] * rs * gsc[5]); w.w = pk2(o[6] * rs * gsc[6], o[7] * rs * gsc[7]);
            *(GAS v4u*)(mix + m * DM + 512 + h * 128 + e0) = w; }
    }
}

__device__ __forceinline__ void combine_local(Frame& F, const bf16* oatt, bf16* mix, const float* lq1, const float* lk1, const float* lq2, const float* lk2, const float* sg, int b, int h, int pr) {
    const float d1 = wave_sum(lq1[FLANE] * lk1[FLANE]), d2 = wave_sum(lq2[FLANE] * lk2[FLANE]);
    const float lam = expf(d1) - expf(d2) + LAM_INIT0;
    const int e0 = 8 * (FLANE & 15);
    float gsc[8];
#pragma unroll
    for (int j = 0; j < 8; ++j) gsc[j] = sg[e0 + j] * (1.0f - LAM_INIT0);
    for (int it = 0; it < 16; it += 4) {
        v4u av[4], bw[4]; size_t rows[4];
#pragma unroll
        for (int r = 0; r < 4; ++r) { const int rl = F.wave * 64 + (it + r) * 4 + (FLANE >> 4); rows[r] = (size_t)b * SEQ + (size_t)((rl < 256) ? pr : 7 - pr) * 256 + (rl & 255);
            av[r] = *(const GAS v4u*)(oatt + rows[r] * DM + h * 256 + e0); bw[r] = *(const GAS v4u*)(oatt + rows[r] * DM + h * 256 + 128 + e0); }
#pragma unroll
        for (int r = 0; r < 4; ++r) { const v4u a = av[r], bb = bw[r];
            float o[8];
            o[0] = bflo(a.x) - lam * bflo(bb.x); o[1] = bfhi(a.x) - lam * bfhi(bb.x); o[2] = bflo(a.y) - lam * bflo(bb.y); o[3] = bfhi(a.y) - lam * bfhi(bb.y);
            o[4] = bflo(a.z) - lam * bflo(bb.z); o[5] = bfhi(a.z) - lam * bfhi(bb.z); o[6] = bflo(a.w) - lam * bflo(bb.w); o[7] = bfhi(a.w) - lam * bfhi(bb.w);
            float s2 = 0.f;
#pragma unroll
            for (int j = 0; j < 8; ++j) s2 += o[j] * o[j];
            s2 += __shfl_xor(s2, 1); s2 += __shfl_xor(s2, 2); s2 += __shfl_xor(s2, 4); s2 += __shfl_xor(s2, 8);
            const float rs = 1.f / sqrtf(s2 * (1.f / 128.f) + LN_EPS);
            v4u w; w.x = pk2(o[0] * rs * gsc[0], o[1] * rs * gsc[1]); w.y = pk2(o[2] * rs * gsc[2], o[3] * rs * gsc[3]); w.z = pk2(o[4] * rs * gsc[4], o[5] * rs * gsc[5]); w.w = pk2(o[6] * rs * gsc[6], o[7] * rs * gsc[7]);
            *(GAS v4u*)(mix + rows[r] * DM + 512 + h * 128 + e0) = w; }
    }
}

__device__ __forceinline__ float dpp_shr1(float x) { return __builtin_bit_cast(float, __builtin_amdgcn_update_dpp(0, __builtin_bit_cast(int, x), 0x111, 0xf, 0xf, true)); }
__device__ __forceinline__ float dpp_shr2(float x) { return __builtin_bit_cast(float, __builtin_amdgcn_update_dpp(0, __builtin_bit_cast(int, x), 0x112, 0xf, 0xf, true)); }
__device__ __forceinline__ float dpp_shr4(float x) { return __builtin_bit_cast(float, __builtin_amdgcn_update_dpp(0, __builtin_bit_cast(int, x), 0x114, 0xf, 0xf, true)); }
__device__ __forceinline__ float dpp_shr8(float x) { return __builtin_bit_cast(float, __builtin_amdgcn_update_dpp(0, __builtin_bit_cast(int, x), 0x118, 0xf, 0xf, true)); }
__device__ __forceinline__ float dpp_shl15(float x) { return __builtin_bit_cast(float, __builtin_amdgcn_update_dpp(0, __builtin_bit_cast(int, x), 0x10f, 0xf, 0xf, true)); }
#define S5_DPP2(fn, v) ((f32x2){fn((v).x), fn((v).y)})
__device__ __forceinline__ float dpp_ror1(float x) { return __builtin_bit_cast(float, __builtin_amdgcn_update_dpp(0, __builtin_bit_cast(int, x), 0x121, 0xf, 0xf, true)); }
template <int hf>
__device__ __forceinline__ void s5_main(Frame& F, const bf16* ug, bf16* yb, const float* dsk, int g, int bh, LAS bf16* W2F, LAS bf16* W3F, LAS bf16* KT, LAS float* PW, int r, int q, int variant) {
        const int b = bh * 4 + (F.wave & 3);
        LAS bf16x8* XX = (LAS bf16x8*)(F.lds + 91648);
        const bf16* up = ug + ((size_t)g * MTOK + (size_t)b * SEQ) * 16;
        unsigned char* yp = (unsigned char*)yb + ((size_t)g * MTOK + (size_t)b * SEQ) * 16 + 4 * q;
        const f32x4 dk = *(const GAS f32x4*)(dsk + g * 16 + 4 * q);
        f32x4 E[4];
#pragma unroll
        for (int i = 0; i < 4; ++i) E[i] = (f32x4){0.f, 0.f, 0.f, 0.f};
        bf16x8 UFn[4], UF[4]; v2u UWn[4], UW[4];
#pragma unroll
        for (int sp = 0; sp < 4; ++sp) UFn[sp] = *(const GAS bf16x8*)(up + (size_t)(r * 8 + 2 * sp + (q >> 1)) * 16 + 8 * (q & 1));
#pragma unroll
        for (int t = 0; t < 4; ++t) UWn[t] = *(const GAS v2u*)(up + (size_t)(r * 8 + 4 * hf + t) * 16 + 4 * q);
#pragma unroll
        for (int sp = 0; sp < 4; ++sp) UF[sp] = UFn[sp];
#pragma unroll
        for (int t = 0; t < 4; ++t) UW[t] = UWn[t];
        f32x2 Pr[4][2][2], Pi[4][2][2];
#pragma unroll
        for (int i2 = 0; i2 < 2; ++i2) { const int rbp = 2 * hf + i2;
            const f32x4 a0 = *(const LAS f32x4*)(PW + (8 * 64 + 16 * rbp + 4 * q) * 2), a1 = *(const LAS f32x4*)(PW + (8 * 64 + 16 * rbp + 4 * q) * 2 + 4);
            Pr[0][i2][0] = (f32x2){a0[0], a0[2]}; Pi[0][i2][0] = (f32x2){a0[1], a0[3]}; Pr[0][i2][1] = (f32x2){a1[0], a1[2]}; Pi[0][i2][1] = (f32x2){a1[1], a1[3]};
#pragma unroll
            for (int k = 1; k < 4; ++k)
#pragma unroll
                for (int h = 0; h < 2; ++h) { const f32x2 pr = Pr[k - 1][i2][h], pi = Pi[k - 1][i2][h]; Pr[k][i2][h] = pr * pr - pi * pi; Pi[k][i2][h] = 2.0f * pr * pi; } }
        for (int cg = 0; cg < 16; ++cg) {
            const int tokbase = cg * 128 + r * 8;
            if (cg < 15) {
#pragma unroll
                for (int sp = 0; sp < 4; ++sp) UFn[sp] = *(const GAS bf16x8*)(up + (size_t)(tokbase + 128 + 2 * sp + (q >> 1)) * 16 + 8 * (q & 1));
#pragma unroll
                for (int t = 0; t < 4; ++t) UWn[t] = *(const GAS v2u*)(up + (size_t)(tokbase + 128 + 4 * hf + t) * 16 + 4 * q); }
            f32x2 Cr[2][2], Ci[2][2];
#pragma unroll
            for (int i2 = 0; i2 < 2; ++i2)
#pragma unroll
                for (int h = 0; h < 2; ++h) { const f32x2 er = h ? E[2 * i2].hi : E[2 * i2].lo, ei = h ? E[2 * i2 + 1].hi : E[2 * i2 + 1].lo; Cr[i2][h] = S5_DPP2(dpp_shl15, er); Ci[i2][h] = S5_DPP2(dpp_shl15, ei); }
#pragma unroll
            for (int i = 0; i < 4; ++i) E[i] = (f32x4){0.f, 0.f, 0.f, 0.f};
#pragma unroll
            for (int sp = 0; sp < 4; ++sp) {
#pragma unroll
                for (int i = 0; i < 4; ++i) E[i] = __builtin_amdgcn_mfma_f32_16x16x32_bf16(*(const LAS bf16x8*)(W2F + (((4 * hf + i) * 4 + sp) * 64 + FLANE) * 8), UF[sp], E[i], 0, 0, 0);
                asm volatile("" ::: "memory"); }
            bf16x8 XBf[4];
            LAS bf16x8* xx = XX + ((cg & 1) * 4 + (F.wave & 3)) * 256;
#pragma unroll
            for (int i2 = 0; i2 < 2; ++i2) { f32x2 xr[2], xi[2];
#pragma unroll
                for (int h = 0; h < 2; ++h) {
                    f32x2 er = h ? E[2 * i2].hi : E[2 * i2].lo, ei = h ? E[2 * i2 + 1].hi : E[2 * i2 + 1].lo; f32x2 sr, si, nr, ni;
                    nr = er + Pr[0][i2][h] * Cr[i2][h] - Pi[0][i2][h] * Ci[i2][h]; ni = ei + Pr[0][i2][h] * Ci[i2][h] + Pi[0][i2][h] * Cr[i2][h]; er = nr; ei = ni;
                    sr = S5_DPP2(dpp_shr1, er); si = S5_DPP2(dpp_shr1, ei); nr = er + Pr[0][i2][h] * sr - Pi[0][i2][h] * si; ni = ei + Pr[0][i2][h] * si + Pi[0][i2][h] * sr; er = nr; ei = ni;
                    sr = S5_DPP2(dpp_shr2, er); si = S5_DPP2(dpp_shr2, ei); nr = er + Pr[1][i2][h] * sr - Pi[1][i2][h] * si; ni = ei + Pr[1][i2][h] * si + Pi[1][i2][h] * sr; er = nr; ei = ni;
                    sr = S5_DPP2(dpp_shr4, er); si = S5_DPP2(dpp_shr4, ei); nr = er + Pr[2][i2][h] * sr - Pi[2][i2][h] * si; ni = ei + Pr[2][i2][h] * si + Pi[2][i2][h] * sr; er = nr; ei = ni;
                    sr = S5_DPP2(dpp_shr8, er); si = S5_DPP2(dpp_shr8, ei); nr = er + Pr[3][i2][h] * sr - Pi[3][i2][h] * si; ni = ei + Pr[3][i2][h] * si + Pi[3][i2][h] * sr; er = nr; ei = ni;
                    if (h) { E[2 * i2].hi = er; E[2 * i2 + 1].hi = ei; } else { E[2 * i2].lo = er; E[2 * i2 + 1].lo = ei; }
                    xr[h] = S5_DPP2(dpp_shr1, er) + Cr[i2][h]; xi[h] = S5_DPP2(dpp_shr1, ei) + Ci[i2][h]; }
                v4u w; w.x = pk2(xr[0].x, xr[0].y); w.y = pk2(xr[1].x, xr[1].y); w.z = pk2(xi[0].x, xi[0].y); w.w = pk2(xi[1].x, xi[1].y);
                XBf[2 * hf + i2] = __builtin_bit_cast(bf16x8, w); xx[(2 * hf + i2) * 64 + FLANE] = XBf[2 * hf + i2]; }
            LDS_WAIT(); __builtin_amdgcn_s_barrier(); asm volatile("" ::: "memory");
#pragma unroll
            for (int i2 = 0; i2 < 2; ++i2) XBf[2 * (1 - hf) + i2] = xx[(2 * (1 - hf) + i2) * 64 + FLANE];
            unsigned yout[4] = {0u, 0u, 0u, 0u};
            if (variant != 2) {
            f32x4 Y[4];
#pragma unroll
            for (int tt = 0; tt < 4; ++tt) Y[tt] = (f32x4){0.f, 0.f, 0.f, 0.f};
#pragma unroll
            for (int sp = 0; sp < 4; ++sp) {
#pragma unroll
                for (int tt = 0; tt < 4; ++tt) { const int t = 4 * hf + tt; if (sp <= (t >> 1)) { const int tau1 = t - 2 * sp - (q >> 1) + 1;
                    Y[tt] = __builtin_amdgcn_mfma_f32_16x16x32_bf16(*(const LAS bf16x8*)(KT + (tau1 * 16 + r) * 16 + 8 * (q & 1)), UF[sp], Y[tt], 0, 0, 0); } }
                asm volatile("" ::: "memory"); }
#pragma unroll
            for (int ks = 0; ks < 4; ++ks) {
#pragma unroll
                for (int tt = 0; tt < 4; ++tt) Y[tt] = __builtin_amdgcn_mfma_f32_16x16x32_bf16(*(const LAS bf16x8*)(W3F + (((4 * hf + tt) * 4 + ks) * 64 + FLANE) * 8), XBf[ks], Y[tt], 0, 0, 0);
                asm volatile("" ::: "memory"); }
#pragma unroll
            for (int tt = 0; tt < 4; ++tt) { const v2u uw = UW[tt];
                const f32x2 ya = gelu_tanh2(Y[tt].lo + dk.lo * (f32x2){bflo(uw.x), bfhi(uw.x)}, SA8), yb2 = gelu_tanh2(Y[tt].hi + dk.hi * (f32x2){bflo(uw.y), bfhi(uw.y)}, SA8);
                yout[tt] = pk4_fp8(ya.x, ya.y, yb2.x, yb2.y);
            } }
            if (cg < 15) {
#pragma unroll
                for (int sp = 0; sp < 4; ++sp) UF[sp] = UFn[sp];
#pragma unroll
                for (int t = 0; t < 4; ++t) UW[t] = UWn[t]; }
            asm volatile("" ::: "memory");
            { auto s01 = __builtin_amdgcn_permlane16_swap(yout[0], yout[1], false, false); auto s23 = __builtin_amdgcn_permlane16_swap(yout[2], yout[3], false, false);
              auto s02 = __builtin_amdgcn_permlane32_swap(s01[0], s23[0], false, false); auto s13 = __builtin_amdgcn_permlane32_swap(s01[1], s23[1], false, false);
              *(GAS v4u*)(yp - 4 * q + (size_t)(tokbase + 4 * hf + q) * 16) = (v4u){s02[0], s13[0], s02[1], s13[1]}; }
        }
}
__device__ __forceinline__ void ph_s5(Frame& F, const bf16* ug, bf16* yb, const float* log_dt, const float* lre, const float* lim, const float* bre, const float* bim,
                                      const float* cre, const float* cim, const float* dsk, int variant) {
    LAS bf16* W2F = (LAS bf16*)F.lds;
    LAS bf16* W3F = (LAS bf16*)(F.lds + 32768);
    LAS bf16* KT = (LAS bf16*)(F.lds + 65536);
    LAS float* PW = (LAS float*)(F.lds + 70144);
    LAS float* ZZ = (LAS float*)(F.lds + 74752);
    LAS float* BB = (LAS float*)(F.lds + 75264);
    LAS float* CC = (LAS float*)(F.lds + 83456);
    LAS bf16* W30 = (LAS bf16*)(F.lds + 124416);
    const int r = FLANE & 15, q = FLANE >> 4;
    for (int it = F.vcu; it < 256; it += F.G) {
        const int g = it & 63, bh = it >> 6;
        __syncthreads();
        if (FTID < 64) { const int p = FTID; const float dt = expf(log_dt[g]), lr = lre[g * 64 + p], li = lim[g * 64 + p];
            const float mg = expf(lr * dt), ar = mg * cosf(li * dt), ai = mg * sinf(li * dt), den = lr * lr + li * li;
            float pr = 1.f, pi = 0.f;
            for (int n = 0; n < 9; ++n) { PW[(n * 64 + p) * 2] = pr; PW[(n * 64 + p) * 2 + 1] = pi; const float t2 = pr * ar - pi * ai; pi = pr * ai + pi * ar; pr = t2; }
            ZZ[p * 2] = ((ar - 1.0f) * lr + ai * li) / den; ZZ[p * 2 + 1] = (ai * lr - (ar - 1.0f) * li) / den; }
        __syncthreads();
        for (int idx = FTID; idx < 1024; idx += 512) {
            { const int p = idx >> 4; const float br = bre[(size_t)g * 1024 + idx], bi = bim[(size_t)g * 1024 + idx], zr = ZZ[p * 2], zi = ZZ[p * 2 + 1];
              BB[idx * 2] = zr * br - zi * bi; BB[idx * 2 + 1] = zr * bi + zi * br; }
            { CC[idx * 2] = cre[(size_t)g * 1024 + idx]; CC[idx * 2 + 1] = cim[(size_t)g * 1024 + idx]; }
        }
        if (FTID < 256) KT[FTID] = 0;
        __syncthreads();
        for (int idx = FTID; idx < 2048; idx += 512) {
            { const int t = idx >> 8, ks = (idx >> 6) & 3, ln = idx & 63, c = ln & 15, qq = ln >> 4; unsigned w[4];
#pragma unroll
              for (int j = 0; j < 4; ++j) { const int p = 16 * ks + 4 * qq + j; const float cr_ = CC[(c * 64 + p) * 2], ci_ = CC[(c * 64 + p) * 2 + 1], pr = PW[((t + 1) * 64 + p) * 2], pi = PW[((t + 1) * 64 + p) * 2 + 1];
                  const float gr = cr_ * pr - ci_ * pi, gi = cr_ * pi + ci_ * pr;
                  if (j & 1) { w[j >> 1] |= f2bf(gr) << 16; w[2 + (j >> 1)] |= f2bf(-gi) << 16; } else { w[j >> 1] = f2bf(gr); w[2 + (j >> 1)] = f2bf(-gi); } }
              *(LAS v4u*)(W3F + (size_t)idx * 8) = (v4u){w[0], w[1], w[2], w[3]}; }
            { const int rb = idx >> 8, sp = (idx >> 6) & 3, ln = idx & 63, rr = ln & 15, qq = ln >> 4, p = 16 * (rb >> 1) + rr, s = 2 * sp + (qq >> 1), c0 = 8 * (qq & 1); unsigned w[4];
              const float pr = PW[((7 - s) * 64 + p) * 2], pi = PW[((7 - s) * 64 + p) * 2 + 1];
#pragma unroll
              for (int j = 0; j < 8; ++j) { const float br = BB[(p * 16 + c0 + j) * 2], bi = BB[(p * 16 + c0 + j) * 2 + 1]; const float v = (rb & 1) ? (pr * bi + pi * br) : (pr * br - pi * bi);
                  if (j & 1) w[j >> 1] |= f2bf(v) << 16; else w[j >> 1] = f2bf(v); }
              *(LAS v4u*)(W2F + (size_t)idx * 8) = (v4u){w[0], w[1], w[2], w[3]}; }
        }
        if (FTID < 256) { const int ks = FTID >> 6, ln = FTID & 63, c = ln & 15, qq = ln >> 4; unsigned w[4];
#pragma unroll
            for (int j = 0; j < 4; ++j) { const int p = 16 * ks + 4 * qq + j; const float gr = CC[(c * 64 + p) * 2], gi = CC[(c * 64 + p) * 2 + 1];
                if (j & 1) { w[j >> 1] |= f2bf(gr) << 16; w[2 + (j >> 1)] |= f2bf(-gi) << 16; } else { w[j >> 1] = f2bf(gr); w[2 + (j >> 1)] = f2bf(-gi); } }
            *(LAS v4u*)(W30 + (size_t)FTID * 8) = (v4u){w[0], w[1], w[2], w[3]}; }
        __syncthreads();
        {
            f32x4 kacc = (f32x4){0.f, 0.f, 0.f, 0.f}; const int tau = F.wave;
#pragma unroll
            for (int ks = 0; ks < 4; ++ks) { unsigned w[4];
#pragma unroll
                for (int j = 0; j < 4; ++j) { const int p = 16 * ks + 4 * q + j; const float br = BB[(p * 16 + r) * 2], bi = BB[(p * 16 + r) * 2 + 1];
                    if (j & 1) { w[j >> 1] |= f2bf(br) << 16; w[2 + (j >> 1)] |= f2bf(bi) << 16; } else { w[j >> 1] = f2bf(br); w[2 + (j >> 1)] = f2bf(bi); } }
                const v4u wb = (v4u){w[0], w[1], w[2], w[3]};
                const bf16x8 af = tau == 0 ? *(const LAS bf16x8*)(W30 + (ks * 64 + FLANE) * 8) : *(const LAS bf16x8*)(W3F + (((tau - 1) * 4 + ks) * 64 + FLANE) * 8);
                kacc = __builtin_amdgcn_mfma_f32_16x16x32_bf16(af, __builtin_bit_cast(bf16x8, wb), kacc, 0, 0, 0); }
#pragma unroll
            for (int k = 0; k < 4; ++k) KT[(tau + 1) * 256 + (4 * q + k) * 16 + r] = (bf16)f2bf(kacc[k]); }
        __syncthreads();
        if (variant != 1) { if ((F.wave >> 2) == 0) s5_main<0>(F, ug, yb, dsk, g, bh, W2F, W3F, KT, PW, r, q, variant); else s5_main<1>(F, ug, yb, dsk, g, bh, W2F, W3F, KT, PW, r, q, variant); }
    }
}

struct PlainSched {
    pg8::TileOrder T; const char* A; const char* B; int tilesPerBatch; size_t bBatch; int splitN; size_t aT = pg8::TSTEP, bT = pg8::TSTEP;
    __device__ __forceinline__ bool next(int i, pg8::Unit& u) const {
        int pm, pn; if (!T.get(i, pm, pn)) return false;
        const int z = pm / tilesPerBatch;
        u.a = A + (size_t)pm * aT; u.b = B + (size_t)z * bBatch + (size_t)pn * bT; u.row0 = pm * 256; u.col0 = pn * 256; u.z = z; u.aux = 0;
        if (splitN) { u.z = pn >= splitN; u.col0 = (pn >= splitN ? pn - splitN : pn) * 256; }
        return true;
    }
};
struct FoldSched {
    int G, c, first; const char* KB; const char* VB; const char* XQ; const char* XOT;
    __device__ __forceinline__ bool next(int i, pg8::Unit& u) const {
        const int idx = i * G + c - first; if (idx < 0 || idx >= 512) return false;
        const int type = idx >> 8, j = idx & 255, b = j >> 4, h = (j >> 2) & 3, t = j & 3;
        if (type == 0) { u.a = KB + (size_t)b * 256 * 2048 + h * 512; u.b = XQ + (size_t)t * pg8::TSTEP + h * 512; u.row0 = b * 1024 + h * 256; u.col0 = t * 256; u.z = 0; }
        else { u.a = XOT + (size_t)t * pg8::TSTEP + h * 512; u.b = VB + (size_t)b * 256 * 2048 + h * 512; u.row0 = b * 1024 + t * 256; u.col0 = h * 256; u.z = 1; }
        u.aux = 0; return true;
    }
};
struct MoeSched {
    LAS const int* tab; int NT, G, c; const char* A; const char* B; size_t bExp; int colw; const int* list; bool gather; size_t tileB;
    __device__ __forceinline__ bool next(int i, pg8::Unit& u) const {
        const int nblk = __builtin_amdgcn_readfirstlane(tab[64]);
        const int x = c >> 5, r = c & 31; int mbl, pn;
        if (G != 256 || NT != 8) { mbl = c / NT; pn = c % NT; } else { pn = 4 * (x & 1) + (r & 3); mbl = 8 * (x >> 1) + (r >> 2); }
        const int mbg = i * (G / NT) + mbl; if (mbg >= nblk) return false;
        const int lane = opaque_tid() & 63; const int v = (lane <= 32) ? tab[32 + lane] : 0x7fffffff;
        const int e = __popcll(__ballot(v <= mbg)) - 1;
        const int mb = mbg - __builtin_amdgcn_readfirstlane(tab[32 + e]);
        u.a = gather ? A : A + (size_t)mbg * tileB; u.b = B + (size_t)e * bExp + (size_t)pn * tileB;
        u.row0 = mbg * 256; u.col0 = pn * colw; u.z = e; u.aux = mb; return true;
    }
    __device__ __forceinline__ const int* rows(const pg8::Unit& u) const { return list + (size_t)u.z * CAP + u.aux * 256; }
    __device__ __forceinline__ static int rowmap(int v) { return (int)(((unsigned)v >> 2) & (unsigned)(MTOK - 1)); }
};

#define EPI_ROWS_BEGIN _Pragma("unroll") for (int ai = 0; ai < 2; ++ai) _Pragma("unroll") for (int m = 0; m < 4; ++m) { const int rloc = ai * 128 + wr * 64 + m * 16 + fr;
#define EPI_ROWS_END }
__device__ __forceinline__ v4u pack8(f32x4 v0, f32x4 v1) { v4u w; w.x = pg8::cvt_pk_bf16(v0[0], v0[1]); w.y = pg8::cvt_pk_bf16(v0[2], v0[3]); w.z = pg8::cvt_pk_bf16(v1[0], v1[1]); w.w = pg8::cvt_pk_bf16(v1[2], v1[3]); return w; }
__device__ __forceinline__ void unpack8(v4u w, f32x4& a, f32x4& b) { a = (f32x4){bflo(w.x), bfhi(w.x), bflo(w.y), bfhi(w.y)}; b = (f32x4){bflo(w.z), bfhi(w.z), bflo(w.w), bfhi(w.w)}; }
__device__ __forceinline__ void rowpair_publish(LAS float* tab, float* dst, int nslot, int slot, int row0, const float (&ss)[8], const float (&qq)[8], int wr, int wc, int fr, int fq) {
    if (fq == 0) {
#pragma unroll
        for (int i = 0; i < 8; ++i) { const int rl = (i >> 2) * 128 + wr * 64 + (i & 3) * 16 + fr; tab[(rl * 4 + wc) * 2] = ss[i]; tab[(rl * 4 + wc) * 2 + 1] = qq[i]; } }
    LDS_WAIT(); __builtin_amdgcn_s_barrier(); asm volatile("" ::: "memory");
    { const int t = opaque_tid(), row = t >> 1, which = t & 1;
      const float v = (tab[(row * 4 + 0) * 2 + which] + tab[(row * 4 + 1) * 2 + which]) + (tab[(row * 4 + 2) * 2 + which] + tab[(row * 4 + 3) * 2 + which]);
      dst[((size_t)(row0 + row) * nslot + slot) * 2 + which] = v; }
    LDS_WAIT(); __builtin_amdgcn_s_barrier(); asm volatile("" ::: "memory");
}
__device__ __forceinline__ void ln_tables(LAS float* tabR, LAS float* tabC, const float* st, int nslot, int row0, const float* sc, int scrow0, const float* v0, const float* v1, int col0) {
    const int t = opaque_tid();
    if (t < 256) { const float* p = st + (size_t)(row0 + t) * 16; float s = 0.f, q = 0.f;
        for (int k = 0; k < nslot; ++k) { s += p[2 * k]; q += p[2 * k + 1]; }
        const float mu = s * (1.f / DM); tabR[2 * t] = mu; tabR[2 * t + 1] = 1.f / sqrtf(fmaxf(q * (1.f / DM) - mu * mu, 0.f) + LN_EPS); }
    else { const int c = t - 256;
        if (sc) { const f32x4 a = *(const GAS f32x4*)(sc + (size_t)(scrow0 + c) * 8), b = *(const GAS f32x4*)(sc + (size_t)(scrow0 + c) * 8 + 4);
            tabC[c] = (a[0] + a[2]) + (b[0] + b[2]); tabC[256 + c] = (a[1] + a[3]) + (b[1] + b[3]); }
        else { tabC[c] = v0[col0 + c]; tabC[256 + c] = v1[col0 + c]; } }
    LDS_WAIT(); __builtin_amdgcn_s_barrier(); asm volatile("" ::: "memory");
}
struct EpiResidStats { const bf16* xb; bf16* zb; unsigned char* z8; float* st; LAS float* tab;
    __device__ __forceinline__ void operator()(EPI_ARGS) const {
        float ss[8], qq[8]; v4u xr[2][4][2];
        EPI_ROWS_BEGIN const size_t off = (size_t)(u.row0 + rloc) * DM + u.col0 + wc * 32 + 8 * fq; xr[ai][m][0] = *(const GAS v4u*)(xb + off); xr[ai][m][1] = *(const GAS v4u*)(xb + off + 128); EPI_ROWS_END
        EPI_ROWS_BEGIN const size_t off = (size_t)(u.row0 + rloc) * DM + u.col0 + wc * 32 + 8 * fq; float s = 0.f, q = 0.f;
#pragma unroll
            for (int bj = 0; bj < 2; ++bj) { f32x4 x0, x1; unpack8(xr[ai][m][bj], x0, x1);
                const f32x4 z0 = x0 * ALPHA + acc[ai][bj][m][0], z1 = x1 * ALPHA + acc[ai][bj][m][1];
                *(GAS v4u*)(zb + off + bj * 128) = pack8(z0, z1);
                v2u w; w.x = pk4_fp8(z0[0] * SZ8, z0[1] * SZ8, z0[2] * SZ8, z0[3] * SZ8); w.y = pk4_fp8(z1[0] * SZ8, z1[1] * SZ8, z1[2] * SZ8, z1[3] * SZ8); *(GAS v2u*)(z8 + off + bj * 128) = w;
                s += ((z0[0] + z0[1]) + (z0[2] + z0[3])) + ((z1[0] + z1[1]) + (z1[2] + z1[3])); q += ((z0[0] * z0[0] + z0[1] * z0[1]) + (z0[2] * z0[2] + z0[3] * z0[3])) + ((z1[0] * z1[0] + z1[1] * z1[1]) + (z1[2] * z1[2] + z1[3] * z1[3])); }
            s += __shfl_xor(s, 16); s += __shfl_xor(s, 32); q += __shfl_xor(q, 16); q += __shfl_xor(q, 32); ss[ai * 4 + m] = s; qq[ai * 4 + m] = q; EPI_ROWS_END
        rowpair_publish(tab, st, 8, u.col0 >> 8, u.row0, ss, qq, wr, wc, fr, fq);
    } };
struct EpiResidLN { bf16* zb; float rs; const float* st; LAS float* tab; const float* g; const float* b; int nslot;
    __device__ __forceinline__ void operator()(EPI_ARGS) const {
        LAS float* tabC = tab + 512; ln_tables(tab, tabC, st, nslot, u.row0, nullptr, 0, g, b, u.col0);
        const int c8 = u.col0 + wc * 32 + 8 * fq, cl = wc * 32 + 8 * fq; v4u zr[2][4][2];
        EPI_ROWS_BEGIN const size_t off = (size_t)(u.row0 + rloc) * DM + c8; zr[ai][m][0] = *(const GAS v4u*)(zb + off); zr[ai][m][1] = *(const GAS v4u*)(zb + off + 128); EPI_ROWS_END
        EPI_ROWS_BEGIN const size_t off = (size_t)(u.row0 + rloc) * DM + c8; const float mu = tab[2 * rloc], rstd = tab[2 * rloc + 1];
#pragma unroll
            for (int bj = 0; bj < 2; ++bj) { f32x4 x0, x1; unpack8(zr[ai][m][bj], x0, x1);
                const f32x4 g0 = *(const LAS f32x4*)(tabC + cl + bj * 128), g1 = *(const LAS f32x4*)(tabC + cl + bj * 128 + 4), b0 = *(const LAS f32x4*)(tabC + 256 + cl + bj * 128), b1 = *(const LAS f32x4*)(tabC + 256 + cl + bj * 128 + 4);
                x0 = (x0 - mu) * rstd * g0 + b0; x1 = (x1 - mu) * rstd * g1 + b1;
                *(GAS v4u*)(zb + off + bj * 128) = pack8(x0 * ALPHA + acc[ai][bj][m][0] * rs, x1 * ALPHA + acc[ai][bj][m][1] * rs); } EPI_ROWS_END
        LDS_WAIT(); __builtin_amdgcn_s_barrier(); asm volatile("" ::: "memory");
    } };
struct EpiFold { unsigned char* kft; unsigned char* vft; const float* g; const float* b; float* sc; LAS float* tab;
    __device__ __forceinline__ void operator()(EPI_ARGS) const {
        if (u.z) {
            EPI_ROWS_BEGIN unsigned char* rowp = vft + (size_t)(u.row0 + rloc) * 1024 + u.col0 + wc * 32 + 8 * fq;
#pragma unroll
                for (int bj = 0; bj < 2; ++bj) { const f32x4 v0 = acc[ai][bj][m][0] * SV8, v1 = acc[ai][bj][m][1] * SV8; v2u w; w.x = pk4_fp8(v0[0], v0[1], v0[2], v0[3]); w.y = pk4_fp8(v1[0], v1[1], v1[2], v1[3]); *(GAS v2u*)(rowp + bj * 128) = w; } EPI_ROWS_END
            return; }
        float ss[8], qq[8]; const int c8 = u.col0 + wc * 32 + 8 * fq, cl = wc * 32 + 8 * fq; LAS float* tabC = tab + 2048;
        { const int t = opaque_tid(); if (t < 256) tabC[t] = g[u.col0 + t] * CSC; else tabC[t] = b[u.col0 + t - 256] * CSC; }
        LDS_WAIT(); __builtin_amdgcn_s_barrier(); asm volatile("" ::: "memory");
        EPI_ROWS_BEGIN unsigned char* rowp = kft + (size_t)(u.row0 + rloc) * 1024 + c8; float s = 0.f, q = 0.f;
#pragma unroll
            for (int bj = 0; bj < 2; ++bj) { const f32x4 g0 = *(const LAS f32x4*)(tabC + cl + bj * 128), g1 = *(const LAS f32x4*)(tabC + cl + bj * 128 + 4), b0 = *(const LAS f32x4*)(tabC + 256 + cl + bj * 128), b1 = *(const LAS f32x4*)(tabC + 256 + cl + bj * 128 + 4);
                const f32x4 k0 = acc[ai][bj][m][0] * g0, k1 = acc[ai][bj][m][1] * g1, c0 = acc[ai][bj][m][0] * b0, c1 = acc[ai][bj][m][1] * b1;
                s += ((k0[0] + k0[1]) + (k0[2] + k0[3])) + ((k1[0] + k1[1]) + (k1[2] + k1[3])); q += ((c0[0] + c0[1]) + (c0[2] + c0[3])) + ((c1[0] + c1[1]) + (c1[2] + c1[3]));
                v2u w; w.x = pk4_fp8(k0[0] * SK8, k0[1] * SK8, k0[2] * SK8, k0[3] * SK8); w.y = pk4_fp8(k1[0] * SK8, k1[1] * SK8, k1[2] * SK8, k1[3] * SK8); *(GAS v2u*)(rowp + bj * 128) = w; }
            s += __shfl_xor(s, 16); s += __shfl_xor(s, 32); q += __shfl_xor(q, 16); q += __shfl_xor(q, 32); ss[ai * 4 + m] = s; qq[ai * 4 + m] = q; EPI_ROWS_END
        rowpair_publish(tab, sc, 4, u.col0 >> 8, u.row0, ss, qq, wr, wc, fr, fq);
    } };
struct EpiStore { bf16* base0; bf16* base1; float s0, s1; int ldc; int f8mask = 0;
    __device__ __forceinline__ void operator()(EPI_ARGS) const {
        bf16* base = u.z ? base1 : base0; const float sc = u.z ? s1 : s0;
        if ((f8mask >> (u.z ? 1 : 0)) & 1) { unsigned char* b8 = (unsigned char*)base;
            EPI_ROWS_BEGIN unsigned char* rowp = b8 + (size_t)(u.row0 + rloc) * ldc + u.col0 + wc * 32 + 8 * fq;
#pragma unroll
                for (int bj = 0; bj < 2; ++bj) { const f32x4 v0 = acc[ai][bj][m][0] * sc, v1 = acc[ai][bj][m][1] * sc; v2u w; w.x = pk4_fp8(v0[0], v0[1], v0[2], v0[3]); w.y = pk4_fp8(v1[0], v1[1], v1[2], v1[3]); *(GAS v2u*)(rowp + bj * 128) = w; } EPI_ROWS_END
            return; }
        EPI_ROWS_BEGIN bf16* rowp = base + (size_t)(u.row0 + rloc) * ldc + u.col0 + wc * 32 + 8 * fq;
#pragma unroll
            for (int bj = 0; bj < 2; ++bj) *(GAS v4u*)(rowp + bj * 128) = pack8(acc[ai][bj][m][0] * sc, acc[ai][bj][m][1] * sc); EPI_ROWS_END
    } };
struct EpiH0 { bf16* uv; bf16* qx; bf16* kx; bf16* vx; float rs;
    __device__ __forceinline__ void operator()(EPI_ARGS) const {
        const int pn = u.col0 >> 8, kind = pn < 4 ? 0 : ((pn - 4) >> 1) + 1;
        bf16* base = kind == 0 ? uv : kind == 1 ? qx : kind == 2 ? kx : vx;
        EPI_ROWS_BEGIN bf16* rowp = base + (size_t)(u.row0 + rloc) * DM;
#pragma unroll
            for (int bj = 0; bj < 2; ++bj) { f32x4 v0 = acc[ai][bj][m][0] * rs, v1 = acc[ai][bj][m][1] * rs;
                if (kind == 0) {
#pragma unroll
                    for (int j = 0; j < 4; ++j) { v0[j] = gelu_tanh(v0[j]); v1[j] = gelu_tanh(v1[j]); }
                    *(GAS v4u*)(rowp + u.col0 + bj * 128 + wc * 32 + 8 * fq) = pack8(v0, v1); }
                else { const int cr = ((pn - 4) & 1) * 256 + bj * 128 + wc * 32 + 8 * fq;
                    if (kind == 1) { v0 = v0 * C2; v1 = v1 * C2; }
                    *(GAS v4u*)(rowp + cr) = pack8(v0, v1); } } EPI_ROWS_END
    } };
struct EpiResid { const bf16* xb; bf16* zb; float rs = 1.0f;
    __device__ __forceinline__ void operator()(EPI_ARGS) const {
        EPI_ROWS_BEGIN const size_t off = (size_t)(u.row0 + rloc) * DM + u.col0 + wc * 32 + 8 * fq;
#pragma unroll
            for (int bj = 0; bj < 2; ++bj) { f32x4 x0, x1; unpack8(*(const GAS v4u*)(xb + off + bj * 128), x0, x1);
                *(GAS v4u*)(zb + off + bj * 128) = pack8(x0 * ALPHA + acc[ai][bj][m][0] * rs, x1 * ALPHA + acc[ai][bj][m][1] * rs); } EPI_ROWS_END
    } };
struct EpiUG { bf16* ug; float rs;
    __device__ __forceinline__ void operator()(EPI_ARGS) const {
        EPI_ROWS_BEGIN
#pragma unroll
            for (int bj = 0; bj < 2; ++bj) { const int col = u.col0 + bj * 128 + wc * 32 + 8 * fq;
                *(GAS v4u*)(ug + ((size_t)(col >> 4) * MTOK + (u.row0 + rloc)) * 16 + (col & 15)) = pack8(acc[ai][bj][m][0] * rs, acc[ai][bj][m][1] * rs); } EPI_ROWS_END
    } };
struct EpiScore { float* sc;
    __device__ __forceinline__ void operator()(EPI_ARGS) const {
        EPI_ROWS_BEGIN float* rowp = sc + (size_t)(u.row0 + rloc) * DM + u.col0 + wc * 32 + 8 * fq;
#pragma unroll
            for (int bj = 0; bj < 2; ++bj) { *(GAS f32x4*)(rowp + bj * 128) = acc[ai][bj][m][0]; *(GAS f32x4*)(rowp + bj * 128 + 4) = acc[ai][bj][m][1]; } EPI_ROWS_END
    } };
struct EpiSoftmaxP { bf16* P; LAS float* tab; float rs0; const float* st; const float* sc; int nslot;
    __device__ __forceinline__ void operator()(EPI_ARGS) const {
        { auto& A = const_cast<f32x4 (&)[2][2][4][2]>(acc); LAS float* tabC = tab + 512; ln_tables(tab, tabC, st, nslot, u.row0, sc, u.z * 1024 + u.col0, nullptr, nullptr, 0);
          const int cl = wc * 32 + 8 * fq;
          EPI_ROWS_BEGIN const float mu = tab[2 * rloc], rstd = tab[2 * rloc + 1];
#pragma unroll
              for (int bj = 0; bj < 2; ++bj)
#pragma unroll
                  for (int n = 0; n < 2; ++n) { const f32x4 s1 = *(const LAS f32x4*)(tabC + cl + bj * 128 + 4 * n), c1 = *(const LAS f32x4*)(tabC + 256 + cl + bj * 128 + 4 * n);
                      A[ai][bj][m][n] = (A[ai][bj][m][n] * rs0 - s1 * mu) * rstd + c1; } EPI_ROWS_END
          LDS_WAIT(); __builtin_amdgcn_s_barrier(); asm volatile("" ::: "memory"); }
        constexpr float rs = 1.0f;
        EPI_ROWS_BEGIN float mx = -3.0e38f;
#pragma unroll
            for (int bj = 0; bj < 2; ++bj)
#pragma unroll
                for (int n = 0; n < 2; ++n)
#pragma unroll
                    for (int j = 0; j < 4; ++j) mx = fmaxf(mx, acc[ai][bj][m][n][j]);
            mx *= rs; mx = fmaxf(mx, __shfl_xor(mx, 16)); mx = fmaxf(mx, __shfl_xor(mx, 32));
            float sm = 0.f;
#pragma unroll
            for (int bj = 0; bj < 2; ++bj)
#pragma unroll
                for (int n = 0; n < 2; ++n)
#pragma unroll
                    for (int j = 0; j < 4; ++j) sm += __builtin_amdgcn_exp2f(acc[ai][bj][m][n][j] * rs - mx);
            sm += __shfl_xor(sm, 16); sm += __shfl_xor(sm, 32);
            if (fq == 0) { tab[(rloc * 4 + wc) * 2] = mx; tab[(rloc * 4 + wc) * 2 + 1] = sm; } EPI_ROWS_END
        LDS_WAIT(); __builtin_amdgcn_s_barrier(); asm volatile("" ::: "memory");
        EPI_ROWS_BEGIN const f32x4 a = *(const LAS f32x4*)(tab + rloc * 8), b = *(const LAS f32x4*)(tab + rloc * 8 + 4);
            const float M = fmaxf(fmaxf(a[0], a[2]), fmaxf(b[0], b[2]));
            const float S = a[1] * __builtin_amdgcn_exp2f(a[0] - M) + a[3] * __builtin_amdgcn_exp2f(a[2] - M) + b[1] * __builtin_amdgcn_exp2f(b[0] - M) + b[3] * __builtin_amdgcn_exp2f(b[2] - M);
            const float inv = SP8 / S; unsigned char* rowp = (unsigned char*)P + (size_t)(u.row0 + rloc) * DM + u.col0 + wc * 32 + 8 * fq;
#pragma unroll
            for (int bj = 0; bj < 2; ++bj) { f32x4 v0, v1;
#pragma unroll
                for (int j = 0; j < 4; ++j) { v0[j] = __builtin_amdgcn_exp2f(acc[ai][bj][m][0][j] * rs - M) * inv; v1[j] = __builtin_amdgcn_exp2f(acc[ai][bj][m][1][j] * rs - M) * inv; }
                v2u w; w.x = pk4_fp8(v0[0], v0[1], v0[2], v0[3]); w.y = pk4_fp8(v1[0], v1[1], v1[2], v1[3]); *(GAS v2u*)(rowp + bj * 128) = w; } EPI_ROWS_END
        LDS_WAIT(); __builtin_amdgcn_s_barrier(); asm volatile("" ::: "memory");
    } };
struct EpiRouter { float* logit;
    __device__ __forceinline__ void operator()(EPI_ARGS) const {
        if (wc == 0) { EPI_ROWS_BEGIN float* rowp = logit + (size_t)(u.row0 + rloc) * 32 + 8 * fq; *(GAS f32x4*)(rowp) = acc[ai][0][m][0]; *(GAS f32x4*)(rowp + 4) = acc[ai][0][m][1]; EPI_ROWS_END }
    } };
struct EpiSwiglu { const float* bup; bf16* act;
    __device__ __forceinline__ void operator()(EPI_ARGS) const {
        const int j0 = u.col0 + wc * 32 + 8 * fq; const float* bb = bup + (size_t)u.z * 2048;
        const f32x4 bg0 = *(const GAS f32x4*)(bb + j0), bg1 = *(const GAS f32x4*)(bb + j0 + 4), bl0 = *(const GAS f32x4*)(bb + 1024 + j0), bl1 = *(const GAS f32x4*)(bb + 1024 + j0 + 4);
        EPI_ROWS_BEGIN f32x4 o0, o1;
#pragma unroll
            for (int j = 0; j < 4; ++j) {
                { const float gl = fminf(acc[ai][0][m][0][j] + bg0[j], 7.0f), ln = fminf(fmaxf(acc[ai][1][m][0][j] + bl0[j], -7.0f), 7.0f); o0[j] = gl * sigmoidf_(1.702f * gl) * (ln + 1.0f); }
                { const float gl = fminf(acc[ai][0][m][1][j] + bg1[j], 7.0f), ln = fminf(fmaxf(acc[ai][1][m][1][j] + bl1[j], -7.0f), 7.0f); o1[j] = gl * sigmoidf_(1.702f * gl) * (ln + 1.0f); } }
            *(GAS v4u*)(act + (size_t)(u.row0 + rloc) * DM + j0) = pack8(o0, o1); EPI_ROWS_END
    } };
struct EpiDown { const float* bdn; const int* list; const float* gate; bf16* ys; LAS const int* tab;
    __device__ __forceinline__ void operator()(EPI_ARGS) const {
        const int e = u.z, cnt = tab[e], c8 = u.col0 + wc * 32 + 8 * fq; const float* bb = bdn + (size_t)e * 1024 + c8;
        f32x4 bv[2][2];
#pragma unroll
        for (int bj = 0; bj < 2; ++bj) { bv[bj][0] = *(const GAS f32x4*)(bb + bj * 128); bv[bj][1] = *(const GAS f32x4*)(bb + bj * 128 + 4); }
        int av[8]; float gv[8];
#pragma unroll
        for (int i = 0; i < 8; ++i) { const int slot = u.aux * 256 + (i >> 2) * 128 + wr * 64 + (i & 3) * 16 + fr; const int sl = slot < cnt ? slot : 0;
            av[i] = (int)((unsigned)list[(size_t)e * CAP + sl] & (unsigned)(NASSIGN - 1)); }
#pragma unroll
        for (int i = 0; i < 8; ++i) gv[i] = gate[av[i]];
        EPI_ROWS_BEGIN const int slot = u.aux * 256 + rloc; const int a = av[ai * 4 + m]; const float gt = gv[ai * 4 + m]; bf16* rowp = ys + (size_t)a * DM + c8;
            if (slot < cnt) {
#pragma unroll
                for (int bj = 0; bj < 2; ++bj) *(GAS v4u*)(rowp + bj * 128) = pack8((acc[ai][bj][m][0] + bv[bj][0]) * gt, (acc[ai][bj][m][1] + bv[bj][1]) * gt); } EPI_ROWS_END
    } };
struct EpiSwiglu8 { const float* bup; unsigned char* act; int skip; LAS float* slot;
    static constexpr bool HAS_PRE = true;
    __device__ __forceinline__ void pre(const pg8::Unit& u, int wid, int lane) const {
        if (wid < 4) { const int t = wid * 64 + lane; const float* src = bup + (size_t)u.z * 2048 + u.col0 + (t < 128 ? t : 1024 + t - 128);
            __builtin_amdgcn_global_load_lds((const unsigned*)src, (LAS unsigned*)(slot + u.par * 256 + wid * 64), 4, 0, 0); } }
    __device__ __forceinline__ void operator()(EPI_ARGS) const {
        if (skip) {
#pragma unroll
            for (int a = 0; a < 2; ++a)
#pragma unroll
                for (int b = 0; b < 2; ++b)
#pragma unroll
                    for (int m = 0; m < 4; ++m) asm volatile("" :: "v"(acc[a][b][m][0]), "v"(acc[a][b][m][1])); return; }
        const int j0 = u.col0 + wc * 32 + 8 * fq; constexpr float RS = 1.0f / (SX8 * SWU8); const LAS float* sb = slot + u.par * 256 + wc * 32 + 8 * fq;
        const f32x4 bg0 = *(const LAS f32x4*)(sb), bg1 = *(const LAS f32x4*)(sb + 4), bl0 = *(const LAS f32x4*)(sb + 128), bl1 = *(const LAS f32x4*)(sb + 132);
        typedef float f32x2 __attribute__((ext_vector_type(2)));
        EPI_ROWS_BEGIN f32x4 o0, o1;
#pragma unroll
            for (int n = 0; n < 2; ++n)
#pragma unroll
                for (int h = 0; h < 2; ++h) {
                    const f32x4 ga = acc[ai][0][m][n], la = acc[ai][1][m][n], bgv = n ? bg1 : bg0, blv = n ? bl1 : bl0;
                    const f32x2 g2 = h ? ga.hi : ga.lo, l2 = h ? la.hi : la.lo, bg2 = h ? bgv.hi : bgv.lo, bl2 = h ? blv.hi : blv.lo;
                    f32x2 gl = g2 * RS + bg2, ln = l2 * RS + bl2;
                    gl.x = fminf(gl.x, 7.0f); gl.y = fminf(gl.y, 7.0f); ln.x = __builtin_amdgcn_fmed3f(ln.x, -7.0f, 7.0f); ln.y = __builtin_amdgcn_fmed3f(ln.y, -7.0f, 7.0f);
                    const f32x2 ea = gl * (-1.702f * LOG2E); f32x2 d; d.x = __builtin_amdgcn_exp2f(ea.x); d.y = __builtin_amdgcn_exp2f(ea.y); d = d + 1.0f;
                    f32x2 rc; rc.x = __builtin_amdgcn_rcpf(d.x); rc.y = __builtin_amdgcn_rcpf(d.y);
                    const f32x2 o = (gl * rc) * (ln * SA8 + SA8);
                    if (n == 0) { o0[2 * h] = o.x; o0[2 * h + 1] = o.y; } else { o1[2 * h] = o.x; o1[2 * h + 1] = o.y; } }
            v2u w; { int r0 = __builtin_amdgcn_cvt_pk_fp8_f32(o0[0], o0[1], 0, false); r0 = __builtin_amdgcn_cvt_pk_fp8_f32(o0[2], o0[3], r0, true); int r1 = __builtin_amdgcn_cvt_pk_fp8_f32(o1[0], o1[1], 0, false); r1 = __builtin_amdgcn_cvt_pk_fp8_f32(o1[2], o1[3], r1, true); w.x = (unsigned)r0; w.y = (unsigned)r1; }
            *(GAS v2u*)(act + (size_t)(u.row0 + rloc) * DM + j0) = w; EPI_ROWS_END
    } };
struct EpiDown8 { const float* bdn; bf16* ys; LAS float* slot;
    static constexpr bool HAS_PRE = true;
    __device__ __forceinline__ void pre(const pg8::Unit& u, int wid, int lane) const {
        if (wid < 4) __builtin_amdgcn_global_load_lds((const unsigned*)(bdn + (size_t)u.z * 1024 + u.col0 + wid * 64 + lane), (LAS unsigned*)(slot + u.par * 256 + wid * 64), 4, 0, 0); }
    __device__ __forceinline__ void operator()(EPI_ARGS) const {
        const int c8 = u.col0 + wc * 32 + 8 * fq; const LAS float* bb = slot + u.par * 256 + wc * 32 + 8 * fq; constexpr float RS = 1.0f / (SA8 * SWD8);
        f32x4 bv[2][2];
#pragma unroll
        for (int bj = 0; bj < 2; ++bj) { bv[bj][0] = *(const LAS f32x4*)(bb + bj * 128); bv[bj][1] = *(const LAS f32x4*)(bb + bj * 128 + 4); }
        EPI_ROWS_BEGIN unsigned char* rowp = (unsigned char*)ys + (size_t)(u.row0 + rloc) * DM + c8;
#pragma unroll
            for (int bj = 0; bj < 2; ++bj) { const f32x4 v0 = (acc[ai][bj][m][0] * RS + bv[bj][0]) * SY8, v1 = (acc[ai][bj][m][1] * RS + bv[bj][1]) * SY8; v2u w; w.x = pk4_fp8(v0[0], v0[1], v0[2], v0[3]); w.y = pk4_fp8(v1[0], v1[1], v1[2], v1[3]); *(GAS v2u*)(rowp + bj * 128) = w; } EPI_ROWS_END
    } };
struct EpiValGate { const bf16* xb; bf16* zb; float rsv, rsg; unsigned char* z8; float* st; LAS float* tab;
    __device__ __forceinline__ void operator()(EPI_ARGS) const {
        float ss[8], qq[8]; v4u xr[2][4];
        EPI_ROWS_BEGIN xr[ai][m] = *(const GAS v4u*)(xb + (size_t)(u.row0 + rloc) * DM + u.col0 + wc * 32 + 8 * fq); EPI_ROWS_END
        EPI_ROWS_BEGIN const size_t off = (size_t)(u.row0 + rloc) * DM + u.col0 + wc * 32 + 8 * fq; f32x4 x0, x1; unpack8(xr[ai][m], x0, x1); f32x4 o0, o1;
#pragma unroll
            for (int j = 0; j < 4; ++j) { o0[j] = x0[j] * ALPHA + acc[ai][0][m][0][j] * rsv * sigmoidf_(acc[ai][1][m][0][j] * rsg); o1[j] = x1[j] * ALPHA + acc[ai][0][m][1][j] * rsv * sigmoidf_(acc[ai][1][m][1][j] * rsg); }
            *(GAS v4u*)(zb + off) = pack8(o0, o1);
            { v2u w; w.x = pk4_fp8(o0[0] * SZ8, o0[1] * SZ8, o0[2] * SZ8, o0[3] * SZ8); w.y = pk4_fp8(o1[0] * SZ8, o1[1] * SZ8, o1[2] * SZ8, o1[3] * SZ8); *(GAS v2u*)(z8 + off) = w; }
            float s = ((o0[0] + o0[1]) + (o0[2] + o0[3])) + ((o1[0] + o1[1]) + (o1[2] + o1[3])), q = ((o0[0] * o0[0] + o0[1] * o0[1]) + (o0[2] * o0[2] + o0[3] * o0[3])) + ((o1[0] * o1[0] + o1[1] * o1[1]) + (o1[2] * o1[2] + o1[3] * o1[3]));
            s += __shfl_xor(s, 16); s += __shfl_xor(s, 32); q += __shfl_xor(q, 16); q += __shfl_xor(q, 32); ss[ai * 4 + m] = s; qq[ai * 4 + m] = q;
            asm volatile("" ::: "memory"); EPI_ROWS_END
        rowpair_publish(tab, st, 8, u.col0 >> 7, u.row0, ss, qq, wr, wc, fr, fq);
    } };

#ifndef ONLY_SITE
#define ONLY_SITE -1
#endif
#define SITE(s) (ONLY_SITE < 0 || ONLY_SITE == (s))
#define IN(k) (lo <= (k) && (k) < hi)
#define SEAM(k) do { if (IN(k) && IN((k) + 1)) xcd_barrier(bar); } while (0)
template <int l>
__device__ __forceinline__ void layer_shared(Frame& F, const Args& args, const XcdBarrier& bar, const int lo, const int hi) {
    unsigned char* ws = args.ws; bf16* const XB = (bf16*)(ws + WS_XB); bf16* const ZB = (bf16*)(ws + WS_ZB); const int cid = (int)blockIdx.x;
    constexpr int pb = 5 + 14 * l;
        gu32* cnt = F.ctl + CW_CNT + l * 32 * 64;
    const float* st1 = (const float*)(ws + WS_ST) + (size_t)l * MTOK * 16; const float* sc1 = (const float*)(ws + WS_SCC) + (size_t)l * 16384 * 8;
    if (IN(pb + 1) && SITE(6)) { PlainSched S; S.T.init(MTOK / 256, 4, F.G, cid); S.A = (const char*)(ws + WS_XFZ); S.B = (const char*)(ws + WS_KFT); S.tilesPerBatch = SEQ / 256; S.bBatch = (size_t)1024 * 1024; S.splitN = 0; S.aT = (size_t)256 * 1024; S.bT = (size_t)256 * 1024;
        EpiSoftmaxP E{(bf16*)(ws + WS_P), (LAS float*)(F.lds + SMX_OFF), 1.0f / (SZ8 * SK8), st1, sc1, l ? 8 : 4}; pg8::gemm_phase<EpiSoftmaxP, PlainSched, false, true>(F.lds, 1024, S, E); } SEAM(pb + 1);
    if (IN(pb + 3) && SITE(8)) { PlainSched S; S.T.init(MTOK / 256, 4, F.G, cid); S.A = (const char*)(ws + WS_P); S.B = (const char*)(ws + WS_VFT); S.tilesPerBatch = SEQ / 256; S.bBatch = (size_t)1024 * 1024; S.splitN = 0; S.aT = (size_t)256 * 1024; S.bT = (size_t)256 * 1024;
        EpiResidLN E{ZB, 1.0f / (SP8 * SV8), st1, (LAS float*)(F.lds + SMX_OFF), (l ? args.in[39] : args.in[14]), (l ? args.in[40] : args.in[15]), l ? 8 : 4}; pg8::gemm_phase<EpiResidLN, PlainSched, false, true>(F.lds, 1024, S, E); } SEAM(pb + 3);
    if (IN(pb + 4) && SITE(9)) { ph_ln2_router(F, ZB, XB, MOE_FP8 ? ws + WS_XF8 : nullptr, (l ? args.in[43] : args.in[18]), (l ? args.in[44] : args.in[19]), (const bf16*)(ws + WS_WR) + (size_t)l * 256 * 1024,
                                               (l ? args.in[46] : args.in[21]), cnt, (int*)(ws + WS_LIST), (float*)(ws + WS_GATE), (int*)(ws + WS_ASG), (float*)(ws + WS_ST2)); } SEAM(pb + 4);
    if (IN(pb + 7) && SITE(12)) { moe_tables(F, cnt);
#if MOE_FP8
        MoeSched S{(LAS const int*)(F.lds + TAB_OFF), 8, F.G, F.vcu, (const char*)(ws + WS_XF8), (const char*)(ws + WS_WUP8), (size_t)2048 * 1024, 128, (const int*)(ws + WS_LIST), true, (size_t)256 * 1024};
        EpiSwiglu8 E{(l ? args.in[48] : args.in[23]), ws + WS_ACT, args.variant == 9, (LAS float*)(F.lds + SMX_OFF)}; pg8::gemm_phase<EpiSwiglu8, MoeSched, true, true>(F.lds, 1024, S, E);
#else
        MoeSched S{(LAS const int*)(F.lds + TAB_OFF), 8, F.G, F.vcu, (const char*)XB, (const char*)(ws + WS_WUP), (size_t)2048 * 1024 * 2, 128, (const int*)(ws + WS_LIST), true, pg8::TSTEP};
        EpiSwiglu E{(l ? args.in[48] : args.in[23]), (bf16*)(ws + WS_ACT)}; pg8::gemm_phase<EpiSwiglu, MoeSched, true>(F.lds, 1024, S, E);
#endif
    } SEAM(pb + 7);
    if (IN(pb + 8) && SITE(13)) { moe_tables(F, cnt);
#if MOE_FP8
        MoeSched S{(LAS const int*)(F.lds + TAB_OFF), 4, F.G, F.vcu, (const char*)(ws + WS_ACT), (const char*)(ws + WS_WDN8), (size_t)1024 * 1024, 256, (const int*)(ws + WS_LIST), false, (size_t)256 * 1024};
        EpiDown8 E{(l ? args.in[50] : args.in[25]), (bf16*)(ws + WS_YS), (LAS float*)(F.lds + SMX_OFF)}; pg8::gemm_phase<EpiDown8, MoeSched, false, true>(F.lds, 1024, S, E);
#else
        MoeSched S{(LAS const int*)(F.lds + TAB_OFF), 4, F.G, F.vcu, (const char*)(ws + WS_ACT), (const char*)(ws + WS_WDN), (size_t)1024 * 1024 * 2, 256, (const int*)(ws + WS_LIST), false, pg8::TSTEP};
        EpiDown E{(l ? args.in[50] : args.in[25]), (const int*)(ws + WS_LIST), (const float*)(ws + WS_GATE), (bf16*)(ws + WS_YS), (LAS const int*)(F.lds + TAB_OFF)}; pg8::gemm_phase<EpiDown, MoeSched, false>(F.lds, 1024, S, E);
#endif
    } SEAM(pb + 8);
    if (IN(pb + 9) && SITE(14)) { moe_tables(F, cnt); ph_ln<1>(F, ZB, (const bf16*)(ws + WS_YS), XB, l ? args.out : nullptr, (l ? args.in[51] : args.in[26]), (l ? args.in[52] : args.in[27]), (l == 0) ? ws + WS_XF8 : nullptr, (const int*)(ws + WS_ASG), (const float*)(ws + WS_GATE),
                                                             (const float*)(ws + WS_ST2), (l ? args.in[43] : args.in[18]), (l ? args.in[44] : args.in[19]));
        if (l == 0) { __syncthreads(); cvt_experts(F, args.in[47], args.in[49], ws); } } SEAM(pb + 9);
}

constexpr int PH_TOTAL = 29;
__global__ void __launch_bounds__(NWAVES * 64, 2) mk_fwd(Args args) {
    extern __shared__ __attribute__((aligned(16))) unsigned char lds[];
    Frame F;
    F.lds = (LAS unsigned char*)lds; F.MISC = (volatile LAS unsigned*)(F.lds + MISC_OFF);
    F.wave = __builtin_amdgcn_readfirstlane((int)threadIdx.x >> 6);
    F.G = gridDim.x; { const int bx = blockIdx.x; F.vcu = (F.G % 8 == 0) ? (bx % 8) * (F.G / 8) + bx / 8 : bx; }
    unsigned char* ws = args.ws;
    F.ctl = (gu32*)(ws + WS_CTL);
    for (int u = FTID; u < (LDS_BYTES - LDSCTL_OFF) / 4; u += NWAVES * 64) ((LAS unsigned*)(F.lds + LDSCTL_OFF))[u] = 0u;
    __syncthreads();
    const int lo = args.ph_lo, hi = args.ph_hi;
    XcdBarrier bar; bar.bar = (unsigned*)(F.ctl + CW_BAR); bar.x = 0; bar.st = nullptr;
    if (hi - lo > 1) bar = xcd_barrier_post((unsigned*)(F.ctl + CW_BAR), F.MISC + 8);
    bf16* const XB = (bf16*)(ws + WS_XB); bf16* const ZB = (bf16*)(ws + WS_ZB);
    const int cid = (int)blockIdx.x;

    if (IN(0) && SITE(0)) { p0_prologue(F, args); } SEAM(0);
    if (IN(1) && SITE(1)) {
        { PlainSched S; S.T.init(MTOK / 256, HW0 / 256, F.G, cid); S.A = (const char*)XB; S.B = (const char*)(ws + WS_WIN0); S.tilesPerBatch = 1 << 20; S.bBatch = 0; S.splitN = 0;
          EpiH0 E{(bf16*)(ws + WS_UV), (bf16*)(ws + WS_QX), (bf16*)(ws + WS_QX) + 512, (bf16*)(ws + WS_VX), 1.0f}; pg8::gemm_phase<EpiH0, PlainSched>(F.lds, 1024, S, E); }
        { PlainSched S; S.T.init(NB * MEMLEN / 256, 2048 / 256, F.G, cid); S.A = (const char*)(ws + WS_MEMB); S.B = (const char*)(ws + WS_WKV); S.tilesPerBatch = 1 << 20; S.bBatch = 0; S.splitN = 4;
          EpiStore E{(bf16*)(ws + WS_KB), (bf16*)(ws + WS_VB), 1.f, 1.f, 1024}; pg8::gemm_phase<EpiStore, PlainSched>(F.lds, 1024, S, E); }
    } SEAM(1);
    if (IN(2) && SITE(2)) {
        attn_body::bf16* oat = (attn_body::bf16*)(ws + WS_OATT);
        { const attn_body::AttnTensors AT{(const attn_body::bf16*)(ws + WS_QX), (const attn_body::bf16*)(ws + WS_QX) + 512, (const attn_body::bf16*)(ws + WS_VX), oat};
          const attn_body::StaticOrder S((int)F.G, (int)blockIdx.x); attn_body::attn_phase<attn_body::StaticOrder>((char*)lds, AT, S); }
        VM_WAIT(); __syncthreads();
        if (F.G == 256) combine_local(F, (const bf16*)(ws + WS_OATT), (bf16*)(ws + WS_MIX), args.in[8], args.in[9], args.in[10], args.in[11], args.in[12], F.vcu >> 4, (F.vcu >> 2) & 3, F.vcu & 3);
        __syncthreads();
        ph_sgu(F, (const bf16*)(ws + WS_UV), (bf16*)(ws + WS_MIX), args.in[4], args.in[5], args.in[6], args.in[7]);
    } SEAM(2);
    if (IN(4) && SITE(4)) {
        { PlainSched S; S.T.init(MTOK / 256, 4, F.G, cid); S.A = (const char*)(ws + WS_MIX); S.B = (const char*)(ws + WS_WOUT0); S.tilesPerBatch = 1 << 20; S.bBatch = 0; S.splitN = 0;
          EpiResidStats E{XB, ZB, ws + WS_XFZ, (float*)(ws + WS_ST), (LAS float*)(F.lds + SMX_OFF)}; pg8::gemm_phase<EpiResidStats, PlainSched>(F.lds, 1024, S, E); }
        { FoldSched S{F.G, F.vcu, 0, (const char*)(ws + WS_KB), (const char*)(ws + WS_VB), (const char*)(ws + WS_XQB), (const char*)(ws + WS_XOT)};
          EpiFold E{ws + WS_KFT, ws + WS_VFT, args.in[14], args.in[15], (float*)(ws + WS_SCC), (LAS float*)(F.lds + SMX_OFF)}; int kf = 256; asm volatile("" : "+s"(kf)); pg8::gemm_phase<EpiFold, FoldSched>(F.lds, kf, S, E); }
    } SEAM(4);

    layer_shared<0>(F, args, bar, lo, hi);
    if (IN(15) && SITE(15)) { { PlainSched S; S.T.init(MTOK / 256, 4, F.G, cid); S.A = (const char*)(ws + WS_XF8); S.B = (const char*)(ws + WS_WIN1); S.tilesPerBatch = 1 << 20; S.bBatch = 0; S.splitN = 0; S.aT = (size_t)256 * 1024; S.bT = (size_t)256 * 1024;
        EpiUG E{(bf16*)(ws + WS_UG), 1.0f / (SX8 * SWU8)}; pg8::gemm_phase<EpiUG, PlainSched, false, true>(F.lds, 1024, S, E); }
        { FoldSched S{F.G, F.vcu, 0, (const char*)(ws + WS_KB), (const char*)(ws + WS_VB), (const char*)(ws + WS_XQB) + 1024 * 1024 * 2, (const char*)(ws + WS_XOT) + 1024 * 1024 * 2};
      EpiFold E{ws + WS_KFT, ws + WS_VFT, args.in[39], args.in[40], (float*)(ws + WS_SCC) + (size_t)16384 * 8, (LAS float*)(F.lds + SMX_OFF)}; int kf = 256; asm volatile("" : "+s"(kf)); pg8::gemm_phase<EpiFold, FoldSched>(F.lds, kf, S, E); }
    } SEAM(15);
    if (IN(16) && SITE(16)) { ph_s5(F, (const bf16*)(ws + WS_UG), (bf16*)(ws + WS_YB), args.in[29], args.in[30], args.in[31], args.in[32], args.in[33], args.in[34], args.in[35], args.in[36], args.variant); } SEAM(16);
    if (IN(17) && SITE(17)) { PlainSched S; S.T.init(MTOK / 256, 8, F.G, cid); S.A = (const char*)(ws + WS_YB); S.B = (const char*)(ws + WS_WVG); S.tilesPerBatch = 1 << 20; S.bBatch = 0; S.splitN = 0; S.aT = (size_t)256 * 16; S.bT = (size_t)256 * 1024;
        struct VGS { PlainSched P; __device__ __forceinline__ bool next(int i, pg8::Unit& u) const { if (!P.next(i, u)) return false; u.col0 >>= 1; return true; } } S2{S};
        EpiValGate E{XB, ZB, 1.0f / (SA8 * SWD8), 1.0f / (SA8 * SWU8), ws + WS_XFZ, (float*)(ws + WS_ST) + (size_t)MTOK * 16, (LAS float*)(F.lds + SMX_OFF)}; pg8::gemm_phase<EpiValGate, VGS, false, true, 1>(F.lds, 1024, S2, E); } SEAM(17);
    layer_shared<1>(F, args, bar, lo, hi);
#undef IN
#undef SEAM
}

extern "C" void kernel_launch(void* const* d_in, const int* in_sizes, int n_in, void* d_out, int out_size, void* d_ws, size_t ws_size, hipStream_t stream) {
    static int grid = 0;
    if (grid == 0) {
        if (n_in != 53 || in_sizes[0] != MTOK * DM || out_size != MTOK * DM || ws_size < WS_END) { fprintf(stderr, "kernel_launch: unexpected problem (n_in %d, in0 %d, out %d, ws %zu < %zu); nothing launched\n", n_in, n_in > 0 ? in_sizes[0] : -1, out_size, ws_size, (size_t)WS_END); grid = -1; return; }
        int dev = 0, cus = 0, per_cu = 0;
        if (hipGetDevice(&dev) != hipSuccess || hipDeviceGetAttribute(&cus, hipDeviceAttributeMultiprocessorCount, dev) != hipSuccess) { grid = -1; return; }
        if (hipFuncSetAttribute((const void*)mk_fwd, hipFuncAttributeMaxDynamicSharedMemorySize, LDS_BYTES) != hipSuccess) { fprintf(stderr, "kernel_launch: hipFuncSetAttribute failed\n"); grid = -1; return; }
        if (hipOccupancyMaxActiveBlocksPerMultiprocessor(&per_cu, (const void*)mk_fwd, NWAVES * 64, LDS_BYTES) != hipSuccess || per_cu < 1) fprintf(stderr, "kernel_launch: note: occupancy query reports %d\n", per_cu);
        (void)hipGetLastError();
        grid = cus;
    }
    if (grid < 0) return;
    if (hipMemsetAsync((char*)d_ws + WS_CTL, 0, CTL_ZERO_BYTES, stream) != hipSuccess) return;
    Args a{};
    for (int i = 0; i < 53; ++i) a.in[i] = (const float*)d_in[i];
    a.out = (float*)d_out; a.ws = (unsigned char*)d_ws;
#if MK_N_LAUNCHES == 1
    a.ph_lo = 0; a.ph_hi = PH_TOTAL;
    hipLaunchKernelGGL(mk_fwd, dim3(grid), dim3(NWAVES * 64), LDS_BYTES, stream, a);
#else
    for (int p = 0; p < PH_TOTAL; ++p) { if (p == 18 || p == 5 || p == 19) continue; a.ph_lo = p; a.ph_hi = p + 1;
        for (int rep = 0; rep < 1 + (int)(((PROBE_REPEAT_MASK) >> p) & 1ull); ++rep) { a.variant = (rep == 0 && (((PROBE_REPEAT_MASK) >> p) & 1ull)) ? PROBE_VARIANT : 0; hipLaunchKernelGGL(mk_fwd, dim3(grid), dim3(NWAVES * 64), LDS_BYTES, stream, a); } }
#endif
}
```

```cpp
#include <hip/hip_runtime.h>
#include <hip/hip_bf16.h>
#include <cstdio>
#include <cstdint>

#ifndef MK_N_LAUNCHES
#define MK_N_LAUNCHES 1
#endif

#ifndef MOE_FP8
#define MOE_FP8 1
#endif
#ifndef PROBE_VARIANT
#define PROBE_VARIANT 0
#endif
#ifndef PROBE_REPEAT_MASK
#define PROBE_REPEAT_MASK 0ull
#endif
#define GAS __attribute__((address_space(1)))
#define LAS __attribute__((address_space(3)))
typedef unsigned short bf16;
typedef unsigned v4u __attribute__((ext_vector_type(4)));
typedef unsigned v2u __attribute__((ext_vector_type(2)));
typedef float f32x4 __attribute__((ext_vector_type(4)));
typedef float f32x2 __attribute__((ext_vector_type(2)));
typedef short bf16x8 __attribute__((ext_vector_type(8)));
typedef int v4i_t __attribute__((ext_vector_type(4)));
typedef GAS unsigned gu32;
#define RLX_AGENT __ATOMIC_RELAXED, __HIP_MEMORY_SCOPE_AGENT
#define LDS_WAIT() asm volatile("s_waitcnt lgkmcnt(0)" ::: "memory")
#define VM_WAIT() asm volatile("s_waitcnt vmcnt(0)" ::: "memory")

constexpr int NB = 16, SEQ = 2048, DM = 1024, MTOK = NB * SEQ;
constexpr int MEMLEN = 256, NEXP = 32, TOPK = 4, NASSIGN = MTOK * TOPK;
constexpr int HW0 = 2560;
constexpr int CAP = MTOK;
constexpr int MAXBLK = NASSIGN / 256 + NEXP;
constexpr float LN_EPS = 1e-5f;
constexpr float ALPHA = 1.41421356237f;
constexpr float LOG2E = 1.4426950408889634f;
constexpr float C2 = 0.125f * LOG2E;
constexpr float CSC = 0.0625f * LOG2E;
constexpr float LAM_INIT0 = 0.2f;

constexpr size_t MiB = 1u << 20;
constexpr size_t WS_CTL = 0, CTL_ZERO_BYTES = 96 * 1024;
constexpr size_t WS_LIST = 1 * MiB;
constexpr size_t WS_GATE = WS_LIST + 4 * MiB;
constexpr size_t WS_ASG = WS_GATE + 512 * 1024;
constexpr size_t WS_LOGIT = WS_GATE + 1 * MiB;
constexpr size_t WS_WKV = WS_LOGIT + 4 * MiB;
constexpr size_t WS_WIN0 = WS_WKV + 4 * MiB;
constexpr size_t WS_WOUT0 = WS_WIN0 + 5 * MiB;
constexpr size_t WS_XQB = WS_WOUT0 + 2 * MiB;
constexpr size_t WS_XOT = WS_XQB + 4 * MiB;
constexpr size_t WS_WIN1 = WS_XOT + 4 * MiB;
constexpr size_t WS_WVG = WS_WIN1 + 2 * MiB;
constexpr size_t WS_WR = WS_WVG + 4 * MiB;
constexpr size_t WS_MEMB = WS_WR + 1 * MiB;
constexpr size_t WS_KB = WS_MEMB + 8 * MiB;
constexpr size_t WS_VB = WS_KB + 8 * MiB;
constexpr size_t WS_KFT = WS_VB + 8 * MiB;
constexpr size_t WS_VFT = WS_KFT + 32 * MiB;
constexpr size_t WS_WUP = WS_VFT + 32 * MiB;
constexpr size_t WS_WDN = WS_WUP + 128 * MiB;
constexpr size_t WS_XB = WS_WDN + 64 * MiB;
constexpr size_t WS_ZB = WS_XB + 64 * MiB;
constexpr size_t WS_BIG1 = WS_ZB + 64 * MiB;
constexpr size_t WS_BIG2 = WS_BIG1 + 272 * MiB;
constexpr size_t WS_END = WS_BIG2 + 272 * MiB;
static_assert(WS_END <= 1024 * MiB, "workspace map exceeds 1 GiB");
constexpr size_t WS_UV = WS_BIG1;
constexpr size_t WS_QX = WS_BIG1 + 64 * MiB;
constexpr size_t WS_KX = WS_BIG1 + 128 * MiB;
constexpr size_t WS_VX = WS_BIG1 + 192 * MiB;
constexpr size_t WS_SC = WS_BIG1;
constexpr size_t WS_WUP8 = WS_WUP;
constexpr size_t WS_WDN8 = WS_WUP + 64 * MiB;
constexpr size_t WS_XF8 = WS_WUP + 96 * MiB;
constexpr float SX8 = 4.0f, SWU8 = 64.0f, SA8 = 4.0f, SWD8 = 128.0f, SP8 = 256.0f, SV8 = 8.0f, SK8 = 32.0f, SY8 = 32.0f;
constexpr size_t WS_XFZ = WS_WDN;
constexpr size_t WS_SCC = WS_WDN + 32 * MiB;
constexpr size_t WS_ST2 = WS_WDN + 40 * MiB;
constexpr size_t WS_ST = WS_LOGIT;
constexpr float SZ8 = 8.0f;
constexpr size_t WS_ACT = WS_BIG1;
constexpr size_t WS_OATT = WS_BIG2;
constexpr size_t WS_MIX = WS_BIG2 + 64 * MiB;
constexpr size_t WS_P = WS_BIG2 + 128 * MiB;
constexpr size_t WS_UG = WS_BIG2;
constexpr size_t WS_YB = WS_BIG2 + 64 * MiB;
constexpr size_t WS_XG = WS_BIG2;
constexpr size_t WS_YS = WS_BIG2;

constexpr int CW_TMO = 0;
constexpr int CW_BAR = 4096;
constexpr int CW_CNT = 16384;
static_assert((CW_CNT + 64 * 64) * 4 <= (int)CTL_ZERO_BYTES && (CW_BAR + 3456) * 4 <= (int)CTL_ZERO_BYTES, "control words inside the per-call memset");

constexpr int RING_BYTES = 131072;
constexpr int SCR_BYTES = 135168;
constexpr int LDSCTL_OFF = SCR_BYTES, MISC_OFF = LDSCTL_OFF + 320;
constexpr int TAB_OFF = MISC_OFF + 128;
constexpr int SMX_OFF = TAB_OFF + 576;
constexpr int LDS_BYTES = 147456;
static_assert(SMX_OFF % 16 == 0 && SMX_OFF + 8192 <= LDS_BYTES, "LDS map");

__device__ __forceinline__ unsigned f2bf(float f) { unsigned u = __builtin_bit_cast(unsigned, f); return (u + 0x7fffu + ((u >> 16) & 1u)) >> 16; }
typedef float pk2_f32x2 __attribute__((ext_vector_type(2))); typedef __bf16 pk2_bf16x2 __attribute__((ext_vector_type(2)));
__device__ __forceinline__ unsigned pk2(float lo, float hi) { const pk2_f32x2 v = {lo, hi}; return __builtin_bit_cast(unsigned, __builtin_convertvector(v, pk2_bf16x2)); }
__device__ __forceinline__ float bflo(unsigned w) { return __builtin_bit_cast(float, w << 16); }
__device__ __forceinline__ float bfhi(unsigned w) { return __builtin_bit_cast(float, w & 0xffff0000u); }
__device__ __forceinline__ float bf2f(bf16 b) { return __builtin_bit_cast(float, ((unsigned)b) << 16); }
__device__ __forceinline__ float wave_sum(float v) {
#pragma unroll
    for (int o = 1; o < 64; o <<= 1) v += __shfl_xor(v, o);
    return v;
}
__device__ __forceinline__ float wave_max(float v) {
#pragma unroll
    for (int o = 1; o < 64; o <<= 1) v = fmaxf(v, __shfl_xor(v, o));
    return v;
}
__device__ __forceinline__ float gelu_tanh(float x) {
    const float t = x * (0.7978845608f * 2.0f * LOG2E) * (1.0f + 0.044715f * x * x);
    return x * __builtin_amdgcn_rcpf(1.0f + __builtin_amdgcn_exp2f(-t));
}
__device__ __forceinline__ f32x2 gelu_tanh2(f32x2 x, float osc) {
    constexpr float K1 = 0.7978845608f * 2.0f * LOG2E, K2 = K1 * 0.044715f; const float io = 1.0f / osc;
    const f32x2 t = x * (x * x * K2 + K1); f32x2 e; e.x = __builtin_amdgcn_exp2f(-t.x); e.y = __builtin_amdgcn_exp2f(-t.y);
    const f32x2 d = e * io + io; f32x2 rc; rc.x = __builtin_amdgcn_rcpf(d.x); rc.y = __builtin_amdgcn_rcpf(d.y); return x * rc; }
__device__ __forceinline__ float sigmoidf_(float x) { return __builtin_amdgcn_rcpf(1.0f + __builtin_amdgcn_exp2f(-x * LOG2E)); }

namespace pg8 {
constexpr int BM = 256, BK = 64, HALF = 128, HTB = HALF * BK * 2, STAGE_BYTES = 8 * HTB, NXCD = 8, WGM = 8;
constexpr int LD = 1024;
constexpr size_t HSTEP = (size_t)HALF * LD * 2, TSTEP = 2 * HSTEP;
__host__ __device__ __forceinline__ int lds_byte(int r, int c) { const int st = (r >> 4) * 2 + (c >> 5), rr = r & 15, cc = c & 31, ob = rr * 64 + cc * 2; return st * 1024 + (ob ^ (((ob >> 9) & 1) << 5)); }
__host__ __device__ __forceinline__ void stage_rc(int b, int& R, int& C) { const int st = b / 1024, sb = b % 1024, swz = sb ^ (((sb >> 9) & 1) << 5); R = (st >> 1) * 16 + swz / 64; C = (st & 1) * 32 + (swz % 64) / 2; }
__host__ __device__ __forceinline__ int perm32(int rho) { const int n = rho >> 4, i = rho & 15; return 8 * (i >> 2) + 4 * n + (i & 3); }

struct Unit { const char* a; const char* b; int row0, col0, z, aux, par; };
template <class E, class = void> struct epi_has_pre { static constexpr bool value = false; };
template <class E> struct epi_has_pre<E, decltype((void)E::HAS_PRE)> { static constexpr bool value = true; };

struct TileOrder {
    int nM, nN, nwg, G, c;
    __device__ void init(int nM_, int nN_, int G_, int c_) { nM = nM_; nN = nN_; nwg = nM * nN; G = G_; c = c_; }
    __device__ bool get(int i, int& pm, int& pn) const {
        const long L = (long)i * G + c; if (L >= nwg) return false;
        int wgid = (int)L; { const int q = nwg / NXCD, r = nwg % NXCD, xcd = wgid % NXCD, off = wgid / NXCD; wgid = (xcd < r ? xcd * (q + 1) : r * (q + 1) + (xcd - r) * q) + off; }
        const int nig = WGM * nN, gid = wgid / nig, fm = gid * WGM, gsz = (nM - fm) < WGM ? (nM - fm) : WGM;
        pm = fm + ((wgid % nig) % gsz); pn = (wgid % nig) / gsz; return true;
    }
};

__device__ __forceinline__ unsigned cvt_pk_bf16(float lo, float hi) { unsigned r; asm volatile("v_cvt_pk_bf16_f32 %0, %1, %2" : "=v"(r) : "v"(lo), "v"(hi)); return r; }

template <class Epi, class Sched, bool GATHER = false, bool FP8 = false, int ALAY = 0>
__device__ __forceinline__ void gemm_phase(LAS unsigned char* lds, const int K, const Sched& S, const Epi& E) {
    int tid = threadIdx.x; asm volatile("" : "+v"(tid));
    const int wid = __builtin_amdgcn_readfirstlane(tid >> 6), lane = tid & 63, wr = wid >> 2, wc = wid & 3, fr = lane & 15, fq = lane >> 4;
    constexpr unsigned ROWB = FP8 ? 1024u : 2048u;
    const int nt = FP8 ? K / 128 : K / BK;
    unsigned voffA[2], voffB[2]; int RA[2], CA[2];
#pragma unroll
    for (int i = 0; i < 2; ++i) { int R, C; stage_rc(tid * 16 + i * 8192, R, C); const int Rb = (R & ~31) + perm32(R & 31);
        voffA[i] = ALAY ? (unsigned)(C >> 3) * (unsigned)(MTOK * 16) + (unsigned)R * 16u : (unsigned)R * ROWB + (unsigned)C * 2u; voffB[i] = (unsigned)Rb * ROWB + (unsigned)C * 2u; RA[i] = R; CA[i] = C; }
    const size_t kstep = (size_t)(BK * 2);
    const size_t kstepA = ALAY ? (size_t)8 * MTOK * 16 : kstep;
    const size_t hstepB = (size_t)HALF * ROWB;
    const size_t hstepA = GATHER ? 0 : (ALAY ? (size_t)HALF * 16 : (size_t)HALF * ROWB);
    const unsigned ldsw = (unsigned)wid * 1024u;
    const int aoff0 = lds_byte(wr * 64 + fr, fq * 8);
    const int boff0 = lds_byte(wc * 32 + fr, fq * 8);
    unsigned aB = (unsigned)(uintptr_t)lds + (unsigned)aoff0, bB = (unsigned)(uintptr_t)lds + 4u * HTB + (unsigned)boff0; asm volatile("" : "+v"(aB), "+v"(bB));
    constexpr int KOFF = 1024;
#define PG8_SA(b, h) (((b) * 2 + (h)) * HTB)
#define PG8_SB(b, h) ((4 + (b) * 2 + (h)) * HTB)
#define PG8_STAGE(bufoff, gbase, voff) do { _Pragma("unroll") for (int _i = 0; _i < 2; ++_i) \
        __builtin_amdgcn_global_load_lds((const unsigned*)((const char*)(gbase) + (voff)[_i]), (LAS unsigned*)(lds + (bufoff) + ldsw + _i * 8192), 16, 0, 0); } while (0)
#define PG8_LD32(base, off0) __builtin_shufflevector(*(const LAS v4i_t*)((base) + (unsigned)(off0)), *(const LAS v4i_t*)((base) + (unsigned)((off0) + KOFF)), 0, 1, 2, 3, 4, 5, 6, 7)
#define PG8_LDA(dst, b, h) do { if constexpr (FP8) { _Pragma("unroll") for (int m = 0; m < 4; ++m) dst##8[m] = PG8_LD32(aB, PG8_SA(b, h) + m * 2048); } else { _Pragma("unroll") for (int m = 0; m < 4; ++m) _Pragma("unroll") for (int k = 0; k < 2; ++k) dst[m][k] = *(const LAS bf16x8*)(aB + (unsigned)(PG8_SA(b, h) + m * 2048 + k * KOFF)); } } while (0)
#define PG8_LDB(dst, b, h) do { if constexpr (FP8) { _Pragma("unroll") for (int n = 0; n < 2; ++n) dst##8[n] = PG8_LD32(bB, PG8_SA(b, h) + n * 2048); } else { _Pragma("unroll") for (int n = 0; n < 2; ++n) _Pragma("unroll") for (int k = 0; k < 2; ++k) dst[n][k] = *(const LAS bf16x8*)(bB + (unsigned)(PG8_SA(b, h) + n * 2048 + k * KOFF)); } } while (0)
#define PG8_MMA(ai, bj, At, Bt) do { __builtin_amdgcn_s_setprio(1); _Pragma("unroll") for (int m = 0; m < 4; ++m) _Pragma("unroll") for (int n = 0; n < 2; ++n) { \
        if constexpr (FP8) asm volatile("v_mfma_scale_f32_16x16x128_f8f6f4 %0, %1, %2, %0, %3, %3 op_sel_hi:[0,0,0]" : "+v"(acc[ai][bj][m][n]) : "v"(Bt##8[n]), "v"(At##8[m]), "v"(sc8)); \
        else { _Pragma("unroll") for (int k = 0; k < 2; ++k) acc[ai][bj][m][n] = __builtin_amdgcn_mfma_f32_16x16x32_bf16(Bt[n][k], At[m][k], acc[ai][bj][m][n], 0, 0, 0); } } __builtin_amdgcn_s_setprio(0); } while (0)
#define PG8_WAIT_V(n) asm volatile("s_waitcnt vmcnt(" #n ")" ::: "memory")
#define PG8_WAIT_L(n) asm volatile("s_waitcnt lgkmcnt(" #n ")" ::: "memory")
#define PG8_BAR __builtin_amdgcn_s_barrier()
#define PG8_SCHED __builtin_amdgcn_sched_barrier(0)
    Unit cur, nxt; int ui = 0;
    if (!S.next(0, cur)) return;
    f32x4 acc[2][2][4][2];
#pragma unroll
    for (int a = 0; a < 2; ++a)
#pragma unroll
        for (int b = 0; b < 2; ++b)
#pragma unroll
            for (int m = 0; m < 4; ++m)
#pragma unroll
                for (int n = 0; n < 2; ++n) acc[a][b][m][n] = (f32x4){0.f, 0.f, 0.f, 0.f};
    typedef int v8i_t __attribute__((ext_vector_type(8)));
    bf16x8 At[4][2], B0[2][2], B1[2][2]; v8i_t At8[4], B08[2], B18[2];
    int sc8 = 0x7f7f7f7f; asm volatile("" : "+v"(sc8));
    const char* cA = cur.a; const char* cB = cur.b;
    unsigned vA0[2], vA1[2], nA0[2], nA1[2];
    if constexpr (GATHER) { const int* rw = S.rows(cur);
#pragma unroll
        for (int i = 0; i < 2; ++i) { vA0[i] = (unsigned)Sched::rowmap(rw[RA[i]]) * ROWB + (unsigned)CA[i] * 2u; vA1[i] = (unsigned)Sched::rowmap(rw[128 + RA[i]]) * ROWB + (unsigned)CA[i] * 2u; nA0[i] = vA0[i]; nA1[i] = vA1[i]; } }
    else {
#pragma unroll
        for (int i = 0; i < 2; ++i) { vA0[i] = voffA[i]; vA1[i] = voffA[i]; nA0[i] = voffA[i]; nA1[i] = voffA[i]; } }
    cur.par = 0; if constexpr (epi_has_pre<Epi>::value) E.pre(cur, wid, lane);
    PG8_STAGE(PG8_SB(0, 0), cB, voffB); PG8_STAGE(PG8_SB(0, 1), cB + hstepB, voffB); PG8_STAGE(PG8_SA(0, 0), cA, vA0); PG8_STAGE(PG8_SA(0, 1), cA + hstepA, vA1);
    if (wr == 1) PG8_BAR;
    PG8_WAIT_V(2); PG8_BAR;
    PG8_STAGE(PG8_SB(1, 0), cB + kstep, voffB); PG8_STAGE(PG8_SA(1, 0), cA + kstepA, vA0); PG8_STAGE(PG8_SB(1, 1), cB + hstepB + kstep, voffB);
    PG8_WAIT_V(6); PG8_BAR;
    for (;;) {
        const bool has_next = S.next(ui + 1, nxt);
        const char* nA = has_next ? nxt.a : cA; const char* nB = has_next ? nxt.b : cB;
        int ri[4] = {0, 0, 0, 0};
        if constexpr (GATHER) { if (has_next) { const int* rw = S.rows(nxt);
#pragma unroll
            for (int i = 0; i < 4; ++i) { const int* pp = rw + (i >> 1) * 128 + RA[i & 1]; asm volatile("global_load_dword %0, %1, off" : "=v"(ri[i]) : "v"(pp) : "memory"); } } }
#pragma nounroll
        for (int t = 0; t < nt; t += 2) {
            const bool last = (t == nt - 2);
            if constexpr (GATHER) { if (last && has_next) { asm volatile("s_waitcnt vmcnt(8) ; ROWIDX" : "+v"(ri[0]), "+v"(ri[1]), "+v"(ri[2]), "+v"(ri[3]) :: "memory");
#pragma unroll
                for (int i = 0; i < 2; ++i) { nA0[i] = (unsigned)Sched::rowmap(ri[i]) * ROWB + (unsigned)CA[i] * 2u; nA1[i] = (unsigned)Sched::rowmap(ri[2 + i]) * ROWB + (unsigned)CA[i] * 2u; } } }
            const char* a1 = cA + (size_t)(t + 1) * kstepA;
            const char* a2 = last ? nA : cA + (size_t)(t + 2) * kstepA; const char* b2 = last ? nB : cB + (size_t)(t + 2) * kstep;
            const char* a3 = a2 + kstepA; const char* b3 = b2 + kstep;
            unsigned w0[2], w1[2];
#pragma unroll
            for (int i = 0; i < 2; ++i) { w0[i] = last ? nA0[i] : vA0[i]; w1[i] = last ? nA1[i] : vA1[i]; }
            PG8_LDB(B0, 0, 0); PG8_LDB(B1, 0, 1); PG8_SCHED; PG8_LDA(At, 0, 0); PG8_STAGE(PG8_SA(1, 1), a1 + hstepA, vA1);
            PG8_WAIT_V(8); PG8_WAIT_L(0); PG8_BAR; PG8_MMA(0, 0, At, B0); PG8_MMA(0, 1, At, B1); PG8_BAR; PG8_SCHED;
            PG8_LDA(At, 0, 1); PG8_STAGE(PG8_SB(0, 0), b2, voffB); PG8_STAGE(PG8_SB(0, 1), b2 + hstepB, voffB); PG8_STAGE(PG8_SA(0, 0), a2, w0);
            PG8_WAIT_V(8); PG8_WAIT_L(0); PG8_BAR; PG8_MMA(1, 0, At, B0); PG8_MMA(1, 1, At, B1); PG8_BAR; PG8_SCHED;
            PG8_LDB(B0, 1, 0); PG8_LDB(B1, 1, 1); PG8_SCHED; PG8_LDA(At, 1, 0); PG8_STAGE(PG8_SA(0, 1), a2 + hstepA, w1);
            PG8_WAIT_V(8); PG8_WAIT_L(0); PG8_BAR; PG8_MMA(0, 0, At, B0); PG8_MMA(0, 1, At, B1); PG8_BAR; PG8_SCHED;
            PG8_LDA(At, 1, 1); PG8_STAGE(PG8_SB(1, 0), b3, voffB); PG8_STAGE(PG8_SB(1, 1), b3 + hstepB, voffB); PG8_STAGE(PG8_SA(1, 0), a3, w0);
            PG8_WAIT_V(8); PG8_WAIT_L(0); PG8_BAR; PG8_MMA(1, 0, At, B0); PG8_MMA(1, 1, At, B1); PG8_BAR; PG8_SCHED;
        }
        if constexpr (epi_has_pre<Epi>::value) { if (has_next) { nxt.par = (ui + 1) & 1; E.pre(nxt, wid, lane); } }
        if (wr == 0) PG8_BAR;
        if constexpr (FP8) asm volatile("s_nop 15\n\ts_nop 15" ::: "memory");
        E(acc, cur, wr, wc, fr, fq);
        if (!has_next) break;
#pragma unroll
        for (int a = 0; a < 2; ++a)
#pragma unroll
            for (int b = 0; b < 2; ++b)
#pragma unroll
                for (int m = 0; m < 4; ++m)
#pragma unroll
                    for (int n = 0; n < 2; ++n) acc[a][b][m][n] = (f32x4){0.f, 0.f, 0.f, 0.f};
        cur = nxt; cA = nA; cB = nB; ++ui;
#pragma unroll
        for (int i = 0; i < 2; ++i) { vA0[i] = nA0[i]; vA1[i] = nA1[i]; }
        if (wr == 1) PG8_BAR;
    }
    PG8_WAIT_V(0);
    PG8_BAR;
#undef PG8_SA
#undef PG8_SB
#undef PG8_STAGE
#undef PG8_LDA
#undef PG8_LDB
#undef PG8_MMA
#undef PG8_LD32
#undef PG8_WAIT_V
#undef PG8_WAIT_L
#undef PG8_BAR
#undef PG8_SCHED
}
}
namespace attn_body {
using bf16=__hip_bfloat16;
using bf16x8=__attribute__((ext_vector_type(8)))short;
using s16x4=__attribute__((ext_vector_type(4)))short;
using f32x16=__attribute__((ext_vector_type(16)))float;
using u32x4=__attribute__((ext_vector_type(4)))unsigned;
constexpr int BATCH=16,NHEAD=16,SEQ=2048,D=64,DM=NHEAD*D;
constexpr int NW=8,QBLK=32,QB=QBLK*NW,KVBLK=64,NQB=SEQ/QB;
constexpr int ATTN_PITCH=DM, ATTN_UNIT_ROWS=QB;
__device__ __forceinline__ int crow(int r,int hi){return (r&3)+8*(r>>2)+4*hi;}
#define SBAR() __builtin_amdgcn_sched_barrier(0)
__device__ __forceinline__ void cmask(f32x16&p0,f32x16&p1,int jb,int qrel,int hi){
  const float NEG=-INFINITY; int kb=64*jb+4*hi;
  #pragma unroll
  for(int r=0;r<16;++r){int kv=kb+(r&3)+8*(r>>2); if(kv>qrel)p0[r]=NEG; if(kv+32>qrel)p1[r]=NEG;}
}

constexpr int NSLOT=3, SLOTB=8192;
constexpr int LDS_K=0, LDS_V=NSLOT*SLOTB, LDS_WS=2*NSLOT*SLOTB, LDS_OST=LDS_WS+NW*64*4, LDS_BYTES=LDS_OST+NW*4096;
constexpr float C2=0.125f*1.4426950408889634f;
__device__ __forceinline__ void glds16(const void*gsrc,unsigned lds_dst){unsigned keep;
  asm volatile("s_mov_b32 %0, m0\n\ts_mov_b32 m0, %2\n\ts_nop 0\n\tglobal_load_lds_dwordx4 %1, off\n\ts_mov_b32 m0, %0":"=&s"(keep):"v"(gsrc),"s"(lds_dst):"memory");}
__device__ __forceinline__ float max3f(float a,float b,float c){float r;asm("v_max3_f32 %0, %1, %2, %3":"=v"(r):"v"(a),"v"(b),"v"(c));return r;}
__device__ __forceinline__ float max2f(float a,float b){float r;asm("v_max_f32_e32 %0, %1, %2":"=v"(r):"v"(a),"v"(b));return r;}
__device__ __forceinline__ float fadd_s(float a,float b){float r;asm("v_add_f32_e32 %0, %1, %2":"=v"(r):"v"(a),"v"(b));return r;}
__device__ __forceinline__ float fsub_s(float a,float b){float r;asm("v_sub_f32_e32 %0, %1, %2":"=v"(r):"v"(a),"v"(b));return r;}
typedef float f32x2_t __attribute__((ext_vector_type(2))); typedef __bf16 bf16x2_t __attribute__((ext_vector_type(2)));
__device__ __forceinline__ unsigned cvtpk_s(float lo,float hi){f32x2_t v={lo,hi};bf16x2_t b=__builtin_convertvector(v,bf16x2_t);return __builtin_bit_cast(unsigned,b);}
#define WAIT_BAR(N) asm volatile("s_waitcnt vmcnt(" #N ") lgkmcnt(0)\n\ts_barrier":::"memory")

__device__ __forceinline__ void qkt(f32x16&p0,f32x16&p1,const char*Kslot,const bf16x8*qr,const f32x16&negm,int r32,int hi){
  const char*kb=Kslot+hi*1024+r32*16;
  #pragma unroll
  for(int d0=0;d0<4;++d0){
    const bf16x8 b0=*reinterpret_cast<const bf16x8*>(kb+d0*2048);
    const bf16x8 b1=*reinterpret_cast<const bf16x8*>(kb+d0*2048+512);
    if(d0==0){p0=__builtin_amdgcn_mfma_f32_32x32x16_bf16(b0,qr[0],negm,0,0,0);p1=__builtin_amdgcn_mfma_f32_32x32x16_bf16(b1,qr[0],negm,0,0,0);}
    else{p0=__builtin_amdgcn_mfma_f32_32x32x16_bf16(b0,qr[d0],p0,0,0,0);p1=__builtin_amdgcn_mfma_f32_32x32x16_bf16(b1,qr[d0],p1,0,0,0);}}
}
typedef __attribute__((address_space(3))) const char* lds_cptr;
typedef short v4i16_t __attribute__((ext_vector_type(4)));
__device__ __forceinline__ void kload8(bf16x8*kf,lds_cptr kp){
  kf[0]=*(const __attribute__((address_space(3))) bf16x8*)(kp);      kf[1]=*(const __attribute__((address_space(3))) bf16x8*)(kp+512);
  kf[2]=*(const __attribute__((address_space(3))) bf16x8*)(kp+2048); kf[3]=*(const __attribute__((address_space(3))) bf16x8*)(kp+2560);
  kf[4]=*(const __attribute__((address_space(3))) bf16x8*)(kp+4096); kf[5]=*(const __attribute__((address_space(3))) bf16x8*)(kp+4608);
  kf[6]=*(const __attribute__((address_space(3))) bf16x8*)(kp+6144); kf[7]=*(const __attribute__((address_space(3))) bf16x8*)(kp+6656);
}
__device__ __forceinline__ void kload2(bf16x8*kf,lds_cptr kp,int j){ kf[2*j]=*(const __attribute__((address_space(3))) bf16x8*)(kp+j*2048); kf[2*j+1]=*(const __attribute__((address_space(3))) bf16x8*)(kp+j*2048+512); }
__device__ __forceinline__ s16x4 vtr(lds_cptr p){ return __builtin_bit_cast(s16x4,__builtin_amdgcn_ds_read_tr16_b64_v4i16((__attribute__((address_space(3))) v4i16_t*)p)); }
__device__ __forceinline__ float rowmax(const f32x16&p0,const f32x16&p1){
  float a=max3f(p0[0],p0[1],p1[0]),b=max3f(p0[2],p0[3],p1[1]);a=max3f(a,p1[2],p1[3]);
  #pragma unroll
  for(int r=4;r<16;r+=4){a=max3f(a,p0[r],p0[r+1]);b=max3f(b,p0[r+2],p0[r+3]);a=max3f(a,p1[r],p1[r+1]);b=max3f(b,p1[r+2],p1[r+3]);}
  const float m=max2f(a,b);
  auto rr=__builtin_amdgcn_permlane32_swap(__float_as_uint(m),__float_as_uint(m),false,false);
  return max2f(__uint_as_float(rr[0]),__uint_as_float(rr[1]));
}
__device__ __forceinline__ void pv(f32x16*o,int vb,bf16x8 pa0,bf16x8 pa1,bf16x8 pa2,bf16x8 pa3){
  #pragma unroll
  for(int d0=0;d0<2;++d0){s16x4 lo[4],hi[4];
    #pragma unroll
    for(int ks=0;ks<4;++ks){
      asm volatile("ds_read_b64_tr_b16 %0,%1 offset:%c2":"=&v"(lo[ks]):"v"(vb),"i"(d0*4096+ks*1024):"memory");
      asm volatile("ds_read_b64_tr_b16 %0,%1 offset:%c2":"=&v"(hi[ks]):"v"(vb),"i"(d0*4096+ks*1024+512):"memory");}
    asm volatile("s_waitcnt lgkmcnt(0)":::"memory");SBAR();
    #define PK(k) (bf16x8){lo[k][0],lo[k][1],lo[k][2],lo[k][3],hi[k][0],hi[k][1],hi[k][2],hi[k][3]}
    o[d0]=__builtin_amdgcn_mfma_f32_32x32x16_bf16(pa0,PK(0),o[d0],0,0,0);
    o[d0]=__builtin_amdgcn_mfma_f32_32x32x16_bf16(pa1,PK(1),o[d0],0,0,0);
    o[d0]=__builtin_amdgcn_mfma_f32_32x32x16_bf16(pa2,PK(2),o[d0],0,0,0);
    o[d0]=__builtin_amdgcn_mfma_f32_32x32x16_bf16(pa3,PK(3),o[d0],0,0,0);
    #undef PK
  }
}

#ifndef ATTN_STORE16
#define ATTN_STORE16(p,v) (*(u32x4*)(p)=(v))
#endif
template<int THRL> __device__ __forceinline__ void attn_unit(int b,int h,int qb,const bf16*Q,const bf16*__restrict__ K,const bf16*__restrict__ V,bf16*O,char*shm){
  const int tid=threadIdx.x,lane=tid&63,r32=lane&31,hi=lane>>5; const int wid=__builtin_amdgcn_readfirstlane(tid>>6);
  const long rowbase=(long)b*SEQ; const int q0=qb*QB;
  const bf16*Qw=Q+(rowbase+q0+wid*QBLK)*DM+h*D;
  const bf16*Kh=K+rowbase*DM+h*D,*Vh=V+rowbase*DM+h*D;
  const unsigned lds0=(unsigned)(uintptr_t)shm;
  float*wsf=(float*)(shm+LDS_WS)+wid*64;
  const bf16*ksrc=Kh+(long)lane*DM+wid*8;
  const bf16*vsrc=Vh+(long)(16*(wid&3)+(lane>>2))*DM+(wid>>2)*32+(lane&3)*8;
  const unsigned kdst=lds0+LDS_K+wid*1024, vdst=lds0+LDS_V+wid*1024;
  #define DMA_K(t,slot) glds16(ksrc+(long)(t)*KVBLK*DM,(unsigned)__builtin_amdgcn_readfirstlane(kdst+(slot)))
  #define DMA_V(t,slot) glds16(vsrc+(long)(t)*KVBLK*DM,(unsigned)__builtin_amdgcn_readfirstlane(vdst+(slot)))
  const int vb0=(int)(lds0+LDS_V)+((lane>>4)&1)*32+(lane&3)*8+(4*hi+((lane&15)>>2))*64;
  const char*Kbase=shm+LDS_K; bf16x8 kf[8];
  const lds_cptr shm3=(lds_cptr)shm; const lds_cptr kp0=shm3+LDS_K+hi*1024+r32*16; const lds_cptr vp0=shm3+LDS_V+((lane>>4)&1)*32+(lane&3)*8+(4*hi+((lane&15)>>2))*64;
  const int NT=(q0+QB)/KVBLK;
  DMA_K(0,0);DMA_V(0,0);DMA_K(1,SLOTB);
  bf16x8 qr[4];
  #pragma unroll
  for(int d0=0;d0<4;++d0)qr[d0]=*reinterpret_cast<const bf16x8*>(&Qw[(long)r32*DM+d0*16+hi*8]);
  float mhat=0.f,l_reg=0.f;f32x16 o[2];o[0]=f32x16{};o[1]=f32x16{};f32x16 negm=f32x16{};asm volatile("":"+v"(negm));
  const int qrel=wid*QBLK+r32;
  #define CMASK(P0,P1,t) do{int jb_=(t)-(NT-4); if(jb_>=0)cmask(P0,P1,jb_,qrel,hi);}while(0)
  bool resc=false;
  #define START(P0,P1) do{ const float rm=rowmax(P0,P1); resc=false; \
    { const float dl=rm; mhat=fadd_s(mhat,dl); \
      _Pragma("unroll") for(int r=0;r<16;++r){P0[r]=fsub_s(P0[r],dl);P1[r]=fsub_s(P1[r],dl);} \
      _Pragma("unroll") for(int r=0;r<16;++r)negm[r]=-mhat; asm volatile("":"+v"(negm)); } \
    _Pragma("unroll") for(int r=0;r<16;++r)P0[r]=__builtin_amdgcn_exp2f(P0[r]); }while(0)
  #define RESC() do{ if(resc){ asm volatile("s_waitcnt lgkmcnt(0)":::"memory"); \
      _Pragma("unroll") for(int d_=0;d_<2;++d_) _Pragma("unroll") for(int r=0;r<16;++r)o[d_][r]*=wsf[crow(r,hi)]; } }while(0)
  f32x16 pA0,pA1,pB0,pB1;
  int sl_prev=0,sl_cur=0,sl_next=SLOTB;
  #define ROT() do{sl_prev=sl_cur;sl_cur=sl_next;sl_next=(sl_next==(NSLOT-1)*SLOTB)?0:sl_next+SLOTB;}while(0)
  DMA_K(2,2*SLOTB);
  WAIT_BAR(3);
  qkt(pA0,pA1,Kbase,qr,negm,r32,hi);asm volatile("s_nop 15\n\ts_nop 7":"+v"(pA0),"+v"(pA1));CMASK(pA0,pA1,0);
  START(pA0,pA1);
  _Pragma("unroll") for(int r=0;r<16;++r)pA1[r]=__builtin_amdgcn_exp2f(pA1[r]);
  WAIT_BAR(0);
  DMA_K(3,0);DMA_V(1,SLOTB);
  ROT();
  kload8(kf,kp0+sl_cur);
  WAIT_BAR(2);
  s16x4 vlo[8],vhi[8]; u32x4 pw0,pw1,pw2,pw3;
  #define PKW(P,B) cvtpk_s(P[B],P[B+1])
  #define PAF(k) __builtin_bit_cast(bf16x8,pw##k)
  #define VFR(i) (bf16x8){vlo[i][0],vlo[i][1],vlo[i][2],vlo[i][3],vhi[i][0],vhi[i][1],vhi[i][2],vhi[i][3]}
  #define PIN(x) asm volatile("":"+v"(x))
  #define MX3(a,b,c) __builtin_fmaxf(__builtin_fmaxf((a),(b)),(c))
  #define GAPA(MF,A0,A1,A2,A3,W0,W1,PW) do{ MF; sacc+=A0; sacc+=A1; sacc+=A2; sacc+=A3; PIN(sacc); W0; W1; PIN(PW); SBAR(); }while(0)
  #define EX(v) __builtin_amdgcn_exp2f(v)
  #define GAPB(MF,X,B) do{ MF; X[B]=EX(X[B]); X[B+1]=EX(X[B+1]); X[B+2]=EX(X[B+2]); X[B+3]=EX(X[B+3]); PIN(X); SBAR(); }while(0)
  #define VRD(i) do{ vlo[i]=vtr(vp_+(((i)>>2)*4096+((i)&3)*1024)); vhi[i]=vtr(vp_+(((i)>>2)*4096+((i)&3)*1024+512)); }while(0)
  #define KRD(G,j) do{ if(G){ kload2(kf,kp0+sl_next,j); SBAR(); } }while(0)
  #define STEP(C0,C1,P0,P1,t,GK,GV,GL) do{ SBAR(); \
    const lds_cptr vp_=vp0+sl_prev; \
    VRD(0); SBAR(); float sacc=(P0[0]+P0[1]); \
    GAPA(C0=__builtin_amdgcn_mfma_f32_32x32x16_bf16(kf[0],qr[0],negm,0,0,0), P0[2],P0[3],P0[4],P0[5],     pw0[0]=PKW(P0,0), pw0[1]=PKW(P0,2), pw0); \
    VRD(4); SBAR(); GAPA(C1=__builtin_amdgcn_mfma_f32_32x32x16_bf16(kf[1],qr[0],negm,0,0,0), P0[6],P0[7],P0[8],P0[9],     pw0[2]=PKW(P0,4), pw0[3]=PKW(P0,6), pw0); \
    VRD(1); SBAR(); GAPA(C0=__builtin_amdgcn_mfma_f32_32x32x16_bf16(kf[2],qr[1],C0,0,0,0),   P0[10],P0[11],P0[12],P0[13], pw1[0]=PKW(P0,8), pw1[1]=PKW(P0,10), pw1); \
    VRD(5); SBAR(); GAPA(C1=__builtin_amdgcn_mfma_f32_32x32x16_bf16(kf[3],qr[1],C1,0,0,0),   P0[14],P0[15],P1[0],P1[1],   pw1[2]=PKW(P0,12),pw1[3]=PKW(P0,14), pw1); \
    VRD(2); SBAR(); GAPA(C0=__builtin_amdgcn_mfma_f32_32x32x16_bf16(kf[4],qr[2],C0,0,0,0),   P1[2],P1[3],P1[4],P1[5],     pw2[0]=PKW(P1,0), pw2[1]=PKW(P1,2), pw2); \
    VRD(6); SBAR(); GAPA(C1=__builtin_amdgcn_mfma_f32_32x32x16_bf16(kf[5],qr[2],C1,0,0,0),   P1[6],P1[7],P1[8],P1[9],     pw2[2]=PKW(P1,4), pw2[3]=PKW(P1,6), pw2); \
    VRD(3); SBAR(); GAPA(C0=__builtin_amdgcn_mfma_f32_32x32x16_bf16(kf[6],qr[3],C0,0,0,0),   P1[10],P1[11],P1[12],P1[13], pw3[0]=PKW(P1,8), pw3[1]=PKW(P1,10), pw3); \
    VRD(7); SBAR(); GAPA(C1=__builtin_amdgcn_mfma_f32_32x32x16_bf16(kf[7],qr[3],C1,0,0,0),   P1[14],P1[15],0.f,0.f,       pw3[2]=PKW(P1,12),pw3[3]=PKW(P1,14), pw3); \
    l_reg+=sacc; \
    if(GK){DMA_K((t)+3,sl_cur);} if(GV){DMA_V((t)+1,sl_next);} \
    CMASK(C0,C1,t); \
    { float a=MX3(C0[0],C0[1],C1[0]),b=MX3(C0[2],C0[3],C1[1]); a=MX3(a,C1[2],C1[3]); \
      _Pragma("unroll") for(int r=4;r<16;r+=4){a=MX3(a,C0[r],C0[r+1]);b=MX3(b,C0[r+2],C0[r+3]);a=MX3(a,C1[r],C1[r+1]);b=MX3(b,C1[r+2],C1[r+3]);} \
      float rm=__builtin_fmaxf(a,b); { auto rr=__builtin_amdgcn_permlane32_swap(__float_as_uint(rm),__float_as_uint(rm),false,false); rm=__builtin_fmaxf(__uint_as_float(rr[0]),__uint_as_float(rr[1])); } \
      resc=false; \
      if(__builtin_expect(__any(rm>(float)THRL),0)){ const float dl=__builtin_fmaxf(rm,0.f); mhat+=dl; \
        _Pragma("unroll") for(int r=0;r<16;++r){C0[r]-=dl;C1[r]-=dl;} \
        _Pragma("unroll") for(int r=0;r<16;++r)negm[r]=-mhat; asm volatile("":"+v"(negm)); \
        const float f=__builtin_amdgcn_exp2f(-dl); l_reg*=f; if(hi==0)wsf[r32]=f; resc=true; } } \
    SBAR(); \
    GAPB(o[0]=__builtin_amdgcn_mfma_f32_32x32x16_bf16(PAF(0),VFR(0),o[0],0,0,0), C0,0); \
    GAPB(o[1]=__builtin_amdgcn_mfma_f32_32x32x16_bf16(PAF(0),VFR(4),o[1],0,0,0), C0,4); \
    KRD(GL,0); GAPB(o[0]=__builtin_amdgcn_mfma_f32_32x32x16_bf16(PAF(1),VFR(1),o[0],0,0,0), C0,8); \
    KRD(GL,1); GAPB(o[1]=__builtin_amdgcn_mfma_f32_32x32x16_bf16(PAF(1),VFR(5),o[1],0,0,0), C0,12); \
    KRD(GL,2); GAPB(o[0]=__builtin_amdgcn_mfma_f32_32x32x16_bf16(PAF(2),VFR(2),o[0],0,0,0), C1,0); \
    KRD(GL,3); GAPB(o[1]=__builtin_amdgcn_mfma_f32_32x32x16_bf16(PAF(2),VFR(6),o[1],0,0,0), C1,4); \
    GAPB(o[0]=__builtin_amdgcn_mfma_f32_32x32x16_bf16(PAF(3),VFR(3),o[0],0,0,0), C1,8); \
    GAPB(o[1]=__builtin_amdgcn_mfma_f32_32x32x16_bf16(PAF(3),VFR(7),o[1],0,0,0), C1,12); \
    }while(0)
  int t=1;
  #undef CMASK
  #define CMASK(P0,P1,t) do{}while(0)
  for(;t+5<NT;t+=2){
    STEP(pB0,pB1,pA0,pA1,t,true,true,true);     WAIT_BAR(2); RESC(); ROT();
    STEP(pA0,pA1,pB0,pB1,t+1,true,true,true);   WAIT_BAR(2); RESC(); ROT();
  }
  #undef CMASK
  #define CMASK(P0,P1,t) do{int jb_=(t)-(NT-4); if(jb_>=0)cmask(P0,P1,jb_,qrel,hi);}while(0)
  #define ENDW(tt) do{ if((tt)+3<NT){WAIT_BAR(2);} else if((tt)+2<NT){WAIT_BAR(1);} else {WAIT_BAR(0);} }while(0)
  for(;t+1<NT;t+=2){
    STEP(pB0,pB1,pA0,pA1,t,(t+3<NT),(t+1<NT),(t+1<NT));       ENDW(t);   RESC(); ROT();
    STEP(pA0,pA1,pB0,pB1,t+1,(t+4<NT),(t+2<NT),(t+2<NT));     ENDW(t+1); RESC(); ROT();
  }
  STEP(pB0,pB1,pA0,pA1,NT-1,false,false,false); RESC();
  { float sacc=pB0[0]+pB0[1]; _Pragma("unroll") for(int r=2;r<16;++r)sacc+=pB0[r]; _Pragma("unroll") for(int r=0;r<16;++r)sacc+=pB1[r]; l_reg+=sacc;
    pw0=(u32x4){PKW(pB0,0),PKW(pB0,2),PKW(pB0,4),PKW(pB0,6)};pw1=(u32x4){PKW(pB0,8),PKW(pB0,10),PKW(pB0,12),PKW(pB0,14)};pw2=(u32x4){PKW(pB1,0),PKW(pB1,2),PKW(pB1,4),PKW(pB1,6)};pw3=(u32x4){PKW(pB1,8),PKW(pB1,10),PKW(pB1,12),PKW(pB1,14)};
    SBAR(); pv(o,vb0+sl_cur,PAF(0),PAF(1),PAF(2),PAF(3)); }
  #undef PKW
  #undef PAF
  #undef VFR
  #undef PIN
  #undef MX3
  #undef GAPA
  #undef GAPB
  #undef EX
  #undef VRD
  #undef KRD
  #undef STEP
  #undef ENDW
  {auto rr=__builtin_amdgcn_permlane32_swap(__float_as_uint(l_reg),__float_as_uint(l_reg),false,false);l_reg=__uint_as_float(rr[0])+__uint_as_float(rr[1]);}
  if(hi==0)wsf[32+r32]=l_reg;asm volatile("s_waitcnt lgkmcnt(0)":::"memory");
  float rli[16];
  #pragma unroll
  for(int r=0;r<16;++r)rli[r]=__builtin_amdgcn_rcpf(wsf[32+crow(r,hi)]);
  bf16*Ow=O+(rowbase+q0+wid*QBLK)*DM+h*D;
  { bf16*stg=(bf16*)(shm+LDS_OST)+wid*2048;
    #pragma unroll
    for(int r=0;r<16;++r){const int orow=crow(r,hi);
      #pragma unroll
      for(int d0=0;d0<2;++d0)stg[orow*64+d0*32+r32]=__float2bfloat16(o[d0][r]*rli[r]);}
    asm volatile("s_waitcnt lgkmcnt(0)":::"memory");
    #pragma unroll
    for(int i=0;i<4;++i){const int row=i*8+(lane>>3),ch=lane&7; const u32x4 v=*(const u32x4*)(stg+row*64+ch*8); ATTN_STORE16(Ow+(long)row*DM+ch*8,v);} }
  asm volatile("s_waitcnt lgkmcnt(0)\n\ts_barrier":::"memory");
  #undef DMA_K
  #undef DMA_V
  #undef CMASK
  #undef START
  #undef RESC
  #undef ROT
}
constexpr int ATTN_LDS_BYTES=LDS_BYTES;
struct AttnTensors { const bf16* Q; const bf16* K; const bf16* V; bf16* O; };
struct AttnUnit { int bh; int qb; };
struct StaticOrder {
  int vcu;
  __device__ __forceinline__ explicit StaticOrder(int grid,int block):vcu((block%8)*(grid/8)+block/8){}
  __device__ __forceinline__ bool next(int i,AttnUnit&u)const{ if(i>=8)return false; const int pr=vcu&3; u.bh=(vcu>>2)*4+(i&3); u.qb=(i==0)?pr:(i==1)?pr:(i==2)?pr:(i==3)?pr:(i==4)?7-pr:(i==5)?7-pr:(i==6)?7-pr:7-pr; return true; }
  __device__ __forceinline__ void a_ready(const AttnUnit&)const{}
  __device__ __forceinline__ void done(const AttnUnit&)const{}
};
template<class Sched,int THRL=8> __device__ __forceinline__ void attn_phase(char*lds,const AttnTensors&T,const Sched&S){
  AttnUnit u;
  for(int i=0;S.next(i,u);++i){ S.a_ready(u); const int vhd=u.bh%NHEAD, hq=vhd>>1, hv=(vhd>>2)*2+(vhd&1);
    attn_unit<THRL>(u.bh/NHEAD,hq,u.qb,T.Q,T.K,T.V+(hv-hq)*D,T.O+(vhd-hq)*D,lds); S.done(u); }
}
#undef SBAR
#undef WAIT_BAR
}
#define XB_TMO      128
#define XB_XCNT(j)  (256  + 64 * (j))
#define XB_XSUB(j)  (1280 + 64 * (j))
#define XB_XGEN(j)  (2304 + 64 * (j))
#define XB_TOP      3328
#define XB_TOPGEN   3392
#define XCD_BAR_WORDS 3456
#define XB_SPIN_CAP (1u << 18)

__device__ __forceinline__ unsigned xb_ld(unsigned* p)              { return __hip_atomic_load(p, __ATOMIC_RELAXED, __HIP_MEMORY_SCOPE_AGENT); }
__device__ __forceinline__ unsigned xb_add(unsigned* p, unsigned v) { return __hip_atomic_fetch_add(p, v, __ATOMIC_RELAXED, __HIP_MEMORY_SCOPE_AGENT); }
__device__ __forceinline__ unsigned xb_xcc_id() { return (unsigned)__builtin_amdgcn_s_getreg((3 << 11) | 20) & 0xFu; }
#define XB_SPIN(cond, bar) do { unsigned _sp = 0; while (cond) { __builtin_amdgcn_s_sleep(1); \
    if ((++_sp & 255u) == 0u) { if (xb_ld(&(bar)[XB_TMO])) break; if (_sp > XB_SPIN_CAP) { atomicAdd(&(bar)[XB_TMO], 1u); break; } } } } while (0)

struct XcdBarrier {
    unsigned* bar; unsigned x;
    volatile LAS unsigned* st;
};

__device__ __forceinline__ XcdBarrier xcd_barrier_post(unsigned* bar, volatile LAS unsigned* st) {
    XcdBarrier b; b.bar = bar; b.x = xb_xcc_id(); b.st = st;
    if (threadIdx.x == 0) (void)xb_add(&bar[XB_XCNT(b.x)], 1u);
    return b;
}
__device__ __forceinline__ void xcd_barrier_complete(unsigned* bar, unsigned x, unsigned& nloc, unsigned& nx) {
    const unsigned G = gridDim.x * gridDim.y * gridDim.z;
    unsigned sum, cnt, mine, sp = 0u;
    for (;;) {
        sum = 0u; cnt = 0u; mine = 0u;
#pragma unroll
        for (unsigned j = 0; j < 16; ++j) { const unsigned c = xb_ld(&bar[XB_XCNT(j)]); sum += c; cnt += (c > 0u) ? 1u : 0u; mine = (j == x) ? c : mine; }
        if (sum == G) break;
        __builtin_amdgcn_s_sleep(1);
        if ((++sp & 255u) == 0u) { if (xb_ld(&bar[XB_TMO])) break; if (sp > XB_SPIN_CAP) { atomicAdd(&bar[XB_TMO], 1u); break; } }
    }
    nloc = mine > 0u ? mine : 1u; nx = cnt > 0u ? cnt : 1u;
}

__device__ __forceinline__ void xcd_barrier(const XcdBarrier& b) {
    asm volatile("s_waitcnt vmcnt(0)" ::: "memory");
    __syncthreads();
    if (threadIdx.x == 0) {
        unsigned* bar = b.bar;
        __builtin_amdgcn_s_waitcnt(0);
        unsigned nloc = b.st[0], nx = b.st[1];
        if (nloc == 0u) { xcd_barrier_complete(bar, b.x, nloc, nx); b.st[0] = nloc; b.st[1] = nx; }
        const unsigned old = xb_add(&bar[XB_XSUB(b.x)], 1u);
        const unsigned gen = old / nloc;
        if (old + 1u == (gen + 1u) * nloc) {
            __builtin_amdgcn_fence(__ATOMIC_RELEASE, "agent");
            asm volatile("s_waitcnt vmcnt(0)" ::: "memory");
            const unsigned og = xb_add(&bar[XB_TOP], 1u);
            const unsigned tg = og / nx;
            if (og + 1u == (tg + 1u) * nx) xb_add(&bar[XB_TOPGEN], 1u);
            else XB_SPIN(xb_ld(&bar[XB_TOPGEN]) == tg, bar);
            __builtin_amdgcn_fence(__ATOMIC_ACQUIRE, "agent");
            xb_add(&bar[XB_XGEN(b.x)], 1u);
            asm volatile("s_waitcnt vmcnt(0)" ::: "memory");
        } else {
            XB_SPIN(xb_ld(&bar[XB_XGEN(b.x)]) == gen, bar);
            __builtin_amdgcn_fence(__ATOMIC_ACQUIRE, "agent");
            asm volatile("s_waitcnt vmcnt(0)" ::: "memory");
        }
    }
    __syncthreads();
}

constexpr int NWAVES = 8;
struct Frame { LAS unsigned char* lds; volatile LAS unsigned* MISC; gu32* ctl; int wave, vcu, G; };
__device__ __forceinline__ int opaque_tid() { int t = (int)threadIdx.x; asm volatile("" : "+v"(t)); return t; }
#define FTID ((int)threadIdx.x)
#define FLANE ((int)(threadIdx.x & 63u))
struct Args { const float* in[53]; float* out; unsigned char* ws; int ph_lo, ph_hi, variant, pad; };
#define EPI_ARGS const f32x4 (&acc)[2][2][4][2], const pg8::Unit& u, int wr, int wc, int fr, int fq

__device__ __forceinline__ int maprow(int mode, int n) {
    if (mode == 0) return n;
    if (mode == 1) return (n >> 7) * 256 + (n & 127);
    if (mode == 2) return (n >> 7) * 256 + 128 + (n & 127);
    const int j = n & 1023; return (j >> 7) * 256 + ((n >> 10) << 7) + (j & 127);
}
__device__ __forceinline__ void tr_item(const float* W, int N, bf16* WT, int mode, LAS float* scr, int item, int lane) {
    const int nblk = N >> 5, kb = item / nblk, nb = item - kb * nblk, k0 = 64 * kb, n0 = 32 * nb;
#pragma unroll 8
    for (int i = 0; i < 32; ++i) { const int kk = 2 * i + (lane >> 5); scr[kk * 33 + (lane & 31)] = W[(size_t)(k0 + kk) * N + n0 + (lane & 31)]; }
    LDS_WAIT(); asm volatile("" ::: "memory");
    const int c = lane & 7; const int r0 = maprow(mode, n0);
#pragma unroll
    for (int j = 0; j < 4; ++j) { const int n = (lane >> 3) + 8 * j; const LAS float* s = scr + (8 * c) * 33 + n;
        v4u o; o.x = pk2(s[0 * 33], s[1 * 33]); o.y = pk2(s[2 * 33], s[3 * 33]); o.z = pk2(s[4 * 33], s[5 * 33]); o.w = pk2(s[6 * 33], s[7 * 33]);
        *(GAS v4u*)(WT + (size_t)(r0 + n) * 1024 + k0 + 8 * c) = o; }
    LDS_WAIT(); asm volatile("" ::: "memory");
}
__device__ __forceinline__ unsigned pk4_fp8(float a, float b, float c, float d) {
    a = __builtin_amdgcn_fmed3f(a, -448.f, 448.f); b = __builtin_amdgcn_fmed3f(b, -448.f, 448.f); c = __builtin_amdgcn_fmed3f(c, -448.f, 448.f); d = __builtin_amdgcn_fmed3f(d, -448.f, 448.f);
    int r = __builtin_amdgcn_cvt_pk_fp8_f32(a, b, 0, false); r = __builtin_amdgcn_cvt_pk_fp8_f32(c, d, r, true); return (unsigned)r; }
__device__ __forceinline__ void tr_item8(const float* W, int N, unsigned char* WT, int mode, float scale, LAS float* scr, int item, int lane) {
    const int nblk = N >> 5, kb = item / nblk, nb = item - kb * nblk, k0 = 128 * kb, n0 = 32 * nb;
#pragma unroll 8
    for (int i = 0; i < 64; ++i) { const int kk = 2 * i + (lane >> 5); scr[kk * 33 + (lane & 31)] = W[(size_t)(k0 + kk) * N + n0 + (lane & 31)] * scale; }
    LDS_WAIT(); asm volatile("" ::: "memory");
    const int c = lane & 7; const int r0 = maprow(mode, n0);
#pragma unroll
    for (int j = 0; j < 4; ++j) { const int n = (lane >> 3) + 8 * j; const LAS float* p = scr + (16 * c) * 33 + n;
        v4u o; o.x = pk4_fp8(p[0 * 33], p[1 * 33], p[2 * 33], p[3 * 33]); o.y = pk4_fp8(p[4 * 33], p[5 * 33], p[6 * 33], p[7 * 33]);
        o.z = pk4_fp8(p[8 * 33], p[9 * 33], p[10 * 33], p[11 * 33]); o.w = pk4_fp8(p[12 * 33], p[13 * 33], p[14 * 33], p[15 * 33]);
        *(GAS v4u*)(WT + (size_t)(r0 + n) * 1024 + k0 + 16 * c) = o; }
    LDS_WAIT(); asm volatile("" ::: "memory");
}
__device__ __forceinline__ void cvt_plain(const float* src, bf16* dst, size_t n, size_t gtid, size_t nth) {
    for (size_t i = gtid * 8; i < n; i += nth * 8) { const f32x4 a = *(const GAS f32x4*)(src + i), b = *(const GAS f32x4*)(src + i + 4);
        v4u o; o.x = pk2(a.x, a.y); o.y = pk2(a.z, a.w); o.z = pk2(b.x, b.y); o.w = pk2(b.z, b.w); *(GAS v4u*)(dst + i) = o; }
}
__device__ __forceinline__ void cvt_experts(Frame& F, const float* wup, const float* wdn, unsigned char* ws) {
    const int gw = F.vcu * NWAVES + F.wave, NGW = F.G * NWAVES;
#if MOE_FP8
    LAS float* tl = (LAS float*)F.lds;
    for (int it = F.vcu; it < NEXP * 96; it += F.G) { const int e = it / 96, r = it - e * 96; const bool up = r < 64; const int rr = up ? r : r - 64;
        const int N = up ? 2048 : 1024, nb = up ? (rr & 7) : (rr & 3), kb = up ? (rr >> 3) : (rr >> 2), k0 = 128 * kb, n0 = 256 * nb;
        const float* W = up ? wup + (size_t)e * 1024 * 2048 : wdn + (size_t)e * 1024 * 1024; unsigned char* WT = up ? ws + WS_WUP8 + (size_t)e * 2048 * 1024 : ws + WS_WDN8 + (size_t)e * 1024 * 1024;
        const float scale = up ? SWU8 : SWD8; const int mode = up ? 3 : 0;
        __syncthreads();
        f32x4 v[16];
#pragma unroll
        for (int i = 0; i < 16; ++i) { const int idx = i * 512 + FTID, row = idx >> 6, c4 = idx & 63; v[i] = *(const GAS f32x4*)(W + (size_t)(k0 + row) * N + n0 + 4 * c4); }
#pragma unroll
        for (int i = 0; i < 16; ++i) { const int idx = i * 512 + FTID, row = idx >> 6, c4 = idx & 63; *(LAS f32x4*)(tl + row * 260 + 4 * (c4 ^ (row >> 4))) = v[i] * scale; }
        __syncthreads();
#pragma unroll
        for (int j = 0; j < 4; ++j) { const int idx = j * 512 + FTID, n = idx >> 3, c = idx & 7; const LAS float* p = tl + (16 * c) * 260 + (n ^ (4 * c));
            v4u o; o.x = pk4_fp8(p[0 * 260], p[1 * 260], p[2 * 260], p[3 * 260]); o.y = pk4_fp8(p[4 * 260], p[5 * 260], p[6 * 260], p[7 * 260]);
            o.z = pk4_fp8(p[8 * 260], p[9 * 260], p[10 * 260], p[11 * 260]); o.w = pk4_fp8(p[12 * 260], p[13 * 260], p[14 * 260], p[15 * 260]);
            *(GAS v4u*)(WT + (size_t)maprow(mode, n0 + n) * 1024 + k0 + 16 * c) = o; }
    }
    __syncthreads();
    return;
#endif
    LAS float* scr = (LAS float*)(F.lds + F.wave * 16384);
    for (int it = gw; it < NEXP * 1536; it += NGW) { const int e = it / 1536, r = it - e * 1536;
        if (r < 1024) tr_item(wup + (size_t)e * 1024 * 2048, 2048, (bf16*)(ws + WS_WUP) + (size_t)e * 2048 * 1024, 3, scr, r, FLANE);
        else tr_item(wdn + (size_t)e * 1024 * 1024, 1024, (bf16*)(ws + WS_WDN) + (size_t)e * 1024 * 1024, 0, scr, r - 1024, FLANE); }
}
__device__ __forceinline__ void p0_prologue(Frame& F, const Args& a) {
    unsigned char* ws = a.ws;
    LAS float* scr = (LAS float*)(F.lds + F.wave * 16896);
    const int gw = F.vcu * NWAVES + F.wave, NGW = F.G * NWAVES;
    constexpr int I0 = 16 * 64, I1 = I0 + 16 * 80, I2 = I1 + 512, I3 = I2 + 512, I4 = I3 + 512, I5 = I4 + 256, I6 = I5 + 256, I7 = I6 + 256, I8 = I7 + 16, I9 = I8 + 16;
    for (int it = gw; it < I9; it += NGW) {
        if (it < I0) tr_item(a.in[2], 2048, (bf16*)(ws + WS_WKV), 0, scr, it, FLANE);
        else if (it < I1) tr_item(a.in[3], 2560, (bf16*)(ws + WS_WIN0), 0, scr, it - I0, FLANE);
        else if (it < I2) tr_item(a.in[13], 1024, (bf16*)(ws + WS_WOUT0), 0, scr, it - I1, FLANE);
        else if (it < I3) tr_item(a.in[17], 1024, (bf16*)(ws + WS_XOT), 0, scr, it - I2, FLANE);
        else if (it < I4) tr_item(a.in[42], 1024, (bf16*)(ws + WS_XOT) + 1024 * 1024, 0, scr, it - I3, FLANE);
        else if (it < I5) tr_item8(a.in[28], 1024, ws + WS_WIN1, 0, SWU8, scr, it - I4, FLANE);
        else if (it < I6) tr_item8(a.in[37], 1024, ws + WS_WVG, 1, SWD8, scr, it - I5, FLANE);
        else if (it < I7) tr_item8(a.in[38], 1024, ws + WS_WVG, 2, SWU8, scr, it - I6, FLANE);
        else if (it < I8) tr_item(a.in[20], 32, (bf16*)(ws + WS_WR), 0, scr, it - I7, FLANE);
        else tr_item(a.in[45], 32, (bf16*)(ws + WS_WR) + 256 * 1024, 0, scr, it - I8, FLANE);
    }
    cvt_experts(F, a.in[22], a.in[24], ws);
    const size_t gtid = (size_t)F.vcu * 512 + FTID, nth = (size_t)F.G * 512;
    cvt_plain(a.in[16], (bf16*)(ws + WS_XQB), 1024 * 1024, gtid, nth);
    cvt_plain(a.in[41], (bf16*)(ws + WS_XQB) + 1024 * 1024, 1024 * 1024, gtid, nth);
    cvt_plain(a.in[1], (bf16*)(ws + WS_MEMB), (size_t)NB * MEMLEN * DM, gtid, nth);
    cvt_plain(a.in[0], (bf16*)(ws + WS_XB), (size_t)MTOK * DM, gtid, nth);
}

__device__ __forceinline__ void moe_tables(Frame& F, gu32* cnt) {
    LAS int* tab = (LAS int*)(F.lds + TAB_OFF);
    if (FTID < 32) tab[FTID] = (int)__hip_atomic_load(cnt + FTID * 64, RLX_AGENT);
    __syncthreads();
    if (FTID == 0) { int s = 0; for (int e = 0; e < NEXP; ++e) { tab[32 + e] = s; s += (tab[e] + 255) >> 8; } tab[64] = s; }
    __syncthreads();
}

template <int MODE>
__device__ __forceinline__ void ph_ln(Frame& F, const bf16* zb, const bf16* ys, bf16* xb, float* outf, const float* g, const float* b, unsigned char* x8 = nullptr, const int* asg = nullptr, const float* gate = nullptr,
                                      const float* st2 = nullptr, const float* g2 = nullptr, const float* b2 = nullptr) {
    LAS const int* tab = (LAS const int*)(F.lds + TAB_OFF);
    const int gw = F.vcu * NWAVES + F.wave, NGW = F.G * NWAVES, c0 = 8 * FLANE;
    float gv[16], bv[16];
#pragma unroll
    for (int h = 0; h < 2; ++h)
#pragma unroll
        for (int q = 0; q < 2; ++q) { const f32x4 t = *(const GAS f32x4*)(g + c0 + 512 * h + 4 * q), s = *(const GAS f32x4*)(b + c0 + 512 * h + 4 * q);
            gv[8 * h + 4 * q + 0] = t.x; gv[8 * h + 4 * q + 1] = t.y; gv[8 * h + 4 * q + 2] = t.z; gv[8 * h + 4 * q + 3] = t.w;
            bv[8 * h + 4 * q + 0] = s.x; bv[8 * h + 4 * q + 1] = s.y; bv[8 * h + 4 * q + 2] = s.z; bv[8 * h + 4 * q + 3] = s.w; }
    constexpr bool REB = (MODE == 1) && MOE_FP8; float g2v[REB ? 16 : 1], b2v[REB ? 16 : 1];
    if constexpr (REB) {
#pragma unroll
        for (int h = 0; h < 2; ++h)
#pragma unroll
            for (int q = 0; q < 2; ++q) { const f32x4 t = *(const GAS f32x4*)(g2 + c0 + 512 * h + 4 * q), s = *(const GAS f32x4*)(b2 + c0 + 512 * h + 4 * q);
#pragma unroll
                for (int j = 0; j < 4; ++j) { g2v[8 * h + 4 * q + j] = ALPHA * t[j]; b2v[8 * h + 4 * q + j] = ALPHA * s[j]; } } }
    constexpr int RI = (MODE == 0) ? 4 : 2;
    for (int m0 = gw * RI; m0 < MTOK; m0 += NGW * RI) {
        v4u raw[RI][2]; v4u yr[(MODE == 1) ? RI : 1][2][4]; f32x4 gt[(MODE == 1) ? RI : 1]; f32x2 ms[RI];
#pragma unroll
        for (int r = 0; r < RI; ++r) { const size_t m = (size_t)(m0 + r); size_t yrow[4] = {0, 0, 0, 0};
            if constexpr (REB) ms[r] = *(const GAS f32x2*)(st2 + m * 2);
            if (MODE == 1) { const v4i_t as = *(const GAS v4i_t*)(asg + m * 4); gt[r] = *(const GAS f32x4*)(gate + m * 4);
#pragma unroll
                for (int k = 0; k < 4; ++k) yrow[k] = (size_t)(tab[32 + (as[k] >> 16)] * 256 + (as[k] & 0xffff)); }
#pragma unroll
            for (int h = 0; h < 2; ++h) {
                raw[r][h] = *(const GAS v4u*)(((MODE == 0 || REB) ? zb : xb) + m * DM + c0 + 512 * h);
                if (MODE == 1) {
#pragma unroll
                    for (int k = 0; k < 4; ++k) { const v2u t8 = *(const GAS v2u*)((const unsigned char*)ys + yrow[k] * DM + c0 + 512 * h); yr[r][h][k] = (v4u){t8.x, t8.y, 0u, 0u}; } } } }
#pragma unroll
        for (int r = 0; r < RI; ++r) { const size_t m = (size_t)(m0 + r);
            float v[16];
#pragma unroll
            for (int h = 0; h < 2; ++h) { const v4u w = raw[r][h]; const float sc = (MODE == 0) ? 1.0f : ALPHA;
                v[8 * h + 0] = sc * bflo(w.x); v[8 * h + 1] = sc * bfhi(w.x); v[8 * h + 2] = sc * bflo(w.y); v[8 * h + 3] = sc * bfhi(w.y); v[8 * h + 4] = sc * bflo(w.z); v[8 * h + 5] = sc * bfhi(w.z); v[8 * h + 6] = sc * bflo(w.w); v[8 * h + 7] = sc * bfhi(w.w);
                if constexpr (REB) { const float mu2 = ms[r][0] * ALPHA, rs2 = ms[r][1];
#pragma unroll
                    for (int j = 0; j < 8; ++j) v[8 * h + j] = (v[8 * h + j] - mu2) * rs2 * g2v[8 * h + j] * (1.0f / ALPHA) + b2v[8 * h + j]; }
                if (MODE == 1) {
#pragma unroll
                    for (int k = 0; k < 4; ++k) { const v4u y = yr[r][h][k]; const float gk = gt[r][k] * (1.0f / SY8);
                        const f32x2 p0 = __builtin_amdgcn_cvt_pk_f32_fp8((int)y.x, false), p1 = __builtin_amdgcn_cvt_pk_f32_fp8((int)y.x, true), p2 = __builtin_amdgcn_cvt_pk_f32_fp8((int)y.y, false), p3 = __builtin_amdgcn_cvt_pk_f32_fp8((int)y.y, true);
                        v[8 * h + 0] += gk * p0[0]; v[8 * h + 1] += gk * p0[1]; v[8 * h + 2] += gk * p1[0]; v[8 * h + 3] += gk * p1[1]; v[8 * h + 4] += gk * p2[0]; v[8 * h + 5] += gk * p2[1]; v[8 * h + 6] += gk * p3[0]; v[8 * h + 7] += gk * p3[1]; } } }
            float s = 0.f;
#pragma unroll
            for (int j = 0; j < 16; ++j) s += v[j];
            const float mean = wave_sum(s) * (1.f / DM); float s2 = 0.f;
#pragma unroll
            for (int j = 0; j < 16; ++j) { v[j] -= mean; s2 += v[j] * v[j]; }
            const float rstd = 1.f / sqrtf(wave_sum(s2) * (1.f / DM) + LN_EPS);
#pragma unroll
            for (int j = 0; j < 16; ++j) v[j] = v[j] * rstd * gv[j] + bv[j];
#pragma unroll
            for (int h = 0; h < 2; ++h) { v4u o; o.x = pk2(v[8 * h], v[8 * h + 1]); o.y = pk2(v[8 * h + 2], v[8 * h + 3]); o.z = pk2(v[8 * h + 4], v[8 * h + 5]); o.w = pk2(v[8 * h + 6], v[8 * h + 7]);
                if (!outf) *(GAS v4u*)(xb + m * DM + c0 + 512 * h) = o;
                if (x8) { v2u o8; o8.x = pk4_fp8(v[8 * h] * SX8, v[8 * h + 1] * SX8, v[8 * h + 2] * SX8, v[8 * h + 3] * SX8); o8.y = pk4_fp8(v[8 * h + 4] * SX8, v[8 * h + 5] * SX8, v[8 * h + 6] * SX8, v[8 * h + 7] * SX8);
                          *(GAS v2u*)(x8 + m * DM + c0 + 512 * h) = o8; }
                if (outf) { *(GAS f32x4*)(outf + m * DM + c0 + 512 * h) = (f32x4){v[8 * h], v[8 * h + 1], v[8 * h + 2], v[8 * h + 3]};
                            *(GAS f32x4*)(outf + m * DM + c0 + 512 * h + 4) = (f32x4){v[8 * h + 4], v[8 * h + 5], v[8 * h + 6], v[8 * h + 7]}; } }
        }
    }
}
__device__ __forceinline__ void ph_ln2_router(Frame& F, const bf16* zb, bf16* xb, unsigned char* x8, const float* g, const float* b, const bf16* wrT, const float* rbias,
                                              gu32* cnt, int* list, float* gate, int* asg, float* st2) {
    LAS int* cl = (LAS int*)F.lds;
    LAS float* gl = (LAS float*)(F.lds + 256);
    LAS bf16* wl = (LAS bf16*)(F.lds + 256 + 8192);
    const int rw = FLANE & 15, q = FLANE >> 4;
    for (int i = FTID; i < 256; i += 512) { ((LAS f32x4*)gl)[i] = *(const GAS f32x4*)(g + 4 * i); ((LAS f32x4*)gl)[256 + i] = *(const GAS f32x4*)(b + 4 * i); }
    for (int i = FTID; i < 4096; i += 512) { const int e = i >> 7, c = i & 127; *(LAS v4u*)(wl + e * 1032 + 8 * c) = *(const GAS v4u*)(wrT + (size_t)e * DM + 8 * c); }
    for (int blk = F.vcu; blk < MTOK / 128; blk += F.G) {
        __syncthreads();
        if (FTID < 64) cl[FTID] = 0;
        __syncthreads();
        const int row = blk * 128 + F.wave * 16 + rw;
        const bf16* zr = zb + (size_t)row * DM + 8 * q;
        v4u zz[32];
#pragma unroll
        for (int ks = 0; ks < 32; ++ks) zz[ks] = *(const GAS v4u*)(zr + 32 * ks);
        float s1 = 0.f, s2 = 0.f;
#pragma unroll
        for (int ks = 0; ks < 32; ++ks) { const v4u w = zz[ks]; const float x0 = bflo(w.x), x1 = bfhi(w.x), x2 = bflo(w.y), x3 = bfhi(w.y), x4 = bflo(w.z), x5 = bfhi(w.z), x6 = bflo(w.w), x7 = bfhi(w.w);
            s1 += ((x0 + x1) + (x2 + x3)) + ((x4 + x5) + (x6 + x7)); s2 += ((x0 * x0 + x1 * x1) + (x2 * x2 + x3 * x3)) + ((x4 * x4 + x5 * x5) + (x6 * x6 + x7 * x7)); }
        s1 += __shfl_xor(s1, 16); s1 += __shfl_xor(s1, 32); s2 += __shfl_xor(s2, 16); s2 += __shfl_xor(s2, 32);
        const float mean = s1 * (1.f / DM), rstd = 1.f / sqrtf(fmaxf(s2 * (1.f / DM) - mean * mean, 0.f) + LN_EPS);
        if (MOE_FP8 && q == 0) { f32x2 ms; ms[0] = mean; ms[1] = rstd; *(GAS f32x2*)(st2 + (size_t)row * 2) = ms; }
        f32x4 acc0 = (f32x4){0.f, 0.f, 0.f, 0.f}, acc1 = (f32x4){0.f, 0.f, 0.f, 0.f};
        bf16* xr = xb + (size_t)row * DM + 8 * q; unsigned char* x8r = x8 + (size_t)row * DM + 8 * q;
        const LAS bf16* w0 = wl + rw * 1032 + 8 * q; const LAS bf16* w1 = wl + (16 + rw) * 1032 + 8 * q;
#pragma unroll
        for (int ks = 0; ks < 32; ++ks) { v4u w = zz[ks]; asm volatile("" : "+v"(w));
            const f32x4 g0 = *(const LAS f32x4*)(gl + 32 * ks + 8 * q), g1 = *(const LAS f32x4*)(gl + 32 * ks + 8 * q + 4), b0 = *(const LAS f32x4*)(gl + 1024 + 32 * ks + 8 * q), b1 = *(const LAS f32x4*)(gl + 1024 + 32 * ks + 8 * q + 4);
            const float y0 = (bflo(w.x) - mean) * rstd * g0[0] + b0[0], y1 = (bfhi(w.x) - mean) * rstd * g0[1] + b0[1], y2 = (bflo(w.y) - mean) * rstd * g0[2] + b0[2], y3 = (bfhi(w.y) - mean) * rstd * g0[3] + b0[3];
            const float y4 = (bflo(w.z) - mean) * rstd * g1[0] + b1[0], y5 = (bfhi(w.z) - mean) * rstd * g1[1] + b1[1], y6 = (bflo(w.w) - mean) * rstd * g1[2] + b1[2], y7 = (bfhi(w.w) - mean) * rstd * g1[3] + b1[3];
            v4u o; o.x = pk2(y0, y1); o.y = pk2(y2, y3); o.z = pk2(y4, y5); o.w = pk2(y6, y7);
            if (!MOE_FP8) *(GAS v4u*)(xr + 32 * ks) = o;
            if (x8) { v2u o8; o8.x = pk4_fp8(y0 * SX8, y1 * SX8, y2 * SX8, y3 * SX8); o8.y = pk4_fp8(y4 * SX8, y5 * SX8, y6 * SX8, y7 * SX8); *(GAS v2u*)(x8r + 32 * ks) = o8; }
            const bf16x8 bfrag = __builtin_bit_cast(bf16x8, o);
            acc0 = __builtin_amdgcn_mfma_f32_16x16x32_bf16(*(const LAS bf16x8*)(w0 + 32 * ks), bfrag, acc0, 0, 0, 0);
            acc1 = __builtin_amdgcn_mfma_f32_16x16x32_bf16(*(const LAS bf16x8*)(w1 + 32 * ks), bfrag, acc1, 0, 0, 0);
            if ((ks & 1) == 1) asm volatile("" ::: "memory"); }
        float lg[8]; const f32x4 rb0 = *(const GAS f32x4*)(rbias + 4 * q), rb1 = *(const GAS f32x4*)(rbias + 16 + 4 * q);
#pragma unroll
        for (int j = 0; j < 4; ++j) { lg[j] = acc0[j] + rb0[j]; lg[4 + j] = acc1[j] + rb1[j]; }
        int idx[4]; float val[4];
#pragma unroll
        for (int k = 0; k < 4; ++k) { float bv = -3.0e38f; int bi = 64;
#pragma unroll
            for (int j = 0; j < 8; ++j) { const int e = (j < 4) ? 4 * q + j : 12 + 4 * q + j; if (lg[j] > bv) { bv = lg[j]; bi = e; } }
#pragma unroll
            for (int o = 16; o <= 32; o <<= 1) { const float pv = __shfl_xor(bv, o); const int pi = __shfl_xor(bi, o); if (pv > bv || (pv == bv && pi < bi)) { bv = pv; bi = pi; } }
            bi &= 31; idx[k] = bi; val[k] = bv;
#pragma unroll
            for (int j = 0; j < 8; ++j) { const int e = (j < 4) ? 4 * q + j : 12 + 4 * q + j; if (e == bi) lg[j] = -3.0e38f; } }
        const float e1 = __builtin_amdgcn_exp2f((val[1] - val[0]) * LOG2E), e2 = __builtin_amdgcn_exp2f((val[2] - val[0]) * LOG2E), e3 = __builtin_amdgcn_exp2f((val[3] - val[0]) * LOG2E);
        const float inv = 1.f / (1.f + e1 + e2 + e3);
        int pos[4] = {0, 0, 0, 0};
        for (int e = 0; e < NEXP; ++e) {
            const int k = (q != 0) ? -1 : (idx[0] == e) ? 0 : (idx[1] == e) ? 1 : (idx[2] == e) ? 2 : (idx[3] == e) ? 3 : -1;
            const unsigned long long mask = __ballot(k >= 0);
            if (mask) { const int n = __popcll(mask), leader = __ffsll((long long)mask) - 1; int bp = 0;
                if (FLANE == leader) bp = __hip_atomic_fetch_add(cl + e, n, __ATOMIC_RELAXED, __HIP_MEMORY_SCOPE_WORKGROUP);
                bp = __shfl(bp, leader);
                const int p = bp + __popcll(mask & ((1ull << FLANE) - 1ull));
                pos[0] = (k == 0) ? p : pos[0]; pos[1] = (k == 1) ? p : pos[1]; pos[2] = (k == 2) ? p : pos[2]; pos[3] = (k == 3) ? p : pos[3]; }
        }
        __syncthreads();
        if (FTID < 32) { const int tot = cl[FTID]; cl[32 + FTID] = tot ? (int)__hip_atomic_fetch_add(cnt + FTID * 64, (unsigned)tot, RLX_AGENT) : 0; }
        __syncthreads();
        if (q == 0) {
            *(GAS f32x4*)(gate + (size_t)row * 4) = (f32x4){inv, e1 * inv, e2 * inv, e3 * inv};
#pragma unroll
            for (int k = 0; k < 4; ++k) { const int pe = cl[32 + idx[k]] + pos[k]; list[(size_t)idx[k] * CAP + pe] = row * 4 + k; pos[k] = (idx[k] << 16) | pe; }
            *(GAS v4i_t*)(asg + (size_t)row * 4) = (v4i_t){pos[0], pos[1], pos[2], pos[3]}; }
    }
}
__device__ __forceinline__ void ph_softmax(Frame& F, const float* sc, bf16* P) {
    const int gw = F.vcu * NWAVES + F.wave, NGW = F.G * NWAVES;
    for (int m = gw; m < MTOK; m += NGW) {
#pragma unroll
        for (int h = 0; h < 4; ++h) { f32x4 v = *(const GAS f32x4*)(sc + (size_t)m * DM + 256 * h + 4 * FLANE);
            const float mx = wave_max(fmaxf(fmaxf(v.x, v.y), fmaxf(v.z, v.w)));
            v.x = __builtin_amdgcn_exp2f(v.x - mx); v.y = __builtin_amdgcn_exp2f(v.y - mx); v.z = __builtin_amdgcn_exp2f(v.z - mx); v.w = __builtin_amdgcn_exp2f(v.w - mx);
            const float inv = 1.f / wave_sum((v.x + v.y) + (v.z + v.w));
            v2u o; o.x = pk2(v.x * inv, v.y * inv); o.y = pk2(v.z * inv, v.w * inv);
            *(GAS v2u*)(P + (size_t)m * DM + 256 * h + 4 * FLANE) = o; }
    }
}
__device__ __forceinline__ void ph_topk(Frame& F, const float* logit, const float* rbias, gu32* cnt, int* list, float* gate) {
    for (int base = F.vcu * 512; base < MTOK; base += F.G * 512) {
        const int m = base + FTID;
        float lg[32];
#pragma unroll
        for (int q = 0; q < 8; ++q) { const f32x4 t = *(const GAS f32x4*)(logit + (size_t)m * 32 + 4 * q), bb = *(const GAS f32x4*)(rbias + 4 * q);
            lg[4 * q] = t.x + bb.x; lg[4 * q + 1] = t.y + bb.y; lg[4 * q + 2] = t.z + bb.z; lg[4 * q + 3] = t.w + bb.w; }
        int idx[4]; float val[4];
#pragma unroll
        for (int k = 0; k < 4; ++k) { float bvv = -3.0e38f; int bi = 0;
#pragma unroll
            for (int e = 0; e < 32; ++e) { const bool taken = (k > 0 && idx[0] == e) || (k > 1 && idx[1] == e) || (k > 2 && idx[2] == e); if (!taken && lg[e] > bvv) { bvv = lg[e]; bi = e; } }
            idx[k] = bi; val[k] = bvv; }
        const float e1 = __builtin_amdgcn_exp2f((val[1] - val[0]) * LOG2E), e2 = __builtin_amdgcn_exp2f((val[2] - val[0]) * LOG2E), e3 = __builtin_amdgcn_exp2f((val[3] - val[0]) * LOG2E);
        const float inv = 1.f / (1.f + e1 + e2 + e3);
        *(GAS f32x4*)(gate + (size_t)m * 4) = (f32x4){inv, e1 * inv, e2 * inv, e3 * inv};
        for (int e = 0; e < NEXP; ++e) {
            const int k = (idx[0] == e) ? 0 : (idx[1] == e) ? 1 : (idx[2] == e) ? 2 : (idx[3] == e) ? 3 : -1;
            const unsigned long long mask = __ballot(k >= 0);
            if (mask) { const int n = __popcll(mask), leader = __ffsll((long long)mask) - 1; unsigned bp = 0;
                if (FLANE == leader) bp = __hip_atomic_fetch_add(cnt + e * 64, (unsigned)n, RLX_AGENT);
                bp = __shfl(bp, leader);
                if (k >= 0) { const int rank = __popcll(mask & ((1ull << FLANE) - 1ull)); list[(size_t)e * CAP + bp + rank] = m * 4 + k; } }
        }
    }
}
__device__ __forceinline__ void ph_sgu(Frame& F, const bf16* hb, bf16* mix, const float* lng, const float* lnb, const float* wsp, const float* bsp) {
    LAS bf16* Wb = (LAS bf16*)F.lds;
    LAS bf16* VT = (LAS bf16*)(F.lds + 34816);
    LAS float* GL = (LAS float*)(F.lds + 69632);
    const int r = FTID >> 2, qq = FTID & 3, n16 = FLANE & 15, q = FLANE >> 4;
    int gcur = -1;
    for (int it = F.vcu; it < 1024; it += F.G) {
        const int g = it & 3, row0 = (it >> 2) * 128;
        if (g != gcur) { __syncthreads(); for (int i = FTID; i < 16384; i += 512) { const int t = i >> 7, s2 = i & 127; Wb[t * 136 + s2] = (bf16)((s2 <= t) ? f2bf(wsp[g * 16384 + i]) : 0u); } gcur = g; }
        { float v[32]; const bf16* src = hb + (size_t)(row0 + r) * DM + 512 + g * 128 + 32 * qq;
#pragma unroll
            for (int j = 0; j < 4; ++j) { const v4u w = *(const GAS v4u*)(src + 8 * j);
                v[8 * j + 0] = bflo(w.x); v[8 * j + 1] = bfhi(w.x); v[8 * j + 2] = bflo(w.y); v[8 * j + 3] = bfhi(w.y); v[8 * j + 4] = bflo(w.z); v[8 * j + 5] = bfhi(w.z); v[8 * j + 6] = bflo(w.w); v[8 * j + 7] = bfhi(w.w); }
            float s = 0.f;
#pragma unroll
            for (int j = 0; j < 32; ++j) s += v[j];
            s += __shfl_xor(s, 1); s += __shfl_xor(s, 2);
            const float mean = s * (1.f / 128.f); float s2 = 0.f;
#pragma unroll
            for (int j = 0; j < 32; ++j) { v[j] -= mean; s2 += v[j] * v[j]; }
            s2 += __shfl_xor(s2, 1); s2 += __shfl_xor(s2, 2);
            const float rstd = 1.f / sqrtf(s2 * (1.f / 128.f) + LN_EPS);
#pragma unroll
            for (int j = 0; j < 8; ++j) { const f32x4 gg = *(const GAS f32x4*)(lng + g * 128 + 32 * qq + 4 * j), bb = *(const GAS f32x4*)(lnb + g * 128 + 32 * qq + 4 * j);
#pragma unroll
                for (int k = 0; k < 4; ++k) VT[(32 * qq + 4 * j + k) * 136 + r] = (bf16)f2bf(v[4 * j + k] * rstd * gg[k] + bb[k]); } }
        __syncthreads();
        { bf16x8 VF[4];
#pragma unroll
            for (int ks = 0; ks < 4; ++ks) VF[ks] = *(const LAS bf16x8*)(VT + (16 * F.wave + n16) * 136 + 32 * ks + 8 * q);
#pragma unroll
            for (int tb = 0; tb < 8; ++tb) { f32x4 acc = (f32x4){0.f, 0.f, 0.f, 0.f};
#pragma unroll
                for (int ks = 0; ks <= (tb >> 1); ++ks) acc = __builtin_amdgcn_mfma_f32_16x16x32_bf16(*(const LAS bf16x8*)(Wb + (16 * tb + n16) * 136 + 32 * ks + 8 * q), VF[ks], acc, 0, 0, 0);
                const f32x4 bt = *(const GAS f32x4*)(bsp + g * 128 + 16 * tb + 4 * q);
#pragma unroll
                for (int k = 0; k < 4; ++k) GL[(16 * tb + 4 * q + k) * 128 + 16 * F.wave + n16] = acc[k] + bt[k]; } }
        __syncthreads();
        { const bf16* usrc = hb + (size_t)(row0 + r) * DM + g * 128 + 32 * qq; bf16* dst = mix + (size_t)(row0 + r) * DM + g * 128 + 32 * qq;
#pragma unroll
            for (int j = 0; j < 4; ++j) { const v4u w = *(const GAS v4u*)(usrc + 8 * j); const f32x4 g0 = *(const LAS f32x4*)(GL + r * 128 + 32 * qq + 8 * j), g1 = *(const LAS f32x4*)(GL + r * 128 + 32 * qq + 8 * j + 4); v4u o;
                o.x = pk2(bflo(w.x) * g0[0], bfhi(w.x) * g0[1]); o.y = pk2(bflo(w.y) * g0[2], bfhi(w.y) * g0[3]); o.z = pk2(bflo(w.z) * g1[0], bfhi(w.z) * g1[1]); o.w = pk2(bflo(w.w) * g1[2], bfhi(w.w) * g1[3]);
                *(GAS v4u*)(dst + 8 * j) = o; } }
    }
}
__device__ __forceinline__ void ph_combine(Frame& F, const bf16* oatt, bf16* mix, const float* lq1, const float* lk1, const float* lq2, const float* lk2, const float* sg) {
    const int gw = F.vcu * NWAVES + F.wave, NGW = F.G * NWAVES;
    const float d1 = wave_sum(lq1[FLANE] * lk1[FLANE]), d2 = wave_sum(lq2[FLANE] * lk2[FLANE]);
    const float lam = expf(d1) - expf(d2) + LAM_INIT0;
    const int h = FLANE >> 4, e0 = 8 * (FLANE & 15);
    float gsc[8];
#pragma unroll
    for (int j = 0; j < 8; ++j) gsc[j] = sg[e0 + j] * (1.0f - LAM_INIT0);
    for (int m0 = gw * 4; m0 < MTOK; m0 += NGW * 4) {
        v4u av[4], bw[4];
#pragma unroll
        for (int r = 0; r < 4; ++r) { av[r] = *(const GAS v4u*)(oatt + (size_t)(m0 + r) * DM + h * 256 + e0); bw[r] = *(const GAS v4u*)(oatt + (size_t)(m0 + r) * DM + h * 256 + 128 + e0); }
#pragma unroll
        for (int r = 0; r < 4; ++r) { const v4u a = av[r], b = bw[r]; const size_t m = (size_t)(m0 + r);
            float o[8];
            o[0] = bflo(a.x) - lam * bflo(b.x); o[1] = bfhi(a.x) - lam * bfhi(b.x); o[2] = bflo(a.y) - lam * bflo(b.y); o[3] = bfhi(a.y) - lam * bfhi(b.y);
            o[4] = bflo(a.z) - lam * bflo(b.z); o[5] = bfhi(a.z) - lam * bfhi(b.z); o[6] = bflo(a.w) - lam * bflo(b.w); o[7] = bfhi(a.w) - lam * bfhi(b.w);
            float s2 = 0.f;
#pragma unroll
            for (int j = 0; j < 8; ++j) s2 += o[j] * o[j];
            s2 += __shfl_xor(s2, 1); s2 += __shfl_xor(s2, 2); s2 += __shfl_xor(s2, 4); s2 += __shfl_xor(s2, 8);
            const float rs = 1.f / sqrtf(s2 * (1.f / 128.f) + LN_EPS);
            v4u w; w.x = pk2(o[0] * rs * gsc[0], o[1] * rs * gsc[1]); w.y = pk2(o[2] * rs * gsc[2], o[3] * rs * gsc[3]); w.z = pk2(o[4] * rs * gsc[4], o[5] * rs * gsc[5]); w.w = pk2(o[6] * rs * gsc[6], o[7] * rs * gsc[7]);
            *(GAS v4u*)(mix + m * DM + 512 + h * 128 + e0) = w; }
    }
}

__device__ __forceinline__ void combine_local(Frame& F, const bf16* oatt, bf16* mix, const float* lq1, const float* lk1, const float* lq2, const float* lk2, const float* sg, int b, int h, int pr) {
    const float d1 = wave_sum(lq1[FLANE] * lk1[FLANE]), d2 = wave_sum(lq2[FLANE] * lk2[FLANE]);
    const float lam = expf(d1) - expf(d2) + LAM_INIT0;
    const int e0 = 8 * (FLANE & 15);
    float gsc[8];
#pragma unroll
    for (int j = 0; j < 8; ++j) gsc[j] = sg[e0 + j] * (1.0f - LAM_INIT0);
    for (int it = 0; it < 16; it += 4) {
        v4u av[4], bw[4]; size_t rows[4];
#pragma unroll
        for (int r = 0; r < 4; ++r) { const int rl = F.wave * 64 + (it + r) * 4 + (FLANE >> 4); rows[r] = (size_t)b * SEQ + (size_t)((rl < 256) ? pr : 7 - pr) * 256 + (rl & 255);
            av[r] = *(const GAS v4u*)(oatt + rows[r] * DM + h * 256 + e0); bw[r] = *(const GAS v4u*)(oatt + rows[r] * DM + h * 256 + 128 + e0); }
#pragma unroll
        for (int r = 0; r < 4; ++r) { const v4u a = av[r], bb = bw[r];
            float o[8];
            o[0] = bflo(a.x) - lam * bflo(bb.x); o[1] = bfhi(a.x) - lam * bfhi(bb.x); o[2] = bflo(a.y) - lam * bflo(bb.y); o[3] = bfhi(a.y) - lam * bfhi(bb.y);
            o[4] = bflo(a.z) - lam * bflo(bb.z); o[5] = bfhi(a.z) - lam * bfhi(bb.z); o[6] = bflo(a.w) - lam * bflo(bb.w); o[7] = bfhi(a.w) - lam * bfhi(bb.w);
            float s2 = 0.f;
#pragma unroll
            for (int j = 0; j < 8; ++j) s2 += o[j] * o[j];
            s2 += __shfl_xor(s2, 1); s2 += __shfl_xor(s2, 2); s2 += __shfl_xor(s2, 4); s2 += __shfl_xor(s2, 8);
            const float rs = 1.f / sqrtf(s2 * (1.f / 128.f) + LN_EPS);
            v4u w; w.x = pk2(o[0] * rs * gsc[0], o[1] * rs * gsc[1]); w.y = pk2(o[2] * rs * gsc[2], o[3] * rs * gsc[3]); w.z = pk2(o[4] * rs * gsc[4], o[5] * rs * gsc[5]); w.w = pk2(o[6] * rs * gsc[6], o[7] * rs * gsc[7]);
            *(GAS v4u*)(mix + rows[r] * DM + 512 + h * 128 + e0) = w; }
    }
}

__device__ __forceinline__ float dpp_shr1(float x) { return __builtin_bit_cast(float, __builtin_amdgcn_update_dpp(0, __builtin_bit_cast(int, x), 0x111, 0xf, 0xf, true)); }
__device__ __forceinline__ float dpp_shr2(float x) { return __builtin_bit_cast(float, __builtin_amdgcn_update_dpp(0, __builtin_bit_cast(int, x), 0x112, 0xf, 0xf, true)); }
__device__ __forceinline__ float dpp_shr4(float x) { return __builtin_bit_cast(float, __builtin_amdgcn_update_dpp(0, __builtin_bit_cast(int, x), 0x114, 0xf, 0xf, true)); }
__device__ __forceinline__ float dpp_shr8(float x) { return __builtin_bit_cast(float, __builtin_amdgcn_update_dpp(0, __builtin_bit_cast(int, x), 0x118, 0xf, 0xf, true)); }
__device__ __forceinline__ float dpp_shl15(float x) { return __builtin_bit_cast(float, __builtin_amdgcn_update_dpp(0, __builtin_bit_cast(int, x), 0x10f, 0xf, 0xf, true)); }
#define S5_DPP2(fn, v) ((f32x2){fn((v).x), fn((v).y)})
__device__ __forceinline__ float dpp_ror1(float x) { return __builtin_bit_cast(float, __builtin_amdgcn_update_dpp(0, __builtin_bit_cast(int, x), 0x121, 0xf, 0xf, true)); }
template <int hf>
__device__ __forceinline__ void s5_main(Frame& F, const bf16* ug, bf16* yb, const float* dsk, int g, int bh, LAS bf16* W2F, LAS bf16* W3F, LAS bf16* KT, LAS float* PW, int r, int q, int variant) {
        const int b = bh * 4 + (F.wave & 3);
        LAS bf16x8* XX = (LAS bf16x8*)(F.lds + 91648);
        const bf16* up = ug + ((size_t)g * MTOK + (size_t)b * SEQ) * 16;
        unsigned char* yp = (unsigned char*)yb + ((size_t)g * MTOK + (size_t)b * SEQ) * 16 + 4 * q;
        const f32x4 dk = *(const GAS f32x4*)(dsk + g * 16 + 4 * q);
        f32x4 E[4];
#pragma unroll
        for (int i = 0; i < 4; ++i) E[i] = (f32x4){0.f, 0.f, 0.f, 0.f};
        bf16x8 UFn[4], UF[4]; v2u UWn[4], UW[4];
#pragma unroll
        for (int sp = 0; sp < 4; ++sp) UFn[sp] = *(const GAS bf16x8*)(up + (size_t)(r * 8 + 2 * sp + (q >> 1)) * 16 + 8 * (q & 1));
#pragma unroll
        for (int t = 0; t < 4; ++t) UWn[t] = *(const GAS v2u*)(up + (size_t)(r * 8 + 4 * hf + t) * 16 + 4 * q);
#pragma unroll
        for (int sp = 0; sp < 4; ++sp) UF[sp] = UFn[sp];
#pragma unroll
        for (int t = 0; t < 4; ++t) UW[t] = UWn[t];
        f32x2 Pr[4][2][2], Pi[4][2][2];
#pragma unroll
        for (int i2 = 0; i2 < 2; ++i2) { const int rbp = 2 * hf + i2;
            const f32x4 a0 = *(const LAS f32x4*)(PW + (8 * 64 + 16 * rbp + 4 * q) * 2), a1 = *(const LAS f32x4*)(PW + (8 * 64 + 16 * rbp + 4 * q) * 2 + 4);
            Pr[0][i2][0] = (f32x2){a0[0], a0[2]}; Pi[0][i2][0] = (f32x2){a0[1], a0[3]}; Pr[0][i2][1] = (f32x2){a1[0], a1[2]}; Pi[0][i2][1] = (f32x2){a1[1], a1[3]};
#pragma unroll
            for (int k = 1; k < 4; ++k)
#pragma unroll
                for (int h = 0; h < 2; ++h) { const f32x2 pr = Pr[k - 1][i2][h], pi = Pi[k - 1][i2][h]; Pr[k][i2][h] = pr * pr - pi * pi; Pi[k][i2][h] = 2.0f * pr * pi; } }
        for (int cg = 0; cg < 16; ++cg) {
            const int tokbase = cg * 128 + r * 8;
            if (cg < 15) {
#pragma unroll
                for (int sp = 0; sp < 4; ++sp) UFn[sp] = *(const GAS bf16x8*)(up + (size_t)(tokbase + 128 + 2 * sp + (q >> 1)) * 16 + 8 * (q & 1));
#pragma unroll
                for (int t = 0; t < 4; ++t) UWn[t] = *(const GAS v2u*)(up + (size_t)(tokbase + 128 + 4 * hf + t) * 16 + 4 * q); }
            f32x2 Cr[2][2], Ci[2][2];
#pragma unroll
            for (int i2 = 0; i2 < 2; ++i2)
#pragma unroll
                for (int h = 0; h < 2; ++h) { const f32x2 er = h ? E[2 * i2].hi : E[2 * i2].lo, ei = h ? E[2 * i2 + 1].hi : E[2 * i2 + 1].lo; Cr[i2][h] = S5_DPP2(dpp_shl15, er); Ci[i2][h] = S5_DPP2(dpp_shl15, ei); }
#pragma unroll
            for (int i = 0; i < 4; ++i) E[i] = (f32x4){0.f, 0.f, 0.f, 0.f};
#pragma unroll
            for (int sp = 0; sp < 4; ++sp) {
#pragma unroll
                for (int i = 0; i < 4; ++i) E[i] = __builtin_amdgcn_mfma_f32_16x16x32_bf16(*(const LAS bf16x8*)(W2F + (((4 * hf + i) * 4 + sp) * 64 + FLANE) * 8), UF[sp], E[i], 0, 0, 0);
                asm volatile("" ::: "memory"); }
            bf16x8 XBf[4];
            LAS bf16x8* xx = XX + ((cg & 1) * 4 + (F.wave & 3)) * 256;
#pragma unroll
            for (int i2 = 0; i2 < 2; ++i2) { f32x2 xr[2], xi[2];
#pragma unroll
                for (int h = 0; h < 2; ++h) {
                    f32x2 er = h ? E[2 * i2].hi : E[2 * i2].lo, ei = h ? E[2 * i2 + 1].hi : E[2 * i2 + 1].lo; f32x2 sr, si, nr, ni;
                    nr = er + Pr[0][i2][h] * Cr[i2][h] - Pi[0][i2][h] * Ci[i2][h]; ni = ei + Pr[0][i2][h] * Ci[i2][h] + Pi[0][i2][h] * Cr[i2][h]; er = nr; ei = ni;
                    sr = S5_DPP2(dpp_shr1, er); si = S5_DPP2(dpp_shr1, ei); nr = er + Pr[0][i2][h] * sr - Pi[0][i2][h] * si; ni = ei + Pr[0][i2][h] * si + Pi[0][i2][h] * sr; er = nr; ei = ni;
                    sr = S5_DPP2(dpp_shr2, er); si = S5_DPP2(dpp_shr2, ei); nr = er + Pr[1][i2][h] * sr - Pi[1][i2][h] * si; ni = ei + Pr[1][i2][h] * si + Pi[1][i2][h] * sr; er = nr; ei = ni;
                    sr = S5_DPP2(dpp_shr4, er); si = S5_DPP2(dpp_shr4, ei); nr = er + Pr[2][i2][h] * sr - Pi[2][i2][h] * si; ni = ei + Pr[2][i2][h] * si + Pi[2][i2][h] * sr; er = nr; ei = ni;
                    sr = S5_DPP2(dpp_shr8, er); si = S5_DPP2(dpp_shr8, ei); nr = er + Pr[3][i2][h] * sr - Pi[3][i2][h] * si; ni = ei + Pr[3][i2][h] * si + Pi[3][i2][h] * sr; er = nr; ei = ni;
                    if (h) { E[2 * i2].hi = er; E[2 * i2 + 1].hi = ei; } else { E[2 * i2].lo = er; E[2 * i2 + 1].lo = ei; }
                    xr[h] = S5_DPP2(dpp_shr1, er) + Cr[i2][h]; xi[h] = S5_DPP2(dpp_shr1, ei) + Ci[i2][h]; }
                v4u w; w.x = pk2(xr[0].x, xr[0].y); w.y = pk2(xr[1].x, xr[1].y); w.z = pk2(xi[0].x, xi[0].y); w.w = pk2(xi[1].x, xi[1].y);
                XBf[2 * hf + i2] = __builtin_bit_cast(bf16x8, w); xx[(2 * hf + i2) * 64 + FLANE] = XBf[2 * hf + i2]; }
            LDS_WAIT(); __builtin_amdgcn_s_barrier(); asm volatile("" ::: "memory");
#pragma unroll
            for (int i2 = 0; i2 < 2; ++i2) XBf[2 * (1 - hf) + i2] = xx[(2 * (1 - hf) + i2) * 64 + FLANE];
            unsigned yout[4] = {0u, 0u, 0u, 0u};
            if (variant != 2) {
            f32x4 Y[4];
#pragma unroll
            for (int tt = 0; tt < 4; ++tt) Y[tt] = (f32x4){0.f, 0.f, 0.f, 0.f};
#pragma unroll
            for (int sp = 0; sp < 4; ++sp) {
#pragma unroll
                for (int tt = 0; tt < 4; ++tt) { const int t = 4 * hf + tt; if (sp <= (t >> 1)) { const int tau1 = t - 2 * sp - (q >> 1) + 1;
                    Y[tt] = __builtin_amdgcn_mfma_f32_16x16x32_bf16(*(const LAS bf16x8*)(KT + (tau1 * 16 + r) * 16 + 8 * (q & 1)), UF[sp], Y[tt], 0, 0, 0); } }
                asm volatile("" ::: "memory"); }
#pragma unroll
            for (int ks = 0; ks < 4; ++ks) {
#pragma unroll
                for (int tt = 0; tt < 4; ++tt) Y[tt] = __builtin_amdgcn_mfma_f32_16x16x32_bf16(*(const LAS bf16x8*)(W3F + (((4 * hf + tt) * 4 + ks) * 64 + FLANE) * 8), XBf[ks], Y[tt], 0, 0, 0);
                asm volatile("" ::: "memory"); }
#pragma unroll
            for (int tt = 0; tt < 4; ++tt) { const v2u uw = UW[tt];
                const f32x2 ya = gelu_tanh2(Y[tt].lo + dk.lo * (f32x2){bflo(uw.x), bfhi(uw.x)}, SA8), yb2 = gelu_tanh2(Y[tt].hi + dk.hi * (f32x2){bflo(uw.y), bfhi(uw.y)}, SA8);
                yout[tt] = pk4_fp8(ya.x, ya.y, yb2.x, yb2.y);
            } }
            if (cg < 15) {
#pragma unroll
                for (int sp = 0; sp < 4; ++sp) UF[sp] = UFn[sp];
#pragma unroll
                for (int t = 0; t < 4; ++t) UW[t] = UWn[t]; }
            asm volatile("" ::: "memory");
            { auto s01 = __builtin_amdgcn_permlane16_swap(yout[0], yout[1], false, false); auto s23 = __builtin_amdgcn_permlane16_swap(yout[2], yout[3], false, false);
              auto s02 = __builtin_amdgcn_permlane32_swap(s01[0], s23[0], false, false); auto s13 = __builtin_amdgcn_permlane32_swap(s01[1], s23[1], false, false);
              *(GAS v4u*)(yp - 4 * q + (size_t)(tokbase + 4 * hf + q) * 16) = (v4u){s02[0], s13[0], s02[1], s13[1]}; }
        }
}
__device__ __forceinline__ void ph_s5(Frame& F, const bf16* ug, bf16* yb, const float* log_dt, const float* lre, const float* lim, const float* bre, const float* bim,
                                      const float* cre, const float* cim, const float* dsk, int variant) {
    LAS bf16* W2F = (LAS bf16*)F.lds;
    LAS bf16* W3F = (LAS bf16*)(F.lds + 32768);
    LAS bf16* KT = (LAS bf16*)(F.lds + 65536);
    LAS float* PW = (LAS float*)(F.lds + 70144);
    LAS float* ZZ = (LAS float*)(F.lds + 74752);
    LAS float* BB = (LAS float*)(F.lds + 75264);
    LAS float* CC = (LAS float*)(F.lds + 83456);
    LAS bf16* W30 = (LAS bf16*)(F.lds + 124416);
    const int r = FLANE & 15, q = FLANE >> 4;
    for (int it = F.vcu; it < 256; it += F.G) {
        const int g = it & 63, bh = it >> 6;
        __syncthreads();
        if (FTID < 64) { const int p = FTID; const float dt = expf(log_dt[g]), lr = lre[g * 64 + p], li = lim[g * 64 + p];
            const float mg = expf(lr * dt), ar = mg * cosf(li * dt), ai = mg * sinf(li * dt), den = lr * lr + li * li;
            float pr = 1.f, pi = 0.f;
            for (int n = 0; n < 9; ++n) { PW[(n * 64 + p) * 2] = pr; PW[(n * 64 + p) * 2 + 1] = pi; const float t2 = pr * ar - pi * ai; pi = pr * ai + pi * ar; pr = t2; }
            ZZ[p * 2] = ((ar - 1.0f) * lr + ai * li) / den; ZZ[p * 2 + 1] = (ai * lr - (ar - 1.0f) * li) / den; }
        __syncthreads();
        for (int idx = FTID; idx < 1024; idx += 512) {
            { const int p = idx >> 4; const float br = bre[(size_t)g * 1024 + idx], bi = bim[(size_t)g * 1024 + idx], zr = ZZ[p * 2], zi = ZZ[p * 2 + 1];
              BB[idx * 2] = zr * br - zi * bi; BB[idx * 2 + 1] = zr * bi + zi * br; }
            { CC[idx * 2] = cre[(size_t)g * 1024 + idx]; CC[idx * 2 + 1] = cim[(size_t)g * 1024 + idx]; }
        }
        if (FTID < 256) KT[FTID] = 0;
        __syncthreads();
        for (int idx = FTID; idx < 2048; idx += 512) {
            { const int t = idx >> 8, ks = (idx >> 6) & 3, ln = idx & 63, c = ln & 15, qq = ln >> 4; unsigned w[4];
#pragma unroll
              for (int j = 0; j < 4; ++j) { const int p = 16 * ks + 4 * qq + j; const float cr_ = CC[(c * 64 + p) * 2], ci_ = CC[(c * 64 + p) * 2 + 1], pr = PW[((t + 1) * 64 + p) * 2], pi = PW[((t + 1) * 64 + p) * 2 + 1];
                  const float gr = cr_ * pr - ci_ * pi, gi = cr_ * pi + ci_ * pr;
                  if (j & 1) { w[j >> 1] |= f2bf(gr) << 16; w[2 + (j >> 1)] |= f2bf(-gi) << 16; } else { w[j >> 1] = f2bf(gr); w[2 + (j >> 1)] = f2bf(-gi); } }
              *(LAS v4u*)(W3F + (size_t)idx * 8) = (v4u){w[0], w[1], w[2], w[3]}; }
            { const int rb = idx >> 8, sp = (idx >> 6) & 3, ln = idx & 63, rr = ln & 15, qq = ln >> 4, p = 16 * (rb >> 1) + rr, s = 2 * sp + (qq >> 1), c0 = 8 * (qq & 1); unsigned w[4];
              const float pr = PW[((7 - s) * 64 + p) * 2], pi = PW[((7 - s) * 64 + p) * 2 + 1];
#pragma unroll
              for (int j = 0; j < 8; ++j) { const float br = BB[(p * 16 + c0 + j) * 2], bi = BB[(p * 16 + c0 + j) * 2 + 1]; const float v = (rb & 1) ? (pr * bi + pi * br) : (pr * br - pi * bi);
                  if (j & 1) w[j >> 1] |= f2bf(v) << 16; else w[j >> 1] = f2bf(v); }
              *(LAS v4u*)(W2F + (size_t)idx * 8) = (v4u){w[0], w[1], w[2], w[3]}; }
        }
        if (FTID < 256) { const int ks = FTID >> 6, ln = FTID & 63, c = ln & 15, qq = ln >> 4; unsigned w[4];
#pragma unroll
            for (int j = 0; j < 4; ++j) { const int p = 16 * ks + 4 * qq + j; const float gr = CC[(c * 64 + p) * 2], gi = CC[(c * 64 + p) * 2 + 1];
                if (j & 1) { w[j >> 1] |= f2bf(gr) << 16; w[2 + (j >> 1)] |= f2bf(-gi) << 16; } else { w[j >> 1] = f2bf(gr); w[2 + (j >> 1)] = f2bf(-gi); } }
            *(LAS v4u*)(W30 + (size_t)FTID * 8) = (v4u){w[0], w[1], w[2], w[3]}; }
        __syncthreads();
        {
            f32x4 kacc = (f32x4){0.f, 0.f, 0.f, 0.f}; const int tau = F.wave;
#pragma unroll
            for (int ks = 0; ks < 4; ++ks) { unsigned w[4];
#pragma unroll
                for (int j = 0; j < 4; ++j) { const int p = 16 * ks + 4 * q + j; const float br = BB[(p * 16 + r) * 2], bi = BB[(p * 16 + r) * 2 + 1];
                    if (j & 1) { w[j >> 1] |= f2bf(br) << 16; w[2 + (j >> 1)] |= f2bf(bi) << 16; } else { w[j >> 1] = f2bf(br); w[2 + (j >> 1)] = f2bf(bi); } }
                const v4u wb = (v4u){w[0], w[1], w[2], w[3]};
                const bf16x8 af = tau == 0 ? *(const LAS bf16x8*)(W30 + (ks * 64 + FLANE) * 8) : *(const LAS bf16x8*)(W3F + (((tau - 1) * 4 + ks) * 64 + FLANE) * 8);
                kacc = __builtin_amdgcn_mfma_f32_16x16x32_bf16(af, __builtin_bit_cast(bf16x8, wb), kacc, 0, 0, 0); }
#pragma unroll
            for (int k = 0; k < 4; ++k) KT[(tau + 1) * 256 + (4 * q + k) * 16 + r] = (bf16)f2bf(kacc[k]); }
        __syncthreads();
        if (variant != 1) { if ((F.wave >> 2) == 0) s5_main<0>(F, ug, yb, dsk, g, bh, W2F, W3F, KT, PW, r, q, variant); else s5_main<1>(F, ug, yb, dsk, g, bh, W2F, W3F, KT, PW, r, q, variant); }
    }
}

struct PlainSched {
    pg8::TileOrder T; const char* A; const char* B; int tilesPerBatch; size_t bBatch; int splitN; size_t aT = pg8::TSTEP, bT = pg8::TSTEP;
    __device__ __forceinline__ bool next(int i, pg8::Unit& u) const {
        int pm, pn; if (!T.get(i, pm, pn)) return false;
        const int z = pm / tilesPerBatch;
        u.a = A + (size_t)pm * aT; u.b = B + (size_t)z * bBatch + (size_t)pn * bT; u.row0 = pm * 256; u.col0 = pn * 256; u.z = z; u.aux = 0;
        if (splitN) { u.z = pn >= splitN; u.col0 = (pn >= splitN ? pn - splitN : pn) * 256; }
        return true;
    }
};
struct FoldSched {
    int G, c, first; const char* KB; const char* VB; const char* XQ; const char* XOT;
    __device__ __forceinline__ bool next(int i, pg8::Unit& u) const {
        const int idx = i * G + c - first; if (idx < 0 || idx >= 512) return false;
        const int type = idx >> 8, j = idx & 255, b = j >> 4, h = (j >> 2) & 3, t = j & 3;
        if (type == 0) { u.a = KB + (size_t)b * 256 * 2048 + h * 512; u.b = XQ + (size_t)t * pg8::TSTEP + h * 512; u.row0 = b * 1024 + h * 256; u.col0 = t * 256; u.z = 0; }
        else { u.a = XOT + (size_t)t * pg8::TSTEP + h * 512; u.b = VB + (size_t)b * 256 * 2048 + h * 512; u.row0 = b * 1024 + t * 256; u.col0 = h * 256; u.z = 1; }
        u.aux = 0; return true;
    }
};
struct MoeSched {
    LAS const int* tab; int NT, G, c; const char* A; const char* B; size_t bExp; int colw; const int* list; bool gather; size_t tileB;
    __device__ __forceinline__ bool next(int i, pg8::Unit& u) const {
        const int nblk = __builtin_amdgcn_readfirstlane(tab[64]);
        const int x = c >> 5, r = c & 31; int mbl, pn;
        if (G != 256 || NT != 8) { mbl = c / NT; pn = c % NT; } else { pn = 4 * (x & 1) + (r & 3); mbl = 8 * (x >> 1) + (r >> 2); }
        const int mbg = i * (G / NT) + mbl; if (mbg >= nblk) return false;
        const int lane = opaque_tid() & 63; const int v = (lane <= 32) ? tab[32 + lane] : 0x7fffffff;
        const int e = __popcll(__ballot(v <= mbg)) - 1;
        const int mb = mbg - __builtin_amdgcn_readfirstlane(tab[32 + e]);
        u.a = gather ? A : A + (size_t)mbg * tileB; u.b = B + (size_t)e * bExp + (size_t)pn * tileB;
        u.row0 = mbg * 256; u.col0 = pn * colw; u.z = e; u.aux = mb; return true;
    }
    __device__ __forceinline__ const int* rows(const pg8::Unit& u) const { return list + (size_t)u.z * CAP + u.aux * 256; }
    __device__ __forceinline__ static int rowmap(int v) { return (int)(((unsigned)v >> 2) & (unsigned)(MTOK - 1)); }
};

#define EPI_ROWS_BEGIN _Pragma("unroll") for (int ai = 0; ai < 2; ++ai) _Pragma("unroll") for (int m = 0; m < 4; ++m) { const int rloc = ai * 128 + wr * 64 + m * 16 + fr;
#define EPI_ROWS_END }
__device__ __forceinline__ v4u pack8(f32x4 v0, f32x4 v1) { v4u w; w.x = pg8::cvt_pk_bf16(v0[0], v0[1]); w.y = pg8::cvt_pk_bf16(v0[2], v0[3]); w.z = pg8::cvt_pk_bf16(v1[0], v1[1]); w.w = pg8::cvt_pk_bf16(v1[2], v1[3]); return w; }
__device__ __forceinline__ void unpack8(v4u w, f32x4& a, f32x4& b) { a = (f32x4){bflo(w.x), bfhi(w.x), bflo(w.y), bfhi(w.y)}; b = (f32x4){bflo(w.z), bfhi(w.z), bflo(w.w), bfhi(w.w)}; }
__device__ __forceinline__ void rowpair_publish(LAS float* tab, float* dst, int nslot, int slot, int row0, const float (&ss)[8], const float (&qq)[8], int wr, int wc, int fr, int fq) {
    if (fq == 0) {
#pragma unroll
        for (int i = 0; i < 8; ++i) { const int rl = (i >> 2) * 128 + wr * 64 + (i & 3) * 16 + fr; tab[(rl * 4 + wc) * 2] = ss[i]; tab[(rl * 4 + wc) * 2 + 1] = qq[i]; } }
    LDS_WAIT(); __builtin_amdgcn_s_barrier(); asm volatile("" ::: "memory");
    { const int t = opaque_tid(), row = t >> 1, which = t & 1;
      const float v = (tab[(row * 4 + 0) * 2 + which] + tab[(row * 4 + 1) * 2 + which]) + (tab[(row * 4 + 2) * 2 + which] + tab[(row * 4 + 3) * 2 + which]);
      dst[((size_t)(row0 + row) * nslot + slot) * 2 + which] = v; }
    LDS_WAIT(); __builtin_amdgcn_s_barrier(); asm volatile("" ::: "memory");
}
__device__ __forceinline__ void ln_tables(LAS float* tabR, LAS float* tabC, const float* st, int nslot, int row0, const float* sc, int scrow0, const float* v0, const float* v1, int col0) {
    const int t = opaque_tid();
    if (t < 256) { const float* p = st + (size_t)(row0 + t) * 16; float s = 0.f, q = 0.f;
        for (int k = 0; k < nslot; ++k) { s += p[2 * k]; q += p[2 * k + 1]; }
        const float mu = s * (1.f / DM); tabR[2 * t] = mu; tabR[2 * t + 1] = 1.f / sqrtf(fmaxf(q * (1.f / DM) - mu * mu, 0.f) + LN_EPS); }
    else { const int c = t - 256;
        if (sc) { const f32x4 a = *(const GAS f32x4*)(sc + (size_t)(scrow0 + c) * 8), b = *(const GAS f32x4*)(sc + (size_t)(scrow0 + c) * 8 + 4);
            tabC[c] = (a[0] + a[2]) + (b[0] + b[2]); tabC[256 + c] = (a[1] + a[3]) + (b[1] + b[3]); }
        else { tabC[c] = v0[col0 + c]; tabC[256 + c] = v1[col0 + c]; } }
    LDS_WAIT(); __builtin_amdgcn_s_barrier(); asm volatile("" ::: "memory");
}
struct EpiResidStats { const bf16* xb; bf16* zb; unsigned char* z8; float* st; LAS float* tab;
    __device__ __forceinline__ void operator()(EPI_ARGS) const {
        float ss[8], qq[8]; v4u xr[2][4][2];
        EPI_ROWS_BEGIN const size_t off = (size_t)(u.row0 + rloc) * DM + u.col0 + wc * 32 + 8 * fq; xr[ai][m][0] = *(const GAS v4u*)(xb + off); xr[ai][m][1] = *(const GAS v4u*)(xb + off + 128); EPI_ROWS_END
        EPI_ROWS_BEGIN const size_t off = (size_t)(u.row0 + rloc) * DM + u.col0 + wc * 32 + 8 * fq; float s = 0.f, q = 0.f;
#pragma unroll
            for (int bj = 0; bj < 2; ++bj) { f32x4 x0, x1; unpack8(xr[ai][m][bj], x0, x1);
                const f32x4 z0 = x0 * ALPHA + acc[ai][bj][m][0], z1 = x1 * ALPHA + acc[ai][bj][m][1];
                *(GAS v4u*)(zb + off + bj * 128) = pack8(z0, z1);
                v2u w; w.x = pk4_fp8(z0[0] * SZ8, z0[1] * SZ8, z0[2] * SZ8, z0[3] * SZ8); w.y = pk4_fp8(z1[0] * SZ8, z1[1] * SZ8, z1[2] * SZ8, z1[3] * SZ8); *(GAS v2u*)(z8 + off + bj * 128) = w;
                s += ((z0[0] + z0[1]) + (z0[2] + z0[3])) + ((z1[0] + z1[1]) + (z1[2] + z1[3])); q += ((z0[0] * z0[0] + z0[1] * z0[1]) + (z0[2] * z0[2] + z0[3] * z0[3])) + ((z1[0] * z1[0] + z1[1] * z1[1]) + (z1[2] * z1[2] + z1[3] * z1[3])); }
            s += __shfl_xor(s, 16); s += __shfl_xor(s, 32); q += __shfl_xor(q, 16); q += __shfl_xor(q, 32); ss[ai * 4 + m] = s; qq[ai * 4 + m] = q; EPI_ROWS_END
        rowpair_publish(tab, st, 8, u.col0 >> 8, u.row0, ss, qq, wr, wc, fr, fq);
    } };
struct EpiResidLN { bf16* zb; float rs; const float* st; LAS float* tab; const float* g; const float* b; int nslot;
    __device__ __forceinline__ void operator()(EPI_ARGS) const {
        LAS float* tabC = tab + 512; ln_tables(tab, tabC, st, nslot, u.row0, nullptr, 0, g, b, u.col0);
        const int c8 = u.col0 + wc * 32 + 8 * fq, cl = wc * 32 + 8 * fq; v4u zr[2][4][2];
        EPI_ROWS_BEGIN const size_t off = (size_t)(u.row0 + rloc) * DM + c8; zr[ai][m][0] = *(const GAS v4u*)(zb + off); zr[ai][m][1] = *(const GAS v4u*)(zb + off + 128); EPI_ROWS_END
        EPI_ROWS_BEGIN const size_t off = (size_t)(u.row0 + rloc) * DM + c8; const float mu = tab[2 * rloc], rstd = tab[2 * rloc + 1];
#pragma unroll
            for (int bj = 0; bj < 2; ++bj) { f32x4 x0, x1; unpack8(zr[ai][m][bj], x0, x1);
                const f32x4 g0 = *(const LAS f32x4*)(tabC + cl + bj * 128), g1 = *(const LAS f32x4*)(tabC + cl + bj * 128 + 4), b0 = *(const LAS f32x4*)(tabC + 256 + cl + bj * 128), b1 = *(const LAS f32x4*)(tabC + 256 + cl + bj * 128 + 4);
                x0 = (x0 - mu) * rstd * g0 + b0; x1 = (x1 - mu) * rstd * g1 + b1;
                *(GAS v4u*)(zb + off + bj * 128) = pack8(x0 * ALPHA + acc[ai][bj][m][0] * rs, x1 * ALPHA + acc[ai][bj][m][1] * rs); } EPI_ROWS_END
        LDS_WAIT(); __builtin_amdgcn_s_barrier(); asm volatile("" ::: "memory");
    } };
struct EpiFold { unsigned char* kft; unsigned char* vft; const float* g; const float* b; float* sc; LAS float* tab;
    __device__ __forceinline__ void operator()(EPI_ARGS) const {
        if (u.z) {
            EPI_ROWS_BEGIN unsigned char* rowp = vft + (size_t)(u.row0 + rloc) * 1024 + u.col0 + wc * 32 + 8 * fq;
#pragma unroll
                for (int bj = 0; bj < 2; ++bj) { const f32x4 v0 = acc[ai][bj][m][0] * SV8, v1 = acc[ai][bj][m][1] * SV8; v2u w; w.x = pk4_fp8(v0[0], v0[1], v0[2], v0[3]); w.y = pk4_fp8(v1[0], v1[1], v1[2], v1[3]); *(GAS v2u*)(rowp + bj * 128) = w; } EPI_ROWS_END
            return; }
        float ss[8], qq[8]; const int c8 = u.col0 + wc * 32 + 8 * fq, cl = wc * 32 + 8 * fq; LAS float* tabC = tab + 2048;
        { const int t = opaque_tid(); if (t < 256) tabC[t] = g[u.col0 + t] * CSC; else tabC[t] = b[u.col0 + t - 256] * CSC; }
        LDS_WAIT(); __builtin_amdgcn_s_barrier(); asm volatile("" ::: "memory");
        EPI_ROWS_BEGIN unsigned char* rowp = kft + (size_t)(u.row0 + rloc) * 1024 + c8; float s = 0.f, q = 0.f;
#pragma unroll
            for (int bj = 0; bj < 2; ++bj) { const f32x4 g0 = *(const LAS f32x4*)(tabC + cl + bj * 128), g1 = *(const LAS f32x4*)(tabC + cl + bj * 128 + 4), b0 = *(const LAS f32x4*)(tabC + 256 + cl + bj * 128), b1 = *(const LAS f32x4*)(tabC + 256 + cl + bj * 128 + 4);
                const f32x4 k0 = acc[ai][bj][m][0] * g0, k1 = acc[ai][bj][m][1] * g1, c0 = acc[ai][bj][m][0] * b0, c1 = acc[ai][bj][m][1] * b1;
                s += ((k0[0] + k0[1]) + (k0[2] + k0[3])) + ((k1[0] + k1[1]) + (k1[2] + k1[3])); q += ((c0[0] + c0[1]) + (c0[2] + c0[3])) + ((c1[0] + c1[1]) + (c1[2] + c1[3]));
                v2u w; w.x = pk4_fp8(k0[0] * SK8, k0[1] * SK8, k0[2] * SK8, k0[3] * SK8); w.y = pk4_fp8(k1[0] * SK8, k1[1] * SK8, k1[2] * SK8, k1[3] * SK8); *(GAS v2u*)(rowp + bj * 128) = w; }
            s += __shfl_xor(s, 16); s += __shfl_xor(s, 32); q += __shfl_xor(q, 16); q += __shfl_xor(q, 32); ss[ai * 4 + m] = s; qq[ai * 4 + m] = q; EPI_ROWS_END
        rowpair_publish(tab, sc, 4, u.col0 >> 8, u.row0, ss, qq, wr, wc, fr, fq);
    } };
struct EpiStore { bf16* base0; bf16* base1; float s0, s1; int ldc; int f8mask = 0;
    __device__ __forceinline__ void operator()(EPI_ARGS) const {
        bf16* base = u.z ? base1 : base0; const float sc = u.z ? s1 : s0;
        if ((f8mask >> (u.z ? 1 : 0)) & 1) { unsigned char* b8 = (unsigned char*)base;
            EPI_ROWS_BEGIN unsigned char* rowp = b8 + (size_t)(u.row0 + rloc) * ldc + u.col0 + wc * 32 + 8 * fq;
#pragma unroll
                for (int bj = 0; bj < 2; ++bj) { const f32x4 v0 = acc[ai][bj][m][0] * sc, v1 = acc[ai][bj][m][1] * sc; v2u w; w.x = pk4_fp8(v0[0], v0[1], v0[2], v0[3]); w.y = pk4_fp8(v1[0], v1[1], v1[2], v1[3]); *(GAS v2u*)(rowp + bj * 128) = w; } EPI_ROWS_END
            return; }
        EPI_ROWS_BEGIN bf16* rowp = base + (size_t)(u.row0 + rloc) * ldc + u.col0 + wc * 32 + 8 * fq;
#pragma unroll
            for (int bj = 0; bj < 2; ++bj) *(GAS v4u*)(rowp + bj * 128) = pack8(acc[ai][bj][m][0] * sc, acc[ai][bj][m][1] * sc); EPI_ROWS_END
    } };
struct EpiH0 { bf16* uv; bf16* qx; bf16* kx; bf16* vx; float rs;
    __device__ __forceinline__ void operator()(EPI_ARGS) const {
        const int pn = u.col0 >> 8, kind = pn < 4 ? 0 : ((pn - 4) >> 1) + 1;
        bf16* base = kind == 0 ? uv : kind == 1 ? qx : kind == 2 ? kx : vx;
        EPI_ROWS_BEGIN bf16* rowp = base + (size_t)(u.row0 + rloc) * DM;
#pragma unroll
            for (int bj = 0; bj < 2; ++bj) { f32x4 v0 = acc[ai][bj][m][0] * rs, v1 = acc[ai][bj][m][1] * rs;
                if (kind == 0) {
#pragma unroll
                    for (int j = 0; j < 4; ++j) { v0[j] = gelu_tanh(v0[j]); v1[j] = gelu_tanh(v1[j]); }
                    *(GAS v4u*)(rowp + u.col0 + bj * 128 + wc * 32 + 8 * fq) = pack8(v0, v1); }
                else { const int cr = ((pn - 4) & 1) * 256 + bj * 128 + wc * 32 + 8 * fq;
                    if (kind == 1) { v0 = v0 * C2; v1 = v1 * C2; }
                    *(GAS v4u*)(rowp + cr) = pack8(v0, v1); } } EPI_ROWS_END
    } };
struct EpiResid { const bf16* xb; bf16* zb; float rs = 1.0f;
    __device__ __forceinline__ void operator()(EPI_ARGS) const {
        EPI_ROWS_BEGIN const size_t off = (size_t)(u.row0 + rloc) * DM + u.col0 + wc * 32 + 8 * fq;
#pragma unroll
            for (int bj = 0; bj < 2; ++bj) { f32x4 x0, x1; unpack8(*(const GAS v4u*)(xb + off + bj * 128), x0, x1);
                *(GAS v4u*)(zb + off + bj * 128) = pack8(x0 * ALPHA + acc[ai][bj][m][0] * rs, x1 * ALPHA + acc[ai][bj][m][1] * rs); } EPI_ROWS_END
    } };
struct EpiUG { bf16* ug; float rs;
    __device__ __forceinline__ void operator()(EPI_ARGS) const {
        EPI_ROWS_BEGIN
#pragma unroll
            for (int bj = 0; bj < 2; ++bj) { const int col = u.col0 + bj * 128 + wc * 32 + 8 * fq;
                *(GAS v4u*)(ug + ((size_t)(col >> 4) * MTOK + (u.row0 + rloc)) * 16 + (col & 15)) = pack8(acc[ai][bj][m][0] * rs, acc[ai][bj][m][1] * rs); } EPI_ROWS_END
    } };
struct EpiScore { float* sc;
    __device__ __forceinline__ void operator()(EPI_ARGS) const {
        EPI_ROWS_BEGIN float* rowp = sc + (size_t)(u.row0 + rloc) * DM + u.col0 + wc * 32 + 8 * fq;
#pragma unroll
            for (int bj = 0; bj < 2; ++bj) { *(GAS f32x4*)(rowp + bj * 128) = acc[ai][bj][m][0]; *(GAS f32x4*)(rowp + bj * 128 + 4) = acc[ai][bj][m][1]; } EPI_ROWS_END
    } };
struct EpiSoftmaxP { bf16* P; LAS float* tab; float rs0; const float* st; const float* sc; int nslot;
    __device__ __forceinline__ void operator()(EPI_ARGS) const {
        { auto& A = const_cast<f32x4 (&)[2][2][4][2]>(acc); LAS float* tabC = tab + 512; ln_tables(tab, tabC, st, nslot, u.row0, sc, u.z * 1024 + u.col0, nullptr, nullptr, 0);
          const int cl = wc * 32 + 8 * fq;
          EPI_ROWS_BEGIN const float mu = tab[2 * rloc], rstd = tab[2 * rloc + 1];
#pragma unroll
              for (int bj = 0; bj < 2; ++bj)
#pragma unroll
                  for (int n = 0; n < 2; ++n) { const f32x4 s1 = *(const LAS f32x4*)(tabC + cl + bj * 128 + 4 * n), c1 = *(const LAS f32x4*)(tabC + 256 + cl + bj * 128 + 4 * n);
                      A[ai][bj][m][n] = (A[ai][bj][m][n] * rs0 - s1 * mu) * rstd + c1; } EPI_ROWS_END
          LDS_WAIT(); __builtin_amdgcn_s_barrier(); asm volatile("" ::: "memory"); }
        constexpr float rs = 1.0f;
        EPI_ROWS_BEGIN float mx = -3.0e38f;
#pragma unroll
            for (int bj = 0; bj < 2; ++bj)
#pragma unroll
                for (int n = 0; n < 2; ++n)
#pragma unroll
                    for (int j = 0; j < 4; ++j) mx = fmaxf(mx, acc[ai][bj][m][n][j]);
            mx *= rs; mx = fmaxf(mx, __shfl_xor(mx, 16)); mx = fmaxf(mx, __shfl_xor(mx, 32));
            float sm = 0.f;
#pragma unroll
            for (int bj = 0; bj < 2; ++bj)
#pragma unroll
                for (int n = 0; n < 2; ++n)
#pragma unroll
                    for (int j = 0; j < 4; ++j) sm += __builtin_amdgcn_exp2f(acc[ai][bj][m][n][j] * rs - mx);
            sm += __shfl_xor(sm, 16); sm += __shfl_xor(sm, 32);
            if (fq == 0) { tab[(rloc * 4 + wc) * 2] = mx; tab[(rloc * 4 + wc) * 2 + 1] = sm; } EPI_ROWS_END
        LDS_WAIT(); __builtin_amdgcn_s_barrier(); asm volatile("" ::: "memory");
        EPI_ROWS_BEGIN const f32x4 a = *(const LAS f32x4*)(tab + rloc * 8), b = *(const LAS f32x4*)(tab + rloc * 8 + 4);
            const float M = fmaxf(fmaxf(a[0], a[2]), fmaxf(b[0], b[2]));
            const float S = a[1] * __builtin_amdgcn_exp2f(a[0] - M) + a[3] * __builtin_amdgcn_exp2f(a[2] - M) + b[1] * __builtin_amdgcn_exp2f(b[0] - M) + b[3] * __builtin_amdgcn_exp2f(b[2] - M);
            const float inv = SP8 / S; unsigned char* rowp = (unsigned char*)P + (size_t)(u.row0 + rloc) * DM + u.col0 + wc * 32 + 8 * fq;
#pragma unroll
            for (int bj = 0; bj < 2; ++bj) { f32x4 v0, v1;
#pragma unroll
                for (int j = 0; j < 4; ++j) { v0[j] = __builtin_amdgcn_exp2f(acc[ai][bj][m][0][j] * rs - M) * inv; v1[j] = __builtin_amdgcn_exp2f(acc[ai][bj][m][1][j] * rs - M) * inv; }
                v2u w; w.x = pk4_fp8(v0[0], v0[1], v0[2], v0[3]); w.y = pk4_fp8(v1[0], v1[1], v1[2], v1[3]); *(GAS v2u*)(rowp + bj * 128) = w; } EPI_ROWS_END
        LDS_WAIT(); __builtin_amdgcn_s_barrier(); asm volatile("" ::: "memory");
    } };
struct EpiRouter { float* logit;
    __device__ __forceinline__ void operator()(EPI_ARGS) const {
        if (wc == 0) { EPI_ROWS_BEGIN float* rowp = logit + (size_t)(u.row0 + rloc) * 32 + 8 * fq; *(GAS f32x4*)(rowp) = acc[ai][0][m][0]; *(GAS f32x4*)(rowp + 4) = acc[ai][0][m][1]; EPI_ROWS_END }
    } };
struct EpiSwiglu { const float* bup; bf16* act;
    __device__ __forceinline__ void operator()(EPI_ARGS) const {
        const int j0 = u.col0 + wc * 32 + 8 * fq; const float* bb = bup + (size_t)u.z * 2048;
        const f32x4 bg0 = *(const GAS f32x4*)(bb + j0), bg1 = *(const GAS f32x4*)(bb + j0 + 4), bl0 = *(const GAS f32x4*)(bb + 1024 + j0), bl1 = *(const GAS f32x4*)(bb + 1024 + j0 + 4);
        EPI_ROWS_BEGIN f32x4 o0, o1;
#pragma unroll
            for (int j = 0; j < 4; ++j) {
                { const float gl = fminf(acc[ai][0][m][0][j] + bg0[j], 7.0f), ln = fminf(fmaxf(acc[ai][1][m][0][j] + bl0[j], -7.0f), 7.0f); o0[j] = gl * sigmoidf_(1.702f * gl) * (ln + 1.0f); }
                { const float gl = fminf(acc[ai][0][m][1][j] + bg1[j], 7.0f), ln = fminf(fmaxf(acc[ai][1][m][1][j] + bl1[j], -7.0f), 7.0f); o1[j] = gl * sigmoidf_(1.702f * gl) * (ln + 1.0f); } }
            *(GAS v4u*)(act + (size_t)(u.row0 + rloc) * DM + j0) = pack8(o0, o1); EPI_ROWS_END
    } };
struct EpiDown { const float* bdn; const int* list; const float* gate; bf16* ys; LAS const int* tab;
    __device__ __forceinline__ void operator()(EPI_ARGS) const {
        const int e = u.z, cnt = tab[e], c8 = u.col0 + wc * 32 + 8 * fq; const float* bb = bdn + (size_t)e * 1024 + c8;
        f32x4 bv[2][2];
#pragma unroll
        for (int bj = 0; bj < 2; ++bj) { bv[bj][0] = *(const GAS f32x4*)(bb + bj * 128); bv[bj][1] = *(const GAS f32x4*)(bb + bj * 128 + 4); }
        int av[8]; float gv[8];
#pragma unroll
        for (int i = 0; i < 8; ++i) { const int slot = u.aux * 256 + (i >> 2) * 128 + wr * 64 + (i & 3) * 16 + fr; const int sl = slot < cnt ? slot : 0;
            av[i] = (int)((unsigned)list[(size_t)e * CAP + sl] & (unsigned)(NASSIGN - 1)); }
#pragma unroll
        for (int i = 0; i < 8; ++i) gv[i] = gate[av[i]];
        EPI_ROWS_BEGIN const int slot = u.aux * 256 + rloc; const int a = av[ai * 4 + m]; const float gt = gv[ai * 4 + m]; bf16* rowp = ys + (size_t)a * DM + c8;
            if (slot < cnt) {
#pragma unroll
                for (int bj = 0; bj < 2; ++bj) *(GAS v4u*)(rowp + bj * 128) = pack8((acc[ai][bj][m][0] + bv[bj][0]) * gt, (acc[ai][bj][m][1] + bv[bj][1]) * gt); } EPI_ROWS_END
    } };
__device__ __forceinline__ void store_rowpair16(unsigned char* base, size_t rowA, size_t rowB, int colp, int fq, v2u a, v2u b) {
    const auto sx = __builtin_amdgcn_permlane16_swap(a.x, b.x, false, false); const auto sy = __builtin_amdgcn_permlane16_swap(a.y, b.y, false, false);
    *(GAS v4u*)(base + ((fq & 1) ? rowB : rowA) * DM + colp) = (v4u){sx[0], sy[0], sx[1], sy[1]}; }
struct EpiSwiglu8 { const float* bup; unsigned char* act; int skip; LAS float* slot;
    static constexpr bool HAS_PRE = true;
    __device__ __forceinline__ void pre(const pg8::Unit& u, int wid, int lane) const {
        if (wid < 4) { const int t = wid * 64 + lane; const float* src = bup + (size_t)u.z * 2048 + u.col0 + (t < 128 ? t : 1024 + t - 128);
            __builtin_amdgcn_global_load_lds((const unsigned*)src, (LAS unsigned*)(slot + u.par * 256 + wid * 64), 4, 0, 0); } }
    __device__ __forceinline__ void operator()(EPI_ARGS) const {
        if (skip) {
#pragma unroll
            for (int a = 0; a < 2; ++a)
#pragma unroll
                for (int b = 0; b < 2; ++b)
#pragma unroll
                    for (int m = 0; m < 4; ++m) asm volatile("" :: "v"(acc[a][b][m][0]), "v"(acc[a][b][m][1])); return; }
        const int j0 = u.col0 + wc * 32 + 8 * fq; constexpr float RS = 1.0f / (SX8 * SWU8); const LAS float* sb = slot + u.par * 256 + wc * 32 + 8 * fq;
        const f32x4 bg0 = *(const LAS f32x4*)(sb), bg1 = *(const LAS f32x4*)(sb + 4), bl0 = *(const LAS f32x4*)(sb + 128), bl1 = *(const LAS f32x4*)(sb + 132);
        typedef float f32x2 __attribute__((ext_vector_type(2)));
        v2u wq[2][4];
        EPI_ROWS_BEGIN f32x4 o0, o1;
#pragma unroll
            for (int n = 0; n < 2; ++n)
#pragma unroll
                for (int h = 0; h < 2; ++h) {
                    const f32x4 ga = acc[ai][0][m][n], la = acc[ai][1][m][n], bgv = n ? bg1 : bg0, blv = n ? bl1 : bl0;
                    const f32x2 g2 = h ? ga.hi : ga.lo, l2 = h ? la.hi : la.lo, bg2 = h ? bgv.hi : bgv.lo, bl2 = h ? blv.hi : blv.lo;
                    f32x2 gl = g2 * RS + bg2, ln = l2 * RS + bl2;
                    gl.x = fminf(gl.x, 7.0f); gl.y = fminf(gl.y, 7.0f); ln.x = __builtin_amdgcn_fmed3f(ln.x, -7.0f, 7.0f); ln.y = __builtin_amdgcn_fmed3f(ln.y, -7.0f, 7.0f);
                    const f32x2 ea = gl * (-1.702f * LOG2E); f32x2 d; d.x = __builtin_amdgcn_exp2f(ea.x); d.y = __builtin_amdgcn_exp2f(ea.y); d = d + 1.0f;
                    f32x2 rc; rc.x = __builtin_amdgcn_rcpf(d.x); rc.y = __builtin_amdgcn_rcpf(d.y);
                    const f32x2 o = (gl * rc) * (ln * SA8 + SA8);
                    if (n == 0) { o0[2 * h] = o.x; o0[2 * h + 1] = o.y; } else { o1[2 * h] = o.x; o1[2 * h + 1] = o.y; } }
            v2u w; { int r0 = __builtin_amdgcn_cvt_pk_fp8_f32(o0[0], o0[1], 0, false); r0 = __builtin_amdgcn_cvt_pk_fp8_f32(o0[2], o0[3], r0, true); int r1 = __builtin_amdgcn_cvt_pk_fp8_f32(o1[0], o1[1], 0, false); r1 = __builtin_amdgcn_cvt_pk_fp8_f32(o1[2], o1[3], r1, true); w.x = (unsigned)r0; w.y = (unsigned)r1; }
            wq[ai][m] = w; EPI_ROWS_END
#pragma unroll
        for (int ai = 0; ai < 2; ++ai)
#pragma unroll
            for (int mp = 0; mp < 2; ++mp) { const size_t rA = (size_t)(u.row0 + ai * 128 + wr * 64 + (2 * mp) * 16 + fr);
                store_rowpair16(act, rA, rA + 16, u.col0 + wc * 32 + 8 * (fq & 2), fq, wq[ai][2 * mp], wq[ai][2 * mp + 1]); }
    } };
struct EpiDown8 { const float* bdn; bf16* ys; LAS float* slot;
    static constexpr bool HAS_PRE = true;
    __device__ __forceinline__ void pre(const pg8::Unit& u, int wid, int lane) const {
        if (wid < 4) __builtin_amdgcn_global_load_lds((const unsigned*)(bdn + (size_t)u.z * 1024 + u.col0 + wid * 64 + lane), (LAS unsigned*)(slot + u.par * 256 + wid * 64), 4, 0, 0); }
    __device__ __forceinline__ void operator()(EPI_ARGS) const {
        const int c8 = u.col0 + wc * 32 + 8 * fq; const LAS float* bb = slot + u.par * 256 + wc * 32 + 8 * fq; constexpr float RS = 1.0f / (SA8 * SWD8);
        f32x4 bv[2][2];
#pragma unroll
        for (int bj = 0; bj < 2; ++bj) { bv[bj][0] = *(const LAS f32x4*)(bb + bj * 128); bv[bj][1] = *(const LAS f32x4*)(bb + bj * 128 + 4); }
#pragma unroll
        for (int ai = 0; ai < 2; ++ai)
#pragma unroll
            for (int mp = 0; mp < 2; ++mp) { const size_t rA = (size_t)(u.row0 + ai * 128 + wr * 64 + (2 * mp) * 16 + fr);
#pragma unroll
                for (int bj = 0; bj < 2; ++bj) { v2u w[2];
#pragma unroll
                    for (int mm = 0; mm < 2; ++mm) { const int m = 2 * mp + mm; const f32x4 v0 = (acc[ai][bj][m][0] * RS + bv[bj][0]) * SY8, v1 = (acc[ai][bj][m][1] * RS + bv[bj][1]) * SY8; w[mm].x = pk4_fp8(v0[0], v0[1], v0[2], v0[3]); w[mm].y = pk4_fp8(v1[0], v1[1], v1[2], v1[3]); }
                    store_rowpair16((unsigned char*)ys, rA, rA + 16, u.col0 + wc * 32 + 8 * (fq & 2) + bj * 128, fq, w[0], w[1]); } }
    } };
struct EpiValGate { const bf16* xb; bf16* zb; float rsv, rsg; unsigned char* z8; float* st; LAS float* tab;
    __device__ __forceinline__ void operator()(EPI_ARGS) const {
        float ss[8], qq[8]; v4u xr[2][4];
        EPI_ROWS_BEGIN xr[ai][m] = *(const GAS v4u*)(xb + (size_t)(u.row0 + rloc) * DM + u.col0 + wc * 32 + 8 * fq); EPI_ROWS_END
        EPI_ROWS_BEGIN const size_t off = (size_t)(u.row0 + rloc) * DM + u.col0 + wc * 32 + 8 * fq; f32x4 x0, x1; unpack8(xr[ai][m], x0, x1); f32x4 o0, o1;
#pragma unroll
            for (int j = 0; j < 4; ++j) { o0[j] = x0[j] * ALPHA + acc[ai][0][m][0][j] * rsv * sigmoidf_(acc[ai][1][m][0][j] * rsg); o1[j] = x1[j] * ALPHA + acc[ai][0][m][1][j] * rsv * sigmoidf_(acc[ai][1][m][1][j] * rsg); }
            *(GAS v4u*)(zb + off) = pack8(o0, o1);
            { v2u w; w.x = pk4_fp8(o0[0] * SZ8, o0[1] * SZ8, o0[2] * SZ8, o0[3] * SZ8); w.y = pk4_fp8(o1[0] * SZ8, o1[1] * SZ8, o1[2] * SZ8, o1[3] * SZ8); *(GAS v2u*)(z8 + off) = w; }
            float s = ((o0[0] + o0[1]) + (o0[2] + o0[3])) + ((o1[0] + o1[1]) + (o1[2] + o1[3])), q = ((o0[0] * o0[0] + o0[1] * o0[1]) + (o0[2] * o0[2] + o0[3] * o0[3])) + ((o1[0] * o1[0] + o1[1] * o1[1]) + (o1[2] * o1[2] + o1[3] * o1[3]));
            s += __shfl_xor(s, 16); s += __shfl_xor(s, 32); q += __shfl_xor(q, 16); q += __shfl_xor(q, 32); ss[ai * 4 + m] = s; qq[ai * 4 + m] = q;
            asm volatile("" ::: "memory"); EPI_ROWS_END
        rowpair_publish(tab, st, 8, u.col0 >> 7, u.row0, ss, qq, wr, wc, fr, fq);
    } };

#ifndef ONLY_SITE
#define ONLY_SITE -1
#endif
#define SITE(s) (ONLY_SITE < 0 || ONLY_SITE == (s))
#define IN(k) (lo <= (k) && (k) < hi)
#define SEAM(k) do { if (IN(k) && IN((k) + 1)) xcd_barrier(bar); } while (0)
template <int l>
__device__ __forceinline__ void layer_shared(Frame& F, const Args& args, const XcdBarrier& bar, const int lo, const int hi) {
    unsigned char* ws = args.ws; bf16* const XB = (bf16*)(ws + WS_XB); bf16* const ZB = (bf16*)(ws + WS_ZB); const int cid = (int)blockIdx.x;
    constexpr int pb = 5 + 14 * l;
        gu32* cnt = F.ctl + CW_CNT + l * 32 * 64;
    const float* st1 = (const float*)(ws + WS_ST) + (size_t)l * MTOK * 16; const float* sc1 = (const float*)(ws + WS_SCC) + (size_t)l * 16384 * 8;
    if (IN(pb + 1) && SITE(6)) { PlainSched S; S.T.init(MTOK / 256, 4, F.G, cid); S.A = (const char*)(ws + WS_XFZ); S.B = (const char*)(ws + WS_KFT); S.tilesPerBatch = SEQ / 256; S.bBatch = (size_t)1024 * 1024; S.splitN = 0; S.aT = (size_t)256 * 1024; S.bT = (size_t)256 * 1024;
        EpiSoftmaxP E{(bf16*)(ws + WS_P), (LAS float*)(F.lds + SMX_OFF), 1.0f / (SZ8 * SK8), st1, sc1, l ? 8 : 4}; pg8::gemm_phase<EpiSoftmaxP, PlainSched, false, true>(F.lds, 1024, S, E); } SEAM(pb + 1);
    if (IN(pb + 3) && SITE(8)) { PlainSched S; S.T.init(MTOK / 256, 4, F.G, cid); S.A = (const char*)(ws + WS_P); S.B = (const char*)(ws + WS_VFT); S.tilesPerBatch = SEQ / 256; S.bBatch = (size_t)1024 * 1024; S.splitN = 0; S.aT = (size_t)256 * 1024; S.bT = (size_t)256 * 1024;
        EpiResidLN E{ZB, 1.0f / (SP8 * SV8), st1, (LAS float*)(F.lds + SMX_OFF), (l ? args.in[39] : args.in[14]), (l ? args.in[40] : args.in[15]), l ? 8 : 4}; pg8::gemm_phase<EpiResidLN, PlainSched, false, true>(F.lds, 1024, S, E); } SEAM(pb + 3);
    if (IN(pb + 4) && SITE(9)) { ph_ln2_router(F, ZB, XB, MOE_FP8 ? ws + WS_XF8 : nullptr, (l ? args.in[43] : args.in[18]), (l ? args.in[44] : args.in[19]), (const bf16*)(ws + WS_WR) + (size_t)l * 256 * 1024,
                                               (l ? args.in[46] : args.in[21]), cnt, (int*)(ws + WS_LIST), (float*)(ws + WS_GATE), (int*)(ws + WS_ASG), (float*)(ws + WS_ST2)); } SEAM(pb + 4);
    if (IN(pb + 7) && SITE(12)) { moe_tables(F, cnt);
#if MOE_FP8
        MoeSched S{(LAS const int*)(F.lds + TAB_OFF), 8, F.G, F.vcu, (const char*)(ws + WS_XF8), (const char*)(ws + WS_WUP8), (size_t)2048 * 1024, 128, (const int*)(ws + WS_LIST), true, (size_t)256 * 1024};
        EpiSwiglu8 E{(l ? args.in[48] : args.in[23]), ws + WS_ACT, args.variant == 9, (LAS float*)(F.lds + SMX_OFF)}; pg8::gemm_phase<EpiSwiglu8, MoeSched, true, true>(F.lds, 1024, S, E);
#else
        MoeSched S{(LAS const int*)(F.lds + TAB_OFF), 8, F.G, F.vcu, (const char*)XB, (const char*)(ws + WS_WUP), (size_t)2048 * 1024 * 2, 128, (const int*)(ws + WS_LIST), true, pg8::TSTEP};
        EpiSwiglu E{(l ? args.in[48] : args.in[23]), (bf16*)(ws + WS_ACT)}; pg8::gemm_phase<EpiSwiglu, MoeSched, true>(F.lds, 1024, S, E);
#endif
    } SEAM(pb + 7);
    if (IN(pb + 8) && SITE(13)) { moe_tables(F, cnt);
#if MOE_FP8
        MoeSched S{(LAS const int*)(F.lds + TAB_OFF), 4, F.G, F.vcu, (const char*)(ws + WS_ACT), (const char*)(ws + WS_WDN8), (size_t)1024 * 1024, 256, (const int*)(ws + WS_LIST), false, (size_t)256 * 1024};
        EpiDown8 E{(l ? args.in[50] : args.in[25]), (bf16*)(ws + WS_YS), (LAS float*)(F.lds + SMX_OFF)}; pg8::gemm_phase<EpiDown8, MoeSched, false, true>(F.lds, 1024, S, E);
#else
        MoeSched S{(LAS const int*)(F.lds + TAB_OFF), 4, F.G, F.vcu, (const char*)(ws + WS_ACT), (const char*)(ws + WS_WDN), (size_t)1024 * 1024 * 2, 256, (const int*)(ws + WS_LIST), false, pg8::TSTEP};
        EpiDown E{(l ? args.in[50] : args.in[25]), (const int*)(ws + WS_LIST), (const float*)(ws + WS_GATE), (bf16*)(ws + WS_YS), (LAS const int*)(F.lds + TAB_OFF)}; pg8::gemm_phase<EpiDown, MoeSched, false>(F.lds, 1024, S, E);
#endif
    } SEAM(pb + 8);
    if (IN(pb + 9) && SITE(14)) { moe_tables(F, cnt); ph_ln<1>(F, ZB, (const bf16*)(ws + WS_YS), XB, l ? args.out : nullptr, (l ? args.in[51] : args.in[26]), (l ? args.in[52] : args.in[27]), (l == 0) ? ws + WS_XF8 : nullptr, (const int*)(ws + WS_ASG), (const float*)(ws + WS_GATE),
                                                             (const float*)(ws + WS_ST2), (l ? args.in[43] : args.in[18]), (l ? args.in[44] : args.in[19]));
        if (l == 0) { __syncthreads(); cvt_experts(F, args.in[47], args.in[49], ws); } } SEAM(pb + 9);
}

constexpr int PH_TOTAL = 29;
__global__ void __launch_bounds__(NWAVES * 64, 2) mk_fwd(Args args) {
    extern __shared__ __attribute__((aligned(16))) unsigned char lds[];
    Frame F;
    F.lds = (LAS unsigned char*)lds; F.MISC = (volatile LAS unsigned*)(F.lds + MISC_OFF);
    F.wave = __builtin_amdgcn_readfirstlane((int)threadIdx.x >> 6);
    F.G = gridDim.x; { const int bx = blockIdx.x; F.vcu = (F.G % 8 == 0) ? (bx % 8) * (F.G / 8) + bx / 8 : bx; }
    unsigned char* ws = args.ws;
    F.ctl = (gu32*)(ws + WS_CTL);
    for (int u = FTID; u < (LDS_BYTES - LDSCTL_OFF) / 4; u += NWAVES * 64) ((LAS unsigned*)(F.lds + LDSCTL_OFF))[u] = 0u;
    __syncthreads();
    const int lo = args.ph_lo, hi = args.ph_hi;
    XcdBarrier bar; bar.bar = (unsigned*)(F.ctl + CW_BAR); bar.x = 0; bar.st = nullptr;
    if (hi - lo > 1) bar = xcd_barrier_post((unsigned*)(F.ctl + CW_BAR), F.MISC + 8);
    bf16* const XB = (bf16*)(ws + WS_XB); bf16* const ZB = (bf16*)(ws + WS_ZB);
    const int cid = (int)blockIdx.x;

    if (IN(0) && SITE(0)) { p0_prologue(F, args); } SEAM(0);
    if (IN(1) && SITE(1)) {
        { PlainSched S; S.T.init(MTOK / 256, HW0 / 256, F.G, cid); S.A = (const char*)XB; S.B = (const char*)(ws + WS_WIN0); S.tilesPerBatch = 1 << 20; S.bBatch = 0; S.splitN = 0;
          EpiH0 E{(bf16*)(ws + WS_UV), (bf16*)(ws + WS_QX), (bf16*)(ws + WS_QX) + 512, (bf16*)(ws + WS_VX), 1.0f}; pg8::gemm_phase<EpiH0, PlainSched>(F.lds, 1024, S, E); }
        { PlainSched S; S.T.init(NB * MEMLEN / 256, 2048 / 256, F.G, cid); S.A = (const char*)(ws + WS_MEMB); S.B = (const char*)(ws + WS_WKV); S.tilesPerBatch = 1 << 20; S.bBatch = 0; S.splitN = 4;
          EpiStore E{(bf16*)(ws + WS_KB), (bf16*)(ws + WS_VB), 1.f, 1.f, 1024}; pg8::gemm_phase<EpiStore, PlainSched>(F.lds, 1024, S, E); }
    } SEAM(1);
    if (IN(2) && SITE(2)) {
        attn_body::bf16* oat = (attn_body::bf16*)(ws + WS_OATT);
        { const attn_body::AttnTensors AT{(const attn_body::bf16*)(ws + WS_QX), (const attn_body::bf16*)(ws + WS_QX) + 512, (const attn_body::bf16*)(ws + WS_VX), oat};
          const attn_body::StaticOrder S((int)F.G, (int)blockIdx.x); attn_body::attn_phase<attn_body::StaticOrder>((char*)lds, AT, S); }
        VM_WAIT(); __syncthreads();
        if (F.G == 256) combine_local(F, (const bf16*)(ws + WS_OATT), (bf16*)(ws + WS_MIX), args.in[8], args.in[9], args.in[10], args.in[11], args.in[12], F.vcu >> 4, (F.vcu >> 2) & 3, F.vcu & 3);
        __syncthreads();
        ph_sgu(F, (const bf16*)(ws + WS_UV), (bf16*)(ws + WS_MIX), args.in[4], args.in[5], args.in[6], args.in[7]);
    } SEAM(2);
    if (IN(4) && SITE(4)) {
        { PlainSched S; S.T.init(MTOK / 256, 4, F.G, cid); S.A = (const char*)(ws + WS_MIX); S.B = (const char*)(ws + WS_WOUT0); S.tilesPerBatch = 1 << 20; S.bBatch = 0; S.splitN = 0;
          EpiResidStats E{XB, ZB, ws + WS_XFZ, (float*)(ws + WS_ST), (LAS float*)(F.lds + SMX_OFF)}; pg8::gemm_phase<EpiResidStats, PlainSched>(F.lds, 1024, S, E); }
        { FoldSched S{F.G, F.vcu, 0, (const char*)(ws + WS_KB), (const char*)(ws + WS_VB), (const char*)(ws + WS_XQB), (const char*)(ws + WS_XOT)};
          EpiFold E{ws + WS_KFT, ws + WS_VFT, args.in[14], args.in[15], (float*)(ws + WS_SCC), (LAS float*)(F.lds + SMX_OFF)}; int kf = 256; asm volatile("" : "+s"(kf)); pg8::gemm_phase<EpiFold, FoldSched>(F.lds, kf, S, E); }
    } SEAM(4);

    layer_shared<0>(F, args, bar, lo, hi);
    if (IN(15) && SITE(15)) { { PlainSched S; S.T.init(MTOK / 256, 4, F.G, cid); S.A = (const char*)(ws + WS_XF8); S.B = (const char*)(ws + WS_WIN1); S.tilesPerBatch = 1 << 20; S.bBatch = 0; S.splitN = 0; S.aT = (size_t)256 * 1024; S.bT = (size_t)256 * 1024;
        EpiUG E{(bf16*)(ws + WS_UG), 1.0f / (SX8 * SWU8)}; pg8::gemm_phase<EpiUG, PlainSched, false, true>(F.lds, 1024, S, E); }
        { FoldSched S{F.G, F.vcu, 0, (const char*)(ws + WS_KB), (const char*)(ws + WS_VB), (const char*)(ws + WS_XQB) + 1024 * 1024 * 2, (const char*)(ws + WS_XOT) + 1024 * 1024 * 2};
      EpiFold E{ws + WS_KFT, ws + WS_VFT, args.in[39], args.in[40], (float*)(ws + WS_SCC) + (size_t)16384 * 8, (LAS float*)(F.lds + SMX_OFF)}; int kf = 256; asm volatile("" : "+s"(kf)); pg8::gemm_phase<EpiFold, FoldSched>(F.lds, kf, S, E); }
    } SEAM(15);
    if (IN(16) && SITE(16)) { ph_s5(F, (const bf16*)(ws + WS_UG), (bf16*)(ws + WS_YB), args.in[29], args.in[30], args.in[31], args.in[32], args.in[33], args.in[34], args.in[35], args.in[36], args.variant); } SEAM(16);
    if (IN(17) && SITE(17)) { PlainSched S; S.T.init(MTOK / 256, 8, F.G, cid); S.A = (const char*)(ws + WS_YB); S.B = (const char*)(ws + WS_WVG); S.tilesPerBatch = 1 << 20; S.bBatch = 0; S.splitN = 0; S.aT = (size_t)256 * 16; S.bT = (size_t)256 * 1024;
        struct VGS { PlainSched P; __device__ __forceinline__ bool next(int i, pg8::Unit& u) const { if (!P.next(i, u)) return false; u.col0 >>= 1; return true; } } S2{S};
        EpiValGate E{XB, ZB, 1.0f / (SA8 * SWD8), 1.0f / (SA8 * SWU8), ws + WS_XFZ, (float*)(ws + WS_ST) + (size_t)MTOK * 16, (LAS float*)(F.lds + SMX_OFF)}; pg8::gemm_phase<EpiValGate, VGS, false, true, 1>(F.lds, 1024, S2, E); } SEAM(17);
    layer_shared<1>(F, args, bar, lo, hi);
#undef IN
#undef SEAM
}

extern "C" void kernel_launch(void* const* d_in, const int* in_sizes, int n_in, void* d_out, int out_size, void* d_ws, size_t ws_size, hipStream_t stream) {
    static int grid = 0;
    if (grid == 0) {
        if (n_in != 53 || in_sizes[0] != MTOK * DM || out_size != MTOK * DM || ws_size < WS_END) { fprintf(stderr, "kernel_launch: unexpected problem (n_in %d, in0 %d, out %d, ws %zu < %zu); nothing launched\n", n_in, n_in > 0 ? in_sizes[0] : -1, out_size, ws_size, (size_t)WS_END); grid = -1; return; }
        int dev = 0, cus = 0, per_cu = 0;
        if (hipGetDevice(&dev) != hipSuccess || hipDeviceGetAttribute(&cus, hipDeviceAttributeMultiprocessorCount, dev) != hipSuccess) { grid = -1; return; }
        if (hipFuncSetAttribute((const void*)mk_fwd, hipFuncAttributeMaxDynamicSharedMemorySize, LDS_BYTES) != hipSuccess) { fprintf(stderr, "kernel_launch: hipFuncSetAttribute failed\n"); grid = -1; return; }
        if (hipOccupancyMaxActiveBlocksPerMultiprocessor(&per_cu, (const void*)mk_fwd, NWAVES * 64, LDS_BYTES) != hipSuccess || per_cu < 1) fprintf(stderr, "kernel_launch: note: occupancy query reports %d\n", per_cu);
        (void)hipGetLastError();
        grid = cus;
    }
    if (grid < 0) return;
    if (hipMemsetAsync((char*)d_ws + WS_CTL, 0, CTL_ZERO_BYTES, stream) != hipSuccess) return;
    Args a{};
    for (int i = 0; i < 53; ++i) a.in[i] = (const float*)d_in[i];
    a.out = (float*)d_out; a.ws = (unsigned char*)d_ws;
#if MK_N_LAUNCHES == 1
    a.ph_lo = 0; a.ph_hi = PH_TOTAL;
    hipLaunchKernelGGL(mk_fwd, dim3(grid), dim3(NWAVES * 64), LDS_BYTES, stream, a);
#else
    for (int p = 0; p < PH_TOTAL; ++p) { if (p == 18 || p == 5 || p == 19) continue; a.ph_lo = p; a.ph_hi = p + 1;
        for (int rep = 0; rep < 1 + (int)(((PROBE_REPEAT_MASK) >> p) & 1ull); ++rep) { a.variant = (rep == 0 && (((PROBE_REPEAT_MASK) >> p) & 1ull)) ? PROBE_VARIANT : 0; hipLaunchKernelGGL(mk_fwd, dim3(grid), dim3(NWAVES * 64), LDS_BYTES, stream, a); } }
#endif
}
```

```cpp
#include <hip/hip_runtime.h>
#include <hip/hip_bf16.h>
#include <cstdio>
#include <cstdint>

#ifndef MK_N_LAUNCHES
#define MK_N_LAUNCHES 1
#endif

#ifndef MOE_FP8
#define MOE_FP8 1
#endif
#ifndef PROBE_VARIANT
#define PROBE_VARIANT 0
#endif
#ifndef PROBE_REPEAT_MASK
#define PROBE_REPEAT_MASK 0ull
#endif
#define GAS __attribute__((address_space(1)))
#define LAS __attribute__((address_space(3)))
typedef unsigned short bf16;
typedef unsigned v4u __attribute__((ext_vector_type(4)));
typedef unsigned v2u __attribute__((ext_vector_type(2)));
typedef float f32x4 __attribute__((ext_vector_type(4)));
typedef float f32x2 __attribute__((ext_vector_type(2)));
typedef short bf16x8 __attribute__((ext_vector_type(8)));
typedef int v4i_t __attribute__((ext_vector_type(4)));
typedef GAS unsigned gu32;
#define RLX_AGENT __ATOMIC_RELAXED, __HIP_MEMORY_SCOPE_AGENT
#define LDS_WAIT() asm volatile("s_waitcnt lgkmcnt(0)" ::: "memory")
#define VM_WAIT() asm volatile("s_waitcnt vmcnt(0)" ::: "memory")

constexpr int NB = 16, SEQ = 2048, DM = 1024, MTOK = NB * SEQ;
constexpr int MEMLEN = 256, NEXP = 32, TOPK = 4, NASSIGN = MTOK * TOPK;
constexpr int HW0 = 2560;
constexpr int CAP = MTOK;
constexpr int MAXBLK = NASSIGN / 256 + NEXP;
constexpr float LN_EPS = 1e-5f;
constexpr float ALPHA = 1.41421356237f;
constexpr float LOG2E = 1.4426950408889634f;
constexpr float C2 = 0.125f * LOG2E;
constexpr float CSC = 0.0625f * LOG2E;
constexpr float LAM_INIT0 = 0.2f;

constexpr size_t MiB = 1u << 20;
constexpr size_t WS_CTL = 0, CTL_ZERO_BYTES = 96 * 1024;
constexpr size_t WS_LIST = 1 * MiB;
constexpr size_t WS_GATE = WS_LIST + 4 * MiB;
constexpr size_t WS_ASG = WS_GATE + 512 * 1024;
constexpr size_t WS_LOGIT = WS_GATE + 1 * MiB;
constexpr size_t WS_WKV = WS_LOGIT + 4 * MiB;
constexpr size_t WS_WIN0 = WS_WKV + 4 * MiB;
constexpr size_t WS_WOUT0 = WS_WIN0 + 5 * MiB;
constexpr size_t WS_XQB = WS_WOUT0 + 2 * MiB;
constexpr size_t WS_XOT = WS_XQB + 4 * MiB;
constexpr size_t WS_WIN1 = WS_XOT + 4 * MiB;
constexpr size_t WS_WVG = WS_WIN1 + 2 * MiB;
constexpr size_t WS_WR = WS_WVG + 4 * MiB;
constexpr size_t WS_MEMB = WS_WR + 1 * MiB;
constexpr size_t WS_KB = WS_MEMB + 8 * MiB;
constexpr size_t WS_VB = WS_KB + 8 * MiB;
constexpr size_t WS_KFT = WS_VB + 8 * MiB;
constexpr size_t WS_VFT = WS_KFT + 32 * MiB;
constexpr size_t WS_WUP = WS_VFT + 32 * MiB;
constexpr size_t WS_WDN = WS_WUP + 128 * MiB;
constexpr size_t WS_XB = WS_WDN + 64 * MiB;
constexpr size_t WS_ZB = WS_XB + 64 * MiB;
constexpr size_t WS_BIG1 = WS_ZB + 64 * MiB;
constexpr size_t WS_BIG2 = WS_BIG1 + 272 * MiB;
constexpr size_t WS_END = WS_BIG2 + 272 * MiB;
static_assert(WS_END <= 1024 * MiB, "workspace map exceeds 1 GiB");
constexpr size_t WS_UV = WS_BIG1;
constexpr size_t WS_QX = WS_BIG1 + 64 * MiB;
constexpr size_t WS_KX = WS_BIG1 + 128 * MiB;
constexpr size_t WS_VX = WS_BIG1 + 192 * MiB;
constexpr size_t WS_SC = WS_BIG1;
constexpr size_t WS_WUP8 = WS_WUP;
constexpr size_t WS_WDN8 = WS_WUP + 64 * MiB;
constexpr size_t WS_XF8 = WS_WUP + 96 * MiB;
constexpr float SX8 = 4.0f, SWU8 = 64.0f, SA8 = 4.0f, SWD8 = 128.0f, SP8 = 256.0f, SV8 = 8.0f, SK8 = 32.0f, SY8 = 32.0f;
constexpr size_t WS_XFZ = WS_WDN;
constexpr size_t WS_SCC = WS_WDN + 32 * MiB;
constexpr size_t WS_ST2 = WS_WDN + 40 * MiB;
constexpr size_t WS_ST = WS_LOGIT;
constexpr float SZ8 = 8.0f;
constexpr size_t WS_ACT = WS_BIG1;
constexpr size_t WS_OATT = WS_BIG2;
constexpr size_t WS_MIX = WS_BIG2 + 64 * MiB;
constexpr size_t WS_P = WS_BIG2 + 128 * MiB;
constexpr size_t WS_UG = WS_BIG2;
constexpr size_t WS_YB = WS_BIG2 + 64 * MiB;
constexpr size_t WS_XG = WS_BIG2;
constexpr size_t WS_YS = WS_BIG2;

constexpr int CW_TMO = 0;
constexpr int CW_BAR = 4096;
constexpr int CW_CNT = 16384;
static_assert((CW_CNT + 64 * 64) * 4 <= (int)CTL_ZERO_BYTES && (CW_BAR + 3456) * 4 <= (int)CTL_ZERO_BYTES, "control words inside the per-call memset");

constexpr int RING_BYTES = 131072;
constexpr int SCR_BYTES = 135168;
constexpr int LDSCTL_OFF = SCR_BYTES, MISC_OFF = LDSCTL_OFF + 320;
constexpr int TAB_OFF = MISC_OFF + 128;
constexpr int SMX_OFF = TAB_OFF + 576;
constexpr int LDS_BYTES = 147456;
static_assert(SMX_OFF % 16 == 0 && SMX_OFF + 8192 <= LDS_BYTES, "LDS map");

__device__ __forceinline__ unsigned f2bf(float f) { unsigned u = __builtin_bit_cast(unsigned, f); return (u + 0x7fffu + ((u >> 16) & 1u)) >> 16; }
typedef float pk2_f32x2 __attribute__((ext_vector_type(2))); typedef __bf16 pk2_bf16x2 __attribute__((ext_vector_type(2)));
__device__ __forceinline__ unsigned pk2(float lo, float hi) { const pk2_f32x2 v = {lo, hi}; return __builtin_bit_cast(unsigned, __builtin_convertvector(v, pk2_bf16x2)); }
__device__ __forceinline__ float bflo(unsigned w) { return __builtin_bit_cast(float, w << 16); }
__device__ __forceinline__ float bfhi(unsigned w) { return __builtin_bit_cast(float, w & 0xffff0000u); }
__device__ __forceinline__ float bf2f(bf16 b) { return __builtin_bit_cast(float, ((unsigned)b) << 16); }
__device__ __forceinline__ float wave_sum(float v) {
#pragma unroll
    for (int o = 1; o < 64; o <<= 1) v += __shfl_xor(v, o);
    return v;
}
__device__ __forceinline__ float wave_max(float v) {
#pragma unroll
    for (int o = 1; o < 64; o <<= 1) v = fmaxf(v, __shfl_xor(v, o));
    return v;
}
__device__ __forceinline__ float gelu_tanh(float x) {
    const float t = x * (0.7978845608f * 2.0f * LOG2E) * (1.0f + 0.044715f * x * x);
    return x * __builtin_amdgcn_rcpf(1.0f + __builtin_amdgcn_exp2f(-t));
}
__device__ __forceinline__ f32x2 gelu_tanh2(f32x2 x, float osc) {
    constexpr float K1 = 0.7978845608f * 2.0f * LOG2E, K2 = K1 * 0.044715f; const float io = 1.0f / osc;
    const f32x2 t = x * (x * x * K2 + K1); f32x2 e; e.x = __builtin_amdgcn_exp2f(-t.x); e.y = __builtin_amdgcn_exp2f(-t.y);
    const f32x2 d = e * io + io; f32x2 rc; rc.x = __builtin_amdgcn_rcpf(d.x); rc.y = __builtin_amdgcn_rcpf(d.y); return x * rc; }
__device__ __forceinline__ float sigmoidf_(float x) { return __builtin_amdgcn_rcpf(1.0f + __builtin_amdgcn_exp2f(-x * LOG2E)); }

namespace pg8 {
constexpr int BM = 256, BK = 64, HALF = 128, HTB = HALF * BK * 2, STAGE_BYTES = 8 * HTB, NXCD = 8, WGM = 8;
constexpr int LD = 1024;
constexpr size_t HSTEP = (size_t)HALF * LD * 2, TSTEP = 2 * HSTEP;
__host__ __device__ __forceinline__ int lds_byte(int r, int c) { const int st = (r >> 4) * 2 + (c >> 5), rr = r & 15, cc = c & 31, ob = rr * 64 + cc * 2; return st * 1024 + (ob ^ (((ob >> 9) & 1) << 5)); }
__host__ __device__ __forceinline__ void stage_rc(int b, int& R, int& C) { const int st = b / 1024, sb = b % 1024, swz = sb ^ (((sb >> 9) & 1) << 5); R = (st >> 1) * 16 + swz / 64; C = (st & 1) * 32 + (swz % 64) / 2; }
__host__ __device__ __forceinline__ int perm32(int rho) { const int n = rho >> 4, i = rho & 15; return 8 * (i >> 2) + 4 * n + (i & 3); }

struct Unit { const char* a; const char* b; int row0, col0, z, aux, par; };
template <class E, class = void> struct epi_has_pre { static constexpr bool value = false; };
template <class E> struct epi_has_pre<E, decltype((void)E::HAS_PRE)> { static constexpr bool value = true; };

struct TileOrder {
    int nM, nN, nwg, G, c;
    __device__ void init(int nM_, int nN_, int G_, int c_) { nM = nM_; nN = nN_; nwg = nM * nN; G = G_; c = c_; }
    __device__ bool get(int i, int& pm, int& pn) const {
        const long L = (long)i * G + c; if (L >= nwg) return false;
        int wgid = (int)L; { const int q = nwg / NXCD, r = nwg % NXCD, xcd = wgid % NXCD, off = wgid / NXCD; wgid = (xcd < r ? xcd * (q + 1) : r * (q + 1) + (xcd - r) * q) + off; }
        const int nig = WGM * nN, gid = wgid / nig, fm = gid * WGM, gsz = (nM - fm) < WGM ? (nM - fm) : WGM;
        pm = fm + ((wgid % nig) % gsz); pn = (wgid % nig) / gsz; return true;
    }
};

__device__ __forceinline__ unsigned cvt_pk_bf16(float lo, float hi) { unsigned r; asm volatile("v_cvt_pk_bf16_f32 %0, %1, %2" : "=v"(r) : "v"(lo), "v"(hi)); return r; }

template <class Epi, class Sched, bool GATHER = false, bool FP8 = false, int ALAY = 0>
__device__ __forceinline__ void gemm_phase(LAS unsigned char* lds, const int K, const Sched& S, const Epi& E) {
    int tid = threadIdx.x; asm volatile("" : "+v"(tid));
    const int wid = __builtin_amdgcn_readfirstlane(tid >> 6), lane = tid & 63, wr = wid >> 2, wc = wid & 3, fr = lane & 15, fq = lane >> 4;
    constexpr unsigned ROWB = FP8 ? 1024u : 2048u;
    const int nt = FP8 ? K / 128 : K / BK;
    unsigned voffA[2], voffB[2]; int RA[2], CA[2];
#pragma unroll
    for (int i = 0; i < 2; ++i) { int R, C; stage_rc(tid * 16 + i * 8192, R, C); const int Rb = (R & ~31) + perm32(R & 31);
        voffA[i] = ALAY ? (unsigned)(C >> 3) * (unsigned)(MTOK * 16) + (unsigned)R * 16u : (unsigned)R * ROWB + (unsigned)C * 2u; voffB[i] = (unsigned)Rb * ROWB + (unsigned)C * 2u; RA[i] = R; CA[i] = C; }
    const size_t kstep = (size_t)(BK * 2);
    const size_t kstepA = ALAY ? (size_t)8 * MTOK * 16 : kstep;
    const size_t hstepB = (size_t)HALF * ROWB;
    const size_t hstepA = GATHER ? 0 : (ALAY ? (size_t)HALF * 16 : (size_t)HALF * ROWB);
    const unsigned ldsw = (unsigned)wid * 1024u;
    const int aoff0 = lds_byte(wr * 64 + fr, fq * 8);
    const int boff0 = lds_byte(wc * 32 + fr, fq * 8);
    unsigned aB = (unsigned)(uintptr_t)lds + (unsigned)aoff0, bB = (unsigned)(uintptr_t)lds + 4u * HTB + (unsigned)boff0; asm volatile("" : "+v"(aB), "+v"(bB));
    constexpr int KOFF = 1024;
#define PG8_SA(b, h) (((b) * 2 + (h)) * HTB)
#define PG8_SB(b, h) ((4 + (b) * 2 + (h)) * HTB)
#define PG8_STAGE(bufoff, gbase, voff) do { _Pragma("unroll") for (int _i = 0; _i < 2; ++_i) \
        __builtin_amdgcn_global_load_lds((const unsigned*)((const char*)(gbase) + (voff)[_i]), (LAS unsigned*)(lds + (bufoff) + ldsw + _i * 8192), 16, 0, 0); } while (0)
#define PG8_LD32(base, off0) __builtin_shufflevector(*(const LAS v4i_t*)((base) + (unsigned)(off0)), *(const LAS v4i_t*)((base) + (unsigned)((off0) + KOFF)), 0, 1, 2, 3, 4, 5, 6, 7)
#define PG8_LDA(dst, b, h) do { if constexpr (FP8) { _Pragma("unroll") for (int m = 0; m < 4; ++m) dst##8[m] = PG8_LD32(aB, PG8_SA(b, h) + m * 2048); } else { _Pragma("unroll") for (int m = 0; m < 4; ++m) _Pragma("unroll") for (int k = 0; k < 2; ++k) dst[m][k] = *(const LAS bf16x8*)(aB + (unsigned)(PG8_SA(b, h) + m * 2048 + k * KOFF)); } } while (0)
#define PG8_LDB(dst, b, h) do { if constexpr (FP8) { _Pragma("unroll") for (int n = 0; n < 2; ++n) dst##8[n] = PG8_LD32(bB, PG8_SA(b, h) + n * 2048); } else { _Pragma("unroll") for (int n = 0; n < 2; ++n) _Pragma("unroll") for (int k = 0; k < 2; ++k) dst[n][k] = *(const LAS bf16x8*)(bB + (unsigned)(PG8_SA(b, h) + n * 2048 + k * KOFF)); } } while (0)
#define PG8_MMA(ai, bj, At, Bt) do { __builtin_amdgcn_s_setprio(1); _Pragma("unroll") for (int m = 0; m < 4; ++m) _Pragma("unroll") for (int n = 0; n < 2; ++n) { \
        if constexpr (FP8) asm volatile("v_mfma_scale_f32_16x16x128_f8f6f4 %0, %1, %2, %0, %3, %3 op_sel_hi:[0,0,0]" : "+v"(acc[ai][bj][m][n]) : "v"(Bt##8[n]), "v"(At##8[m]), "v"(sc8)); \
        else { _Pragma("unroll") for (int k = 0; k < 2; ++k) acc[ai][bj][m][n] = __builtin_amdgcn_mfma_f32_16x16x32_bf16(Bt[n][k], At[m][k], acc[ai][bj][m][n], 0, 0, 0); } } __builtin_amdgcn_s_setprio(0); } while (0)
#define PG8_WAIT_V(n) asm volatile("s_waitcnt vmcnt(" #n ")" ::: "memory")
#define PG8_WAIT_L(n) asm volatile("s_waitcnt lgkmcnt(" #n ")" ::: "memory")
#define PG8_BAR __builtin_amdgcn_s_barrier()
#define PG8_SCHED __builtin_amdgcn_sched_barrier(0)
    Unit cur, nxt; int ui = 0;
    if (!S.next(0, cur)) return;
    f32x4 acc[2][2][4][2];
#pragma unroll
    for (int a = 0; a < 2; ++a)
#pragma unroll
        for (int b = 0; b < 2; ++b)
#pragma unroll
            for (int m = 0; m < 4; ++m)
#pragma unroll
                for (int n = 0; n < 2; ++n) acc[a][b][m][n] = (f32x4){0.f, 0.f, 0.f, 0.f};
    typedef int v8i_t __attribute__((ext_vector_type(8)));
    bf16x8 At[4][2], B0[2][2], B1[2][2]; v8i_t At8[4], B08[2], B18[2];
    int sc8 = 0x7f7f7f7f; asm volatile("" : "+v"(sc8));
    const char* cA = cur.a; const char* cB = cur.b;
    unsigned vA0[2], vA1[2], nA0[2], nA1[2];
    if constexpr (GATHER) { const int* rw = S.rows(cur);
#pragma unroll
        for (int i = 0; i < 2; ++i) { vA0[i] = (unsigned)Sched::rowmap(rw[RA[i]]) * ROWB + (unsigned)CA[i] * 2u; vA1[i] = (unsigned)Sched::rowmap(rw[128 + RA[i]]) * ROWB + (unsigned)CA[i] * 2u; nA0[i] = vA0[i]; nA1[i] = vA1[i]; } }
    else {
#pragma unroll
        for (int i = 0; i < 2; ++i) { vA0[i] = voffA[i]; vA1[i] = voffA[i]; nA0[i] = voffA[i]; nA1[i] = voffA[i]; } }
    cur.par = 0; if constexpr (epi_has_pre<Epi>::value) E.pre(cur, wid, lane);
    PG8_STAGE(PG8_SB(0, 0), cB, voffB); PG8_STAGE(PG8_SB(0, 1), cB + hstepB, voffB); PG8_STAGE(PG8_SA(0, 0), cA, vA0); PG8_STAGE(PG8_SA(0, 1), cA + hstepA, vA1);
    if (wr == 1) PG8_BAR;
    PG8_WAIT_V(2); PG8_BAR;
    PG8_STAGE(PG8_SB(1, 0), cB + kstep, voffB); PG8_STAGE(PG8_SA(1, 0), cA + kstepA, vA0); PG8_STAGE(PG8_SB(1, 1), cB + hstepB + kstep, voffB);
    PG8_WAIT_V(6); PG8_BAR;
    for (;;) {
        const bool has_next = S.next(ui + 1, nxt);
        const char* nA = has_next ? nxt.a : cA; const char* nB = has_next ? nxt.b : cB;
        int ri[4] = {0, 0, 0, 0};
        if constexpr (GATHER) { if (has_next) { const int* rw = S.rows(nxt);
#pragma unroll
            for (int i = 0; i < 4; ++i) { const int* pp = rw + (i >> 1) * 128 + RA[i & 1]; asm volatile("global_load_dword %0, %1, off" : "=v"(ri[i]) : "v"(pp) : "memory"); } } }
#pragma nounroll
        for (int t = 0; t < nt; t += 2) {
            const bool last = (t == nt - 2);
            if constexpr (GATHER) { if (last && has_next) { asm volatile("s_waitcnt vmcnt(8) ; ROWIDX" : "+v"(ri[0]), "+v"(ri[1]), "+v"(ri[2]), "+v"(ri[3]) :: "memory");
#pragma unroll
                for (int i = 0; i < 2; ++i) { nA0[i] = (unsigned)Sched::rowmap(ri[i]) * ROWB + (unsigned)CA[i] * 2u; nA1[i] = (unsigned)Sched::rowmap(ri[2 + i]) * ROWB + (unsigned)CA[i] * 2u; } } }
            const char* a1 = cA + (size_t)(t + 1) * kstepA;
            const char* a2 = last ? nA : cA + (size_t)(t + 2) * kstepA; const char* b2 = last ? nB : cB + (size_t)(t + 2) * kstep;
            const char* a3 = a2 + kstepA; const char* b3 = b2 + kstep;
            unsigned w0[2], w1[2];
#pragma unroll
            for (int i = 0; i < 2; ++i) { w0[i] = last ? nA0[i] : vA0[i]; w1[i] = last ? nA1[i] : vA1[i]; }
            PG8_LDB(B0, 0, 0); PG8_LDB(B1, 0, 1); PG8_SCHED; PG8_LDA(At, 0, 0); PG8_STAGE(PG8_SA(1, 1), a1 + hstepA, vA1);
            PG8_WAIT_V(8); PG8_WAIT_L(0); PG8_BAR; PG8_MMA(0, 0, At, B0); PG8_MMA(0, 1, At, B1); PG8_BAR; PG8_SCHED;
            PG8_LDA(At, 0, 1); PG8_STAGE(PG8_SB(0, 0), b2, voffB); PG8_STAGE(PG8_SB(0, 1), b2 + hstepB, voffB); PG8_STAGE(PG8_SA(0, 0), a2, w0);
            PG8_WAIT_V(8); PG8_WAIT_L(0); PG8_BAR; PG8_MMA(1, 0, At, B0); PG8_MMA(1, 1, At, B1); PG8_BAR; PG8_SCHED;
            PG8_LDB(B0, 1, 0); PG8_LDB(B1, 1, 1); PG8_SCHED; PG8_LDA(At, 1, 0); PG8_STAGE(PG8_SA(0, 1), a2 + hstepA, w1);
            PG8_WAIT_V(8); PG8_WAIT_L(0); PG8_BAR; PG8_MMA(0, 0, At, B0); PG8_MMA(0, 1, At, B1); PG8_BAR; PG8_SCHED;
            PG8_LDA(At, 1, 1); PG8_STAGE(PG8_SB(1, 0), b3, voffB); PG8_STAGE(PG8_SB(1, 1), b3 + hstepB, voffB); PG8_STAGE(PG8_SA(1, 0), a3, w0);
            PG8_WAIT_V(8); PG8_WAIT_L(0); PG8_BAR; PG8_MMA(1, 0, At, B0); PG8_MMA(1, 1, At, B1); PG8_BAR; PG8_SCHED;
        }
        if constexpr (epi_has_pre<Epi>::value) { if (has_next) { nxt.par = (ui + 1) & 1; E.pre(nxt, wid, lane); } }
        if (wr == 0) PG8_BAR;
        if constexpr (FP8) asm volatile("s_nop 15\n\ts_nop 15" ::: "memory");
        E(acc, cur, wr, wc, fr, fq);
        if (!has_next) break;
#pragma unroll
        for (int a = 0; a < 2; ++a)
#pragma unroll
            for (int b = 0; b < 2; ++b)
#pragma unroll
                for (int m = 0; m < 4; ++m)
#pragma unroll
                    for (int n = 0; n < 2; ++n) acc[a][b][m][n] = (f32x4){0.f, 0.f, 0.f, 0.f};
        cur = nxt; cA = nA; cB = nB; ++ui;
#pragma unroll
        for (int i = 0; i < 2; ++i) { vA0[i] = nA0[i]; vA1[i] = nA1[i]; }
        if (wr == 1) PG8_BAR;
    }
    PG8_WAIT_V(0);
    PG8_BAR;
#undef PG8_SA
#undef PG8_SB
#undef PG8_STAGE
#undef PG8_LDA
#undef PG8_LDB
#undef PG8_MMA
#undef PG8_LD32
#undef PG8_WAIT_V
#undef PG8_WAIT_L
#undef PG8_BAR
#undef PG8_SCHED
}
}
namespace attn_body {
using bf16=__hip_bfloat16;
using bf16x8=__attribute__((ext_vector_type(8)))short;
using s16x4=__attribute__((ext_vector_type(4)))short;
using f32x16=__attribute__((ext_vector_type(16)))float;
using u32x4=__attribute__((ext_vector_type(4)))unsigned;
constexpr int BATCH=16,NHEAD=16,SEQ=2048,D=64,DM=NHEAD*D;
constexpr int NW=8,QBLK=32,QB=QBLK*NW,KVBLK=64,NQB=SEQ/QB;
constexpr int ATTN_PITCH=DM, ATTN_UNIT_ROWS=QB;
__device__ __forceinline__ int crow(int r,int hi){return (r&3)+8*(r>>2)+4*hi;}
#define SBAR() __builtin_amdgcn_sched_barrier(0)
__device__ __forceinline__ void cmask(f32x16&p0,f32x16&p1,int jb,int qrel,int hi){
  const float NEG=-INFINITY; int kb=64*jb+4*hi;
  #pragma unroll
  for(int r=0;r<16;++r){int kv=kb+(r&3)+8*(r>>2); if(kv>qrel)p0[r]=NEG; if(kv+32>qrel)p1[r]=NEG;}
}

constexpr int NSLOT=3, SLOTB=8192;
constexpr int LDS_K=0, LDS_V=NSLOT*SLOTB, LDS_WS=2*NSLOT*SLOTB, LDS_OST=LDS_WS+NW*64*4, LDS_BYTES=LDS_OST+NW*4096;
constexpr float C2=0.125f*1.4426950408889634f;
__device__ __forceinline__ void glds16(const void*gsrc,unsigned lds_dst){unsigned keep;
  asm volatile("s_mov_b32 %0, m0\n\ts_mov_b32 m0, %2\n\ts_nop 0\n\tglobal_load_lds_dwordx4 %1, off\n\ts_mov_b32 m0, %0":"=&s"(keep):"v"(gsrc),"s"(lds_dst):"memory");}
__device__ __forceinline__ float max3f(float a,float b,float c){float r;asm("v_max3_f32 %0, %1, %2, %3":"=v"(r):"v"(a),"v"(b),"v"(c));return r;}
__device__ __forceinline__ float max2f(float a,float b){float r;asm("v_max_f32_e32 %0, %1, %2":"=v"(r):"v"(a),"v"(b));return r;}
__device__ __forceinline__ float fadd_s(float a,float b){float r;asm("v_add_f32_e32 %0, %1, %2":"=v"(r):"v"(a),"v"(b));return r;}
__device__ __forceinline__ float fsub_s(float a,float b){float r;asm("v_sub_f32_e32 %0, %1, %2":"=v"(r):"v"(a),"v"(b));return r;}
typedef float f32x2_t __attribute__((ext_vector_type(2))); typedef __bf16 bf16x2_t __attribute__((ext_vector_type(2)));
__device__ __forceinline__ unsigned cvtpk_s(float lo,float hi){f32x2_t v={lo,hi};bf16x2_t b=__builtin_convertvector(v,bf16x2_t);return __builtin_bit_cast(unsigned,b);}
#define WAIT_BAR(N) asm volatile("s_waitcnt vmcnt(" #N ") lgkmcnt(0)\n\ts_barrier":::"memory")

__device__ __forceinline__ void qkt(f32x16&p0,f32x16&p1,const char*Kslot,const bf16x8*qr,const f32x16&negm,int r32,int hi){
  const char*kb=Kslot+hi*1024+r32*16;
  #pragma unroll
  for(int d0=0;d0<4;++d0){
    const bf16x8 b0=*reinterpret_cast<const bf16x8*>(kb+d0*2048);
    const bf16x8 b1=*reinterpret_cast<const bf16x8*>(kb+d0*2048+512);
    if(d0==0){p0=__builtin_amdgcn_mfma_f32_32x32x16_bf16(b0,qr[0],negm,0,0,0);p1=__builtin_amdgcn_mfma_f32_32x32x16_bf16(b1,qr[0],negm,0,0,0);}
    else{p0=__builtin_amdgcn_mfma_f32_32x32x16_bf16(b0,qr[d0],p0,0,0,0);p1=__builtin_amdgcn_mfma_f32_32x32x16_bf16(b1,qr[d0],p1,0,0,0);}}
}
typedef __attribute__((address_space(3))) const char* lds_cptr;
typedef short v4i16_t __attribute__((ext_vector_type(4)));
__device__ __forceinline__ void kload8(bf16x8*kf,lds_cptr kp){
  kf[0]=*(const __attribute__((address_space(3))) bf16x8*)(kp);      kf[1]=*(const __attribute__((address_space(3))) bf16x8*)(kp+512);
  kf[2]=*(const __attribute__((address_space(3))) bf16x8*)(kp+2048); kf[3]=*(const __attribute__((address_space(3))) bf16x8*)(kp+2560);
  kf[4]=*(const __attribute__((address_space(3))) bf16x8*)(kp+4096); kf[5]=*(const __attribute__((address_space(3))) bf16x8*)(kp+4608);
  kf[6]=*(const __attribute__((address_space(3))) bf16x8*)(kp+6144); kf[7]=*(const __attribute__((address_space(3))) bf16x8*)(kp+6656);
}
__device__ __forceinline__ void kload2(bf16x8*kf,lds_cptr kp,int j){ kf[2*j]=*(const __attribute__((address_space(3))) bf16x8*)(kp+j*2048); kf[2*j+1]=*(const __attribute__((address_space(3))) bf16x8*)(kp+j*2048+512); }
__device__ __forceinline__ s16x4 vtr(lds_cptr p){ return __builtin_bit_cast(s16x4,__builtin_amdgcn_ds_read_tr16_b64_v4i16((__attribute__((address_space(3))) v4i16_t*)p)); }
__device__ __forceinline__ float rowmax(const f32x16&p0,const f32x16&p1){
  float a=max3f(p0[0],p0[1],p1[0]),b=max3f(p0[2],p0[3],p1[1]);a=max3f(a,p1[2],p1[3]);
  #pragma unroll
  for(int r=4;r<16;r+=4){a=max3f(a,p0[r],p0[r+1]);b=max3f(b,p0[r+2],p0[r+3]);a=max3f(a,p1[r],p1[r+1]);b=max3f(b,p1[r+2],p1[r+3]);}
  const float m=max2f(a,b);
  auto rr=__builtin_amdgcn_permlane32_swap(__float_as_uint(m),__float_as_uint(m),false,false);
  return max2f(__uint_as_float(rr[0]),__uint_as_float(rr[1]));
}
__device__ __forceinline__ void pv(f32x16*o,int vb,bf16x8 pa0,bf16x8 pa1,bf16x8 pa2,bf16x8 pa3){
  #pragma unroll
  for(int d0=0;d0<2;++d0){s16x4 lo[4],hi[4];
    #pragma unroll
    for(int ks=0;ks<4;++ks){
      asm volatile("ds_read_b64_tr_b16 %0,%1 offset:%c2":"=&v"(lo[ks]):"v"(vb),"i"(d0*4096+ks*1024):"memory");
      asm volatile("ds_read_b64_tr_b16 %0,%1 offset:%c2":"=&v"(hi[ks]):"v"(vb),"i"(d0*4096+ks*1024+512):"memory");}
    asm volatile("s_waitcnt lgkmcnt(0)":::"memory");SBAR();
    #define PK(k) (bf16x8){lo[k][0],lo[k][1],lo[k][2],lo[k][3],hi[k][0],hi[k][1],hi[k][2],hi[k][3]}
    o[d0]=__builtin_amdgcn_mfma_f32_32x32x16_bf16(pa0,PK(0),o[d0],0,0,0);
    o[d0]=__builtin_amdgcn_mfma_f32_32x32x16_bf16(pa1,PK(1),o[d0],0,0,0);
    o[d0]=__builtin_amdgcn_mfma_f32_32x32x16_bf16(pa2,PK(2),o[d0],0,0,0);
    o[d0]=__builtin_amdgcn_mfma_f32_32x32x16_bf16(pa3,PK(3),o[d0],0,0,0);
    #undef PK
  }
}

#ifndef ATTN_STORE16
#define ATTN_STORE16(p,v) (*(u32x4*)(p)=(v))
#endif
template<int THRL> __device__ __forceinline__ void attn_unit(int b,int h,int qb,const bf16*Q,const bf16*__restrict__ K,const bf16*__restrict__ V,bf16*O,char*shm){
  const int tid=threadIdx.x,lane=tid&63,r32=lane&31,hi=lane>>5; const int wid=__builtin_amdgcn_readfirstlane(tid>>6);
  const long rowbase=(long)b*SEQ; const int q0=qb*QB;
  const bf16*Qw=Q+(rowbase+q0+wid*QBLK)*DM+h*D;
  const bf16*Kh=K+rowbase*DM+h*D,*Vh=V+rowbase*DM+h*D;
  const unsigned lds0=(unsigned)(uintptr_t)shm;
  float*wsf=(float*)(shm+LDS_WS)+wid*64;
  const bf16*ksrc=Kh+(long)lane*DM+wid*8;
  const bf16*vsrc=Vh+(long)(16*(wid&3)+(lane>>2))*DM+(wid>>2)*32+(lane&3)*8;
  const unsigned kdst=lds0+LDS_K+wid*1024, vdst=lds0+LDS_V+wid*1024;
  #define DMA_K(t,slot) glds16(ksrc+(long)(t)*KVBLK*DM,(unsigned)__builtin_amdgcn_readfirstlane(kdst+(slot)))
  #define DMA_V(t,slot) glds16(vsrc+(long)(t)*KVBLK*DM,(unsigned)__builtin_amdgcn_readfirstlane(vdst+(slot)))
  const int vb0=(int)(lds0+LDS_V)+((lane>>4)&1)*32+(lane&3)*8+(4*hi+((lane&15)>>2))*64;
  const char*Kbase=shm+LDS_K; bf16x8 kf[8];
  const lds_cptr shm3=(lds_cptr)shm; const lds_cptr kp0=shm3+LDS_K+hi*1024+r32*16; const lds_cptr vp0=shm3+LDS_V+((lane>>4)&1)*32+(lane&3)*8+(4*hi+((lane&15)>>2))*64;
  const int NT=(q0+QB)/KVBLK;
  DMA_K(0,0);DMA_V(0,0);DMA_K(1,SLOTB);
  bf16x8 qr[4];
  #pragma unroll
  for(int d0=0;d0<4;++d0)qr[d0]=*reinterpret_cast<const bf16x8*>(&Qw[(long)r32*DM+d0*16+hi*8]);
  float mhat=0.f,l_reg=0.f;f32x16 o[2];o[0]=f32x16{};o[1]=f32x16{};f32x16 negm=f32x16{};asm volatile("":"+v"(negm));
  const int qrel=wid*QBLK+r32;
  #define CMASK(P0,P1,t) do{int jb_=(t)-(NT-4); if(jb_>=0)cmask(P0,P1,jb_,qrel,hi);}while(0)
  bool resc=false;
  #define START(P0,P1) do{ const float rm=rowmax(P0,P1); resc=false; \
    { const float dl=rm; mhat=fadd_s(mhat,dl); \
      _Pragma("unroll") for(int r=0;r<16;++r){P0[r]=fsub_s(P0[r],dl);P1[r]=fsub_s(P1[r],dl);} \
      _Pragma("unroll") for(int r=0;r<16;++r)negm[r]=-mhat; asm volatile("":"+v"(negm)); } \
    _Pragma("unroll") for(int r=0;r<16;++r)P0[r]=__builtin_amdgcn_exp2f(P0[r]); }while(0)
  #define RESC() do{ if(resc){ asm volatile("s_waitcnt lgkmcnt(0)":::"memory"); \
      _Pragma("unroll") for(int d_=0;d_<2;++d_) _Pragma("unroll") for(int r=0;r<16;++r)o[d_][r]*=wsf[crow(r,hi)]; } }while(0)
  f32x16 pA0,pA1,pB0,pB1;
  int sl_prev=0,sl_cur=0,sl_next=SLOTB;
  #define ROT() do{sl_prev=sl_cur;sl_cur=sl_next;sl_next=(sl_next==(NSLOT-1)*SLOTB)?0:sl_next+SLOTB;}while(0)
  DMA_K(2,2*SLOTB);
  WAIT_BAR(3);
  qkt(pA0,pA1,Kbase,qr,negm,r32,hi);asm volatile("s_nop 15\n\ts_nop 7":"+v"(pA0),"+v"(pA1));CMASK(pA0,pA1,0);
  START(pA0,pA1);
  _Pragma("unroll") for(int r=0;r<16;++r)pA1[r]=__builtin_amdgcn_exp2f(pA1[r]);
  WAIT_BAR(0);
  DMA_K(3,0);DMA_V(1,SLOTB);
  ROT();
  kload8(kf,kp0+sl_cur);
  WAIT_BAR(2);
  s16x4 vlo[8],vhi[8]; u32x4 pw0,pw1,pw2,pw3;
  #define PKW(P,B) cvtpk_s(P[B],P[B+1])
  #define PAF(k) __builtin_bit_cast(bf16x8,pw##k)
  #define VFR(i) (bf16x8){vlo[i][0],vlo[i][1],vlo[i][2],vlo[i][3],vhi[i][0],vhi[i][1],vhi[i][2],vhi[i][3]}
  #define PIN(x) asm volatile("":"+v"(x))
  #define MX3(a,b,c) __builtin_fmaxf(__builtin_fmaxf((a),(b)),(c))
  #define GAPA(MF,A0,A1,A2,A3,W0,W1,PW) do{ MF; sacc+=A0; sacc+=A1; sacc+=A2; sacc+=A3; PIN(sacc); W0; W1; PIN(PW); SBAR(); }while(0)
  #define EX(v) __builtin_amdgcn_exp2f(v)
  #define GAPB(MF,X,B) do{ MF; X[B]=EX(X[B]); X[B+1]=EX(X[B+1]); X[B+2]=EX(X[B+2]); X[B+3]=EX(X[B+3]); PIN(X); SBAR(); }while(0)
  #define VRD(i) do{ vlo[i]=vtr(vp_+(((i)>>2)*4096+((i)&3)*1024)); vhi[i]=vtr(vp_+(((i)>>2)*4096+((i)&3)*1024+512)); }while(0)
  #define KRD(G,j) do{ if(G){ kload2(kf,kp0+sl_next,j); SBAR(); } }while(0)
  #define STEP(C0,C1,P0,P1,t,GK,GV,GL) do{ SBAR(); \
    const lds_cptr vp_=vp0+sl_prev; \
    VRD(0); SBAR(); float sacc=(P0[0]+P0[1]); \
    GAPA(C0=__builtin_amdgcn_mfma_f32_32x32x16_bf16(kf[0],qr[0],negm,0,0,0), P0[2],P0[3],P0[4],P0[5],     pw0[0]=PKW(P0,0), pw0[1]=PKW(P0,2), pw0); \
    VRD(4); SBAR(); GAPA(C1=__builtin_amdgcn_mfma_f32_32x32x16_bf16(kf[1],qr[0],negm,0,0,0), P0[6],P0[7],P0[8],P0[9],     pw0[2]=PKW(P0,4), pw0[3]=PKW(P0,6), pw0); \
    VRD(1); SBAR(); GAPA(C0=__builtin_amdgcn_mfma_f32_32x32x16_bf16(kf[2],qr[1],C0,0,0,0),   P0[10],P0[11],P0[12],P0[13], pw1[0]=PKW(P0,8), pw1[1]=PKW(P0,10), pw1); \
    VRD(5); SBAR(); GAPA(C1=__builtin_amdgcn_mfma_f32_32x32x16_bf16(kf[3],qr[1],C1,0,0,0),   P0[14],P0[15],P1[0],P1[1],   pw1[2]=PKW(P0,12),pw1[3]=PKW(P0,14), pw1); \
    VRD(2); SBAR(); GAPA(C0=__builtin_amdgcn_mfma_f32_32x32x16_bf16(kf[4],qr[2],C0,0,0,0),   P1[2],P1[3],P1[4],P1[5],     pw2[0]=PKW(P1,0), pw2[1]=PKW(P1,2), pw2); \
    VRD(6); SBAR(); GAPA(C1=__builtin_amdgcn_mfma_f32_32x32x16_bf16(kf[5],qr[2],C1,0,0,0),   P1[6],P1[7],P1[8],P1[9],     pw2[2]=PKW(P1,4), pw2[3]=PKW(P1,6), pw2); \
    VRD(3); SBAR(); GAPA(C0=__builtin_amdgcn_mfma_f32_32x32x16_bf16(kf[6],qr[3],C0,0,0,0),   P1[10],P1[11],P1[12],P1[13], pw3[0]=PKW(P1,8), pw3[1]=PKW(P1,10), pw3); \
    VRD(7); SBAR(); GAPA(C1=__builtin_amdgcn_mfma_f32_32x32x16_bf16(kf[7],qr[3],C1,0,0,0),   P1[14],P1[15],0.f,0.f,       pw3[2]=PKW(P1,12),pw3[3]=PKW(P1,14), pw3); \
    l_reg+=sacc; \
    if(GK){DMA_K((t)+3,sl_cur);} if(GV){DMA_V((t)+1,sl_next);} \
    CMASK(C0,C1,t); \
    { float a=MX3(C0[0],C0[1],C1[0]),b=MX3(C0[2],C0[3],C1[1]); a=MX3(a,C1[2],C1[3]); \
      _Pragma("unroll") for(int r=4;r<16;r+=4){a=MX3(a,C0[r],C0[r+1]);b=MX3(b,C0[r+2],C0[r+3]);a=MX3(a,C1[r],C1[r+1]);b=MX3(b,C1[r+2],C1[r+3]);} \
      float rm=__builtin_fmaxf(a,b); { auto rr=__builtin_amdgcn_permlane32_swap(__float_as_uint(rm),__float_as_uint(rm),false,false); rm=__builtin_fmaxf(__uint_as_float(rr[0]),__uint_as_float(rr[1])); } \
      resc=false; \
      if(__builtin_expect(__any(rm>(float)THRL),0)){ const float dl=__builtin_fmaxf(rm,0.f); mhat+=dl; \
        _Pragma("unroll") for(int r=0;r<16;++r){C0[r]-=dl;C1[r]-=dl;} \
        _Pragma("unroll") for(int r=0;r<16;++r)negm[r]=-mhat; asm volatile("":"+v"(negm)); \
        const float f=__builtin_amdgcn_exp2f(-dl); l_reg*=f; if(hi==0)wsf[r32]=f; resc=true; } } \
    SBAR(); \
    GAPB(o[0]=__builtin_amdgcn_mfma_f32_32x32x16_bf16(PAF(0),VFR(0),o[0],0,0,0), C0,0); \
    GAPB(o[1]=__builtin_amdgcn_mfma_f32_32x32x16_bf16(PAF(0),VFR(4),o[1],0,0,0), C0,4); \
    KRD(GL,0); GAPB(o[0]=__builtin_amdgcn_mfma_f32_32x32x16_bf16(PAF(1),VFR(1),o[0],0,0,0), C0,8); \
    KRD(GL,1); GAPB(o[1]=__builtin_amdgcn_mfma_f32_32x32x16_bf16(PAF(1),VFR(5),o[1],0,0,0), C0,12); \
    KRD(GL,2); GAPB(o[0]=__builtin_amdgcn_mfma_f32_32x32x16_bf16(PAF(2),VFR(2),o[0],0,0,0), C1,0); \
    KRD(GL,3); GAPB(o[1]=__builtin_amdgcn_mfma_f32_32x32x16_bf16(PAF(2),VFR(6),o[1],0,0,0), C1,4); \
    GAPB(o[0]=__builtin_amdgcn_mfma_f32_32x32x16_bf16(PAF(3),VFR(3),o[0],0,0,0), C1,8); \
    GAPB(o[1]=__builtin_amdgcn_mfma_f32_32x32x16_bf16(PAF(3),VFR(7),o[1],0,0,0), C1,12); \
    }while(0)
  int t=1;
  #undef CMASK
  #define CMASK(P0,P1,t) do{}while(0)
  for(;t+5<NT;t+=2){
    STEP(pB0,pB1,pA0,pA1,t,true,true,true);     WAIT_BAR(2); RESC(); ROT();
    STEP(pA0,pA1,pB0,pB1,t+1,true,true,true);   WAIT_BAR(2); RESC(); ROT();
  }
  #undef CMASK
  #define CMASK(P0,P1,t) do{int jb_=(t)-(NT-4); if(jb_>=0)cmask(P0,P1,jb_,qrel,hi);}while(0)
  #define ENDW(tt) do{ if((tt)+3<NT){WAIT_BAR(2);} else if((tt)+2<NT){WAIT_BAR(1);} else {WAIT_BAR(0);} }while(0)
  for(;t+1<NT;t+=2){
    STEP(pB0,pB1,pA0,pA1,t,(t+3<NT),(t+1<NT),(t+1<NT));       ENDW(t);   RESC(); ROT();
    STEP(pA0,pA1,pB0,pB1,t+1,(t+4<NT),(t+2<NT),(t+2<NT));     ENDW(t+1); RESC(); ROT();
  }
  STEP(pB0,pB1,pA0,pA1,NT-1,false,false,false); RESC();
  { float sacc=pB0[0]+pB0[1]; _Pragma("unroll") for(int r=2;r<16;++r)sacc+=pB0[r]; _Pragma("unroll") for(int r=0;r<16;++r)sacc+=pB1[r]; l_reg+=sacc;
    pw0=(u32x4){PKW(pB0,0),PKW(pB0,2),PKW(pB0,4),PKW(pB0,6)};pw1=(u32x4){PKW(pB0,8),PKW(pB0,10),PKW(pB0,12),PKW(pB0,14)};pw2=(u32x4){PKW(pB1,0),PKW(pB1,2),PKW(pB1,4),PKW(pB1,6)};pw3=(u32x4){PKW(pB1,8),PKW(pB1,10),PKW(pB1,12),PKW(pB1,14)};
    SBAR(); pv(o,vb0+sl_cur,PAF(0),PAF(1),PAF(2),PAF(3)); }
  #undef PKW
  #undef PAF
  #undef VFR
  #undef PIN
  #undef MX3
  #undef GAPA
  #undef GAPB
  #undef EX
  #undef VRD
  #undef KRD
  #undef STEP
  #undef ENDW
  {auto rr=__builtin_amdgcn_permlane32_swap(__float_as_uint(l_reg),__float_as_uint(l_reg),false,false);l_reg=__uint_as_float(rr[0])+__uint_as_float(rr[1]);}
  if(hi==0)wsf[32+r32]=l_reg;asm volatile("s_waitcnt lgkmcnt(0)":::"memory");
  float rli[16];
  #pragma unroll
  for(int r=0;r<16;++r)rli[r]=__builtin_amdgcn_rcpf(wsf[32+crow(r,hi)]);
  bf16*Ow=O+(rowbase+q0+wid*QBLK)*DM+h*D;
  { bf16*stg=(bf16*)(shm+LDS_OST)+wid*2048;
    #pragma unroll
    for(int r=0;r<16;++r){const int orow=crow(r,hi);
      #pragma unroll
      for(int d0=0;d0<2;++d0)stg[orow*64+d0*32+r32]=__float2bfloat16(o[d0][r]*rli[r]);}
    asm volatile("s_waitcnt lgkmcnt(0)":::"memory");
    #pragma unroll
    for(int i=0;i<4;++i){const int row=i*8+(lane>>3),ch=lane&7; const u32x4 v=*(const u32x4*)(stg+row*64+ch*8); ATTN_STORE16(Ow+(long)row*DM+ch*8,v);} }
  asm volatile("s_waitcnt lgkmcnt(0)\n\ts_barrier":::"memory");
  #undef DMA_K
  #undef DMA_V
  #undef CMASK
  #undef START
  #undef RESC
  #undef ROT
}
constexpr int ATTN_LDS_BYTES=LDS_BYTES;
struct AttnTensors { const bf16* Q; const bf16* K; const bf16* V; bf16* O; };
struct AttnUnit { int bh; int qb; };
struct StaticOrder {
  int vcu;
  __device__ __forceinline__ explicit StaticOrder(int grid,int block):vcu((block%8)*(grid/8)+block/8){}
  __device__ __forceinline__ bool next(int i,AttnUnit&u)const{ if(i>=8)return false; const int pr=vcu&3; u.bh=(vcu>>2)*4+(i&3); u.qb=(i==0)?pr:(i==1)?pr:(i==2)?pr:(i==3)?pr:(i==4)?7-pr:(i==5)?7-pr:(i==6)?7-pr:7-pr; return true; }
  __device__ __forceinline__ void a_ready(const AttnUnit&)const{}
  __device__ __forceinline__ void done(const AttnUnit&)const{}
};
template<class Sched,int THRL=8> __device__ __forceinline__ void attn_phase(char*lds,const AttnTensors&T,const Sched&S){
  AttnUnit u;
  for(int i=0;S.next(i,u);++i){ S.a_ready(u); const int vhd=u.bh%NHEAD, hq=vhd>>1, hv=(vhd>>2)*2+(vhd&1);
    attn_unit<THRL>(u.bh/NHEAD,hq,u.qb,T.Q,T.K,T.V+(hv-hq)*D,T.O+(vhd-hq)*D,lds); S.done(u); }
}
#undef SBAR
#undef WAIT_BAR
}
#define XB_TMO      128
#define XB_XCNT(j)  (256  + 64 * (j))
#define XB_XSUB(j)  (1280 + 64 * (j))
#define XB_XGEN(j)  (2304 + 64 * (j))
#define XB_TOP      3328
#define XB_TOPGEN   3392
#define XCD_BAR_WORDS 3456
#define XB_SPIN_CAP (1u << 18)

__device__ __forceinline__ unsigned xb_ld(unsigned* p)              { return __hip_atomic_load(p, __ATOMIC_RELAXED, __HIP_MEMORY_SCOPE_AGENT); }
__device__ __forceinline__ unsigned xb_add(unsigned* p, unsigned v) { return __hip_atomic_fetch_add(p, v, __ATOMIC_RELAXED, __HIP_MEMORY_SCOPE_AGENT); }
__device__ __forceinline__ unsigned xb_xcc_id() { return (unsigned)__builtin_amdgcn_s_getreg((3 << 11) | 20) & 0xFu; }
#define XB_SPIN(cond, bar) do { unsigned _sp = 0; while (cond) { __builtin_amdgcn_s_sleep(1); \
    if ((++_sp & 255u) == 0u) { if (xb_ld(&(bar)[XB_TMO])) break; if (_sp > XB_SPIN_CAP) { atomicAdd(&(bar)[XB_TMO], 1u); break; } } } } while (0)

struct XcdBarrier {
    unsigned* bar; unsigned x;
    volatile LAS unsigned* st;
};

__device__ __forceinline__ XcdBarrier xcd_barrier_post(unsigned* bar, volatile LAS unsigned* st) {
    XcdBarrier b; b.bar = bar; b.x = xb_xcc_id(); b.st = st;
    if (threadIdx.x == 0) (void)xb_add(&bar[XB_XCNT(b.x)], 1u);
    return b;
}
__device__ __forceinline__ void xcd_barrier_complete(unsigned* bar, unsigned x, unsigned& nloc, unsigned& nx) {
    const unsigned G = gridDim.x * gridDim.y * gridDim.z;
    unsigned sum, cnt, mine, sp = 0u;
    for (;;) {
        sum = 0u; cnt = 0u; mine = 0u;
#pragma unroll
        for (unsigned j = 0; j < 16; ++j) { const unsigned c = xb_ld(&bar[XB_XCNT(j)]); sum += c; cnt += (c > 0u) ? 1u : 0u; mine = (j == x) ? c : mine; }
        if (sum == G) break;
        __builtin_amdgcn_s_sleep(1);
        if ((++sp & 255u) == 0u) { if (xb_ld(&bar[XB_TMO])) break; if (sp > XB_SPIN_CAP) { atomicAdd(&bar[XB_TMO], 1u); break; } }
    }
    nloc = mine > 0u ? mine : 1u; nx = cnt > 0u ? cnt : 1u;
}

__device__ __forceinline__ void xcd_barrier(const XcdBarrier& b) {
    asm volatile("s_waitcnt vmcnt(0)" ::: "memory");
    __syncthreads();
    if (threadIdx.x == 0) {
        unsigned* bar = b.bar;
        __builtin_amdgcn_s_waitcnt(0);
        unsigned nloc = b.st[0], nx = b.st[1];
        if (nloc == 0u) { xcd_barrier_complete(bar, b.x, nloc, nx); b.st[0] = nloc; b.st[1] = nx; }
        const unsigned old = xb_add(&bar[XB_XSUB(b.x)], 1u);
        const unsigned gen = old / nloc;
        if (old + 1u == (gen + 1u) * nloc) {
            __builtin_amdgcn_fence(__ATOMIC_RELEASE, "agent");
            asm volatile("s_waitcnt vmcnt(0)" ::: "memory");
            const unsigned og = xb_add(&bar[XB_TOP], 1u);
            const unsigned tg = og / nx;
            if (og + 1u == (tg + 1u) * nx) xb_add(&bar[XB_TOPGEN], 1u);
            else XB_SPIN(xb_ld(&bar[XB_TOPGEN]) == tg, bar);
            __builtin_amdgcn_fence(__ATOMIC_ACQUIRE, "agent");
            xb_add(&bar[XB_XGEN(b.x)], 1u);
            asm volatile("s_waitcnt vmcnt(0)" ::: "memory");
        } else {
            XB_SPIN(xb_ld(&bar[XB_XGEN(b.x)]) == gen, bar);
            __builtin_amdgcn_fence(__ATOMIC_ACQUIRE, "agent");
            asm volatile("s_waitcnt vmcnt(0)" ::: "memory");
        }
    }
    __syncthreads();
}

constexpr int NWAVES = 8;
struct Frame { LAS unsigned char* lds; volatile LAS unsigned* MISC; gu32* ctl; int wave, vcu, G; };
__device__ __forceinline__ int opaque_tid() { int t = (int)threadIdx.x; asm volatile("" : "+v"(t)); return t; }
#define FTID ((int)threadIdx.x)
#define FLANE ((int)(threadIdx.x & 63u))
struct Args { const float* in[53]; float* out; unsigned char* ws; int ph_lo, ph_hi, variant, pad; };
#define EPI_ARGS const f32x4 (&acc)[2][2][4][2], const pg8::Unit& u, int wr, int wc, int fr, int fq

__device__ __forceinline__ int maprow(int mode, int n) {
    if (mode == 0) return n;
    if (mode == 1) return (n >> 7) * 256 + (n & 127);
    if (mode == 2) return (n >> 7) * 256 + 128 + (n & 127);
    const int j = n & 1023; return (j >> 7) * 256 + ((n >> 10) << 7) + (j & 127);
}
__device__ __forceinline__ void tr_item(const float* W, int N, bf16* WT, int mode, LAS float* scr, int item, int lane) {
    const int nblk = N >> 5, kb = item / nblk, nb = item - kb * nblk, k0 = 64 * kb, n0 = 32 * nb;
#pragma unroll 8
    for (int i = 0; i < 32; ++i) { const int kk = 2 * i + (lane >> 5); scr[kk * 33 + (lane & 31)] = W[(size_t)(k0 + kk) * N + n0 + (lane & 31)]; }
    LDS_WAIT(); asm volatile("" ::: "memory");
    const int c = lane & 7; const int r0 = maprow(mode, n0);
#pragma unroll
    for (int j = 0; j < 4; ++j) { const int n = (lane >> 3) + 8 * j; const LAS float* s = scr + (8 * c) * 33 + n;
        v4u o; o.x = pk2(s[0 * 33], s[1 * 33]); o.y = pk2(s[2 * 33], s[3 * 33]); o.z = pk2(s[4 * 33], s[5 * 33]); o.w = pk2(s[6 * 33], s[7 * 33]);
        *(GAS v4u*)(WT + (size_t)(r0 + n) * 1024 + k0 + 8 * c) = o; }
    LDS_WAIT(); asm volatile("" ::: "memory");
}
__device__ __forceinline__ unsigned pk4_fp8(float a, float b, float c, float d) {
    a = __builtin_amdgcn_fmed3f(a, -448.f, 448.f); b = __builtin_amdgcn_fmed3f(b, -448.f, 448.f); c = __builtin_amdgcn_fmed3f(c, -448.f, 448.f); d = __builtin_amdgcn_fmed3f(d, -448.f, 448.f);
    int r = __builtin_amdgcn_cvt_pk_fp8_f32(a, b, 0, false); r = __builtin_amdgcn_cvt_pk_fp8_f32(c, d, r, true); return (unsigned)r; }
__device__ __forceinline__ void tr_item8(const float* W, int N, unsigned char* WT, int mode, float scale, LAS float* scr, int item, int lane) {
    const int nblk = N >> 5, kb = item / nblk, nb = item - kb * nblk, k0 = 128 * kb, n0 = 32 * nb;
#pragma unroll 8
    for (int i = 0; i < 64; ++i) { const int kk = 2 * i + (lane >> 5); scr[kk * 33 + (lane & 31)] = W[(size_t)(k0 + kk) * N + n0 + (lane & 31)] * scale; }
    LDS_WAIT(); asm volatile("" ::: "memory");
    const int c = lane & 7; const int r0 = maprow(mode, n0);
#pragma unroll
    for (int j = 0; j < 4; ++j) { const int n = (lane >> 3) + 8 * j; const LAS float* p = scr + (16 * c) * 33 + n;
        v4u o; o.x = pk4_fp8(p[0 * 33], p[1 * 33], p[2 * 33], p[3 * 33]); o.y = pk4_fp8(p[4 * 33], p[5 * 33], p[6 * 33], p[7 * 33]);
        o.z = pk4_fp8(p[8 * 33], p[9 * 33], p[10 * 33], p[11 * 33]); o.w = pk4_fp8(p[12 * 33], p[13 * 33], p[14 * 33], p[15 * 33]);
        *(GAS v4u*)(WT + (size_t)(r0 + n) * 1024 + k0 + 16 * c) = o; }
    LDS_WAIT(); asm volatile("" ::: "memory");
}
__device__ __forceinline__ void cvt_plain(const float* src, bf16* dst, size_t n, size_t gtid, size_t nth) {
    for (size_t i = gtid * 8; i < n; i += nth * 8) { const f32x4 a = *(const GAS f32x4*)(src + i), b = *(const GAS f32x4*)(src + i + 4);
        v4u o; o.x = pk2(a.x, a.y); o.y = pk2(a.z, a.w); o.z = pk2(b.x, b.y); o.w = pk2(b.z, b.w); *(GAS v4u*)(dst + i) = o; }
}
__device__ __forceinline__ void cvt_experts(Frame& F, const float* wup, const float* wdn, unsigned char* ws) {
    const int gw = F.vcu * NWAVES + F.wave, NGW = F.G * NWAVES;
#if MOE_FP8
    LAS float* tl = (LAS float*)F.lds;
    for (int it = F.vcu; it < NEXP * 96; it += F.G) { const int e = it / 96, r = it - e * 96; const bool up = r < 64; const int rr = up ? r : r - 64;
        const int N = up ? 2048 : 1024, nb = up ? (rr & 7) : (rr & 3), kb = up ? (rr >> 3) : (rr >> 2), k0 = 128 * kb, n0 = 256 * nb;
        const float* W = up ? wup + (size_t)e * 1024 * 2048 : wdn + (size_t)e * 1024 * 1024; unsigned char* WT = up ? ws + WS_WUP8 + (size_t)e * 2048 * 1024 : ws + WS_WDN8 + (size_t)e * 1024 * 1024;
        const float scale = up ? SWU8 : SWD8; const int mode = up ? 3 : 0;
        __syncthreads();
        f32x4 v[16];
#pragma unroll
        for (int i = 0; i < 16; ++i) { const int idx = i * 512 + FTID, row = idx >> 6, c4 = idx & 63; v[i] = *(const GAS f32x4*)(W + (size_t)(k0 + row) * N + n0 + 4 * c4); }
#pragma unroll
        for (int i = 0; i < 16; ++i) { const int idx = i * 512 + FTID, row = idx >> 6, c4 = idx & 63; *(LAS f32x4*)(tl + row * 260 + 4 * (c4 ^ (row >> 4))) = v[i] * scale; }
        __syncthreads();
#pragma unroll
        for (int j = 0; j < 4; ++j) { const int idx = j * 512 + FTID, n = idx >> 3, c = idx & 7; const LAS float* p = tl + (16 * c) * 260 + (n ^ (4 * c));
            v4u o; o.x = pk4_fp8(p[0 * 260], p[1 * 260], p[2 * 260], p[3 * 260]); o.y = pk4_fp8(p[4 * 260], p[5 * 260], p[6 * 260], p[7 * 260]);
            o.z = pk4_fp8(p[8 * 260], p[9 * 260], p[10 * 260], p[11 * 260]); o.w = pk4_fp8(p[12 * 260], p[13 * 260], p[14 * 260], p[15 * 260]);
            *(GAS v4u*)(WT + (size_t)maprow(mode, n0 + n) * 1024 + k0 + 16 * c) = o; }
    }
    __syncthreads();
    return;
#endif
    LAS float* scr = (LAS float*)(F.lds + F.wave * 16384);
    for (int it = gw; it < NEXP * 1536; it += NGW) { const int e = it / 1536, r = it - e * 1536;
        if (r < 1024) tr_item(wup + (size_t)e * 1024 * 2048, 2048, (bf16*)(ws + WS_WUP) + (size_t)e * 2048 * 1024, 3, scr, r, FLANE);
        else tr_item(wdn + (size_t)e * 1024 * 1024, 1024, (bf16*)(ws + WS_WDN) + (size_t)e * 1024 * 1024, 0, scr, r - 1024, FLANE); }
}
__device__ __forceinline__ void p0_prologue(Frame& F, const Args& a) {
    unsigned char* ws = a.ws;
    LAS float* scr = (LAS float*)(F.lds + F.wave * 16896);
    const int gw = F.vcu * NWAVES + F.wave, NGW = F.G * NWAVES;
    constexpr int I0 = 16 * 64, I1 = I0 + 16 * 80, I2 = I1 + 512, I3 = I2 + 512, I4 = I3 + 512, I5 = I4 + 256, I6 = I5 + 256, I7 = I6 + 256, I8 = I7 + 16, I9 = I8 + 16;
    for (int it = gw; it < I9; it += NGW) {
        if (it < I0) tr_item(a.in[2], 2048, (bf16*)(ws + WS_WKV), 0, scr, it, FLANE);
        else if (it < I1) tr_item(a.in[3], 2560, (bf16*)(ws + WS_WIN0), 0, scr, it - I0, FLANE);
        else if (it < I2) tr_item(a.in[13], 1024, (bf16*)(ws + WS_WOUT0), 0, scr, it - I1, FLANE);
        else if (it < I3) tr_item(a.in[17], 1024, (bf16*)(ws + WS_XOT), 0, scr, it - I2, FLANE);
        else if (it < I4) tr_item(a.in[42], 1024, (bf16*)(ws + WS_XOT) + 1024 * 1024, 0, scr, it - I3, FLANE);
        else if (it < I5) tr_item8(a.in[28], 1024, ws + WS_WIN1, 0, SWU8, scr, it - I4, FLANE);
        else if (it < I6) tr_item8(a.in[37], 1024, ws + WS_WVG, 1, SWD8, scr, it - I5, FLANE);
        else if (it < I7) tr_item8(a.in[38], 1024, ws + WS_WVG, 2, SWU8, scr, it - I6, FLANE);
        else if (it < I8) tr_item(a.in[20], 32, (bf16*)(ws + WS_WR), 0, scr, it - I7, FLANE);
        else tr_item(a.in[45], 32, (bf16*)(ws + WS_WR) + 256 * 1024, 0, scr, it - I8, FLANE);
    }
    cvt_experts(F, a.in[22], a.in[24], ws);
    const size_t gtid = (size_t)F.vcu * 512 + FTID, nth = (size_t)F.G * 512;
    cvt_plain(a.in[16], (bf16*)(ws + WS_XQB), 1024 * 1024, gtid, nth);
    cvt_plain(a.in[41], (bf16*)(ws + WS_XQB) + 1024 * 1024, 1024 * 1024, gtid, nth);
    cvt_plain(a.in[1], (bf16*)(ws + WS_MEMB), (size_t)NB * MEMLEN * DM, gtid, nth);
    cvt_plain(a.in[0], (bf16*)(ws + WS_XB), (size_t)MTOK * DM, gtid, nth);
}

__device__ __forceinline__ void moe_tables(Frame& F, gu32* cnt) {
    LAS int* tab = (LAS int*)(F.lds + TAB_OFF);
    if (FTID < 32) tab[FTID] = (int)__hip_atomic_load(cnt + FTID * 64, RLX_AGENT);
    __syncthreads();
    if (FTID == 0) { int s = 0; for (int e = 0; e < NEXP; ++e) { tab[32 + e] = s; s += (tab[e] + 255) >> 8; } tab[64] = s; }
    __syncthreads();
}

template <int MODE>
__device__ __forceinline__ void ph_ln(Frame& F, const bf16* zb, const bf16* ys, bf16* xb, float* outf, const float* g, const float* b, unsigned char* x8 = nullptr, const int* asg = nullptr, const float* gate = nullptr,
                                      const float* st2 = nullptr, const float* g2 = nullptr, const float* b2 = nullptr) {
    LAS const int* tab = (LAS const int*)(F.lds + TAB_OFF);
    const int gw = F.vcu * NWAVES + F.wave, NGW = F.G * NWAVES, c0 = 8 * FLANE;
    float gv[16], bv[16];
#pragma unroll
    for (int h = 0; h < 2; ++h)
#pragma unroll
        for (int q = 0; q < 2; ++q) { const f32x4 t = *(const GAS f32x4*)(g + c0 + 512 * h + 4 * q), s = *(const GAS f32x4*)(b + c0 + 512 * h + 4 * q);
            gv[8 * h + 4 * q + 0] = t.x; gv[8 * h + 4 * q + 1] = t.y; gv[8 * h + 4 * q + 2] = t.z; gv[8 * h + 4 * q + 3] = t.w;
            bv[8 * h + 4 * q + 0] = s.x; bv[8 * h + 4 * q + 1] = s.y; bv[8 * h + 4 * q + 2] = s.z; bv[8 * h + 4 * q + 3] = s.w; }
    constexpr bool REB = (MODE == 1) && MOE_FP8; float g2v[REB ? 16 : 1], b2v[REB ? 16 : 1];
    if constexpr (REB) {
#pragma unroll
        for (int h = 0; h < 2; ++h)
#pragma unroll
            for (int q = 0; q < 2; ++q) { const f32x4 t = *(const GAS f32x4*)(g2 + c0 + 512 * h + 4 * q), s = *(const GAS f32x4*)(b2 + c0 + 512 * h + 4 * q);
#pragma unroll
                for (int j = 0; j < 4; ++j) { g2v[8 * h + 4 * q + j] = ALPHA * t[j]; b2v[8 * h + 4 * q + j] = ALPHA * s[j]; } } }
    constexpr int RI = (MODE == 0) ? 4 : 2;
    for (int m0 = gw * RI; m0 < MTOK; m0 += NGW * RI) {
        v4u raw[RI][2]; v4u yr[(MODE == 1) ? RI : 1][2][4]; f32x4 gt[(MODE == 1) ? RI : 1]; f32x2 ms[RI];
#pragma unroll
        for (int r = 0; r < RI; ++r) { const size_t m = (size_t)(m0 + r); size_t yrow[4] = {0, 0, 0, 0};
            if constexpr (REB) ms[r] = *(const GAS f32x2*)(st2 + m * 2);
            if (MODE == 1) { const v4i_t as = *(const GAS v4i_t*)(asg + m * 4); gt[r] = *(const GAS f32x4*)(gate + m * 4);
#pragma unroll
                for (int k = 0; k < 4; ++k) yrow[k] = (size_t)(tab[32 + (as[k] >> 16)] * 256 + (as[k] & 0xffff)); }
#pragma unroll
            for (int h = 0; h < 2; ++h) {
                raw[r][h] = *(const GAS v4u*)(((MODE == 0 || REB) ? zb : xb) + m * DM + c0 + 512 * h);
                if (MODE == 1) {
#pragma unroll
                    for (int k = 0; k < 4; ++k) { const v2u t8 = *(const GAS v2u*)((const unsigned char*)ys + yrow[k] * DM + c0 + 512 * h); yr[r][h][k] = (v4u){t8.x, t8.y, 0u, 0u}; } } } }
#pragma unroll
        for (int r = 0; r < RI; ++r) { const size_t m = (size_t)(m0 + r);
            float v[16];
#pragma unroll
            for (int h = 0; h < 2; ++h) { const v4u w = raw[r][h]; const float sc = (MODE == 0) ? 1.0f : ALPHA;
                v[8 * h + 0] = sc * bflo(w.x); v[8 * h + 1] = sc * bfhi(w.x); v[8 * h + 2] = sc * bflo(w.y); v[8 * h + 3] = sc * bfhi(w.y); v[8 * h + 4] = sc * bflo(w.z); v[8 * h + 5] = sc * bfhi(w.z); v[8 * h + 6] = sc * bflo(w.w); v[8 * h + 7] = sc * bfhi(w.w);
                if constexpr (REB) { const float mu2 = ms[r][0] * ALPHA, rs2 = ms[r][1];
#pragma unroll
                    for (int j = 0; j < 8; ++j) v[8 * h + j] = (v[8 * h + j] - mu2) * rs2 * g2v[8 * h + j] * (1.0f / ALPHA) + b2v[8 * h + j]; }
                if (MODE == 1) {
#pragma unroll
                    for (int k = 0; k < 4; ++k) { const v4u y = yr[r][h][k]; const float gk = gt[r][k] * (1.0f / SY8);
                        const f32x2 p0 = __builtin_amdgcn_cvt_pk_f32_fp8((int)y.x, false), p1 = __builtin_amdgcn_cvt_pk_f32_fp8((int)y.x, true), p2 = __builtin_amdgcn_cvt_pk_f32_fp8((int)y.y, false), p3 = __builtin_amdgcn_cvt_pk_f32_fp8((int)y.y, true);
                        v[8 * h + 0] += gk * p0[0]; v[8 * h + 1] += gk * p0[1]; v[8 * h + 2] += gk * p1[0]; v[8 * h + 3] += gk * p1[1]; v[8 * h + 4] += gk * p2[0]; v[8 * h + 5] += gk * p2[1]; v[8 * h + 6] += gk * p3[0]; v[8 * h + 7] += gk * p3[1]; } } }
            float s = 0.f;
#pragma unroll
            for (int j = 0; j < 16; ++j) s += v[j];
            const float mean = wave_sum(s) * (1.f / DM); float s2 = 0.f;
#pragma unroll
            for (int j = 0; j < 16; ++j) { v[j] -= mean; s2 += v[j] * v[j]; }
            const float rstd = 1.f / sqrtf(wave_sum(s2) * (1.f / DM) + LN_EPS);
#pragma unroll
            for (int j = 0; j < 16; ++j) v[j] = v[j] * rstd * gv[j] + bv[j];
#pragma unroll
            for (int h = 0; h < 2; ++h) { v4u o; o.x = pk2(v[8 * h], v[8 * h + 1]); o.y = pk2(v[8 * h + 2], v[8 * h + 3]); o.z = pk2(v[8 * h + 4], v[8 * h + 5]); o.w = pk2(v[8 * h + 6], v[8 * h + 7]);
                if (!outf) *(GAS v4u*)(xb + m * DM + c0 + 512 * h) = o;
                if (x8) { v2u o8; o8.x = pk4_fp8(v[8 * h] * SX8, v[8 * h + 1] * SX8, v[8 * h + 2] * SX8, v[8 * h + 3] * SX8); o8.y = pk4_fp8(v[8 * h + 4] * SX8, v[8 * h + 5] * SX8, v[8 * h + 6] * SX8, v[8 * h + 7] * SX8);
                          *(GAS v2u*)(x8 + m * DM + c0 + 512 * h) = o8; }
                if (outf) { *(GAS f32x4*)(outf + m * DM + c0 + 512 * h) = (f32x4){v[8 * h], v[8 * h + 1], v[8 * h + 2], v[8 * h + 3]};
                            *(GAS f32x4*)(outf + m * DM + c0 + 512 * h + 4) = (f32x4){v[8 * h + 4], v[8 * h + 5], v[8 * h + 6], v[8 * h + 7]}; } }
        }
    }
}
__device__ __forceinline__ void ph_ln2_router(Frame& F, const bf16* zb, bf16* xb, unsigned char* x8, const float* g, const float* b, const bf16* wrT, const float* rbias,
                                              gu32* cnt, int* list, float* gate, int* asg, float* st2) {
    LAS int* cl = (LAS int*)F.lds;
    LAS float* gl = (LAS float*)(F.lds + 256);
    LAS bf16* wl = (LAS bf16*)(F.lds + 256 + 8192);
    const int rw = FLANE & 15, q = FLANE >> 4;
    for (int i = FTID; i < 256; i += 512) { ((LAS f32x4*)gl)[i] = *(const GAS f32x4*)(g + 4 * i); ((LAS f32x4*)gl)[256 + i] = *(const GAS f32x4*)(b + 4 * i); }
    for (int i = FTID; i < 4096; i += 512) { const int e = i >> 7, c = i & 127; *(LAS v4u*)(wl + e * 1032 + 8 * c) = *(const GAS v4u*)(wrT + (size_t)e * DM + 8 * c); }
    for (int blk = F.vcu; blk < MTOK / 128; blk += F.G) {
        __syncthreads();
        if (FTID < 64) cl[FTID] = 0;
        __syncthreads();
        const int row = blk * 128 + F.wave * 16 + rw;
        const bf16* zr = zb + (size_t)row * DM + 8 * q;
        v4u zz[32];
#pragma unroll
        for (int ks = 0; ks < 32; ++ks) zz[ks] = *(const GAS v4u*)(zr + 32 * ks);
        float s1 = 0.f, s2 = 0.f;
#pragma unroll
        for (int ks = 0; ks < 32; ++ks) { const v4u w = zz[ks]; const float x0 = bflo(w.x), x1 = bfhi(w.x), x2 = bflo(w.y), x3 = bfhi(w.y), x4 = bflo(w.z), x5 = bfhi(w.z), x6 = bflo(w.w), x7 = bfhi(w.w);
            s1 += ((x0 + x1) + (x2 + x3)) + ((x4 + x5) + (x6 + x7)); s2 += ((x0 * x0 + x1 * x1) + (x2 * x2 + x3 * x3)) + ((x4 * x4 + x5 * x5) + (x6 * x6 + x7 * x7)); }
        s1 += __shfl_xor(s1, 16); s1 += __shfl_xor(s1, 32); s2 += __shfl_xor(s2, 16); s2 += __shfl_xor(s2, 32);
        const float mean = s1 * (1.f / DM), rstd = 1.f / sqrtf(fmaxf(s2 * (1.f / DM) - mean * mean, 0.f) + LN_EPS);
        if (MOE_FP8 && q == 0) { f32x2 ms; ms[0] = mean; ms[1] = rstd; *(GAS f32x2*)(st2 + (size_t)row * 2) = ms; }
        f32x4 acc0 = (f32x4){0.f, 0.f, 0.f, 0.f}, acc1 = (f32x4){0.f, 0.f, 0.f, 0.f};
        bf16* xr = xb + (size_t)row * DM + 8 * q; unsigned char* x8r = x8 + (size_t)row * DM + 8 * q; v2u h8;
        const LAS bf16* w0 = wl + rw * 1032 + 8 * q; const LAS bf16* w1 = wl + (16 + rw) * 1032 + 8 * q;
#pragma unroll
        for (int ks = 0; ks < 32; ++ks) { v4u w = zz[ks]; asm volatile("" : "+v"(w));
            const f32x4 g0 = *(const LAS f32x4*)(gl + 32 * ks + 8 * q), g1 = *(const LAS f32x4*)(gl + 32 * ks + 8 * q + 4), b0 = *(const LAS f32x4*)(gl + 1024 + 32 * ks + 8 * q), b1 = *(const LAS f32x4*)(gl + 1024 + 32 * ks + 8 * q + 4);
            const float y0 = (bflo(w.x) - mean) * rstd * g0[0] + b0[0], y1 = (bfhi(w.x) - mean) * rstd * g0[1] + b0[1], y2 = (bflo(w.y) - mean) * rstd * g0[2] + b0[2], y3 = (bfhi(w.y) - mean) * rstd * g0[3] + b0[3];
            const float y4 = (bflo(w.z) - mean) * rstd * g1[0] + b1[0], y5 = (bfhi(w.z) - mean) * rstd * g1[1] + b1[1], y6 = (bflo(w.w) - mean) * rstd * g1[2] + b1[2], y7 = (bfhi(w.w) - mean) * rstd * g1[3] + b1[3];
            v4u o; o.x = pk2(y0, y1); o.y = pk2(y2, y3); o.z = pk2(y4, y5); o.w = pk2(y6, y7);
            if (!MOE_FP8) *(GAS v4u*)(xr + 32 * ks) = o;
            if (x8) { v2u o8; o8.x = pk4_fp8(y0 * SX8, y1 * SX8, y2 * SX8, y3 * SX8); o8.y = pk4_fp8(y4 * SX8, y5 * SX8, y6 * SX8, y7 * SX8);
                if ((ks & 1) == 0) h8 = o8;
                else { const auto sx = __builtin_amdgcn_permlane16_swap(h8.x, o8.x, false, false); const auto sy = __builtin_amdgcn_permlane16_swap(h8.y, o8.y, false, false);
                    *(GAS v4u*)(x8r - 8 * q + 8 * (q & 2) + 32 * ((q & 1) ? ks : ks - 1)) = (v4u){sx[0], sy[0], sx[1], sy[1]}; } }
            const bf16x8 bfrag = __builtin_bit_cast(bf16x8, o);
            acc0 = __builtin_amdgcn_mfma_f32_16x16x32_bf16(*(const LAS bf16x8*)(w0 + 32 * ks), bfrag, acc0, 0, 0, 0);
            acc1 = __builtin_amdgcn_mfma_f32_16x16x32_bf16(*(const LAS bf16x8*)(w1 + 32 * ks), bfrag, acc1, 0, 0, 0);
            if ((ks & 1) == 1) asm volatile("" ::: "memory"); }
        float lg[8]; const f32x4 rb0 = *(const GAS f32x4*)(rbias + 4 * q), rb1 = *(const GAS f32x4*)(rbias + 16 + 4 * q);
#pragma unroll
        for (int j = 0; j < 4; ++j) { lg[j] = acc0[j] + rb0[j]; lg[4 + j] = acc1[j] + rb1[j]; }
        int idx[4]; float val[4];
#pragma unroll
        for (int k = 0; k < 4; ++k) { float bv = -3.0e38f; int bi = 64;
#pragma unroll
            for (int j = 0; j < 8; ++j) { const int e = (j < 4) ? 4 * q + j : 12 + 4 * q + j; if (lg[j] > bv) { bv = lg[j]; bi = e; } }
#pragma unroll
            for (int o = 16; o <= 32; o <<= 1) { const float pv = __shfl_xor(bv, o); const int pi = __shfl_xor(bi, o); if (pv > bv || (pv == bv && pi < bi)) { bv = pv; bi = pi; } }
            bi &= 31; idx[k] = bi; val[k] = bv;
#pragma unroll
            for (int j = 0; j < 8; ++j) { const int e = (j < 4) ? 4 * q + j : 12 + 4 * q + j; if (e == bi) lg[j] = -3.0e38f; } }
        const float e1 = __builtin_amdgcn_exp2f((val[1] - val[0]) * LOG2E), e2 = __builtin_amdgcn_exp2f((val[2] - val[0]) * LOG2E), e3 = __builtin_amdgcn_exp2f((val[3] - val[0]) * LOG2E);
        const float inv = 1.f / (1.f + e1 + e2 + e3);
        int pos[4] = {0, 0, 0, 0};
        for (int e = 0; e < NEXP; ++e) {
            const int k = (q != 0) ? -1 : (idx[0] == e) ? 0 : (idx[1] == e) ? 1 : (idx[2] == e) ? 2 : (idx[3] == e) ? 3 : -1;
            const unsigned long long mask = __ballot(k >= 0);
            if (mask) { const int n = __popcll(mask), leader = __ffsll((long long)mask) - 1; int bp = 0;
                if (FLANE == leader) bp = __hip_atomic_fetch_add(cl + e, n, __ATOMIC_RELAXED, __HIP_MEMORY_SCOPE_WORKGROUP);
                bp = __shfl(bp, leader);
                const int p = bp + __popcll(mask & ((1ull << FLANE) - 1ull));
                pos[0] = (k == 0) ? p : pos[0]; pos[1] = (k == 1) ? p : pos[1]; pos[2] = (k == 2) ? p : pos[2]; pos[3] = (k == 3) ? p : pos[3]; }
        }
        __syncthreads();
        if (FTID < 32) { const int tot = cl[FTID]; cl[32 + FTID] = tot ? (int)__hip_atomic_fetch_add(cnt + FTID * 64, (unsigned)tot, RLX_AGENT) : 0; }
        __syncthreads();
        if (q == 0) {
            *(GAS f32x4*)(gate + (size_t)row * 4) = (f32x4){inv, e1 * inv, e2 * inv, e3 * inv};
#pragma unroll
            for (int k = 0; k < 4; ++k) { const int pe = cl[32 + idx[k]] + pos[k]; list[(size_t)idx[k] * CAP + pe] = row * 4 + k; pos[k] = (idx[k] << 16) | pe; }
            *(GAS v4i_t*)(asg + (size_t)row * 4) = (v4i_t){pos[0], pos[1], pos[2], pos[3]}; }
    }
}
__device__ __forceinline__ void ph_softmax(Frame& F, const float* sc, bf16* P) {
    const int gw = F.vcu * NWAVES + F.wave, NGW = F.G * NWAVES;
    for (int m = gw; m < MTOK; m += NGW) {
#pragma unroll
        for (int h = 0; h < 4; ++h) { f32x4 v = *(const GAS f32x4*)(sc + (size_t)m * DM + 256 * h + 4 * FLANE);
            const float mx = wave_max(fmaxf(fmaxf(v.x, v.y), fmaxf(v.z, v.w)));
            v.x = __builtin_amdgcn_exp2f(v.x - mx); v.y = __builtin_amdgcn_exp2f(v.y - mx); v.z = __builtin_amdgcn_exp2f(v.z - mx); v.w = __builtin_amdgcn_exp2f(v.w - mx);
            const float inv = 1.f / wave_sum((v.x + v.y) + (v.z + v.w));
            v2u o; o.x = pk2(v.x * inv, v.y * inv); o.y = pk2(v.z * inv, v.w * inv);
            *(GAS v2u*)(P + (size_t)m * DM + 256 * h + 4 * FLANE) = o; }
    }
}
__device__ __forceinline__ void ph_topk(Frame& F, const float* logit, const float* rbias, gu32* cnt, int* list, float* gate) {
    for (int base = F.vcu * 512; base < MTOK; base += F.G * 512) {
        const int m = base + FTID;
        float lg[32];
#pragma unroll
        for (int q = 0; q < 8; ++q) { const f32x4 t = *(const GAS f32x4*)(logit + (size_t)m * 32 + 4 * q), bb = *(const GAS f32x4*)(rbias + 4 * q);
            lg[4 * q] = t.x + bb.x; lg[4 * q + 1] = t.y + bb.y; lg[4 * q + 2] = t.z + bb.z; lg[4 * q + 3] = t.w + bb.w; }
        int idx[4]; float val[4];
#pragma unroll
        for (int k = 0; k < 4; ++k) { float bvv = -3.0e38f; int bi = 0;
#pragma unroll
            for (int e = 0; e < 32; ++e) { const bool taken = (k > 0 && idx[0] == e) || (k > 1 && idx[1] == e) || (k > 2 && idx[2] == e); if (!taken && lg[e] > bvv) { bvv = lg[e]; bi = e; } }
            idx[k] = bi; val[k] = bvv; }
        const float e1 = __builtin_amdgcn_exp2f((val[1] - val[0]) * LOG2E), e2 = __builtin_amdgcn_exp2f((val[2] - val[0]) * LOG2E), e3 = __builtin_amdgcn_exp2f((val[3] - val[0]) * LOG2E);
        const float inv = 1.f / (1.f + e1 + e2 + e3);
        *(GAS f32x4*)(gate + (size_t)m * 4) = (f32x4){inv, e1 * inv, e2 * inv, e3 * inv};
        for (int e = 0; e < NEXP; ++e) {
            const int k = (idx[0] == e) ? 0 : (idx[1] == e) ? 1 : (idx[2] == e) ? 2 : (idx[3] == e) ? 3 : -1;
            const unsigned long long mask = __ballot(k >= 0);
            if (mask) { const int n = __popcll(mask), leader = __ffsll((long long)mask) - 1; unsigned bp = 0;
                if (FLANE == leader) bp = __hip_atomic_fetch_add(cnt + e * 64, (unsigned)n, RLX_AGENT);
                bp = __shfl(bp, leader);
                if (k >= 0) { const int rank = __popcll(mask & ((1ull << FLANE) - 1ull)); list[(size_t)e * CAP + bp + rank] = m * 4 + k; } }
        }
    }
}
__device__ __forceinline__ void ph_sgu(Frame& F, const bf16* hb, bf16* mix, const float* lng, const float* lnb, const float* wsp, const float* bsp) {
    LAS bf16* Wb = (LAS bf16*)F.lds;
    LAS bf16* VT = (LAS bf16*)(F.lds + 34816);
    LAS float* GL = (LAS float*)(F.lds + 69632);
    const int r = FTID >> 2, qq = FTID & 3, n16 = FLANE & 15, q = FLANE >> 4;
    int gcur = -1;
    for (int it = F.vcu; it < 1024; it += F.G) {
        const int g = it & 3, row0 = (it >> 2) * 128;
        if (g != gcur) { __syncthreads(); for (int i = FTID; i < 16384; i += 512) { const int t = i >> 7, s2 = i & 127; Wb[t * 136 + s2] = (bf16)((s2 <= t) ? f2bf(wsp[g * 16384 + i]) : 0u); } gcur = g; }
        { float v[32]; const bf16* src = hb + (size_t)(row0 + r) * DM + 512 + g * 128 + 32 * qq;
#pragma unroll
            for (int j = 0; j < 4; ++j) { const v4u w = *(const GAS v4u*)(src + 8 * j);
                v[8 * j + 0] = bflo(w.x); v[8 * j + 1] = bfhi(w.x); v[8 * j + 2] = bflo(w.y); v[8 * j + 3] = bfhi(w.y); v[8 * j + 4] = bflo(w.z); v[8 * j + 5] = bfhi(w.z); v[8 * j + 6] = bflo(w.w); v[8 * j + 7] = bfhi(w.w); }
            float s = 0.f;
#pragma unroll
            for (int j = 0; j < 32; ++j) s += v[j];
            s += __shfl_xor(s, 1); s += __shfl_xor(s, 2);
            const float mean = s * (1.f / 128.f); float s2 = 0.f;
#pragma unroll
            for (int j = 0; j < 32; ++j) { v[j] -= mean; s2 += v[j] * v[j]; }
            s2 += __shfl_xor(s2, 1); s2 += __shfl_xor(s2, 2);
            const float rstd = 1.f / sqrtf(s2 * (1.f / 128.f) + LN_EPS);
#pragma unroll
            for (int j = 0; j < 8; ++j) { const f32x4 gg = *(const GAS f32x4*)(lng + g * 128 + 32 * qq + 4 * j), bb = *(const GAS f32x4*)(lnb + g * 128 + 32 * qq + 4 * j);
#pragma unroll
                for (int k = 0; k < 4; ++k) VT[(32 * qq + 4 * j + k) * 136 + r] = (bf16)f2bf(v[4 * j + k] * rstd * gg[k] + bb[k]); } }
        __syncthreads();
        { bf16x8 VF[4];
#pragma unroll
            for (int ks = 0; ks < 4; ++ks) VF[ks] = *(const LAS bf16x8*)(VT + (16 * F.wave + n16) * 136 + 32 * ks + 8 * q);
#pragma unroll
            for (int tb = 0; tb < 8; ++tb) { f32x4 acc = (f32x4){0.f, 0.f, 0.f, 0.f};
#pragma unroll
                for (int ks = 0; ks <= (tb >> 1); ++ks) acc = __builtin_amdgcn_mfma_f32_16x16x32_bf16(*(const LAS bf16x8*)(Wb + (16 * tb + n16) * 136 + 32 * ks + 8 * q), VF[ks], acc, 0, 0, 0);
                const f32x4 bt = *(const GAS f32x4*)(bsp + g * 128 + 16 * tb + 4 * q);
#pragma unroll
                for (int k = 0; k < 4; ++k) GL[(16 * tb + 4 * q + k) * 128 + 16 * F.wave + n16] = acc[k] + bt[k]; } }
        __syncthreads();
        { const bf16* usrc = hb + (size_t)(row0 + r) * DM + g * 128 + 32 * qq; bf16* dst = mix + (size_t)(row0 + r) * DM + g * 128 + 32 * qq;
#pragma unroll
            for (int j = 0; j < 4; ++j) { const v4u w = *(const GAS v4u*)(usrc + 8 * j); const f32x4 g0 = *(const LAS f32x4*)(GL + r * 128 + 32 * qq + 8 * j), g1 = *(const LAS f32x4*)(GL + r * 128 + 32 * qq + 8 * j + 4); v4u o;
                o.x = pk2(bflo(w.x) * g0[0], bfhi(w.x) * g0[1]); o.y = pk2(bflo(w.y) * g0[2], bfhi(w.y) * g0[3]); o.z = pk2(bflo(w.z) * g1[0], bfhi(w.z) * g1[1]); o.w = pk2(bflo(w.w) * g1[2], bfhi(w.w) * g1[3]);
                *(GAS v4u*)(dst + 8 * j) = o; } }
    }
}
__device__ __forceinline__ void ph_combine(Frame& F, const bf16* oatt, bf16* mix, const float* lq1, const float* lk1, const float* lq2, const float* lk2, const float* sg) {
    const int gw = F.vcu * NWAVES + F.wave, NGW = F.G * NWAVES;
    const float d1 = wave_sum(lq1[FLANE] * lk1[FLANE]), d2 = wave_sum(lq2[FLANE] * lk2[FLANE]);
    const float lam = expf(d1) - expf(d2) + LAM_INIT0;
    const int h = FLANE >> 4, e0 = 8 * (FLANE & 15);
    float gsc[8];
#pragma unroll
    for (int j = 0; j < 8; ++j) gsc[j] = sg[e0 + j] * (1.0f - LAM_INIT0);
    for (int m0 = gw * 4; m0 < MTOK; m0 += NGW * 4) {
        v4u av[4], bw[4];
#pragma unroll
        for (int r = 0; r < 4; ++r) { av[r] = *(const GAS v4u*)(oatt + (size_t)(m0 + r) * DM + h * 256 + e0); bw[r] = *(const GAS v4u*)(oatt + (size_t)(m0 + r) * DM + h * 256 + 128 + e0); }
#pragma unroll
        for (int r = 0; r < 4; ++r) { const v4u a = av[r], b = bw[r]; const size_t m = (size_t)(m0 + r);
            float o[8];
            o[0] = bflo(a.x) - lam * bflo(b.x); o[1] = bfhi(a.x) - lam * bfhi(b.x); o[2] = bflo(a.y) - lam * bflo(b.y); o[3] = bfhi(a.y) - lam * bfhi(b.y);
            o[4] = bflo(a.z) - lam * bflo(b.z); o[5] = bfhi(a.z) - lam * bfhi(b.z); o[6] = bflo(a.w) - lam * bflo(b.w); o[7] = bfhi(a.w) - lam * bfhi(b.w);
            float s2 = 0.f;
#pragma unroll
            for (int j = 0; j < 8; ++j) s2 += o[j] * o[j];
            s2 += __shfl_xor(s2, 1); s2 += __shfl_xor(s2, 2); s2 += __shfl_xor(s2, 4); s2 += __shfl_xor(s2, 8);
            const float rs = 1.f / sqrtf(s2 * (1.f / 128.f) + LN_EPS);
            v4u w; w.x = pk2(o[0] * rs * gsc[0], o[1] * rs * gsc[1]); w.y = pk2(o[2] * rs * gsc[2], o[3] * rs * gsc[3]); w.z = pk2(o[4] * rs * gsc[4], o[5] * rs * gsc[5]); w.w = pk2(o[6] * rs * gsc[6], o[7] * rs * gsc[7]);
            *(GAS v4u*)(mix + m * DM + 512 + h * 128 + e0) = w; }
    }
}

__device__ __forceinline__ void combine_local(Frame& F, const bf16* oatt, bf16* mix, const float* lq1, const float* lk1, const float* lq2, const float* lk2, const float* sg, int b, int h, int pr) {
    const float d1 = wave_sum(lq1[FLANE] * lk1[FLANE]), d2 = wave_sum(lq2[FLANE] * lk2[FLANE]);
    const float lam = expf(d1) - expf(d2) + LAM_INIT0;
    const int e0 = 8 * (FLANE & 15);
    float gsc[8];
#pragma unroll
    for (int j = 0; j < 8; ++j) gsc[j] = sg[e0 + j] * (1.0f - LAM_INIT0);
    for (int it = 0; it < 16; it += 4) {
        v4u av[4], bw[4]; size_t rows[4];
#pragma unroll
        for (int r = 0; r < 4; ++r) { const int rl = F.wave * 64 + (it + r) * 4 + (FLANE >> 4); rows[r] = (size_t)b * SEQ + (size_t)((rl < 256) ? pr : 7 - pr) * 256 + (rl & 255);
            av[r] = *(const GAS v4u*)(oatt + rows[r] * DM + h * 256 + e0); bw[r] = *(const GAS v4u*)(oatt + rows[r] * DM + h * 256 + 128 + e0); }
#pragma unroll
        for (int r = 0; r < 4; ++r) { const v4u a = av[r], bb = bw[r];
            float o[8];
            o[0] = bflo(a.x) - lam * bflo(bb.x); o[1] = bfhi(a.x) - lam * bfhi(bb.x); o[2] = bflo(a.y) - lam * bflo(bb.y); o[3] = bfhi(a.y) - lam * bfhi(bb.y);
            o[4] = bflo(a.z) - lam * bflo(bb.z); o[5] = bfhi(a.z) - lam * bfhi(bb.z); o[6] = bflo(a.w) - lam * bflo(bb.w); o[7] = bfhi(a.w) - lam * bfhi(bb.w);
            float s2 = 0.f;
#pragma unroll
            for (int j = 0; j < 8; ++j) s2 += o[j] * o[j];
            s2 += __shfl_xor(s2, 1); s2 += __shfl_xor(s2, 2); s2 += __shfl_xor(s2, 4); s2 += __shfl_xor(s2, 8);
            const float rs = 1.f / sqrtf(s2 * (1.f / 128.f) + LN_EPS);
            v4u w; w.x = pk2(o[0] * rs * gsc[0], o[1] * rs * gsc[1]); w.y = pk2(o[2] * rs * gsc[2], o[3] * rs * gsc[3]); w.z = pk2(o[4] * rs * gsc[4], o[5] * rs * gsc[5]); w.w = pk2(o[6] * rs * gsc[6], o[7] * rs * gsc[7]);
            *(GAS v4u*)(mix + rows[r] * DM + 512 + h * 128 + e0) = w; }
    }
}

__device__ __forceinline__ float dpp_shr1(float x) { return __builtin_bit_cast(float, __builtin_amdgcn_update_dpp(0, __builtin_bit_cast(int, x), 0x111, 0xf, 0xf, true)); }
__device__ __forceinline__ float dpp_shr2(float x) { return __builtin_bit_cast(float, __builtin_amdgcn_update_dpp(0, __builtin_bit_cast(int, x), 0x112, 0xf, 0xf, true)); }
__device__ __forceinline__ float dpp_shr4(float x) { return __builtin_bit_cast(float, __builtin_amdgcn_update_dpp(0, __builtin_bit_cast(int, x), 0x114, 0xf, 0xf, true)); }
__device__ __forceinline__ float dpp_shr8(float x) { return __builtin_bit_cast(float, __builtin_amdgcn_update_dpp(0, __builtin_bit_cast(int, x), 0x118, 0xf, 0xf, true)); }
__device__ __forceinline__ float dpp_shl15(float x) { return __builtin_bit_cast(float, __builtin_amdgcn_update_dpp(0, __builtin_bit_cast(int, x), 0x10f, 0xf, 0xf, true)); }
#define S5_DPP2(fn, v) ((f32x2){fn((v).x), fn((v).y)})
__device__ __forceinline__ float dpp_ror1(float x) { return __builtin_bit_cast(float, __builtin_amdgcn_update_dpp(0, __builtin_bit_cast(int, x), 0x121, 0xf, 0xf, true)); }
template <int hf>
__device__ __forceinline__ void s5_main(Frame& F, const bf16* ug, bf16* yb, const float* dsk, int g, int bh, LAS bf16* W2F, LAS bf16* W3F, LAS bf16* KT, LAS float* PW, int r, int q, int variant) {
        const int b = bh * 4 + (F.wave & 3);
        LAS bf16x8* XX = (LAS bf16x8*)(F.lds + 91648);
        const bf16* up = ug + ((size_t)g * MTOK + (size_t)b * SEQ) * 16;
        unsigned char* yp = (unsigned char*)yb + ((size_t)g * MTOK + (size_t)b * SEQ) * 16 + 4 * q;
        const f32x4 dk = *(const GAS f32x4*)(dsk + g * 16 + 4 * q);
        f32x4 E[4];
#pragma unroll
        for (int i = 0; i < 4; ++i) E[i] = (f32x4){0.f, 0.f, 0.f, 0.f};
        bf16x8 UFn[4], UF[4]; v2u UWn[4], UW[4];
#pragma unroll
        for (int sp = 0; sp < 4; ++sp) UFn[sp] = *(const GAS bf16x8*)(up + (size_t)(r * 8 + 2 * sp + (q >> 1)) * 16 + 8 * (q & 1));
#pragma unroll
        for (int t = 0; t < 4; ++t) UWn[t] = *(const GAS v2u*)(up + (size_t)(r * 8 + 4 * hf + t) * 16 + 4 * q);
#pragma unroll
        for (int sp = 0; sp < 4; ++sp) UF[sp] = UFn[sp];
#pragma unroll
        for (int t = 0; t < 4; ++t) UW[t] = UWn[t];
        f32x2 Pr[4][2][2], Pi[4][2][2];
#pragma unroll
        for (int i2 = 0; i2 < 2; ++i2) { const int rbp = 2 * hf + i2;
            const f32x4 a0 = *(const LAS f32x4*)(PW + (8 * 64 + 16 * rbp + 4 * q) * 2), a1 = *(const LAS f32x4*)(PW + (8 * 64 + 16 * rbp + 4 * q) * 2 + 4);
            Pr[0][i2][0] = (f32x2){a0[0], a0[2]}; Pi[0][i2][0] = (f32x2){a0[1], a0[3]}; Pr[0][i2][1] = (f32x2){a1[0], a1[2]}; Pi[0][i2][1] = (f32x2){a1[1], a1[3]};
#pragma unroll
            for (int k = 1; k < 4; ++k)
#pragma unroll
                for (int h = 0; h < 2; ++h) { const f32x2 pr = Pr[k - 1][i2][h], pi = Pi[k - 1][i2][h]; Pr[k][i2][h] = pr * pr - pi * pi; Pi[k][i2][h] = 2.0f * pr * pi; } }
        for (int cg = 0; cg < 16; ++cg) {
            const int tokbase = cg * 128 + r * 8;
            if (cg < 15) {
#pragma unroll
                for (int sp = 0; sp < 4; ++sp) UFn[sp] = *(const GAS bf16x8*)(up + (size_t)(tokbase + 128 + 2 * sp + (q >> 1)) * 16 + 8 * (q & 1));
#pragma unroll
                for (int t = 0; t < 4; ++t) UWn[t] = *(const GAS v2u*)(up + (size_t)(tokbase + 128 + 4 * hf + t) * 16 + 4 * q); }
            f32x2 Cr[2][2], Ci[2][2];
#pragma unroll
            for (int i2 = 0; i2 < 2; ++i2)
#pragma unroll
                for (int h = 0; h < 2; ++h) { const f32x2 er = h ? E[2 * i2].hi : E[2 * i2].lo, ei = h ? E[2 * i2 + 1].hi : E[2 * i2 + 1].lo; Cr[i2][h] = S5_DPP2(dpp_shl15, er); Ci[i2][h] = S5_DPP2(dpp_shl15, ei); }
#pragma unroll
            for (int i = 0; i < 4; ++i) E[i] = (f32x4){0.f, 0.f, 0.f, 0.f};
#pragma unroll
            for (int sp = 0; sp < 4; ++sp) {
#pragma unroll
                for (int i = 0; i < 4; ++i) E[i] = __builtin_amdgcn_mfma_f32_16x16x32_bf16(*(const LAS bf16x8*)(W2F + (((4 * hf + i) * 4 + sp) * 64 + FLANE) * 8), UF[sp], E[i], 0, 0, 0);
                asm volatile("" ::: "memory"); }
            bf16x8 XBf[4];
            LAS bf16x8* xx = XX + ((cg & 1) * 4 + (F.wave & 3)) * 256;
#pragma unroll
            for (int i2 = 0; i2 < 2; ++i2) { f32x2 xr[2], xi[2];
#pragma unroll
                for (int h = 0; h < 2; ++h) {
                    f32x2 er = h ? E[2 * i2].hi : E[2 * i2].lo, ei = h ? E[2 * i2 + 1].hi : E[2 * i2 + 1].lo; f32x2 sr, si, nr, ni;
                    nr = er + Pr[0][i2][h] * Cr[i2][h] - Pi[0][i2][h] * Ci[i2][h]; ni = ei + Pr[0][i2][h] * Ci[i2][h] + Pi[0][i2][h] * Cr[i2][h]; er = nr; ei = ni;
                    sr = S5_DPP2(dpp_shr1, er); si = S5_DPP2(dpp_shr1, ei); nr = er + Pr[0][i2][h] * sr - Pi[0][i2][h] * si; ni = ei + Pr[0][i2][h] * si + Pi[0][i2][h] * sr; er = nr; ei = ni;
                    sr = S5_DPP2(dpp_shr2, er); si = S5_DPP2(dpp_shr2, ei); nr = er + Pr[1][i2][h] * sr - Pi[1][i2][h] * si; ni = ei + Pr[1][i2][h] * si + Pi[1][i2][h] * sr; er = nr; ei = ni;
                    sr = S5_DPP2(dpp_shr4, er); si = S5_DPP2(dpp_shr4, ei); nr = er + Pr[2][i2][h] * sr - Pi[2][i2][h] * si; ni = ei + Pr[2][i2][h] * si + Pi[2][i2][h] * sr; er = nr; ei = ni;
                    sr = S5_DPP2(dpp_shr8, er); si = S5_DPP2(dpp_shr8, ei); nr = er + Pr[3][i2][h] * sr - Pi[3][i2][h] * si; ni = ei + Pr[3][i2][h] * si + Pi[3][i2][h] * sr; er = nr; ei = ni;
                    if (h) { E[2 * i2].hi = er; E[2 * i2 + 1].hi = ei; } else { E[2 * i2].lo = er; E[2 * i2 + 1].lo = ei; }
                    xr[h] = S5_DPP2(dpp_shr1, er) + Cr[i2][h]; xi[h] = S5_DPP2(dpp_shr1, ei) + Ci[i2][h]; }
                v4u w; w.x = pk2(xr[0].x, xr[0].y); w.y = pk2(xr[1].x, xr[1].y); w.z = pk2(xi[0].x, xi[0].y); w.w = pk2(xi[1].x, xi[1].y);
                XBf[2 * hf + i2] = __builtin_bit_cast(bf16x8, w); xx[(2 * hf + i2) * 64 + FLANE] = XBf[2 * hf + i2]; }
            LDS_WAIT(); __builtin_amdgcn_s_barrier(); asm volatile("" ::: "memory");
#pragma unroll
            for (int i2 = 0; i2 < 2; ++i2) XBf[2 * (1 - hf) + i2] = xx[(2 * (1 - hf) + i2) * 64 + FLANE];
            unsigned yout[4] = {0u, 0u, 0u, 0u};
            if (variant != 2) {
            f32x4 Y[4];
#pragma unroll
            for (int tt = 0; tt < 4; ++tt) Y[tt] = (f32x4){0.f, 0.f, 0.f, 0.f};
#pragma unroll
            for (int sp = 0; sp < 4; ++sp) {
#pragma unroll
                for (int tt = 0; tt < 4; ++tt) { const int t = 4 * hf + tt; if (sp <= (t >> 1)) { const int tau1 = t - 2 * sp - (q >> 1) + 1;
                    Y[tt] = __builtin_amdgcn_mfma_f32_16x16x32_bf16(*(const LAS bf16x8*)(KT + (tau1 * 16 + r) * 16 + 8 * (q & 1)), UF[sp], Y[tt], 0, 0, 0); } }
                asm volatile("" ::: "memory"); }
#pragma unroll
            for (int ks = 0; ks < 4; ++ks) {
#pragma unroll
                for (int tt = 0; tt < 4; ++tt) Y[tt] = __builtin_amdgcn_mfma_f32_16x16x32_bf16(*(const LAS bf16x8*)(W3F + (((4 * hf + tt) * 4 + ks) * 64 + FLANE) * 8), XBf[ks], Y[tt], 0, 0, 0);
                asm volatile("" ::: "memory"); }
#pragma unroll
            for (int tt = 0; tt < 4; ++tt) { const v2u uw = UW[tt];
                const f32x2 ya = gelu_tanh2(Y[tt].lo + dk.lo * (f32x2){bflo(uw.x), bfhi(uw.x)}, SA8), yb2 = gelu_tanh2(Y[tt].hi + dk.hi * (f32x2){bflo(uw.y), bfhi(uw.y)}, SA8);
                yout[tt] = pk4_fp8(ya.x, ya.y, yb2.x, yb2.y);
            } }
            if (cg < 15) {
#pragma unroll
                for (int sp = 0; sp < 4; ++sp) UF[sp] = UFn[sp];
#pragma unroll
                for (int t = 0; t < 4; ++t) UW[t] = UWn[t]; }
            asm volatile("" ::: "memory");
            { auto s01 = __builtin_amdgcn_permlane16_swap(yout[0], yout[1], false, false); auto s23 = __builtin_amdgcn_permlane16_swap(yout[2], yout[3], false, false);
              auto s02 = __builtin_amdgcn_permlane32_swap(s01[0], s23[0], false, false); auto s13 = __builtin_amdgcn_permlane32_swap(s01[1], s23[1], false, false);
              *(GAS v4u*)(yp - 4 * q + (size_t)(tokbase + 4 * hf + q) * 16) = (v4u){s02[0], s13[0], s02[1], s13[1]}; }
        }
}
__device__ __forceinline__ void ph_s5(Frame& F, const bf16* ug, bf16* yb, const float* log_dt, const float* lre, const float* lim, const float* bre, const float* bim,
                                      const float* cre, const float* cim, const float* dsk, int variant) {
    LAS bf16* W2F = (LAS bf16*)F.lds;
    LAS bf16* W3F = (LAS bf16*)(F.lds + 32768);
    LAS bf16* KT = (LAS bf16*)(F.lds + 65536);
    LAS float* PW = (LAS float*)(F.lds + 70144);
    LAS float* ZZ = (LAS float*)(F.lds + 74752);
    LAS float* BB = (LAS float*)(F.lds + 75264);
    LAS float* CC = (LAS float*)(F.lds + 83456);
    LAS bf16* W30 = (LAS bf16*)(F.lds + 124416);
    const int r = FLANE & 15, q = FLANE >> 4;
    for (int it = F.vcu; it < 256; it += F.G) {
        const int g = it & 63, bh = it >> 6;
        __syncthreads();
        if (FTID < 64) { const int p = FTID; const float dt = expf(log_dt[g]), lr = lre[g * 64 + p], li = lim[g * 64 + p];
            const float mg = expf(lr * dt), ar = mg * cosf(li * dt), ai = mg * sinf(li * dt), den = lr * lr + li * li;
            float pr = 1.f, pi = 0.f;
            for (int n = 0; n < 9; ++n) { PW[(n * 64 + p) * 2] = pr; PW[(n * 64 + p) * 2 + 1] = pi; const float t2 = pr * ar - pi * ai; pi = pr * ai + pi * ar; pr = t2; }
            ZZ[p * 2] = ((ar - 1.0f) * lr + ai * li) / den; ZZ[p * 2 + 1] = (ai * lr - (ar - 1.0f) * li) / den; }
        __syncthreads();
        for (int idx = FTID; idx < 1024; idx += 512) {
            { const int p = idx >> 4; const float br = bre[(size_t)g * 1024 + idx], bi = bim[(size_t)g * 1024 + idx], zr = ZZ[p * 2], zi = ZZ[p * 2 + 1];
              BB[idx * 2] = zr * br - zi * bi; BB[idx * 2 + 1] = zr * bi + zi * br; }
            { CC[idx * 2] = cre[(size_t)g * 1024 + idx]; CC[idx * 2 + 1] = cim[(size_t)g * 1024 + idx]; }
        }
        if (FTID < 256) KT[FTID] = 0;
        __syncthreads();
        for (int idx = FTID; idx < 2048; idx += 512) {
            { const int t = idx >> 8, ks = (idx >> 6) & 3, ln = idx & 63, c = ln & 15, qq = ln >> 4; unsigned w[4];
#pragma unroll
              for (int j = 0; j < 4; ++j) { const int p = 16 * ks + 4 * qq + j; const float cr_ = CC[(c * 64 + p) * 2], ci_ = CC[(c * 64 + p) * 2 + 1], pr = PW[((t + 1) * 64 + p) * 2], pi = PW[((t + 1) * 64 + p) * 2 + 1];
                  const float gr = cr_ * pr - ci_ * pi, gi = cr_ * pi + ci_ * pr;
                  if (j & 1) { w[j >> 1] |= f2bf(gr) << 16; w[2 + (j >> 1)] |= f2bf(-gi) << 16; } else { w[j >> 1] = f2bf(gr); w[2 + (j >> 1)] = f2bf(-gi); } }
              *(LAS v4u*)(W3F + (size_t)idx * 8) = (v4u){w[0], w[1], w[2], w[3]}; }
            { const int rb = idx >> 8, sp = (idx >> 6) & 3, ln = idx & 63, rr = ln & 15, qq = ln >> 4, p = 16 * (rb >> 1) + rr, s = 2 * sp + (qq >> 1), c0 = 8 * (qq & 1); unsigned w[4];
              const float pr = PW[((7 - s) * 64 + p) * 2], pi = PW[((7 - s) * 64 + p) * 2 + 1];
#pragma unroll
              for (int j = 0; j < 8; ++j) { const float br = BB[(p * 16 + c0 + j) * 2], bi = BB[(p * 16 + c0 + j) * 2 + 1]; const float v = (rb & 1) ? (pr * bi + pi * br) : (pr * br - pi * bi);
                  if (j & 1) w[j >> 1] |= f2bf(v) << 16; else w[j >> 1] = f2bf(v); }
              *(LAS v4u*)(W2F + (size_t)idx * 8) = (v4u){w[0], w[1], w[2], w[3]}; }
        }
        if (FTID < 256) { const int ks = FTID >> 6, ln = FTID & 63, c = ln & 15, qq = ln >> 4; unsigned w[4];
#pragma unroll
            for (int j = 0; j < 4; ++j) { const int p = 16 * ks + 4 * qq + j; const float gr = CC[(c * 64 + p) * 2], gi = CC[(c * 64 + p) * 2 + 1];
                if (j & 1) { w[j >> 1] |= f2bf(gr) << 16; w[2 + (j >> 1)] |= f2bf(-gi) << 16; } else { w[j >> 1] = f2bf(gr); w[2 + (j >> 1)] = f2bf(-gi); } }
            *(LAS v4u*)(W30 + (size_t)FTID * 8) = (v4u){w[0], w[1], w[2], w[3]}; }
        __syncthreads();
        {
            f32x4 kacc = (f32x4){0.f, 0.f, 0.f, 0.f}; const int tau = F.wave;
#pragma unroll
            for (int ks = 0; ks < 4; ++ks) { unsigned w[4];
#pragma unroll
                for (int j = 0; j < 4; ++j) { const int p = 16 * ks + 4 * q + j; const float br = BB[(p * 16 + r) * 2], bi = BB[(p * 16 + r) * 2 + 1];
                    if (j & 1) { w[j >> 1] |= f2bf(br) << 16; w[2 + (j >> 1)] |= f2bf(bi) << 16; } else { w[j >> 1] = f2bf(br); w[2 + (j >> 1)] = f2bf(bi); } }
                const v4u wb = (v4u){w[0], w[1], w[2], w[3]};
                const bf16x8 af = tau == 0 ? *(const LAS bf16x8*)(W30 + (ks * 64 + FLANE) * 8) : *(const LAS bf16x8*)(W3F + (((tau - 1) * 4 + ks) * 64 + FLANE) * 8);
                kacc = __builtin_amdgcn_mfma_f32_16x16x32_bf16(af, __builtin_bit_cast(bf16x8, wb), kacc, 0, 0, 0); }
#pragma unroll
            for (int k = 0; k < 4; ++k) KT[(tau + 1) * 256 + (4 * q + k) * 16 + r] = (bf16)f2bf(kacc[k]); }
        __syncthreads();
        if (variant != 1) { if ((F.wave >> 2) == 0) s5_main<0>(F, ug, yb, dsk, g, bh, W2F, W3F, KT, PW, r, q, variant); else s5_main<1>(F, ug, yb, dsk, g, bh, W2F, W3F, KT, PW, r, q, variant); }
    }
}

struct PlainSched {
    pg8::TileOrder T; const char* A; const char* B; int tilesPerBatch; size_t bBatch; int splitN; size_t aT = pg8::TSTEP, bT = pg8::TSTEP;
    __device__ __forceinline__ bool next(int i, pg8::Unit& u) const {
        int pm, pn; if (!T.get(i, pm, pn)) return false;
        const int z = pm / tilesPerBatch;
        u.a = A + (size_t)pm * aT; u.b = B + (size_t)z * bBatch + (size_t)pn * bT; u.row0 = pm * 256; u.col0 = pn * 256; u.z = z; u.aux = 0;
        if (splitN) { u.z = pn >= splitN; u.col0 = (pn >= splitN ? pn - splitN : pn) * 256; }
        return true;
    }
};
struct FoldSched {
    int G, c, first; const char* KB; const char* VB; const char* XQ; const char* XOT;
    __device__ __forceinline__ bool next(int i, pg8::Unit& u) const {
        const int idx = i * G + c - first; if (idx < 0 || idx >= 512) return false;
        const int type = idx >> 8, j = idx & 255, b = j >> 4, h = (j >> 2) & 3, t = j & 3;
        if (type == 0) { u.a = KB + (size_t)b * 256 * 2048 + h * 512; u.b = XQ + (size_t)t * pg8::TSTEP + h * 512; u.row0 = b * 1024 + h * 256; u.col0 = t * 256; u.z = 0; }
        else { u.a = XOT + (size_t)t * pg8::TSTEP + h * 512; u.b = VB + (size_t)b * 256 * 2048 + h * 512; u.row0 = b * 1024 + t * 256; u.col0 = h * 256; u.z = 1; }
        u.aux = 0; return true;
    }
};
struct MoeSched {
    LAS const int* tab; int NT, G, c; const char* A; const char* B; size_t bExp; int colw; const int* list; bool gather; size_t tileB;
    __device__ __forceinline__ bool next(int i, pg8::Unit& u) const {
        const int nblk = __builtin_amdgcn_readfirstlane(tab[64]);
        const int x = c >> 5, r = c & 31; int mbl, pn;
        if (G != 256 || NT != 8) { mbl = c / NT; pn = c % NT; } else { pn = 4 * (x & 1) + (r & 3); mbl = 8 * (x >> 1) + (r >> 2); }
        const int mbg = i * (G / NT) + mbl; if (mbg >= nblk) return false;
        const int lane = opaque_tid() & 63; const int v = (lane <= 32) ? tab[32 + lane] : 0x7fffffff;
        const int e = __popcll(__ballot(v <= mbg)) - 1;
        const int mb = mbg - __builtin_amdgcn_readfirstlane(tab[32 + e]);
        u.a = gather ? A : A + (size_t)mbg * tileB; u.b = B + (size_t)e * bExp + (size_t)pn * tileB;
        u.row0 = mbg * 256; u.col0 = pn * colw; u.z = e; u.aux = mb; return true;
    }
    __device__ __forceinline__ const int* rows(const pg8::Unit& u) const { return list + (size_t)u.z * CAP + u.aux * 256; }
    __device__ __forceinline__ static int rowmap(int v) { return (int)(((unsigned)v >> 2) & (unsigned)(MTOK - 1)); }
};

__device__ __forceinline__ void store_rowpair16(unsigned char* base, size_t rowA, size_t rowB, int colp, int fq, v2u a, v2u b, size_t pitch = DM) {
    const auto sx = __builtin_amdgcn_permlane16_swap(a.x, b.x, false, false); const auto sy = __builtin_amdgcn_permlane16_swap(a.y, b.y, false, false);
    *(GAS v4u*)(base + ((fq & 1) ? rowB : rowA) * pitch + colp) = (v4u){sx[0], sy[0], sx[1], sy[1]}; }
#define ST8_ROWPAIR(basep, rowcur, colp, hold, w, pitch) do { if ((m & 1) == 0) (hold) = (w); else store_rowpair16((unsigned char*)(basep), (size_t)(rowcur) - 16, (size_t)(rowcur), (colp), fq, (hold), (w), (pitch)); } while (0)
#define EPI_ROWS_BEGIN _Pragma("unroll") for (int ai = 0; ai < 2; ++ai) _Pragma("unroll") for (int m = 0; m < 4; ++m) { const int rloc = ai * 128 + wr * 64 + m * 16 + fr;
#define EPI_ROWS_END }
__device__ __forceinline__ v4u pack8(f32x4 v0, f32x4 v1) { v4u w; w.x = pg8::cvt_pk_bf16(v0[0], v0[1]); w.y = pg8::cvt_pk_bf16(v0[2], v0[3]); w.z = pg8::cvt_pk_bf16(v1[0], v1[1]); w.w = pg8::cvt_pk_bf16(v1[2], v1[3]); return w; }
__device__ __forceinline__ void unpack8(v4u w, f32x4& a, f32x4& b) { a = (f32x4){bflo(w.x), bfhi(w.x), bflo(w.y), bfhi(w.y)}; b = (f32x4){bflo(w.z), bfhi(w.z), bflo(w.w), bfhi(w.w)}; }
__device__ __forceinline__ void rowpair_publish(LAS float* tab, float* dst, int nslot, int slot, int row0, const float (&ss)[8], const float (&qq)[8], int wr, int wc, int fr, int fq) {
    if (fq == 0) {
#pragma unroll
        for (int i = 0; i < 8; ++i) { const int rl = (i >> 2) * 128 + wr * 64 + (i & 3) * 16 + fr; tab[(rl * 4 + wc) * 2] = ss[i]; tab[(rl * 4 + wc) * 2 + 1] = qq[i]; } }
    LDS_WAIT(); __builtin_amdgcn_s_barrier(); asm volatile("" ::: "memory");
    { const int t = opaque_tid(), row = t >> 1, which = t & 1;
      const float v = (tab[(row * 4 + 0) * 2 + which] + tab[(row * 4 + 1) * 2 + which]) + (tab[(row * 4 + 2) * 2 + which] + tab[(row * 4 + 3) * 2 + which]);
      dst[((size_t)(row0 + row) * nslot + slot) * 2 + which] = v; }
    LDS_WAIT(); __builtin_amdgcn_s_barrier(); asm volatile("" ::: "memory");
}
__device__ __forceinline__ void ln_tables(LAS float* tabR, LAS float* tabC, const float* st, int nslot, int row0, const float* sc, int scrow0, const float* v0, const float* v1, int col0) {
    const int t = opaque_tid();
    if (t < 256) { const float* p = st + (size_t)(row0 + t) * 16; float s = 0.f, q = 0.f;
        for (int k = 0; k < nslot; ++k) { s += p[2 * k]; q += p[2 * k + 1]; }
        const float mu = s * (1.f / DM); tabR[2 * t] = mu; tabR[2 * t + 1] = 1.f / sqrtf(fmaxf(q * (1.f / DM) - mu * mu, 0.f) + LN_EPS); }
    else { const int c = t - 256;
        if (sc) { const f32x4 a = *(const GAS f32x4*)(sc + (size_t)(scrow0 + c) * 8), b = *(const GAS f32x4*)(sc + (size_t)(scrow0 + c) * 8 + 4);
            tabC[c] = (a[0] + a[2]) + (b[0] + b[2]); tabC[256 + c] = (a[1] + a[3]) + (b[1] + b[3]); }
        else { tabC[c] = v0[col0 + c]; tabC[256 + c] = v1[col0 + c]; } }
    LDS_WAIT(); __builtin_amdgcn_s_barrier(); asm volatile("" ::: "memory");
}
struct EpiResidStats { const bf16* xb; bf16* zb; unsigned char* z8; float* st; LAS float* tab;
    __device__ __forceinline__ void operator()(EPI_ARGS) const {
        float ss[8], qq[8]; v4u xr[2][4][2];
        EPI_ROWS_BEGIN const size_t off = (size_t)(u.row0 + rloc) * DM + u.col0 + wc * 32 + 8 * fq; xr[ai][m][0] = *(const GAS v4u*)(xb + off); xr[ai][m][1] = *(const GAS v4u*)(xb + off + 128); EPI_ROWS_END
        EPI_ROWS_BEGIN const size_t off = (size_t)(u.row0 + rloc) * DM + u.col0 + wc * 32 + 8 * fq; float s = 0.f, q = 0.f;
#pragma unroll
            for (int bj = 0; bj < 2; ++bj) { f32x4 x0, x1; unpack8(xr[ai][m][bj], x0, x1);
                const f32x4 z0 = x0 * ALPHA + acc[ai][bj][m][0], z1 = x1 * ALPHA + acc[ai][bj][m][1];
                *(GAS v4u*)(zb + off + bj * 128) = pack8(z0, z1);
                v2u w; w.x = pk4_fp8(z0[0] * SZ8, z0[1] * SZ8, z0[2] * SZ8, z0[3] * SZ8); w.y = pk4_fp8(z1[0] * SZ8, z1[1] * SZ8, z1[2] * SZ8, z1[3] * SZ8); *(GAS v2u*)(z8 + off + bj * 128) = w;
                s += ((z0[0] + z0[1]) + (z0[2] + z0[3])) + ((z1[0] + z1[1]) + (z1[2] + z1[3])); q += ((z0[0] * z0[0] + z0[1] * z0[1]) + (z0[2] * z0[2] + z0[3] * z0[3])) + ((z1[0] * z1[0] + z1[1] * z1[1]) + (z1[2] * z1[2] + z1[3] * z1[3])); }
            s += __shfl_xor(s, 16); s += __shfl_xor(s, 32); q += __shfl_xor(q, 16); q += __shfl_xor(q, 32); ss[ai * 4 + m] = s; qq[ai * 4 + m] = q; EPI_ROWS_END
        rowpair_publish(tab, st, 8, u.col0 >> 8, u.row0, ss, qq, wr, wc, fr, fq);
    } };
struct EpiResidLN { bf16* zb; float rs; const float* st; LAS float* tab; const float* g; const float* b; int nslot;
    __device__ __forceinline__ void operator()(EPI_ARGS) const {
        LAS float* tabC = tab + 512; ln_tables(tab, tabC, st, nslot, u.row0, nullptr, 0, g, b, u.col0);
        const int c8 = u.col0 + wc * 32 + 8 * fq, cl = wc * 32 + 8 * fq; v4u zr[2][4][2];
        EPI_ROWS_BEGIN const size_t off = (size_t)(u.row0 + rloc) * DM + c8; zr[ai][m][0] = *(const GAS v4u*)(zb + off); zr[ai][m][1] = *(const GAS v4u*)(zb + off + 128); EPI_ROWS_END
        EPI_ROWS_BEGIN const size_t off = (size_t)(u.row0 + rloc) * DM + c8; const float mu = tab[2 * rloc], rstd = tab[2 * rloc + 1];
#pragma unroll
            for (int bj = 0; bj < 2; ++bj) { f32x4 x0, x1; unpack8(zr[ai][m][bj], x0, x1);
                const f32x4 g0 = *(const LAS f32x4*)(tabC + cl + bj * 128), g1 = *(const LAS f32x4*)(tabC + cl + bj * 128 + 4), b0 = *(const LAS f32x4*)(tabC + 256 + cl + bj * 128), b1 = *(const LAS f32x4*)(tabC + 256 + cl + bj * 128 + 4);
                x0 = (x0 - mu) * rstd * g0 + b0; x1 = (x1 - mu) * rstd * g1 + b1;
                *(GAS v4u*)(zb + off + bj * 128) = pack8(x0 * ALPHA + acc[ai][bj][m][0] * rs, x1 * ALPHA + acc[ai][bj][m][1] * rs); } EPI_ROWS_END
        LDS_WAIT(); __builtin_amdgcn_s_barrier(); asm volatile("" ::: "memory");
    } };
struct EpiFold { unsigned char* kft; unsigned char* vft; const float* g; const float* b; float* sc; LAS float* tab;
    __device__ __forceinline__ void operator()(EPI_ARGS) const {
        if (u.z) {
            v2u hold8[2];
            EPI_ROWS_BEGIN
#pragma unroll
                for (int bj = 0; bj < 2; ++bj) { const f32x4 v0 = acc[ai][bj][m][0] * SV8, v1 = acc[ai][bj][m][1] * SV8; v2u w; w.x = pk4_fp8(v0[0], v0[1], v0[2], v0[3]); w.y = pk4_fp8(v1[0], v1[1], v1[2], v1[3]); ST8_ROWPAIR(vft, u.row0 + rloc, u.col0 + wc * 32 + 8 * (fq & 2) + bj * 128, hold8[bj], w, 1024); } EPI_ROWS_END
            return; }
        float ss[8], qq[8]; const int c8 = u.col0 + wc * 32 + 8 * fq, cl = wc * 32 + 8 * fq; LAS float* tabC = tab + 2048;
        { const int t = opaque_tid(); if (t < 256) tabC[t] = g[u.col0 + t] * CSC; else tabC[t] = b[u.col0 + t - 256] * CSC; }
        LDS_WAIT(); __builtin_amdgcn_s_barrier(); asm volatile("" ::: "memory");
        v2u hold8[2];
        EPI_ROWS_BEGIN float s = 0.f, q = 0.f;
#pragma unroll
            for (int bj = 0; bj < 2; ++bj) { const f32x4 g0 = *(const LAS f32x4*)(tabC + cl + bj * 128), g1 = *(const LAS f32x4*)(tabC + cl + bj * 128 + 4), b0 = *(const LAS f32x4*)(tabC + 256 + cl + bj * 128), b1 = *(const LAS f32x4*)(tabC + 256 + cl + bj * 128 + 4);
                const f32x4 k0 = acc[ai][bj][m][0] * g0, k1 = acc[ai][bj][m][1] * g1, c0 = acc[ai][bj][m][0] * b0, c1 = acc[ai][bj][m][1] * b1;
                s += ((k0[0] + k0[1]) + (k0[2] + k0[3])) + ((k1[0] + k1[1]) + (k1[2] + k1[3])); q += ((c0[0] + c0[1]) + (c0[2] + c0[3])) + ((c1[0] + c1[1]) + (c1[2] + c1[3]));
                v2u w; w.x = pk4_fp8(k0[0] * SK8, k0[1] * SK8, k0[2] * SK8, k0[3] * SK8); w.y = pk4_fp8(k1[0] * SK8, k1[1] * SK8, k1[2] * SK8, k1[3] * SK8); ST8_ROWPAIR(kft, u.row0 + rloc, u.col0 + wc * 32 + 8 * (fq & 2) + bj * 128, hold8[bj], w, 1024); }
            s += __shfl_xor(s, 16); s += __shfl_xor(s, 32); q += __shfl_xor(q, 16); q += __shfl_xor(q, 32); ss[ai * 4 + m] = s; qq[ai * 4 + m] = q; EPI_ROWS_END
        rowpair_publish(tab, sc, 4, u.col0 >> 8, u.row0, ss, qq, wr, wc, fr, fq);
    } };
struct EpiStore { bf16* base0; bf16* base1; float s0, s1; int ldc; int f8mask = 0;
    __device__ __forceinline__ void operator()(EPI_ARGS) const {
        bf16* base = u.z ? base1 : base0; const float sc = u.z ? s1 : s0;
        if ((f8mask >> (u.z ? 1 : 0)) & 1) { unsigned char* b8 = (unsigned char*)base;
            v2u hold8[2];
            EPI_ROWS_BEGIN
#pragma unroll
                for (int bj = 0; bj < 2; ++bj) { const f32x4 v0 = acc[ai][bj][m][0] * sc, v1 = acc[ai][bj][m][1] * sc; v2u w; w.x = pk4_fp8(v0[0], v0[1], v0[2], v0[3]); w.y = pk4_fp8(v1[0], v1[1], v1[2], v1[3]); ST8_ROWPAIR(b8, u.row0 + rloc, u.col0 + wc * 32 + 8 * (fq & 2) + bj * 128, hold8[bj], w, (size_t)ldc); } EPI_ROWS_END
            return; }
        EPI_ROWS_BEGIN bf16* rowp = base + (size_t)(u.row0 + rloc) * ldc + u.col0 + wc * 32 + 8 * fq;
#pragma unroll
            for (int bj = 0; bj < 2; ++bj) *(GAS v4u*)(rowp + bj * 128) = pack8(acc[ai][bj][m][0] * sc, acc[ai][bj][m][1] * sc); EPI_ROWS_END
    } };
struct EpiH0 { bf16* uv; bf16* qx; bf16* kx; bf16* vx; float rs;
    __device__ __forceinline__ void operator()(EPI_ARGS) const {
        const int pn = u.col0 >> 8, kind = pn < 4 ? 0 : ((pn - 4) >> 1) + 1;
        bf16* base = kind == 0 ? uv : kind == 1 ? qx : kind == 2 ? kx : vx;
        EPI_ROWS_BEGIN bf16* rowp = base + (size_t)(u.row0 + rloc) * DM;
#pragma unroll
            for (int bj = 0; bj < 2; ++bj) { f32x4 v0 = acc[ai][bj][m][0] * rs, v1 = acc[ai][bj][m][1] * rs;
                if (kind == 0) {
#pragma unroll
                    for (int j = 0; j < 4; ++j) { v0[j] = gelu_tanh(v0[j]); v1[j] = gelu_tanh(v1[j]); }
                    *(GAS v4u*)(rowp + u.col0 + bj * 128 + wc * 32 + 8 * fq) = pack8(v0, v1); }
                else { const int cr = ((pn - 4) & 1) * 256 + bj * 128 + wc * 32 + 8 * fq;
                    if (kind == 1) { v0 = v0 * C2; v1 = v1 * C2; }
                    *(GAS v4u*)(rowp + cr) = pack8(v0, v1); } } EPI_ROWS_END
    } };
struct EpiResid { const bf16* xb; bf16* zb; float rs = 1.0f;
    __device__ __forceinline__ void operator()(EPI_ARGS) const {
        EPI_ROWS_BEGIN const size_t off = (size_t)(u.row0 + rloc) * DM + u.col0 + wc * 32 + 8 * fq;
#pragma unroll
            for (int bj = 0; bj < 2; ++bj) { f32x4 x0, x1; unpack8(*(const GAS v4u*)(xb + off + bj * 128), x0, x1);
                *(GAS v4u*)(zb + off + bj * 128) = pack8(x0 * ALPHA + acc[ai][bj][m][0] * rs, x1 * ALPHA + acc[ai][bj][m][1] * rs); } EPI_ROWS_END
    } };
struct EpiUG { bf16* ug; float rs;
    __device__ __forceinline__ void operator()(EPI_ARGS) const {
        EPI_ROWS_BEGIN
#pragma unroll
            for (int bj = 0; bj < 2; ++bj) { const int col = u.col0 + bj * 128 + wc * 32 + 8 * fq;
                *(GAS v4u*)(ug + ((size_t)(col >> 4) * MTOK + (u.row0 + rloc)) * 16 + (col & 15)) = pack8(acc[ai][bj][m][0] * rs, acc[ai][bj][m][1] * rs); } EPI_ROWS_END
    } };
struct EpiScore { float* sc;
    __device__ __forceinline__ void operator()(EPI_ARGS) const {
        EPI_ROWS_BEGIN float* rowp = sc + (size_t)(u.row0 + rloc) * DM + u.col0 + wc * 32 + 8 * fq;
#pragma unroll
            for (int bj = 0; bj < 2; ++bj) { *(GAS f32x4*)(rowp + bj * 128) = acc[ai][bj][m][0]; *(GAS f32x4*)(rowp + bj * 128 + 4) = acc[ai][bj][m][1]; } EPI_ROWS_END
    } };
struct EpiSoftmaxP { bf16* P; LAS float* tab; float rs0; const float* st; const float* sc; int nslot;
    __device__ __forceinline__ void operator()(EPI_ARGS) const {
        { auto& A = const_cast<f32x4 (&)[2][2][4][2]>(acc); LAS float* tabC = tab + 512; ln_tables(tab, tabC, st, nslot, u.row0, sc, u.z * 1024 + u.col0, nullptr, nullptr, 0);
          const int cl = wc * 32 + 8 * fq;
          EPI_ROWS_BEGIN const float mu = tab[2 * rloc], rstd = tab[2 * rloc + 1];
#pragma unroll
              for (int bj = 0; bj < 2; ++bj)
#pragma unroll
                  for (int n = 0; n < 2; ++n) { const f32x4 s1 = *(const LAS f32x4*)(tabC + cl + bj * 128 + 4 * n), c1 = *(const LAS f32x4*)(tabC + 256 + cl + bj * 128 + 4 * n);
                      A[ai][bj][m][n] = (A[ai][bj][m][n] * rs0 - s1 * mu) * rstd + c1; } EPI_ROWS_END
          LDS_WAIT(); __builtin_amdgcn_s_barrier(); asm volatile("" ::: "memory"); }
        constexpr float rs = 1.0f;
        EPI_ROWS_BEGIN float mx = -3.0e38f;
#pragma unroll
            for (int bj = 0; bj < 2; ++bj)
#pragma unroll
                for (int n = 0; n < 2; ++n)
#pragma unroll
                    for (int j = 0; j < 4; ++j) mx = fmaxf(mx, acc[ai][bj][m][n][j]);
            mx *= rs; mx = fmaxf(mx, __shfl_xor(mx, 16)); mx = fmaxf(mx, __shfl_xor(mx, 32));
            float sm = 0.f;
#pragma unroll
            for (int bj = 0; bj < 2; ++bj)
#pragma unroll
                for (int n = 0; n < 2; ++n)
#pragma unroll
                    for (int j = 0; j < 4; ++j) sm += __builtin_amdgcn_exp2f(acc[ai][bj][m][n][j] * rs - mx);
            sm += __shfl_xor(sm, 16); sm += __shfl_xor(sm, 32);
            if (fq == 0) { tab[(rloc * 4 + wc) * 2] = mx; tab[(rloc * 4 + wc) * 2 + 1] = sm; } EPI_ROWS_END
        LDS_WAIT(); __builtin_amdgcn_s_barrier(); asm volatile("" ::: "memory");
        v2u holdP[2];
        EPI_ROWS_BEGIN const f32x4 a = *(const LAS f32x4*)(tab + rloc * 8), b = *(const LAS f32x4*)(tab + rloc * 8 + 4);
            const float M = fmaxf(fmaxf(a[0], a[2]), fmaxf(b[0], b[2]));
            const float S = a[1] * __builtin_amdgcn_exp2f(a[0] - M) + a[3] * __builtin_amdgcn_exp2f(a[2] - M) + b[1] * __builtin_amdgcn_exp2f(b[0] - M) + b[3] * __builtin_amdgcn_exp2f(b[2] - M);
            const float inv = SP8 / S;
#pragma unroll
            for (int bj = 0; bj < 2; ++bj) { f32x4 v0, v1;
#pragma unroll
                for (int j = 0; j < 4; ++j) { v0[j] = __builtin_amdgcn_exp2f(acc[ai][bj][m][0][j] * rs - M) * inv; v1[j] = __builtin_amdgcn_exp2f(acc[ai][bj][m][1][j] * rs - M) * inv; }
                v2u w; w.x = pk4_fp8(v0[0], v0[1], v0[2], v0[3]); w.y = pk4_fp8(v1[0], v1[1], v1[2], v1[3]); ST8_ROWPAIR(P, u.row0 + rloc, u.col0 + wc * 32 + 8 * (fq & 2) + bj * 128, holdP[bj], w, DM); } EPI_ROWS_END
        LDS_WAIT(); __builtin_amdgcn_s_barrier(); asm volatile("" ::: "memory");
    } };
struct EpiRouter { float* logit;
    __device__ __forceinline__ void operator()(EPI_ARGS) const {
        if (wc == 0) { EPI_ROWS_BEGIN float* rowp = logit + (size_t)(u.row0 + rloc) * 32 + 8 * fq; *(GAS f32x4*)(rowp) = acc[ai][0][m][0]; *(GAS f32x4*)(rowp + 4) = acc[ai][0][m][1]; EPI_ROWS_END }
    } };
struct EpiSwiglu { const float* bup; bf16* act;
    __device__ __forceinline__ void operator()(EPI_ARGS) const {
        const int j0 = u.col0 + wc * 32 + 8 * fq; const float* bb = bup + (size_t)u.z * 2048;
        const f32x4 bg0 = *(const GAS f32x4*)(bb + j0), bg1 = *(const GAS f32x4*)(bb + j0 + 4), bl0 = *(const GAS f32x4*)(bb + 1024 + j0), bl1 = *(const GAS f32x4*)(bb + 1024 + j0 + 4);
        EPI_ROWS_BEGIN f32x4 o0, o1;
#pragma unroll
            for (int j = 0; j < 4; ++j) {
                { const float gl = fminf(acc[ai][0][m][0][j] + bg0[j], 7.0f), ln = fminf(fmaxf(acc[ai][1][m][0][j] + bl0[j], -7.0f), 7.0f); o0[j] = gl * sigmoidf_(1.702f * gl) * (ln + 1.0f); }
                { const float gl = fminf(acc[ai][0][m][1][j] + bg1[j], 7.0f), ln = fminf(fmaxf(acc[ai][1][m][1][j] + bl1[j], -7.0f), 7.0f); o1[j] = gl * sigmoidf_(1.702f * gl) * (ln + 1.0f); } }
            *(GAS v4u*)(act + (size_t)(u.row0 + rloc) * DM + j0) = pack8(o0, o1); EPI_ROWS_END
    } };
struct EpiDown { const float* bdn; const int* list; const float* gate; bf16* ys; LAS const int* tab;
    __device__ __forceinline__ void operator()(EPI_ARGS) const {
        const int e = u.z, cnt = tab[e], c8 = u.col0 + wc * 32 + 8 * fq; const float* bb = bdn + (size_t)e * 1024 + c8;
        f32x4 bv[2][2];
#pragma unroll
        for (int bj = 0; bj < 2; ++bj) { bv[bj][0] = *(const GAS f32x4*)(bb + bj * 128); bv[bj][1] = *(const GAS f32x4*)(bb + bj * 128 + 4); }
        int av[8]; float gv[8];
#pragma unroll
        for (int i = 0; i < 8; ++i) { const int slot = u.aux * 256 + (i >> 2) * 128 + wr * 64 + (i & 3) * 16 + fr; const int sl = slot < cnt ? slot : 0;
            av[i] = (int)((unsigned)list[(size_t)e * CAP + sl] & (unsigned)(NASSIGN - 1)); }
#pragma unroll
        for (int i = 0; i < 8; ++i) gv[i] = gate[av[i]];
        EPI_ROWS_BEGIN const int slot = u.aux * 256 + rloc; const int a = av[ai * 4 + m]; const float gt = gv[ai * 4 + m]; bf16* rowp = ys + (size_t)a * DM + c8;
            if (slot < cnt) {
#pragma unroll
                for (int bj = 0; bj < 2; ++bj) *(GAS v4u*)(rowp + bj * 128) = pack8((acc[ai][bj][m][0] + bv[bj][0]) * gt, (acc[ai][bj][m][1] + bv[bj][1]) * gt); } EPI_ROWS_END
    } };
struct EpiSwiglu8 { const float* bup; unsigned char* act; int skip; LAS float* slot;
    static constexpr bool HAS_PRE = true;
    __device__ __forceinline__ void pre(const pg8::Unit& u, int wid, int lane) const {
        if (wid < 4) { const int t = wid * 64 + lane; const float* src = bup + (size_t)u.z * 2048 + u.col0 + (t < 128 ? t : 1024 + t - 128);
            __builtin_amdgcn_global_load_lds((const unsigned*)src, (LAS unsigned*)(slot + u.par * 256 + wid * 64), 4, 0, 0); } }
    __device__ __forceinline__ void operator()(EPI_ARGS) const {
        if (skip) {
#pragma unroll
            for (int a = 0; a < 2; ++a)
#pragma unroll
                for (int b = 0; b < 2; ++b)
#pragma unroll
                    for (int m = 0; m < 4; ++m) asm volatile("" :: "v"(acc[a][b][m][0]), "v"(acc[a][b][m][1])); return; }
        const int j0 = u.col0 + wc * 32 + 8 * fq; constexpr float RS = 1.0f / (SX8 * SWU8); const LAS float* sb = slot + u.par * 256 + wc * 32 + 8 * fq;
        const f32x4 bg0 = *(const LAS f32x4*)(sb), bg1 = *(const LAS f32x4*)(sb + 4), bl0 = *(const LAS f32x4*)(sb + 128), bl1 = *(const LAS f32x4*)(sb + 132);
        typedef float f32x2 __attribute__((ext_vector_type(2)));
        v2u wq[2][4];
        EPI_ROWS_BEGIN f32x4 o0, o1;
#pragma unroll
            for (int n = 0; n < 2; ++n)
#pragma unroll
                for (int h = 0; h < 2; ++h) {
                    const f32x4 ga = acc[ai][0][m][n], la = acc[ai][1][m][n], bgv = n ? bg1 : bg0, blv = n ? bl1 : bl0;
                    const f32x2 g2 = h ? ga.hi : ga.lo, l2 = h ? la.hi : la.lo, bg2 = h ? bgv.hi : bgv.lo, bl2 = h ? blv.hi : blv.lo;
                    f32x2 gl = g2 * RS + bg2, ln = l2 * RS + bl2;
                    gl.x = fminf(gl.x, 7.0f); gl.y = fminf(gl.y, 7.0f); ln.x = __builtin_amdgcn_fmed3f(ln.x, -7.0f, 7.0f); ln.y = __builtin_amdgcn_fmed3f(ln.y, -7.0f, 7.0f);
                    const f32x2 ea = gl * (-1.702f * LOG2E); f32x2 d; d.x = __builtin_amdgcn_exp2f(ea.x); d.y = __builtin_amdgcn_exp2f(ea.y); d = d + 1.0f;
                    f32x2 rc; rc.x = __builtin_amdgcn_rcpf(d.x); rc.y = __builtin_amdgcn_rcpf(d.y);
                    const f32x2 o = (gl * rc) * (ln * SA8 + SA8);
                    if (n == 0) { o0[2 * h] = o.x; o0[2 * h + 1] = o.y; } else { o1[2 * h] = o.x; o1[2 * h + 1] = o.y; } }
            v2u w; { int r0 = __builtin_amdgcn_cvt_pk_fp8_f32(o0[0], o0[1], 0, false); r0 = __builtin_amdgcn_cvt_pk_fp8_f32(o0[2], o0[3], r0, true); int r1 = __builtin_amdgcn_cvt_pk_fp8_f32(o1[0], o1[1], 0, false); r1 = __builtin_amdgcn_cvt_pk_fp8_f32(o1[2], o1[3], r1, true); w.x = (unsigned)r0; w.y = (unsigned)r1; }
            wq[ai][m] = w; EPI_ROWS_END
#pragma unroll
        for (int ai = 0; ai < 2; ++ai)
#pragma unroll
            for (int mp = 0; mp < 2; ++mp) { const size_t rA = (size_t)(u.row0 + ai * 128 + wr * 64 + (2 * mp) * 16 + fr);
                store_rowpair16(act, rA, rA + 16, u.col0 + wc * 32 + 8 * (fq & 2), fq, wq[ai][2 * mp], wq[ai][2 * mp + 1]); }
    } };
struct EpiDown8 { const float* bdn; bf16* ys; LAS float* slot;
    static constexpr bool HAS_PRE = true;
    __device__ __forceinline__ void pre(const pg8::Unit& u, int wid, int lane) const {
        if (wid < 4) __builtin_amdgcn_global_load_lds((const unsigned*)(bdn + (size_t)u.z * 1024 + u.col0 + wid * 64 + lane), (LAS unsigned*)(slot + u.par * 256 + wid * 64), 4, 0, 0); }
    __device__ __forceinline__ void operator()(EPI_ARGS) const {
        const int c8 = u.col0 + wc * 32 + 8 * fq; const LAS float* bb = slot + u.par * 256 + wc * 32 + 8 * fq; constexpr float RS = 1.0f / (SA8 * SWD8);
        f32x4 bv[2][2];
#pragma unroll
        for (int bj = 0; bj < 2; ++bj) { bv[bj][0] = *(const LAS f32x4*)(bb + bj * 128); bv[bj][1] = *(const LAS f32x4*)(bb + bj * 128 + 4); }
#pragma unroll
        for (int ai = 0; ai < 2; ++ai)
#pragma unroll
            for (int mp = 0; mp < 2; ++mp) { const size_t rA = (size_t)(u.row0 + ai * 128 + wr * 64 + (2 * mp) * 16 + fr);
#pragma unroll
                for (int bj = 0; bj < 2; ++bj) { v2u w[2];
#pragma unroll
                    for (int mm = 0; mm < 2; ++mm) { const int m = 2 * mp + mm; const f32x4 v0 = (acc[ai][bj][m][0] * RS + bv[bj][0]) * SY8, v1 = (acc[ai][bj][m][1] * RS + bv[bj][1]) * SY8; w[mm].x = pk4_fp8(v0[0], v0[1], v0[2], v0[3]); w[mm].y = pk4_fp8(v1[0], v1[1], v1[2], v1[3]); }
                    store_rowpair16((unsigned char*)ys, rA, rA + 16, u.col0 + wc * 32 + 8 * (fq & 2) + bj * 128, fq, w[0], w[1]); } }
    } };
struct EpiValGate { const bf16* xb; bf16* zb; float rsv, rsg; unsigned char* z8; float* st; LAS float* tab;
    __device__ __forceinline__ void operator()(EPI_ARGS) const {
        float ss[8], qq[8]; v4u xr[2][4];
        EPI_ROWS_BEGIN xr[ai][m] = *(const GAS v4u*)(xb + (size_t)(u.row0 + rloc) * DM + u.col0 + wc * 32 + 8 * fq); EPI_ROWS_END
        v2u hold8;
        EPI_ROWS_BEGIN const size_t off = (size_t)(u.row0 + rloc) * DM + u.col0 + wc * 32 + 8 * fq; f32x4 x0, x1; unpack8(xr[ai][m], x0, x1); f32x4 o0, o1;
#pragma unroll
            for (int j = 0; j < 4; ++j) { o0[j] = x0[j] * ALPHA + acc[ai][0][m][0][j] * rsv * sigmoidf_(acc[ai][1][m][0][j] * rsg); o1[j] = x1[j] * ALPHA + acc[ai][0][m][1][j] * rsv * sigmoidf_(acc[ai][1][m][1][j] * rsg); }
            *(GAS v4u*)(zb + off) = pack8(o0, o1);
            { v2u w; w.x = pk4_fp8(o0[0] * SZ8, o0[1] * SZ8, o0[2] * SZ8, o0[3] * SZ8); w.y = pk4_fp8(o1[0] * SZ8, o1[1] * SZ8, o1[2] * SZ8, o1[3] * SZ8); ST8_ROWPAIR(z8, u.row0 + rloc, u.col0 + wc * 32 + 8 * (fq & 2), hold8, w, DM); }
            float s = ((o0[0] + o0[1]) + (o0[2] + o0[3])) + ((o1[0] + o1[1]) + (o1[2] + o1[3])), q = ((o0[0] * o0[0] + o0[1] * o0[1]) + (o0[2] * o0[2] + o0[3] * o0[3])) + ((o1[0] * o1[0] + o1[1] * o1[1]) + (o1[2] * o1[2] + o1[3] * o1[3]));
            s += __shfl_xor(s, 16); s += __shfl_xor(s, 32); q += __shfl_xor(q, 16); q += __shfl_xor(q, 32); ss[ai * 4 + m] = s; qq[ai * 4 + m] = q;
            asm volatile("" ::: "memory"); EPI_ROWS_END
        rowpair_publish(tab, st, 8, u.col0 >> 7, u.row0, ss, qq, wr, wc, fr, fq);
    } };

#ifndef ONLY_SITE
#define ONLY_SITE -1
#endif
#define SITE(s) (ONLY_SITE < 0 || ONLY_SITE == (s))
#define IN(k) (lo <= (k) && (k) < hi)
#define SEAM(k) do { if (IN(k) && IN((k) + 1)) xcd_barrier(bar); } while (0)
template <int l>
__device__ __forceinline__ void layer_shared(Frame& F, const Args& args, const XcdBarrier& bar, const int lo, const int hi) {
    unsigned char* ws = args.ws; bf16* const XB = (bf16*)(ws + WS_XB); bf16* const ZB = (bf16*)(ws + WS_ZB); const int cid = (int)blockIdx.x;
    constexpr int pb = 5 + 14 * l;
        gu32* cnt = F.ctl + CW_CNT + l * 32 * 64;
    const float* st1 = (const float*)(ws + WS_ST) + (size_t)l * MTOK * 16; const float* sc1 = (const float*)(ws + WS_SCC) + (size_t)l * 16384 * 8;
    if (IN(pb + 1) && SITE(6)) { PlainSched S; S.T.init(MTOK / 256, 4, F.G, cid); S.A = (const char*)(ws + WS_XFZ); S.B = (const char*)(ws + WS_KFT); S.tilesPerBatch = SEQ / 256; S.bBatch = (size_t)1024 * 1024; S.splitN = 0; S.aT = (size_t)256 * 1024; S.bT = (size_t)256 * 1024;
        EpiSoftmaxP E{(bf16*)(ws + WS_P), (LAS float*)(F.lds + SMX_OFF), 1.0f / (SZ8 * SK8), st1, sc1, l ? 8 : 4}; pg8::gemm_phase<EpiSoftmaxP, PlainSched, false, true>(F.lds, 1024, S, E); } SEAM(pb + 1);
    if (IN(pb + 3) && SITE(8)) { PlainSched S; S.T.init(MTOK / 256, 4, F.G, cid); S.A = (const char*)(ws + WS_P); S.B = (const char*)(ws + WS_VFT); S.tilesPerBatch = SEQ / 256; S.bBatch = (size_t)1024 * 1024; S.splitN = 0; S.aT = (size_t)256 * 1024; S.bT = (size_t)256 * 1024;
        EpiResidLN E{ZB, 1.0f / (SP8 * SV8), st1, (LAS float*)(F.lds + SMX_OFF), (l ? args.in[39] : args.in[14]), (l ? args.in[40] : args.in[15]), l ? 8 : 4}; pg8::gemm_phase<EpiResidLN, PlainSched, false, true>(F.lds, 1024, S, E); } SEAM(pb + 3);
    if (IN(pb + 4) && SITE(9)) { ph_ln2_router(F, ZB, XB, MOE_FP8 ? ws + WS_XF8 : nullptr, (l ? args.in[43] : args.in[18]), (l ? args.in[44] : args.in[19]), (const bf16*)(ws + WS_WR) + (size_t)l * 256 * 1024,
                                               (l ? args.in[46] : args.in[21]), cnt, (int*)(ws + WS_LIST), (float*)(ws + WS_GATE), (int*)(ws + WS_ASG), (float*)(ws + WS_ST2)); } SEAM(pb + 4);
    if (IN(pb + 7) && SITE(12)) { moe_tables(F, cnt);
#if MOE_FP8
        MoeSched S{(LAS const int*)(F.lds + TAB_OFF), 8, F.G, F.vcu, (const char*)(ws + WS_XF8), (const char*)(ws + WS_WUP8), (size_t)2048 * 1024, 128, (const int*)(ws + WS_LIST), true, (size_t)256 * 1024};
        EpiSwiglu8 E{(l ? args.in[48] : args.in[23]), ws + WS_ACT, args.variant == 9, (LAS float*)(F.lds + SMX_OFF)}; pg8::gemm_phase<EpiSwiglu8, MoeSched, true, true>(F.lds, 1024, S, E);
#else
        MoeSched S{(LAS const int*)(F.lds + TAB_OFF), 8, F.G, F.vcu, (const char*)XB, (const char*)(ws + WS_WUP), (size_t)2048 * 1024 * 2, 128, (const int*)(ws + WS_LIST), true, pg8::TSTEP};
        EpiSwiglu E{(l ? args.in[48] : args.in[23]), (bf16*)(ws + WS_ACT)}; pg8::gemm_phase<EpiSwiglu, MoeSched, true>(F.lds, 1024, S, E);
#endif
    } SEAM(pb + 7);
    if (IN(pb + 8) && SITE(13)) { moe_tables(F, cnt);
#if MOE_FP8
        MoeSched S{(LAS const int*)(F.lds + TAB_OFF), 4, F.G, F.vcu, (const char*)(ws + WS_ACT), (const char*)(ws + WS_WDN8), (size_t)1024 * 1024, 256, (const int*)(ws + WS_LIST), false, (size_t)256 * 1024};
        EpiDown8 E{(l ? args.in[50] : args.in[25]), (bf16*)(ws + WS_YS), (LAS float*)(F.lds + SMX_OFF)}; pg8::gemm_phase<EpiDown8, MoeSched, false, true>(F.lds, 1024, S, E);
#else
        MoeSched S{(LAS const int*)(F.lds + TAB_OFF), 4, F.G, F.vcu, (const char*)(ws + WS_ACT), (const char*)(ws + WS_WDN), (size_t)1024 * 1024 * 2, 256, (const int*)(ws + WS_LIST), false, pg8::TSTEP};
        EpiDown E{(l ? args.in[50] : args.in[25]), (const int*)(ws + WS_LIST), (const float*)(ws + WS_GATE), (bf16*)(ws + WS_YS), (LAS const int*)(F.lds + TAB_OFF)}; pg8::gemm_phase<EpiDown, MoeSched, false>(F.lds, 1024, S, E);
#endif
    } SEAM(pb + 8);
    if (IN(pb + 9) && SITE(14)) { moe_tables(F, cnt); ph_ln<1>(F, ZB, (const bf16*)(ws + WS_YS), XB, l ? args.out : nullptr, (l ? args.in[51] : args.in[26]), (l ? args.in[52] : args.in[27]), (l == 0) ? ws + WS_XF8 : nullptr, (const int*)(ws + WS_ASG), (const float*)(ws + WS_GATE),
                                                             (const float*)(ws + WS_ST2), (l ? args.in[43] : args.in[18]), (l ? args.in[44] : args.in[19]));
        if (l == 0) { __syncthreads(); cvt_experts(F, args.in[47], args.in[49], ws); } } SEAM(pb + 9);
}

constexpr int PH_TOTAL = 29;
__global__ void __launch_bounds__(NWAVES * 64, 2) mk_fwd(Args args) {
    extern __shared__ __attribute__((aligned(16))) unsigned char lds[];
    Frame F;
    F.lds = (LAS unsigned char*)lds; F.MISC = (volatile LAS unsigned*)(F.lds + MISC_OFF);
    F.wave = __builtin_amdgcn_readfirstlane((int)threadIdx.x >> 6);
    F.G = gridDim.x; { const int bx = blockIdx.x; F.vcu = (F.G % 8 == 0) ? (bx % 8) * (F.G / 8) + bx / 8 : bx; }
    unsigned char* ws = args.ws;
    F.ctl = (gu32*)(ws + WS_CTL);
    for (int u = FTID; u < (LDS_BYTES - LDSCTL_OFF) / 4; u += NWAVES * 64) ((LAS unsigned*)(F.lds + LDSCTL_OFF))[u] = 0u;
    __syncthreads();
    const int lo = args.ph_lo, hi = args.ph_hi;
    XcdBarrier bar; bar.bar = (unsigned*)(F.ctl + CW_BAR); bar.x = 0; bar.st = nullptr;
    if (hi - lo > 1) bar = xcd_barrier_post((unsigned*)(F.ctl + CW_BAR), F.MISC + 8);
    bf16* const XB = (bf16*)(ws + WS_XB); bf16* const ZB = (bf16*)(ws + WS_ZB);
    const int cid = (int)blockIdx.x;

    if (IN(0) && SITE(0)) { p0_prologue(F, args); } SEAM(0);
    if (IN(1) && SITE(1)) {
        { PlainSched S; S.T.init(MTOK / 256, HW0 / 256, F.G, cid); S.A = (const char*)XB; S.B = (const char*)(ws + WS_WIN0); S.tilesPerBatch = 1 << 20; S.bBatch = 0; S.splitN = 0;
          EpiH0 E{(bf16*)(ws + WS_UV), (bf16*)(ws + WS_QX), (bf16*)(ws + WS_QX) + 512, (bf16*)(ws + WS_VX), 1.0f}; pg8::gemm_phase<EpiH0, PlainSched>(F.lds, 1024, S, E); }
        { PlainSched S; S.T.init(NB * MEMLEN / 256, 2048 / 256, F.G, cid); S.A = (const char*)(ws + WS_MEMB); S.B = (const char*)(ws + WS_WKV); S.tilesPerBatch = 1 << 20; S.bBatch = 0; S.splitN = 4;
          EpiStore E{(bf16*)(ws + WS_KB), (bf16*)(ws + WS_VB), 1.f, 1.f, 1024}; pg8::gemm_phase<EpiStore, PlainSched>(F.lds, 1024, S, E); }
    } SEAM(1);
    if (IN(2) && SITE(2)) {
        attn_body::bf16* oat = (attn_body::bf16*)(ws + WS_OATT);
        { const attn_body::AttnTensors AT{(const attn_body::bf16*)(ws + WS_QX), (const attn_body::bf16*)(ws + WS_QX) + 512, (const attn_body::bf16*)(ws + WS_VX), oat};
          const attn_body::StaticOrder S((int)F.G, (int)blockIdx.x); attn_body::attn_phase<attn_body::StaticOrder>((char*)lds, AT, S); }
        VM_WAIT(); __syncthreads();
        if (F.G == 256) combine_local(F, (const bf16*)(ws + WS_OATT), (bf16*)(ws + WS_MIX), args.in[8], args.in[9], args.in[10], args.in[11], args.in[12], F.vcu >> 4, (F.vcu >> 2) & 3, F.vcu & 3);
        __syncthreads();
        ph_sgu(F, (const bf16*)(ws + WS_UV), (bf16*)(ws + WS_MIX), args.in[4], args.in[5], args.in[6], args.in[7]);
    } SEAM(2);
    if (IN(4) && SITE(4)) {
        { PlainSched S; S.T.init(MTOK / 256, 4, F.G, cid); S.A = (const char*)(ws + WS_MIX); S.B = (const char*)(ws + WS_WOUT0); S.tilesPerBatch = 1 << 20; S.bBatch = 0; S.splitN = 0;
          EpiResidStats E{XB, ZB, ws + WS_XFZ, (float*)(ws + WS_ST), (LAS float*)(F.lds + SMX_OFF)}; pg8::gemm_phase<EpiResidStats, PlainSched>(F.lds, 1024, S, E); }
        { FoldSched S{F.G, F.vcu, 0, (const char*)(ws + WS_KB), (const char*)(ws + WS_VB), (const char*)(ws + WS_XQB), (const char*)(ws + WS_XOT)};
          EpiFold E{ws + WS_KFT, ws + WS_VFT, args.in[14], args.in[15], (float*)(ws + WS_SCC), (LAS float*)(F.lds + SMX_OFF)}; int kf = 256; asm volatile("" : "+s"(kf)); pg8::gemm_phase<EpiFold, FoldSched>(F.lds, kf, S, E); }
    } SEAM(4);

    layer_shared<0>(F, args, bar, lo, hi);
    if (IN(15) && SITE(15)) { { PlainSched S; S.T.init(MTOK / 256, 4, F.G, cid); S.A = (const char*)(ws + WS_XF8); S.B = (const char*)(ws + WS_WIN1); S.tilesPerBatch = 1 << 20; S.bBatch = 0; S.splitN = 0; S.aT = (size_t)256 * 1024; S.bT = (size_t)256 * 1024;
        EpiUG E{(bf16*)(ws + WS_UG), 1.0f / (SX8 * SWU8)}; pg8::gemm_phase<EpiUG, PlainSched, false, true>(F.lds, 1024, S, E); }
        { FoldSched S{F.G, F.vcu, 0, (const char*)(ws + WS_KB), (const char*)(ws + WS_VB), (const char*)(ws + WS_XQB) + 1024 * 1024 * 2, (const char*)(ws + WS_XOT) + 1024 * 1024 * 2};
      EpiFold E{ws + WS_KFT, ws + WS_VFT, args.in[39], args.in[40], (float*)(ws + WS_SCC) + (size_t)16384 * 8, (LAS float*)(F.lds + SMX_OFF)}; int kf = 256; asm volatile("" : "+s"(kf)); pg8::gemm_phase<EpiFold, FoldSched>(F.lds, kf, S, E); }
    } SEAM(15);
    if (IN(16) && SITE(16)) { ph_s5(F, (const bf16*)(ws + WS_UG), (bf16*)(ws + WS_YB), args.in[29], args.in[30], args.in[31], args.in[32], args.in[33], args.in[34], args.in[35], args.in[36], args.variant); } SEAM(16);
    if (IN(17) && SITE(17)) { PlainSched S; S.T.init(MTOK / 256, 8, F.G, cid); S.A = (const char*)(ws + WS_YB); S.B = (const char*)(ws + WS_WVG); S.tilesPerBatch = 1 << 20; S.bBatch = 0; S.splitN = 0; S.aT = (size_t)256 * 16; S.bT = (size_t)256 * 1024;
        struct VGS { PlainSched P; __device__ __forceinline__ bool next(int i, pg8::Unit& u) const { if (!P.next(i, u)) return false; u.col0 >>= 1; return true; } } S2{S};
        EpiValGate E{XB, ZB, 1.0f / (SA8 * SWD8), 1.0f / (SA8 * SWU8), ws + WS_XFZ, (float*)(ws + WS_ST) + (size_t)MTOK * 16, (LAS float*)(F.lds + SMX_OFF)}; pg8::gemm_phase<EpiValGate, VGS, false, true, 1>(F.lds, 1024, S2, E); } SEAM(17);
    layer_shared<1>(F, args, bar, lo, hi);
#undef IN
#undef SEAM
}

extern "C" void kernel_launch(void* const* d_in, const int* in_sizes, int n_in, void* d_out, int out_size, void* d_ws, size_t ws_size, hipStream_t stream) {
    static int grid = 0;
    if (grid == 0) {
        if (n_in != 53 || in_sizes[0] != MTOK * DM || out_size != MTOK * DM || ws_size < WS_END) { fprintf(stderr, "kernel_launch: unexpected problem (n_in %d, in0 %d, out %d, ws %zu < %zu); nothing launched\n", n_in, n_in > 0 ? in_sizes[0] : -1, out_size, ws_size, (size_t)WS_END); grid = -1; return; }
        int dev = 0, cus = 0, per_cu = 0;
        if (hipGetDevice(&dev) != hipSuccess || hipDeviceGetAttribute(&cus, hipDeviceAttributeMultiprocessorCount, dev) != hipSuccess) { grid = -1; return; }
        if (hipFuncSetAttribute((const void*)mk_fwd, hipFuncAttributeMaxDynamicSharedMemorySize, LDS_BYTES) != hipSuccess) { fprintf(stderr, "kernel_launch: hipFuncSetAttribute failed\n"); grid = -1; return; }
        if (hipOccupancyMaxActiveBlocksPerMultiprocessor(&per_cu, (const void*)mk_fwd, NWAVES * 64, LDS_BYTES) != hipSuccess || per_cu < 1) fprintf(stderr, "kernel_launch: note: occupancy query reports %d\n", per_cu);
        (void)hipGetLastError();
        grid = cus;
    }
    if (grid < 0) return;
    if (hipMemsetAsync((char*)d_ws + WS_CTL, 0, CTL_ZERO_BYTES, stream) != hipSuccess) return;
    Args a{};
    for (int i = 0; i < 53; ++i) a.in[i] = (const float*)d_in[i];
    a.out = (float*)d_out; a.ws = (unsigned char*)d_ws;
#if MK_N_LAUNCHES == 1
    a.ph_lo = 0; a.ph_hi = PH_TOTAL;
    hipLaunchKernelGGL(mk_fwd, dim3(grid), dim3(NWAVES * 64), LDS_BYTES, stream, a);
#else
    for (int p = 0; p < PH_TOTAL; ++p) { if (p == 18 || p == 5 || p == 19) continue; a.ph_lo = p; a.ph_hi = p + 1;
        for (int rep = 0; rep < 1 + (int)(((PROBE_REPEAT_MASK) >> p) & 1ull); ++rep) { a.variant = (rep == 0 && (((PROBE_REPEAT_MASK) >> p) & 1ull)) ? PROBE_VARIANT : 0; hipLaunchKernelGGL(mk_fwd, dim3(grid), dim3(NWAVES * 64), LDS_BYTES, stream, a); } }
#endif
}
```

```cpp
#include <hip/hip_runtime.h>
#include <hip/hip_bf16.h>
#include <cstdio>
#include <cstdint>

#ifndef MK_N_LAUNCHES
#define MK_N_LAUNCHES 1
#endif

#ifndef MOE_FP8
#define MOE_FP8 1
#endif
#ifndef PROBE_VARIANT
#define PROBE_VARIANT 0
#endif
#ifndef PROBE_REPEAT_MASK
#define PROBE_REPEAT_MASK 0ull
#endif
#define GAS __attribute__((address_space(1)))
#define LAS __attribute__((address_space(3)))
typedef unsigned short bf16;
typedef unsigned v4u __attribute__((ext_vector_type(4)));
typedef unsigned v2u __attribute__((ext_vector_type(2)));
typedef float f32x4 __attribute__((ext_vector_type(4)));
typedef float f32x2 __attribute__((ext_vector_type(2)));
typedef short bf16x8 __attribute__((ext_vector_type(8)));
typedef int v4i_t __attribute__((ext_vector_type(4)));
typedef GAS unsigned gu32;
#define RLX_AGENT __ATOMIC_RELAXED, __HIP_MEMORY_SCOPE_AGENT
#define LDS_WAIT() asm volatile("s_waitcnt lgkmcnt(0)" ::: "memory")
#define VM_WAIT() asm volatile("s_waitcnt vmcnt(0)" ::: "memory")

constexpr int NB = 16, SEQ = 2048, DM = 1024, MTOK = NB * SEQ;
constexpr int MEMLEN = 256, NEXP = 32, TOPK = 4, NASSIGN = MTOK * TOPK;
constexpr int HW0 = 2560;
constexpr int CAP = MTOK;
constexpr int MAXBLK = NASSIGN / 256 + NEXP;
constexpr float LN_EPS = 1e-5f;
constexpr float ALPHA = 1.41421356237f;
constexpr float LOG2E = 1.4426950408889634f;
constexpr float C2 = 0.125f * LOG2E;
constexpr float CSC = 0.0625f * LOG2E;
constexpr float LAM_INIT0 = 0.2f;

constexpr size_t MiB = 1u << 20;
constexpr size_t WS_CTL = 0, CTL_ZERO_BYTES = 96 * 1024;
constexpr size_t WS_LIST = 1 * MiB;
constexpr size_t WS_GATE = WS_LIST + 4 * MiB;
constexpr size_t WS_ASG = WS_GATE + 512 * 1024;
constexpr size_t WS_LOGIT = WS_GATE + 1 * MiB;
constexpr size_t WS_WKV = WS_LOGIT + 4 * MiB;
constexpr size_t WS_WIN0 = WS_WKV + 4 * MiB;
constexpr size_t WS_WOUT0 = WS_WIN0 + 5 * MiB;
constexpr size_t WS_XQB = WS_WOUT0 + 2 * MiB;
constexpr size_t WS_XOT = WS_XQB + 4 * MiB;
constexpr size_t WS_WIN1 = WS_XOT + 4 * MiB;
constexpr size_t WS_WVG = WS_WIN1 + 2 * MiB;
constexpr size_t WS_WR = WS_WVG + 4 * MiB;
constexpr size_t WS_MEMB = WS_WR + 1 * MiB;
constexpr size_t WS_KB = WS_MEMB + 8 * MiB;
constexpr size_t WS_VB = WS_KB + 8 * MiB;
constexpr size_t WS_KFT = WS_VB + 8 * MiB;
constexpr size_t WS_VFT = WS_KFT + 32 * MiB;
constexpr size_t WS_WUP = WS_VFT + 32 * MiB;
constexpr size_t WS_WDN = WS_WUP + 128 * MiB;
constexpr size_t WS_XB = WS_WDN + 64 * MiB;
constexpr size_t WS_ZB = WS_XB + 64 * MiB;
constexpr size_t WS_BIG1 = WS_ZB + 64 * MiB;
constexpr size_t WS_BIG2 = WS_BIG1 + 272 * MiB;
constexpr size_t WS_END = WS_BIG2 + 272 * MiB;
static_assert(WS_END <= 1024 * MiB, "workspace map exceeds 1 GiB");
constexpr size_t WS_UV = WS_BIG1;
constexpr size_t WS_QX = WS_BIG1 + 64 * MiB;
constexpr size_t WS_KX = WS_BIG1 + 128 * MiB;
constexpr size_t WS_VX = WS_BIG1 + 192 * MiB;
constexpr size_t WS_SC = WS_BIG1;
constexpr size_t WS_WUP8 = WS_WUP;
constexpr size_t WS_WDN8 = WS_WUP + 64 * MiB;
constexpr size_t WS_XF8 = WS_WUP + 96 * MiB;
constexpr float SX8 = 4.0f, SWU8 = 64.0f, SA8 = 4.0f, SWD8 = 128.0f, SP8 = 256.0f, SV8 = 8.0f, SK8 = 32.0f, SY8 = 32.0f;
constexpr size_t WS_XFZ = WS_WDN;
constexpr size_t WS_SCC = WS_WDN + 32 * MiB;
constexpr size_t WS_ST2 = WS_WDN + 40 * MiB;
constexpr size_t WS_ST = WS_LOGIT;
constexpr float SZ8 = 8.0f;
constexpr size_t WS_ACT = WS_BIG1;
constexpr size_t WS_OATT = WS_BIG2;
constexpr size_t WS_MIX = WS_BIG2 + 64 * MiB;
constexpr size_t WS_P = WS_BIG2 + 128 * MiB;
constexpr size_t WS_UG = WS_BIG2;
constexpr size_t WS_YB = WS_BIG2 + 64 * MiB;
constexpr size_t WS_XG = WS_BIG2;
constexpr size_t WS_YS = WS_BIG2;

constexpr int CW_TMO = 0;
constexpr int CW_BAR = 4096;
constexpr int CW_CNT = 16384;
static_assert((CW_CNT + 64 * 64) * 4 <= (int)CTL_ZERO_BYTES && (CW_BAR + 3456) * 4 <= (int)CTL_ZERO_BYTES, "control words inside the per-call memset");

constexpr int RING_BYTES = 131072;
constexpr int SCR_BYTES = 135168;
constexpr int LDSCTL_OFF = SCR_BYTES, MISC_OFF = LDSCTL_OFF + 320;
constexpr int TAB_OFF = MISC_OFF + 128;
constexpr int SMX_OFF = TAB_OFF + 576;
constexpr int LDS_BYTES = 147456;
static_assert(SMX_OFF % 16 == 0 && SMX_OFF + 8192 <= LDS_BYTES, "LDS map");

__device__ __forceinline__ unsigned f2bf(float f) { unsigned u = __builtin_bit_cast(unsigned, f); return (u + 0x7fffu + ((u >> 16) & 1u)) >> 16; }
typedef float pk2_f32x2 __attribute__((ext_vector_type(2))); typedef __bf16 pk2_bf16x2 __attribute__((ext_vector_type(2)));
__device__ __forceinline__ unsigned pk2(float lo, float hi) { const pk2_f32x2 v = {lo, hi}; return __builtin_bit_cast(unsigned, __builtin_convertvector(v, pk2_bf16x2)); }
__device__ __forceinline__ float bflo(unsigned w) { return __builtin_bit_cast(float, w << 16); }
__device__ __forceinline__ float bfhi(unsigned w) { return __builtin_bit_cast(float, w & 0xffff0000u); }
__device__ __forceinline__ float bf2f(bf16 b) { return __builtin_bit_cast(float, ((unsigned)b) << 16); }
__device__ __forceinline__ float wave_sum(float v) {
#pragma unroll
    for (int o = 1; o < 64; o <<= 1) v += __shfl_xor(v, o);
    return v;
}
__device__ __forceinline__ float wave_max(float v) {
#pragma unroll
    for (int o = 1; o < 64; o <<= 1) v = fmaxf(v, __shfl_xor(v, o));
    return v;
}
__device__ __forceinline__ float gelu_tanh(float x) {
    const float t = x * (0.7978845608f * 2.0f * LOG2E) * (1.0f + 0.044715f * x * x);
    return x * __builtin_amdgcn_rcpf(1.0f + __builtin_amdgcn_exp2f(-t));
}
__device__ __forceinline__ f32x2 gelu_tanh2(f32x2 x, float osc) {
    constexpr float K1 = 0.7978845608f * 2.0f * LOG2E, K2 = K1 * 0.044715f; const float io = 1.0f / osc;
    const f32x2 t = x * (x * x * K2 + K1); f32x2 e; e.x = __builtin_amdgcn_exp2f(-t.x); e.y = __builtin_amdgcn_exp2f(-t.y);
    const f32x2 d = e * io + io; f32x2 rc; rc.x = __builtin_amdgcn_rcpf(d.x); rc.y = __builtin_amdgcn_rcpf(d.y); return x * rc; }
__device__ __forceinline__ float sigmoidf_(float x) { return __builtin_amdgcn_rcpf(1.0f + __builtin_amdgcn_exp2f(-x * LOG2E)); }

namespace pg8 {
constexpr int BM = 256, BK = 64, HALF = 128, HTB = HALF * BK * 2, STAGE_BYTES = 8 * HTB, NXCD = 8, WGM = 8;
constexpr int LD = 1024;
constexpr size_t HSTEP = (size_t)HALF * LD * 2, TSTEP = 2 * HSTEP;
__host__ __device__ __forceinline__ int lds_byte(int r, int c) { const int st = (r >> 4) * 2 + (c >> 5), rr = r & 15, cc = c & 31, ob = rr * 64 + cc * 2; return st * 1024 + (ob ^ (((ob >> 9) & 1) << 5)); }
__host__ __device__ __forceinline__ void stage_rc(int b, int& R, int& C) { const int st = b / 1024, sb = b % 1024, swz = sb ^ (((sb >> 9) & 1) << 5); R = (st >> 1) * 16 + swz / 64; C = (st & 1) * 32 + (swz % 64) / 2; }
__host__ __device__ __forceinline__ int perm32(int rho) { const int n = rho >> 4, i = rho & 15; return 8 * (i >> 2) + 4 * n + (i & 3); }

struct Unit { const char* a; const char* b; int row0, col0, z, aux, par; };
template <class E, class = void> struct epi_has_pre { static constexpr bool value = false; };
template <class E> struct epi_has_pre<E, decltype((void)E::HAS_PRE)> { static constexpr bool value = true; };

struct TileOrder {
    int nM, nN, nwg, G, c;
    __device__ void init(int nM_, int nN_, int G_, int c_) { nM = nM_; nN = nN_; nwg = nM * nN; G = G_; c = c_; }
    __device__ bool get(int i, int& pm, int& pn) const {
        const long L = (long)i * G + c; if (L >= nwg) return false;
        int wgid = (int)L; { const int q = nwg / NXCD, r = nwg % NXCD, xcd = wgid % NXCD, off = wgid / NXCD; wgid = (xcd < r ? xcd * (q + 1) : r * (q + 1) + (xcd - r) * q) + off; }
        const int nig = WGM * nN, gid = wgid / nig, fm = gid * WGM, gsz = (nM - fm) < WGM ? (nM - fm) : WGM;
        pm = fm + ((wgid % nig) % gsz); pn = (wgid % nig) / gsz; return true;
    }
};

__device__ __forceinline__ unsigned cvt_pk_bf16(float lo, float hi) { unsigned r; asm volatile("v_cvt_pk_bf16_f32 %0, %1, %2" : "=v"(r) : "v"(lo), "v"(hi)); return r; }

template <class Epi, class Sched, bool GATHER = false, bool FP8 = false, int ALAY = 0>
__device__ __forceinline__ void gemm_phase(LAS unsigned char* lds, const int K, const Sched& S, const Epi& E) {
    int tid = threadIdx.x; asm volatile("" : "+v"(tid));
    const int wid = __builtin_amdgcn_readfirstlane(tid >> 6), lane = tid & 63, wr = wid >> 2, wc = wid & 3, fr = lane & 15, fq = lane >> 4;
    constexpr unsigned ROWB = FP8 ? 1024u : 2048u;
    const int nt = FP8 ? K / 128 : K / BK;
    unsigned voffA[2], voffB[2]; int RA[2], CA[2];
#pragma unroll
    for (int i = 0; i < 2; ++i) { int R, C; stage_rc(tid * 16 + i * 8192, R, C); const int Rb = (R & ~31) + perm32(R & 31);
        voffA[i] = ALAY ? (unsigned)(C >> 3) * (unsigned)(MTOK * 16) + (unsigned)R * 16u : (unsigned)R * ROWB + (unsigned)C * 2u; voffB[i] = (unsigned)Rb * ROWB + (unsigned)C * 2u; RA[i] = R; CA[i] = C; }
    const size_t kstep = (size_t)(BK * 2);
    const size_t kstepA = ALAY ? (size_t)8 * MTOK * 16 : kstep;
    const size_t hstepB = (size_t)HALF * ROWB;
    const size_t hstepA = GATHER ? 0 : (ALAY ? (size_t)HALF * 16 : (size_t)HALF * ROWB);
    const unsigned ldsw = (unsigned)wid * 1024u;
    const int aoff0 = lds_byte(wr * 64 + fr, fq * 8);
    const int boff0 = lds_byte(wc * 32 + fr, fq * 8);
    unsigned aB = (unsigned)(uintptr_t)lds + (unsigned)aoff0, bB = (unsigned)(uintptr_t)lds + 4u * HTB + (unsigned)boff0; asm volatile("" : "+v"(aB), "+v"(bB));
    constexpr int KOFF = 1024;
#define PG8_SA(b, h) (((b) * 2 + (h)) * HTB)
#define PG8_SB(b, h) ((4 + (b) * 2 + (h)) * HTB)
#define PG8_STAGE(bufoff, gbase, voff) do { _Pragma("unroll") for (int _i = 0; _i < 2; ++_i) \
        __builtin_amdgcn_global_load_lds((const unsigned*)((const char*)(gbase) + (voff)[_i]), (LAS unsigned*)(lds + (bufoff) + ldsw + _i * 8192), 16, 0, 0); } while (0)
#define PG8_LD32(base, off0) __builtin_shufflevector(*(const LAS v4i_t*)((base) + (unsigned)(off0)), *(const LAS v4i_t*)((base) + (unsigned)((off0) + KOFF)), 0, 1, 2, 3, 4, 5, 6, 7)
#define PG8_LDA(dst, b, h) do { if constexpr (FP8) { _Pragma("unroll") for (int m = 0; m < 4; ++m) dst##8[m] = PG8_LD32(aB, PG8_SA(b, h) + m * 2048); } else { _Pragma("unroll") for (int m = 0; m < 4; ++m) _Pragma("unroll") for (int k = 0; k < 2; ++k) dst[m][k] = *(const LAS bf16x8*)(aB + (unsigned)(PG8_SA(b, h) + m * 2048 + k * KOFF)); } } while (0)
#define PG8_LDB(dst, b, h) do { if constexpr (FP8) { _Pragma("unroll") for (int n = 0; n < 2; ++n) dst##8[n] = PG8_LD32(bB, PG8_SA(b, h) + n * 2048); } else { _Pragma("unroll") for (int n = 0; n < 2; ++n) _Pragma("unroll") for (int k = 0; k < 2; ++k) dst[n][k] = *(const LAS bf16x8*)(bB + (unsigned)(PG8_SA(b, h) + n * 2048 + k * KOFF)); } } while (0)
#define PG8_MMA(ai, bj, At, Bt) do { __builtin_amdgcn_s_setprio(1); _Pragma("unroll") for (int m = 0; m < 4; ++m) _Pragma("unroll") for (int n = 0; n < 2; ++n) { \
        if constexpr (FP8) asm volatile("v_mfma_scale_f32_16x16x128_f8f6f4 %0, %1, %2, %0, %3, %3 op_sel_hi:[0,0,0]" : "+v"(acc[ai][bj][m][n]) : "v"(Bt##8[n]), "v"(At##8[m]), "v"(sc8)); \
        else { _Pragma("unroll") for (int k = 0; k < 2; ++k) acc[ai][bj][m][n] = __builtin_amdgcn_mfma_f32_16x16x32_bf16(Bt[n][k], At[m][k], acc[ai][bj][m][n], 0, 0, 0); } } __builtin_amdgcn_s_setprio(0); } while (0)
#define PG8_WAIT_V(n) asm volatile("s_waitcnt vmcnt(" #n ")" ::: "memory")
#define PG8_WAIT_L(n) asm volatile("s_waitcnt lgkmcnt(" #n ")" ::: "memory")
#define PG8_BAR __builtin_amdgcn_s_barrier()
#define PG8_SCHED __builtin_amdgcn_sched_barrier(0)
    Unit cur, nxt; int ui = 0;
    if (!S.next(0, cur)) return;
    f32x4 acc[2][2][4][2];
#pragma unroll
    for (int a = 0; a < 2; ++a)
#pragma unroll
        for (int b = 0; b < 2; ++b)
#pragma unroll
            for (int m = 0; m < 4; ++m)
#pragma unroll
                for (int n = 0; n < 2; ++n) acc[a][b][m][n] = (f32x4){0.f, 0.f, 0.f, 0.f};
    typedef int v8i_t __attribute__((ext_vector_type(8)));
    bf16x8 At[4][2], B0[2][2], B1[2][2]; v8i_t At8[4], B08[2], B18[2];
    int sc8 = 0x7f7f7f7f; asm volatile("" : "+v"(sc8));
    const char* cA = cur.a; const char* cB = cur.b;
    unsigned vA0[2], vA1[2], nA0[2], nA1[2];
    if constexpr (GATHER) { const int* rw = S.rows(cur);
#pragma unroll
        for (int i = 0; i < 2; ++i) { vA0[i] = (unsigned)Sched::rowmap(rw[RA[i]]) * ROWB + (unsigned)CA[i] * 2u; vA1[i] = (unsigned)Sched::rowmap(rw[128 + RA[i]]) * ROWB + (unsigned)CA[i] * 2u; nA0[i] = vA0[i]; nA1[i] = vA1[i]; } }
    else {
#pragma unroll
        for (int i = 0; i < 2; ++i) { vA0[i] = voffA[i]; vA1[i] = voffA[i]; nA0[i] = voffA[i]; nA1[i] = voffA[i]; } }
    cur.par = 0; if constexpr (epi_has_pre<Epi>::value) E.pre(cur, wid, lane);
    PG8_STAGE(PG8_SB(0, 0), cB, voffB); PG8_STAGE(PG8_SB(0, 1), cB + hstepB, voffB); PG8_STAGE(PG8_SA(0, 0), cA, vA0); PG8_STAGE(PG8_SA(0, 1), cA + hstepA, vA1);
    if (wr == 1) PG8_BAR;
    PG8_WAIT_V(2); PG8_BAR;
    PG8_STAGE(PG8_SB(1, 0), cB + kstep, voffB); PG8_STAGE(PG8_SA(1, 0), cA + kstepA, vA0); PG8_STAGE(PG8_SB(1, 1), cB + hstepB + kstep, voffB);
    PG8_WAIT_V(6); PG8_BAR;
    for (;;) {
        const bool has_next = S.next(ui + 1, nxt);
        const char* nA = has_next ? nxt.a : cA; const char* nB = has_next ? nxt.b : cB;
        int ri[4] = {0, 0, 0, 0};
        if constexpr (GATHER) { if (has_next) { const int* rw = S.rows(nxt);
#pragma unroll
            for (int i = 0; i < 4; ++i) { const int* pp = rw + (i >> 1) * 128 + RA[i & 1]; asm volatile("global_load_dword %0, %1, off" : "=v"(ri[i]) : "v"(pp) : "memory"); } } }
#pragma nounroll
        for (int t = 0; t < nt; t += 2) {
            const bool last = (t == nt - 2);
            if constexpr (GATHER) { if (last && has_next) { asm volatile("s_waitcnt vmcnt(8) ; ROWIDX" : "+v"(ri[0]), "+v"(ri[1]), "+v"(ri[2]), "+v"(ri[3]) :: "memory");
#pragma unroll
                for (int i = 0; i < 2; ++i) { nA0[i] = (unsigned)Sched::rowmap(ri[i]) * ROWB + (unsigned)CA[i] * 2u; nA1[i] = (unsigned)Sched::rowmap(ri[2 + i]) * ROWB + (unsigned)CA[i] * 2u; } } }
            const char* a1 = cA + (size_t)(t + 1) * kstepA;
            const char* a2 = last ? nA : cA + (size_t)(t + 2) * kstepA; const char* b2 = last ? nB : cB + (size_t)(t + 2) * kstep;
            const char* a3 = a2 + kstepA; const char* b3 = b2 + kstep;
            unsigned w0[2], w1[2];
#pragma unroll
            for (int i = 0; i < 2; ++i) { w0[i] = last ? nA0[i] : vA0[i]; w1[i] = last ? nA1[i] : vA1[i]; }
            PG8_LDB(B0, 0, 0); PG8_LDB(B1, 0, 1); PG8_SCHED; PG8_LDA(At, 0, 0); PG8_STAGE(PG8_SA(1, 1), a1 + hstepA, vA1);
            PG8_WAIT_V(8); PG8_WAIT_L(0); PG8_BAR; PG8_MMA(0, 0, At, B0); PG8_MMA(0, 1, At, B1); PG8_BAR; PG8_SCHED;
            PG8_LDA(At, 0, 1); PG8_STAGE(PG8_SB(0, 0), b2, voffB); PG8_STAGE(PG8_SB(0, 1), b2 + hstepB, voffB); PG8_STAGE(PG8_SA(0, 0), a2, w0);
            PG8_WAIT_V(8); PG8_WAIT_L(0); PG8_BAR; PG8_MMA(1, 0, At, B0); PG8_MMA(1, 1, At, B1); PG8_BAR; PG8_SCHED;
            PG8_LDB(B0, 1, 0); PG8_LDB(B1, 1, 1); PG8_SCHED; PG8_LDA(At, 1, 0); PG8_STAGE(PG8_SA(0, 1), a2 + hstepA, w1);
            PG8_WAIT_V(8); PG8_WAIT_L(0); PG8_BAR; PG8_MMA(0, 0, At, B0); PG8_MMA(0, 1, At, B1); PG8_BAR; PG8_SCHED;
            PG8_LDA(At, 1, 1); PG8_STAGE(PG8_SB(1, 0), b3, voffB); PG8_STAGE(PG8_SB(1, 1), b3 + hstepB, voffB); PG8_STAGE(PG8_SA(1, 0), a3, w0);
            PG8_WAIT_V(8); PG8_WAIT_L(0); PG8_BAR; PG8_MMA(1, 0, At, B0); PG8_MMA(1, 1, At, B1); PG8_BAR; PG8_SCHED;
        }
        if constexpr (epi_has_pre<Epi>::value) { if (has_next) { nxt.par = (ui + 1) & 1; E.pre(nxt, wid, lane); } }
        if (wr == 0) PG8_BAR;
        if constexpr (FP8) asm volatile("s_nop 15\n\ts_nop 15" ::: "memory");
        E(acc, cur, wr, wc, fr, fq);
        if (!has_next) break;
#pragma unroll
        for (int a = 0; a < 2; ++a)
#pragma unroll
            for (int b = 0; b < 2; ++b)
#pragma unroll
                for (int m = 0; m < 4; ++m)
#pragma unroll
                    for (int n = 0; n < 2; ++n) acc[a][b][m][n] = (f32x4){0.f, 0.f, 0.f, 0.f};
        cur = nxt; cA = nA; cB = nB; ++ui;
#pragma unroll
        for (int i = 0; i < 2; ++i) { vA0[i] = nA0[i]; vA1[i] = nA1[i]; }
        if (wr == 1) PG8_BAR;
    }
    PG8_WAIT_V(0);
    PG8_BAR;
#undef PG8_SA
#undef PG8_SB
#undef PG8_STAGE
#undef PG8_LDA
#undef PG8_LDB
#undef PG8_MMA
#undef PG8_LD32
#undef PG8_WAIT_V
#undef PG8_WAIT_L
#undef PG8_BAR
#undef PG8_SCHED
}
}
namespace attn_body {
using bf16=__hip_bfloat16;
using bf16x8=__attribute__((ext_vector_type(8)))short;
using s16x4=__attribute__((ext_vector_type(4)))short;
using f32x16=__attribute__((ext_vector_type(16)))float;
using u32x4=__attribute__((ext_vector_type(4)))unsigned;
constexpr int BATCH=16,NHEAD=16,SEQ=2048,D=64,DM=NHEAD*D;
constexpr int NW=8,QBLK=32,QB=QBLK*NW,KVBLK=64,NQB=SEQ/QB;
constexpr int ATTN_PITCH=DM, ATTN_UNIT_ROWS=QB;
__device__ __forceinline__ int crow(int r,int hi){return (r&3)+8*(r>>2)+4*hi;}
#define SBAR() __builtin_amdgcn_sched_barrier(0)
__device__ __forceinline__ void cmask(f32x16&p0,f32x16&p1,int jb,int qrel,int hi){
  const float NEG=-INFINITY; int kb=64*jb+4*hi;
  #pragma unroll
  for(int r=0;r<16;++r){int kv=kb+(r&3)+8*(r>>2); if(kv>qrel)p0[r]=NEG; if(kv+32>qrel)p1[r]=NEG;}
}

constexpr int NSLOT=3, SLOTB=8192;
constexpr int LDS_K=0, LDS_V=NSLOT*SLOTB, LDS_WS=2*NSLOT*SLOTB, LDS_OST=LDS_WS+NW*64*4, LDS_BYTES=LDS_OST+NW*4096;
constexpr float C2=0.125f*1.4426950408889634f;
__device__ __forceinline__ void glds16(const void*gsrc,unsigned lds_dst){unsigned keep;
  asm volatile("s_mov_b32 %0, m0\n\ts_mov_b32 m0, %2\n\ts_nop 0\n\tglobal_load_lds_dwordx4 %1, off\n\ts_mov_b32 m0, %0":"=&s"(keep):"v"(gsrc),"s"(lds_dst):"memory");}
__device__ __forceinline__ float max3f(float a,float b,float c){float r;asm("v_max3_f32 %0, %1, %2, %3":"=v"(r):"v"(a),"v"(b),"v"(c));return r;}
__device__ __forceinline__ float max2f(float a,float b){float r;asm("v_max_f32_e32 %0, %1, %2":"=v"(r):"v"(a),"v"(b));return r;}
__device__ __forceinline__ float fadd_s(float a,float b){float r;asm("v_add_f32_e32 %0, %1, %2":"=v"(r):"v"(a),"v"(b));return r;}
__device__ __forceinline__ float fsub_s(float a,float b){float r;asm("v_sub_f32_e32 %0, %1, %2":"=v"(r):"v"(a),"v"(b));return r;}
typedef float f32x2_t __attribute__((ext_vector_type(2))); typedef __bf16 bf16x2_t __attribute__((ext_vector_type(2)));
__device__ __forceinline__ unsigned cvtpk_s(float lo,float hi){f32x2_t v={lo,hi};bf16x2_t b=__builtin_convertvector(v,bf16x2_t);return __builtin_bit_cast(unsigned,b);}
#define WAIT_BAR(N) asm volatile("s_waitcnt vmcnt(" #N ") lgkmcnt(0)\n\ts_barrier":::"memory")

__device__ __forceinline__ void qkt(f32x16&p0,f32x16&p1,const char*Kslot,const bf16x8*qr,const f32x16&negm,int r32,int hi){
  const char*kb=Kslot+hi*1024+r32*16;
  #pragma unroll
  for(int d0=0;d0<4;++d0){
    const bf16x8 b0=*reinterpret_cast<const bf16x8*>(kb+d0*2048);
    const bf16x8 b1=*reinterpret_cast<const bf16x8*>(kb+d0*2048+512);
    if(d0==0){p0=__builtin_amdgcn_mfma_f32_32x32x16_bf16(b0,qr[0],negm,0,0,0);p1=__builtin_amdgcn_mfma_f32_32x32x16_bf16(b1,qr[0],negm,0,0,0);}
    else{p0=__builtin_amdgcn_mfma_f32_32x32x16_bf16(b0,qr[d0],p0,0,0,0);p1=__builtin_amdgcn_mfma_f32_32x32x16_bf16(b1,qr[d0],p1,0,0,0);}}
}
typedef __attribute__((address_space(3))) const char* lds_cptr;
typedef short v4i16_t __attribute__((ext_vector_type(4)));
__device__ __forceinline__ void kload8(bf16x8*kf,lds_cptr kp){
  kf[0]=*(const __attribute__((address_space(3))) bf16x8*)(kp);      kf[1]=*(const __attribute__((address_space(3))) bf16x8*)(kp+512);
  kf[2]=*(const __attribute__((address_space(3))) bf16x8*)(kp+2048); kf[3]=*(const __attribute__((address_space(3))) bf16x8*)(kp+2560);
  kf[4]=*(const __attribute__((address_space(3))) bf16x8*)(kp+4096); kf[5]=*(const __attribute__((address_space(3))) bf16x8*)(kp+4608);
  kf[6]=*(const __attribute__((address_space(3))) bf16x8*)(kp+6144); kf[7]=*(const __attribute__((address_space(3))) bf16x8*)(kp+6656);
}
__device__ __forceinline__ void kload2(bf16x8*kf,lds_cptr kp,int j){ kf[2*j]=*(const __attribute__((address_space(3))) bf16x8*)(kp+j*2048); kf[2*j+1]=*(const __attribute__((address_space(3))) bf16x8*)(kp+j*2048+512); }
__device__ __forceinline__ s16x4 vtr(lds_cptr p){ return __builtin_bit_cast(s16x4,__builtin_amdgcn_ds_read_tr16_b64_v4i16((__attribute__((address_space(3))) v4i16_t*)p)); }
__device__ __forceinline__ float rowmax(const f32x16&p0,const f32x16&p1){
  float a=max3f(p0[0],p0[1],p1[0]),b=max3f(p0[2],p0[3],p1[1]);a=max3f(a,p1[2],p1[3]);
  #pragma unroll
  for(int r=4;r<16;r+=4){a=max3f(a,p0[r],p0[r+1]);b=max3f(b,p0[r+2],p0[r+3]);a=max3f(a,p1[r],p1[r+1]);b=max3f(b,p1[r+2],p1[r+3]);}
  const float m=max2f(a,b);
  auto rr=__builtin_amdgcn_permlane32_swap(__float_as_uint(m),__float_as_uint(m),false,false);
  return max2f(__uint_as_float(rr[0]),__uint_as_float(rr[1]));
}
__device__ __forceinline__ void pv(f32x16*o,int vb,bf16x8 pa0,bf16x8 pa1,bf16x8 pa2,bf16x8 pa3){
  #pragma unroll
  for(int d0=0;d0<2;++d0){s16x4 lo[4],hi[4];
    #pragma unroll
    for(int ks=0;ks<4;++ks){
      asm volatile("ds_read_b64_tr_b16 %0,%1 offset:%c2":"=&v"(lo[ks]):"v"(vb),"i"(d0*4096+ks*1024):"memory");
      asm volatile("ds_read_b64_tr_b16 %0,%1 offset:%c2":"=&v"(hi[ks]):"v"(vb),"i"(d0*4096+ks*1024+512):"memory");}
    asm volatile("s_waitcnt lgkmcnt(0)":::"memory");SBAR();
    #define PK(k) (bf16x8){lo[k][0],lo[k][1],lo[k][2],lo[k][3],hi[k][0],hi[k][1],hi[k][2],hi[k][3]}
    o[d0]=__builtin_amdgcn_mfma_f32_32x32x16_bf16(pa0,PK(0),o[d0],0,0,0);
    o[d0]=__builtin_amdgcn_mfma_f32_32x32x16_bf16(pa1,PK(1),o[d0],0,0,0);
    o[d0]=__builtin_amdgcn_mfma_f32_32x32x16_bf16(pa2,PK(2),o[d0],0,0,0);
    o[d0]=__builtin_amdgcn_mfma_f32_32x32x16_bf16(pa3,PK(3),o[d0],0,0,0);
    #undef PK
  }
}

#ifndef ATTN_STORE16
#define ATTN_STORE16(p,v) (*(u32x4*)(p)=(v))
#endif
template<int THRL> __device__ __forceinline__ void attn_unit(int b,int h,int qb,const bf16*Q,const bf16*__restrict__ K,const bf16*__restrict__ V,bf16*O,char*shm){
  const int tid=threadIdx.x,lane=tid&63,r32=lane&31,hi=lane>>5; const int wid=__builtin_amdgcn_readfirstlane(tid>>6);
  const long rowbase=(long)b*SEQ; const int q0=qb*QB;
  const bf16*Qw=Q+(rowbase+q0+wid*QBLK)*DM+h*D;
  const bf16*Kh=K+rowbase*DM+h*D,*Vh=V+rowbase*DM+h*D;
  const unsigned lds0=(unsigned)(uintptr_t)shm;
  float*wsf=(float*)(shm+LDS_WS)+wid*64;
  const bf16*ksrc=Kh+(long)lane*DM+wid*8;
  const bf16*vsrc=Vh+(long)(16*(wid&3)+(lane>>2))*DM+(wid>>2)*32+(lane&3)*8;
  const unsigned kdst=lds0+LDS_K+wid*1024, vdst=lds0+LDS_V+wid*1024;
  #define DMA_K(t,slot) glds16(ksrc+(long)(t)*KVBLK*DM,(unsigned)__builtin_amdgcn_readfirstlane(kdst+(slot)))
  #define DMA_V(t,slot) glds16(vsrc+(long)(t)*KVBLK*DM,(unsigned)__builtin_amdgcn_readfirstlane(vdst+(slot)))
  const int vb0=(int)(lds0+LDS_V)+((lane>>4)&1)*32+(lane&3)*8+(4*hi+((lane&15)>>2))*64;
  const char*Kbase=shm+LDS_K; bf16x8 kf[8];
  const lds_cptr shm3=(lds_cptr)shm; const lds_cptr kp0=shm3+LDS_K+hi*1024+r32*16; const lds_cptr vp0=shm3+LDS_V+((lane>>4)&1)*32+(lane&3)*8+(4*hi+((lane&15)>>2))*64;
  const int NT=(q0+QB)/KVBLK;
  DMA_K(0,0);DMA_V(0,0);DMA_K(1,SLOTB);
  bf16x8 qr[4];
  #pragma unroll
  for(int d0=0;d0<4;++d0)qr[d0]=*reinterpret_cast<const bf16x8*>(&Qw[(long)r32*DM+d0*16+hi*8]);
  float mhat=0.f,l_reg=0.f;f32x16 o[2];o[0]=f32x16{};o[1]=f32x16{};f32x16 negm=f32x16{};asm volatile("":"+v"(negm));
  const int qrel=wid*QBLK+r32;
  #define CMASK(P0,P1,t) do{int jb_=(t)-(NT-4); if(jb_>=0)cmask(P0,P1,jb_,qrel,hi);}while(0)
  bool resc=false;
  #define START(P0,P1) do{ const float rm=rowmax(P0,P1); resc=false; \
    { const float dl=rm; mhat=fadd_s(mhat,dl); \
      _Pragma("unroll") for(int r=0;r<16;++r){P0[r]=fsub_s(P0[r],dl);P1[r]=fsub_s(P1[r],dl);} \
      _Pragma("unroll") for(int r=0;r<16;++r)negm[r]=-mhat; asm volatile("":"+v"(negm)); } \
    _Pragma("unroll") for(int r=0;r<16;++r)P0[r]=__builtin_amdgcn_exp2f(P0[r]); }while(0)
  #define RESC() do{ if(resc){ asm volatile("s_waitcnt lgkmcnt(0)":::"memory"); \
      _Pragma("unroll") for(int d_=0;d_<2;++d_) _Pragma("unroll") for(int r=0;r<16;++r)o[d_][r]*=wsf[crow(r,hi)]; } }while(0)
  f32x16 pA0,pA1,pB0,pB1;
  int sl_prev=0,sl_cur=0,sl_next=SLOTB;
  #define ROT() do{sl_prev=sl_cur;sl_cur=sl_next;sl_next=(sl_next==(NSLOT-1)*SLOTB)?0:sl_next+SLOTB;}while(0)
  DMA_K(2,2*SLOTB);
  WAIT_BAR(3);
  qkt(pA0,pA1,Kbase,qr,negm,r32,hi);asm volatile("s_nop 15\n\ts_nop 7":"+v"(pA0),"+v"(pA1));CMASK(pA0,pA1,0);
  START(pA0,pA1);
  _Pragma("unroll") for(int r=0;r<16;++r)pA1[r]=__builtin_amdgcn_exp2f(pA1[r]);
  WAIT_BAR(0);
  DMA_K(3,0);DMA_V(1,SLOTB);
  ROT();
  kload8(kf,kp0+sl_cur);
  WAIT_BAR(2);
  s16x4 vlo[8],vhi[8]; u32x4 pw0,pw1,pw2,pw3;
  #define PKW(P,B) cvtpk_s(P[B],P[B+1])
  #define PAF(k) __builtin_bit_cast(bf16x8,pw##k)
  #define VFR(i) (bf16x8){vlo[i][0],vlo[i][1],vlo[i][2],vlo[i][3],vhi[i][0],vhi[i][1],vhi[i][2],vhi[i][3]}
  #define PIN(x) asm volatile("":"+v"(x))
  #define MX3(a,b,c) __builtin_fmaxf(__builtin_fmaxf((a),(b)),(c))
  #define GAPA(MF,A0,A1,A2,A3,W0,W1,PW) do{ MF; sacc+=A0; sacc+=A1; sacc+=A2; sacc+=A3; PIN(sacc); W0; W1; PIN(PW); SBAR(); }while(0)
  #define EX(v) __builtin_amdgcn_exp2f(v)
  #define GAPB(MF,X,B) do{ MF; X[B]=EX(X[B]); X[B+1]=EX(X[B+1]); X[B+2]=EX(X[B+2]); X[B+3]=EX(X[B+3]); PIN(X); SBAR(); }while(0)
  #define VRD(i) do{ vlo[i]=vtr(vp_+(((i)>>2)*4096+((i)&3)*1024)); vhi[i]=vtr(vp_+(((i)>>2)*4096+((i)&3)*1024+512)); }while(0)
  #define KRD(G,j) do{ if(G){ kload2(kf,kp0+sl_next,j); SBAR(); } }while(0)
  #define STEP(C0,C1,P0,P1,t,GK,GV,GL) do{ SBAR(); \
    const lds_cptr vp_=vp0+sl_prev; \
    VRD(0); SBAR(); float sacc=(P0[0]+P0[1]); \
    GAPA(C0=__builtin_amdgcn_mfma_f32_32x32x16_bf16(kf[0],qr[0],negm,0,0,0), P0[2],P0[3],P0[4],P0[5],     pw0[0]=PKW(P0,0), pw0[1]=PKW(P0,2), pw0); \
    VRD(4); SBAR(); GAPA(C1=__builtin_amdgcn_mfma_f32_32x32x16_bf16(kf[1],qr[0],negm,0,0,0), P0[6],P0[7],P0[8],P0[9],     pw0[2]=PKW(P0,4), pw0[3]=PKW(P0,6), pw0); \
    VRD(1); SBAR(); GAPA(C0=__builtin_amdgcn_mfma_f32_32x32x16_bf16(kf[2],qr[1],C0,0,0,0),   P0[10],P0[11],P0[12],P0[13], pw1[0]=PKW(P0,8), pw1[1]=PKW(P0,10), pw1); \
    VRD(5); SBAR(); GAPA(C1=__builtin_amdgcn_mfma_f32_32x32x16_bf16(kf[3],qr[1],C1,0,0,0),   P0[14],P0[15],P1[0],P1[1],   pw1[2]=PKW(P0,12),pw1[3]=PKW(P0,14), pw1); \
    VRD(2); SBAR(); GAPA(C0=__builtin_amdgcn_mfma_f32_32x32x16_bf16(kf[4],qr[2],C0,0,0,0),   P1[2],P1[3],P1[4],P1[5],     pw2[0]=PKW(P1,0), pw2[1]=PKW(P1,2), pw2); \
    VRD(6); SBAR(); GAPA(C1=__builtin_amdgcn_mfma_f32_32x32x16_bf16(kf[5],qr[2],C1,0,0,0),   P1[6],P1[7],P1[8],P1[9],     pw2[2]=PKW(P1,4), pw2[3]=PKW(P1,6), pw2); \
    VRD(3); SBAR(); GAPA(C0=__builtin_amdgcn_mfma_f32_32x32x16_bf16(kf[6],qr[3],C0,0,0,0),   P1[10],P1[11],P1[12],P1[13], pw3[0]=PKW(P1,8), pw3[1]=PKW(P1,10), pw3); \
    VRD(7); SBAR(); GAPA(C1=__builtin_amdgcn_mfma_f32_32x32x16_bf16(kf[7],qr[3],C1,0,0,0),   P1[14],P1[15],0.f,0.f,       pw3[2]=PKW(P1,12),pw3[3]=PKW(P1,14), pw3); \
    l_reg+=sacc; \
    if(GK){DMA_K((t)+3,sl_cur);} if(GV){DMA_V((t)+1,sl_next);} \
    CMASK(C0,C1,t); \
    { float a=MX3(C0[0],C0[1],C1[0]),b=MX3(C0[2],C0[3],C1[1]); a=MX3(a,C1[2],C1[3]); \
      _Pragma("unroll") for(int r=4;r<16;r+=4){a=MX3(a,C0[r],C0[r+1]);b=MX3(b,C0[r+2],C0[r+3]);a=MX3(a,C1[r],C1[r+1]);b=MX3(b,C1[r+2],C1[r+3]);} \
      float rm=__builtin_fmaxf(a,b); { auto rr=__builtin_amdgcn_permlane32_swap(__float_as_uint(rm),__float_as_uint(rm),false,false); rm=__builtin_fmaxf(__uint_as_float(rr[0]),__uint_as_float(rr[1])); } \
      resc=false; \
      if(__builtin_expect(__any(rm>(float)THRL),0)){ const float dl=__builtin_fmaxf(rm,0.f); mhat+=dl; \
        _Pragma("unroll") for(int r=0;r<16;++r){C0[r]-=dl;C1[r]-=dl;} \
        _Pragma("unroll") for(int r=0;r<16;++r)negm[r]=-mhat; asm volatile("":"+v"(negm)); \
        const float f=__builtin_amdgcn_exp2f(-dl); l_reg*=f; if(hi==0)wsf[r32]=f; resc=true; } } \
    SBAR(); \
    GAPB(o[0]=__builtin_amdgcn_mfma_f32_32x32x16_bf16(PAF(0),VFR(0),o[0],0,0,0), C0,0); \
    GAPB(o[1]=__builtin_amdgcn_mfma_f32_32x32x16_bf16(PAF(0),VFR(4),o[1],0,0,0), C0,4); \
    KRD(GL,0); GAPB(o[0]=__builtin_amdgcn_mfma_f32_32x32x16_bf16(PAF(1),VFR(1),o[0],0,0,0), C0,8); \
    KRD(GL,1); GAPB(o[1]=__builtin_amdgcn_mfma_f32_32x32x16_bf16(PAF(1),VFR(5),o[1],0,0,0), C0,12); \
    KRD(GL,2); GAPB(o[0]=__builtin_amdgcn_mfma_f32_32x32x16_bf16(PAF(2),VFR(2),o[0],0,0,0), C1,0); \
    KRD(GL,3); GAPB(o[1]=__builtin_amdgcn_mfma_f32_32x32x16_bf16(PAF(2),VFR(6),o[1],0,0,0), C1,4); \
    GAPB(o[0]=__builtin_amdgcn_mfma_f32_32x32x16_bf16(PAF(3),VFR(3),o[0],0,0,0), C1,8); \
    GAPB(o[1]=__builtin_amdgcn_mfma_f32_32x32x16_bf16(PAF(3),VFR(7),o[1],0,0,0), C1,12); \
    }while(0)
  int t=1;
  #undef CMASK
  #define CMASK(P0,P1,t) do{}while(0)
  for(;t+5<NT;t+=2){
    STEP(pB0,pB1,pA0,pA1,t,true,true,true);     WAIT_BAR(2); RESC(); ROT();
    STEP(pA0,pA1,pB0,pB1,t+1,true,true,true);   WAIT_BAR(2); RESC(); ROT();
  }
  #undef CMASK
  #define CMASK(P0,P1,t) do{int jb_=(t)-(NT-4); if(jb_>=0)cmask(P0,P1,jb_,qrel,hi);}while(0)
  #define ENDW(tt) do{ if((tt)+3<NT){WAIT_BAR(2);} else if((tt)+2<NT){WAIT_BAR(1);} else {WAIT_BAR(0);} }while(0)
  for(;t+1<NT;t+=2){
    STEP(pB0,pB1,pA0,pA1,t,(t+3<NT),(t+1<NT),(t+1<NT));       ENDW(t);   RESC(); ROT();
    STEP(pA0,pA1,pB0,pB1,t+1,(t+4<NT),(t+2<NT),(t+2<NT));     ENDW(t+1); RESC(); ROT();
  }
  STEP(pB0,pB1,pA0,pA1,NT-1,false,false,false); RESC();
  { float sacc=pB0[0]+pB0[1]; _Pragma("unroll") for(int r=2;r<16;++r)sacc+=pB0[r]; _Pragma("unroll") for(int r=0;r<16;++r)sacc+=pB1[r]; l_reg+=sacc;
    pw0=(u32x4){PKW(pB0,0),PKW(pB0,2),PKW(pB0,4),PKW(pB0,6)};pw1=(u32x4){PKW(pB0,8),PKW(pB0,10),PKW(pB0,12),PKW(pB0,14)};pw2=(u32x4){PKW(pB1,0),PKW(pB1,2),PKW(pB1,4),PKW(pB1,6)};pw3=(u32x4){PKW(pB1,8),PKW(pB1,10),PKW(pB1,12),PKW(pB1,14)};
    SBAR(); pv(o,vb0+sl_cur,PAF(0),PAF(1),PAF(2),PAF(3)); }
  #undef PKW
  #undef PAF
  #undef VFR
  #undef PIN
  #undef MX3
  #undef GAPA
  #undef GAPB
  #undef EX
  #undef VRD
  #undef KRD
  #undef STEP
  #undef ENDW
  {auto rr=__builtin_amdgcn_permlane32_swap(__float_as_uint(l_reg),__float_as_uint(l_reg),false,false);l_reg=__uint_as_float(rr[0])+__uint_as_float(rr[1]);}
  if(hi==0)wsf[32+r32]=l_reg;asm volatile("s_waitcnt lgkmcnt(0)":::"memory");
  float rli[16];
  #pragma unroll
  for(int r=0;r<16;++r)rli[r]=__builtin_amdgcn_rcpf(wsf[32+crow(r,hi)]);
  bf16*Ow=O+(rowbase+q0+wid*QBLK)*DM+h*D;
  { bf16*stg=(bf16*)(shm+LDS_OST)+wid*2048;
    #pragma unroll
    for(int r=0;r<16;++r){const int orow=crow(r,hi);
      #pragma unroll
      for(int d0=0;d0<2;++d0)stg[orow*64+d0*32+r32]=__float2bfloat16(o[d0][r]*rli[r]);}
    asm volatile("s_waitcnt lgkmcnt(0)":::"memory");
    #pragma unroll
    for(int i=0;i<4;++i){const int row=i*8+(lane>>3),ch=lane&7; const u32x4 v=*(const u32x4*)(stg+row*64+ch*8); ATTN_STORE16(Ow+(long)row*DM+ch*8,v);} }
  asm volatile("s_waitcnt lgkmcnt(0)\n\ts_barrier":::"memory");
  #undef DMA_K
  #undef DMA_V
  #undef CMASK
  #undef START
  #undef RESC
  #undef ROT
}
constexpr int ATTN_LDS_BYTES=LDS_BYTES;
struct AttnTensors { const bf16* Q; const bf16* K; const bf16* V; bf16* O; };
struct AttnUnit { int bh; int qb; };
struct StaticOrder {
  int vcu;
  __device__ __forceinline__ explicit StaticOrder(int grid,int block):vcu((block%8)*(grid/8)+block/8){}
  __device__ __forceinline__ bool next(int i,AttnUnit&u)const{ if(i>=8)return false; const int pr=vcu&3; u.bh=(vcu>>2)*4+(i&3); u.qb=(i==0)?pr:(i==1)?pr:(i==2)?pr:(i==3)?pr:(i==4)?7-pr:(i==5)?7-pr:(i==6)?7-pr:7-pr; return true; }
  __device__ __forceinline__ void a_ready(const AttnUnit&)const{}
  __device__ __forceinline__ void done(const AttnUnit&)const{}
};
template<class Sched,int THRL=8> __device__ __forceinline__ void attn_phase(char*lds,const AttnTensors&T,const Sched&S){
  AttnUnit u;
  for(int i=0;S.next(i,u);++i){ S.a_ready(u); const int vhd=u.bh%NHEAD, hq=vhd>>1, hv=(vhd>>2)*2+(vhd&1);
    attn_unit<THRL>(u.bh/NHEAD,hq,u.qb,T.Q,T.K,T.V+(hv-hq)*D,T.O+(vhd-hq)*D,lds); S.done(u); }
}
#undef SBAR
#undef WAIT_BAR
}
#define XB_TMO      128
#define XB_XCNT(j)  (256  + 64 * (j))
#define XB_XSUB(j)  (1280 + 64 * (j))
#define XB_XGEN(j)  (2304 + 64 * (j))
#define XB_TOP      3328
#define XB_TOPGEN   3392
#define XCD_BAR_WORDS 3456
#define XB_SPIN_CAP (1u << 18)

__device__ __forceinline__ unsigned xb_ld(unsigned* p)              { return __hip_atomic_load(p, __ATOMIC_RELAXED, __HIP_MEMORY_SCOPE_AGENT); }
__device__ __forceinline__ unsigned xb_add(unsigned* p, unsigned v) { return __hip_atomic_fetch_add(p, v, __ATOMIC_RELAXED, __HIP_MEMORY_SCOPE_AGENT); }
__device__ __forceinline__ unsigned xb_xcc_id() { return (unsigned)__builtin_amdgcn_s_getreg((3 << 11) | 20) & 0xFu; }
#define XB_SPIN(cond, bar) do { unsigned _sp = 0; while (cond) { __builtin_amdgcn_s_sleep(1); \
    if ((++_sp & 255u) == 0u) { if (xb_ld(&(bar)[XB_TMO])) break; if (_sp > XB_SPIN_CAP) { atomicAdd(&(bar)[XB_TMO], 1u); break; } } } } while (0)

struct XcdBarrier {
    unsigned* bar; unsigned x;
    volatile LAS unsigned* st;
};

__device__ __forceinline__ XcdBarrier xcd_barrier_post(unsigned* bar, volatile LAS unsigned* st) {
    XcdBarrier b; b.bar = bar; b.x = xb_xcc_id(); b.st = st;
    if (threadIdx.x == 0) (void)xb_add(&bar[XB_XCNT(b.x)], 1u);
    return b;
}
__device__ __forceinline__ void xcd_barrier_complete(unsigned* bar, unsigned x, unsigned& nloc, unsigned& nx) {
    const unsigned G = gridDim.x * gridDim.y * gridDim.z;
    unsigned sum, cnt, mine, sp = 0u;
    for (;;) {
        sum = 0u; cnt = 0u; mine = 0u;
#pragma unroll
        for (unsigned j = 0; j < 16; ++j) { const unsigned c = xb_ld(&bar[XB_XCNT(j)]); sum += c; cnt += (c > 0u) ? 1u : 0u; mine = (j == x) ? c : mine; }
        if (sum == G) break;
        __builtin_amdgcn_s_sleep(1);
        if ((++sp & 255u) == 0u) { if (xb_ld(&bar[XB_TMO])) break; if (sp > XB_SPIN_CAP) { atomicAdd(&bar[XB_TMO], 1u); break; } }
    }
    nloc = mine > 0u ? mine : 1u; nx = cnt > 0u ? cnt : 1u;
}

__device__ __forceinline__ void xcd_barrier(const XcdBarrier& b) {
    asm volatile("s_waitcnt vmcnt(0)" ::: "memory");
    __syncthreads();
    if (threadIdx.x == 0) {
        unsigned* bar = b.bar;
        __builtin_amdgcn_s_waitcnt(0);
        unsigned nloc = b.st[0], nx = b.st[1];
        if (nloc == 0u) { xcd_barrier_complete(bar, b.x, nloc, nx); b.st[0] = nloc; b.st[1] = nx; }
        const unsigned old = xb_add(&bar[XB_XSUB(b.x)], 1u);
        const unsigned gen = old / nloc;
        if (old + 1u == (gen + 1u) * nloc) {
            __builtin_amdgcn_fence(__ATOMIC_RELEASE, "agent");
            asm volatile("s_waitcnt vmcnt(0)" ::: "memory");
            const unsigned og = xb_add(&bar[XB_TOP], 1u);
            const unsigned tg = og / nx;
            if (og + 1u == (tg + 1u) * nx) xb_add(&bar[XB_TOPGEN], 1u);
            else XB_SPIN(xb_ld(&bar[XB_TOPGEN]) == tg, bar);
            __builtin_amdgcn_fence(__ATOMIC_ACQUIRE, "agent");
            xb_add(&bar[XB_XGEN(b.x)], 1u);
            asm volatile("s_waitcnt vmcnt(0)" ::: "memory");
        } else {
            XB_SPIN(xb_ld(&bar[XB_XGEN(b.x)]) == gen, bar);
            __builtin_amdgcn_fence(__ATOMIC_ACQUIRE, "agent");
            asm volatile("s_waitcnt vmcnt(0)" ::: "memory");
        }
    }
    __syncthreads();
}

constexpr int NWAVES = 8;
struct Frame { LAS unsigned char* lds; volatile LAS unsigned* MISC; gu32* ctl; int wave, vcu, G; };
__device__ __forceinline__ int opaque_tid() { int t = (int)threadIdx.x; asm volatile("" : "+v"(t)); return t; }
#define FTID ((int)threadIdx.x)
#define FLANE ((int)(threadIdx.x & 63u))
struct Args { const float* in[53]; float* out; unsigned char* ws; int ph_lo, ph_hi, variant, pad; };
#define EPI_ARGS const f32x4 (&acc)[2][2][4][2], const pg8::Unit& u, int wr, int wc, int fr, int fq

__device__ __forceinline__ int maprow(int mode, int n) {
    if (mode == 0) return n;
    if (mode == 1) return (n >> 7) * 256 + (n & 127);
    if (mode == 2) return (n >> 7) * 256 + 128 + (n & 127);
    const int j = n & 1023; return (j >> 7) * 256 + ((n >> 10) << 7) + (j & 127);
}
__device__ __forceinline__ void tr_item(const float* W, int N, bf16* WT, int mode, LAS float* scr, int item, int lane) {
    const int nblk = N >> 5, kb = item / nblk, nb = item - kb * nblk, k0 = 64 * kb, n0 = 32 * nb;
#pragma unroll 8
    for (int i = 0; i < 32; ++i) { const int kk = 2 * i + (lane >> 5); scr[kk * 33 + (lane & 31)] = W[(size_t)(k0 + kk) * N + n0 + (lane & 31)]; }
    LDS_WAIT(); asm volatile("" ::: "memory");
    const int c = lane & 7; const int r0 = maprow(mode, n0);
#pragma unroll
    for (int j = 0; j < 4; ++j) { const int n = (lane >> 3) + 8 * j; const LAS float* s = scr + (8 * c) * 33 + n;
        v4u o; o.x = pk2(s[0 * 33], s[1 * 33]); o.y = pk2(s[2 * 33], s[3 * 33]); o.z = pk2(s[4 * 33], s[5 * 33]); o.w = pk2(s[6 * 33], s[7 * 33]);
        *(GAS v4u*)(WT + (size_t)(r0 + n) * 1024 + k0 + 8 * c) = o; }
    LDS_WAIT(); asm volatile("" ::: "memory");
}
__device__ __forceinline__ unsigned pk4_fp8(float a, float b, float c, float d) {
    a = __builtin_amdgcn_fmed3f(a, -448.f, 448.f); b = __builtin_amdgcn_fmed3f(b, -448.f, 448.f); c = __builtin_amdgcn_fmed3f(c, -448.f, 448.f); d = __builtin_amdgcn_fmed3f(d, -448.f, 448.f);
    int r = __builtin_amdgcn_cvt_pk_fp8_f32(a, b, 0, false); r = __builtin_amdgcn_cvt_pk_fp8_f32(c, d, r, true); return (unsigned)r; }
__device__ __forceinline__ void tr_item8(const float* W, int N, unsigned char* WT, int mode, float scale, LAS float* scr, int item, int lane) {
    const int nblk = N >> 5, kb = item / nblk, nb = item - kb * nblk, k0 = 128 * kb, n0 = 32 * nb;
#pragma unroll 8
    for (int i = 0; i < 64; ++i) { const int kk = 2 * i + (lane >> 5); scr[kk * 33 + (lane & 31)] = W[(size_t)(k0 + kk) * N + n0 + (lane & 31)] * scale; }
    LDS_WAIT(); asm volatile("" ::: "memory");
    const int c = lane & 7; const int r0 = maprow(mode, n0);
#pragma unroll
    for (int j = 0; j < 4; ++j) { const int n = (lane >> 3) + 8 * j; const LAS float* p = scr + (16 * c) * 33 + n;
        v4u o; o.x = pk4_fp8(p[0 * 33], p[1 * 33], p[2 * 33], p[3 * 33]); o.y = pk4_fp8(p[4 * 33], p[5 * 33], p[6 * 33], p[7 * 33]);
        o.z = pk4_fp8(p[8 * 33], p[9 * 33], p[10 * 33], p[11 * 33]); o.w = pk4_fp8(p[12 * 33], p[13 * 33], p[14 * 33], p[15 * 33]);
        *(GAS v4u*)(WT + (size_t)(r0 + n) * 1024 + k0 + 16 * c) = o; }
    LDS_WAIT(); asm volatile("" ::: "memory");
}
__device__ __forceinline__ void cvt_plain(const float* src, bf16* dst, size_t n, size_t gtid, size_t nth) {
    for (size_t i = gtid * 8; i < n; i += nth * 8) { const f32x4 a = *(const GAS f32x4*)(src + i), b = *(const GAS f32x4*)(src + i + 4);
        v4u o; o.x = pk2(a.x, a.y); o.y = pk2(a.z, a.w); o.z = pk2(b.x, b.y); o.w = pk2(b.z, b.w); *(GAS v4u*)(dst + i) = o; }
}
__device__ __forceinline__ void cvt_experts(Frame& F, const float* wup, const float* wdn, unsigned char* ws) {
    const int gw = F.vcu * NWAVES + F.wave, NGW = F.G * NWAVES;
#if MOE_FP8
    LAS float* tl = (LAS float*)F.lds;
    for (int it = F.vcu; it < NEXP * 96; it += F.G) { const int e = it / 96, r = it - e * 96; const bool up = r < 64; const int rr = up ? r : r - 64;
        const int N = up ? 2048 : 1024, nb = up ? (rr & 7) : (rr & 3), kb = up ? (rr >> 3) : (rr >> 2), k0 = 128 * kb, n0 = 256 * nb;
        const float* W = up ? wup + (size_t)e * 1024 * 2048 : wdn + (size_t)e * 1024 * 1024; unsigned char* WT = up ? ws + WS_WUP8 + (size_t)e * 2048 * 1024 : ws + WS_WDN8 + (size_t)e * 1024 * 1024;
        const float scale = up ? SWU8 : SWD8; const int mode = up ? 3 : 0;
        __syncthreads();
        f32x4 v[16];
#pragma unroll
        for (int i = 0; i < 16; ++i) { const int idx = i * 512 + FTID, row = idx >> 6, c4 = idx & 63; v[i] = *(const GAS f32x4*)(W + (size_t)(k0 + row) * N + n0 + 4 * c4); }
#pragma unroll
        for (int i = 0; i < 16; ++i) { const int idx = i * 512 + FTID, row = idx >> 6, c4 = idx & 63; *(LAS f32x4*)(tl + row * 260 + 4 * (c4 ^ (row >> 4))) = v[i] * scale; }
        __syncthreads();
#pragma unroll
        for (int j = 0; j < 4; ++j) { const int idx = j * 512 + FTID, n = idx >> 3, c = idx & 7; const LAS float* p = tl + (16 * c) * 260 + (n ^ (4 * c));
            v4u o; o.x = pk4_fp8(p[0 * 260], p[1 * 260], p[2 * 260], p[3 * 260]); o.y = pk4_fp8(p[4 * 260], p[5 * 260], p[6 * 260], p[7 * 260]);
            o.z = pk4_fp8(p[8 * 260], p[9 * 260], p[10 * 260], p[11 * 260]); o.w = pk4_fp8(p[12 * 260], p[13 * 260], p[14 * 260], p[15 * 260]);
            *(GAS v4u*)(WT + (size_t)maprow(mode, n0 + n) * 1024 + k0 + 16 * c) = o; }
    }
    __syncthreads();
    return;
#endif
    LAS float* scr = (LAS float*)(F.lds + F.wave * 16384);
    for (int it = gw; it < NEXP * 1536; it += NGW) { const int e = it / 1536, r = it - e * 1536;
        if (r < 1024) tr_item(wup + (size_t)e * 1024 * 2048, 2048, (bf16*)(ws + WS_WUP) + (size_t)e * 2048 * 1024, 3, scr, r, FLANE);
        else tr_item(wdn + (size_t)e * 1024 * 1024, 1024, (bf16*)(ws + WS_WDN) + (size_t)e * 1024 * 1024, 0, scr, r - 1024, FLANE); }
}
__device__ __forceinline__ void p0_prologue(Frame& F, const Args& a) {
    unsigned char* ws = a.ws;
    LAS float* scr = (LAS float*)(F.lds + F.wave * 16896);
    const int gw = F.vcu * NWAVES + F.wave, NGW = F.G * NWAVES;
    constexpr int I0 = 16 * 64, I1 = I0 + 16 * 80, I2 = I1 + 512, I3 = I2 + 512, I4 = I3 + 512, I5 = I4 + 256, I6 = I5 + 256, I7 = I6 + 256, I8 = I7 + 16, I9 = I8 + 16;
    for (int it = gw; it < I9; it += NGW) {
        if (it < I0) tr_item(a.in[2], 2048, (bf16*)(ws + WS_WKV), 0, scr, it, FLANE);
        else if (it < I1) tr_item(a.in[3], 2560, (bf16*)(ws + WS_WIN0), 0, scr, it - I0, FLANE);
        else if (it < I2) tr_item(a.in[13], 1024, (bf16*)(ws + WS_WOUT0), 0, scr, it - I1, FLANE);
        else if (it < I3) tr_item(a.in[17], 1024, (bf16*)(ws + WS_XOT), 0, scr, it - I2, FLANE);
        else if (it < I4) tr_item(a.in[42], 1024, (bf16*)(ws + WS_XOT) + 1024 * 1024, 0, scr, it - I3, FLANE);
        else if (it < I5) tr_item8(a.in[28], 1024, ws + WS_WIN1, 0, SWU8, scr, it - I4, FLANE);
        else if (it < I6) tr_item8(a.in[37], 1024, ws + WS_WVG, 1, SWD8, scr, it - I5, FLANE);
        else if (it < I7) tr_item8(a.in[38], 1024, ws + WS_WVG, 2, SWU8, scr, it - I6, FLANE);
        else if (it < I8) tr_item(a.in[20], 32, (bf16*)(ws + WS_WR), 0, scr, it - I7, FLANE);
        else tr_item(a.in[45], 32, (bf16*)(ws + WS_WR) + 256 * 1024, 0, scr, it - I8, FLANE);
    }
    cvt_experts(F, a.in[22], a.in[24], ws);
    const size_t gtid = (size_t)F.vcu * 512 + FTID, nth = (size_t)F.G * 512;
    cvt_plain(a.in[16], (bf16*)(ws + WS_XQB), 1024 * 1024, gtid, nth);
    cvt_plain(a.in[41], (bf16*)(ws + WS_XQB) + 1024 * 1024, 1024 * 1024, gtid, nth);
    cvt_plain(a.in[1], (bf16*)(ws + WS_MEMB), (size_t)NB * MEMLEN * DM, gtid, nth);
    cvt_plain(a.in[0], (bf16*)(ws + WS_XB), (size_t)MTOK * DM, gtid, nth);
}

__device__ __forceinline__ void moe_tables(Frame& F, gu32* cnt) {
    LAS int* tab = (LAS int*)(F.lds + TAB_OFF);
    if (FTID < 32) tab[FTID] = (int)__hip_atomic_load(cnt + FTID * 64, RLX_AGENT);
    __syncthreads();
    if (FTID == 0) { int s = 0; for (int e = 0; e < NEXP; ++e) { tab[32 + e] = s; s += (tab[e] + 255) >> 8; } tab[64] = s; }
    __syncthreads();
}

template <int MODE>
__device__ __forceinline__ void ph_ln(Frame& F, const bf16* zb, const bf16* ys, bf16* xb, float* outf, const float* g, const float* b, unsigned char* x8 = nullptr, const int* asg = nullptr, const float* gate = nullptr,
                                      const float* st2 = nullptr, const float* g2 = nullptr, const float* b2 = nullptr) {
    LAS const int* tab = (LAS const int*)(F.lds + TAB_OFF);
    const int gw = F.vcu * NWAVES + F.wave, NGW = F.G * NWAVES, c0 = 8 * FLANE;
    float gv[16], bv[16];
#pragma unroll
    for (int h = 0; h < 2; ++h)
#pragma unroll
        for (int q = 0; q < 2; ++q) { const f32x4 t = *(const GAS f32x4*)(g + c0 + 512 * h + 4 * q), s = *(const GAS f32x4*)(b + c0 + 512 * h + 4 * q);
            gv[8 * h + 4 * q + 0] = t.x; gv[8 * h + 4 * q + 1] = t.y; gv[8 * h + 4 * q + 2] = t.z; gv[8 * h + 4 * q + 3] = t.w;
            bv[8 * h + 4 * q + 0] = s.x; bv[8 * h + 4 * q + 1] = s.y; bv[8 * h + 4 * q + 2] = s.z; bv[8 * h + 4 * q + 3] = s.w; }
    constexpr bool REB = (MODE == 1) && MOE_FP8; float g2v[REB ? 16 : 1], b2v[REB ? 16 : 1];
    if constexpr (REB) {
#pragma unroll
        for (int h = 0; h < 2; ++h)
#pragma unroll
            for (int q = 0; q < 2; ++q) { const f32x4 t = *(const GAS f32x4*)(g2 + c0 + 512 * h + 4 * q), s = *(const GAS f32x4*)(b2 + c0 + 512 * h + 4 * q);
#pragma unroll
                for (int j = 0; j < 4; ++j) { g2v[8 * h + 4 * q + j] = ALPHA * t[j]; b2v[8 * h + 4 * q + j] = ALPHA * s[j]; } } }
    constexpr int RI = (MODE == 0) ? 4 : 2;
    for (int m0 = gw * RI; m0 < MTOK; m0 += NGW * RI) {
        v4u raw[RI][2]; v4u yr[(MODE == 1) ? RI : 1][2][4]; f32x4 gt[(MODE == 1) ? RI : 1]; f32x2 ms[RI];
#pragma unroll
        for (int r = 0; r < RI; ++r) { const size_t m = (size_t)(m0 + r); size_t yrow[4] = {0, 0, 0, 0};
            if constexpr (REB) ms[r] = *(const GAS f32x2*)(st2 + m * 2);
            if (MODE == 1) { const v4i_t as = *(const GAS v4i_t*)(asg + m * 4); gt[r] = *(const GAS f32x4*)(gate + m * 4);
#pragma unroll
                for (int k = 0; k < 4; ++k) yrow[k] = (size_t)(tab[32 + (as[k] >> 16)] * 256 + (as[k] & 0xffff)); }
#pragma unroll
            for (int h = 0; h < 2; ++h) {
                raw[r][h] = *(const GAS v4u*)(((MODE == 0 || REB) ? zb : xb) + m * DM + c0 + 512 * h);
                if (MODE == 1) {
#pragma unroll
                    for (int k = 0; k < 4; ++k) { const v2u t8 = *(const GAS v2u*)((const unsigned char*)ys + yrow[k] * DM + c0 + 512 * h); yr[r][h][k] = (v4u){t8.x, t8.y, 0u, 0u}; } } } }
#pragma unroll
        for (int r = 0; r < RI; ++r) { const size_t m = (size_t)(m0 + r);
            float v[16];
#pragma unroll
            for (int h = 0; h < 2; ++h) { const v4u w = raw[r][h]; const float sc = (MODE == 0) ? 1.0f : ALPHA;
                v[8 * h + 0] = sc * bflo(w.x); v[8 * h + 1] = sc * bfhi(w.x); v[8 * h + 2] = sc * bflo(w.y); v[8 * h + 3] = sc * bfhi(w.y); v[8 * h + 4] = sc * bflo(w.z); v[8 * h + 5] = sc * bfhi(w.z); v[8 * h + 6] = sc * bflo(w.w); v[8 * h + 7] = sc * bfhi(w.w);
                if constexpr (REB) { const float mu2 = ms[r][0] * ALPHA, rs2 = ms[r][1];
#pragma unroll
                    for (int j = 0; j < 8; ++j) v[8 * h + j] = (v[8 * h + j] - mu2) * rs2 * g2v[8 * h + j] * (1.0f / ALPHA) + b2v[8 * h + j]; }
                if (MODE == 1) {
#pragma unroll
                    for (int k = 0; k < 4; ++k) { const v4u y = yr[r][h][k]; const float gk = gt[r][k] * (1.0f / SY8);
                        const f32x2 p0 = __builtin_amdgcn_cvt_pk_f32_fp8((int)y.x, false), p1 = __builtin_amdgcn_cvt_pk_f32_fp8((int)y.x, true), p2 = __builtin_amdgcn_cvt_pk_f32_fp8((int)y.y, false), p3 = __builtin_amdgcn_cvt_pk_f32_fp8((int)y.y, true);
                        v[8 * h + 0] += gk * p0[0]; v[8 * h + 1] += gk * p0[1]; v[8 * h + 2] += gk * p1[0]; v[8 * h + 3] += gk * p1[1]; v[8 * h + 4] += gk * p2[0]; v[8 * h + 5] += gk * p2[1]; v[8 * h + 6] += gk * p3[0]; v[8 * h + 7] += gk * p3[1]; } } }
            float s = 0.f;
#pragma unroll
            for (int j = 0; j < 16; ++j) s += v[j];
            const float mean = wave_sum(s) * (1.f / DM); float s2 = 0.f;
#pragma unroll
            for (int j = 0; j < 16; ++j) { v[j] -= mean; s2 += v[j] * v[j]; }
            const float rstd = 1.f / sqrtf(wave_sum(s2) * (1.f / DM) + LN_EPS);
#pragma unroll
            for (int j = 0; j < 16; ++j) v[j] = v[j] * rstd * gv[j] + bv[j];
#pragma unroll
            for (int h = 0; h < 2; ++h) { v4u o; o.x = pk2(v[8 * h], v[8 * h + 1]); o.y = pk2(v[8 * h + 2], v[8 * h + 3]); o.z = pk2(v[8 * h + 4], v[8 * h + 5]); o.w = pk2(v[8 * h + 6], v[8 * h + 7]);
                if (!outf) *(GAS v4u*)(xb + m * DM + c0 + 512 * h) = o;
                if (x8) { v2u o8; o8.x = pk4_fp8(v[8 * h] * SX8, v[8 * h + 1] * SX8, v[8 * h + 2] * SX8, v[8 * h + 3] * SX8); o8.y = pk4_fp8(v[8 * h + 4] * SX8, v[8 * h + 5] * SX8, v[8 * h + 6] * SX8, v[8 * h + 7] * SX8);
                          *(GAS v2u*)(x8 + m * DM + c0 + 512 * h) = o8; }
                if (outf) { *(GAS f32x4*)(outf + m * DM + c0 + 512 * h) = (f32x4){v[8 * h], v[8 * h + 1], v[8 * h + 2], v[8 * h + 3]};
                            *(GAS f32x4*)(outf + m * DM + c0 + 512 * h + 4) = (f32x4){v[8 * h + 4], v[8 * h + 5], v[8 * h + 6], v[8 * h + 7]}; } }
        }
    }
}
__device__ __forceinline__ void ph_ln2_router(Frame& F, const bf16* zb, bf16* xb, unsigned char* x8, const float* g, const float* b, const bf16* wrT, const float* rbias,
                                              gu32* cnt, int* list, float* gate, int* asg, float* st2) {
    LAS int* cl = (LAS int*)F.lds;
    LAS float* gl = (LAS float*)(F.lds + 256);
    LAS bf16* wl = (LAS bf16*)(F.lds + 256 + 8192);
    const int rw = FLANE & 15, q = FLANE >> 4;
    for (int i = FTID; i < 256; i += 512) { ((LAS f32x4*)gl)[i] = *(const GAS f32x4*)(g + 4 * i); ((LAS f32x4*)gl)[256 + i] = *(const GAS f32x4*)(b + 4 * i); }
    for (int i = FTID; i < 4096; i += 512) { const int e = i >> 7, c = i & 127; *(LAS v4u*)(wl + e * 1032 + 8 * c) = *(const GAS v4u*)(wrT + (size_t)e * DM + 8 * c); }
    for (int blk = F.vcu; blk < MTOK / 128; blk += F.G) {
        __syncthreads();
        if (FTID < 64) cl[FTID] = 0;
        __syncthreads();
        const int row = blk * 128 + F.wave * 16 + rw;
        const bf16* zr = zb + (size_t)row * DM + 8 * q;
        v4u zz[32];
#pragma unroll
        for (int ks = 0; ks < 32; ++ks) zz[ks] = *(const GAS v4u*)(zr + 32 * ks);
        float s1 = 0.f, s2 = 0.f;
#pragma unroll
        for (int ks = 0; ks < 32; ++ks) { const v4u w = zz[ks]; const float x0 = bflo(w.x), x1 = bfhi(w.x), x2 = bflo(w.y), x3 = bfhi(w.y), x4 = bflo(w.z), x5 = bfhi(w.z), x6 = bflo(w.w), x7 = bfhi(w.w);
            s1 += ((x0 + x1) + (x2 + x3)) + ((x4 + x5) + (x6 + x7)); s2 += ((x0 * x0 + x1 * x1) + (x2 * x2 + x3 * x3)) + ((x4 * x4 + x5 * x5) + (x6 * x6 + x7 * x7)); }
        s1 += __shfl_xor(s1, 16); s1 += __shfl_xor(s1, 32); s2 += __shfl_xor(s2, 16); s2 += __shfl_xor(s2, 32);
        const float mean = s1 * (1.f / DM), rstd = 1.f / sqrtf(fmaxf(s2 * (1.f / DM) - mean * mean, 0.f) + LN_EPS);
        if (MOE_FP8 && q == 0) { f32x2 ms; ms[0] = mean; ms[1] = rstd; *(GAS f32x2*)(st2 + (size_t)row * 2) = ms; }
        f32x4 acc0 = (f32x4){0.f, 0.f, 0.f, 0.f}, acc1 = (f32x4){0.f, 0.f, 0.f, 0.f};
        bf16* xr = xb + (size_t)row * DM + 8 * q; unsigned char* x8r = x8 + (size_t)row * DM + 8 * q; v2u h8;
        const LAS bf16* w0 = wl + rw * 1032 + 8 * q; const LAS bf16* w1 = wl + (16 + rw) * 1032 + 8 * q;
#pragma unroll
        for (int ks = 0; ks < 32; ++ks) { v4u w = zz[ks]; asm volatile("" : "+v"(w));
            const f32x4 g0 = *(const LAS f32x4*)(gl + 32 * ks + 8 * q), g1 = *(const LAS f32x4*)(gl + 32 * ks + 8 * q + 4), b0 = *(const LAS f32x4*)(gl + 1024 + 32 * ks + 8 * q), b1 = *(const LAS f32x4*)(gl + 1024 + 32 * ks + 8 * q + 4);
            const float y0 = (bflo(w.x) - mean) * rstd * g0[0] + b0[0], y1 = (bfhi(w.x) - mean) * rstd * g0[1] + b0[1], y2 = (bflo(w.y) - mean) * rstd * g0[2] + b0[2], y3 = (bfhi(w.y) - mean) * rstd * g0[3] + b0[3];
            const float y4 = (bflo(w.z) - mean) * rstd * g1[0] + b1[0], y5 = (bfhi(w.z) - mean) * rstd * g1[1] + b1[1], y6 = (bflo(w.w) - mean) * rstd * g1[2] + b1[2], y7 = (bfhi(w.w) - mean) * rstd * g1[3] + b1[3];
            v4u o; o.x = pk2(y0, y1); o.y = pk2(y2, y3); o.z = pk2(y4, y5); o.w = pk2(y6, y7);
            if (!MOE_FP8) *(GAS v4u*)(xr + 32 * ks) = o;
            if (x8) { v2u o8; o8.x = pk4_fp8(y0 * SX8, y1 * SX8, y2 * SX8, y3 * SX8); o8.y = pk4_fp8(y4 * SX8, y5 * SX8, y6 * SX8, y7 * SX8);
                if ((ks & 1) == 0) h8 = o8;
                else { const auto sx = __builtin_amdgcn_permlane16_swap(h8.x, o8.x, false, false); const auto sy = __builtin_amdgcn_permlane16_swap(h8.y, o8.y, false, false);
                    *(GAS v4u*)(x8r - 8 * q + 8 * (q & 2) + 32 * ((q & 1) ? ks : ks - 1)) = (v4u){sx[0], sy[0], sx[1], sy[1]}; } }
            const bf16x8 bfrag = __builtin_bit_cast(bf16x8, o);
            acc0 = __builtin_amdgcn_mfma_f32_16x16x32_bf16(*(const LAS bf16x8*)(w0 + 32 * ks), bfrag, acc0, 0, 0, 0);
            acc1 = __builtin_amdgcn_mfma_f32_16x16x32_bf16(*(const LAS bf16x8*)(w1 + 32 * ks), bfrag, acc1, 0, 0, 0);
            if ((ks & 1) == 1) asm volatile("" ::: "memory"); }
        float lg[8]; const f32x4 rb0 = *(const GAS f32x4*)(rbias + 4 * q), rb1 = *(const GAS f32x4*)(rbias + 16 + 4 * q);
#pragma unroll
        for (int j = 0; j < 4; ++j) { lg[j] = acc0[j] + rb0[j]; lg[4 + j] = acc1[j] + rb1[j]; }
        int idx[4]; float val[4];
#pragma unroll
        for (int k = 0; k < 4; ++k) { float bv = -3.0e38f; int bi = 64;
#pragma unroll
            for (int j = 0; j < 8; ++j) { const int e = (j < 4) ? 4 * q + j : 12 + 4 * q + j; if (lg[j] > bv) { bv = lg[j]; bi = e; } }
#pragma unroll
            for (int o = 16; o <= 32; o <<= 1) { const float pv = __shfl_xor(bv, o); const int pi = __shfl_xor(bi, o); if (pv > bv || (pv == bv && pi < bi)) { bv = pv; bi = pi; } }
            bi &= 31; idx[k] = bi; val[k] = bv;
#pragma unroll
            for (int j = 0; j < 8; ++j) { const int e = (j < 4) ? 4 * q + j : 12 + 4 * q + j; if (e == bi) lg[j] = -3.0e38f; } }
        const float e1 = __builtin_amdgcn_exp2f((val[1] - val[0]) * LOG2E), e2 = __builtin_amdgcn_exp2f((val[2] - val[0]) * LOG2E), e3 = __builtin_amdgcn_exp2f((val[3] - val[0]) * LOG2E);
        const float inv = 1.f / (1.f + e1 + e2 + e3);
        int pos[4] = {0, 0, 0, 0};
        for (int e = 0; e < NEXP; ++e) {
            const int k = (q != 0) ? -1 : (idx[0] == e) ? 0 : (idx[1] == e) ? 1 : (idx[2] == e) ? 2 : (idx[3] == e) ? 3 : -1;
            const unsigned long long mask = __ballot(k >= 0);
            if (mask) { const int n = __popcll(mask), leader = __ffsll((long long)mask) - 1; int bp = 0;
                if (FLANE == leader) bp = __hip_atomic_fetch_add(cl + e, n, __ATOMIC_RELAXED, __HIP_MEMORY_SCOPE_WORKGROUP);
                bp = __shfl(bp, leader);
                const int p = bp + __popcll(mask & ((1ull << FLANE) - 1ull));
                pos[0] = (k == 0) ? p : pos[0]; pos[1] = (k == 1) ? p : pos[1]; pos[2] = (k == 2) ? p : pos[2]; pos[3] = (k == 3) ? p : pos[3]; }
        }
        __syncthreads();
        if (FTID < 32) { const int tot = cl[FTID]; cl[32 + FTID] = tot ? (int)__hip_atomic_fetch_add(cnt + FTID * 64, (unsigned)tot, RLX_AGENT) : 0; }
        __syncthreads();
        if (q == 0) {
            *(GAS f32x4*)(gate + (size_t)row * 4) = (f32x4){inv, e1 * inv, e2 * inv, e3 * inv};
#pragma unroll
            for (int k = 0; k < 4; ++k) { const int pe = cl[32 + idx[k]] + pos[k]; list[(size_t)idx[k] * CAP + pe] = row * 4 + k; pos[k] = (idx[k] << 16) | pe; }
            *(GAS v4i_t*)(asg + (size_t)row * 4) = (v4i_t){pos[0], pos[1], pos[2], pos[3]}; }
    }
}
__device__ __forceinline__ void ph_softmax(Frame& F, const float* sc, bf16* P) {
    const int gw = F.vcu * NWAVES + F.wave, NGW = F.G * NWAVES;
    for (int m = gw; m < MTOK; m += NGW) {
#pragma unroll
        for (int h = 0; h < 4; ++h) { f32x4 v = *(const GAS f32x4*)(sc + (size_t)m * DM + 256 * h + 4 * FLANE);
            const float mx = wave_max(fmaxf(fmaxf(v.x, v.y), fmaxf(v.z, v.w)));
            v.x = __builtin_amdgcn_exp2f(v.x - mx); v.y = __builtin_amdgcn_exp2f(v.y - mx); v.z = __builtin_amdgcn_exp2f(v.z - mx); v.w = __builtin_amdgcn_exp2f(v.w - mx);
            const float inv = 1.f / wave_sum((v.x + v.y) + (v.z + v.w));
            v2u o; o.x = pk2(v.x * inv, v.y * inv); o.y = pk2(v.z * inv, v.w * inv);
            *(GAS v2u*)(P + (size_t)m * DM + 256 * h + 4 * FLANE) = o; }
    }
}
__device__ __forceinline__ void ph_topk(Frame& F, const float* logit, const float* rbias, gu32* cnt, int* list, float* gate) {
    for (int base = F.vcu * 512; base < MTOK; base += F.G * 512) {
        const int m = base + FTID;
        float lg[32];
#pragma unroll
        for (int q = 0; q < 8; ++q) { const f32x4 t = *(const GAS f32x4*)(logit + (size_t)m * 32 + 4 * q), bb = *(const GAS f32x4*)(rbias + 4 * q);
            lg[4 * q] = t.x + bb.x; lg[4 * q + 1] = t.y + bb.y; lg[4 * q + 2] = t.z + bb.z; lg[4 * q + 3] = t.w + bb.w; }
        int idx[4]; float val[4];
#pragma unroll
        for (int k = 0; k < 4; ++k) { float bvv = -3.0e38f; int bi = 0;
#pragma unroll
            for (int e = 0; e < 32; ++e) { const bool taken = (k > 0 && idx[0] == e) || (k > 1 && idx[1] == e) || (k > 2 && idx[2] == e); if (!taken && lg[e] > bvv) { bvv = lg[e]; bi = e; } }
            idx[k] = bi; val[k] = bvv; }
        const float e1 = __builtin_amdgcn_exp2f((val[1] - val[0]) * LOG2E), e2 = __builtin_amdgcn_exp2f((val[2] - val[0]) * LOG2E), e3 = __builtin_amdgcn_exp2f((val[3] - val[0]) * LOG2E);
        const float inv = 1.f / (1.f + e1 + e2 + e3);
        *(GAS f32x4*)(gate + (size_t)m * 4) = (f32x4){inv, e1 * inv, e2 * inv, e3 * inv};
        for (int e = 0; e < NEXP; ++e) {
            const int k = (idx[0] == e) ? 0 : (idx[1] == e) ? 1 : (idx[2] == e) ? 2 : (idx[3] == e) ? 3 : -1;
            const unsigned long long mask = __ballot(k >= 0);
            if (mask) { const int n = __popcll(mask), leader = __ffsll((long long)mask) - 1; unsigned bp = 0;
                if (FLANE == leader) bp = __hip_atomic_fetch_add(cnt + e * 64, (unsigned)n, RLX_AGENT);
                bp = __shfl(bp, leader);
                if (k >= 0) { const int rank = __popcll(mask & ((1ull << FLANE) - 1ull)); list[(size_t)e * CAP + bp + rank] = m * 4 + k; } }
        }
    }
}
__device__ __forceinline__ void ph_sgu(Frame& F, const bf16* hb, bf16* mix, const float* lng, const float* lnb, const float* wsp, const float* bsp) {
    LAS bf16* Wb = (LAS bf16*)F.lds;
    LAS bf16* VT = (LAS bf16*)(F.lds + 34816);
    LAS float* GL = (LAS float*)(F.lds + 69632);
    const int r = FTID >> 2, qq = FTID & 3, n16 = FLANE & 15, q = FLANE >> 4;
    int gcur = -1;
    for (int it = F.vcu; it < 1024; it += F.G) {
        const int g = it & 3, row0 = (it >> 2) * 128;
        if (g != gcur) { __syncthreads(); for (int i = FTID; i < 16384; i += 512) { const int t = i >> 7, s2 = i & 127; Wb[t * 136 + s2] = (bf16)((s2 <= t) ? f2bf(wsp[g * 16384 + i]) : 0u); } gcur = g; }
        { float v[32]; const bf16* src = hb + (size_t)(row0 + r) * DM + 512 + g * 128 + 32 * qq;
#pragma unroll
            for (int j = 0; j < 4; ++j) { const v4u w = *(const GAS v4u*)(src + 8 * j);
                v[8 * j + 0] = bflo(w.x); v[8 * j + 1] = bfhi(w.x); v[8 * j + 2] = bflo(w.y); v[8 * j + 3] = bfhi(w.y); v[8 * j + 4] = bflo(w.z); v[8 * j + 5] = bfhi(w.z); v[8 * j + 6] = bflo(w.w); v[8 * j + 7] = bfhi(w.w); }
            float s = 0.f;
#pragma unroll
            for (int j = 0; j < 32; ++j) s += v[j];
            s += __shfl_xor(s, 1); s += __shfl_xor(s, 2);
            const float mean = s * (1.f / 128.f); float s2 = 0.f;
#pragma unroll
            for (int j = 0; j < 32; ++j) { v[j] -= mean; s2 += v[j] * v[j]; }
            s2 += __shfl_xor(s2, 1); s2 += __shfl_xor(s2, 2);
            const float rstd = 1.f / sqrtf(s2 * (1.f / 128.f) + LN_EPS);
#pragma unroll
            for (int j = 0; j < 8; ++j) { const f32x4 gg = *(const GAS f32x4*)(lng + g * 128 + 32 * qq + 4 * j), bb = *(const GAS f32x4*)(lnb + g * 128 + 32 * qq + 4 * j);
#pragma unroll
                for (int k = 0; k < 4; ++k) VT[(32 * qq + 4 * j + k) * 136 + r] = (bf16)f2bf(v[4 * j + k] * rstd * gg[k] + bb[k]); } }
        __syncthreads();
        { bf16x8 VF[4];
#pragma unroll
            for (int ks = 0; ks < 4; ++ks) VF[ks] = *(const LAS bf16x8*)(VT + (16 * F.wave + n16) * 136 + 32 * ks + 8 * q);
#pragma unroll
            for (int tb = 0; tb < 8; ++tb) { f32x4 acc = (f32x4){0.f, 0.f, 0.f, 0.f};
#pragma unroll
                for (int ks = 0; ks <= (tb >> 1); ++ks) acc = __builtin_amdgcn_mfma_f32_16x16x32_bf16(*(const LAS bf16x8*)(Wb + (16 * tb + n16) * 136 + 32 * ks + 8 * q), VF[ks], acc, 0, 0, 0);
                const f32x4 bt = *(const GAS f32x4*)(bsp + g * 128 + 16 * tb + 4 * q);
#pragma unroll
                for (int k = 0; k < 4; ++k) GL[(16 * tb + 4 * q + k) * 128 + 16 * F.wave + n16] = acc[k] + bt[k]; } }
        __syncthreads();
        { const bf16* usrc = hb + (size_t)(row0 + r) * DM + g * 128 + 32 * qq; bf16* dst = mix + (size_t)(row0 + r) * DM + g * 128 + 32 * qq;
#pragma unroll
            for (int j = 0; j < 4; ++j) { const v4u w = *(const GAS v4u*)(usrc + 8 * j); const f32x4 g0 = *(const LAS f32x4*)(GL + r * 128 + 32 * qq + 8 * j), g1 = *(const LAS f32x4*)(GL + r * 128 + 32 * qq + 8 * j + 4); v4u o;
                o.x = pk2(bflo(w.x) * g0[0], bfhi(w.x) * g0[1]); o.y = pk2(bflo(w.y) * g0[2], bfhi(w.y) * g0[3]); o.z = pk2(bflo(w.z) * g1[0], bfhi(w.z) * g1[1]); o.w = pk2(bflo(w.w) * g1[2], bfhi(w.w) * g1[3]);
                *(GAS v4u*)(dst + 8 * j) = o; } }
    }
}
__device__ __forceinline__ void ph_combine(Frame& F, const bf16* oatt, bf16* mix, const float* lq1, const float* lk1, const float* lq2, const float* lk2, const float* sg) {
    const int gw = F.vcu * NWAVES + F.wave, NGW = F.G * NWAVES;
    const float d1 = wave_sum(lq1[FLANE] * lk1[FLANE]), d2 = wave_sum(lq2[FLANE] * lk2[FLANE]);
    const float lam = expf(d1) - expf(d2) + LAM_INIT0;
    const int h = FLANE >> 4, e0 = 8 * (FLANE & 15);
    float gsc[8];
#pragma unroll
    for (int j = 0; j < 8; ++j) gsc[j] = sg[e0 + j] * (1.0f - LAM_INIT0);
    for (int m0 = gw * 4; m0 < MTOK; m0 += NGW * 4) {
        v4u av[4], bw[4];
#pragma unroll
        for (int r = 0; r < 4; ++r) { av[r] = *(const GAS v4u*)(oatt + (size_t)(m0 + r) * DM + h * 256 + e0); bw[r] = *(const GAS v4u*)(oatt + (size_t)(m0 + r) * DM + h * 256 + 128 + e0); }
#pragma unroll
        for (int r = 0; r < 4; ++r) { const v4u a = av[r], b = bw[r]; const size_t m = (size_t)(m0 + r);
            float o[8];
            o[0] = bflo(a.x) - lam * bflo(b.x); o[1] = bfhi(a.x) - lam * bfhi(b.x); o[2] = bflo(a.y) - lam * bflo(b.y); o[3] = bfhi(a.y) - lam * bfhi(b.y);
            o[4] = bflo(a.z) - lam * bflo(b.z); o[5] = bfhi(a.z) - lam * bfhi(b.z); o[6] = bflo(a.w) - lam * bflo(b.w); o[7] = bfhi(a.w) - lam * bfhi(b.w);
            float s2 = 0.f;
#pragma unroll
            for (int j = 0; j < 8; ++j) s2 += o[j] * o[j];
            s2 += __shfl_xor(s2, 1); s2 += __shfl_xor(s2, 2); s2 += __shfl_xor(s2, 4); s2 += __shfl_xor(s2, 8);
            const float rs = 1.f / sqrtf(s2 * (1.f / 128.f) + LN_EPS);
            v4u w; w.x = pk2(o[0] * rs * gsc[0], o[1] * rs * gsc[1]); w.y = pk2(o[2] * rs * gsc[2], o[3] * rs * gsc[3]); w.z = pk2(o[4] * rs * gsc[4], o[5] * rs * gsc[5]); w.w = pk2(o[6] * rs * gsc[6], o[7] * rs * gsc[7]);
            *(GAS v4u*)(mix + m * DM + 512 + h * 128 + e0) = w; }
    }
}

__device__ __forceinline__ void combine_local(Frame& F, const bf16* oatt, bf16* mix, const float* lq1, const float* lk1, const float* lq2, const float* lk2, const float* sg, int b, int h, int pr) {
    const float d1 = wave_sum(lq1[FLANE] * lk1[FLANE]), d2 = wave_sum(lq2[FLANE] * lk2[FLANE]);
    const float lam = expf(d1) - expf(d2) + LAM_INIT0;
    const int e0 = 8 * (FLANE & 15);
    float gsc[8];
#pragma unroll
    for (int j = 0; j < 8; ++j) gsc[j] = sg[e0 + j] * (1.0f - LAM_INIT0);
    for (int it = 0; it < 16; it += 4) {
        v4u av[4], bw[4]; size_t rows[4];
#pragma unroll
        for (int r = 0; r < 4; ++r) { const int rl = F.wave * 64 + (it + r) * 4 + (FLANE >> 4); rows[r] = (size_t)b * SEQ + (size_t)((rl < 256) ? pr : 7 - pr) * 256 + (rl & 255);
            av[r] = *(const GAS v4u*)(oatt + rows[r] * DM + h * 256 + e0); bw[r] = *(const GAS v4u*)(oatt + rows[r] * DM + h * 256 + 128 + e0); }
#pragma unroll
        for (int r = 0; r < 4; ++r) { const v4u a = av[r], bb = bw[r];
            float o[8];
            o[0] = bflo(a.x) - lam * bflo(bb.x); o[1] = bfhi(a.x) - lam * bfhi(bb.x); o[2] = bflo(a.y) - lam * bflo(bb.y); o[3] = bfhi(a.y) - lam * bfhi(bb.y);
            o[4] = bflo(a.z) - lam * bflo(bb.z); o[5] = bfhi(a.z) - lam * bfhi(bb.z); o[6] = bflo(a.w) - lam * bflo(bb.w); o[7] = bfhi(a.w) - lam * bfhi(bb.w);
            float s2 = 0.f;
#pragma unroll
            for (int j = 0; j < 8; ++j) s2 += o[j] * o[j];
            s2 += __shfl_xor(s2, 1); s2 += __shfl_xor(s2, 2); s2 += __shfl_xor(s2, 4); s2 += __shfl_xor(s2, 8);
            const float rs = 1.f / sqrtf(s2 * (1.f / 128.f) + LN_EPS);
            v4u w; w.x = pk2(o[0] * rs * gsc[0], o[1] * rs * gsc[1]); w.y = pk2(o[2] * rs * gsc[2], o[3] * rs * gsc[3]); w.z = pk2(o[4] * rs * gsc[4], o[5] * rs * gsc[5]); w.w = pk2(o[6] * rs * gsc[6], o[7] * rs * gsc[7]);
            *(GAS v4u*)(mix + rows[r] * DM + 512 + h * 128 + e0) = w; }
    }
}

__device__ __forceinline__ float dpp_shr1(float x) { return __builtin_bit_cast(float, __builtin_amdgcn_update_dpp(0, __builtin_bit_cast(int, x), 0x111, 0xf, 0xf, true)); }
__device__ __forceinline__ float dpp_shr2(float x) { return __builtin_bit_cast(float, __builtin_amdgcn_update_dpp(0, __builtin_bit_cast(int, x), 0x112, 0xf, 0xf, true)); }
__device__ __forceinline__ float dpp_shr4(float x) { return __builtin_bit_cast(float, __builtin_amdgcn_update_dpp(0, __builtin_bit_cast(int, x), 0x114, 0xf, 0xf, true)); }
__device__ __forceinline__ float dpp_shr8(float x) { return __builtin_bit_cast(float, __builtin_amdgcn_update_dpp(0, __builtin_bit_cast(int, x), 0x118, 0xf, 0xf, true)); }
__device__ __forceinline__ float dpp_shl15(float x) { return __builtin_bit_cast(float, __builtin_amdgcn_update_dpp(0, __builtin_bit_cast(int, x), 0x10f, 0xf, 0xf, true)); }
#define S5_DPP2(fn, v) ((f32x2){fn((v).x), fn((v).y)})
__device__ __forceinline__ float dpp_ror1(float x) { return __builtin_bit_cast(float, __builtin_amdgcn_update_dpp(0, __builtin_bit_cast(int, x), 0x121, 0xf, 0xf, true)); }
template <int hf>
__device__ __forceinline__ void s5_main(Frame& F, const bf16* ug, bf16* yb, const float* dsk, int g, int bh, LAS bf16* W2F, LAS bf16* W3F, LAS bf16* KT, LAS float* PW, int r, int q, int variant) {
        const int b = bh * 4 + (F.wave & 3);
        LAS bf16x8* XX = (LAS bf16x8*)(F.lds + 91648);
        const bf16* up = ug + ((size_t)g * MTOK + (size_t)b * SEQ) * 16;
        unsigned char* yp = (unsigned char*)yb + ((size_t)g * MTOK + (size_t)b * SEQ) * 16 + 4 * q;
        const f32x4 dk = *(const GAS f32x4*)(dsk + g * 16 + 4 * q);
        f32x4 E[4];
#pragma unroll
        for (int i = 0; i < 4; ++i) E[i] = (f32x4){0.f, 0.f, 0.f, 0.f};
        bf16x8 UFn[4], UF[4]; v2u UWn[4], UW[4];
#pragma unroll
        for (int sp = 0; sp < 4; ++sp) UFn[sp] = *(const GAS bf16x8*)(up + (size_t)(r * 8 + 2 * sp + (q >> 1)) * 16 + 8 * (q & 1));
#pragma unroll
        for (int t = 0; t < 4; ++t) UWn[t] = *(const GAS v2u*)(up + (size_t)(r * 8 + 4 * hf + t) * 16 + 4 * q);
#pragma unroll
        for (int sp = 0; sp < 4; ++sp) UF[sp] = UFn[sp];
#pragma unroll
        for (int t = 0; t < 4; ++t) UW[t] = UWn[t];
        f32x2 Pr[4][2][2], Pi[4][2][2];
#pragma unroll
        for (int i2 = 0; i2 < 2; ++i2) { const int rbp = 2 * hf + i2;
            const f32x4 a0 = *(const LAS f32x4*)(PW + (8 * 64 + 16 * rbp + 4 * q) * 2), a1 = *(const LAS f32x4*)(PW + (8 * 64 + 16 * rbp + 4 * q) * 2 + 4);
            Pr[0][i2][0] = (f32x2){a0[0], a0[2]}; Pi[0][i2][0] = (f32x2){a0[1], a0[3]}; Pr[0][i2][1] = (f32x2){a1[0], a1[2]}; Pi[0][i2][1] = (f32x2){a1[1], a1[3]};
#pragma unroll
            for (int k = 1; k < 4; ++k)
#pragma unroll
                for (int h = 0; h < 2; ++h) { const f32x2 pr = Pr[k - 1][i2][h], pi = Pi[k - 1][i2][h]; Pr[k][i2][h] = pr * pr - pi * pi; Pi[k][i2][h] = 2.0f * pr * pi; } }
        for (int cg = 0; cg < 16; ++cg) {
            const int tokbase = cg * 128 + r * 8;
            if (cg < 15) {
#pragma unroll
                for (int sp = 0; sp < 4; ++sp) UFn[sp] = *(const GAS bf16x8*)(up + (size_t)(tokbase + 128 + 2 * sp + (q >> 1)) * 16 + 8 * (q & 1));
#pragma unroll
                for (int t = 0; t < 4; ++t) UWn[t] = *(const GAS v2u*)(up + (size_t)(tokbase + 128 + 4 * hf + t) * 16 + 4 * q); }
            f32x2 Cr[2][2], Ci[2][2];
#pragma unroll
            for (int i2 = 0; i2 < 2; ++i2)
#pragma unroll
                for (int h = 0; h < 2; ++h) { const f32x2 er = h ? E[2 * i2].hi : E[2 * i2].lo, ei = h ? E[2 * i2 + 1].hi : E[2 * i2 + 1].lo; Cr[i2][h] = S5_DPP2(dpp_shl15, er); Ci[i2][h] = S5_DPP2(dpp_shl15, ei); }
#pragma unroll
            for (int i = 0; i < 4; ++i) E[i] = (f32x4){0.f, 0.f, 0.f, 0.f};
#pragma unroll
            for (int sp = 0; sp < 4; ++sp) {
#pragma unroll
                for (int i = 0; i < 4; ++i) E[i] = __builtin_amdgcn_mfma_f32_16x16x32_bf16(*(const LAS bf16x8*)(W2F + (((4 * hf + i) * 4 + sp) * 64 + FLANE) * 8), UF[sp], E[i], 0, 0, 0);
                asm volatile("" ::: "memory"); }
            bf16x8 XBf[4];
            LAS bf16x8* xx = XX + ((cg & 1) * 4 + (F.wave & 3)) * 256;
#pragma unroll
            for (int i2 = 0; i2 < 2; ++i2) { f32x2 xr[2], xi[2];
#pragma unroll
                for (int h = 0; h < 2; ++h) {
                    f32x2 er = h ? E[2 * i2].hi : E[2 * i2].lo, ei = h ? E[2 * i2 + 1].hi : E[2 * i2 + 1].lo; f32x2 sr, si, nr, ni;
                    nr = er + Pr[0][i2][h] * Cr[i2][h] - Pi[0][i2][h] * Ci[i2][h]; ni = ei + Pr[0][i2][h] * Ci[i2][h] + Pi[0][i2][h] * Cr[i2][h]; er = nr; ei = ni;
                    sr = S5_DPP2(dpp_shr1, er); si = S5_DPP2(dpp_shr1, ei); nr = er + Pr[0][i2][h] * sr - Pi[0][i2][h] * si; ni = ei + Pr[0][i2][h] * si + Pi[0][i2][h] * sr; er = nr; ei = ni;
                    sr = S5_DPP2(dpp_shr2, er); si = S5_DPP2(dpp_shr2, ei); nr = er + Pr[1][i2][h] * sr - Pi[1][i2][h] * si; ni = ei + Pr[1][i2][h] * si + Pi[1][i2][h] * sr; er = nr; ei = ni;
                    sr = S5_DPP2(dpp_shr4, er); si = S5_DPP2(dpp_shr4, ei); nr = er + Pr[2][i2][h] * sr - Pi[2][i2][h] * si; ni = ei + Pr[2][i2][h] * si + Pi[2][i2][h] * sr; er = nr; ei = ni;
                    sr = S5_DPP2(dpp_shr8, er); si = S5_DPP2(dpp_shr8, ei); nr = er + Pr[3][i2][h] * sr - Pi[3][i2][h] * si; ni = ei + Pr[3][i2][h] * si + Pi[3][i2][h] * sr; er = nr; ei = ni;
                    if (h) { E[2 * i2].hi = er; E[2 * i2 + 1].hi = ei; } else { E[2 * i2].lo = er; E[2 * i2 + 1].lo = ei; }
                    xr[h] = S5_DPP2(dpp_shr1, er) + Cr[i2][h]; xi[h] = S5_DPP2(dpp_shr1, ei) + Ci[i2][h]; }
                v4u w; w.x = pk2(xr[0].x, xr[0].y); w.y = pk2(xr[1].x, xr[1].y); w.z = pk2(xi[0].x, xi[0].y); w.w = pk2(xi[1].x, xi[1].y);
                XBf[2 * hf + i2] = __builtin_bit_cast(bf16x8, w); xx[(2 * hf + i2) * 64 + FLANE] = XBf[2 * hf + i2]; }
            LDS_WAIT(); __builtin_amdgcn_s_barrier(); asm volatile("" ::: "memory");
#pragma unroll
            for (int i2 = 0; i2 < 2; ++i2) XBf[2 * (1 - hf) + i2] = xx[(2 * (1 - hf) + i2) * 64 + FLANE];
            unsigned yout[4] = {0u, 0u, 0u, 0u};
            if (variant != 2) {
            f32x4 Y[4];
#pragma unroll
            for (int tt = 0; tt < 4; ++tt) Y[tt] = (f32x4){0.f, 0.f, 0.f, 0.f};
#pragma unroll
            for (int sp = 0; sp < 4; ++sp) {
#pragma unroll
                for (int tt = 0; tt < 4; ++tt) { const int t = 4 * hf + tt; if (sp <= (t >> 1)) { const int tau1 = t - 2 * sp - (q >> 1) + 1;
                    Y[tt] = __builtin_amdgcn_mfma_f32_16x16x32_bf16(*(const LAS bf16x8*)(KT + (tau1 * 16 + r) * 16 + 8 * (q & 1)), UF[sp], Y[tt], 0, 0, 0); } }
                asm volatile("" ::: "memory"); }
#pragma unroll
            for (int ks = 0; ks < 4; ++ks) {
#pragma unroll
                for (int tt = 0; tt < 4; ++tt) Y[tt] = __builtin_amdgcn_mfma_f32_16x16x32_bf16(*(const LAS bf16x8*)(W3F + (((4 * hf + tt) * 4 + ks) * 64 + FLANE) * 8), XBf[ks], Y[tt], 0, 0, 0);
                asm volatile("" ::: "memory"); }
#pragma unroll
            for (int tt = 0; tt < 4; ++tt) { const v2u uw = UW[tt];
                const f32x2 ya = gelu_tanh2(Y[tt].lo + dk.lo * (f32x2){bflo(uw.x), bfhi(uw.x)}, SA8), yb2 = gelu_tanh2(Y[tt].hi + dk.hi * (f32x2){bflo(uw.y), bfhi(uw.y)}, SA8);
                yout[tt] = pk4_fp8(ya.x, ya.y, yb2.x, yb2.y);
            } }
            if (cg < 15) {
#pragma unroll
                for (int sp = 0; sp < 4; ++sp) UF[sp] = UFn[sp];
#pragma unroll
                for (int t = 0; t < 4; ++t) UW[t] = UWn[t]; }
            asm volatile("" ::: "memory");
            { auto s01 = __builtin_amdgcn_permlane16_swap(yout[0], yout[1], false, false); auto s23 = __builtin_amdgcn_permlane16_swap(yout[2], yout[3], false, false);
              auto s02 = __builtin_amdgcn_permlane32_swap(s01[0], s23[0], false, false); auto s13 = __builtin_amdgcn_permlane32_swap(s01[1], s23[1], false, false);
              *(GAS v4u*)(yp - 4 * q + (size_t)(tokbase + 4 * hf + q) * 16) = (v4u){s02[0], s13[0], s02[1], s13[1]}; }
        }
}
__device__ __forceinline__ void ph_s5(Frame& F, const bf16* ug, bf16* yb, const float* log_dt, const float* lre, const float* lim, const float* bre, const float* bim,
                                      const float* cre, const float* cim, const float* dsk, int variant) {
    LAS bf16* W2F = (LAS bf16*)F.lds;
    LAS bf16* W3F = (LAS bf16*)(F.lds + 32768);
    LAS bf16* KT = (LAS bf16*)(F.lds + 65536);
    LAS float* PW = (LAS float*)(F.lds + 70144);
    LAS float* ZZ = (LAS float*)(F.lds + 74752);
    LAS float* BB = (LAS float*)(F.lds + 75264);
    LAS float* CC = (LAS float*)(F.lds + 83456);
    LAS bf16* W30 = (LAS bf16*)(F.lds + 124416);
    const int r = FLANE & 15, q = FLANE >> 4;
    for (int it = F.vcu; it < 256; it += F.G) {
        const int g = it & 63, bh = it >> 6;
        __syncthreads();
        if (FTID < 64) { const int p = FTID; const float dt = expf(log_dt[g]), lr = lre[g * 64 + p], li = lim[g * 64 + p];
            const float mg = expf(lr * dt), ar = mg * cosf(li * dt), ai = mg * sinf(li * dt), den = lr * lr + li * li;
            float pr = 1.f, pi = 0.f;
            for (int n = 0; n < 9; ++n) { PW[(n * 64 + p) * 2] = pr; PW[(n * 64 + p) * 2 + 1] = pi; const float t2 = pr * ar - pi * ai; pi = pr * ai + pi * ar; pr = t2; }
            ZZ[p * 2] = ((ar - 1.0f) * lr + ai * li) / den; ZZ[p * 2 + 1] = (ai * lr - (ar - 1.0f) * li) / den; }
        __syncthreads();
        for (int idx = FTID; idx < 1024; idx += 512) {
            { const int p = idx >> 4; const float br = bre[(size_t)g * 1024 + idx], bi = bim[(size_t)g * 1024 + idx], zr = ZZ[p * 2], zi = ZZ[p * 2 + 1];
              BB[idx * 2] = zr * br - zi * bi; BB[idx * 2 + 1] = zr * bi + zi * br; }
            { CC[idx * 2] = cre[(size_t)g * 1024 + idx]; CC[idx * 2 + 1] = cim[(size_t)g * 1024 + idx]; }
        }
        if (FTID < 256) KT[FTID] = 0;
        __syncthreads();
        for (int idx = FTID; idx < 2048; idx += 512) {
            { const int t = idx >> 8, ks = (idx >> 6) & 3, ln = idx & 63, c = ln & 15, qq = ln >> 4; unsigned w[4];
#pragma unroll
              for (int j = 0; j < 4; ++j) { const int p = 16 * ks + 4 * qq + j; const float cr_ = CC[(c * 64 + p) * 2], ci_ = CC[(c * 64 + p) * 2 + 1], pr = PW[((t + 1) * 64 + p) * 2], pi = PW[((t + 1) * 64 + p) * 2 + 1];
                  const float gr = cr_ * pr - ci_ * pi, gi = cr_ * pi + ci_ * pr;
                  if (j & 1) { w[j >> 1] |= f2bf(gr) << 16; w[2 + (j >> 1)] |= f2bf(-gi) << 16; } else { w[j >> 1] = f2bf(gr); w[2 + (j >> 1)] = f2bf(-gi); } }
              *(LAS v4u*)(W3F + (size_t)idx * 8) = (v4u){w[0], w[1], w[2], w[3]}; }
            { const int rb = idx >> 8, sp = (idx >> 6) & 3, ln = idx & 63, rr = ln & 15, qq = ln >> 4, p = 16 * (rb >> 1) + rr, s = 2 * sp + (qq >> 1), c0 = 8 * (qq & 1); unsigned w[4];
              const float pr = PW[((7 - s) * 64 + p) * 2], pi = PW[((7 - s) * 64 + p) * 2 + 1];
#pragma unroll
              for (int j = 0; j < 8; ++j) { const float br = BB[(p * 16 + c0 + j) * 2], bi = BB[(p * 16 + c0 + j) * 2 + 1]; const float v = (rb & 1) ? (pr * bi + pi * br) : (pr * br - pi * bi);
                  if (j & 1) w[j >> 1] |= f2bf(v) << 16; else w[j >> 1] = f2bf(v); }
              *(LAS v4u*)(W2F + (size_t)idx * 8) = (v4u){w[0], w[1], w[2], w[3]}; }
        }
        if (FTID < 256) { const int ks = FTID >> 6, ln = FTID & 63, c = ln & 15, qq = ln >> 4; unsigned w[4];
#pragma unroll
            for (int j = 0; j < 4; ++j) { const int p = 16 * ks + 4 * qq + j; const float gr = CC[(c * 64 + p) * 2], gi = CC[(c * 64 + p) * 2 + 1];
                if (j & 1) { w[j >> 1] |= f2bf(gr) << 16; w[2 + (j >> 1)] |= f2bf(-gi) << 16; } else { w[j >> 1] = f2bf(gr); w[2 + (j >> 1)] = f2bf(-gi); } }
            *(LAS v4u*)(W30 + (size_t)FTID * 8) = (v4u){w[0], w[1], w[2], w[3]}; }
        __syncthreads();
        {
            f32x4 kacc = (f32x4){0.f, 0.f, 0.f, 0.f}; const int tau = F.wave;
#pragma unroll
            for (int ks = 0; ks < 4; ++ks) { unsigned w[4];
#pragma unroll
                for (int j = 0; j < 4; ++j) { const int p = 16 * ks + 4 * q + j; const float br = BB[(p * 16 + r) * 2], bi = BB[(p * 16 + r) * 2 + 1];
                    if (j & 1) { w[j >> 1] |= f2bf(br) << 16; w[2 + (j >> 1)] |= f2bf(bi) << 16; } else { w[j >> 1] = f2bf(br); w[2 + (j >> 1)] = f2bf(bi); } }
                const v4u wb = (v4u){w[0], w[1], w[2], w[3]};
                const bf16x8 af = tau == 0 ? *(const LAS bf16x8*)(W30 + (ks * 64 + FLANE) * 8) : *(const LAS bf16x8*)(W3F + (((tau - 1) * 4 + ks) * 64 + FLANE) * 8);
                kacc = __builtin_amdgcn_mfma_f32_16x16x32_bf16(af, __builtin_bit_cast(bf16x8, wb), kacc, 0, 0, 0); }
#pragma unroll
            for (int k = 0; k < 4; ++k) KT[(tau + 1) * 256 + (4 * q + k) * 16 + r] = (bf16)f2bf(kacc[k]); }
        __syncthreads();
        if (variant != 1) { if ((F.wave >> 2) == 0) s5_main<0>(F, ug, yb, dsk, g, bh, W2F, W3F, KT, PW, r, q, variant); else s5_main<1>(F, ug, yb, dsk, g, bh, W2F, W3F, KT, PW, r, q, variant); }
    }
}

struct PlainSched {
    pg8::TileOrder T; const char* A; const char* B; int tilesPerBatch; size_t bBatch; int splitN; size_t aT = pg8::TSTEP, bT = pg8::TSTEP;
    __device__ __forceinline__ bool next(int i, pg8::Unit& u) const {
        int pm, pn; if (!T.get(i, pm, pn)) return false;
        const int z = pm / tilesPerBatch;
        u.a = A + (size_t)pm * aT; u.b = B + (size_t)z * bBatch + (size_t)pn * bT; u.row0 = pm * 256; u.col0 = pn * 256; u.z = z; u.aux = 0;
        if (splitN) { u.z = pn >= splitN; u.col0 = (pn >= splitN ? pn - splitN : pn) * 256; }
        return true;
    }
};
struct FoldSched {
    int G, c, first; const char* KB; const char* VB; const char* XQ; const char* XOT;
    __device__ __forceinline__ bool next(int i, pg8::Unit& u) const {
        const int idx = i * G + c - first; if (idx < 0 || idx >= 512) return false;
        const int type = idx >> 8, j = idx & 255, b = j >> 4, h = (j >> 2) & 3, t = j & 3;
        if (type == 0) { u.a = KB + (size_t)b * 256 * 2048 + h * 512; u.b = XQ + (size_t)t * pg8::TSTEP + h * 512; u.row0 = b * 1024 + h * 256; u.col0 = t * 256; u.z = 0; }
        else { u.a = XOT + (size_t)t * pg8::TSTEP + h * 512; u.b = VB + (size_t)b * 256 * 2048 + h * 512; u.row0 = b * 1024 + t * 256; u.col0 = h * 256; u.z = 1; }
        u.aux = 0; return true;
    }
};
struct MoeSched {
    LAS const int* tab; int NT, G, c; const char* A; const char* B; size_t bExp; int colw; const int* list; bool gather; size_t tileB;
    __device__ __forceinline__ bool next(int i, pg8::Unit& u) const {
        const int nblk = __builtin_amdgcn_readfirstlane(tab[64]);
        const int x = c >> 5, r = c & 31; int mbl, pn;
        if (G != 256 || NT != 8) { mbl = c / NT; pn = c % NT; } else { pn = 4 * (x & 1) + (r & 3); mbl = 8 * (x >> 1) + (r >> 2); }
        const int mbg = i * (G / NT) + mbl; if (mbg >= nblk) return false;
        const int lane = opaque_tid() & 63; const int v = (lane <= 32) ? tab[32 + lane] : 0x7fffffff;
        const int e = __popcll(__ballot(v <= mbg)) - 1;
        const int mb = mbg - __builtin_amdgcn_readfirstlane(tab[32 + e]);
        u.a = gather ? A : A + (size_t)mbg * tileB; u.b = B + (size_t)e * bExp + (size_t)pn * tileB;
        u.row0 = mbg * 256; u.col0 = pn * colw; u.z = e; u.aux = mb; return true;
    }
    __device__ __forceinline__ const int* rows(const pg8::Unit& u) const { return list + (size_t)u.z * CAP + u.aux * 256; }
    __device__ __forceinline__ static int rowmap(int v) { return (int)(((unsigned)v >> 2) & (unsigned)(MTOK - 1)); }
};

__device__ __forceinline__ void store_rowpair16(unsigned char* base, size_t rowA, size_t rowB, int colp, int fq, v2u a, v2u b, size_t pitch = DM) {
    const auto sx = __builtin_amdgcn_permlane16_swap(a.x, b.x, false, false); const auto sy = __builtin_amdgcn_permlane16_swap(a.y, b.y, false, false);
    *(GAS v4u*)(base + ((fq & 1) ? rowB : rowA) * pitch + colp) = (v4u){sx[0], sy[0], sx[1], sy[1]}; }
#define ST8_ROWPAIR(basep, rowcur, colp, hold, w, pitch) do { if ((m & 1) == 0) (hold) = (w); else store_rowpair16((unsigned char*)(basep), (size_t)(rowcur) - 16, (size_t)(rowcur), (colp), fq, (hold), (w), (pitch)); } while (0)
#define EPI_ROWS_BEGIN _Pragma("unroll") for (int ai = 0; ai < 2; ++ai) _Pragma("unroll") for (int m = 0; m < 4; ++m) { const int rloc = ai * 128 + wr * 64 + m * 16 + fr;
#define EPI_ROWS_END }
__device__ __forceinline__ v4u pack8(f32x4 v0, f32x4 v1) { v4u w; w.x = pg8::cvt_pk_bf16(v0[0], v0[1]); w.y = pg8::cvt_pk_bf16(v0[2], v0[3]); w.z = pg8::cvt_pk_bf16(v1[0], v1[1]); w.w = pg8::cvt_pk_bf16(v1[2], v1[3]); return w; }
__device__ __forceinline__ void unpack8(v4u w, f32x4& a, f32x4& b) { a = (f32x4){bflo(w.x), bfhi(w.x), bflo(w.y), bfhi(w.y)}; b = (f32x4){bflo(w.z), bfhi(w.z), bflo(w.w), bfhi(w.w)}; }
__device__ __forceinline__ void rowpair_publish(LAS float* tab, float* dst, int nslot, int slot, int row0, const float (&ss)[8], const float (&qq)[8], int wr, int wc, int fr, int fq) {
    if (fq == 0) {
#pragma unroll
        for (int i = 0; i < 8; ++i) { const int rl = (i >> 2) * 128 + wr * 64 + (i & 3) * 16 + fr; tab[(rl * 4 + wc) * 2] = ss[i]; tab[(rl * 4 + wc) * 2 + 1] = qq[i]; } }
    LDS_WAIT(); __builtin_amdgcn_s_barrier(); asm volatile("" ::: "memory");
    { const int t = opaque_tid(), row = t >> 1, which = t & 1;
      const float v = (tab[(row * 4 + 0) * 2 + which] + tab[(row * 4 + 1) * 2 + which]) + (tab[(row * 4 + 2) * 2 + which] + tab[(row * 4 + 3) * 2 + which]);
      dst[((size_t)(row0 + row) * nslot + slot) * 2 + which] = v; }
    LDS_WAIT(); __builtin_amdgcn_s_barrier(); asm volatile("" ::: "memory");
}
__device__ __forceinline__ void ln_tables(LAS float* tabR, LAS float* tabC, const float* st, int nslot, int row0, const float* sc, int scrow0, const float* v0, const float* v1, int col0) {
    const int t = opaque_tid();
    if (t < 256) { const float* p = st + (size_t)(row0 + t) * 16; float s = 0.f, q = 0.f;
        for (int k = 0; k < nslot; ++k) { s += p[2 * k]; q += p[2 * k + 1]; }
        const float mu = s * (1.f / DM); tabR[2 * t] = mu; tabR[2 * t + 1] = 1.f / sqrtf(fmaxf(q * (1.f / DM) - mu * mu, 0.f) + LN_EPS); }
    else { const int c = t - 256;
        if (sc) { const f32x4 a = *(const GAS f32x4*)(sc + (size_t)(scrow0 + c) * 8), b = *(const GAS f32x4*)(sc + (size_t)(scrow0 + c) * 8 + 4);
            tabC[c] = (a[0] + a[2]) + (b[0] + b[2]); tabC[256 + c] = (a[1] + a[3]) + (b[1] + b[3]); }
        else { tabC[c] = v0[col0 + c]; tabC[256 + c] = v1[col0 + c]; } }
    LDS_WAIT(); __builtin_amdgcn_s_barrier(); asm volatile("" ::: "memory");
}
struct EpiResidStats { const bf16* xb; bf16* zb; unsigned char* z8; float* st; LAS float* tab;
    __device__ __forceinline__ void operator()(EPI_ARGS) const {
        float ss[8], qq[8]; v4u xr[2][4][2];
        EPI_ROWS_BEGIN const size_t off = (size_t)(u.row0 + rloc) * DM + u.col0 + wc * 32 + 8 * fq; xr[ai][m][0] = *(const GAS v4u*)(xb + off); xr[ai][m][1] = *(const GAS v4u*)(xb + off + 128); EPI_ROWS_END
        EPI_ROWS_BEGIN const size_t off = (size_t)(u.row0 + rloc) * DM + u.col0 + wc * 32 + 8 * fq; float s = 0.f, q = 0.f;
#pragma unroll
            for (int bj = 0; bj < 2; ++bj) { f32x4 x0, x1; unpack8(xr[ai][m][bj], x0, x1);
                const f32x4 z0 = x0 * ALPHA + acc[ai][bj][m][0], z1 = x1 * ALPHA + acc[ai][bj][m][1];
                *(GAS v4u*)(zb + off + bj * 128) = pack8(z0, z1);
                v2u w; w.x = pk4_fp8(z0[0] * SZ8, z0[1] * SZ8, z0[2] * SZ8, z0[3] * SZ8); w.y = pk4_fp8(z1[0] * SZ8, z1[1] * SZ8, z1[2] * SZ8, z1[3] * SZ8); *(GAS v2u*)(z8 + off + bj * 128) = w;
                s += ((z0[0] + z0[1]) + (z0[2] + z0[3])) + ((z1[0] + z1[1]) + (z1[2] + z1[3])); q += ((z0[0] * z0[0] + z0[1] * z0[1]) + (z0[2] * z0[2] + z0[3] * z0[3])) + ((z1[0] * z1[0] + z1[1] * z1[1]) + (z1[2] * z1[2] + z1[3] * z1[3])); }
            s += __shfl_xor(s, 16); s += __shfl_xor(s, 32); q += __shfl_xor(q, 16); q += __shfl_xor(q, 32); ss[ai * 4 + m] = s; qq[ai * 4 + m] = q; EPI_ROWS_END
        rowpair_publish(tab, st, 8, u.col0 >> 8, u.row0, ss, qq, wr, wc, fr, fq);
    } };
struct EpiResidLN { bf16* zb; float rs; const float* st; LAS float* tab; const float* g; const float* b; int nslot;
    __device__ __forceinline__ void operator()(EPI_ARGS) const {
        LAS float* tabC = tab + 512; ln_tables(tab, tabC, st, nslot, u.row0, nullptr, 0, g, b, u.col0);
        const int c8 = u.col0 + wc * 32 + 8 * fq, cl = wc * 32 + 8 * fq; v4u zr[2][4][2];
        EPI_ROWS_BEGIN const size_t off = (size_t)(u.row0 + rloc) * DM + c8; zr[ai][m][0] = *(const GAS v4u*)(zb + off); zr[ai][m][1] = *(const GAS v4u*)(zb + off + 128); EPI_ROWS_END
        EPI_ROWS_BEGIN const size_t off = (size_t)(u.row0 + rloc) * DM + c8; const float mu = tab[2 * rloc], rstd = tab[2 * rloc + 1];
#pragma unroll
            for (int bj = 0; bj < 2; ++bj) { f32x4 x0, x1; unpack8(zr[ai][m][bj], x0, x1);
                const f32x4 g0 = *(const LAS f32x4*)(tabC + cl + bj * 128), g1 = *(const LAS f32x4*)(tabC + cl + bj * 128 + 4), b0 = *(const LAS f32x4*)(tabC + 256 + cl + bj * 128), b1 = *(const LAS f32x4*)(tabC + 256 + cl + bj * 128 + 4);
                x0 = (x0 - mu) * rstd * g0 + b0; x1 = (x1 - mu) * rstd * g1 + b1;
                *(GAS v4u*)(zb + off + bj * 128) = pack8(x0 * ALPHA + acc[ai][bj][m][0] * rs, x1 * ALPHA + acc[ai][bj][m][1] * rs); } EPI_ROWS_END
        LDS_WAIT(); __builtin_amdgcn_s_barrier(); asm volatile("" ::: "memory");
    } };
struct EpiFold { unsigned char* kft; unsigned char* vft; const float* g; const float* b; float* sc; LAS float* tab;
    __device__ __forceinline__ void operator()(EPI_ARGS) const {
        if (u.z) {
            v2u hold8[2];
            EPI_ROWS_BEGIN
#pragma unroll
                for (int bj = 0; bj < 2; ++bj) { const f32x4 v0 = acc[ai][bj][m][0] * SV8, v1 = acc[ai][bj][m][1] * SV8; v2u w; w.x = pk4_fp8(v0[0], v0[1], v0[2], v0[3]); w.y = pk4_fp8(v1[0], v1[1], v1[2], v1[3]); ST8_ROWPAIR(vft, u.row0 + rloc, u.col0 + wc * 32 + 8 * (fq & 2) + bj * 128, hold8[bj], w, 1024); } EPI_ROWS_END
            return; }
        float ss[8], qq[8]; const int c8 = u.col0 + wc * 32 + 8 * fq, cl = wc * 32 + 8 * fq; LAS float* tabC = tab + 2048;
        { const int t = opaque_tid(); if (t < 256) tabC[t] = g[u.col0 + t] * CSC; else tabC[t] = b[u.col0 + t - 256] * CSC; }
        LDS_WAIT(); __builtin_amdgcn_s_barrier(); asm volatile("" ::: "memory");
        v2u hold8[2];
        EPI_ROWS_BEGIN float s = 0.f, q = 0.f;
#pragma unroll
            for (int bj = 0; bj < 2; ++bj) { const f32x4 g0 = *(const LAS f32x4*)(tabC + cl + bj * 128), g1 = *(const LAS f32x4*)(tabC + cl + bj * 128 + 4), b0 = *(const LAS f32x4*)(tabC + 256 + cl + bj * 128), b1 = *(const LAS f32x4*)(tabC + 256 + cl + bj * 128 + 4);
                const f32x4 k0 = acc[ai][bj][m][0] * g0, k1 = acc[ai][bj][m][1] * g1, c0 = acc[ai][bj][m][0] * b0, c1 = acc[ai][bj][m][1] * b1;
                s += ((k0[0] + k0[1]) + (k0[2] + k0[3])) + ((k1[0] + k1[1]) + (k1[2] + k1[3])); q += ((c0[0] + c0[1]) + (c0[2] + c0[3])) + ((c1[0] + c1[1]) + (c1[2] + c1[3]));
                v2u w; w.x = pk4_fp8(k0[0] * SK8, k0[1] * SK8, k0[2] * SK8, k0[3] * SK8); w.y = pk4_fp8(k1[0] * SK8, k1[1] * SK8, k1[2] * SK8, k1[3] * SK8); ST8_ROWPAIR(kft, u.row0 + rloc, u.col0 + wc * 32 + 8 * (fq & 2) + bj * 128, hold8[bj], w, 1024); }
            s += __shfl_xor(s, 16); s += __shfl_xor(s, 32); q += __shfl_xor(q, 16); q += __shfl_xor(q, 32); ss[ai * 4 + m] = s; qq[ai * 4 + m] = q; EPI_ROWS_END
        rowpair_publish(tab, sc, 4, u.col0 >> 8, u.row0, ss, qq, wr, wc, fr, fq);
    } };
struct EpiStore { bf16* base0; bf16* base1; float s0, s1; int ldc; int f8mask = 0;
    __device__ __forceinline__ void operator()(EPI_ARGS) const {
        bf16* base = u.z ? base1 : base0; const float sc = u.z ? s1 : s0;
        if ((f8mask >> (u.z ? 1 : 0)) & 1) { unsigned char* b8 = (unsigned char*)base;
            v2u hold8[2];
            EPI_ROWS_BEGIN
#pragma unroll
                for (int bj = 0; bj < 2; ++bj) { const f32x4 v0 = acc[ai][bj][m][0] * sc, v1 = acc[ai][bj][m][1] * sc; v2u w; w.x = pk4_fp8(v0[0], v0[1], v0[2], v0[3]); w.y = pk4_fp8(v1[0], v1[1], v1[2], v1[3]); ST8_ROWPAIR(b8, u.row0 + rloc, u.col0 + wc * 32 + 8 * (fq & 2) + bj * 128, hold8[bj], w, (size_t)ldc); } EPI_ROWS_END
            return; }
        EPI_ROWS_BEGIN bf16* rowp = base + (size_t)(u.row0 + rloc) * ldc + u.col0 + wc * 32 + 8 * fq;
#pragma unroll
            for (int bj = 0; bj < 2; ++bj) *(GAS v4u*)(rowp + bj * 128) = pack8(acc[ai][bj][m][0] * sc, acc[ai][bj][m][1] * sc); EPI_ROWS_END
    } };
struct EpiH0 { bf16* uv; bf16* qx; bf16* kx; bf16* vx; float rs;
    __device__ __forceinline__ void operator()(EPI_ARGS) const {
        const int pn = u.col0 >> 8, kind = pn < 4 ? 0 : ((pn - 4) >> 1) + 1;
        bf16* base = kind == 0 ? uv : kind == 1 ? qx : kind == 2 ? kx : vx;
        EPI_ROWS_BEGIN bf16* rowp = base + (size_t)(u.row0 + rloc) * DM;
#pragma unroll
            for (int bj = 0; bj < 2; ++bj) { f32x4 v0 = acc[ai][bj][m][0] * rs, v1 = acc[ai][bj][m][1] * rs;
                if (kind == 0) {
#pragma unroll
                    for (int j = 0; j < 1; ++j) { v0.lo = gelu_tanh2(v0.lo, 1.0f); v0.hi = gelu_tanh2(v0.hi, 1.0f); v1.lo = gelu_tanh2(v1.lo, 1.0f); v1.hi = gelu_tanh2(v1.hi, 1.0f); }
                    *(GAS v4u*)(rowp + u.col0 + bj * 128 + wc * 32 + 8 * fq) = pack8(v0, v1); }
                else { const int cr = ((pn - 4) & 1) * 256 + bj * 128 + wc * 32 + 8 * fq;
                    if (kind == 1) { v0 = v0 * C2; v1 = v1 * C2; }
                    *(GAS v4u*)(rowp + cr) = pack8(v0, v1); } } EPI_ROWS_END
    } };
struct EpiResid { const bf16* xb; bf16* zb; float rs = 1.0f;
    __device__ __forceinline__ void operator()(EPI_ARGS) const {
        EPI_ROWS_BEGIN const size_t off = (size_t)(u.row0 + rloc) * DM + u.col0 + wc * 32 + 8 * fq;
#pragma unroll
            for (int bj = 0; bj < 2; ++bj) { f32x4 x0, x1; unpack8(*(const GAS v4u*)(xb + off + bj * 128), x0, x1);
                *(GAS v4u*)(zb + off + bj * 128) = pack8(x0 * ALPHA + acc[ai][bj][m][0] * rs, x1 * ALPHA + acc[ai][bj][m][1] * rs); } EPI_ROWS_END
    } };
struct EpiUG { bf16* ug; float rs;
    __device__ __forceinline__ void operator()(EPI_ARGS) const {
        EPI_ROWS_BEGIN
#pragma unroll
            for (int bj = 0; bj < 2; ++bj) { const int col = u.col0 + bj * 128 + wc * 32 + 8 * fq;
                *(GAS v4u*)(ug + ((size_t)(col >> 4) * MTOK + (u.row0 + rloc)) * 16 + (col & 15)) = pack8(acc[ai][bj][m][0] * rs, acc[ai][bj][m][1] * rs); } EPI_ROWS_END
    } };
struct EpiScore { float* sc;
    __device__ __forceinline__ void operator()(EPI_ARGS) const {
        EPI_ROWS_BEGIN float* rowp = sc + (size_t)(u.row0 + rloc) * DM + u.col0 + wc * 32 + 8 * fq;
#pragma unroll
            for (int bj = 0; bj < 2; ++bj) { *(GAS f32x4*)(rowp + bj * 128) = acc[ai][bj][m][0]; *(GAS f32x4*)(rowp + bj * 128 + 4) = acc[ai][bj][m][1]; } EPI_ROWS_END
    } };
struct EpiSoftmaxP { bf16* P; LAS float* tab; float rs0; const float* st; const float* sc; int nslot;
    __device__ __forceinline__ void operator()(EPI_ARGS) const {
        { auto& A = const_cast<f32x4 (&)[2][2][4][2]>(acc); LAS float* tabC = tab + 512; ln_tables(tab, tabC, st, nslot, u.row0, sc, u.z * 1024 + u.col0, nullptr, nullptr, 0);
          const int cl = wc * 32 + 8 * fq;
          EPI_ROWS_BEGIN const float mu = tab[2 * rloc], rstd = tab[2 * rloc + 1];
#pragma unroll
              for (int bj = 0; bj < 2; ++bj)
#pragma unroll
                  for (int n = 0; n < 2; ++n) { const f32x4 s1 = *(const LAS f32x4*)(tabC + cl + bj * 128 + 4 * n), c1 = *(const LAS f32x4*)(tabC + 256 + cl + bj * 128 + 4 * n);
                      A[ai][bj][m][n] = (A[ai][bj][m][n] * rs0 - s1 * mu) * rstd + c1; } EPI_ROWS_END
          LDS_WAIT(); __builtin_amdgcn_s_barrier(); asm volatile("" ::: "memory"); }
        constexpr float rs = 1.0f; auto& A2 = const_cast<f32x4 (&)[2][2][4][2]>(acc);
        EPI_ROWS_BEGIN float mx = -3.0e38f;
#pragma unroll
            for (int bj = 0; bj < 2; ++bj)
#pragma unroll
                for (int n = 0; n < 2; ++n)
#pragma unroll
                    for (int j = 0; j < 4; ++j) mx = fmaxf(mx, acc[ai][bj][m][n][j]);
            mx *= rs; mx = fmaxf(mx, __shfl_xor(mx, 16)); mx = fmaxf(mx, __shfl_xor(mx, 32));
            float sm = 0.f;
#pragma unroll
            for (int bj = 0; bj < 2; ++bj)
#pragma unroll
                for (int n = 0; n < 2; ++n)
#pragma unroll
                    for (int j = 0; j < 4; ++j) { const float p = __builtin_amdgcn_exp2f(acc[ai][bj][m][n][j] * rs - mx); A2[ai][bj][m][n][j] = p; sm += p; }
            sm += __shfl_xor(sm, 16); sm += __shfl_xor(sm, 32);
            if (fq == 0) { tab[(rloc * 4 + wc) * 2] = mx; tab[(rloc * 4 + wc) * 2 + 1] = sm; } EPI_ROWS_END
        LDS_WAIT(); __builtin_amdgcn_s_barrier(); asm volatile("" ::: "memory");
        v2u holdP[2];
        EPI_ROWS_BEGIN const f32x4 a = *(const LAS f32x4*)(tab + rloc * 8), b = *(const LAS f32x4*)(tab + rloc * 8 + 4);
            const float M = fmaxf(fmaxf(a[0], a[2]), fmaxf(b[0], b[2]));
            const float S = a[1] * __builtin_amdgcn_exp2f(a[0] - M) + a[3] * __builtin_amdgcn_exp2f(a[2] - M) + b[1] * __builtin_amdgcn_exp2f(b[0] - M) + b[3] * __builtin_amdgcn_exp2f(b[2] - M);
            const float mown = wc == 0 ? a[0] : wc == 1 ? a[2] : wc == 2 ? b[0] : b[2];
            const float inv = SP8 / S * __builtin_amdgcn_exp2f(mown - M);
#pragma unroll
            for (int bj = 0; bj < 2; ++bj) { const f32x4 v0 = acc[ai][bj][m][0] * inv, v1 = acc[ai][bj][m][1] * inv;
                v2u w; w.x = pk4_fp8(v0[0], v0[1], v0[2], v0[3]); w.y = pk4_fp8(v1[0], v1[1], v1[2], v1[3]); ST8_ROWPAIR(P, u.row0 + rloc, u.col0 + wc * 32 + 8 * (fq & 2) + bj * 128, holdP[bj], w, DM); } EPI_ROWS_END
        LDS_WAIT(); __builtin_amdgcn_s_barrier(); asm volatile("" ::: "memory");
    } };
struct EpiRouter { float* logit;
    __device__ __forceinline__ void operator()(EPI_ARGS) const {
        if (wc == 0) { EPI_ROWS_BEGIN float* rowp = logit + (size_t)(u.row0 + rloc) * 32 + 8 * fq; *(GAS f32x4*)(rowp) = acc[ai][0][m][0]; *(GAS f32x4*)(rowp + 4) = acc[ai][0][m][1]; EPI_ROWS_END }
    } };
struct EpiSwiglu { const float* bup; bf16* act;
    __device__ __forceinline__ void operator()(EPI_ARGS) const {
        const int j0 = u.col0 + wc * 32 + 8 * fq; const float* bb = bup + (size_t)u.z * 2048;
        const f32x4 bg0 = *(const GAS f32x4*)(bb + j0), bg1 = *(const GAS f32x4*)(bb + j0 + 4), bl0 = *(const GAS f32x4*)(bb + 1024 + j0), bl1 = *(const GAS f32x4*)(bb + 1024 + j0 + 4);
        EPI_ROWS_BEGIN f32x4 o0, o1;
#pragma unroll
            for (int j = 0; j < 4; ++j) {
                { const float gl = fminf(acc[ai][0][m][0][j] + bg0[j], 7.0f), ln = fminf(fmaxf(acc[ai][1][m][0][j] + bl0[j], -7.0f), 7.0f); o0[j] = gl * sigmoidf_(1.702f * gl) * (ln + 1.0f); }
                { const float gl = fminf(acc[ai][0][m][1][j] + bg1[j], 7.0f), ln = fminf(fmaxf(acc[ai][1][m][1][j] + bl1[j], -7.0f), 7.0f); o1[j] = gl * sigmoidf_(1.702f * gl) * (ln + 1.0f); } }
            *(GAS v4u*)(act + (size_t)(u.row0 + rloc) * DM + j0) = pack8(o0, o1); EPI_ROWS_END
    } };
struct EpiDown { const float* bdn; const int* list; const float* gate; bf16* ys; LAS const int* tab;
    __device__ __forceinline__ void operator()(EPI_ARGS) const {
        const int e = u.z, cnt = tab[e], c8 = u.col0 + wc * 32 + 8 * fq; const float* bb = bdn + (size_t)e * 1024 + c8;
        f32x4 bv[2][2];
#pragma unroll
        for (int bj = 0; bj < 2; ++bj) { bv[bj][0] = *(const GAS f32x4*)(bb + bj * 128); bv[bj][1] = *(const GAS f32x4*)(bb + bj * 128 + 4); }
        int av[8]; float gv[8];
#pragma unroll
        for (int i = 0; i < 8; ++i) { const int slot = u.aux * 256 + (i >> 2) * 128 + wr * 64 + (i & 3) * 16 + fr; const int sl = slot < cnt ? slot : 0;
            av[i] = (int)((unsigned)list[(size_t)e * CAP + sl] & (unsigned)(NASSIGN - 1)); }
#pragma unroll
        for (int i = 0; i < 8; ++i) gv[i] = gate[av[i]];
        EPI_ROWS_BEGIN const int slot = u.aux * 256 + rloc; const int a = av[ai * 4 + m]; const float gt = gv[ai * 4 + m]; bf16* rowp = ys + (size_t)a * DM + c8;
            if (slot < cnt) {
#pragma unroll
                for (int bj = 0; bj < 2; ++bj) *(GAS v4u*)(rowp + bj * 128) = pack8((acc[ai][bj][m][0] + bv[bj][0]) * gt, (acc[ai][bj][m][1] + bv[bj][1]) * gt); } EPI_ROWS_END
    } };
struct EpiSwiglu8 { const float* bup; unsigned char* act; int skip; LAS float* slot;
    static constexpr bool HAS_PRE = true;
    __device__ __forceinline__ void pre(const pg8::Unit& u, int wid, int lane) const {
        if (wid < 4) { const int t = wid * 64 + lane; const float* src = bup + (size_t)u.z * 2048 + u.col0 + (t < 128 ? t : 1024 + t - 128);
            __builtin_amdgcn_global_load_lds((const unsigned*)src, (LAS unsigned*)(slot + u.par * 256 + wid * 64), 4, 0, 0); } }
    __device__ __forceinline__ void operator()(EPI_ARGS) const {
        if (skip) {
#pragma unroll
            for (int a = 0; a < 2; ++a)
#pragma unroll
                for (int b = 0; b < 2; ++b)
#pragma unroll
                    for (int m = 0; m < 4; ++m) asm volatile("" :: "v"(acc[a][b][m][0]), "v"(acc[a][b][m][1])); return; }
        const int j0 = u.col0 + wc * 32 + 8 * fq; constexpr float RS = 1.0f / (SX8 * SWU8); const LAS float* sb = slot + u.par * 256 + wc * 32 + 8 * fq;
        const f32x4 bg0 = *(const LAS f32x4*)(sb), bg1 = *(const LAS f32x4*)(sb + 4), bl0 = *(const LAS f32x4*)(sb + 128), bl1 = *(const LAS f32x4*)(sb + 132);
        typedef float f32x2 __attribute__((ext_vector_type(2)));
        v2u wq[2][4];
        EPI_ROWS_BEGIN f32x4 o0, o1;
#pragma unroll
            for (int n = 0; n < 2; ++n)
#pragma unroll
                for (int h = 0; h < 2; ++h) {
                    const f32x4 ga = acc[ai][0][m][n], la = acc[ai][1][m][n], bgv = n ? bg1 : bg0, blv = n ? bl1 : bl0;
                    const f32x2 g2 = h ? ga.hi : ga.lo, l2 = h ? la.hi : la.lo, bg2 = h ? bgv.hi : bgv.lo, bl2 = h ? blv.hi : blv.lo;
                    f32x2 gl = g2 * RS + bg2, ln = l2 * RS + bl2;
                    gl.x = fminf(gl.x, 7.0f); gl.y = fminf(gl.y, 7.0f); ln.x = __builtin_amdgcn_fmed3f(ln.x, -7.0f, 7.0f); ln.y = __builtin_amdgcn_fmed3f(ln.y, -7.0f, 7.0f);
                    const f32x2 ea = gl * (-1.702f * LOG2E); f32x2 d; d.x = __builtin_amdgcn_exp2f(ea.x); d.y = __builtin_amdgcn_exp2f(ea.y); d = d + 1.0f;
                    f32x2 rc; rc.x = __builtin_amdgcn_rcpf(d.x); rc.y = __builtin_amdgcn_rcpf(d.y);
                    const f32x2 o = (gl * rc) * (ln * SA8 + SA8);
                    if (n == 0) { o0[2 * h] = o.x; o0[2 * h + 1] = o.y; } else { o1[2 * h] = o.x; o1[2 * h + 1] = o.y; } }
            v2u w; { int r0 = __builtin_amdgcn_cvt_pk_fp8_f32(o0[0], o0[1], 0, false); r0 = __builtin_amdgcn_cvt_pk_fp8_f32(o0[2], o0[3], r0, true); int r1 = __builtin_amdgcn_cvt_pk_fp8_f32(o1[0], o1[1], 0, false); r1 = __builtin_amdgcn_cvt_pk_fp8_f32(o1[2], o1[3], r1, true); w.x = (unsigned)r0; w.y = (unsigned)r1; }
            wq[ai][m] = w; EPI_ROWS_END
#pragma unroll
        for (int ai = 0; ai < 2; ++ai)
#pragma unroll
            for (int mp = 0; mp < 2; ++mp) { const size_t rA = (size_t)(u.row0 + ai * 128 + wr * 64 + (2 * mp) * 16 + fr);
                store_rowpair16(act, rA, rA + 16, u.col0 + wc * 32 + 8 * (fq & 2), fq, wq[ai][2 * mp], wq[ai][2 * mp + 1]); }
    } };
struct EpiDown8 { const float* bdn; bf16* ys; LAS float* slot;
    static constexpr bool HAS_PRE = true;
    __device__ __forceinline__ void pre(const pg8::Unit& u, int wid, int lane) const {
        if (wid < 4) __builtin_amdgcn_global_load_lds((const unsigned*)(bdn + (size_t)u.z * 1024 + u.col0 + wid * 64 + lane), (LAS unsigned*)(slot + u.par * 256 + wid * 64), 4, 0, 0); }
    __device__ __forceinline__ void operator()(EPI_ARGS) const {
        const int c8 = u.col0 + wc * 32 + 8 * fq; const LAS float* bb = slot + u.par * 256 + wc * 32 + 8 * fq; constexpr float RS = 1.0f / (SA8 * SWD8);
        f32x4 bv[2][2];
#pragma unroll
        for (int bj = 0; bj < 2; ++bj) { bv[bj][0] = *(const LAS f32x4*)(bb + bj * 128); bv[bj][1] = *(const LAS f32x4*)(bb + bj * 128 + 4); }
#pragma unroll
        for (int ai = 0; ai < 2; ++ai)
#pragma unroll
            for (int mp = 0; mp < 2; ++mp) { const size_t rA = (size_t)(u.row0 + ai * 128 + wr * 64 + (2 * mp) * 16 + fr);
#pragma unroll
                for (int bj = 0; bj < 2; ++bj) { v2u w[2];
#pragma unroll
                    for (int mm = 0; mm < 2; ++mm) { const int m = 2 * mp + mm; const f32x4 v0 = (acc[ai][bj][m][0] * RS + bv[bj][0]) * SY8, v1 = (acc[ai][bj][m][1] * RS + bv[bj][1]) * SY8; w[mm].x = pk4_fp8(v0[0], v0[1], v0[2], v0[3]); w[mm].y = pk4_fp8(v1[0], v1[1], v1[2], v1[3]); }
                    store_rowpair16((unsigned char*)ys, rA, rA + 16, u.col0 + wc * 32 + 8 * (fq & 2) + bj * 128, fq, w[0], w[1]); } }
    } };
struct EpiValGate { const bf16* xb; bf16* zb; float rsv, rsg; unsigned char* z8; float* st; LAS float* tab;
    __device__ __forceinline__ void operator()(EPI_ARGS) const {
        float ss[8], qq[8]; v4u xr[2][4];
        EPI_ROWS_BEGIN xr[ai][m] = *(const GAS v4u*)(xb + (size_t)(u.row0 + rloc) * DM + u.col0 + wc * 32 + 8 * fq); EPI_ROWS_END
        v2u hold8;
        EPI_ROWS_BEGIN const size_t off = (size_t)(u.row0 + rloc) * DM + u.col0 + wc * 32 + 8 * fq; f32x4 x0, x1; unpack8(xr[ai][m], x0, x1); f32x4 o0, o1;
#pragma unroll
            for (int j = 0; j < 4; ++j) { o0[j] = x0[j] * ALPHA + acc[ai][0][m][0][j] * rsv * sigmoidf_(acc[ai][1][m][0][j] * rsg); o1[j] = x1[j] * ALPHA + acc[ai][0][m][1][j] * rsv * sigmoidf_(acc[ai][1][m][1][j] * rsg); }
            *(GAS v4u*)(zb + off) = pack8(o0, o1);
            { v2u w; w.x = pk4_fp8(o0[0] * SZ8, o0[1] * SZ8, o0[2] * SZ8, o0[3] * SZ8); w.y = pk4_fp8(o1[0] * SZ8, o1[1] * SZ8, o1[2] * SZ8, o1[3] * SZ8); ST8_ROWPAIR(z8, u.row0 + rloc, u.col0 + wc * 32 + 8 * (fq & 2), hold8, w, DM); }
            float s = ((o0[0] + o0[1]) + (o0[2] + o0[3])) + ((o1[0] + o1[1]) + (o1[2] + o1[3])), q = ((o0[0] * o0[0] + o0[1] * o0[1]) + (o0[2] * o0[2] + o0[3] * o0[3])) + ((o1[0] * o1[0] + o1[1] * o1[1]) + (o1[2] * o1[2] + o1[3] * o1[3]));
            s += __shfl_xor(s, 16); s += __shfl_xor(s, 32); q += __shfl_xor(q, 16); q += __shfl_xor(q, 32); ss[ai * 4 + m] = s; qq[ai * 4 + m] = q;
            asm volatile("" ::: "memory"); EPI_ROWS_END
        rowpair_publish(tab, st, 8, u.col0 >> 7, u.row0, ss, qq, wr, wc, fr, fq);
    } };

#ifndef ONLY_SITE
#define ONLY_SITE -1
#endif
#define SITE(s) (ONLY_SITE < 0 || ONLY_SITE == (s))
#define IN(k) (lo <= (k) && (k) < hi)
#define SEAM(k) do { if (IN(k) && IN((k) + 1)) xcd_barrier(bar); } while (0)
template <int l>
__device__ __forceinline__ void layer_shared(Frame& F, const Args& args, const XcdBarrier& bar, const int lo, const int hi) {
    unsigned char* ws = args.ws; bf16* const XB = (bf16*)(ws + WS_XB); bf16* const ZB = (bf16*)(ws + WS_ZB); const int cid = (int)blockIdx.x;
    constexpr int pb = 5 + 14 * l;
        gu32* cnt = F.ctl + CW_CNT + l * 32 * 64;
    const float* st1 = (const float*)(ws + WS_ST) + (size_t)l * MTOK * 16; const float* sc1 = (const float*)(ws + WS_SCC) + (size_t)l * 16384 * 8;
    if (IN(pb + 1) && SITE(6)) { PlainSched S; S.T.init(MTOK / 256, 4, F.G, cid); S.A = (const char*)(ws + WS_XFZ); S.B = (const char*)(ws + WS_KFT); S.tilesPerBatch = SEQ / 256; S.bBatch = (size_t)1024 * 1024; S.splitN = 0; S.aT = (size_t)256 * 1024; S.bT = (size_t)256 * 1024;
        EpiSoftmaxP E{(bf16*)(ws + WS_P), (LAS float*)(F.lds + SMX_OFF), 1.0f / (SZ8 * SK8), st1, sc1, l ? 8 : 4}; pg8::gemm_phase<EpiSoftmaxP, PlainSched, false, true>(F.lds, 1024, S, E); } SEAM(pb + 1);
    if (IN(pb + 3) && SITE(8)) { PlainSched S; S.T.init(MTOK / 256, 4, F.G, cid); S.A = (const char*)(ws + WS_P); S.B = (const char*)(ws + WS_VFT); S.tilesPerBatch = SEQ / 256; S.bBatch = (size_t)1024 * 1024; S.splitN = 0; S.aT = (size_t)256 * 1024; S.bT = (size_t)256 * 1024;
        EpiResidLN E{ZB, 1.0f / (SP8 * SV8), st1, (LAS float*)(F.lds + SMX_OFF), (l ? args.in[39] : args.in[14]), (l ? args.in[40] : args.in[15]), l ? 8 : 4}; pg8::gemm_phase<EpiResidLN, PlainSched, false, true>(F.lds, 1024, S, E); } SEAM(pb + 3);
    if (IN(pb + 4) && SITE(9)) { ph_ln2_router(F, ZB, XB, MOE_FP8 ? ws + WS_XF8 : nullptr, (l ? args.in[43] : args.in[18]), (l ? args.in[44] : args.in[19]), (const bf16*)(ws + WS_WR) + (size_t)l * 256 * 1024,
                                               (l ? args.in[46] : args.in[21]), cnt, (int*)(ws + WS_LIST), (float*)(ws + WS_GATE), (int*)(ws + WS_ASG), (float*)(ws + WS_ST2)); } SEAM(pb + 4);
    if (IN(pb + 7) && SITE(12)) { moe_tables(F, cnt);
#if MOE_FP8
        MoeSched S{(LAS const int*)(F.lds + TAB_OFF), 8, F.G, F.vcu, (const char*)(ws + WS_XF8), (const char*)(ws + WS_WUP8), (size_t)2048 * 1024, 128, (const int*)(ws + WS_LIST), true, (size_t)256 * 1024};
        EpiSwiglu8 E{(l ? args.in[48] : args.in[23]), ws + WS_ACT, args.variant == 9, (LAS float*)(F.lds + SMX_OFF)}; pg8::gemm_phase<EpiSwiglu8, MoeSched, true, true>(F.lds, 1024, S, E);
#else
        MoeSched S{(LAS const int*)(F.lds + TAB_OFF), 8, F.G, F.vcu, (const char*)XB, (const char*)(ws + WS_WUP), (size_t)2048 * 1024 * 2, 128, (const int*)(ws + WS_LIST), true, pg8::TSTEP};
        EpiSwiglu E{(l ? args.in[48] : args.in[23]), (bf16*)(ws + WS_ACT)}; pg8::gemm_phase<EpiSwiglu, MoeSched, true>(F.lds, 1024, S, E);
#endif
    } SEAM(pb + 7);
    if (IN(pb + 8) && SITE(13)) { moe_tables(F, cnt);
#if MOE_FP8
        MoeSched S{(LAS const int*)(F.lds + TAB_OFF), 4, F.G, F.vcu, (const char*)(ws + WS_ACT), (const char*)(ws + WS_WDN8), (size_t)1024 * 1024, 256, (const int*)(ws + WS_LIST), false, (size_t)256 * 1024};
        EpiDown8 E{(l ? args.in[50] : args.in[25]), (bf16*)(ws + WS_YS), (LAS float*)(F.lds + SMX_OFF)}; pg8::gemm_phase<EpiDown8, MoeSched, false, true>(F.lds, 1024, S, E);
#else
        MoeSched S{(LAS const int*)(F.lds + TAB_OFF), 4, F.G, F.vcu, (const char*)(ws + WS_ACT), (const char*)(ws + WS_WDN), (size_t)1024 * 1024 * 2, 256, (const int*)(ws + WS_LIST), false, pg8::TSTEP};
        EpiDown E{(l ? args.in[50] : args.in[25]), (const int*)(ws + WS_LIST), (const float*)(ws + WS_GATE), (bf16*)(ws + WS_YS), (LAS const int*)(F.lds + TAB_OFF)}; pg8::gemm_phase<EpiDown, MoeSched, false>(F.lds, 1024, S, E);
#endif
    } SEAM(pb + 8);
    if (IN(pb + 9) && SITE(14)) { moe_tables(F, cnt); ph_ln<1>(F, ZB, (const bf16*)(ws + WS_YS), XB, l ? args.out : nullptr, (l ? args.in[51] : args.in[26]), (l ? args.in[52] : args.in[27]), (l == 0) ? ws + WS_XF8 : nullptr, (const int*)(ws + WS_ASG), (const float*)(ws + WS_GATE),
                                                             (const float*)(ws + WS_ST2), (l ? args.in[43] : args.in[18]), (l ? args.in[44] : args.in[19]));
        if (l == 0) { __syncthreads(); cvt_experts(F, args.in[47], args.in[49], ws); } } SEAM(pb + 9);
}

constexpr int PH_TOTAL = 29;
__global__ void __launch_bounds__(NWAVES * 64, 2) mk_fwd(Args args) {
    extern __shared__ __attribute__((aligned(16))) unsigned char lds[];
    Frame F;
    F.lds = (LAS unsigned char*)lds; F.MISC = (volatile LAS unsigned*)(F.lds + MISC_OFF);
    F.wave = __builtin_amdgcn_readfirstlane((int)threadIdx.x >> 6);
    F.G = gridDim.x; { const int bx = blockIdx.x; F.vcu = (F.G % 8 == 0) ? (bx % 8) * (F.G / 8) + bx / 8 : bx; }
    unsigned char* ws = args.ws;
    F.ctl = (gu32*)(ws + WS_CTL);
    for (int u = FTID; u < (LDS_BYTES - LDSCTL_OFF) / 4; u += NWAVES * 64) ((LAS unsigned*)(F.lds + LDSCTL_OFF))[u] = 0u;
    __syncthreads();
    const int lo = args.ph_lo, hi = args.ph_hi;
    XcdBarrier bar; bar.bar = (unsigned*)(F.ctl + CW_BAR); bar.x = 0; bar.st = nullptr;
    if (hi - lo > 1) bar = xcd_barrier_post((unsigned*)(F.ctl + CW_BAR), F.MISC + 8);
    bf16* const XB = (bf16*)(ws + WS_XB); bf16* const ZB = (bf16*)(ws + WS_ZB);
    const int cid = (int)blockIdx.x;

    if (IN(0) && SITE(0)) { p0_prologue(F, args); } SEAM(0);
    if (IN(1) && SITE(1)) {
        { PlainSched S; S.T.init(MTOK / 256, HW0 / 256, F.G, cid); S.A = (const char*)XB; S.B = (const char*)(ws + WS_WIN0); S.tilesPerBatch = 1 << 20; S.bBatch = 0; S.splitN = 0;
          EpiH0 E{(bf16*)(ws + WS_UV), (bf16*)(ws + WS_QX), (bf16*)(ws + WS_QX) + 512, (bf16*)(ws + WS_VX), 1.0f}; pg8::gemm_phase<EpiH0, PlainSched>(F.lds, 1024, S, E); }
        { PlainSched S; S.T.init(NB * MEMLEN / 256, 2048 / 256, F.G, cid); S.A = (const char*)(ws + WS_MEMB); S.B = (const char*)(ws + WS_WKV); S.tilesPerBatch = 1 << 20; S.bBatch = 0; S.splitN = 4;
          EpiStore E{(bf16*)(ws + WS_KB), (bf16*)(ws + WS_VB), 1.f, 1.f, 1024}; pg8::gemm_phase<EpiStore, PlainSched>(F.lds, 1024, S, E); }
    } SEAM(1);
    if (IN(2) && SITE(2)) {
        attn_body::bf16* oat = (attn_body::bf16*)(ws + WS_OATT);
        { const attn_body::AttnTensors AT{(const attn_body::bf16*)(ws + WS_QX), (const attn_body::bf16*)(ws + WS_QX) + 512, (const attn_body::bf16*)(ws + WS_VX), oat};
          const attn_body::StaticOrder S((int)F.G, (int)blockIdx.x); attn_body::attn_phase<attn_body::StaticOrder>((char*)lds, AT, S); }
        VM_WAIT(); __syncthreads();
        if (F.G == 256) combine_local(F, (const bf16*)(ws + WS_OATT), (bf16*)(ws + WS_MIX), args.in[8], args.in[9], args.in[10], args.in[11], args.in[12], F.vcu >> 4, (F.vcu >> 2) & 3, F.vcu & 3);
        __syncthreads();
        ph_sgu(F, (const bf16*)(ws + WS_UV), (bf16*)(ws + WS_MIX), args.in[4], args.in[5], args.in[6], args.in[7]);
    } SEAM(2);
    if (IN(4) && SITE(4)) {
        { PlainSched S; S.T.init(MTOK / 256, 4, F.G, cid); S.A = (const char*)(ws + WS_MIX); S.B = (const char*)(ws + WS_WOUT0); S.tilesPerBatch = 1 << 20; S.bBatch = 0; S.splitN = 0;
          EpiResidStats E{XB, ZB, ws + WS_XFZ, (float*)(ws + WS_ST), (LAS float*)(F.lds + SMX_OFF)}; pg8::gemm_phase<EpiResidStats, PlainSched>(F.lds, 1024, S, E); }
        { FoldSched S{F.G, F.vcu, 0, (const char*)(ws + WS_KB), (const char*)(ws + WS_VB), (const char*)(ws + WS_XQB), (const char*)(ws + WS_XOT)};
          EpiFold E{ws + WS_KFT, ws + WS_VFT, args.in[14], args.in[15], (float*)(ws + WS_SCC), (LAS float*)(F.lds + SMX_OFF)}; int kf = 256; asm volatile("" : "+s"(kf)); pg8::gemm_phase<EpiFold, FoldSched>(F.lds, kf, S, E); }
    } SEAM(4);

    layer_shared<0>(F, args, bar, lo, hi);
    if (IN(15) && SITE(15)) { { PlainSched S; S.T.init(MTOK / 256, 4, F.G, cid); S.A = (const char*)(ws + WS_XF8); S.B = (const char*)(ws + WS_WIN1); S.tilesPerBatch = 1 << 20; S.bBatch = 0; S.splitN = 0; S.aT = (size_t)256 * 1024; S.bT = (size_t)256 * 1024;
        EpiUG E{(bf16*)(ws + WS_UG), 1.0f / (SX8 * SWU8)}; pg8::gemm_phase<EpiUG, PlainSched, false, true>(F.lds, 1024, S, E); }
        { FoldSched S{F.G, F.vcu, 0, (const char*)(ws + WS_KB), (const char*)(ws + WS_VB), (const char*)(ws + WS_XQB) + 1024 * 1024 * 2, (const char*)(ws + WS_XOT) + 1024 * 1024 * 2};
      EpiFold E{ws + WS_KFT, ws + WS_VFT, args.in[39], args.in[40], (float*)(ws + WS_SCC) + (size_t)16384 * 8, (LAS float*)(F.lds + SMX_OFF)}; int kf = 256; asm volatile("" : "+s"(kf)); pg8::gemm_phase<EpiFold, FoldSched>(F.lds, kf, S, E); }
    } SEAM(15);
    if (IN(16) && SITE(16)) { ph_s5(F, (const bf16*)(ws + WS_UG), (bf16*)(ws + WS_YB), args.in[29], args.in[30], args.in[31], args.in[32], args.in[33], args.in[34], args.in[35], args.in[36], args.variant); } SEAM(16);
    if (IN(17) && SITE(17)) { PlainSched S; S.T.init(MTOK / 256, 8, F.G, cid); S.A = (const char*)(ws + WS_YB); S.B = (const char*)(ws + WS_WVG); S.tilesPerBatch = 1 << 20; S.bBatch = 0; S.splitN = 0; S.aT = (size_t)256 * 16; S.bT = (size_t)256 * 1024;
        struct VGS { PlainSched P; __device__ __forceinline__ bool next(int i, pg8::Unit& u) const { if (!P.next(i, u)) return false; u.col0 >>= 1; return true; } } S2{S};
        EpiValGate E{XB, ZB, 1.0f / (SA8 * SWD8), 1.0f / (SA8 * SWU8), ws + WS_XFZ, (float*)(ws + WS_ST) + (size_t)MTOK * 16, (LAS float*)(F.lds + SMX_OFF)}; pg8::gemm_phase<EpiValGate, VGS, false, true, 1>(F.lds, 1024, S2, E); } SEAM(17);
    layer_shared<1>(F, args, bar, lo, hi);
#undef IN
#undef SEAM
}

extern "C" void kernel_launch(void* const* d_in, const int* in_sizes, int n_in, void* d_out, int out_size, void* d_ws, size_t ws_size, hipStream_t stream) {
    static int grid = 0;
    if (grid == 0) {
        if (n_in != 53 || in_sizes[0] != MTOK * DM || out_size != MTOK * DM || ws_size < WS_END) { fprintf(stderr, "kernel_launch: unexpected problem (n_in %d, in0 %d, out %d, ws %zu < %zu); nothing launched\n", n_in, n_in > 0 ? in_sizes[0] : -1, out_size, ws_size, (size_t)WS_END); grid = -1; return; }
        int dev = 0, cus = 0, per_cu = 0;
        if (hipGetDevice(&dev) != hipSuccess || hipDeviceGetAttribute(&cus, hipDeviceAttributeMultiprocessorCount, dev) != hipSuccess) { grid = -1; return; }
        if (hipFuncSetAttribute((const void*)mk_fwd, hipFuncAttributeMaxDynamicSharedMemorySize, LDS_BYTES) != hipSuccess) { fprintf(stderr, "kernel_launch: hipFuncSetAttribute failed\n"); grid = -1; return; }
        if (hipOccupancyMaxActiveBlocksPerMultiprocessor(&per_cu, (const void*)mk_fwd, NWAVES * 64, LDS_BYTES) != hipSuccess || per_cu < 1) fprintf(stderr, "kernel_launch: note: occupancy query reports %d\n", per_cu);
        (void)hipGetLastError();
        grid = cus;
    }
    if (grid < 0) return;
    if (hipMemsetAsync((char*)d_ws + WS_CTL, 0, CTL_ZERO_BYTES, stream) != hipSuccess) return;
    Args a{};
    for (int i = 0; i < 53; ++i) a.in[i] = (const float*)d_in[i];
    a.out = (float*)d_out; a.ws = (unsigned char*)d_ws;
#if MK_N_LAUNCHES == 1
    a.ph_lo = 0; a.ph_hi = PH_TOTAL;
    hipLaunchKernelGGL(mk_fwd, dim3(grid), dim3(NWAVES * 64), LDS_BYTES, stream, a);
#else
    for (int p = 0; p < PH_TOTAL; ++p) { if (p == 18 || p == 5 || p == 19) continue; a.ph_lo = p; a.ph_hi = p + 1;
        for (int rep = 0; rep < 1 + (int)(((PROBE_REPEAT_MASK) >> p) & 1ull); ++rep) { a.variant = (rep == 0 && (((PROBE_REPEAT_MASK) >> p) & 1ull)) ? PROBE_VARIANT : 0; hipLaunchKernelGGL(mk_fwd, dim3(grid), dim3(NWAVES * 64), LDS_BYTES, stream, a); } }
#endif
}
```

```cpp
#include <hip/hip_runtime.h>
#include <hip/hip_bf16.h>
#include <cstdio>
#include <cstdint>

#ifndef MK_N_LAUNCHES
#define MK_N_LAUNCHES 1
#endif

#ifndef MOE_FP8
#define MOE_FP8 1
#endif
#ifndef H0_FP8
#define H0_FP8 2
#endif
#ifndef CVT0_IN_ATTN
#define CVT0_IN_ATTN 1
#endif
#ifndef CVT1_IN_UP
#define CVT1_IN_UP 1
#endif
#ifndef FOLD1_IN_LN3
#define FOLD1_IN_LN3 1
#endif
#ifndef KV_IN_P0
#define KV_IN_P0 1
#endif
#ifndef CVT1_IN_ATTN
#define CVT1_IN_ATTN 1
#endif
#ifndef PROBE_VARIANT
#define PROBE_VARIANT 0
#endif
#ifndef PROBE_REPEAT_MASK
#define PROBE_REPEAT_MASK 0ull
#endif
#define GAS __attribute__((address_space(1)))
#define LAS __attribute__((address_space(3)))
typedef unsigned short bf16;
typedef unsigned v4u __attribute__((ext_vector_type(4)));
typedef unsigned v2u __attribute__((ext_vector_type(2)));
typedef float f32x4 __attribute__((ext_vector_type(4)));
typedef float f32x2 __attribute__((ext_vector_type(2)));
typedef short bf16x8 __attribute__((ext_vector_type(8)));
typedef int v4i_t __attribute__((ext_vector_type(4)));
typedef GAS unsigned gu32;
#define RLX_AGENT __ATOMIC_RELAXED, __HIP_MEMORY_SCOPE_AGENT
#define LDS_WAIT() asm volatile("s_waitcnt lgkmcnt(0)" ::: "memory")
#define VM_WAIT() asm volatile("s_waitcnt vmcnt(0)" ::: "memory")

constexpr int NB = 16, SEQ = 2048, DM = 1024, MTOK = NB * SEQ;
constexpr int MEMLEN = 256, NEXP = 32, TOPK = 4, NASSIGN = MTOK * TOPK;
constexpr int HW0 = 2560;
constexpr int CAP = MTOK;
constexpr int MAXBLK = NASSIGN / 256 + NEXP;
constexpr float LN_EPS = 1e-5f;
constexpr float ALPHA = 1.41421356237f;
constexpr float LOG2E = 1.4426950408889634f;
constexpr float C2 = 0.125f * LOG2E;
constexpr float CSC = 0.0625f * LOG2E;
constexpr float LAM_INIT0 = 0.2f;

constexpr size_t MiB = 1u << 20;
constexpr size_t WS_CTL = 0, CTL_ZERO_BYTES = 96 * 1024;
constexpr size_t WS_LIST = 1 * MiB;
constexpr size_t WS_GATE = WS_LIST + 4 * MiB;
constexpr size_t WS_ASG = WS_GATE + 512 * 1024;
constexpr size_t WS_LOGIT = WS_GATE + 1 * MiB;
constexpr size_t WS_WKV = WS_LOGIT + 4 * MiB;
constexpr size_t WS_WIN0 = WS_WKV + 4 * MiB;
constexpr size_t WS_WOUT0 = WS_WIN0 + 5 * MiB;
constexpr size_t WS_XQB = WS_WOUT0 + 2 * MiB;
constexpr size_t WS_XOT = WS_XQB + 4 * MiB;
constexpr size_t WS_WIN1 = WS_XOT + 4 * MiB;
constexpr size_t WS_WVG = WS_WIN1 + 2 * MiB;
constexpr size_t WS_WR = WS_WVG + 4 * MiB;
constexpr size_t WS_MEMB = WS_WR + 1 * MiB;
constexpr size_t WS_KB = WS_MEMB + 8 * MiB;
constexpr size_t WS_VB = WS_KB + 8 * MiB;
constexpr size_t WS_KFT = WS_VB + 8 * MiB;
constexpr size_t WS_VFT = WS_KFT + 32 * MiB;
constexpr size_t WS_WUP = WS_VFT + 32 * MiB;
constexpr size_t WS_WDN = WS_WUP + 128 * MiB;
constexpr size_t WS_XB = WS_WDN + 64 * MiB;
constexpr size_t WS_ZB = WS_XB + 64 * MiB;
constexpr size_t WS_BIG1 = WS_ZB + 64 * MiB;
constexpr size_t WS_BIG2 = WS_BIG1 + 272 * MiB;
constexpr size_t WS_END = WS_BIG2 + 272 * MiB;
static_assert(WS_END <= 1024 * MiB, "workspace map exceeds 1 GiB");
constexpr size_t WS_UV = WS_BIG1;
constexpr size_t WS_QX = WS_BIG1 + 64 * MiB;
constexpr size_t WS_KX = WS_BIG1 + 128 * MiB;
constexpr size_t WS_VX = WS_BIG1 + 192 * MiB;
constexpr size_t WS_SC = WS_BIG1;
constexpr size_t WS_WUP8 = WS_WUP;
constexpr size_t WS_WDN8 = WS_WUP + 64 * MiB;
constexpr size_t WS_XF8 = WS_WUP + 96 * MiB;
constexpr float SX8 = 4.0f, SWU8 = 64.0f, SA8 = 4.0f, SWD8 = 128.0f, SP8 = 256.0f, SV8 = 8.0f, SK8 = 32.0f, SY8 = 32.0f;
constexpr size_t WS_XFZ = WS_WDN;
constexpr size_t WS_SCC = WS_WDN + 32 * MiB;
constexpr size_t WS_ST2 = WS_WDN + 40 * MiB;
constexpr size_t WS_WIN0F8 = WS_WDN + 48 * MiB;
constexpr size_t WS_ST = WS_LOGIT;
constexpr float SZ8 = 8.0f;
constexpr size_t WS_WUP8_1 = WS_BIG2 + 160 * MiB;
constexpr size_t WS_WDN8_1 = WS_BIG2 + 224 * MiB;
constexpr size_t WS_ACT = WS_BIG1;
constexpr size_t WS_OATT = WS_BIG2;
constexpr size_t WS_MIX = WS_BIG2 + 64 * MiB;
constexpr size_t WS_P = WS_BIG2 + 128 * MiB;
constexpr size_t WS_UG = WS_BIG2;
constexpr size_t WS_YB = WS_BIG2 + 64 * MiB;
constexpr size_t WS_XG = WS_BIG2;
constexpr size_t WS_YS = WS_BIG2;

constexpr int CW_TMO = 0;
constexpr int CW_BAR = 4096;
constexpr int CW_CNT = 16384;
static_assert((CW_CNT + 64 * 64) * 4 <= (int)CTL_ZERO_BYTES && (CW_BAR + 3456) * 4 <= (int)CTL_ZERO_BYTES, "control words inside the per-call memset");

constexpr int RING_BYTES = 131072;
constexpr int SCR_BYTES = 135168;
constexpr int LDSCTL_OFF = SCR_BYTES, MISC_OFF = LDSCTL_OFF + 320;
constexpr int TAB_OFF = MISC_OFF + 128;
constexpr int SMX_OFF = TAB_OFF + 576;
constexpr int LDS_BYTES = 147456;
static_assert(SMX_OFF % 16 == 0 && SMX_OFF + 8192 <= LDS_BYTES, "LDS map");

__device__ __forceinline__ unsigned f2bf(float f) { unsigned u = __builtin_bit_cast(unsigned, f); return (u + 0x7fffu + ((u >> 16) & 1u)) >> 16; }
typedef float pk2_f32x2 __attribute__((ext_vector_type(2))); typedef __bf16 pk2_bf16x2 __attribute__((ext_vector_type(2)));
__device__ __forceinline__ unsigned pk2(float lo, float hi) { const pk2_f32x2 v = {lo, hi}; return __builtin_bit_cast(unsigned, __builtin_convertvector(v, pk2_bf16x2)); }
__device__ __forceinline__ float bflo(unsigned w) { return __builtin_bit_cast(float, w << 16); }
__device__ __forceinline__ float bfhi(unsigned w) { return __builtin_bit_cast(float, w & 0xffff0000u); }
__device__ __forceinline__ float bf2f(bf16 b) { return __builtin_bit_cast(float, ((unsigned)b) << 16); }
__device__ __forceinline__ float wave_sum(float v) {
#pragma unroll
    for (int o = 1; o < 64; o <<= 1) v += __shfl_xor(v, o);
    return v;
}
__device__ __forceinline__ float wave_max(float v) {
#pragma unroll
    for (int o = 1; o < 64; o <<= 1) v = fmaxf(v, __shfl_xor(v, o));
    return v;
}
__device__ __forceinline__ float gelu_tanh(float x) {
    const float t = x * (0.7978845608f * 2.0f * LOG2E) * (1.0f + 0.044715f * x * x);
    return x * __builtin_amdgcn_rcpf(1.0f + __builtin_amdgcn_exp2f(-t));
}
__device__ __forceinline__ f32x2 gelu_tanh2(f32x2 x, float osc) {
    constexpr float K1 = 0.7978845608f * 2.0f * LOG2E, K2 = K1 * 0.044715f; const float io = 1.0f / osc;
    const f32x2 t = x * (x * x * K2 + K1); f32x2 e; e.x = __builtin_amdgcn_exp2f(-t.x); e.y = __builtin_amdgcn_exp2f(-t.y);
    const f32x2 d = e * io + io; f32x2 rc; rc.x = __builtin_amdgcn_rcpf(d.x); rc.y = __builtin_amdgcn_rcpf(d.y); return x * rc; }
__device__ __forceinline__ float sigmoidf_(float x) { return __builtin_amdgcn_rcpf(1.0f + __builtin_amdgcn_exp2f(-x * LOG2E)); }

namespace pg8 {
constexpr int BM = 256, BK = 64, HALF = 128, HTB = HALF * BK * 2, STAGE_BYTES = 8 * HTB, NXCD = 8, WGM = 8;
constexpr int LD = 1024;
constexpr size_t HSTEP = (size_t)HALF * LD * 2, TSTEP = 2 * HSTEP;
__host__ __device__ __forceinline__ int lds_byte(int r, int c) { const int st = (r >> 4) * 2 + (c >> 5), rr = r & 15, cc = c & 31, ob = rr * 64 + cc * 2; return st * 1024 + (ob ^ (((ob >> 9) & 1) << 5)); }
__host__ __device__ __forceinline__ void stage_rc(int b, int& R, int& C) { const int st = b / 1024, sb = b % 1024, swz = sb ^ (((sb >> 9) & 1) << 5); R = (st >> 1) * 16 + swz / 64; C = (st & 1) * 32 + (swz % 64) / 2; }
__host__ __device__ __forceinline__ int perm32(int rho) { const int n = rho >> 4, i = rho & 15; return 8 * (i >> 2) + 4 * n + (i & 3); }

struct Unit { const char* a; const char* b; int row0, col0, z, aux, par; };
template <class E, class = void> struct epi_has_pre { static constexpr bool value = false; };
template <class E> struct epi_has_pre<E, decltype((void)E::HAS_PRE)> { static constexpr bool value = true; };

struct TileOrder {
    int nM, nN, nwg, G, c;
    __device__ void init(int nM_, int nN_, int G_, int c_) { nM = nM_; nN = nN_; nwg = nM * nN; G = G_; c = c_; }
    __device__ bool get(int i, int& pm, int& pn) const {
        const long L = (long)i * G + c; if (L >= nwg) return false;
        int wgid = (int)L; { const int q = nwg / NXCD, r = nwg % NXCD, xcd = wgid % NXCD, off = wgid / NXCD; wgid = (xcd < r ? xcd * (q + 1) : r * (q + 1) + (xcd - r) * q) + off; }
        const int nig = WGM * nN, gid = wgid / nig, fm = gid * WGM, gsz = (nM - fm) < WGM ? (nM - fm) : WGM;
        pm = fm + ((wgid % nig) % gsz); pn = (wgid % nig) / gsz; return true;
    }
};

__device__ __forceinline__ unsigned cvt_pk_bf16(float lo, float hi) { unsigned r; asm volatile("v_cvt_pk_bf16_f32 %0, %1, %2" : "=v"(r) : "v"(lo), "v"(hi)); return r; }

template <class Epi, class Sched, bool GATHER = false, bool FP8 = false, int ALAY = 0>
__device__ __forceinline__ void gemm_phase(LAS unsigned char* lds, const int K, const Sched& S, const Epi& E) {
    int tid = threadIdx.x; asm volatile("" : "+v"(tid));
    const int wid = __builtin_amdgcn_readfirstlane(tid >> 6), lane = tid & 63, wr = wid >> 2, wc = wid & 3, fr = lane & 15, fq = lane >> 4;
    constexpr unsigned ROWB = FP8 ? 1024u : 2048u;
    const int nt = FP8 ? K / 128 : K / BK;
    unsigned voffA[2], voffB[2]; int RA[2], CA[2];
#pragma unroll
    for (int i = 0; i < 2; ++i) { int R, C; stage_rc(tid * 16 + i * 8192, R, C); const int Rb = (R & ~31) + perm32(R & 31);
        voffA[i] = ALAY ? (unsigned)(C >> 3) * (unsigned)(MTOK * 16) + (unsigned)R * 16u : (unsigned)R * ROWB + (unsigned)C * 2u; voffB[i] = (unsigned)Rb * ROWB + (unsigned)C * 2u; RA[i] = R; CA[i] = C; }
    const size_t kstep = (size_t)(BK * 2);
    const size_t kstepA = ALAY ? (size_t)8 * MTOK * 16 : kstep;
    const size_t hstepB = (size_t)HALF * ROWB;
    const size_t hstepA = GATHER ? 0 : (ALAY ? (size_t)HALF * 16 : (size_t)HALF * ROWB);
    const unsigned ldsw = (unsigned)wid * 1024u;
    const int aoff0 = lds_byte(wr * 64 + fr, fq * 8);
    const int boff0 = lds_byte(wc * 32 + fr, fq * 8);
    unsigned aB = (unsigned)(uintptr_t)lds + (unsigned)aoff0, bB = (unsigned)(uintptr_t)lds + 4u * HTB + (unsigned)boff0; asm volatile("" : "+v"(aB), "+v"(bB));
    constexpr int KOFF = 1024;
#define PG8_SA(b, h) (((b) * 2 + (h)) * HTB)
#define PG8_SB(b, h) ((4 + (b) * 2 + (h)) * HTB)
#define PG8_STAGE(bufoff, gbase, voff) do { _Pragma("unroll") for (int _i = 0; _i < 2; ++_i) \
        __builtin_amdgcn_global_load_lds((const unsigned*)((const char*)(gbase) + (voff)[_i]), (LAS unsigned*)(lds + (bufoff) + ldsw + _i * 8192), 16, 0, 0); } while (0)
#define PG8_LD32(base, off0) __builtin_shufflevector(*(const LAS v4i_t*)((base) + (unsigned)(off0)), *(const LAS v4i_t*)((base) + (unsigned)((off0) + KOFF)), 0, 1, 2, 3, 4, 5, 6, 7)
#define PG8_LDA(dst, b, h) do { if constexpr (FP8) { _Pragma("unroll") for (int m = 0; m < 4; ++m) dst##8[m] = PG8_LD32(aB, PG8_SA(b, h) + m * 2048); } else { _Pragma("unroll") for (int m = 0; m < 4; ++m) _Pragma("unroll") for (int k = 0; k < 2; ++k) dst[m][k] = *(const LAS bf16x8*)(aB + (unsigned)(PG8_SA(b, h) + m * 2048 + k * KOFF)); } } while (0)
#define PG8_LDB(dst, b, h) do { if constexpr (FP8) { _Pragma("unroll") for (int n = 0; n < 2; ++n) dst##8[n] = PG8_LD32(bB, PG8_SA(b, h) + n * 2048); } else { _Pragma("unroll") for (int n = 0; n < 2; ++n) _Pragma("unroll") for (int k = 0; k < 2; ++k) dst[n][k] = *(const LAS bf16x8*)(bB + (unsigned)(PG8_SA(b, h) + n * 2048 + k * KOFF)); } } while (0)
#define PG8_MMA(ai, bj, At, Bt) do { __builtin_amdgcn_s_setprio(1); _Pragma("unroll") for (int m = 0; m < 4; ++m) _Pragma("unroll") for (int n = 0; n < 2; ++n) { \
        if constexpr (FP8) asm volatile("v_mfma_scale_f32_16x16x128_f8f6f4 %0, %1, %2, %0, %3, %3 op_sel_hi:[0,0,0]" : "+v"(acc[ai][bj][m][n]) : "v"(Bt##8[n]), "v"(At##8[m]), "v"(sc8)); \
        else { _Pragma("unroll") for (int k = 0; k < 2; ++k) acc[ai][bj][m][n] = __builtin_amdgcn_mfma_f32_16x16x32_bf16(Bt[n][k], At[m][k], acc[ai][bj][m][n], 0, 0, 0); } } __builtin_amdgcn_s_setprio(0); } while (0)
#define PG8_WAIT_V(n) asm volatile("s_waitcnt vmcnt(" #n ")" ::: "memory")
#define PG8_WAIT_L(n) asm volatile("s_waitcnt lgkmcnt(" #n ")" ::: "memory")
#define PG8_BAR __builtin_amdgcn_s_barrier()
#define PG8_SCHED __builtin_amdgcn_sched_barrier(0)
    Unit cur, nxt; int ui = 0;
    if (!S.next(0, cur)) return;
    f32x4 acc[2][2][4][2];
#pragma unroll
    for (int a = 0; a < 2; ++a)
#pragma unroll
        for (int b = 0; b < 2; ++b)
#pragma unroll
            for (int m = 0; m < 4; ++m)
#pragma unroll
                for (int n = 0; n < 2; ++n) acc[a][b][m][n] = (f32x4){0.f, 0.f, 0.f, 0.f};
    typedef int v8i_t __attribute__((ext_vector_type(8)));
    bf16x8 At[4][2], B0[2][2], B1[2][2]; v8i_t At8[4], B08[2], B18[2];
    int sc8 = 0x7f7f7f7f; asm volatile("" : "+v"(sc8));
    const char* cA = cur.a; const char* cB = cur.b;
    unsigned vA0[2], vA1[2], nA0[2], nA1[2];
    if constexpr (GATHER) { const int* rw = S.rows(cur);
#pragma unroll
        for (int i = 0; i < 2; ++i) { vA0[i] = (unsigned)Sched::rowmap(rw[RA[i]]) * ROWB + (unsigned)CA[i] * 2u; vA1[i] = (unsigned)Sched::rowmap(rw[128 + RA[i]]) * ROWB + (unsigned)CA[i] * 2u; nA0[i] = vA0[i]; nA1[i] = vA1[i]; } }
    else {
#pragma unroll
        for (int i = 0; i < 2; ++i) { vA0[i] = voffA[i]; vA1[i] = voffA[i]; nA0[i] = voffA[i]; nA1[i] = voffA[i]; } }
    cur.par = 0; if constexpr (epi_has_pre<Epi>::value) E.pre(cur, wid, lane);
    PG8_STAGE(PG8_SB(0, 0), cB, voffB); PG8_STAGE(PG8_SB(0, 1), cB + hstepB, voffB); PG8_STAGE(PG8_SA(0, 0), cA, vA0); PG8_STAGE(PG8_SA(0, 1), cA + hstepA, vA1);
    if (wr == 1) PG8_BAR;
    PG8_WAIT_V(2); PG8_BAR;
    PG8_STAGE(PG8_SB(1, 0), cB + kstep, voffB); PG8_STAGE(PG8_SA(1, 0), cA + kstepA, vA0); PG8_STAGE(PG8_SB(1, 1), cB + hstepB + kstep, voffB);
    PG8_WAIT_V(6); PG8_BAR;
    for (;;) {
        const bool has_next = S.next(ui + 1, nxt);
        const char* nA = has_next ? nxt.a : cA; const char* nB = has_next ? nxt.b : cB;
        int ri[4] = {0, 0, 0, 0};
        if constexpr (GATHER) { if (has_next) { const int* rw = S.rows(nxt);
#pragma unroll
            for (int i = 0; i < 4; ++i) { const int* pp = rw + (i >> 1) * 128 + RA[i & 1]; asm volatile("global_load_dword %0, %1, off" : "=v"(ri[i]) : "v"(pp) : "memory"); } } }
#pragma nounroll
        for (int t = 0; t < nt; t += 2) {
            const bool last = (t == nt - 2);
            if constexpr (GATHER) { if (last && has_next) { asm volatile("s_waitcnt vmcnt(8) ; ROWIDX" : "+v"(ri[0]), "+v"(ri[1]), "+v"(ri[2]), "+v"(ri[3]) :: "memory");
#pragma unroll
                for (int i = 0; i < 2; ++i) { nA0[i] = (unsigned)Sched::rowmap(ri[i]) * ROWB + (unsigned)CA[i] * 2u; nA1[i] = (unsigned)Sched::rowmap(ri[2 + i]) * ROWB + (unsigned)CA[i] * 2u; } } }
            const char* a1 = cA + (size_t)(t + 1) * kstepA;
            const char* a2 = last ? nA : cA + (size_t)(t + 2) * kstepA; const char* b2 = last ? nB : cB + (size_t)(t + 2) * kstep;
            const char* a3 = a2 + kstepA; const char* b3 = b2 + kstep;
            unsigned w0[2], w1[2];
#pragma unroll
            for (int i = 0; i < 2; ++i) { w0[i] = last ? nA0[i] : vA0[i]; w1[i] = last ? nA1[i] : vA1[i]; }
            PG8_LDB(B0, 0, 0); PG8_LDB(B1, 0, 1); PG8_SCHED; PG8_LDA(At, 0, 0); PG8_STAGE(PG8_SA(1, 1), a1 + hstepA, vA1);
            PG8_WAIT_V(8); PG8_WAIT_L(0); PG8_BAR; PG8_MMA(0, 0, At, B0); PG8_MMA(0, 1, At, B1); PG8_BAR; PG8_SCHED;
            PG8_LDA(At, 0, 1); PG8_STAGE(PG8_SB(0, 0), b2, voffB); PG8_STAGE(PG8_SB(0, 1), b2 + hstepB, voffB); PG8_STAGE(PG8_SA(0, 0), a2, w0);
            PG8_WAIT_V(8); PG8_WAIT_L(0); PG8_BAR; PG8_MMA(1, 0, At, B0); PG8_MMA(1, 1, At, B1); PG8_BAR; PG8_SCHED;
            PG8_LDB(B0, 1, 0); PG8_LDB(B1, 1, 1); PG8_SCHED; PG8_LDA(At, 1, 0); PG8_STAGE(PG8_SA(0, 1), a2 + hstepA, w1);
            PG8_WAIT_V(8); PG8_WAIT_L(0); PG8_BAR; PG8_MMA(0, 0, At, B0); PG8_MMA(0, 1, At, B1); PG8_BAR; PG8_SCHED;
            PG8_LDA(At, 1, 1); PG8_STAGE(PG8_SB(1, 0), b3, voffB); PG8_STAGE(PG8_SB(1, 1), b3 + hstepB, voffB); PG8_STAGE(PG8_SA(1, 0), a3, w0);
            PG8_WAIT_V(8); PG8_WAIT_L(0); PG8_BAR; PG8_MMA(1, 0, At, B0); PG8_MMA(1, 1, At, B1); PG8_BAR; PG8_SCHED;
        }
        if constexpr (epi_has_pre<Epi>::value) { if (has_next) { nxt.par = (ui + 1) & 1; E.pre(nxt, wid, lane); } }
        if (wr == 0) PG8_BAR;
        if constexpr (FP8) asm volatile("s_nop 15\n\ts_nop 15" ::: "memory");
        E(acc, cur, wr, wc, fr, fq);
        if (!has_next) break;
#pragma unroll
        for (int a = 0; a < 2; ++a)
#pragma unroll
            for (int b = 0; b < 2; ++b)
#pragma unroll
                for (int m = 0; m < 4; ++m)
#pragma unroll
                    for (int n = 0; n < 2; ++n) acc[a][b][m][n] = (f32x4){0.f, 0.f, 0.f, 0.f};
        cur = nxt; cA = nA; cB = nB; ++ui;
#pragma unroll
        for (int i = 0; i < 2; ++i) { vA0[i] = nA0[i]; vA1[i] = nA1[i]; }
        if (wr == 1) PG8_BAR;
    }
    PG8_WAIT_V(0);
    PG8_BAR;
#undef PG8_SA
#undef PG8_SB
#undef PG8_STAGE
#undef PG8_LDA
#undef PG8_LDB
#undef PG8_MMA
#undef PG8_LD32
#undef PG8_WAIT_V
#undef PG8_WAIT_L
#undef PG8_BAR
#undef PG8_SCHED
}
}
namespace attn_body {
using bf16=__hip_bfloat16;
using bf16x8=__attribute__((ext_vector_type(8)))short;
using s16x4=__attribute__((ext_vector_type(4)))short;
using f32x16=__attribute__((ext_vector_type(16)))float;
using u32x4=__attribute__((ext_vector_type(4)))unsigned;
constexpr int BATCH=16,NHEAD=16,SEQ=2048,D=64,DM=NHEAD*D;
constexpr int NW=8,QBLK=32,QB=QBLK*NW,KVBLK=64,NQB=SEQ/QB;
constexpr int ATTN_PITCH=DM, ATTN_UNIT_ROWS=QB;
__device__ __forceinline__ int crow(int r,int hi){return (r&3)+8*(r>>2)+4*hi;}
#define SBAR() __builtin_amdgcn_sched_barrier(0)
__device__ __forceinline__ void cmask(f32x16&p0,f32x16&p1,int jb,int qrel,int hi){
  const float NEG=-INFINITY; int kb=64*jb+4*hi;
  #pragma unroll
  for(int r=0;r<16;++r){int kv=kb+(r&3)+8*(r>>2); if(kv>qrel)p0[r]=NEG; if(kv+32>qrel)p1[r]=NEG;}
}

constexpr int NSLOT=3, SLOTB=8192;
constexpr int LDS_K=0, LDS_V=NSLOT*SLOTB, LDS_WS=2*NSLOT*SLOTB, LDS_OST=LDS_WS+NW*64*4, LDS_BYTES=LDS_OST+NW*4096;
constexpr float C2=0.125f*1.4426950408889634f;
__device__ __forceinline__ void glds16(const void*gsrc,unsigned lds_dst){unsigned keep;
  asm volatile("s_mov_b32 %0, m0\n\ts_mov_b32 m0, %2\n\ts_nop 0\n\tglobal_load_lds_dwordx4 %1, off\n\ts_mov_b32 m0, %0":"=&s"(keep):"v"(gsrc),"s"(lds_dst):"memory");}
__device__ __forceinline__ float max3f(float a,float b,float c){float r;asm("v_max3_f32 %0, %1, %2, %3":"=v"(r):"v"(a),"v"(b),"v"(c));return r;}
__device__ __forceinline__ float max2f(float a,float b){float r;asm("v_max_f32_e32 %0, %1, %2":"=v"(r):"v"(a),"v"(b));return r;}
__device__ __forceinline__ float fadd_s(float a,float b){float r;asm("v_add_f32_e32 %0, %1, %2":"=v"(r):"v"(a),"v"(b));return r;}
__device__ __forceinline__ float fsub_s(float a,float b){float r;asm("v_sub_f32_e32 %0, %1, %2":"=v"(r):"v"(a),"v"(b));return r;}
typedef float f32x2_t __attribute__((ext_vector_type(2))); typedef __bf16 bf16x2_t __attribute__((ext_vector_type(2)));
__device__ __forceinline__ unsigned cvtpk_s(float lo,float hi){f32x2_t v={lo,hi};bf16x2_t b=__builtin_convertvector(v,bf16x2_t);return __builtin_bit_cast(unsigned,b);}
#define WAIT_BAR(N) asm volatile("s_waitcnt vmcnt(" #N ") lgkmcnt(0)\n\ts_barrier":::"memory")

__device__ __forceinline__ void qkt(f32x16&p0,f32x16&p1,const char*Kslot,const bf16x8*qr,const f32x16&negm,int r32,int hi){
  const char*kb=Kslot+hi*1024+r32*16;
  #pragma unroll
  for(int d0=0;d0<4;++d0){
    const bf16x8 b0=*reinterpret_cast<const bf16x8*>(kb+d0*2048);
    const bf16x8 b1=*reinterpret_cast<const bf16x8*>(kb+d0*2048+512);
    if(d0==0){p0=__builtin_amdgcn_mfma_f32_32x32x16_bf16(b0,qr[0],negm,0,0,0);p1=__builtin_amdgcn_mfma_f32_32x32x16_bf16(b1,qr[0],negm,0,0,0);}
    else{p0=__builtin_amdgcn_mfma_f32_32x32x16_bf16(b0,qr[d0],p0,0,0,0);p1=__builtin_amdgcn_mfma_f32_32x32x16_bf16(b1,qr[d0],p1,0,0,0);}}
}
typedef __attribute__((address_space(3))) const char* lds_cptr;
typedef short v4i16_t __attribute__((ext_vector_type(4)));
__device__ __forceinline__ void kload8(bf16x8*kf,lds_cptr kp){
  kf[0]=*(const __attribute__((address_space(3))) bf16x8*)(kp);      kf[1]=*(const __attribute__((address_space(3))) bf16x8*)(kp+512);
  kf[2]=*(const __attribute__((address_space(3))) bf16x8*)(kp+2048); kf[3]=*(const __attribute__((address_space(3))) bf16x8*)(kp+2560);
  kf[4]=*(const __attribute__((address_space(3))) bf16x8*)(kp+4096); kf[5]=*(const __attribute__((address_space(3))) bf16x8*)(kp+4608);
  kf[6]=*(const __attribute__((address_space(3))) bf16x8*)(kp+6144); kf[7]=*(const __attribute__((address_space(3))) bf16x8*)(kp+6656);
}
__device__ __forceinline__ void kload2(bf16x8*kf,lds_cptr kp,int j){ kf[2*j]=*(const __attribute__((address_space(3))) bf16x8*)(kp+j*2048); kf[2*j+1]=*(const __attribute__((address_space(3))) bf16x8*)(kp+j*2048+512); }
__device__ __forceinline__ s16x4 vtr(lds_cptr p){ return __builtin_bit_cast(s16x4,__builtin_amdgcn_ds_read_tr16_b64_v4i16((__attribute__((address_space(3))) v4i16_t*)p)); }
__device__ __forceinline__ float rowmax(const f32x16&p0,const f32x16&p1){
  float a=max3f(p0[0],p0[1],p1[0]),b=max3f(p0[2],p0[3],p1[1]);a=max3f(a,p1[2],p1[3]);
  #pragma unroll
  for(int r=4;r<16;r+=4){a=max3f(a,p0[r],p0[r+1]);b=max3f(b,p0[r+2],p0[r+3]);a=max3f(a,p1[r],p1[r+1]);b=max3f(b,p1[r+2],p1[r+3]);}
  const float m=max2f(a,b);
  auto rr=__builtin_amdgcn_permlane32_swap(__float_as_uint(m),__float_as_uint(m),false,false);
  return max2f(__uint_as_float(rr[0]),__uint_as_float(rr[1]));
}
__device__ __forceinline__ void pv(f32x16*o,int vb,bf16x8 pa0,bf16x8 pa1,bf16x8 pa2,bf16x8 pa3){
  #pragma unroll
  for(int d0=0;d0<2;++d0){s16x4 lo[4],hi[4];
    #pragma unroll
    for(int ks=0;ks<4;++ks){
      asm volatile("ds_read_b64_tr_b16 %0,%1 offset:%c2":"=&v"(lo[ks]):"v"(vb),"i"(d0*4096+ks*1024):"memory");
      asm volatile("ds_read_b64_tr_b16 %0,%1 offset:%c2":"=&v"(hi[ks]):"v"(vb),"i"(d0*4096+ks*1024+512):"memory");}
    asm volatile("s_waitcnt lgkmcnt(0)":::"memory");SBAR();
    #define PK(k) (bf16x8){lo[k][0],lo[k][1],lo[k][2],lo[k][3],hi[k][0],hi[k][1],hi[k][2],hi[k][3]}
    o[d0]=__builtin_amdgcn_mfma_f32_32x32x16_bf16(pa0,PK(0),o[d0],0,0,0);
    o[d0]=__builtin_amdgcn_mfma_f32_32x32x16_bf16(pa1,PK(1),o[d0],0,0,0);
    o[d0]=__builtin_amdgcn_mfma_f32_32x32x16_bf16(pa2,PK(2),o[d0],0,0,0);
    o[d0]=__builtin_amdgcn_mfma_f32_32x32x16_bf16(pa3,PK(3),o[d0],0,0,0);
    #undef PK
  }
}

#ifndef ATTN_STORE16
#define ATTN_STORE16(p,v) (*(u32x4*)(p)=(v))
#endif
template<int THRL> __device__ __forceinline__ void attn_unit(int b,int h,int qb,const bf16*Q,const bf16*__restrict__ K,const bf16*__restrict__ V,bf16*O,char*shm){
  const int tid=threadIdx.x,lane=tid&63,r32=lane&31,hi=lane>>5; const int wid=__builtin_amdgcn_readfirstlane(tid>>6);
  const long rowbase=(long)b*SEQ; const int q0=qb*QB;
  const bf16*Qw=Q+(rowbase+q0+wid*QBLK)*DM+h*D;
  const bf16*Kh=K+rowbase*DM+h*D,*Vh=V+rowbase*DM+h*D;
  const unsigned lds0=(unsigned)(uintptr_t)shm;
  float*wsf=(float*)(shm+LDS_WS)+wid*64;
  const bf16*ksrc=Kh+(long)lane*DM+wid*8;
  const bf16*vsrc=Vh+(long)(16*(wid&3)+(lane>>2))*DM+(wid>>2)*32+(lane&3)*8;
  const unsigned kdst=lds0+LDS_K+wid*1024, vdst=lds0+LDS_V+wid*1024;
  #define DMA_K(t,slot) glds16(ksrc+(long)(t)*KVBLK*DM,(unsigned)__builtin_amdgcn_readfirstlane(kdst+(slot)))
  #define DMA_V(t,slot) glds16(vsrc+(long)(t)*KVBLK*DM,(unsigned)__builtin_amdgcn_readfirstlane(vdst+(slot)))
  const int vb0=(int)(lds0+LDS_V)+((lane>>4)&1)*32+(lane&3)*8+(4*hi+((lane&15)>>2))*64;
  const char*Kbase=shm+LDS_K; bf16x8 kf[8];
  const lds_cptr shm3=(lds_cptr)shm; const lds_cptr kp0=shm3+LDS_K+hi*1024+r32*16; const lds_cptr vp0=shm3+LDS_V+((lane>>4)&1)*32+(lane&3)*8+(4*hi+((lane&15)>>2))*64;
  const int NT=(q0+QB)/KVBLK;
  DMA_K(0,0);DMA_V(0,0);DMA_K(1,SLOTB);
  bf16x8 qr[4];
  #pragma unroll
  for(int d0=0;d0<4;++d0)qr[d0]=*reinterpret_cast<const bf16x8*>(&Qw[(long)r32*DM+d0*16+hi*8]);
  float mhat=0.f,l_reg=0.f;f32x16 o[2];o[0]=f32x16{};o[1]=f32x16{};f32x16 negm=f32x16{};asm volatile("":"+v"(negm));
  const int qrel=wid*QBLK+r32;
  #define CMASK(P0,P1,t) do{int jb_=(t)-(NT-4); if(jb_>=0)cmask(P0,P1,jb_,qrel,hi);}while(0)
  bool resc=false;
  #define START(P0,P1) do{ const float rm=rowmax(P0,P1); resc=false; \
    { const float dl=rm; mhat=fadd_s(mhat,dl); \
      _Pragma("unroll") for(int r=0;r<16;++r){P0[r]=fsub_s(P0[r],dl);P1[r]=fsub_s(P1[r],dl);} \
      _Pragma("unroll") for(int r=0;r<16;++r)negm[r]=-mhat; asm volatile("":"+v"(negm)); } \
    _Pragma("unroll") for(int r=0;r<16;++r)P0[r]=__builtin_amdgcn_exp2f(P0[r]); }while(0)
  #define RESC() do{ if(resc){ asm volatile("s_waitcnt lgkmcnt(0)":::"memory"); \
      _Pragma("unroll") for(int d_=0;d_<2;++d_) _Pragma("unroll") for(int r=0;r<16;++r)o[d_][r]*=wsf[crow(r,hi)]; } }while(0)
  f32x16 pA0,pA1,pB0,pB1;
  int sl_prev=0,sl_cur=0,sl_next=SLOTB;
  #define ROT() do{sl_prev=sl_cur;sl_cur=sl_next;sl_next=(sl_next==(NSLOT-1)*SLOTB)?0:sl_next+SLOTB;}while(0)
  DMA_K(2,2*SLOTB);
  WAIT_BAR(3);
  qkt(pA0,pA1,Kbase,qr,negm,r32,hi);asm volatile("s_nop 15\n\ts_nop 7":"+v"(pA0),"+v"(pA1));CMASK(pA0,pA1,0);
  START(pA0,pA1);
  _Pragma("unroll") for(int r=0;r<16;++r)pA1[r]=__builtin_amdgcn_exp2f(pA1[r]);
  WAIT_BAR(0);
  DMA_K(3,0);DMA_V(1,SLOTB);
  ROT();
  kload8(kf,kp0+sl_cur);
  WAIT_BAR(2);
  s16x4 vlo[8],vhi[8]; u32x4 pw0,pw1,pw2,pw3;
  #define PKW(P,B) cvtpk_s(P[B],P[B+1])
  #define PAF(k) __builtin_bit_cast(bf16x8,pw##k)
  #define VFR(i) (bf16x8){vlo[i][0],vlo[i][1],vlo[i][2],vlo[i][3],vhi[i][0],vhi[i][1],vhi[i][2],vhi[i][3]}
  #define PIN(x) asm volatile("":"+v"(x))
  #define MX3(a,b,c) __builtin_fmaxf(__builtin_fmaxf((a),(b)),(c))
  #define GAPA(MF,A0,A1,A2,A3,W0,W1,PW) do{ MF; sacc+=A0; sacc+=A1; sacc+=A2; sacc+=A3; PIN(sacc); W0; W1; PIN(PW); SBAR(); }while(0)
  #define EX(v) __builtin_amdgcn_exp2f(v)
  #define GAPB(MF,X,B) do{ MF; X[B]=EX(X[B]); X[B+1]=EX(X[B+1]); X[B+2]=EX(X[B+2]); X[B+3]=EX(X[B+3]); PIN(X); SBAR(); }while(0)
  #define VRD(i) do{ vlo[i]=vtr(vp_+(((i)>>2)*4096+((i)&3)*1024)); vhi[i]=vtr(vp_+(((i)>>2)*4096+((i)&3)*1024+512)); }while(0)
  #define KRD(G,j) do{ if(G){ kload2(kf,kp0+sl_next,j); SBAR(); } }while(0)
  #define STEP(C0,C1,P0,P1,t,GK,GV,GL) do{ SBAR(); \
    const lds_cptr vp_=vp0+sl_prev; \
    VRD(0); SBAR(); float sacc=(P0[0]+P0[1]); \
    GAPA(C0=__builtin_amdgcn_mfma_f32_32x32x16_bf16(kf[0],qr[0],negm,0,0,0), P0[2],P0[3],P0[4],P0[5],     pw0[0]=PKW(P0,0), pw0[1]=PKW(P0,2), pw0); \
    VRD(4); SBAR(); GAPA(C1=__builtin_amdgcn_mfma_f32_32x32x16_bf16(kf[1],qr[0],negm,0,0,0), P0[6],P0[7],P0[8],P0[9],     pw0[2]=PKW(P0,4), pw0[3]=PKW(P0,6), pw0); \
    VRD(1); SBAR(); GAPA(C0=__builtin_amdgcn_mfma_f32_32x32x16_bf16(kf[2],qr[1],C0,0,0,0),   P0[10],P0[11],P0[12],P0[13], pw1[0]=PKW(P0,8), pw1[1]=PKW(P0,10), pw1); \
    VRD(5); SBAR(); GAPA(C1=__builtin_amdgcn_mfma_f32_32x32x16_bf16(kf[3],qr[1],C1,0,0,0),   P0[14],P0[15],P1[0],P1[1],   pw1[2]=PKW(P0,12),pw1[3]=PKW(P0,14), pw1); \
    VRD(2); SBAR(); GAPA(C0=__builtin_amdgcn_mfma_f32_32x32x16_bf16(kf[4],qr[2],C0,0,0,0),   P1[2],P1[3],P1[4],P1[5],     pw2[0]=PKW(P1,0), pw2[1]=PKW(P1,2), pw2); \
    VRD(6); SBAR(); GAPA(C1=__builtin_amdgcn_mfma_f32_32x32x16_bf16(kf[5],qr[2],C1,0,0,0),   P1[6],P1[7],P1[8],P1[9],     pw2[2]=PKW(P1,4), pw2[3]=PKW(P1,6), pw2); \
    VRD(3); SBAR(); GAPA(C0=__builtin_amdgcn_mfma_f32_32x32x16_bf16(kf[6],qr[3],C0,0,0,0),   P1[10],P1[11],P1[12],P1[13], pw3[0]=PKW(P1,8), pw3[1]=PKW(P1,10), pw3); \
    VRD(7); SBAR(); GAPA(C1=__builtin_amdgcn_mfma_f32_32x32x16_bf16(kf[7],qr[3],C1,0,0,0),   P1[14],P1[15],0.f,0.f,       pw3[2]=PKW(P1,12),pw3[3]=PKW(P1,14), pw3); \
    l_reg+=sacc; \
    if(GK){DMA_K((t)+3,sl_cur);} if(GV){DMA_V((t)+1,sl_next);} \
    CMASK(C0,C1,t); \
    { float a=MX3(C0[0],C0[1],C1[0]),b=MX3(C0[2],C0[3],C1[1]); a=MX3(a,C1[2],C1[3]); \
      _Pragma("unroll") for(int r=4;r<16;r+=4){a=MX3(a,C0[r],C0[r+1]);b=MX3(b,C0[r+2],C0[r+3]);a=MX3(a,C1[r],C1[r+1]);b=MX3(b,C1[r+2],C1[r+3]);} \
      float rm=__builtin_fmaxf(a,b); { auto rr=__builtin_amdgcn_permlane32_swap(__float_as_uint(rm),__float_as_uint(rm),false,false); rm=__builtin_fmaxf(__uint_as_float(rr[0]),__uint_as_float(rr[1])); } \
      resc=false; \
      if(__builtin_expect(__any(rm>(float)THRL),0)){ const float dl=__builtin_fmaxf(rm,0.f); mhat+=dl; \
        _Pragma("unroll") for(int r=0;r<16;++r){C0[r]-=dl;C1[r]-=dl;} \
        _Pragma("unroll") for(int r=0;r<16;++r)negm[r]=-mhat; asm volatile("":"+v"(negm)); \
        const float f=__builtin_amdgcn_exp2f(-dl); l_reg*=f; if(hi==0)wsf[r32]=f; resc=true; } } \
    SBAR(); \
    GAPB(o[0]=__builtin_amdgcn_mfma_f32_32x32x16_bf16(PAF(0),VFR(0),o[0],0,0,0), C0,0); \
    GAPB(o[1]=__builtin_amdgcn_mfma_f32_32x32x16_bf16(PAF(0),VFR(4),o[1],0,0,0), C0,4); \
    KRD(GL,0); GAPB(o[0]=__builtin_amdgcn_mfma_f32_32x32x16_bf16(PAF(1),VFR(1),o[0],0,0,0), C0,8); \
    KRD(GL,1); GAPB(o[1]=__builtin_amdgcn_mfma_f32_32x32x16_bf16(PAF(1),VFR(5),o[1],0,0,0), C0,12); \
    KRD(GL,2); GAPB(o[0]=__builtin_amdgcn_mfma_f32_32x32x16_bf16(PAF(2),VFR(2),o[0],0,0,0), C1,0); \
    KRD(GL,3); GAPB(o[1]=__builtin_amdgcn_mfma_f32_32x32x16_bf16(PAF(2),VFR(6),o[1],0,0,0), C1,4); \
    GAPB(o[0]=__builtin_amdgcn_mfma_f32_32x32x16_bf16(PAF(3),VFR(3),o[0],0,0,0), C1,8); \
    GAPB(o[1]=__builtin_amdgcn_mfma_f32_32x32x16_bf16(PAF(3),VFR(7),o[1],0,0,0), C1,12); \
    }while(0)
  int t=1;
  #undef CMASK
  #define CMASK(P0,P1,t) do{}while(0)
  for(;t+5<NT;t+=2){
    STEP(pB0,pB1,pA0,pA1,t,true,true,true);     WAIT_BAR(2); RESC(); ROT();
    STEP(pA0,pA1,pB0,pB1,t+1,true,true,true);   WAIT_BAR(2); RESC(); ROT();
  }
  #undef CMASK
  #define CMASK(P0,P1,t) do{int jb_=(t)-(NT-4); if(jb_>=0)cmask(P0,P1,jb_,qrel,hi);}while(0)
  #define ENDW(tt) do{ if((tt)+3<NT){WAIT_BAR(2);} else if((tt)+2<NT){WAIT_BAR(1);} else {WAIT_BAR(0);} }while(0)
  for(;t+1<NT;t+=2){
    STEP(pB0,pB1,pA0,pA1,t,(t+3<NT),(t+1<NT),(t+1<NT));       ENDW(t);   RESC(); ROT();
    STEP(pA0,pA1,pB0,pB1,t+1,(t+4<NT),(t+2<NT),(t+2<NT));     ENDW(t+1); RESC(); ROT();
  }
  STEP(pB0,pB1,pA0,pA1,NT-1,false,false,false); RESC();
  { float sacc=pB0[0]+pB0[1]; _Pragma("unroll") for(int r=2;r<16;++r)sacc+=pB0[r]; _Pragma("unroll") for(int r=0;r<16;++r)sacc+=pB1[r]; l_reg+=sacc;
    pw0=(u32x4){PKW(pB0,0),PKW(pB0,2),PKW(pB0,4),PKW(pB0,6)};pw1=(u32x4){PKW(pB0,8),PKW(pB0,10),PKW(pB0,12),PKW(pB0,14)};pw2=(u32x4){PKW(pB1,0),PKW(pB1,2),PKW(pB1,4),PKW(pB1,6)};pw3=(u32x4){PKW(pB1,8),PKW(pB1,10),PKW(pB1,12),PKW(pB1,14)};
    SBAR(); pv(o,vb0+sl_cur,PAF(0),PAF(1),PAF(2),PAF(3)); }
  #undef PKW
  #undef PAF
  #undef VFR
  #undef PIN
  #undef MX3
  #undef GAPA
  #undef GAPB
  #undef EX
  #undef VRD
  #undef KRD
  #undef STEP
  #undef ENDW
  {auto rr=__builtin_amdgcn_permlane32_swap(__float_as_uint(l_reg),__float_as_uint(l_reg),false,false);l_reg=__uint_as_float(rr[0])+__uint_as_float(rr[1]);}
  if(hi==0)wsf[32+r32]=l_reg;asm volatile("s_waitcnt lgkmcnt(0)":::"memory");
  float rli[16];
  #pragma unroll
  for(int r=0;r<16;++r)rli[r]=__builtin_amdgcn_rcpf(wsf[32+crow(r,hi)]);
  bf16*Ow=O+(rowbase+q0+wid*QBLK)*DM+h*D;
  { bf16*stg=(bf16*)(shm+LDS_OST)+wid*2048;
    #pragma unroll
    for(int r=0;r<16;++r){const int orow=crow(r,hi);
      #pragma unroll
      for(int d0=0;d0<2;++d0)stg[orow*64+d0*32+r32]=__float2bfloat16(o[d0][r]*rli[r]);}
    asm volatile("s_waitcnt lgkmcnt(0)":::"memory");
    #pragma unroll
    for(int i=0;i<4;++i){const int row=i*8+(lane>>3),ch=lane&7; const u32x4 v=*(const u32x4*)(stg+row*64+ch*8); ATTN_STORE16(Ow+(long)row*DM+ch*8,v);} }
  asm volatile("s_waitcnt lgkmcnt(0)\n\ts_barrier":::"memory");
  #undef DMA_K
  #undef DMA_V
  #undef CMASK
  #undef START
  #undef RESC
  #undef ROT
}
constexpr int ATTN_LDS_BYTES=LDS_BYTES;
struct AttnTensors { const bf16* Q; const bf16* K; const bf16* V; bf16* O; };
struct AttnUnit { int bh; int qb; };
struct StaticOrder {
  int vcu;
  __device__ __forceinline__ explicit StaticOrder(int grid,int block):vcu((block%8)*(grid/8)+block/8){}
  __device__ __forceinline__ bool next(int i,AttnUnit&u)const{ if(i>=8)return false; const int pr=vcu&3; u.bh=(vcu>>2)*4+(i&3); u.qb=(i==0)?pr:(i==1)?pr:(i==2)?pr:(i==3)?pr:(i==4)?7-pr:(i==5)?7-pr:(i==6)?7-pr:7-pr; return true; }
  __device__ __forceinline__ void a_ready(const AttnUnit&)const{}
  __device__ __forceinline__ void done(const AttnUnit&)const{}
};
template<class Sched,int THRL=8> __device__ __forceinline__ void attn_phase(char*lds,const AttnTensors&T,const Sched&S){
  AttnUnit u;
  for(int i=0;S.next(i,u);++i){ S.a_ready(u); const int vhd=u.bh%NHEAD, hq=vhd>>1, hv=(vhd>>2)*2+(vhd&1);
    attn_unit<THRL>(u.bh/NHEAD,hq,u.qb,T.Q,T.K,T.V+(hv-hq)*D,T.O+(vhd-hq)*D,lds); S.done(u); }
}
#undef SBAR
#undef WAIT_BAR
}
namespace a128 {
enum { ORDER_NATURAL = 0, ORDER_REVERSED = 1, ORDER_PAIRED = 2, ORDER_XCD = 4 };
using TIN = __hip_bfloat16; using TOUT = __hip_bfloat16;
constexpr int B = 16, H = 8, HKV = 8, SQ = 2048, SKV = 2048, D = 128;
constexpr int QOFF = 0; constexpr int WINDOW = SKV; constexpr float THR = 8.f; constexpr int ORDER = ORDER_PAIRED; constexpr int GRID_WGS = 0; constexpr bool WSKIP = false;
constexpr int DQK = 64;
constexpr float SCALE = 0.125f;
constexpr int NW = 8, QBLK = 32, KVBLK = 64, QB = NW * QBLK;
constexpr int SHM_V = KVBLK * D * 2, SHM_K = KVBLK * D * 2;
constexpr int LDS_BYTES = 2 * SHM_V + 2 * SHM_K + NW * 64 * 4;
static_assert(D == 128 && SQ % QB == 0 && SKV % KVBLK == 0 && H % HKV == 0 && QOFF >= 0 && QOFF + SQ <= SKV && WINDOW >= 1, "geometry");

using bf16 = __hip_bfloat16;
typedef short bf16x8 __attribute__((ext_vector_type(8)));
typedef short s16x4 __attribute__((ext_vector_type(4)));
typedef float f32x16 __attribute__((ext_vector_type(16)));
typedef float f32x4 __attribute__((ext_vector_type(4)));
typedef unsigned u32x4 __attribute__((ext_vector_type(4)));
template <class A, class Bt> struct same_t { static constexpr bool v = false; };
template <class A> struct same_t<A, A> { static constexpr bool v = true; };

#define KSWZ(row, colB) ((row) * 256 + ((colB) ^ (((row) & 7) << 4)))
#define SBAR() __builtin_amdgcn_sched_barrier(0)
__device__ __forceinline__ int v_st(int k, int c) { const int kk = (k & ~0xC) | ((k & 4) << 1) | ((k & 8) >> 1); return ((kk >> 3) * 4 + (c >> 5)) * 512 + ((kk & 7) * 32 + (c & 31)) * 2; }
__device__ __forceinline__ int v_rd_base(int lane) { return ((lane & 3) << 3) | (((lane >> 2) & 3) << 6) | (((lane >> 4) & 1) << 5) | (((lane >> 5) & 1) << 8); }
constexpr int v_rd_off(int d0, int ks, int half) { return d0 * 512 + ks * 4096 + half * 2048; }
__device__ __forceinline__ int crow(int r, int hi) { return (r & 3) + 8 * (r >> 2) + 4 * hi; }
__device__ __forceinline__ unsigned cvtpk(float lo, float hi) {
    unsigned r; asm volatile("v_cvt_pk_bf16_f32 %0, %1, %2" : "=v"(r) : "v"(lo), "v"(hi)); return r;
}
__device__ __forceinline__ bf16x8 pack8(f32x4 a, f32x4 b) {
    u32x4 w = {cvtpk(a[0], a[1]), cvtpk(a[2], a[3]), cvtpk(b[0], b[1]), cvtpk(b[2], b[3])};
    return *reinterpret_cast<bf16x8*>(&w);
}
template <class T> __device__ __forceinline__ bf16x8 load8(const T* p) {
    if constexpr (same_t<T, float>::v) { return pack8(*(const f32x4*)p, *(const f32x4*)(p + 4)); }
    else { return *reinterpret_cast<const bf16x8*>(p); }
}
__device__ __forceinline__ void mask_tile(f32x16& p0, f32x16& p1, int dq, unsigned W) {
    const float NEG = -__builtin_inff();
#pragma unroll
    for (int r = 0; r < 16; ++r) {
        const int c = (r & 3) + 8 * (r >> 2);
        if ((unsigned)(dq - c) >= W) p0[r] = NEG;
        if ((unsigned)(dq - c - 32) >= W) p1[r] = NEG;
    }
}
__device__ __forceinline__ void partialSM(f32x16& p0, f32x16& p1, float& m_reg, float& mn, float& alpha) {
    float pmax = p0[0]; for (int r = 1; r < 16; ++r) pmax = fmaxf(pmax, p0[r]); for (int r = 0; r < 16; ++r) pmax = fmaxf(pmax, p1[r]);
    { auto rr = __builtin_amdgcn_permlane32_swap(__float_as_uint(pmax), __float_as_uint(pmax), false, false);
      pmax = fmaxf(__uint_as_float(rr[0]), __uint_as_float(rr[1])); }
    constexpr float C2 = 1.4426950408889634f * SCALE;
    if (__builtin_expect(__all((pmax - m_reg) * SCALE <= THR), 1)) { mn = m_reg; alpha = 1.f; }
    else { mn = fmaxf(m_reg, pmax); alpha = __builtin_amdgcn_exp2f((m_reg - mn) * C2); m_reg = mn; }
    const float mnL = -mn * C2;
    for (int r = 0; r < 16; ++r) p0[r] = fmaf(p0[r], C2, mnL); for (int r = 0; r < 16; ++r) p1[r] = fmaf(p1[r], C2, mnL);
    for (int r = 0; r < 16; ++r) p0[r] = __builtin_amdgcn_exp2f(p0[r]);
}
__device__ __forceinline__ void finishSM(f32x16& p0, f32x16& p1, float alpha, float& l_reg, bf16x8& pa0, bf16x8& pa1, bf16x8& pa2, bf16x8& pa3) {
    for (int r = 0; r < 16; ++r) p1[r] = __builtin_amdgcn_exp2f(p1[r]);
    float ps = 0; for (int r = 0; r < 16; ++r) ps += p0[r]; for (int r = 0; r < 16; ++r) ps += p1[r];
    { auto rr = __builtin_amdgcn_permlane32_swap(__float_as_uint(ps), __float_as_uint(ps), false, false);
      ps = __uint_as_float(rr[0]) + __uint_as_float(rr[1]); }
    l_reg = l_reg * alpha + ps;
#define PK4(P, B_, OUT) do { unsigned a0 = cvtpk(P[B_+0], P[B_+1]), a1 = cvtpk(P[B_+2], P[B_+3]);                          \
        unsigned b0 = cvtpk(P[B_+4], P[B_+5]), b1 = cvtpk(P[B_+6], P[B_+7]);                                             \
        auto r0 = __builtin_amdgcn_permlane32_swap(a0, b0, false, false); auto r1 = __builtin_amdgcn_permlane32_swap(a1, b1, false, false); \
        u32x4 w = {r0[0], r1[0], r0[1], r1[1]}; OUT = *reinterpret_cast<bf16x8*>(&w); } while (0)
    PK4(p0, 0, pa0); PK4(p0, 8, pa1); PK4(p1, 0, pa2); PK4(p1, 8, pa3);
#undef PK4
}
template <int KB, bool SK>
__device__ __forceinline__ void qkt(f32x16& p0, f32x16& p1, const char* K_lds, int r32, int hi, const bf16x8* qr, bool act) {
    if (SK && !act) { const float NEG = -__builtin_inff();
#pragma unroll
        for (int r = 0; r < 16; ++r) { p0[r] = NEG; p1[r] = NEG; } return; }
    p0 = f32x16{}; p1 = f32x16{};
    const char* kb[4];
#pragma unroll
    for (int dd = 0; dd < 4; ++dd) kb[dd] = K_lds + KB * SHM_K + KSWZ(r32, (dd * 16 + hi * 8) * 2);
#pragma unroll
    for (int d0 = 0; d0 < DQK / 16; ++d0) { const char* a = kb[d0 & 3] + (d0 >> 2) * 128;
        bf16x8 b0 = *reinterpret_cast<const bf16x8*>(a);
        bf16x8 b1 = *reinterpret_cast<const bf16x8*>(a + 32 * 256);
        p0 = __builtin_amdgcn_mfma_f32_32x32x16_bf16(b0, qr[d0], p0, 0, 0, 0);
        p1 = __builtin_amdgcn_mfma_f32_32x32x16_bf16(b1, qr[d0], p1, 0, 0, 0); }
}
template <int VB, bool SK>
__device__ __forceinline__ void pv_tile(f32x16* o, int vb0, bf16x8 pa0, bf16x8 pa1, bf16x8 pa2, bf16x8 pa3, bool act) {
    if (SK && !act) return;
#define TRRD(dst, off) asm volatile("ds_read_b64_tr_b16 %0, %1 offset:%2" : "=&v"(dst) : "v"(vb0), "i"(off) : "memory")
#define PV_D0(d0) do { s16x4 l0, l1, l2, l3, h0, h1, h2, h3; constexpr int b_ = VB * SHM_V + v_rd_off(d0, 0, 0);     \
        TRRD(l0, b_); TRRD(h0, b_ + 2048); TRRD(l1, b_ + 4096); TRRD(h1, b_ + 6144); TRRD(l2, b_ + 8192); TRRD(h2, b_ + 10240); TRRD(l3, b_ + 12288); TRRD(h3, b_ + 14336); \
        asm volatile("s_waitcnt lgkmcnt(0)" ::: "memory"); SBAR();                 \
        o[d0] = __builtin_amdgcn_mfma_f32_32x32x16_bf16(pa0, (bf16x8){l0[0], l0[1], l0[2], l0[3], h0[0], h0[1], h0[2], h0[3]}, o[d0], 0, 0, 0);   \
        o[d0] = __builtin_amdgcn_mfma_f32_32x32x16_bf16(pa1, (bf16x8){l1[0], l1[1], l1[2], l1[3], h1[0], h1[1], h1[2], h1[3]}, o[d0], 0, 0, 0);   \
        o[d0] = __builtin_amdgcn_mfma_f32_32x32x16_bf16(pa2, (bf16x8){l2[0], l2[1], l2[2], l2[3], h2[0], h2[1], h2[2], h2[3]}, o[d0], 0, 0, 0);   \
        o[d0] = __builtin_amdgcn_mfma_f32_32x32x16_bf16(pa3, (bf16x8){l3[0], l3[1], l3[2], l3[3], h3[0], h3[1], h3[2], h3[3]}, o[d0], 0, 0, 0); } while (0)
    PV_D0(0); PV_D0(1); PV_D0(2); PV_D0(3);
#undef PV_D0
#undef TRRD
}

template <class TIn, class TOut> struct BlockRef { const TIn* Q; const TIn* K; const TIn* V; TOut* O; int P0; };
template <class TIn> struct Seam {
    bf16x8 qr[8];
    bf16x8 st_v0, st_v1, st_k0, st_k1; f32x4 sf0, sf1, sf2, sf3;
    f32x4 tq[16];
};
__device__ __forceinline__ int swa_jlo(int P0, int W) { const int lowk = P0 - W + 1; return lowk > 0 ? lowk / KVBLK : 0; }
#define ROW(p, k0, rr) ((p) + (size_t)((k0) + (rr)) * D + sc)
#define ROWK(p, k0, rr) ((p) + (size_t)((k0) + (rr)) * DQK + sc)
#define VMW() asm volatile("s_waitcnt vmcnt(0)" ::: "memory")
#define VMWN(n) asm volatile("s_waitcnt vmcnt(%0)" :: "i"(n) : "memory")
#define SLOAD_H(Kp, Vp, k0) do { S.st_v0 = load8<TIn>(ROW(Vp, k0, sr)); S.st_v1 = load8<TIn>(ROW(Vp, k0, 32 + sr));              \
                         S.st_k0 = load8<TIn>(ROWK(Kp, k0, sr)); S.st_k1 = load8<TIn>(ROWK(Kp, k0, 32 + sr)); } while (0)
#define SWRITE_HK(bf) do { *(bf16x8*)(K_lds + (bf) * SHM_K + kws) = S.st_k0; *(bf16x8*)(K_lds + (bf) * SHM_K + kws + 32 * 256) = S.st_k1; } while (0)
#define SWRITE_HV(bf) do { *(bf16x8*)(V_lds + (bf) * SHM_V + vst0) = S.st_v0; *(bf16x8*)(V_lds + (bf) * SHM_V + vst1) = S.st_v1; } while (0)
#define SWRITE_H(bf) do { SWRITE_HV(bf); SWRITE_HK(bf); } while (0)
#define SLOAD_F(p, k0) do { S.sf0 = *(const f32x4*)ROW(p, k0, sr); S.sf1 = *(const f32x4*)(ROW(p, k0, sr) + 4);                \
                            S.sf2 = *(const f32x4*)ROW(p, k0, 32 + sr); S.sf3 = *(const f32x4*)(ROW(p, k0, 32 + sr) + 4); } while (0)
#define SWRITE_KF(bf) do { *(bf16x8*)(K_lds + (bf) * SHM_K + kws) = pack8(S.sf0, S.sf1); *(bf16x8*)(K_lds + (bf) * SHM_K + kws + 32 * 256) = pack8(S.sf2, S.sf3); } while (0)
#define SWRITE_VF(bf) do { *(bf16x8*)(V_lds + (bf) * SHM_V + vst0) = pack8(S.sf0, S.sf1); *(bf16x8*)(V_lds + (bf) * SHM_V + vst1) = pack8(S.sf2, S.sf3); } while (0)
template <class TIn, class TOut>
__device__ __forceinline__ void causal_swa_prime(const BlockRef<TIn, TOut>& cur, int W, char* lds, Seam<TIn>& S) {
    constexpr bool F32 = same_t<TIn, float>::v;
    const int tid = threadIdx.x, wid = __builtin_amdgcn_readfirstlane(tid >> 6), lane = tid & 63, r32 = lane & 31, hi = lane >> 5;
    const int sr = tid >> 4, sc = (tid & 15) * 8, kws = KSWZ(sr, sc * 2); char* K_lds = lds + 2 * SHM_V;
    const int kb0 = swa_jlo(cur.P0, W) * KVBLK;
    for (int d0 = 0; d0 < DQK / 16; ++d0) S.qr[d0] = load8<TIn>(cur.Q + (size_t)(wid * QBLK + r32) * DQK + d0 * 16 + hi * 8);
    if constexpr (F32) { SLOAD_F((const float*)cur.K, kb0); VMW(); SWRITE_KF(0); SBAR(); SLOAD_F((const float*)cur.V, kb0); }
    else { SLOAD_H(cur.K, cur.V, kb0); VMW(); SWRITE_HK(0); }
    __syncthreads();
}
template <class TIn, class TOut>
__device__ __forceinline__ void causal_swa_block(const BlockRef<TIn, TOut>& cur, const BlockRef<TIn, TOut>& nxt, int skv, int W, char* lds, Seam<TIn>& S) {
    constexpr bool F32 = same_t<TIn, float>::v;
    const int tid = threadIdx.x, wid = __builtin_amdgcn_readfirstlane(tid >> 6), lane = tid & 63, r32 = lane & 31, hi = lane >> 5;
    const int j_lo = swa_jlo(cur.P0, W);
    int j_hi = (cur.P0 + QB - 1) / KVBLK + 1; if (j_hi > skv / KVBLK) j_hi = skv / KVBLK;
    const int NT = j_hi - j_lo;
    const int kbn = swa_jlo(nxt.P0, W) * KVBLK;
    const int qlo = cur.P0 + wid * QBLK, qm = qlo + r32 - 4 * hi;
    char* V_lds = lds; char* K_lds = lds + 2 * SHM_V;
    float* ws = (float*)(lds + 2 * SHM_V + 2 * SHM_K) + wid * 64; float* li_l = ws, * al_l = ws + 32;
    float m_reg = -1e30f, l_reg = 0; f32x16 o[4] = {};
    const int sr = tid >> 4, sc = (tid & 15) * 8, vst0 = v_st(sr, sc), vst1 = v_st(32 + sr, sc), kws = KSWZ(sr, sc * 2);
    const int vb0 = (int)(uintptr_t)V_lds + v_rd_base(lane);
    const TIn* Kh = cur.K; const TIn* Vh = cur.V;
#define RESC(a) do { if (__any((a) < 1.f)) { if (hi == 0) al_l[r32] = (a); asm volatile("s_waitcnt lgkmcnt(0)" ::: "memory");              \
                     for (int d_ = 0; d_ < 4; ++d_) for (int r = 0; r < 16; ++r) o[d_][r] *= al_l[crow(r, hi)]; } } while (0)
#define KBASE(t) ((j_lo + (t)) * KVBLK)
#define ACT(t) (KBASE(t) <= qlo + QBLK - 1 && KBASE(t) + KVBLK - 1 >= qlo - W + 1)
#define MASKT(P0_, P1_, t) do { const int kb_ = KBASE(t); if ((!SK || ACT(t)) && (kb_ + KVBLK - 1 > qlo || kb_ <= qlo + QBLK - 1 - W)) mask_tile(P0_, P1_, qm - kb_, (unsigned)W); } while (0)
    constexpr int NQL = F32 ? 16 : DQK / 16;
    constexpr bool SK = WSKIP && !F32;
#define SEAM_K0() do { VMWN(NQL); if constexpr (F32) { SWRITE_KF(0); SBAR(); SLOAD_F((const float*)nxt.V, kbn); } else { SWRITE_HK(0); } SBAR(); } while (0)
    f32x16 pA0, pA1, pB0, pB1; float mnA, mnB, alA, alB; bf16x8 pa0, pa1, pa2, pa3;
    if constexpr (F32) { VMW(); SWRITE_VF(0); SBAR(); } else { SWRITE_HV(0); SBAR(); }
    if (NT > 1) { if constexpr (F32) SLOAD_F((const float*)Kh, KBASE(1)); else SLOAD_H(Kh, Vh, KBASE(1)); }
    SBAR(); qkt<0, SK>(pA0, pA1, K_lds, r32, hi, S.qr, ACT(0));
    if constexpr (F32) { if (NT > 1) { VMW(); SWRITE_KF(1); SBAR(); SLOAD_F((const float*)Vh, KBASE(1)); } }
    MASKT(pA0, pA1, 0); partialSM(pA0, pA1, m_reg, mnA, alA);
    if (NT > 1) { VMW(); if constexpr (F32) { SWRITE_VF(1); SBAR(); if (NT > 2) SLOAD_F((const float*)Kh, KBASE(2)); } else SWRITE_H(1); }
    __syncthreads();
#define HALF_STEP(PX0, PX1, mnX, alX, PY0, PY1, alY, t, KB, VB, SB) do {                                                      \
        SBAR(); qkt<KB, SK>(PX0, PX1, K_lds, r32, hi, S.qr, ACT(t));                                             \
        finishSM(PY0, PY1, alY, l_reg, pa0, pa1, pa2, pa3); SBAR();                                                           \
        if ((t) + 1 < NT) { if constexpr (F32) { VMW(); SWRITE_KF(SB); SBAR(); SLOAD_F((const float*)Vh, KBASE((t) + 1)); }  \
                            else { SLOAD_H(Kh, Vh, KBASE((t) + 1)); } SBAR(); }                                               \
        pv_tile<VB, SK>(o, vb0, pa0, pa1, pa2, pa3, ACT((t) - 1)); MASKT(PX0, PX1, (t)); partialSM(PX0, PX1, m_reg, mnX, alX);                                        \
        __syncthreads();                                                                                                      \
        if ((t) + 1 < NT) { VMW(); if constexpr (F32) { SWRITE_VF(SB); SBAR(); if ((t) + 2 < NT) SLOAD_F((const float*)Kh, KBASE((t) + 2)); } \
                            else { SWRITE_H(SB); } }                                                                          \
        RESC(alX); __syncthreads(); } while (0)
    for (int t = 1; t + 1 < NT; t += 2) {
        HALF_STEP(pB0, pB1, mnB, alB, pA0, pA1, alA, t, 1, 0, 0);
        HALF_STEP(pA0, pA1, mnA, alA, pB0, pB1, alB, t + 1, 0, 1, 1);
    }
    const bool even = (NT & 1) == 0;
    if (even) { SBAR(); qkt<1, SK>(pB0, pB1, K_lds, r32, hi, S.qr, ACT(NT - 1)); SBAR(); }
#define QROW(e) (nxt.Q + (size_t)(wid * QBLK + r32) * D + ((e) >> 1) * 16 + hi * 8 + ((e) & 1) * 4)
    if constexpr (F32) { SLOAD_F((const float*)nxt.K, kbn); SBAR();
#pragma unroll
        for (int e = 0; e < 8; ++e) S.tq[e] = *(const f32x4*)QROW(e); }
    else { SLOAD_H(nxt.K, nxt.V, kbn); SBAR();
#pragma unroll
        for (int d0 = 0; d0 < DQK / 16; ++d0) S.qr[d0] = load8<TIn>(nxt.Q + (size_t)(wid * QBLK + r32) * DQK + d0 * 16 + hi * 8); }
    SBAR();
    finishSM(pA0, pA1, alA, l_reg, pa0, pa1, pa2, pa3); SBAR();
    if constexpr (F32) {
#pragma unroll
        for (int e = 8; e < 16; ++e) S.tq[e] = *(const f32x4*)QROW(e); SBAR(); }
#undef QROW
    pv_tile<0, SK>(o, vb0, pa0, pa1, pa2, pa3, ACT(even ? NT - 2 : NT - 1));
    if (even) { MASKT(pB0, pB1, NT - 1); partialSM(pB0, pB1, m_reg, mnB, alB); __syncthreads(); RESC(alB);
        finishSM(pB0, pB1, alB, l_reg, pa0, pa1, pa2, pa3); SBAR(); pv_tile<1, SK>(o, vb0, pa0, pa1, pa2, pa3, ACT(NT - 1)); }
    SBAR(); SEAM_K0();
    if (hi == 0) li_l[r32] = l_reg; asm volatile("s_waitcnt lgkmcnt(0)" ::: "memory");
    float rli[16];
#pragma unroll
    for (int r = 0; r < 16; ++r) rli[r] = __builtin_amdgcn_rcpf(li_l[crow(r, hi)]);
    TOut* Ow = cur.O + (size_t)(wid * QBLK) * D;
#pragma unroll
    for (int r = 0; r < 16; ++r) { const int orow = crow(r, hi);
#pragma unroll
        for (int d0 = 0; d0 < 4; ++d0) { const float v = o[d0][r] * rli[r];
            if constexpr (same_t<TOut, float>::v) { Ow[(size_t)orow * D + d0 * 32 + r32] = v; }
            else { const float vn = __shfl_xor(v, 1);
                   if ((r32 & 1) == 0) *(unsigned*)(Ow + (size_t)orow * D + d0 * 32 + r32) = cvtpk(v, vn); } } }
    if constexpr (F32) {
#pragma unroll
        for (int d0 = 0; d0 < 8; ++d0) S.qr[d0] = pack8(S.tq[2 * d0], S.tq[2 * d0 + 1]); }
    __syncthreads();
#undef RESC
#undef KBASE
#undef ACT
#undef MASKT
#undef SEAM_K0
#undef HALF_STEP
}
#undef ROW
#undef ROWK
#undef VMW
#undef VMWN
#undef SLOAD_H
#undef SWRITE_HK
#undef SWRITE_HV
#undef SWRITE_H
#undef SLOAD_F
#undef SWRITE_KF
#undef SWRITE_VF

__host__ __device__ inline int swa_nramp(int nqb, int W, int qoff) { const int t = W - 1 - qoff; const int n = t < 0 ? 0 : t / QB + 1; return n > nqb ? nqb : n; }
__host__ __device__ inline int swa_nx(int nqb, int nramp, int order) { return (order & ORDER_PAIRED) ? (nramp + 1) / 2 + (nqb - nramp) : nqb; }
struct SwaItem { int bh, qb0, qb1; };
__device__ __forceinline__ SwaItem swa_decode(int L, int nb, int nh, int nhkv, int nqb, int nx, int nramp, int order) {
    const int G = nh / nhkv; SwaItem it; int x;
    if ((order & ORDER_XCD) && (nb * nhkv) % 8 == 0) { const int xcd = L & 7, k = L >> 3, per = G * nx, gi = k / per, r = k - gi * per;
        it.bh = (gi * 8 + xcd) * G + r / nx; x = r % nx; }
    else { it.bh = L / nx; x = L - it.bh * nx; }
    if (order & ORDER_PAIRED) { const int ns = nqb - nramp;
        if (x < ns) { it.qb0 = it.qb1 = nqb - 1 - x; } else { it.qb0 = x - ns; it.qb1 = nramp - 1 - it.qb0; } }
    else { it.qb0 = it.qb1 = ((order & 3) == ORDER_REVERSED) ? nqb - 1 - x : x; }
    return it;
}
template <class TIn, class TOut>
__device__ __forceinline__ BlockRef<TIn, TOut> swa_ref(const SwaItem& it, int pass, const TIn* Q, const TIn* K, const TIn* V, TOut* O,
                                                    int nh, int nhkv, int sq, int skv, int qoff) {
    const int qb = pass ? it.qb1 : it.qb0, kvh = it.bh / (nh / nhkv);
    BlockRef<TIn, TOut> r;
    r.Q = Q + ((size_t)it.bh * sq + (size_t)qb * QB) * DQK; r.O = O + ((size_t)it.bh * sq + (size_t)qb * QB) * D;
    r.K = K + (size_t)kvh * skv * DQK; r.V = V + (size_t)(kvh >> 1) * skv * D; r.P0 = qoff + qb * QB;
    return r;
}
#undef KSWZ
#undef SBAR
__device__ __forceinline__ void attn_phase128(char* lds, const TIN* Q, const TIN* K, const TIN* V, TOUT* O, int L, const int stride, const int last_L) {
    constexpr int nb = B, nh = H, nhkv = HKV, sq = SQ, skv = SKV, W = WINDOW, qoff = QOFF, order = ORDER;
    const int nqb = sq / QB, nramp = swa_nramp(nqb, W, qoff), nx = swa_nx(nqb, nramp, order), total = nx * nb * nh;
    if (L >= total) return; (void)total;
    SwaItem it = swa_decode(L, nb, nh, nhkv, nqb, nx, nramp, order); int pass = 0;
    BlockRef<TIN, TOUT> cur = swa_ref<TIN, TOUT>(it, 0, Q, K, V, O, nh, nhkv, sq, skv, qoff);
    Seam<TIN> S;
    causal_swa_prime<TIN, TOUT>(cur, W, lds, S);
    for (;;) {
        const bool more_pass = pass == 0 && it.qb1 != it.qb0, more_item = L + stride <= last_L, last = !more_pass && !more_item;
        SwaItem itn = it; int passn = pass + 1, Ln = L;
        if (!more_pass) { passn = 0; Ln = more_item ? L + stride : L; itn = swa_decode(Ln, nb, nh, nhkv, nqb, nx, nramp, order); }
        const BlockRef<TIN, TOUT> nxt = last ? cur : swa_ref<TIN, TOUT>(itn, passn, Q, K, V, O, nh, nhkv, sq, skv, qoff);
        causal_swa_block<TIN, TOUT>(cur, nxt, skv, W, lds, S);
        if (last) break;
        cur = nxt; it = itn; pass = passn; L = Ln;
    }
}
}
#define XB_TMO      128
#define XB_XCNT(j)  (256  + 64 * (j))
#define XB_XSUB(j)  (1280 + 64 * (j))
#define XB_XGEN(j)  (2304 + 64 * (j))
#define XB_TOP      3328
#define XB_TOPGEN   3392
#define XCD_BAR_WORDS 3456
#define XB_SPIN_CAP (1u << 18)

__device__ __forceinline__ unsigned xb_ld(unsigned* p)              { return __hip_atomic_load(p, __ATOMIC_RELAXED, __HIP_MEMORY_SCOPE_AGENT); }
__device__ __forceinline__ unsigned xb_add(unsigned* p, unsigned v) { return __hip_atomic_fetch_add(p, v, __ATOMIC_RELAXED, __HIP_MEMORY_SCOPE_AGENT); }
__device__ __forceinline__ unsigned xb_xcc_id() { return (unsigned)__builtin_amdgcn_s_getreg((3 << 11) | 20) & 0xFu; }
#define XB_SPIN(cond, bar) do { unsigned _sp = 0; while (cond) { __builtin_amdgcn_s_sleep(1); \
    if ((++_sp & 255u) == 0u) { if (xb_ld(&(bar)[XB_TMO])) break; if (_sp > XB_SPIN_CAP) { atomicAdd(&(bar)[XB_TMO], 1u); break; } } } } while (0)

struct XcdBarrier {
    unsigned* bar; unsigned x;
    volatile LAS unsigned* st;
};

__device__ __forceinline__ XcdBarrier xcd_barrier_post(unsigned* bar, volatile LAS unsigned* st) {
    XcdBarrier b; b.bar = bar; b.x = xb_xcc_id(); b.st = st;
    if (threadIdx.x == 0) (void)xb_add(&bar[XB_XCNT(b.x)], 1u);
    return b;
}
__device__ __forceinline__ void xcd_barrier_complete(unsigned* bar, unsigned x, unsigned& nloc, unsigned& nx) {
    const unsigned G = gridDim.x * gridDim.y * gridDim.z;
    unsigned sum, cnt, mine, sp = 0u;
    for (;;) {
        sum = 0u; cnt = 0u; mine = 0u;
#pragma unroll
        for (unsigned j = 0; j < 16; ++j) { const unsigned c = xb_ld(&bar[XB_XCNT(j)]); sum += c; cnt += (c > 0u) ? 1u : 0u; mine = (j == x) ? c : mine; }
        if (sum == G) break;
        __builtin_amdgcn_s_sleep(1);
        if ((++sp & 255u) == 0u) { if (xb_ld(&bar[XB_TMO])) break; if (sp > XB_SPIN_CAP) { atomicAdd(&bar[XB_TMO], 1u); break; } }
    }
    nloc = mine > 0u ? mine : 1u; nx = cnt > 0u ? cnt : 1u;
}

__device__ __forceinline__ void xcd_barrier(const XcdBarrier& b) {
    asm volatile("s_waitcnt vmcnt(0)" ::: "memory");
    __syncthreads();
    if (threadIdx.x == 0) {
        unsigned* bar = b.bar;
        __builtin_amdgcn_s_waitcnt(0);
        unsigned nloc = b.st[0], nx = b.st[1];
        if (nloc == 0u) { xcd_barrier_complete(bar, b.x, nloc, nx); b.st[0] = nloc; b.st[1] = nx; }
        const unsigned old = xb_add(&bar[XB_XSUB(b.x)], 1u);
        const unsigned gen = old / nloc;
        if (old + 1u == (gen + 1u) * nloc) {
            __builtin_amdgcn_fence(__ATOMIC_RELEASE, "agent");
            asm volatile("s_waitcnt vmcnt(0)" ::: "memory");
            const unsigned og = xb_add(&bar[XB_TOP], 1u);
            const unsigned tg = og / nx;
            if (og + 1u == (tg + 1u) * nx) xb_add(&bar[XB_TOPGEN], 1u);
            else XB_SPIN(xb_ld(&bar[XB_TOPGEN]) == tg, bar);
            __builtin_amdgcn_fence(__ATOMIC_ACQUIRE, "agent");
            xb_add(&bar[XB_XGEN(b.x)], 1u);
            asm volatile("s_waitcnt vmcnt(0)" ::: "memory");
        } else {
            XB_SPIN(xb_ld(&bar[XB_XGEN(b.x)]) == gen, bar);
            __builtin_amdgcn_fence(__ATOMIC_ACQUIRE, "agent");
            asm volatile("s_waitcnt vmcnt(0)" ::: "memory");
        }
    }
    __syncthreads();
}

constexpr int NWAVES = 8;
struct Frame { LAS unsigned char* lds; volatile LAS unsigned* MISC; gu32* ctl; int wave, vcu, G; };
__device__ __forceinline__ int opaque_tid() { int t = (int)threadIdx.x; asm volatile("" : "+v"(t)); return t; }
#define FTID ((int)threadIdx.x)
#define FLANE ((int)(threadIdx.x & 63u))
struct Args { const float* in[53]; float* out; unsigned char* ws; int ph_lo, ph_hi, variant, pad; };
#define EPI_ARGS const f32x4 (&acc)[2][2][4][2], const pg8::Unit& u, int wr, int wc, int fr, int fq

__device__ __forceinline__ int maprow(int mode, int n) {
    if (mode == 0) return n;
    if (mode == 1) return (n >> 7) * 256 + (n & 127);
    if (mode == 2) return (n >> 7) * 256 + 128 + (n & 127);
    const int j = n & 1023; return (j >> 7) * 256 + ((n >> 10) << 7) + (j & 127);
}
__device__ __forceinline__ void tr_item(const float* W, int N, bf16* WT, int mode, LAS float* scr, int item, int lane) {
    const int nblk = N >> 5, kb = item / nblk, nb = item - kb * nblk, k0 = 64 * kb, n0 = 32 * nb;
#pragma unroll 8
    for (int i = 0; i < 32; ++i) { const int kk = 2 * i + (lane >> 5); scr[kk * 33 + (lane & 31)] = W[(size_t)(k0 + kk) * N + n0 + (lane & 31)]; }
    LDS_WAIT(); asm volatile("" ::: "memory");
    const int c = lane & 7; const int r0 = maprow(mode, n0);
#pragma unroll
    for (int j = 0; j < 4; ++j) { const int n = (lane >> 3) + 8 * j; const LAS float* s = scr + (8 * c) * 33 + n;
        v4u o; o.x = pk2(s[0 * 33], s[1 * 33]); o.y = pk2(s[2 * 33], s[3 * 33]); o.z = pk2(s[4 * 33], s[5 * 33]); o.w = pk2(s[6 * 33], s[7 * 33]);
        *(GAS v4u*)(WT + (size_t)(r0 + n) * 1024 + k0 + 8 * c) = o; }
    LDS_WAIT(); asm volatile("" ::: "memory");
}
__device__ __forceinline__ unsigned pk4_fp8_w(float a, float b, float c, float d) {
    int r = __builtin_amdgcn_cvt_pk_fp8_f32(a, b, 0, false); r = __builtin_amdgcn_cvt_pk_fp8_f32(c, d, r, true); return (unsigned)r; }
__device__ __forceinline__ unsigned pk4_fp8(float a, float b, float c, float d) {
    a = __builtin_amdgcn_fmed3f(a, -448.f, 448.f); b = __builtin_amdgcn_fmed3f(b, -448.f, 448.f); c = __builtin_amdgcn_fmed3f(c, -448.f, 448.f); d = __builtin_amdgcn_fmed3f(d, -448.f, 448.f);
    int r = __builtin_amdgcn_cvt_pk_fp8_f32(a, b, 0, false); r = __builtin_amdgcn_cvt_pk_fp8_f32(c, d, r, true); return (unsigned)r; }
__device__ __forceinline__ void tr_item8(const float* W, int N, unsigned char* WT, int mode, float scale, LAS float* scr, int item, int lane) {
    const int nblk = N >> 5, kb = item / nblk, nb = item - kb * nblk, k0 = 128 * kb, n0 = 32 * nb;
#pragma unroll 8
    for (int i = 0; i < 64; ++i) { const int kk = 2 * i + (lane >> 5); scr[kk * 33 + (lane & 31)] = W[(size_t)(k0 + kk) * N + n0 + (lane & 31)] * scale; }
    LDS_WAIT(); asm volatile("" ::: "memory");
    const int c = lane & 7; const int r0 = maprow(mode, n0);
#pragma unroll
    for (int j = 0; j < 4; ++j) { const int n = (lane >> 3) + 8 * j; const LAS float* p = scr + (16 * c) * 33 + n;
        v4u o; o.x = pk4_fp8(p[0 * 33], p[1 * 33], p[2 * 33], p[3 * 33]); o.y = pk4_fp8(p[4 * 33], p[5 * 33], p[6 * 33], p[7 * 33]);
        o.z = pk4_fp8(p[8 * 33], p[9 * 33], p[10 * 33], p[11 * 33]); o.w = pk4_fp8(p[12 * 33], p[13 * 33], p[14 * 33], p[15 * 33]);
        *(GAS v4u*)(WT + (size_t)(r0 + n) * 1024 + k0 + 16 * c) = o; }
    LDS_WAIT(); asm volatile("" ::: "memory");
}
__device__ __forceinline__ void cvt_plain(const float* src, bf16* dst, size_t n, size_t gtid, size_t nth) {
    for (size_t i = gtid * 8; i < n; i += nth * 8) { const f32x4 a = *(const GAS f32x4*)(src + i), b = *(const GAS f32x4*)(src + i + 4);
        v4u o; o.x = pk2(a.x, a.y); o.y = pk2(a.z, a.w); o.z = pk2(b.x, b.y); o.w = pk2(b.z, b.w); *(GAS v4u*)(dst + i) = o; }
}
__device__ __forceinline__ void cvt_experts(Frame& F, const float* wup, const float* wdn, unsigned char* ws, unsigned char* dup = nullptr, unsigned char* ddn = nullptr) {
    if (!dup) { dup = ws + WS_WUP8; ddn = ws + WS_WDN8; }
    const int gw = F.vcu * NWAVES + F.wave, NGW = F.G * NWAVES;
#if MOE_FP8
    LAS float* tl = (LAS float*)F.lds;
    struct Tile { const float* W; unsigned char* WT; int N, k0, n0, mode; float scale; };
    auto tile_of = [&](int it) { Tile t; const int e = it / 96, r = it - e * 96; const bool up = r < 64; const int rr = up ? r : r - 64;
        t.N = up ? 2048 : 1024; const int nb = up ? (rr & 7) : (rr & 3), kb = up ? (rr >> 3) : (rr >> 2); t.k0 = 128 * kb; t.n0 = 256 * nb;
        t.W = up ? wup + (size_t)e * 1024 * 2048 : wdn + (size_t)e * 1024 * 1024; t.WT = up ? dup + (size_t)e * 2048 * 1024 : ddn + (size_t)e * 1024 * 1024;
        t.scale = up ? SWU8 : SWD8; t.mode = up ? 3 : 0; return t; };
    int it = F.vcu;
    if (it < NEXP * 96) {
        Tile cur = tile_of(it); f32x4 v[16];
#pragma unroll
        for (int i = 0; i < 16; ++i) { const int idx = i * 512 + FTID, row = idx >> 6, c4 = idx & 63; v[i] = *(const GAS f32x4*)(cur.W + (size_t)(cur.k0 + row) * cur.N + cur.n0 + 4 * c4); }
        for (;;) {
            __syncthreads();
#pragma unroll
            for (int i = 0; i < 16; ++i) { const int idx = i * 512 + FTID, row = idx >> 6, c4 = idx & 63; *(LAS f32x4*)(tl + row * 260 + 4 * (c4 ^ (row >> 4))) = v[i] * cur.scale; }
            __syncthreads();
            const int itn = it + F.G; const bool more = itn < NEXP * 96; Tile nxt = cur;
            if (more) { nxt = tile_of(itn);
#pragma unroll
                for (int i = 0; i < 16; ++i) { const int idx = i * 512 + FTID, row = idx >> 6, c4 = idx & 63; v[i] = *(const GAS f32x4*)(nxt.W + (size_t)(nxt.k0 + row) * nxt.N + nxt.n0 + 4 * c4); } }
#pragma unroll
            for (int j = 0; j < 4; ++j) { const int idx = j * 512 + FTID, n = idx >> 3, c = idx & 7; const LAS float* p = tl + (16 * c) * 260 + (n ^ (4 * c));
                v4u o; o.x = pk4_fp8_w(p[0 * 260], p[1 * 260], p[2 * 260], p[3 * 260]); o.y = pk4_fp8_w(p[4 * 260], p[5 * 260], p[6 * 260], p[7 * 260]);
                o.z = pk4_fp8_w(p[8 * 260], p[9 * 260], p[10 * 260], p[11 * 260]); o.w = pk4_fp8_w(p[12 * 260], p[13 * 260], p[14 * 260], p[15 * 260]);
                *(GAS v4u*)(cur.WT + (size_t)maprow(cur.mode, cur.n0 + n) * 1024 + cur.k0 + 16 * c) = o; }
            if (!more) break;
            cur = nxt; it = itn;
        }
    }
    __syncthreads();
    return;
#endif
    LAS float* scr = (LAS float*)(F.lds + F.wave * 16384);
    for (int it = gw; it < NEXP * 1536; it += NGW) { const int e = it / 1536, r = it - e * 1536;
        if (r < 1024) tr_item(wup + (size_t)e * 1024 * 2048, 2048, (bf16*)(ws + WS_WUP) + (size_t)e * 2048 * 1024, 3, scr, r, FLANE);
        else tr_item(wdn + (size_t)e * 1024 * 1024, 1024, (bf16*)(ws + WS_WDN) + (size_t)e * 1024 * 1024, 0, scr, r - 1024, FLANE); }
}
__device__ __forceinline__ void p0_prologue(Frame& F, const Args& a, const bool do_rest, const size_t x_lo, const size_t x_hi, const int x_rank, const int x_n) {
    unsigned char* ws = a.ws;
    LAS float* scr = (LAS float*)(F.lds + F.wave * 16896);
    const int gw = F.vcu * NWAVES + F.wave, NGW = F.G * NWAVES;
    if (do_rest) {
    constexpr int I0 = 16 * 64, IB = I0 + (H0_FP8 == 2 ? 0 : 16 * 80), I1 = IB + (H0_FP8 ? 8 * 80 : 0), I2 = I1 + 512, I3 = I2 + 512, I4 = I3 + 512, I5 = I4 + 256, I6 = I5 + 256, I7 = I6 + 256, I8 = I7 + 16, I9 = I8 + 16;
    for (int it = gw; it < I9; it += NGW) {
        if (it < I0) tr_item(a.in[2], 2048, (bf16*)(ws + WS_WKV), 0, scr, it, FLANE);
        else if (it < IB) tr_item(a.in[3], 2560, (bf16*)(ws + WS_WIN0), 0, scr, it - I0, FLANE);
        else if (it < I1) tr_item8(a.in[3], 2560, ws + WS_WIN0F8, 0, SWU8, scr, it - IB, FLANE);
        else if (it < I2) tr_item(a.in[13], 1024, (bf16*)(ws + WS_WOUT0), 0, scr, it - I1, FLANE);
        else if (it < I3) tr_item(a.in[17], 1024, (bf16*)(ws + WS_XOT), 0, scr, it - I2, FLANE);
        else if (it < I4) tr_item(a.in[42], 1024, (bf16*)(ws + WS_XOT) + 1024 * 1024, 0, scr, it - I3, FLANE);
        else if (it < I5) tr_item8(a.in[28], 1024, ws + WS_WIN1, 0, SWU8, scr, it - I4, FLANE);
        else if (it < I6) tr_item8(a.in[37], 1024, ws + WS_WVG, 1, SWD8, scr, it - I5, FLANE);
        else if (it < I7) tr_item8(a.in[38], 1024, ws + WS_WVG, 2, SWU8, scr, it - I6, FLANE);
        else if (it < I8) tr_item(a.in[20], 32, (bf16*)(ws + WS_WR), 0, scr, it - I7, FLANE);
        else tr_item(a.in[45], 32, (bf16*)(ws + WS_WR) + 256 * 1024, 0, scr, it - I8, FLANE);
    }
    if (!(CVT0_IN_ATTN && MOE_FP8) || F.G != 256) cvt_experts(F, a.in[22], a.in[24], ws);
    const size_t gtid = (size_t)F.vcu * 512 + FTID, nth = (size_t)F.G * 512;
    cvt_plain(a.in[16], (bf16*)(ws + WS_XQB), 1024 * 1024, gtid, nth);
    cvt_plain(a.in[41], (bf16*)(ws + WS_XQB) + 1024 * 1024, 1024 * 1024, gtid, nth);
    cvt_plain(a.in[1], (bf16*)(ws + WS_MEMB), (size_t)NB * MEMLEN * DM, gtid, nth);
    }
    const size_t xt = ((size_t)x_rank * 512 + FTID) * 8, xs = (size_t)x_n * 512 * 8;
    if (H0_FP8) { const float* src = a.in[0]; bf16* dst = (bf16*)(ws + WS_XB); unsigned char* d8 = ws + WS_XF8;
        for (size_t i = x_lo + xt; i < x_hi; i += xs) { const f32x4 p = *(const GAS f32x4*)(src + i), q = *(const GAS f32x4*)(src + i + 4);
            v4u o; o.x = pk2(p.x, p.y); o.y = pk2(p.z, p.w); o.z = pk2(q.x, q.y); o.w = pk2(q.z, q.w); *(GAS v4u*)(dst + i) = o;
            v2u o8; o8.x = pk4_fp8(p.x * SX8, p.y * SX8, p.z * SX8, p.w * SX8); o8.y = pk4_fp8(q.x * SX8, q.y * SX8, q.z * SX8, q.w * SX8); *(GAS v2u*)(d8 + i) = o8; } }
    else if (x_hi > x_lo) cvt_plain(a.in[0], (bf16*)(ws + WS_XB), (size_t)MTOK * DM, (size_t)x_rank * 512 + FTID, (size_t)x_n * 512);
}

__device__ __forceinline__ void moe_tables(Frame& F, gu32* cnt) {
    LAS int* tab = (LAS int*)(F.lds + TAB_OFF);
    if (FTID < 32) tab[FTID] = (int)__hip_atomic_load(cnt + FTID * 64, RLX_AGENT);
    __syncthreads();
    if (FTID == 0) { int s = 0; for (int e = 0; e < NEXP; ++e) { tab[32 + e] = s; s += (tab[e] + 255) >> 8; } tab[64] = s; }
    __syncthreads();
}

template <int MODE>
__device__ __forceinline__ void ph_ln(Frame& F, const bf16* zb, const bf16* ys, bf16* xb, float* outf, const float* g, const float* b, unsigned char* x8 = nullptr, const int* asg = nullptr, const float* gate = nullptr,
                                      const float* st2 = nullptr, const float* g2 = nullptr, const float* b2 = nullptr) {
    LAS const int* tab = (LAS const int*)(F.lds + TAB_OFF);
    const int gw = F.vcu * NWAVES + F.wave, NGW = F.G * NWAVES, c0 = 8 * FLANE;
    float gv[16], bv[16];
#pragma unroll
    for (int h = 0; h < 2; ++h)
#pragma unroll
        for (int q = 0; q < 2; ++q) { const f32x4 t = *(const GAS f32x4*)(g + c0 + 512 * h + 4 * q), s = *(const GAS f32x4*)(b + c0 + 512 * h + 4 * q);
            gv[8 * h + 4 * q + 0] = t.x; gv[8 * h + 4 * q + 1] = t.y; gv[8 * h + 4 * q + 2] = t.z; gv[8 * h + 4 * q + 3] = t.w;
            bv[8 * h + 4 * q + 0] = s.x; bv[8 * h + 4 * q + 1] = s.y; bv[8 * h + 4 * q + 2] = s.z; bv[8 * h + 4 * q + 3] = s.w; }
    constexpr bool REB = (MODE == 1) && MOE_FP8; float g2v[REB ? 16 : 1], b2v[REB ? 16 : 1];
    if constexpr (REB) {
#pragma unroll
        for (int h = 0; h < 2; ++h)
#pragma unroll
            for (int q = 0; q < 2; ++q) { const f32x4 t = *(const GAS f32x4*)(g2 + c0 + 512 * h + 4 * q), s = *(const GAS f32x4*)(b2 + c0 + 512 * h + 4 * q);
#pragma unroll
                for (int j = 0; j < 4; ++j) { g2v[8 * h + 4 * q + j] = ALPHA * t[j]; b2v[8 * h + 4 * q + j] = ALPHA * s[j]; } } }
    constexpr int RI = (MODE == 0) ? 4 : 2;
    for (int m0 = gw * RI; m0 < MTOK; m0 += NGW * RI) {
        v4u raw[RI][2]; v4u yr[(MODE == 1) ? RI : 1][2][4]; f32x4 gt[(MODE == 1) ? RI : 1]; f32x2 ms[RI];
#pragma unroll
        for (int r = 0; r < RI; ++r) { const size_t m = (size_t)(m0 + r); size_t yrow[4] = {0, 0, 0, 0};
            if constexpr (REB) ms[r] = *(const GAS f32x2*)(st2 + m * 2);
            if (MODE == 1) { const v4i_t as = *(const GAS v4i_t*)(asg + m * 4); gt[r] = *(const GAS f32x4*)(gate + m * 4);
#pragma unroll
                for (int k = 0; k < 4; ++k) yrow[k] = (size_t)(tab[32 + (as[k] >> 16)] * 256 + (as[k] & 0xffff)); }
#pragma unroll
            for (int h = 0; h < 2; ++h) {
                raw[r][h] = *(const GAS v4u*)(((MODE == 0 || REB) ? zb : xb) + m * DM + c0 + 512 * h);
                if (MODE == 1) {
#pragma unroll
                    for (int k = 0; k < 4; ++k) { const v2u t8 = *(const GAS v2u*)((const unsigned char*)ys + yrow[k] * DM + c0 + 512 * h); yr[r][h][k] = (v4u){t8.x, t8.y, 0u, 0u}; } } } }
#pragma unroll
        for (int r = 0; r < RI; ++r) { const size_t m = (size_t)(m0 + r);
            float v[16];
#pragma unroll
            for (int h = 0; h < 2; ++h) { const v4u w = raw[r][h]; const float sc = (MODE == 0) ? 1.0f : ALPHA;
                v[8 * h + 0] = sc * bflo(w.x); v[8 * h + 1] = sc * bfhi(w.x); v[8 * h + 2] = sc * bflo(w.y); v[8 * h + 3] = sc * bfhi(w.y); v[8 * h + 4] = sc * bflo(w.z); v[8 * h + 5] = sc * bfhi(w.z); v[8 * h + 6] = sc * bflo(w.w); v[8 * h + 7] = sc * bfhi(w.w);
                if constexpr (REB) { const float mu2 = ms[r][0] * ALPHA, rs2 = ms[r][1];
#pragma unroll
                    for (int j = 0; j < 8; ++j) v[8 * h + j] = (v[8 * h + j] - mu2) * rs2 * g2v[8 * h + j] * (1.0f / ALPHA) + b2v[8 * h + j]; }
                if (MODE == 1) {
#pragma unroll
                    for (int k = 0; k < 4; ++k) { const v4u y = yr[r][h][k]; const float gk = gt[r][k] * (1.0f / SY8);
                        const f32x2 p0 = __builtin_amdgcn_cvt_pk_f32_fp8((int)y.x, false), p1 = __builtin_amdgcn_cvt_pk_f32_fp8((int)y.x, true), p2 = __builtin_amdgcn_cvt_pk_f32_fp8((int)y.y, false), p3 = __builtin_amdgcn_cvt_pk_f32_fp8((int)y.y, true);
                        v[8 * h + 0] += gk * p0[0]; v[8 * h + 1] += gk * p0[1]; v[8 * h + 2] += gk * p1[0]; v[8 * h + 3] += gk * p1[1]; v[8 * h + 4] += gk * p2[0]; v[8 * h + 5] += gk * p2[1]; v[8 * h + 6] += gk * p3[0]; v[8 * h + 7] += gk * p3[1]; } } }
            float s = 0.f;
#pragma unroll
            for (int j = 0; j < 16; ++j) s += v[j];
            const float mean = wave_sum(s) * (1.f / DM); float s2 = 0.f;
#pragma unroll
            for (int j = 0; j < 16; ++j) { v[j] -= mean; s2 += v[j] * v[j]; }
            const float rstd = 1.f / sqrtf(wave_sum(s2) * (1.f / DM) + LN_EPS);
#pragma unroll
            for (int j = 0; j < 16; ++j) v[j] = v[j] * rstd * gv[j] + bv[j];
#pragma unroll
            for (int h = 0; h < 2; ++h) { v4u o; o.x = pk2(v[8 * h], v[8 * h + 1]); o.y = pk2(v[8 * h + 2], v[8 * h + 3]); o.z = pk2(v[8 * h + 4], v[8 * h + 5]); o.w = pk2(v[8 * h + 6], v[8 * h + 7]);
                if (!outf) *(GAS v4u*)(xb + m * DM + c0 + 512 * h) = o;
                if (x8) { v2u o8; o8.x = pk4_fp8(v[8 * h] * SX8, v[8 * h + 1] * SX8, v[8 * h + 2] * SX8, v[8 * h + 3] * SX8); o8.y = pk4_fp8(v[8 * h + 4] * SX8, v[8 * h + 5] * SX8, v[8 * h + 6] * SX8, v[8 * h + 7] * SX8);
                          *(GAS v2u*)(x8 + m * DM + c0 + 512 * h) = o8; }
                if (outf) { *(GAS f32x4*)(outf + m * DM + c0 + 512 * h) = (f32x4){v[8 * h], v[8 * h + 1], v[8 * h + 2], v[8 * h + 3]};
                            *(GAS f32x4*)(outf + m * DM + c0 + 512 * h + 4) = (f32x4){v[8 * h + 4], v[8 * h + 5], v[8 * h + 6], v[8 * h + 7]}; } }
        }
    }
}
__device__ __forceinline__ void ph_ln2_router(Frame& F, const bf16* zb, bf16* xb, unsigned char* x8, const float* g, const float* b, const bf16* wrT, const float* rbias,
                                              gu32* cnt, int* list, float* gate, int* asg, float* st2) {
    LAS int* cl = (LAS int*)F.lds;
    LAS float* gl = (LAS float*)(F.lds + 256);
    LAS bf16* wl = (LAS bf16*)(F.lds + 256 + 8192);
    const int rw = FLANE & 15, q = FLANE >> 4;
    for (int i = FTID; i < 256; i += 512) { ((LAS f32x4*)gl)[i] = *(const GAS f32x4*)(g + 4 * i); ((LAS f32x4*)gl)[256 + i] = *(const GAS f32x4*)(b + 4 * i); }
    for (int i = FTID; i < 4096; i += 512) { const int e = i >> 7, c = i & 127; *(LAS v4u*)(wl + e * 1032 + 8 * c) = *(const GAS v4u*)(wrT + (size_t)e * DM + 8 * c); }
    for (int blk = F.vcu; blk < MTOK / 128; blk += F.G) {
        __syncthreads();
        if (FTID < 64) cl[FTID] = 0;
        __syncthreads();
        const int row = blk * 128 + F.wave * 16 + rw;
        const bf16* zr = zb + (size_t)row * DM + 8 * q;
        v4u zz[32];
#pragma unroll
        for (int ks = 0; ks < 32; ++ks) zz[ks] = *(const GAS v4u*)(zr + 32 * ks);
        float s1 = 0.f, s2 = 0.f;
#pragma unroll
        for (int ks = 0; ks < 32; ++ks) { const v4u w = zz[ks]; const float x0 = bflo(w.x), x1 = bfhi(w.x), x2 = bflo(w.y), x3 = bfhi(w.y), x4 = bflo(w.z), x5 = bfhi(w.z), x6 = bflo(w.w), x7 = bfhi(w.w);
            s1 += ((x0 + x1) + (x2 + x3)) + ((x4 + x5) + (x6 + x7)); s2 += ((x0 * x0 + x1 * x1) + (x2 * x2 + x3 * x3)) + ((x4 * x4 + x5 * x5) + (x6 * x6 + x7 * x7)); }
        s1 += __shfl_xor(s1, 16); s1 += __shfl_xor(s1, 32); s2 += __shfl_xor(s2, 16); s2 += __shfl_xor(s2, 32);
        const float mean = s1 * (1.f / DM), rstd = 1.f / sqrtf(fmaxf(s2 * (1.f / DM) - mean * mean, 0.f) + LN_EPS);
        if (MOE_FP8 && q == 0) { f32x2 ms; ms[0] = mean; ms[1] = rstd; *(GAS f32x2*)(st2 + (size_t)row * 2) = ms; }
        const float nmr = -mean * rstd;
        f32x4 acc0 = (f32x4){0.f, 0.f, 0.f, 0.f}, acc1 = (f32x4){0.f, 0.f, 0.f, 0.f};
        bf16* xr = xb + (size_t)row * DM + 8 * q; unsigned char* x8r = x8 + (size_t)row * DM + 8 * q; v2u h8;
        const LAS bf16* w0 = wl + rw * 1032 + 8 * q; const LAS bf16* w1 = wl + (16 + rw) * 1032 + 8 * q;
#pragma unroll
        for (int ks = 0; ks < 32; ++ks) { v4u w = zz[ks]; asm volatile("" : "+v"(w));
            const f32x4 g0 = *(const LAS f32x4*)(gl + 32 * ks + 8 * q), g1 = *(const LAS f32x4*)(gl + 32 * ks + 8 * q + 4), b0 = *(const LAS f32x4*)(gl + 1024 + 32 * ks + 8 * q), b1 = *(const LAS f32x4*)(gl + 1024 + 32 * ks + 8 * q + 4);
            const f32x2 y01 = ((f32x2){bflo(w.x), bfhi(w.x)} * rstd + nmr) * g0.lo + b0.lo, y23 = ((f32x2){bflo(w.y), bfhi(w.y)} * rstd + nmr) * g0.hi + b0.hi;
            const f32x2 y45 = ((f32x2){bflo(w.z), bfhi(w.z)} * rstd + nmr) * g1.lo + b1.lo, y67 = ((f32x2){bflo(w.w), bfhi(w.w)} * rstd + nmr) * g1.hi + b1.hi;
            const float y0 = y01.x, y1 = y01.y, y2 = y23.x, y3 = y23.y, y4 = y45.x, y5 = y45.y, y6 = y67.x, y7 = y67.y;
            v4u o; o.x = pk2(y0, y1); o.y = pk2(y2, y3); o.z = pk2(y4, y5); o.w = pk2(y6, y7);
            if (!MOE_FP8) *(GAS v4u*)(xr + 32 * ks) = o;
            if (x8) { const f32x2 s01 = y01 * SX8, s23 = y23 * SX8, s45 = y45 * SX8, s67 = y67 * SX8; v2u o8; o8.x = pk4_fp8(s01.x, s01.y, s23.x, s23.y); o8.y = pk4_fp8(s45.x, s45.y, s67.x, s67.y);
                if ((ks & 1) == 0) h8 = o8;
                else { const auto sx = __builtin_amdgcn_permlane16_swap(h8.x, o8.x, false, false); const auto sy = __builtin_amdgcn_permlane16_swap(h8.y, o8.y, false, false);
                    *(GAS v4u*)(x8r - 8 * q + 8 * (q & 2) + 32 * ((q & 1) ? ks : ks - 1)) = (v4u){sx[0], sy[0], sx[1], sy[1]}; } }
            const bf16x8 bfrag = __builtin_bit_cast(bf16x8, o);
            acc0 = __builtin_amdgcn_mfma_f32_16x16x32_bf16(*(const LAS bf16x8*)(w0 + 32 * ks), bfrag, acc0, 0, 0, 0);
            acc1 = __builtin_amdgcn_mfma_f32_16x16x32_bf16(*(const LAS bf16x8*)(w1 + 32 * ks), bfrag, acc1, 0, 0, 0);
            if ((ks & 1) == 1) asm volatile("" ::: "memory"); }
        float lg[8]; const f32x4 rb0 = *(const GAS f32x4*)(rbias + 4 * q), rb1 = *(const GAS f32x4*)(rbias + 16 + 4 * q);
#pragma unroll
        for (int j = 0; j < 4; ++j) { lg[j] = acc0[j] + rb0[j]; lg[4 + j] = acc1[j] + rb1[j]; }
        int idx[4]; float val[4];
#pragma unroll
        for (int k = 0; k < 4; ++k) { float bv = -3.0e38f; int bi = 64;
#pragma unroll
            for (int j = 0; j < 8; ++j) { const int e = (j < 4) ? 4 * q + j : 12 + 4 * q + j; if (lg[j] > bv) { bv = lg[j]; bi = e; } }
#pragma unroll
            for (int o = 16; o <= 32; o <<= 1) { const float pv = __shfl_xor(bv, o); const int pi = __shfl_xor(bi, o); if (pv > bv || (pv == bv && pi < bi)) { bv = pv; bi = pi; } }
            bi &= 31; idx[k] = bi; val[k] = bv;
#pragma unroll
            for (int j = 0; j < 8; ++j) { const int e = (j < 4) ? 4 * q + j : 12 + 4 * q + j; if (e == bi) lg[j] = -3.0e38f; } }
        const float e1 = __builtin_amdgcn_exp2f((val[1] - val[0]) * LOG2E), e2 = __builtin_amdgcn_exp2f((val[2] - val[0]) * LOG2E), e3 = __builtin_amdgcn_exp2f((val[3] - val[0]) * LOG2E);
        const float inv = 1.f / (1.f + e1 + e2 + e3);
        int pos[4] = {0, 0, 0, 0};
        for (int e = 0; e < NEXP; ++e) {
            const int k = (q != 0) ? -1 : (idx[0] == e) ? 0 : (idx[1] == e) ? 1 : (idx[2] == e) ? 2 : (idx[3] == e) ? 3 : -1;
            const unsigned long long mask = __ballot(k >= 0);
            if (mask) { const int n = __popcll(mask), leader = __ffsll((long long)mask) - 1; int bp = 0;
                if (FLANE == leader) bp = __hip_atomic_fetch_add(cl + e, n, __ATOMIC_RELAXED, __HIP_MEMORY_SCOPE_WORKGROUP);
                bp = __shfl(bp, leader);
                const int p = bp + __popcll(mask & ((1ull << FLANE) - 1ull));
                pos[0] = (k == 0) ? p : pos[0]; pos[1] = (k == 1) ? p : pos[1]; pos[2] = (k == 2) ? p : pos[2]; pos[3] = (k == 3) ? p : pos[3]; }
        }
        __syncthreads();
        if (FTID < 32) { const int tot = cl[FTID]; cl[32 + FTID] = tot ? (int)__hip_atomic_fetch_add(cnt + FTID * 64, (unsigned)tot, RLX_AGENT) : 0; }
        __syncthreads();
        if (q == 0) {
            *(GAS f32x4*)(gate + (size_t)row * 4) = (f32x4){inv, e1 * inv, e2 * inv, e3 * inv};
#pragma unroll
            for (int k = 0; k < 4; ++k) { const int pe = cl[32 + idx[k]] + pos[k]; list[(size_t)idx[k] * CAP + pe] = row * 4 + k; pos[k] = (idx[k] << 16) | pe; }
            *(GAS v4i_t*)(asg + (size_t)row * 4) = (v4i_t){pos[0], pos[1], pos[2], pos[3]}; }
    }
}
__device__ __forceinline__ void ph_softmax(Frame& F, const float* sc, bf16* P) {
    const int gw = F.vcu * NWAVES + F.wave, NGW = F.G * NWAVES;
    for (int m = gw; m < MTOK; m += NGW) {
#pragma unroll
        for (int h = 0; h < 4; ++h) { f32x4 v = *(const GAS f32x4*)(sc + (size_t)m * DM + 256 * h + 4 * FLANE);
            const float mx = wave_max(fmaxf(fmaxf(v.x, v.y), fmaxf(v.z, v.w)));
            v.x = __builtin_amdgcn_exp2f(v.x - mx); v.y = __builtin_amdgcn_exp2f(v.y - mx); v.z = __builtin_amdgcn_exp2f(v.z - mx); v.w = __builtin_amdgcn_exp2f(v.w - mx);
            const float inv = 1.f / wave_sum((v.x + v.y) + (v.z + v.w));
            v2u o; o.x = pk2(v.x * inv, v.y * inv); o.y = pk2(v.z * inv, v.w * inv);
            *(GAS v2u*)(P + (size_t)m * DM + 256 * h + 4 * FLANE) = o; }
    }
}
__device__ __forceinline__ void ph_topk(Frame& F, const float* logit, const float* rbias, gu32* cnt, int* list, float* gate) {
    for (int base = F.vcu * 512; base < MTOK; base += F.G * 512) {
        const int m = base + FTID;
        float lg[32];
#pragma unroll
        for (int q = 0; q < 8; ++q) { const f32x4 t = *(const GAS f32x4*)(logit + (size_t)m * 32 + 4 * q), bb = *(const GAS f32x4*)(rbias + 4 * q);
            lg[4 * q] = t.x + bb.x; lg[4 * q + 1] = t.y + bb.y; lg[4 * q + 2] = t.z + bb.z; lg[4 * q + 3] = t.w + bb.w; }
        int idx[4]; float val[4];
#pragma unroll
        for (int k = 0; k < 4; ++k) { float bvv = -3.0e38f; int bi = 0;
#pragma unroll
            for (int e = 0; e < 32; ++e) { const bool taken = (k > 0 && idx[0] == e) || (k > 1 && idx[1] == e) || (k > 2 && idx[2] == e); if (!taken && lg[e] > bvv) { bvv = lg[e]; bi = e; } }
            idx[k] = bi; val[k] = bvv; }
        const float e1 = __builtin_amdgcn_exp2f((val[1] - val[0]) * LOG2E), e2 = __builtin_amdgcn_exp2f((val[2] - val[0]) * LOG2E), e3 = __builtin_amdgcn_exp2f((val[3] - val[0]) * LOG2E);
        const float inv = 1.f / (1.f + e1 + e2 + e3);
        *(GAS f32x4*)(gate + (size_t)m * 4) = (f32x4){inv, e1 * inv, e2 * inv, e3 * inv};
        for (int e = 0; e < NEXP; ++e) {
            const int k = (idx[0] == e) ? 0 : (idx[1] == e) ? 1 : (idx[2] == e) ? 2 : (idx[3] == e) ? 3 : -1;
            const unsigned long long mask = __ballot(k >= 0);
            if (mask) { const int n = __popcll(mask), leader = __ffsll((long long)mask) - 1; unsigned bp = 0;
                if (FLANE == leader) bp = __hip_atomic_fetch_add(cnt + e * 64, (unsigned)n, RLX_AGENT);
                bp = __shfl(bp, leader);
                if (k >= 0) { const int rank = __popcll(mask & ((1ull << FLANE) - 1ull)); list[(size_t)e * CAP + bp + rank] = m * 4 + k; } }
        }
    }
}
__device__ __forceinline__ void ph_sgu(Frame& F, const bf16* hb, bf16* mix, const float* lng, const float* lnb, const float* wsp, const float* bsp) {
    LAS bf16* Wb = (LAS bf16*)F.lds;
    LAS bf16* VT = (LAS bf16*)(F.lds + 34816);
    LAS float* GL = (LAS float*)(F.lds + 69632);
    const int r = FTID >> 2, qq = FTID & 3, n16 = FLANE & 15, q = FLANE >> 4;
    int gcur = -1;
    for (int it = F.vcu; it < 1024; it += F.G) {
        const int g = it & 3, row0 = (it >> 2) * 128;
        if (g != gcur) { __syncthreads(); for (int i = FTID; i < 16384; i += 512) { const int t = i >> 7, s2 = i & 127; Wb[t * 136 + s2] = (bf16)((s2 <= t) ? f2bf(wsp[g * 16384 + i]) : 0u); } gcur = g; }
        v4u uw[4];
        { const bf16* usrc = hb + (size_t)(row0 + r) * DM + g * 128 + 32 * qq;
#pragma unroll
            for (int j = 0; j < 4; ++j) uw[j] = *(const GAS v4u*)(usrc + 8 * j); }
        { float v[32]; const bf16* src = hb + (size_t)(row0 + r) * DM + 512 + g * 128 + 32 * qq;
#pragma unroll
            for (int j = 0; j < 4; ++j) { const v4u w = *(const GAS v4u*)(src + 8 * j);
                v[8 * j + 0] = bflo(w.x); v[8 * j + 1] = bfhi(w.x); v[8 * j + 2] = bflo(w.y); v[8 * j + 3] = bfhi(w.y); v[8 * j + 4] = bflo(w.z); v[8 * j + 5] = bfhi(w.z); v[8 * j + 6] = bflo(w.w); v[8 * j + 7] = bfhi(w.w); }
            float s = 0.f;
#pragma unroll
            for (int j = 0; j < 32; ++j) s += v[j];
            s += __shfl_xor(s, 1); s += __shfl_xor(s, 2);
            const float mean = s * (1.f / 128.f); float s2 = 0.f;
#pragma unroll
            for (int j = 0; j < 32; ++j) { v[j] -= mean; s2 += v[j] * v[j]; }
            s2 += __shfl_xor(s2, 1); s2 += __shfl_xor(s2, 2);
            const float rstd = 1.f / sqrtf(s2 * (1.f / 128.f) + LN_EPS);
#pragma unroll
            for (int j = 0; j < 8; ++j) { const f32x4 gg = *(const GAS f32x4*)(lng + g * 128 + 32 * qq + 4 * j), bb = *(const GAS f32x4*)(lnb + g * 128 + 32 * qq + 4 * j);
#pragma unroll
                for (int k = 0; k < 4; ++k) VT[(32 * qq + 4 * j + k) * 136 + r] = (bf16)f2bf(v[4 * j + k] * rstd * gg[k] + bb[k]); } }
        __syncthreads();
        { bf16x8 VF[4];
#pragma unroll
            for (int ks = 0; ks < 4; ++ks) VF[ks] = *(const LAS bf16x8*)(VT + (16 * F.wave + n16) * 136 + 32 * ks + 8 * q);
#pragma unroll
            for (int tb = 0; tb < 8; ++tb) { f32x4 acc = (f32x4){0.f, 0.f, 0.f, 0.f};
#pragma unroll
                for (int ks = 0; ks <= (tb >> 1); ++ks) acc = __builtin_amdgcn_mfma_f32_16x16x32_bf16(*(const LAS bf16x8*)(Wb + (16 * tb + n16) * 136 + 32 * ks + 8 * q), VF[ks], acc, 0, 0, 0);
                const f32x4 bt = *(const GAS f32x4*)(bsp + g * 128 + 16 * tb + 4 * q);
#pragma unroll
                for (int k = 0; k < 4; ++k) GL[(16 * tb + 4 * q + k) * 128 + 16 * F.wave + n16] = acc[k] + bt[k]; } }
        __syncthreads();
        { bf16* dst = mix + (size_t)(row0 + r) * DM + g * 128 + 32 * qq;
#pragma unroll
            for (int j = 0; j < 4; ++j) { const v4u w = uw[j]; const f32x4 g0 = *(const LAS f32x4*)(GL + r * 128 + 32 * qq + 8 * j), g1 = *(const LAS f32x4*)(GL + r * 128 + 32 * qq + 8 * j + 4); v4u o;
                o.x = pk2(bflo(w.x) * g0[0], bfhi(w.x) * g0[1]); o.y = pk2(bflo(w.y) * g0[2], bfhi(w.y) * g0[3]); o.z = pk2(bflo(w.z) * g1[0], bfhi(w.z) * g1[1]); o.w = pk2(bflo(w.w) * g1[2], bfhi(w.w) * g1[3]);
                *(GAS v4u*)(dst + 8 * j) = o; } }
    }
}
__device__ __forceinline__ void ph_combine(Frame& F, const bf16* oatt, bf16* mix, const float* lq1, const float* lk1, const float* lq2, const float* lk2, const float* sg) {
    const int gw = F.vcu * NWAVES + F.wave, NGW = F.G * NWAVES;
    const float d1 = wave_sum(lq1[FLANE] * lk1[FLANE]), d2 = wave_sum(lq2[FLANE] * lk2[FLANE]);
    const float lam = expf(d1) - expf(d2) + LAM_INIT0;
    const int h = FLANE >> 4, e0 = 8 * (FLANE & 15);
    float gsc[8];
#pragma unroll
    for (int j = 0; j < 8; ++j) gsc[j] = sg[e0 + j] * (1.0f - LAM_INIT0);
    for (int m0 = gw * 4; m0 < MTOK; m0 += NGW * 4) {
        v4u av[4], bw[4];
#pragma unroll
        for (int r = 0; r < 4; ++r) { av[r] = *(const GAS v4u*)(oatt + (size_t)(m0 + r) * DM + h * 256 + e0); bw[r] = *(const GAS v4u*)(oatt + (size_t)(m0 + r) * DM + h * 256 + 128 + e0); }
#pragma unroll
        for (int r = 0; r < 4; ++r) { const v4u a = av[r], b = bw[r]; const size_t m = (size_t)(m0 + r);
            float o[8];
            o[0] = bflo(a.x) - lam * bflo(b.x); o[1] = bfhi(a.x) - lam * bfhi(b.x); o[2] = bflo(a.y) - lam * bflo(b.y); o[3] = bfhi(a.y) - lam * bfhi(b.y);
            o[4] = bflo(a.z) - lam * bflo(b.z); o[5] = bfhi(a.z) - lam * bfhi(b.z); o[6] = bflo(a.w) - lam * bflo(b.w); o[7] = bfhi(a.w) - lam * bfhi(b.w);
            float s2 = 0.f;
#pragma unroll
            for (int j = 0; j < 8; ++j) s2 += o[j] * o[j];
            s2 += __shfl_xor(s2, 1); s2 += __shfl_xor(s2, 2); s2 += __shfl_xor(s2, 4); s2 += __shfl_xor(s2, 8);
            const float rs = 1.f / sqrtf(s2 * (1.f / 128.f) + LN_EPS);
            v4u w; w.x = pk2(o[0] * rs * gsc[0], o[1] * rs * gsc[1]); w.y = pk2(o[2] * rs * gsc[2], o[3] * rs * gsc[3]); w.z = pk2(o[4] * rs * gsc[4], o[5] * rs * gsc[5]); w.w = pk2(o[6] * rs * gsc[6], o[7] * rs * gsc[7]);
            *(GAS v4u*)(mix + m * DM + 512 + h * 128 + e0) = w; }
    }
}

__device__ __forceinline__ void ph_combine_hm(Frame& F, const bf16* oatt, bf16* mix, const float* lq1, const float* lk1, const float* lq2, const float* lk2, const float* sg) {
    const int gw = F.vcu * NWAVES + F.wave, NGW = F.G * NWAVES;
    const float d1 = wave_sum(lq1[FLANE] * lk1[FLANE]), d2 = wave_sum(lq2[FLANE] * lk2[FLANE]);
    const float lam = expf(d1) - expf(d2) + LAM_INIT0;
    const int h = FLANE >> 4, e0 = 8 * (FLANE & 15);
    float gsc[8];
#pragma unroll
    for (int j = 0; j < 8; ++j) gsc[j] = sg[e0 + j] * (1.0f - LAM_INIT0);
    for (int m0 = gw * 4; m0 < MTOK; m0 += NGW * 4) {
        v4u av[4], bw[4];
#pragma unroll
        for (int r = 0; r < 4; ++r) { const int m = m0 + r, bb = m >> 11, ss = m & 2047; const bf16* p = oatt + ((size_t)(bb * 8 + 2 * h) * SEQ + ss) * 128 + e0;
            av[r] = *(const GAS v4u*)p; bw[r] = *(const GAS v4u*)(p + (size_t)SEQ * 128); }
#pragma unroll
        for (int r = 0; r < 4; ++r) { const v4u a = av[r], b = bw[r]; const size_t m = (size_t)(m0 + r);
            float o[8];
            o[0] = bflo(a.x) - lam * bflo(b.x); o[1] = bfhi(a.x) - lam * bfhi(b.x); o[2] = bflo(a.y) - lam * bflo(b.y); o[3] = bfhi(a.y) - lam * bfhi(b.y);
            o[4] = bflo(a.z) - lam * bflo(b.z); o[5] = bfhi(a.z) - lam * bfhi(b.z); o[6] = bflo(a.w) - lam * bflo(b.w); o[7] = bfhi(a.w) - lam * bfhi(b.w);
            float s2 = 0.f;
#pragma unroll
            for (int j = 0; j < 8; ++j) s2 += o[j] * o[j];
            s2 += __shfl_xor(s2, 1); s2 += __shfl_xor(s2, 2); s2 += __shfl_xor(s2, 4); s2 += __shfl_xor(s2, 8);
            const float rs = 1.f / sqrtf(s2 * (1.f / 128.f) + LN_EPS);
            v4u w; w.x = pk2(o[0] * rs * gsc[0], o[1] * rs * gsc[1]); w.y = pk2(o[2] * rs * gsc[2], o[3] * rs * gsc[3]); w.z = pk2(o[4] * rs * gsc[4], o[5] * rs * gsc[5]); w.w = pk2(o[6] * rs * gsc[6], o[7] * rs * gsc[7]);
            *(GAS v4u*)(mix + m * DM + 512 + h * 128 + e0) = w; }
    }
}

__device__ __forceinline__ void combine_local(Frame& F, const bf16* oatt, bf16* mix, const float* lq1, const float* lk1, const float* lq2, const float* lk2, const float* sg, int b, int h, int pr) {
    const float d1 = wave_sum(lq1[FLANE] * lk1[FLANE]), d2 = wave_sum(lq2[FLANE] * lk2[FLANE]);
    const float lam = expf(d1) - expf(d2) + LAM_INIT0;
    const int e0 = 8 * (FLANE & 15);
    float gsc[8];
#pragma unroll
    for (int j = 0; j < 8; ++j) gsc[j] = sg[e0 + j] * (1.0f - LAM_INIT0);
    for (int it = 0; it < 16; it += 4) {
        v4u av[4], bw[4]; size_t rows[4];
#pragma unroll
        for (int r = 0; r < 4; ++r) { const int rl = F.wave * 64 + (it + r) * 4 + (FLANE >> 4); rows[r] = (size_t)b * SEQ + (size_t)((rl < 256) ? pr : 7 - pr) * 256 + (rl & 255);
            const bf16* p = oatt + ((size_t)(b * 8 + 2 * h) * SEQ + (rows[r] - (size_t)b * SEQ)) * 128 + e0; av[r] = *(const GAS v4u*)p; bw[r] = *(const GAS v4u*)(p + (size_t)SEQ * 128); }
#pragma unroll
        for (int r = 0; r < 4; ++r) { const v4u a = av[r], bb = bw[r];
            float o[8];
            o[0] = bflo(a.x) - lam * bflo(bb.x); o[1] = bfhi(a.x) - lam * bfhi(bb.x); o[2] = bflo(a.y) - lam * bflo(bb.y); o[3] = bfhi(a.y) - lam * bfhi(bb.y);
            o[4] = bflo(a.z) - lam * bflo(bb.z); o[5] = bfhi(a.z) - lam * bfhi(bb.z); o[6] = bflo(a.w) - lam * bflo(bb.w); o[7] = bfhi(a.w) - lam * bfhi(bb.w);
            float s2 = 0.f;
#pragma unroll
            for (int j = 0; j < 8; ++j) s2 += o[j] * o[j];
            s2 += __shfl_xor(s2, 1); s2 += __shfl_xor(s2, 2); s2 += __shfl_xor(s2, 4); s2 += __shfl_xor(s2, 8);
            const float rs = 1.f / sqrtf(s2 * (1.f / 128.f) + LN_EPS);
            v4u w; w.x = pk2(o[0] * rs * gsc[0], o[1] * rs * gsc[1]); w.y = pk2(o[2] * rs * gsc[2], o[3] * rs * gsc[3]); w.z = pk2(o[4] * rs * gsc[4], o[5] * rs * gsc[5]); w.w = pk2(o[6] * rs * gsc[6], o[7] * rs * gsc[7]);
            *(GAS v4u*)(mix + rows[r] * DM + 512 + h * 128 + e0) = w; }
    }
}

__device__ __forceinline__ float dpp_shr1(float x) { return __builtin_bit_cast(float, __builtin_amdgcn_update_dpp(0, __builtin_bit_cast(int, x), 0x111, 0xf, 0xf, true)); }
__device__ __forceinline__ float dpp_shr2(float x) { return __builtin_bit_cast(float, __builtin_amdgcn_update_dpp(0, __builtin_bit_cast(int, x), 0x112, 0xf, 0xf, true)); }
__device__ __forceinline__ float dpp_shr4(float x) { return __builtin_bit_cast(float, __builtin_amdgcn_update_dpp(0, __builtin_bit_cast(int, x), 0x114, 0xf, 0xf, true)); }
__device__ __forceinline__ float dpp_shr8(float x) { return __builtin_bit_cast(float, __builtin_amdgcn_update_dpp(0, __builtin_bit_cast(int, x), 0x118, 0xf, 0xf, true)); }
__device__ __forceinline__ float dpp_shl15(float x) { return __builtin_bit_cast(float, __builtin_amdgcn_update_dpp(0, __builtin_bit_cast(int, x), 0x10f, 0xf, 0xf, true)); }
#define S5_DPP2(fn, v) ((f32x2){fn((v).x), fn((v).y)})
__device__ __forceinline__ float dpp_ror1(float x) { return __builtin_bit_cast(float, __builtin_amdgcn_update_dpp(0, __builtin_bit_cast(int, x), 0x121, 0xf, 0xf, true)); }
template <int hf>
__device__ __forceinline__ void s5_main(Frame& F, const bf16* ug, bf16* yb, const float* dsk, int g, int bh, LAS bf16* W2F, LAS bf16* W3F, LAS bf16* KT, LAS float* PW, int r, int q, int variant) {
        const int b = bh * 4 + (F.wave & 3);
        LAS bf16x8* XX = (LAS bf16x8*)(F.lds + 91648);
        const bf16* up = ug + ((size_t)g * MTOK + (size_t)b * SEQ) * 16;
        unsigned char* yp = (unsigned char*)yb + ((size_t)g * MTOK + (size_t)b * SEQ) * 16 + 4 * q;
        const f32x4 dk = *(const GAS f32x4*)(dsk + g * 16 + 4 * q);
        f32x4 E[4];
#pragma unroll
        for (int i = 0; i < 4; ++i) E[i] = (f32x4){0.f, 0.f, 0.f, 0.f};
        bf16x8 UFn[4], UF[4]; v2u UWn[4], UW[4];
#pragma unroll
        for (int sp = 0; sp < 4; ++sp) UFn[sp] = *(const GAS bf16x8*)(up + (size_t)(r * 8 + 2 * sp + (q >> 1)) * 16 + 8 * (q & 1));
#pragma unroll
        for (int t = 0; t < 4; ++t) UWn[t] = *(const GAS v2u*)(up + (size_t)(r * 8 + 4 * hf + t) * 16 + 4 * q);
#pragma unroll
        for (int sp = 0; sp < 4; ++sp) UF[sp] = UFn[sp];
#pragma unroll
        for (int t = 0; t < 4; ++t) UW[t] = UWn[t];
        f32x2 Pr[4][2][2], Pi[4][2][2];
#pragma unroll
        for (int i2 = 0; i2 < 2; ++i2) { const int rbp = 2 * hf + i2;
            const f32x4 a0 = *(const LAS f32x4*)(PW + (8 * 64 + 16 * rbp + 4 * q) * 2), a1 = *(const LAS f32x4*)(PW + (8 * 64 + 16 * rbp + 4 * q) * 2 + 4);
            Pr[0][i2][0] = (f32x2){a0[0], a0[2]}; Pi[0][i2][0] = (f32x2){a0[1], a0[3]}; Pr[0][i2][1] = (f32x2){a1[0], a1[2]}; Pi[0][i2][1] = (f32x2){a1[1], a1[3]};
#pragma unroll
            for (int k = 1; k < 4; ++k)
#pragma unroll
                for (int h = 0; h < 2; ++h) { const f32x2 pr = Pr[k - 1][i2][h], pi = Pi[k - 1][i2][h]; Pr[k][i2][h] = pr * pr - pi * pi; Pi[k][i2][h] = 2.0f * pr * pi; } }
        for (int cg = 0; cg < 16; ++cg) {
            const int tokbase = cg * 128 + r * 8;
            if (cg < 15) {
#pragma unroll
                for (int sp = 0; sp < 4; ++sp) UFn[sp] = *(const GAS bf16x8*)(up + (size_t)(tokbase + 128 + 2 * sp + (q >> 1)) * 16 + 8 * (q & 1));
#pragma unroll
                for (int t = 0; t < 4; ++t) UWn[t] = *(const GAS v2u*)(up + (size_t)(tokbase + 128 + 4 * hf + t) * 16 + 4 * q); }
            f32x2 Cr[2][2], Ci[2][2];
#pragma unroll
            for (int i2 = 0; i2 < 2; ++i2)
#pragma unroll
                for (int h = 0; h < 2; ++h) { const f32x2 er = h ? E[2 * i2].hi : E[2 * i2].lo, ei = h ? E[2 * i2 + 1].hi : E[2 * i2 + 1].lo; Cr[i2][h] = S5_DPP2(dpp_shl15, er); Ci[i2][h] = S5_DPP2(dpp_shl15, ei); }
#pragma unroll
            for (int i = 0; i < 4; ++i) E[i] = (f32x4){0.f, 0.f, 0.f, 0.f};
#pragma unroll
            for (int sp = 0; sp < 4; ++sp) {
#pragma unroll
                for (int i = 0; i < 4; ++i) E[i] = __builtin_amdgcn_mfma_f32_16x16x32_bf16(*(const LAS bf16x8*)(W2F + (((4 * hf + i) * 4 + sp) * 64 + FLANE) * 8), UF[sp], E[i], 0, 0, 0);
                asm volatile("" ::: "memory"); }
            bf16x8 XBf[4];
            LAS bf16x8* xx = XX + ((cg & 1) * 4 + (F.wave & 3)) * 256;
#pragma unroll
            for (int i2 = 0; i2 < 2; ++i2) { f32x2 xr[2], xi[2];
#pragma unroll
                for (int h = 0; h < 2; ++h) {
                    f32x2 er = h ? E[2 * i2].hi : E[2 * i2].lo, ei = h ? E[2 * i2 + 1].hi : E[2 * i2 + 1].lo; f32x2 sr, si, nr, ni;
                    nr = er + Pr[0][i2][h] * Cr[i2][h] - Pi[0][i2][h] * Ci[i2][h]; ni = ei + Pr[0][i2][h] * Ci[i2][h] + Pi[0][i2][h] * Cr[i2][h]; er = nr; ei = ni;
                    sr = S5_DPP2(dpp_shr1, er); si = S5_DPP2(dpp_shr1, ei); nr = er + Pr[0][i2][h] * sr - Pi[0][i2][h] * si; ni = ei + Pr[0][i2][h] * si + Pi[0][i2][h] * sr; er = nr; ei = ni;
                    sr = S5_DPP2(dpp_shr2, er); si = S5_DPP2(dpp_shr2, ei); nr = er + Pr[1][i2][h] * sr - Pi[1][i2][h] * si; ni = ei + Pr[1][i2][h] * si + Pi[1][i2][h] * sr; er = nr; ei = ni;
                    sr = S5_DPP2(dpp_shr4, er); si = S5_DPP2(dpp_shr4, ei); nr = er + Pr[2][i2][h] * sr - Pi[2][i2][h] * si; ni = ei + Pr[2][i2][h] * si + Pi[2][i2][h] * sr; er = nr; ei = ni;
                    sr = S5_DPP2(dpp_shr8, er); si = S5_DPP2(dpp_shr8, ei); nr = er + Pr[3][i2][h] * sr - Pi[3][i2][h] * si; ni = ei + Pr[3][i2][h] * si + Pi[3][i2][h] * sr; er = nr; ei = ni;
                    if (h) { E[2 * i2].hi = er; E[2 * i2 + 1].hi = ei; } else { E[2 * i2].lo = er; E[2 * i2 + 1].lo = ei; }
                    xr[h] = S5_DPP2(dpp_shr1, er) + Cr[i2][h]; xi[h] = S5_DPP2(dpp_shr1, ei) + Ci[i2][h]; }
                v4u w; w.x = pk2(xr[0].x, xr[0].y); w.y = pk2(xr[1].x, xr[1].y); w.z = pk2(xi[0].x, xi[0].y); w.w = pk2(xi[1].x, xi[1].y);
                XBf[2 * hf + i2] = __builtin_bit_cast(bf16x8, w); xx[(2 * hf + i2) * 64 + FLANE] = XBf[2 * hf + i2]; }
            LDS_WAIT(); __builtin_amdgcn_s_barrier(); asm volatile("" ::: "memory");
#pragma unroll
            for (int i2 = 0; i2 < 2; ++i2) XBf[2 * (1 - hf) + i2] = xx[(2 * (1 - hf) + i2) * 64 + FLANE];
            unsigned yout[4] = {0u, 0u, 0u, 0u};
            if (variant != 2) {
            f32x4 Y[4];
#pragma unroll
            for (int tt = 0; tt < 4; ++tt) Y[tt] = (f32x4){0.f, 0.f, 0.f, 0.f};
#pragma unroll
            for (int sp = 0; sp < 4; ++sp) {
#pragma unroll
                for (int tt = 0; tt < 4; ++tt) { const int t = 4 * hf + tt; if (sp <= (t >> 1)) { const int tau1 = t - 2 * sp - (q >> 1) + 1;
                    Y[tt] = __builtin_amdgcn_mfma_f32_16x16x32_bf16(*(const LAS bf16x8*)(KT + (tau1 * 16 + r) * 16 + 8 * (q & 1)), UF[sp], Y[tt], 0, 0, 0); } }
                asm volatile("" ::: "memory"); }
#pragma unroll
            for (int ks = 0; ks < 4; ++ks) {
#pragma unroll
                for (int tt = 0; tt < 4; ++tt) Y[tt] = __builtin_amdgcn_mfma_f32_16x16x32_bf16(*(const LAS bf16x8*)(W3F + (((4 * hf + tt) * 4 + ks) * 64 + FLANE) * 8), XBf[ks], Y[tt], 0, 0, 0);
                asm volatile("" ::: "memory"); }
#pragma unroll
            for (int tt = 0; tt < 4; ++tt) { const v2u uw = UW[tt];
                const f32x2 ya = gelu_tanh2(Y[tt].lo + dk.lo * (f32x2){bflo(uw.x), bfhi(uw.x)}, SA8), yb2 = gelu_tanh2(Y[tt].hi + dk.hi * (f32x2){bflo(uw.y), bfhi(uw.y)}, SA8);
                yout[tt] = pk4_fp8(ya.x, ya.y, yb2.x, yb2.y);
            } }
            if (cg < 15) {
#pragma unroll
                for (int sp = 0; sp < 4; ++sp) UF[sp] = UFn[sp];
#pragma unroll
                for (int t = 0; t < 4; ++t) UW[t] = UWn[t]; }
            asm volatile("" ::: "memory");
            { auto s01 = __builtin_amdgcn_permlane16_swap(yout[0], yout[1], false, false); auto s23 = __builtin_amdgcn_permlane16_swap(yout[2], yout[3], false, false);
              auto s02 = __builtin_amdgcn_permlane32_swap(s01[0], s23[0], false, false); auto s13 = __builtin_amdgcn_permlane32_swap(s01[1], s23[1], false, false);
              *(GAS v4u*)(yp - 4 * q + (size_t)(tokbase + 4 * hf + q) * 16) = (v4u){s02[0], s13[0], s02[1], s13[1]}; }
        }
}
__device__ __forceinline__ void ph_s5(Frame& F, const bf16* ug, bf16* yb, const float* log_dt, const float* lre, const float* lim, const float* bre, const float* bim,
                                      const float* cre, const float* cim, const float* dsk, int variant) {
    LAS bf16* W2F = (LAS bf16*)F.lds;
    LAS bf16* W3F = (LAS bf16*)(F.lds + 32768);
    LAS bf16* KT = (LAS bf16*)(F.lds + 65536);
    LAS float* PW = (LAS float*)(F.lds + 70144);
    LAS float* ZZ = (LAS float*)(F.lds + 74752);
    LAS float* BB = (LAS float*)(F.lds + 75264);
    LAS float* CC = (LAS float*)(F.lds + 83456);
    LAS bf16* W30 = (LAS bf16*)(F.lds + 124416);
    const int r = FLANE & 15, q = FLANE >> 4;
    for (int it = F.vcu; it < 256; it += F.G) {
        const int g = it & 63, bh = it >> 6;
        __syncthreads();
        if (FTID < 64) { const int p = FTID; const float dt = expf(log_dt[g]), lr = lre[g * 64 + p], li = lim[g * 64 + p];
            const float mg = expf(lr * dt), ar = mg * cosf(li * dt), ai = mg * sinf(li * dt), den = lr * lr + li * li;
            float pr = 1.f, pi = 0.f;
            for (int n = 0; n < 9; ++n) { PW[(n * 64 + p) * 2] = pr; PW[(n * 64 + p) * 2 + 1] = pi; const float t2 = pr * ar - pi * ai; pi = pr * ai + pi * ar; pr = t2; }
            ZZ[p * 2] = ((ar - 1.0f) * lr + ai * li) / den; ZZ[p * 2 + 1] = (ai * lr - (ar - 1.0f) * li) / den; }
        __syncthreads();
        for (int idx = FTID; idx < 1024; idx += 512) {
            { const int p = idx >> 4; const float br = bre[(size_t)g * 1024 + idx], bi = bim[(size_t)g * 1024 + idx], zr = ZZ[p * 2], zi = ZZ[p * 2 + 1];
              BB[idx * 2] = zr * br - zi * bi; BB[idx * 2 + 1] = zr * bi + zi * br; }
            { CC[idx * 2] = cre[(size_t)g * 1024 + idx]; CC[idx * 2 + 1] = cim[(size_t)g * 1024 + idx]; }
        }
        if (FTID < 256) KT[FTID] = 0;
        __syncthreads();
        for (int idx = FTID; idx < 2048; idx += 512) {
            { const int t = idx >> 8, ks = (idx >> 6) & 3, ln = idx & 63, c = ln & 15, qq = ln >> 4; unsigned w[4];
#pragma unroll
              for (int j = 0; j < 4; ++j) { const int p = 16 * ks + 4 * qq + j; const float cr_ = CC[(c * 64 + p) * 2], ci_ = CC[(c * 64 + p) * 2 + 1], pr = PW[((t + 1) * 64 + p) * 2], pi = PW[((t + 1) * 64 + p) * 2 + 1];
                  const float gr = cr_ * pr - ci_ * pi, gi = cr_ * pi + ci_ * pr;
                  if (j & 1) { w[j >> 1] |= f2bf(gr) << 16; w[2 + (j >> 1)] |= f2bf(-gi) << 16; } else { w[j >> 1] = f2bf(gr); w[2 + (j >> 1)] = f2bf(-gi); } }
              *(LAS v4u*)(W3F + (size_t)idx * 8) = (v4u){w[0], w[1], w[2], w[3]}; }
            { const int rb = idx >> 8, sp = (idx >> 6) & 3, ln = idx & 63, rr = ln & 15, qq = ln >> 4, p = 16 * (rb >> 1) + rr, s = 2 * sp + (qq >> 1), c0 = 8 * (qq & 1); unsigned w[4];
              const float pr = PW[((7 - s) * 64 + p) * 2], pi = PW[((7 - s) * 64 + p) * 2 + 1];
#pragma unroll
              for (int j = 0; j < 8; ++j) { const float br = BB[(p * 16 + c0 + j) * 2], bi = BB[(p * 16 + c0 + j) * 2 + 1]; const float v = (rb & 1) ? (pr * bi + pi * br) : (pr * br - pi * bi);
                  if (j & 1) w[j >> 1] |= f2bf(v) << 16; else w[j >> 1] = f2bf(v); }
              *(LAS v4u*)(W2F + (size_t)idx * 8) = (v4u){w[0], w[1], w[2], w[3]}; }
        }
        if (FTID < 256) { const int ks = FTID >> 6, ln = FTID & 63, c = ln & 15, qq = ln >> 4; unsigned w[4];
#pragma unroll
            for (int j = 0; j < 4; ++j) { const int p = 16 * ks + 4 * qq + j; const float gr = CC[(c * 64 + p) * 2], gi = CC[(c * 64 + p) * 2 + 1];
                if (j & 1) { w[j >> 1] |= f2bf(gr) << 16; w[2 + (j >> 1)] |= f2bf(-gi) << 16; } else { w[j >> 1] = f2bf(gr); w[2 + (j >> 1)] = f2bf(-gi); } }
            *(LAS v4u*)(W30 + (size_t)FTID * 8) = (v4u){w[0], w[1], w[2], w[3]}; }
        __syncthreads();
        {
            f32x4 kacc = (f32x4){0.f, 0.f, 0.f, 0.f}; const int tau = F.wave;
#pragma unroll
            for (int ks = 0; ks < 4; ++ks) { unsigned w[4];
#pragma unroll
                for (int j = 0; j < 4; ++j) { const int p = 16 * ks + 4 * q + j; const float br = BB[(p * 16 + r) * 2], bi = BB[(p * 16 + r) * 2 + 1];
                    if (j & 1) { w[j >> 1] |= f2bf(br) << 16; w[2 + (j >> 1)] |= f2bf(bi) << 16; } else { w[j >> 1] = f2bf(br); w[2 + (j >> 1)] = f2bf(bi); } }
                const v4u wb = (v4u){w[0], w[1], w[2], w[3]};
                const bf16x8 af = tau == 0 ? *(const LAS bf16x8*)(W30 + (ks * 64 + FLANE) * 8) : *(const LAS bf16x8*)(W3F + (((tau - 1) * 4 + ks) * 64 + FLANE) * 8);
                kacc = __builtin_amdgcn_mfma_f32_16x16x32_bf16(af, __builtin_bit_cast(bf16x8, wb), kacc, 0, 0, 0); }
#pragma unroll
            for (int k = 0; k < 4; ++k) KT[(tau + 1) * 256 + (4 * q + k) * 16 + r] = (bf16)f2bf(kacc[k]); }
        __syncthreads();
        if (variant != 1) { if ((F.wave >> 2) == 0) s5_main<0>(F, ug, yb, dsk, g, bh, W2F, W3F, KT, PW, r, q, variant); else s5_main<1>(F, ug, yb, dsk, g, bh, W2F, W3F, KT, PW, r, q, variant); }
    }
}

struct PlainSched {
    pg8::TileOrder T; const char* A; const char* B; int tilesPerBatch; size_t bBatch; int splitN; size_t aT = pg8::TSTEP, bT = pg8::TSTEP;
    int pnAdd = 0, pnSkipFrom = 1 << 20, pnSkip = 0;
    __device__ __forceinline__ bool next(int i, pg8::Unit& u) const {
        int pm, pn; if (!T.get(i, pm, pn)) return false;
        pn += pnAdd + (pn >= pnSkipFrom ? pnSkip : 0);
        const int z = pm / tilesPerBatch;
        u.a = A + (size_t)pm * aT; u.b = B + (size_t)z * bBatch + (size_t)pn * bT; u.row0 = pm * 256; u.col0 = pn * 256; u.z = z; u.aux = 0;
        if (splitN) { u.z = pn >= splitN; u.col0 = (pn >= splitN ? pn - splitN : pn) * 256; }
        return true;
    }
};
struct FoldSched {
    int G, c, first; const char* KB; const char* VB; const char* XQ; const char* XOT;
    __device__ __forceinline__ bool next(int i, pg8::Unit& u) const {
        const int idx = i * G + c - first; if (idx < 0 || idx >= 512) return false;
        const int type = idx >> 8, j = idx & 255, b = j >> 4, h = (j >> 2) & 3, t = j & 3;
        if (type == 0) { u.a = KB + (size_t)b * 256 * 2048 + h * 512; u.b = XQ + (size_t)t * pg8::TSTEP + h * 512; u.row0 = b * 1024 + h * 256; u.col0 = t * 256; u.z = 0; }
        else { u.a = XOT + (size_t)t * pg8::TSTEP + h * 512; u.b = VB + (size_t)b * 256 * 2048 + h * 512; u.row0 = b * 1024 + t * 256; u.col0 = h * 256; u.z = 1; }
        u.aux = 0; return true;
    }
};
struct MoeSched {
    LAS const int* tab; int NT, G, c; const char* A; const char* B; size_t bExp; int colw; const int* list; bool gather; size_t tileB;
    __device__ __forceinline__ bool next(int i, pg8::Unit& u) const {
        const int nblk = __builtin_amdgcn_readfirstlane(tab[64]);
        const int x = c >> 5, r = c & 31; int mbl, pn;
        if (G != 256 || NT != 8) { mbl = c / NT; pn = c % NT; } else { pn = 4 * (x & 1) + (r & 3); mbl = 8 * (x >> 1) + (r >> 2); }
        const int mbg = i * (G / NT) + mbl; if (mbg >= nblk) return false;
        const int lane = opaque_tid() & 63; const int v = (lane <= 32) ? tab[32 + lane] : 0x7fffffff;
        const int e = __popcll(__ballot(v <= mbg)) - 1;
        const int mb = mbg - __builtin_amdgcn_readfirstlane(tab[32 + e]);
        u.a = gather ? A : A + (size_t)mbg * tileB; u.b = B + (size_t)e * bExp + (size_t)pn * tileB;
        u.row0 = mbg * 256; u.col0 = pn * colw; u.z = e; u.aux = mb; return true;
    }
    __device__ __forceinline__ const int* rows(const pg8::Unit& u) const { return list + (size_t)u.z * CAP + u.aux * 256; }
    __device__ __forceinline__ static int rowmap(int v) { return (int)(((unsigned)v >> 2) & (unsigned)(MTOK - 1)); }
};

__device__ __forceinline__ void store_rowpair16(unsigned char* base, size_t rowA, size_t rowB, int colp, int fq, v2u a, v2u b, size_t pitch = DM) {
    const auto sx = __builtin_amdgcn_permlane16_swap(a.x, b.x, false, false); const auto sy = __builtin_amdgcn_permlane16_swap(a.y, b.y, false, false);
    *(GAS v4u*)(base + ((fq & 1) ? rowB : rowA) * pitch + colp) = (v4u){sx[0], sy[0], sx[1], sy[1]}; }
#define ST8_ROWPAIR(basep, rowcur, colp, hold, w, pitch) do { if ((m & 1) == 0) (hold) = (w); else store_rowpair16((unsigned char*)(basep), (size_t)(rowcur) - 16, (size_t)(rowcur), (colp), fq, (hold), (w), (pitch)); } while (0)
#define EPI_ROWS_BEGIN _Pragma("unroll") for (int ai = 0; ai < 2; ++ai) _Pragma("unroll") for (int m = 0; m < 4; ++m) { const int rloc = ai * 128 + wr * 64 + m * 16 + fr;
#define EPI_ROWS_END }
__device__ __forceinline__ v4u pack8(f32x4 v0, f32x4 v1) { v4u w; w.x = pg8::cvt_pk_bf16(v0[0], v0[1]); w.y = pg8::cvt_pk_bf16(v0[2], v0[3]); w.z = pg8::cvt_pk_bf16(v1[0], v1[1]); w.w = pg8::cvt_pk_bf16(v1[2], v1[3]); return w; }
__device__ __forceinline__ void unpack8(v4u w, f32x4& a, f32x4& b) { a = (f32x4){bflo(w.x), bfhi(w.x), bflo(w.y), bfhi(w.y)}; b = (f32x4){bflo(w.z), bfhi(w.z), bflo(w.w), bfhi(w.w)}; }
__device__ __forceinline__ void rowpair_publish(LAS float* tab, float* dst, int nslot, int slot, int row0, const float (&ss)[8], const float (&qq)[8], int wr, int wc, int fr, int fq) {
    if (fq == 0) {
#pragma unroll
        for (int i = 0; i < 8; ++i) { const int rl = (i >> 2) * 128 + wr * 64 + (i & 3) * 16 + fr; tab[(rl * 4 + wc) * 2] = ss[i]; tab[(rl * 4 + wc) * 2 + 1] = qq[i]; } }
    LDS_WAIT(); __builtin_amdgcn_s_barrier(); asm volatile("" ::: "memory");
    { const int t = opaque_tid(), row = t >> 1, which = t & 1;
      const float v = (tab[(row * 4 + 0) * 2 + which] + tab[(row * 4 + 1) * 2 + which]) + (tab[(row * 4 + 2) * 2 + which] + tab[(row * 4 + 3) * 2 + which]);
      dst[((size_t)(row0 + row) * nslot + slot) * 2 + which] = v; }
    LDS_WAIT(); __builtin_amdgcn_s_barrier(); asm volatile("" ::: "memory");
}
__device__ __forceinline__ void ln_tables(LAS float* tabR, LAS float* tabC, const float* st, int nslot, int row0, const float* sc, int scrow0, const float* v0, const float* v1, int col0) {
    const int t = opaque_tid();
    if (t < 256) { const float* p = st + (size_t)(row0 + t) * 16; float s = 0.f, q = 0.f;
        for (int k = 0; k < nslot; ++k) { s += p[2 * k]; q += p[2 * k + 1]; }
        const float mu = s * (1.f / DM); tabR[2 * t] = mu; tabR[2 * t + 1] = 1.f / sqrtf(fmaxf(q * (1.f / DM) - mu * mu, 0.f) + LN_EPS); }
    else { const int c = t - 256;
        if (sc) { const f32x4 a = *(const GAS f32x4*)(sc + (size_t)(scrow0 + c) * 8), b = *(const GAS f32x4*)(sc + (size_t)(scrow0 + c) * 8 + 4);
            tabC[c] = (a[0] + a[2]) + (b[0] + b[2]); tabC[256 + c] = (a[1] + a[3]) + (b[1] + b[3]); }
        else { tabC[c] = v0[col0 + c]; tabC[256 + c] = v1[col0 + c]; } }
    LDS_WAIT(); __builtin_amdgcn_s_barrier(); asm volatile("" ::: "memory");
}
struct EpiResidStats { const bf16* xb; bf16* zb; unsigned char* z8; float* st; LAS float* tab;
    __device__ __forceinline__ void operator()(EPI_ARGS) const {
        int frq_ = fr | (fq << 8); asm volatile("" : "+v"(frq_));
        const int fr_ = frq_ & 255, fq_ = frq_ >> 8;
        { const int fr = fr_, fq = fq_;
        float ss[8], qq[8]; v4u xr[2][4][2];
        EPI_ROWS_BEGIN const size_t off = (size_t)(u.row0 + rloc) * DM + u.col0 + wc * 32 + 8 * fq; xr[ai][m][0] = *(const GAS v4u*)(xb + off); xr[ai][m][1] = *(const GAS v4u*)(xb + off + 128); EPI_ROWS_END
        EPI_ROWS_BEGIN const size_t off = (size_t)(u.row0 + rloc) * DM + u.col0 + wc * 32 + 8 * fq; float s = 0.f, q = 0.f;
#pragma unroll
            for (int bj = 0; bj < 2; ++bj) { f32x4 x0, x1; unpack8(xr[ai][m][bj], x0, x1);
                const f32x4 z0 = x0 * ALPHA + acc[ai][bj][m][0], z1 = x1 * ALPHA + acc[ai][bj][m][1];
                *(GAS v4u*)(zb + off + bj * 128) = pack8(z0, z1);
                v2u w; w.x = pk4_fp8(z0[0] * SZ8, z0[1] * SZ8, z0[2] * SZ8, z0[3] * SZ8); w.y = pk4_fp8(z1[0] * SZ8, z1[1] * SZ8, z1[2] * SZ8, z1[3] * SZ8); *(GAS v2u*)(z8 + off + bj * 128) = w;
                s += ((z0[0] + z0[1]) + (z0[2] + z0[3])) + ((z1[0] + z1[1]) + (z1[2] + z1[3])); q += ((z0[0] * z0[0] + z0[1] * z0[1]) + (z0[2] * z0[2] + z0[3] * z0[3])) + ((z1[0] * z1[0] + z1[1] * z1[1]) + (z1[2] * z1[2] + z1[3] * z1[3])); }
            s += __shfl_xor(s, 16); s += __shfl_xor(s, 32); q += __shfl_xor(q, 16); q += __shfl_xor(q, 32); ss[ai * 4 + m] = s; qq[ai * 4 + m] = q; EPI_ROWS_END
        rowpair_publish(tab, st, 8, u.col0 >> 8, u.row0, ss, qq, wr, wc, fr, fq); }
    } };
struct EpiResidLN { bf16* zb; float rs; const float* st; LAS float* tab; const float* g; const float* b; int nslot;
    __device__ __forceinline__ void operator()(EPI_ARGS) const {
        LAS float* tabC = tab + 512; ln_tables(tab, tabC, st, nslot, u.row0, nullptr, 0, g, b, u.col0);
        const int c8 = u.col0 + wc * 32 + 8 * fq, cl = wc * 32 + 8 * fq; v4u zr[2][4][2];
        EPI_ROWS_BEGIN const size_t off = (size_t)(u.row0 + rloc) * DM + c8; zr[ai][m][0] = *(const GAS v4u*)(zb + off); zr[ai][m][1] = *(const GAS v4u*)(zb + off + 128); EPI_ROWS_END
        EPI_ROWS_BEGIN const size_t off = (size_t)(u.row0 + rloc) * DM + c8; const float mu = tab[2 * rloc], rstd = tab[2 * rloc + 1];
#pragma unroll
            for (int bj = 0; bj < 2; ++bj) { f32x4 x0, x1; unpack8(zr[ai][m][bj], x0, x1);
                const f32x4 g0 = *(const LAS f32x4*)(tabC + cl + bj * 128), g1 = *(const LAS f32x4*)(tabC + cl + bj * 128 + 4), b0 = *(const LAS f32x4*)(tabC + 256 + cl + bj * 128), b1 = *(const LAS f32x4*)(tabC + 256 + cl + bj * 128 + 4);
                x0 = (x0 - mu) * rstd * g0 + b0; x1 = (x1 - mu) * rstd * g1 + b1;
                *(GAS v4u*)(zb + off + bj * 128) = pack8(x0 * ALPHA + acc[ai][bj][m][0] * rs, x1 * ALPHA + acc[ai][bj][m][1] * rs); } EPI_ROWS_END
        LDS_WAIT(); __builtin_amdgcn_s_barrier(); asm volatile("" ::: "memory");
    } };
struct EpiFold { unsigned char* kft; unsigned char* vft; const float* g; const float* b; float* sc; LAS float* tab;
    __device__ __forceinline__ void operator()(EPI_ARGS) const {
        if (u.z) {
            v2u hold8[2];
            EPI_ROWS_BEGIN
#pragma unroll
                for (int bj = 0; bj < 2; ++bj) { const f32x4 v0 = acc[ai][bj][m][0] * SV8, v1 = acc[ai][bj][m][1] * SV8; v2u w; w.x = pk4_fp8(v0[0], v0[1], v0[2], v0[3]); w.y = pk4_fp8(v1[0], v1[1], v1[2], v1[3]); ST8_ROWPAIR(vft, u.row0 + rloc, u.col0 + wc * 32 + 8 * (fq & 2) + bj * 128, hold8[bj], w, 1024); } EPI_ROWS_END
            return; }
        float ss[8], qq[8]; const int c8 = u.col0 + wc * 32 + 8 * fq, cl = wc * 32 + 8 * fq; LAS float* tabC = tab + 2048;
        { const int t = opaque_tid(); if (t < 256) tabC[t] = g[u.col0 + t] * CSC; else tabC[t] = b[u.col0 + t - 256] * CSC; }
        LDS_WAIT(); __builtin_amdgcn_s_barrier(); asm volatile("" ::: "memory");
        v2u hold8[2];
        EPI_ROWS_BEGIN float s = 0.f, q = 0.f;
#pragma unroll
            for (int bj = 0; bj < 2; ++bj) { const f32x4 g0 = *(const LAS f32x4*)(tabC + cl + bj * 128), g1 = *(const LAS f32x4*)(tabC + cl + bj * 128 + 4), b0 = *(const LAS f32x4*)(tabC + 256 + cl + bj * 128), b1 = *(const LAS f32x4*)(tabC + 256 + cl + bj * 128 + 4);
                const f32x4 k0 = acc[ai][bj][m][0] * g0, k1 = acc[ai][bj][m][1] * g1, c0 = acc[ai][bj][m][0] * b0, c1 = acc[ai][bj][m][1] * b1;
                s += ((k0[0] + k0[1]) + (k0[2] + k0[3])) + ((k1[0] + k1[1]) + (k1[2] + k1[3])); q += ((c0[0] + c0[1]) + (c0[2] + c0[3])) + ((c1[0] + c1[1]) + (c1[2] + c1[3]));
                v2u w; w.x = pk4_fp8(k0[0] * SK8, k0[1] * SK8, k0[2] * SK8, k0[3] * SK8); w.y = pk4_fp8(k1[0] * SK8, k1[1] * SK8, k1[2] * SK8, k1[3] * SK8); ST8_ROWPAIR(kft, u.row0 + rloc, u.col0 + wc * 32 + 8 * (fq & 2) + bj * 128, hold8[bj], w, 1024); }
            s += __shfl_xor(s, 16); s += __shfl_xor(s, 32); q += __shfl_xor(q, 16); q += __shfl_xor(q, 32); ss[ai * 4 + m] = s; qq[ai * 4 + m] = q; EPI_ROWS_END
        rowpair_publish(tab, sc, 4, u.col0 >> 8, u.row0, ss, qq, wr, wc, fr, fq);
    } };
struct EpiStore { bf16* base0; bf16* base1; float s0, s1; int ldc; int f8mask = 0;
    __device__ __forceinline__ void operator()(EPI_ARGS) const {
        bf16* base = u.z ? base1 : base0; const float sc = u.z ? s1 : s0;
        if ((f8mask >> (u.z ? 1 : 0)) & 1) { unsigned char* b8 = (unsigned char*)base;
            v2u hold8[2];
            EPI_ROWS_BEGIN
#pragma unroll
                for (int bj = 0; bj < 2; ++bj) { const f32x4 v0 = acc[ai][bj][m][0] * sc, v1 = acc[ai][bj][m][1] * sc; v2u w; w.x = pk4_fp8(v0[0], v0[1], v0[2], v0[3]); w.y = pk4_fp8(v1[0], v1[1], v1[2], v1[3]); ST8_ROWPAIR(b8, u.row0 + rloc, u.col0 + wc * 32 + 8 * (fq & 2) + bj * 128, hold8[bj], w, (size_t)ldc); } EPI_ROWS_END
            return; }
        EPI_ROWS_BEGIN bf16* rowp = base + (size_t)(u.row0 + rloc) * ldc + u.col0 + wc * 32 + 8 * fq;
#pragma unroll
            for (int bj = 0; bj < 2; ++bj) *(GAS v4u*)(rowp + bj * 128) = pack8(acc[ai][bj][m][0] * sc, acc[ai][bj][m][1] * sc); EPI_ROWS_END
    } };
struct EpiH0 { bf16* uv; bf16* qx; bf16* kx; bf16* vx; float rs;
    __device__ __forceinline__ void operator()(EPI_ARGS) const {
        const int pn = u.col0 >> 8, kind = pn < 4 ? 0 : ((pn - 4) >> 1) + 1;
        bf16* base = kind == 0 ? uv : kind == 1 ? qx : kind == 2 ? kx : vx;
        int frq_ = fr | (fq << 8); asm volatile("" : "+v"(frq_));
        { const int fr = frq_ & 255, fq = frq_ >> 8;
        EPI_ROWS_BEGIN bf16* rowp = base + (size_t)(u.row0 + rloc) * DM;
#pragma unroll
            for (int bj = 0; bj < 2; ++bj) { f32x4 v0 = acc[ai][bj][m][0] * rs, v1 = acc[ai][bj][m][1] * rs;
                if (kind == 0) {
#pragma unroll
                    for (int j = 0; j < 1; ++j) { v0.lo = gelu_tanh2(v0.lo, 1.0f); v0.hi = gelu_tanh2(v0.hi, 1.0f); v1.lo = gelu_tanh2(v1.lo, 1.0f); v1.hi = gelu_tanh2(v1.hi, 1.0f); }
                    *(GAS v4u*)(rowp + u.col0 + bj * 128 + wc * 32 + 8 * fq) = pack8(v0, v1); }
                else { const int cr = ((pn - 4) & 1) * 256 + bj * 128 + wc * 32 + 8 * fq, row = u.row0 + rloc, bb = row >> 11, ss = row & 2047;
                    const v4u pk = pack8(v0, v1);
                    if (kind == 3) { const int hh = cr >> 7, dv = cr & 127; *(GAS v4u*)(base + ((size_t)(bb * 4 + hh) * SEQ + ss) * 128 + dv) = pk; }
                    else { *(GAS v4u*)(base + ((size_t)(bb * 8 + (cr >> 6)) * SEQ + ss) * 64 + (cr & 63)) = pk; } } } EPI_ROWS_END }
    } };
struct EpiResid { const bf16* xb; bf16* zb; float rs = 1.0f;
    __device__ __forceinline__ void operator()(EPI_ARGS) const {
        EPI_ROWS_BEGIN const size_t off = (size_t)(u.row0 + rloc) * DM + u.col0 + wc * 32 + 8 * fq;
#pragma unroll
            for (int bj = 0; bj < 2; ++bj) { f32x4 x0, x1; unpack8(*(const GAS v4u*)(xb + off + bj * 128), x0, x1);
                *(GAS v4u*)(zb + off + bj * 128) = pack8(x0 * ALPHA + acc[ai][bj][m][0] * rs, x1 * ALPHA + acc[ai][bj][m][1] * rs); } EPI_ROWS_END
    } };
struct EpiUG { bf16* ug; float rs;
    __device__ __forceinline__ void operator()(EPI_ARGS) const {
        EPI_ROWS_BEGIN
#pragma unroll
            for (int bj = 0; bj < 2; ++bj) { const int col = u.col0 + bj * 128 + wc * 32 + 8 * fq;
                *(GAS v4u*)(ug + ((size_t)(col >> 4) * MTOK + (u.row0 + rloc)) * 16 + (col & 15)) = pack8(acc[ai][bj][m][0] * rs, acc[ai][bj][m][1] * rs); } EPI_ROWS_END
    } };
struct EpiScore { float* sc;
    __device__ __forceinline__ void operator()(EPI_ARGS) const {
        EPI_ROWS_BEGIN float* rowp = sc + (size_t)(u.row0 + rloc) * DM + u.col0 + wc * 32 + 8 * fq;
#pragma unroll
            for (int bj = 0; bj < 2; ++bj) { *(GAS f32x4*)(rowp + bj * 128) = acc[ai][bj][m][0]; *(GAS f32x4*)(rowp + bj * 128 + 4) = acc[ai][bj][m][1]; } EPI_ROWS_END
    } };
struct EpiSoftmaxP { bf16* P; LAS float* tab; float rs0; const float* st; const float* sc; int nslot;
    __device__ __forceinline__ void operator()(EPI_ARGS) const {
        { auto& A = const_cast<f32x4 (&)[2][2][4][2]>(acc); LAS float* tabC = tab + 512; ln_tables(tab, tabC, st, nslot, u.row0, sc, u.z * 1024 + u.col0, nullptr, nullptr, 0);
          const int cl = wc * 32 + 8 * fq;
          EPI_ROWS_BEGIN const float mu = tab[2 * rloc], rstd = tab[2 * rloc + 1];
#pragma unroll
              for (int bj = 0; bj < 2; ++bj)
#pragma unroll
                  for (int n = 0; n < 2; ++n) { const f32x4 s1 = *(const LAS f32x4*)(tabC + cl + bj * 128 + 4 * n), c1 = *(const LAS f32x4*)(tabC + 256 + cl + bj * 128 + 4 * n);
                      A[ai][bj][m][n] = (A[ai][bj][m][n] * rs0 - s1 * mu) * rstd + c1; } EPI_ROWS_END
          LDS_WAIT(); __builtin_amdgcn_s_barrier(); asm volatile("" ::: "memory"); }
        constexpr float rs = 1.0f; auto& A2 = const_cast<f32x4 (&)[2][2][4][2]>(acc);
        EPI_ROWS_BEGIN float mx = -3.0e38f;
#pragma unroll
            for (int bj = 0; bj < 2; ++bj)
#pragma unroll
                for (int n = 0; n < 2; ++n)
#pragma unroll
                    for (int j = 0; j < 4; ++j) mx = fmaxf(mx, acc[ai][bj][m][n][j]);
            mx *= rs; mx = fmaxf(mx, __shfl_xor(mx, 16)); mx = fmaxf(mx, __shfl_xor(mx, 32));
            float sm = 0.f;
#pragma unroll
            for (int bj = 0; bj < 2; ++bj)
#pragma unroll
                for (int n = 0; n < 2; ++n)
#pragma unroll
                    for (int j = 0; j < 4; ++j) { const float p = __builtin_amdgcn_exp2f(acc[ai][bj][m][n][j] * rs - mx); A2[ai][bj][m][n][j] = p; sm += p; }
            sm += __shfl_xor(sm, 16); sm += __shfl_xor(sm, 32);
            if (fq == 0) { tab[(rloc * 4 + wc) * 2] = mx; tab[(rloc * 4 + wc) * 2 + 1] = sm; } EPI_ROWS_END
        LDS_WAIT(); __builtin_amdgcn_s_barrier(); asm volatile("" ::: "memory");
        v2u holdP[2];
        EPI_ROWS_BEGIN const f32x4 a = *(const LAS f32x4*)(tab + rloc * 8), b = *(const LAS f32x4*)(tab + rloc * 8 + 4);
            const float M = fmaxf(fmaxf(a[0], a[2]), fmaxf(b[0], b[2]));
            const float S = a[1] * __builtin_amdgcn_exp2f(a[0] - M) + a[3] * __builtin_amdgcn_exp2f(a[2] - M) + b[1] * __builtin_amdgcn_exp2f(b[0] - M) + b[3] * __builtin_amdgcn_exp2f(b[2] - M);
            const float mown = wc == 0 ? a[0] : wc == 1 ? a[2] : wc == 2 ? b[0] : b[2];
            const float inv = SP8 / S * __builtin_amdgcn_exp2f(mown - M);
#pragma unroll
            for (int bj = 0; bj < 2; ++bj) { const f32x4 v0 = acc[ai][bj][m][0] * inv, v1 = acc[ai][bj][m][1] * inv;
                v2u w; w.x = pk4_fp8(v0[0], v0[1], v0[2], v0[3]); w.y = pk4_fp8(v1[0], v1[1], v1[2], v1[3]); ST8_ROWPAIR(P, u.row0 + rloc, u.col0 + wc * 32 + 8 * (fq & 2) + bj * 128, holdP[bj], w, DM); } EPI_ROWS_END
        LDS_WAIT(); __builtin_amdgcn_s_barrier(); asm volatile("" ::: "memory");
    } };
struct EpiRouter { float* logit;
    __device__ __forceinline__ void operator()(EPI_ARGS) const {
        if (wc == 0) { EPI_ROWS_BEGIN float* rowp = logit + (size_t)(u.row0 + rloc) * 32 + 8 * fq; *(GAS f32x4*)(rowp) = acc[ai][0][m][0]; *(GAS f32x4*)(rowp + 4) = acc[ai][0][m][1]; EPI_ROWS_END }
    } };
struct EpiSwiglu { const float* bup; bf16* act;
    __device__ __forceinline__ void operator()(EPI_ARGS) const {
        const int j0 = u.col0 + wc * 32 + 8 * fq; const float* bb = bup + (size_t)u.z * 2048;
        const f32x4 bg0 = *(const GAS f32x4*)(bb + j0), bg1 = *(const GAS f32x4*)(bb + j0 + 4), bl0 = *(const GAS f32x4*)(bb + 1024 + j0), bl1 = *(const GAS f32x4*)(bb + 1024 + j0 + 4);
        EPI_ROWS_BEGIN f32x4 o0, o1;
#pragma unroll
            for (int j = 0; j < 4; ++j) {
                { const float gl = fminf(acc[ai][0][m][0][j] + bg0[j], 7.0f), ln = fminf(fmaxf(acc[ai][1][m][0][j] + bl0[j], -7.0f), 7.0f); o0[j] = gl * sigmoidf_(1.702f * gl) * (ln + 1.0f); }
                { const float gl = fminf(acc[ai][0][m][1][j] + bg1[j], 7.0f), ln = fminf(fmaxf(acc[ai][1][m][1][j] + bl1[j], -7.0f), 7.0f); o1[j] = gl * sigmoidf_(1.702f * gl) * (ln + 1.0f); } }
            *(GAS v4u*)(act + (size_t)(u.row0 + rloc) * DM + j0) = pack8(o0, o1); EPI_ROWS_END
    } };
struct EpiDown { const float* bdn; const int* list; const float* gate; bf16* ys; LAS const int* tab;
    __device__ __forceinline__ void operator()(EPI_ARGS) const {
        const int e = u.z, cnt = tab[e], c8 = u.col0 + wc * 32 + 8 * fq; const float* bb = bdn + (size_t)e * 1024 + c8;
        f32x4 bv[2][2];
#pragma unroll
        for (int bj = 0; bj < 2; ++bj) { bv[bj][0] = *(const GAS f32x4*)(bb + bj * 128); bv[bj][1] = *(const GAS f32x4*)(bb + bj * 128 + 4); }
        int av[8]; float gv[8];
#pragma unroll
        for (int i = 0; i < 8; ++i) { const int slot = u.aux * 256 + (i >> 2) * 128 + wr * 64 + (i & 3) * 16 + fr; const int sl = slot < cnt ? slot : 0;
            av[i] = (int)((unsigned)list[(size_t)e * CAP + sl] & (unsigned)(NASSIGN - 1)); }
#pragma unroll
        for (int i = 0; i < 8; ++i) gv[i] = gate[av[i]];
        EPI_ROWS_BEGIN const int slot = u.aux * 256 + rloc; const int a = av[ai * 4 + m]; const float gt = gv[ai * 4 + m]; bf16* rowp = ys + (size_t)a * DM + c8;
            if (slot < cnt) {
#pragma unroll
                for (int bj = 0; bj < 2; ++bj) *(GAS v4u*)(rowp + bj * 128) = pack8((acc[ai][bj][m][0] + bv[bj][0]) * gt, (acc[ai][bj][m][1] + bv[bj][1]) * gt); } EPI_ROWS_END
    } };
struct EpiSwiglu8 { const float* bup; unsigned char* act; int skip; LAS float* slot;
    static constexpr bool HAS_PRE = true;
    __device__ __forceinline__ void pre(const pg8::Unit& u, int wid, int lane) const {
        if (wid < 4) { const int t = wid * 64 + lane; const float* src = bup + (size_t)u.z * 2048 + u.col0 + (t < 128 ? t : 1024 + t - 128);
            __builtin_amdgcn_global_load_lds((const unsigned*)src, (LAS unsigned*)(slot + u.par * 256 + wid * 64), 4, 0, 0); } }
    __device__ __forceinline__ void operator()(EPI_ARGS) const {
        if (skip) {
#pragma unroll
            for (int a = 0; a < 2; ++a)
#pragma unroll
                for (int b = 0; b < 2; ++b)
#pragma unroll
                    for (int m = 0; m < 4; ++m) asm volatile("" :: "v"(acc[a][b][m][0]), "v"(acc[a][b][m][1])); return; }
        const int j0 = u.col0 + wc * 32 + 8 * fq; constexpr float RS = 1.0f / (SX8 * SWU8); const LAS float* sb = slot + u.par * 256 + wc * 32 + 8 * fq;
        const f32x4 bg0 = *(const LAS f32x4*)(sb), bg1 = *(const LAS f32x4*)(sb + 4), bl0 = *(const LAS f32x4*)(sb + 128), bl1 = *(const LAS f32x4*)(sb + 132);
        typedef float f32x2 __attribute__((ext_vector_type(2)));
        v2u wq[2][4];
        EPI_ROWS_BEGIN f32x4 o0, o1;
#pragma unroll
            for (int n = 0; n < 2; ++n)
#pragma unroll
                for (int h = 0; h < 2; ++h) {
                    const f32x4 ga = acc[ai][0][m][n], la = acc[ai][1][m][n], bgv = n ? bg1 : bg0, blv = n ? bl1 : bl0;
                    const f32x2 g2 = h ? ga.hi : ga.lo, l2 = h ? la.hi : la.lo, bg2 = h ? bgv.hi : bgv.lo, bl2 = h ? blv.hi : blv.lo;
                    f32x2 gl = g2 * RS + bg2, ln = l2 * RS + bl2;
                    gl.x = fminf(gl.x, 7.0f); gl.y = fminf(gl.y, 7.0f); ln.x = __builtin_amdgcn_fmed3f(ln.x, -7.0f, 7.0f); ln.y = __builtin_amdgcn_fmed3f(ln.y, -7.0f, 7.0f);
                    const f32x2 ea = gl * (-1.702f * LOG2E); f32x2 d; d.x = __builtin_amdgcn_exp2f(ea.x); d.y = __builtin_amdgcn_exp2f(ea.y); d = d + 1.0f;
                    f32x2 rc; rc.x = __builtin_amdgcn_rcpf(d.x); rc.y = __builtin_amdgcn_rcpf(d.y);
                    const f32x2 o = (gl * rc) * (ln * SA8 + SA8);
                    if (n == 0) { o0[2 * h] = o.x; o0[2 * h + 1] = o.y; } else { o1[2 * h] = o.x; o1[2 * h + 1] = o.y; } }
            v2u w; { int r0 = __builtin_amdgcn_cvt_pk_fp8_f32(o0[0], o0[1], 0, false); r0 = __builtin_amdgcn_cvt_pk_fp8_f32(o0[2], o0[3], r0, true); int r1 = __builtin_amdgcn_cvt_pk_fp8_f32(o1[0], o1[1], 0, false); r1 = __builtin_amdgcn_cvt_pk_fp8_f32(o1[2], o1[3], r1, true); w.x = (unsigned)r0; w.y = (unsigned)r1; }
            wq[ai][m] = w; EPI_ROWS_END
#pragma unroll
        for (int ai = 0; ai < 2; ++ai)
#pragma unroll
            for (int mp = 0; mp < 2; ++mp) { const size_t rA = (size_t)(u.row0 + ai * 128 + wr * 64 + (2 * mp) * 16 + fr);
                store_rowpair16(act, rA, rA + 16, u.col0 + wc * 32 + 8 * (fq & 2), fq, wq[ai][2 * mp], wq[ai][2 * mp + 1]); }
    } };
struct EpiDown8 { const float* bdn; bf16* ys; LAS float* slot;
    static constexpr bool HAS_PRE = true;
    __device__ __forceinline__ void pre(const pg8::Unit& u, int wid, int lane) const {
        if (wid < 4) __builtin_amdgcn_global_load_lds((const unsigned*)(bdn + (size_t)u.z * 1024 + u.col0 + wid * 64 + lane), (LAS unsigned*)(slot + u.par * 256 + wid * 64), 4, 0, 0); }
    __device__ __forceinline__ void operator()(EPI_ARGS) const {
        const int c8 = u.col0 + wc * 32 + 8 * fq; const LAS float* bb = slot + u.par * 256 + wc * 32 + 8 * fq; constexpr float RS = 1.0f / (SA8 * SWD8);
        f32x4 bv[2][2];
#pragma unroll
        for (int bj = 0; bj < 2; ++bj) { bv[bj][0] = *(const LAS f32x4*)(bb + bj * 128); bv[bj][1] = *(const LAS f32x4*)(bb + bj * 128 + 4); }
#pragma unroll
        for (int ai = 0; ai < 2; ++ai)
#pragma unroll
            for (int mp = 0; mp < 2; ++mp) { const size_t rA = (size_t)(u.row0 + ai * 128 + wr * 64 + (2 * mp) * 16 + fr);
#pragma unroll
                for (int bj = 0; bj < 2; ++bj) { v2u w[2];
#pragma unroll
                    for (int mm = 0; mm < 2; ++mm) { const int m = 2 * mp + mm; const f32x4 v0 = (acc[ai][bj][m][0] * RS + bv[bj][0]) * SY8, v1 = (acc[ai][bj][m][1] * RS + bv[bj][1]) * SY8; w[mm].x = pk4_fp8(v0[0], v0[1], v0[2], v0[3]); w[mm].y = pk4_fp8(v1[0], v1[1], v1[2], v1[3]); }
                    store_rowpair16((unsigned char*)ys, rA, rA + 16, u.col0 + wc * 32 + 8 * (fq & 2) + bj * 128, fq, w[0], w[1]); } }
    } };
struct EpiValGate { const bf16* xb; bf16* zb; float rsv, rsg; unsigned char* z8; float* st; LAS float* tab;
    __device__ __forceinline__ void operator()(EPI_ARGS) const {
        float ss[8], qq[8]; v4u xr[2][4];
        EPI_ROWS_BEGIN xr[ai][m] = *(const GAS v4u*)(xb + (size_t)(u.row0 + rloc) * DM + u.col0 + wc * 32 + 8 * fq); EPI_ROWS_END
        v2u hold8;
        EPI_ROWS_BEGIN const size_t off = (size_t)(u.row0 + rloc) * DM + u.col0 + wc * 32 + 8 * fq; f32x4 x0, x1; unpack8(xr[ai][m], x0, x1); f32x4 o0, o1;
#pragma unroll
            for (int j = 0; j < 4; ++j) { o0[j] = x0[j] * ALPHA + acc[ai][0][m][0][j] * rsv * sigmoidf_(acc[ai][1][m][0][j] * rsg); o1[j] = x1[j] * ALPHA + acc[ai][0][m][1][j] * rsv * sigmoidf_(acc[ai][1][m][1][j] * rsg); }
            *(GAS v4u*)(zb + off) = pack8(o0, o1);
            { v2u w; w.x = pk4_fp8(o0[0] * SZ8, o0[1] * SZ8, o0[2] * SZ8, o0[3] * SZ8); w.y = pk4_fp8(o1[0] * SZ8, o1[1] * SZ8, o1[2] * SZ8, o1[3] * SZ8); ST8_ROWPAIR(z8, u.row0 + rloc, u.col0 + wc * 32 + 8 * (fq & 2), hold8, w, DM); }
            float s = ((o0[0] + o0[1]) + (o0[2] + o0[3])) + ((o1[0] + o1[1]) + (o1[2] + o1[3])), q = ((o0[0] * o0[0] + o0[1] * o0[1]) + (o0[2] * o0[2] + o0[3] * o0[3])) + ((o1[0] * o1[0] + o1[1] * o1[1]) + (o1[2] * o1[2] + o1[3] * o1[3]));
            s += __shfl_xor(s, 16); s += __shfl_xor(s, 32); q += __shfl_xor(q, 16); q += __shfl_xor(q, 32); ss[ai * 4 + m] = s; qq[ai * 4 + m] = q;
            asm volatile("" ::: "memory"); EPI_ROWS_END
        rowpair_publish(tab, st, 8, u.col0 >> 7, u.row0, ss, qq, wr, wc, fr, fq);
    } };

#ifndef ONLY_SITE
#define ONLY_SITE -1
#endif
#define SITE(s) (ONLY_SITE < 0 || ONLY_SITE == (s))
#define IN(k) (lo <= (k) && (k) < hi)
#define SEAM(k) do { if (IN(k) && IN((k) + 1)) xcd_barrier(bar); } while (0)
__device__ __forceinline__ void fold_layer1(Frame& F, const Args& args) {
    unsigned char* ws = args.ws;
    FoldSched S{F.G, F.vcu, 0, (const char*)(ws + WS_KB), (const char*)(ws + WS_VB), (const char*)(ws + WS_XQB) + 1024 * 1024 * 2, (const char*)(ws + WS_XOT) + 1024 * 1024 * 2};
    EpiFold E{ws + WS_KFT, ws + WS_VFT, args.in[39], args.in[40], (float*)(ws + WS_SCC) + (size_t)16384 * 8, (LAS float*)(F.lds + SMX_OFF)}; int kf = 256; asm volatile("" : "+s"(kf)); pg8::gemm_phase<EpiFold, FoldSched>(F.lds, kf, S, E);
}
template <int l>
__device__ __forceinline__ void layer_shared(Frame& F, const Args& args, const XcdBarrier& bar, const int lo, const int hi) {
    unsigned char* ws = args.ws; bf16* const XB = (bf16*)(ws + WS_XB); bf16* const ZB = (bf16*)(ws + WS_ZB); const int cid = (int)blockIdx.x;
    constexpr int pb = 5 + 14 * l;
        gu32* cnt = F.ctl + CW_CNT + l * 32 * 64;
    const float* st1 = (const float*)(ws + WS_ST) + (size_t)l * MTOK * 16; const float* sc1 = (const float*)(ws + WS_SCC) + (size_t)l * 16384 * 8;
    if (IN(pb + 1) && SITE(6)) { PlainSched S; S.T.init(MTOK / 256, 4, F.G, cid); S.A = (const char*)(ws + WS_XFZ); S.B = (const char*)(ws + WS_KFT); S.tilesPerBatch = SEQ / 256; S.bBatch = (size_t)1024 * 1024; S.splitN = 0; S.aT = (size_t)256 * 1024; S.bT = (size_t)256 * 1024;
        EpiSoftmaxP E{(bf16*)(ws + WS_P), (LAS float*)(F.lds + SMX_OFF), 1.0f / (SZ8 * SK8), st1, sc1, l ? 8 : 4}; pg8::gemm_phase<EpiSoftmaxP, PlainSched, false, true>(F.lds, 1024, S, E); } SEAM(pb + 1);
    if (IN(pb + 3) && SITE(8)) { PlainSched S; S.T.init(MTOK / 256, 4, F.G, cid); S.A = (const char*)(ws + WS_P); S.B = (const char*)(ws + WS_VFT); S.tilesPerBatch = SEQ / 256; S.bBatch = (size_t)1024 * 1024; S.splitN = 0; S.aT = (size_t)256 * 1024; S.bT = (size_t)256 * 1024;
        EpiResidLN E{ZB, 1.0f / (SP8 * SV8), st1, (LAS float*)(F.lds + SMX_OFF), (l ? args.in[39] : args.in[14]), (l ? args.in[40] : args.in[15]), l ? 8 : 4}; pg8::gemm_phase<EpiResidLN, PlainSched, false, true>(F.lds, 1024, S, E); } SEAM(pb + 3);
    if (IN(pb + 4) && SITE(9)) { ph_ln2_router(F, ZB, XB, MOE_FP8 ? ws + WS_XF8 : nullptr, (l ? args.in[43] : args.in[18]), (l ? args.in[44] : args.in[19]), (const bf16*)(ws + WS_WR) + (size_t)l * 256 * 1024,
                                               (l ? args.in[46] : args.in[21]), cnt, (int*)(ws + WS_LIST), (float*)(ws + WS_GATE), (int*)(ws + WS_ASG), (float*)(ws + WS_ST2)); } SEAM(pb + 4);
    if (IN(pb + 7) && SITE(12)) { moe_tables(F, cnt);
#if MOE_FP8
        MoeSched S{(LAS const int*)(F.lds + TAB_OFF), 8, F.G, F.vcu, (const char*)(ws + WS_XF8), (const char*)(ws + ((l && CVT1_IN_UP) ? WS_WUP8_1 : WS_WUP8)), (size_t)2048 * 1024, 128, (const int*)(ws + WS_LIST), true, (size_t)256 * 1024};
        const bool cvt_here = (l == 0) && CVT1_IN_UP && !CVT1_IN_ATTN && F.G == 256, cvt_first = (F.vcu & 1) == 0;
        if (cvt_here && cvt_first) { cvt_experts(F, args.in[47], args.in[49], ws, ws + WS_WUP8_1, ws + WS_WDN8_1); __syncthreads(); }
        EpiSwiglu8 E{(l ? args.in[48] : args.in[23]), ws + WS_ACT, args.variant == 9, (LAS float*)(F.lds + SMX_OFF)}; pg8::gemm_phase<EpiSwiglu8, MoeSched, true, true>(F.lds, 1024, S, E);
        if (cvt_here && !cvt_first) { __syncthreads(); cvt_experts(F, args.in[47], args.in[49], ws, ws + WS_WUP8_1, ws + WS_WDN8_1); }
#else
        MoeSched S{(LAS const int*)(F.lds + TAB_OFF), 8, F.G, F.vcu, (const char*)XB, (const char*)(ws + WS_WUP), (size_t)2048 * 1024 * 2, 128, (const int*)(ws + WS_LIST), true, pg8::TSTEP};
        EpiSwiglu E{(l ? args.in[48] : args.in[23]), (bf16*)(ws + WS_ACT)}; pg8::gemm_phase<EpiSwiglu, MoeSched, true>(F.lds, 1024, S, E);
#endif
    } SEAM(pb + 7);
    if (IN(pb + 8) && SITE(13)) { moe_tables(F, cnt);
#if MOE_FP8
        MoeSched S{(LAS const int*)(F.lds + TAB_OFF), 4, F.G, F.vcu, (const char*)(ws + WS_ACT), (const char*)(ws + ((l && CVT1_IN_UP) ? WS_WDN8_1 : WS_WDN8)), (size_t)1024 * 1024, 256, (const int*)(ws + WS_LIST), false, (size_t)256 * 1024};
        EpiDown8 E{(l ? args.in[50] : args.in[25]), (bf16*)(ws + WS_YS), (LAS float*)(F.lds + SMX_OFF)}; pg8::gemm_phase<EpiDown8, MoeSched, false, true>(F.lds, 1024, S, E);
#else
        MoeSched S{(LAS const int*)(F.lds + TAB_OFF), 4, F.G, F.vcu, (const char*)(ws + WS_ACT), (const char*)(ws + WS_WDN), (size_t)1024 * 1024 * 2, 256, (const int*)(ws + WS_LIST), false, pg8::TSTEP};
        EpiDown E{(l ? args.in[50] : args.in[25]), (const int*)(ws + WS_LIST), (const float*)(ws + WS_GATE), (bf16*)(ws + WS_YS), (LAS const int*)(F.lds + TAB_OFF)}; pg8::gemm_phase<EpiDown, MoeSched, false>(F.lds, 1024, S, E);
#endif
    } SEAM(pb + 8);
    if (IN(pb + 9) && SITE(14)) {
        const bool fold_here = (l == 0) && FOLD1_IN_LN3 && F.G == 256, fold_first = (F.vcu & 1) == 0;
        if (fold_here && fold_first) { fold_layer1(F, args); __syncthreads(); }
        moe_tables(F, cnt); ph_ln<1>(F, ZB, (const bf16*)(ws + WS_YS), XB, l ? args.out : nullptr, (l ? args.in[51] : args.in[26]), (l ? args.in[52] : args.in[27]), (l == 0) ? ws + WS_XF8 : nullptr, (const int*)(ws + WS_ASG), (const float*)(ws + WS_GATE),
                                                             (const float*)(ws + WS_ST2), (l ? args.in[43] : args.in[18]), (l ? args.in[44] : args.in[19]));
        if (fold_here && !fold_first) { __syncthreads(); fold_layer1(F, args); }
        if (l == 0 && !(CVT1_IN_UP && F.G == 256)) { __syncthreads(); if (CVT1_IN_UP) cvt_experts(F, args.in[47], args.in[49], ws, ws + WS_WUP8_1, ws + WS_WDN8_1); else cvt_experts(F, args.in[47], args.in[49], ws); } } SEAM(pb + 9);
}

constexpr int PH_TOTAL = 29;
__global__ void __launch_bounds__(NWAVES * 64, 2) mk_fwd(Args args) {
    extern __shared__ __attribute__((aligned(16))) unsigned char lds[];
    Frame F;
    F.lds = (LAS unsigned char*)lds; F.MISC = (volatile LAS unsigned*)(F.lds + MISC_OFF);
    F.wave = __builtin_amdgcn_readfirstlane((int)threadIdx.x >> 6);
    F.G = gridDim.x; { const int bx = blockIdx.x; F.vcu = (F.G % 8 == 0) ? (bx % 8) * (F.G / 8) + bx / 8 : bx; }
    unsigned char* ws = args.ws;
    F.ctl = (gu32*)(ws + WS_CTL);
    for (int u = FTID; u < (LDS_BYTES - LDSCTL_OFF) / 4; u += NWAVES * 64) ((LAS unsigned*)(F.lds + LDSCTL_OFF))[u] = 0u;
    __syncthreads();
    const int lo = args.ph_lo, hi = args.ph_hi;
    XcdBarrier bar; bar.bar = (unsigned*)(F.ctl + CW_BAR); bar.x = 0; bar.st = nullptr;
    if (hi - lo > 1) bar = xcd_barrier_post((unsigned*)(F.ctl + CW_BAR), F.MISC + 8);
    bf16* const XB = (bf16*)(ws + WS_XB); bf16* const ZB = (bf16*)(ws + WS_ZB);
    const int cid = (int)blockIdx.x;

    const bool kv_in_p0 = KV_IN_P0 && (H0_FP8 == 2) && F.G == 256 && (hi - lo > 1);
    if (IN(0) && SITE(0)) {
        if (!kv_in_p0) p0_prologue(F, args, true, 0, (size_t)MTOK * DM, F.vcu, F.G);
        else { p0_prologue(F, args, true, 0, 0, 0, 1);
            xcd_barrier(bar);
            constexpr size_t NX = (size_t)MTOK * DM, XE = NX / 4 * 3;
            if (F.vcu & 1) { { PlainSched S; S.T.init(NB * MEMLEN / 256, 2048 / 256, F.G / 2, F.vcu >> 1); S.A = (const char*)(ws + WS_MEMB); S.B = (const char*)(ws + WS_WKV); S.tilesPerBatch = 1 << 20; S.bBatch = 0; S.splitN = 4;
                  EpiStore E{(bf16*)(ws + WS_KB), (bf16*)(ws + WS_VB), 1.f, 1.f, 1024}; pg8::gemm_phase<EpiStore, PlainSched>(F.lds, 1024, S, E); }
                __syncthreads(); p0_prologue(F, args, false, XE, NX, F.vcu >> 1, F.G / 2); }
            else p0_prologue(F, args, false, 0, XE, F.vcu >> 1, F.G / 2); }
    } SEAM(0);
    if (IN(1) && SITE(1)) {
        if (H0_FP8 == 2) { PlainSched S; S.T.init(MTOK / 256, HW0 / 256, F.G, cid); S.A = (const char*)(ws + WS_XF8); S.B = (const char*)(ws + WS_WIN0F8); S.tilesPerBatch = 1 << 20; S.bBatch = 0; S.splitN = 0; S.aT = (size_t)256 * 1024; S.bT = (size_t)256 * 1024;
            EpiH0 E{(bf16*)(ws + WS_UV), (bf16*)(ws + WS_QX), (bf16*)(ws + WS_KX), (bf16*)(ws + WS_VX), 1.0f / (SX8 * SWU8)}; pg8::gemm_phase<EpiH0, PlainSched, false, true>(F.lds, 1024, S, E); }
        else if (H0_FP8) {
          { PlainSched S; S.T.init(MTOK / 256, 6, F.G, cid); S.A = (const char*)(ws + WS_XF8); S.B = (const char*)(ws + WS_WIN0F8); S.tilesPerBatch = 1 << 20; S.bBatch = 0; S.splitN = 0; S.aT = (size_t)256 * 1024; S.bT = (size_t)256 * 1024; S.pnSkipFrom = 4; S.pnSkip = 4;
            EpiH0 E{(bf16*)(ws + WS_UV), (bf16*)(ws + WS_QX), (bf16*)(ws + WS_KX), (bf16*)(ws + WS_VX), 1.0f / (SX8 * SWU8)}; pg8::gemm_phase<EpiH0, PlainSched, false, true>(F.lds, 1024, S, E); }
          { PlainSched S; S.T.init(MTOK / 256, 4, F.G, cid); S.A = (const char*)XB; S.B = (const char*)(ws + WS_WIN0); S.tilesPerBatch = 1 << 20; S.bBatch = 0; S.splitN = 0; S.pnAdd = 4;
            EpiH0 E{(bf16*)(ws + WS_UV), (bf16*)(ws + WS_QX), (bf16*)(ws + WS_KX), (bf16*)(ws + WS_VX), 1.0f}; pg8::gemm_phase<EpiH0, PlainSched>(F.lds, 1024, S, E); } }
        else { PlainSched S; S.T.init(MTOK / 256, HW0 / 256, F.G, cid); S.A = (const char*)XB; S.B = (const char*)(ws + WS_WIN0); S.tilesPerBatch = 1 << 20; S.bBatch = 0; S.splitN = 0;
          EpiH0 E{(bf16*)(ws + WS_UV), (bf16*)(ws + WS_QX), (bf16*)(ws + WS_KX), (bf16*)(ws + WS_VX), 1.0f}; pg8::gemm_phase<EpiH0, PlainSched>(F.lds, 1024, S, E); }
        if (!kv_in_p0) { PlainSched S; S.T.init(NB * MEMLEN / 256, 2048 / 256, F.G, cid); S.A = (const char*)(ws + WS_MEMB); S.B = (const char*)(ws + WS_WKV); S.tilesPerBatch = 1 << 20; S.bBatch = 0; S.splitN = 4;
          EpiStore E{(bf16*)(ws + WS_KB), (bf16*)(ws + WS_VB), 1.f, 1.f, 1024}; pg8::gemm_phase<EpiStore, PlainSched>(F.lds, 1024, S, E); }
    } SEAM(1);
    if (IN(2) && SITE(2)) {
        const bool cvt_here = CVT0_IN_ATTN && MOE_FP8 && F.G == 256; const int grp = cvt_here ? (int)((F.vcu >> 2) & 3) : 3;
#define P2_CONVERT() do { cvt_experts(F, args.in[22], args.in[24], ws); __syncthreads(); if (CVT1_IN_ATTN) { cvt_experts(F, args.in[47], args.in[49], ws, ws + WS_WUP8_1, ws + WS_WDN8_1); __syncthreads(); } } while (0)
        if (cvt_here && grp == 0) P2_CONVERT();
        if (grp < 2) { ph_sgu(F, (const bf16*)(ws + WS_UV), (bf16*)(ws + WS_MIX), args.in[4], args.in[5], args.in[6], args.in[7]); __syncthreads(); }
        if (cvt_here && grp == 1) P2_CONVERT();
        if (F.G == 256) { const int b_ = F.vcu >> 4, h_ = (F.vcu >> 2) & 3, x_ = F.vcu & 3, L0 = ((b_ * 8 + 2 * h_) * 4 + x_);
            a128::attn_phase128((char*)lds, (const a128::TIN*)(ws + WS_QX), (const a128::TIN*)(ws + WS_KX), (const a128::TIN*)(ws + WS_VX), (a128::TOUT*)(ws + WS_OATT), L0, 4, L0 + 4); }
        else a128::attn_phase128((char*)lds, (const a128::TIN*)(ws + WS_QX), (const a128::TIN*)(ws + WS_KX), (const a128::TIN*)(ws + WS_VX), (a128::TOUT*)(ws + WS_OATT), (int)blockIdx.x, (int)F.G, 511);
        VM_WAIT(); __syncthreads();
        if (F.G == 256) combine_local(F, (const bf16*)(ws + WS_OATT), (bf16*)(ws + WS_MIX), args.in[8], args.in[9], args.in[10], args.in[11], args.in[12], F.vcu >> 4, (F.vcu >> 2) & 3, F.vcu & 3);
        __syncthreads();
        if (cvt_here && grp == 2) P2_CONVERT();
        if (grp >= 2) { ph_sgu(F, (const bf16*)(ws + WS_UV), (bf16*)(ws + WS_MIX), args.in[4], args.in[5], args.in[6], args.in[7]); __syncthreads(); }
        if (cvt_here && grp == 3) P2_CONVERT();
#undef P2_CONVERT
    } SEAM(2);
    if (IN(3) && SITE(3)) { if (F.G != 256) ph_combine_hm(F, (const bf16*)(ws + WS_OATT), (bf16*)(ws + WS_MIX), args.in[8], args.in[9], args.in[10], args.in[11], args.in[12]); } if (F.G != 256) SEAM(3);
    if (IN(4) && SITE(4)) {
        { PlainSched S; S.T.init(MTOK / 256, 4, F.G, cid); S.A = (const char*)(ws + WS_MIX); S.B = (const char*)(ws + WS_WOUT0); S.tilesPerBatch = 1 << 20; S.bBatch = 0; S.splitN = 0;
          EpiResidStats E{XB, ZB, ws + WS_XFZ, (float*)(ws + WS_ST), (LAS float*)(F.lds + SMX_OFF)}; pg8::gemm_phase<EpiResidStats, PlainSched>(F.lds, 1024, S, E); }
        { FoldSched S{F.G, F.vcu, 0, (const char*)(ws + WS_KB), (const char*)(ws + WS_VB), (const char*)(ws + WS_XQB), (const char*)(ws + WS_XOT)};
          EpiFold E{ws + WS_KFT, ws + WS_VFT, args.in[14], args.in[15], (float*)(ws + WS_SCC), (LAS float*)(F.lds + SMX_OFF)}; int kf = 256; asm volatile("" : "+s"(kf)); pg8::gemm_phase<EpiFold, FoldSched>(F.lds, kf, S, E); }
    } SEAM(4);

    layer_shared<0>(F, args, bar, lo, hi);
    if (IN(15) && SITE(15)) { { PlainSched S; S.T.init(MTOK / 256, 4, F.G, cid); S.A = (const char*)(ws + WS_XF8); S.B = (const char*)(ws + WS_WIN1); S.tilesPerBatch = 1 << 20; S.bBatch = 0; S.splitN = 0; S.aT = (size_t)256 * 1024; S.bT = (size_t)256 * 1024;
        EpiUG E{(bf16*)(ws + WS_UG), 1.0f / (SX8 * SWU8)}; pg8::gemm_phase<EpiUG, PlainSched, false, true>(F.lds, 1024, S, E); }
        if (!(FOLD1_IN_LN3 && F.G == 256)) fold_layer1(F, args);
    } SEAM(15);
    if (IN(16) && SITE(16)) { ph_s5(F, (const bf16*)(ws + WS_UG), (bf16*)(ws + WS_YB), args.in[29], args.in[30], args.in[31], args.in[32], args.in[33], args.in[34], args.in[35], args.in[36], args.variant); } SEAM(16);
    if (IN(17) && SITE(17)) { PlainSched S; S.T.init(MTOK / 256, 8, F.G, cid); S.A = (const char*)(ws + WS_YB); S.B = (const char*)(ws + WS_WVG); S.tilesPerBatch = 1 << 20; S.bBatch = 0; S.splitN = 0; S.aT = (size_t)256 * 16; S.bT = (size_t)256 * 1024;
        struct VGS { PlainSched P; __device__ __forceinline__ bool next(int i, pg8::Unit& u) const { if (!P.next(i, u)) return false; u.col0 >>= 1; return true; } } S2{S};
        EpiValGate E{XB, ZB, 1.0f / (SA8 * SWD8), 1.0f / (SA8 * SWU8), ws + WS_XFZ, (float*)(ws + WS_ST) + (size_t)MTOK * 16, (LAS float*)(F.lds + SMX_OFF)}; pg8::gemm_phase<EpiValGate, VGS, false, true, 1>(F.lds, 1024, S2, E); } SEAM(17);
    layer_shared<1>(F, args, bar, lo, hi);
#undef IN
#undef SEAM
}

extern "C" void kernel_launch(void* const* d_in, const int* in_sizes, int n_in, void* d_out, int out_size, void* d_ws, size_t ws_size, hipStream_t stream) {
    static int grid = 0;
    if (grid == 0) {
        if (n_in != 53 || in_sizes[0] != MTOK * DM || out_size != MTOK * DM || ws_size < WS_END) { fprintf(stderr, "kernel_launch: unexpected problem (n_in %d, in0 %d, out %d, ws %zu < %zu); nothing launched\n", n_in, n_in > 0 ? in_sizes[0] : -1, out_size, ws_size, (size_t)WS_END); grid = -1; return; }
        int dev = 0, cus = 0, per_cu = 0;
        if (hipGetDevice(&dev) != hipSuccess || hipDeviceGetAttribute(&cus, hipDeviceAttributeMultiprocessorCount, dev) != hipSuccess) { grid = -1; return; }
        if (hipFuncSetAttribute((const void*)mk_fwd, hipFuncAttributeMaxDynamicSharedMemorySize, LDS_BYTES) != hipSuccess) { fprintf(stderr, "kernel_launch: hipFuncSetAttribute failed\n"); grid = -1; return; }
        if (hipOccupancyMaxActiveBlocksPerMultiprocessor(&per_cu, (const void*)mk_fwd, NWAVES * 64, LDS_BYTES) != hipSuccess || per_cu < 1) fprintf(stderr, "kernel_launch: note: occupancy query reports %d\n", per_cu);
        (void)hipGetLastError();
        grid = cus;
    }
    if (grid < 0) return;
    if (hipMemsetAsync((char*)d_ws + WS_CTL, 0, CTL_ZERO_BYTES, stream) != hipSuccess) return;
    Args a{};
    for (int i = 0; i < 53; ++i) a.in[i] = (const float*)d_in[i];
    a.out = (float*)d_out; a.ws = (unsigned char*)d_ws;
#if MK_N_LAUNCHES == 1
    a.ph_lo = 0; a.ph_hi = PH_TOTAL;
    hipLaunchKernelGGL(mk_fwd, dim3(grid), dim3(NWAVES * 64), LDS_BYTES, stream, a);
#else
    for (int p = 0; p < PH_TOTAL; ++p) { if (p == 18 || p == 5 || p == 19) continue; a.ph_lo = p; a.ph_hi = p + 1;
        for (int rep = 0; rep < 1 + (int)(((PROBE_REPEAT_MASK) >> p) & 1ull); ++rep) { a.variant = (rep == 0 && (((PROBE_REPEAT_MASK) >> p) & 1ull)) ? PROBE_VARIANT : 0; hipLaunchKernelGGL(mk_fwd, dim3(grid), dim3(NWAVES * 64), LDS_BYTES, stream, a); } }
#endif
}
```
